# Optimizing an MI355X kernel written in HIP

```python
import math
import jax, jax.numpy as jnp
from jax import lax
import numpy as np

D_MODEL = 1024
BATCH = 16
SEQ = 4096
DEPTH = 4

HEAD_DIM = 64
BLOCK = 128
A_HEADS = D_MODEL // (2 * HEAD_DIM)
A_KV_HEADS = 2
A_GROUP = A_HEADS // A_KV_HEADS
WINDOW = 128
B_HEADS = D_MODEL // (4 * HEAD_DIM)
B_VDIM = 2 * HEAD_DIM
C_HEADS = D_MODEL // HEAD_DIM
N_BUCKETS = 32
MAX_EXACT = N_BUCKETS // 2
MAX_DISTANCE = 128
SOFT_HEADS = A_HEADS + B_HEADS
A_Q = A_HEADS * HEAD_DIM
A_KV = A_KV_HEADS * HEAD_DIM
B_QK = B_HEADS * 2 * HEAD_DIM
B_V = B_HEADS * B_VDIM
EVEN_IN = A_Q + 2 * A_KV + 2 * B_QK + B_V
EVEN_OUT = A_Q + B_V
EVEN_SPLITS = [A_Q, A_Q + A_KV, A_Q + 2 * A_KV, A_Q + 2 * A_KV + B_QK, A_Q + 2 * A_KV + 2 * B_QK]
C_WIDTH = C_HEADS * HEAD_DIM
ODD_IN = 3 * C_WIDTH
D_FF = 2816
CONV_W = 3
N_EVEN = (DEPTH + 1) // 2
N_ODD = DEPTH // 2
EPS = 1e-6
SCALE = HEAD_DIM ** -0.5

kernel_name = "hybrid_swa_sink_diff_stickbreak_convffn"


def rms_norm(x, g):
    x32 = x.astype(jnp.float32)
    y = x32 * lax.rsqrt(jnp.mean(x32 * x32, axis=-1, keepdims=True) + EPS)
    return (y * g.astype(jnp.float32)).astype(x.dtype)


def t5_bucket(dist):
    n = jnp.maximum(dist, 0)
    nf = jnp.maximum(n, 1).astype(jnp.float32)
    large = MAX_EXACT + (jnp.log(nf / MAX_EXACT) / math.log(MAX_DISTANCE / MAX_EXACT)
                         * (N_BUCKETS - MAX_EXACT)).astype(jnp.int32)
    large = jnp.minimum(large, N_BUCKETS - 1)
    return jnp.where(n < MAX_EXACT, n, large)


def sliding_window_sink_attention(q, k, v, sinks, bias_table):
    bsz, seq = q.shape[:2]
    nb = seq // BLOCK
    qb = q.reshape(bsz, nb, BLOCK, A_KV_HEADS, A_GROUP, HEAD_DIM)

    def band(t):
        tb = t.reshape(bsz, nb, BLOCK, A_KV_HEADS, HEAD_DIM)
        prev = jnp.concatenate([jnp.zeros_like(tb[:, :1]), tb[:, :-1]], axis=1)
        return jnp.concatenate([prev, tb], axis=2)

    kb, vb = band(k), band(v)
    qi = jnp.arange(BLOCK)[:, None]
    kj = jnp.arange(2 * BLOCK)[None, :]
    dist = qi + BLOCK - kj
    in_window = (dist >= 0) & (dist < WINDOW)
    blk = jnp.arange(nb)[:, None, None]
    valid = in_window[None] & (blk * BLOCK - BLOCK + kj[None] >= 0)
    bias = bias_table[t5_bucket(dist)]
    bias = bias.reshape(BLOCK, 2 * BLOCK, A_KV_HEADS, A_GROUP).transpose(2, 3, 0, 1)
    s = jnp.einsum('bnqhgd,bnkhd->bnhgqk', qb, kb).astype(jnp.float32) * SCALE + bias
    s = jnp.where(valid[None, :, None, None], s, -jnp.inf)
    sink = sinks.astype(jnp.float32).reshape(A_KV_HEADS, A_GROUP)[None, None, :, :, None, None]
    m = jnp.maximum(jnp.max(s, axis=-1, keepdims=True), sink)
    p = jnp.exp(s - m)
    w = p / (jnp.sum(p, axis=-1, keepdims=True) + jnp.exp(sink - m))
    o = jnp.einsum('bnhgqk,bnkhd->bnqhgd', w.astype(v.dtype), vb)
    return o.reshape(bsz, seq, A_Q)


def differential_attention(q1, q2, k1, k2, v, lam, lambda_init, bias_table, gain):
    bsz, seq = q1.shape[:2]
    nb = seq // BLOCK
    kpos = jnp.arange(seq)

    def block(i):
        start = i * BLOCK
        qpos = start + jnp.arange(BLOCK)
        dist = qpos[:, None] - kpos[None, :]
        causal = dist >= 0
        bias = bias_table[t5_bucket(dist)].transpose(2, 0, 1)

        def probs(q, k):
            qb = lax.dynamic_slice_in_dim(q, start, BLOCK, axis=1)
            s = jnp.einsum('bqhd,bkhd->bhqk', qb, k).astype(jnp.float32) * SCALE + bias
            return jax.nn.softmax(jnp.where(causal, s, -jnp.inf), axis=-1)

        w = probs(q1, k1) - lam * probs(q2, k2)
        return jnp.einsum('bhqk,bkhe->bqhe', w.astype(v.dtype), v)

    o = lax.map(block, jnp.arange(nb))
    o = o.transpose(1, 0, 2, 3, 4).reshape(bsz, seq, B_HEADS, B_VDIM)
    o = rms_norm(o, gain) * (1.0 - lambda_init)
    return o.reshape(bsz, seq, B_V)


def stick_breaking_attention(q, k, v):
    bsz, seq = q.shape[:2]
    nb = seq // BLOCK
    kpos = jnp.arange(seq)

    def block(i):
        start = i * BLOCK
        qb = lax.dynamic_slice_in_dim(q, start, BLOCK, axis=1)
        qpos = start + jnp.arange(BLOCK)
        strict = (qpos[:, None] - kpos[None, :]) > 0
        z = jnp.einsum('bqhd,bkhd->bhqk', qb, k).astype(jnp.float32) * SCALE
        log_beta = jax.nn.log_sigmoid(z)
        log_1m_beta = jnp.where(strict, log_beta - z, 0.0)
        later = lax.cumsum(log_1m_beta, axis=3, reverse=True) - log_1m_beta
        a = jnp.where(strict, jnp.exp(log_beta + later), 0.0)
        return jnp.einsum('bhqk,bkhd->bqhd', a.astype(v.dtype), v)

    o = lax.map(block, jnp.arange(nb))
    return o.transpose(1, 0, 2, 3, 4).reshape(bsz, seq, C_WIDTH)


def conv_gated_ffn(h, w_up, w_conv, b_conv, w_down):
    seq = h.shape[1]
    u = h @ w_up
    up = jnp.pad(u, ((0, 0), (CONV_W - 1, 0), (0, 0)))
    u = sum(up[:, tap:tap + seq] * w_conv[tap] for tap in range(CONV_W)) + b_conv
    gate, val = jnp.split(u, 2, axis=-1)
    return (jax.nn.silu(gate) * val) @ w_down


def setup_inputs(seed: int = 0) -> dict:
    key = jax.random.key(seed)
    ks = jax.random.split(key, 22)

    def nrm(k, shape, scale):
        return jax.random.normal(k, shape, jnp.float32) * scale

    return {
        "x": nrm(ks[0], (BATCH, SEQ, D_MODEL), 1.0),
        "rel_bias": nrm(ks[1], (N_BUCKETS, SOFT_HEADS), 0.5),
        "norm_mix": 1.0 + nrm(ks[2], (DEPTH, D_MODEL), 0.02),
        "norm_ffn": 1.0 + nrm(ks[3], (DEPTH, D_MODEL), 0.02),
        "norm_final": 1.0 + nrm(ks[4], (D_MODEL,), 0.02),
        "w_in_even": nrm(ks[5], (N_EVEN, D_MODEL, EVEN_IN), D_MODEL ** -0.5),
        "w_out_even": nrm(ks[6], (N_EVEN, EVEN_OUT, D_MODEL), EVEN_OUT ** -0.5),
        "sinks": nrm(ks[7], (N_EVEN, A_HEADS), 0.5),
        "lam_q1": nrm(ks[8], (N_EVEN, HEAD_DIM), 0.1),
        "lam_k1": nrm(ks[9], (N_EVEN, HEAD_DIM), 0.1),
        "lam_q2": nrm(ks[10], (N_EVEN, HEAD_DIM), 0.1),
        "lam_k2": nrm(ks[11], (N_EVEN, HEAD_DIM), 0.1),
        "diff_norm": 1.0 + nrm(ks[12], (N_EVEN, B_VDIM), 0.02),
        "w_in_odd": nrm(ks[13], (N_ODD, D_MODEL, ODD_IN), D_MODEL ** -0.5),
        "w_out_odd": nrm(ks[14], (N_ODD, C_WIDTH, D_MODEL), C_WIDTH ** -0.5),
        "ffn_up": nrm(ks[15], (DEPTH, D_MODEL, 2 * D_FF), D_MODEL ** -0.5),
        "ffn_conv": nrm(ks[16], (DEPTH, CONV_W, 2 * D_FF), CONV_W ** -0.5),
        "ffn_conv_b": nrm(ks[17], (DEPTH, 2 * D_FF), 0.02),
        "ffn_down": nrm(ks[18], (DEPTH, D_FF, D_MODEL), D_FF ** -0.5),
    }


def reference(x, rel_bias, norm_mix, norm_ffn, norm_final, w_in_even, w_out_even, sinks,
              lam_q1, lam_k1, lam_q2, lam_k2, diff_norm, w_in_odd, w_out_odd,
              ffn_up, ffn_conv, ffn_conv_b, ffn_down):
    bsz, seq = x.shape[:2]
    for layer in range(DEPTH):
        h = rms_norm(x, norm_mix[layer])
        if layer % 2 == 0:
            e = layer // 2
            proj = h @ w_in_even[e]
            aq, ak, av, bq, bk, bv = jnp.split(proj, EVEN_SPLITS, axis=-1)
            aq = aq.reshape(bsz, seq, A_HEADS, HEAD_DIM)
            ak = ak.reshape(bsz, seq, A_KV_HEADS, HEAD_DIM)
            av = av.reshape(bsz, seq, A_KV_HEADS, HEAD_DIM)
            oa = sliding_window_sink_attention(aq, ak, av, sinks[e], rel_bias[:, :A_HEADS])
            bq = bq.reshape(bsz, seq, B_HEADS, 2, HEAD_DIM)
            bk = bk.reshape(bsz, seq, B_HEADS, 2, HEAD_DIM)
            bv = bv.reshape(bsz, seq, B_HEADS, B_VDIM)
            lambda_init = 0.8 - 0.6 * math.exp(-0.3 * layer)
            lam = (jnp.exp(jnp.sum(lam_q1[e].astype(jnp.float32) * lam_k1[e].astype(jnp.float32)))
                   - jnp.exp(jnp.sum(lam_q2[e].astype(jnp.float32) * lam_k2[e].astype(jnp.float32)))
                   + lambda_init)
            ob = differential_attention(bq[..., 0, :], bq[..., 1, :], bk[..., 0, :], bk[..., 1, :], bv,
                                        lam, lambda_init, rel_bias[:, A_HEADS:], diff_norm[e])
            x = x + jnp.concatenate([oa, ob], axis=-1) @ w_out_even[e]
        else:
            o = layer // 2
            cq, ck, cv = jnp.split(h @ w_in_odd[o], 3, axis=-1)
            shp = (bsz, seq, C_HEADS, HEAD_DIM)
            oc = stick_breaking_attention(cq.reshape(shp), ck.reshape(shp), cv.reshape(shp))
            x = x + oc @ w_out_odd[o]
        h = rms_norm(x, norm_ffn[layer])
        x = x + conv_gated_ffn(h, ffn_up[layer], ffn_conv[layer], ffn_conv_b[layer], ffn_down[layer])
    return rms_norm(x, norm_final)
```

```cpp
#include <hip/hip_runtime.h>
#include <hip/hip_cooperative_groups.h>
#include <cstdio>
#include <cstdint>
namespace cg = cooperative_groups;
namespace pg8 {
#define PG8_LAS __attribute__((address_space(3)))
typedef unsigned short bf16_t;
typedef short bf16x8 __attribute__((ext_vector_type(8)));
typedef float f32x4 __attribute__((ext_vector_type(4)));
typedef unsigned u32x4 __attribute__((ext_vector_type(4)));
constexpr int BM = 256, BK = 64, HALF = 128, HTB = HALF * BK * 2  , STAGE_BYTES = 8 * HTB, NXCD = 8, WGM = 8;

__host__ __device__ __forceinline__ int lds_byte(int r, int c) { const int st = (r >> 4) * 2 + (c >> 5), rr = r & 15, cc = c & 31, ob = rr * 64 + cc * 2; return st * 1024 + (ob ^ (((ob >> 9) & 1) << 5)); }
__host__ __device__ __forceinline__ void stage_rc(int b, int& R, int& C) { const int st = b / 1024, sb = b % 1024, swz = sb ^ (((sb >> 9) & 1) << 5); R = (st >> 1) * 16 + swz / 64; C = (st & 1) * 32 + (swz % 64) / 2; }
__host__ __device__ __forceinline__ int perm32(int rho) { const int n = rho >> 4, i = rho & 15; return 8 * (i >> 2) + 4 * n + (i & 3); }

struct Unit { int pm, pn; };
struct Gemm { const bf16_t* A; const bf16_t* Bt; int M, N, K; };

struct StaticOrder {
    int nM, nN, nwg, G, c;
    __host__ __device__ void init(int M, int N, int G_, int c_) { nM = M / BM; nN = N / BM; nwg = nM * nN; G = G_; c = c_; }
    __host__ __device__ bool next(int i, Unit& u) const {
        const long L = (long)i * G + c; if (L >= nwg) return false;
        int wgid = (int)L; { const int q = nwg / NXCD, r = nwg % NXCD, xcd = wgid % NXCD, off = wgid / NXCD; wgid = (xcd < r ? xcd * (q + 1) : r * (q + 1) + (xcd - r) * q) + off; }
        const int nig = WGM * nN, gid = wgid / nig, fm = gid * WGM, gsz = (nM - fm) < WGM ? (nM - fm) : WGM;
        u.pm = fm + ((wgid % nig) % gsz); u.pn = (wgid % nig) / gsz; return true;
    }
    __device__ __forceinline__ void a_ready(const Unit&) const {}
    __device__ __forceinline__ void done(const Unit&) const {}
};

__device__ __forceinline__ unsigned cvt_pk_bf16(float lo, float hi) { unsigned r; asm volatile("v_cvt_pk_bf16_f32 %0, %1, %2" : "=v"(r) : "v"(lo), "v"(hi)); return r; }
typedef float f32x2 __attribute__((ext_vector_type(2)));
typedef unsigned u32x2 __attribute__((ext_vector_type(2)));
constexpr float RMS_EPS = 1e-6f;
__device__ __forceinline__ float row_rstd(const float* ssq, int row) {
    const f32x4* s = (const f32x4*)(ssq + (size_t)row * 16);
    const f32x4 a = s[0], b = s[1], c = s[2], d = s[3];
    const float t = ((a[0] + a[1]) + (a[2] + a[3])) + ((b[0] + b[1]) + (b[2] + b[3])) + ((c[0] + c[1]) + (c[2] + c[3])) + ((d[0] + d[1]) + (d[2] + d[3]));
    return __builtin_amdgcn_rsqf(t * (1.0f / 1024.0f) + RMS_EPS);
}
struct EpiScaleBf16 {
    static constexpr bool PERM = true, AFTER_DRAIN = false;
    bf16_t* O; int ldc; const float* ssq;
    __device__ __forceinline__ void operator()(const f32x4 (&acc)[2][2][4][2], const Unit& u, int wr, int wc, int fr, int fq) const {
        const int row0 = u.pm * BM + wr * 64 + fr, col0 = u.pn * BM + wc * 32 + 8 * fq;
#pragma unroll
        for (int ai = 0; ai < 2; ++ai)
#pragma unroll
            for (int m = 0; m < 4; ++m) { const int row = row0 + ai * HALF + m * 16; const float rs = row_rstd(ssq, row); bf16_t* rowp = O + (size_t)row * ldc + col0;
#pragma unroll
                for (int bj = 0; bj < 2; ++bj) { const f32x4 v0 = acc[ai][bj][m][0] * rs, v1 = acc[ai][bj][m][1] * rs;
                    u32x4 w; w.x = cvt_pk_bf16(v0[0], v0[1]); w.y = cvt_pk_bf16(v0[2], v0[3]); w.z = cvt_pk_bf16(v1[0], v1[1]); w.w = cvt_pk_bf16(v1[2], v1[3]);
                    *(u32x4*)(rowp + bj * HALF) = w; }
                asm volatile("" ::: "memory"); }
    }
};
struct EpiResid {
    static constexpr bool PERM = false, AFTER_DRAIN = false;
    const float* base; float* out; bf16_t* xb; float* ssq;
    __device__ __forceinline__ void operator()(const f32x4 (&acc)[2][2][4][2], const Unit& u, int wr, int wc, int fr, int fq) const {
        const int col0 = u.pn * BM + wc * 32 + 4 * fq;
#pragma unroll
        for (int ai = 0; ai < 2; ++ai)
#pragma unroll
            for (int m = 0; m < 4; ++m) { const int row = u.pm * BM + ai * HALF + wr * 64 + m * 16 + fr; const size_t off = (size_t)row * 1024 + col0; float q = 0.f;
#pragma unroll
                for (int bj = 0; bj < 2; ++bj)
#pragma unroll
                    for (int n = 0; n < 2; ++n) { const f32x4 bs = *(const f32x4*)(base + off + bj * HALF + n * 16); const f32x4 o = bs + acc[ai][bj][m][n];
                        *(f32x4*)(out + off + bj * HALF + n * 16) = o; q += (o[0] * o[0] + o[1] * o[1]) + (o[2] * o[2] + o[3] * o[3]);
                        u32x2 w; w.x = cvt_pk_bf16(o[0], o[1]); w.y = cvt_pk_bf16(o[2], o[3]); *(u32x2*)(xb + off + bj * HALF + n * 16) = w; }
                q += __shfl_xor(q, 16); q += __shfl_xor(q, 32);
                if (fq == 0) ssq[(size_t)row * 16 + u.pn * 4 + wc] = q;
                asm volatile("" ::: "memory"); }
    }
};
template <class Epi, class Sched, bool ALIGN_EPI = false, bool SP2 = false>
__device__ __forceinline__ void gemm_phase(PG8_LAS unsigned char* lds, const Gemm g, const Sched& S, const Epi& E) {
    int tid_ = threadIdx.x; asm volatile("" : "+v"(tid_));
    const int tid = tid_, wid = __builtin_amdgcn_readfirstlane(tid >> 6), lane = tid & 63, wr = wid >> 2, wc = wid & 3, fr = lane & 15, fq = lane >> 4;
    const int K = g.K, nt = K / BK;
    unsigned voffA[2], voffB[2];
#pragma unroll
    for (int i = 0; i < 2; ++i) { int R, C; stage_rc(tid * 16 + i * 8192, R, C); const int Rb = Epi::PERM ? ((R & ~31) + perm32(R & 31)) : R;
        voffA[i] = (unsigned)(R * K + C) * 2u; voffB[i] = (unsigned)(Rb * K + C) * 2u; }
    const size_t kstep = (size_t)(BK * 2);
    const size_t hstep = (size_t)HALF * K * 2;
    const size_t tstep = 2 * hstep;
    const unsigned ldsw = (unsigned)wid * 1024u;
    const int aoff = lds_byte(wr * 64 + fr, fq * 8), boff = lds_byte(wc * 32 + fr, fq * 8);
#define PG8_SA(b, h) (((b) * 2 + (h)) * HTB)
#define PG8_SB(b, h) ((4 + (b) * 2 + (h)) * HTB)
#define PG8_STAGE(bufoff, gbase, voff) do { _Pragma("unroll") for (int _i = 0; _i < 2; ++_i) \
        __builtin_amdgcn_global_load_lds((const unsigned*)((const char*)(gbase) + (voff)[_i]), (PG8_LAS unsigned*)(lds + (bufoff) + ldsw + _i * 8192), 16, 0, 0); } while (0)
#define PG8_LDA(dst, b, h) do { _Pragma("unroll") for (int m = 0; m < 4; ++m) _Pragma("unroll") for (int k = 0; k < 2; ++k) dst[m][k] = *(const PG8_LAS bf16x8*)(lds + PG8_SA(b, h) + aoff + m * 2048 + k * 1024); } while (0)
#define PG8_LDB(dst, b, h) do { _Pragma("unroll") for (int n = 0; n < 2; ++n) _Pragma("unroll") for (int k = 0; k < 2; ++k) dst[n][k] = *(const PG8_LAS bf16x8*)(lds + PG8_SB(b, h) + boff + n * 2048 + k * 1024); } while (0)
#define PG8_MMA(ai, bj, At, Bt) do { __builtin_amdgcn_s_setprio(1); _Pragma("unroll") for (int m = 0; m < 4; ++m) _Pragma("unroll") for (int n = 0; n < 2; ++n) _Pragma("unroll") for (int k = 0; k < 2; ++k) \
        acc[ai][bj][m][n] = __builtin_amdgcn_mfma_f32_16x16x32_bf16(Bt[n][k], At[m][k], acc[ai][bj][m][n], 0, 0, 0); __builtin_amdgcn_s_setprio(0); } while (0)
#define PG8_WAIT_V(n) asm volatile("s_waitcnt vmcnt(" #n ")" ::: "memory")
#define PG8_WAIT_L(n) asm volatile("s_waitcnt lgkmcnt(" #n ")" ::: "memory")
#define PG8_BAR __builtin_amdgcn_s_barrier()
#define PG8_SCHED __builtin_amdgcn_sched_barrier(0)
    Unit cur, nxt; int ui = 0;
    if (!S.next(0, cur)) return;
    f32x4 acc[2][2][4][2];
#pragma unroll
    for (int a = 0; a < 2; ++a)
#pragma unroll
        for (int b = 0; b < 2; ++b)
#pragma unroll
            for (int m = 0; m < 4; ++m)
#pragma unroll
                for (int n = 0; n < 2; ++n) acc[a][b][m][n] = (f32x4){0.f, 0.f, 0.f, 0.f};
    bf16x8 At[4][2], B0[2][2], B1[2][2];
    const char* cA = (const char*)g.A + (size_t)cur.pm * tstep; const char* cB = (const char*)g.Bt + (size_t)cur.pn * tstep;
    S.a_ready(cur);
    if constexpr (SP2) {
        PG8_STAGE(PG8_SB(0, 0), cB, voffB); PG8_STAGE(PG8_SB(0, 1), cB + hstep, voffB); PG8_STAGE(PG8_SA(0, 0), cA, voffA); PG8_STAGE(PG8_SA(0, 1), cA + hstep, voffA);
        if (wr == 1) PG8_BAR;
        PG8_WAIT_V(2); PG8_BAR;
        PG8_STAGE(PG8_SB(1, 0), cB + kstep, voffB); PG8_STAGE(PG8_SA(1, 0), cA + kstep, voffA); PG8_STAGE(PG8_SB(1, 1), cB + hstep + kstep, voffB);
        PG8_WAIT_V(6); PG8_BAR;
    } else {
        PG8_STAGE(PG8_SB(0, 0), cB, voffB); PG8_STAGE(PG8_SA(0, 0), cA, voffA); PG8_STAGE(PG8_SB(0, 1), cB + hstep, voffB); PG8_STAGE(PG8_SA(0, 1), cA + hstep, voffA);
        if (wr == 1) PG8_BAR;
        PG8_WAIT_V(4); PG8_BAR;
        PG8_STAGE(PG8_SB(1, 0), cB + kstep, voffB); PG8_STAGE(PG8_SA(1, 0), cA + kstep, voffA); PG8_STAGE(PG8_SB(1, 1), cB + hstep + kstep, voffB);
        PG8_WAIT_V(6); PG8_BAR;
    }
    for (;;) {
        const bool has_next = S.next(ui + 1, nxt);
        const char* nA = has_next ? (const char*)g.A + (size_t)nxt.pm * tstep : cA; const char* nB = has_next ? (const char*)g.Bt + (size_t)nxt.pn * tstep : cB;
        for (int t = 0; t < nt; t += 2) {
            const bool last = (t == nt - 2);
            const char* a1 = cA + (size_t)(t + 1) * kstep;
            const char* a2 = last ? nA : cA + (size_t)(t + 2) * kstep; const char* b2 = last ? nB : cB + (size_t)(t + 2) * kstep;
            const char* a3 = a2 + kstep; const char* b3 = b2 + kstep;
            if (last && has_next) S.a_ready(nxt);
            if constexpr (SP2) {
            PG8_LDB(B0, 0, 0); PG8_LDB(B1, 0, 1); PG8_SCHED; PG8_LDA(At, 0, 0); PG8_STAGE(PG8_SA(1, 1), a1 + hstep, voffA);
            PG8_WAIT_V(8); PG8_WAIT_L(0); PG8_BAR; PG8_MMA(0, 0, At, B0); PG8_MMA(0, 1, At, B1); PG8_BAR; PG8_SCHED;
            PG8_LDA(At, 0, 1); PG8_STAGE(PG8_SB(0, 0), b2, voffB); PG8_STAGE(PG8_SB(0, 1), b2 + hstep, voffB); PG8_STAGE(PG8_SA(0, 0), a2, voffA);
            PG8_WAIT_V(8); PG8_WAIT_L(0); PG8_BAR; PG8_MMA(1, 0, At, B0); PG8_MMA(1, 1, At, B1); PG8_BAR; PG8_SCHED;
            PG8_LDB(B0, 1, 0); PG8_LDB(B1, 1, 1); PG8_SCHED; PG8_LDA(At, 1, 0); PG8_STAGE(PG8_SA(0, 1), a2 + hstep, voffA);
            PG8_WAIT_V(8); PG8_WAIT_L(0); PG8_BAR; PG8_MMA(0, 0, At, B0); PG8_MMA(0, 1, At, B1); PG8_BAR; PG8_SCHED;
            PG8_LDA(At, 1, 1); PG8_STAGE(PG8_SB(1, 0), b3, voffB); PG8_STAGE(PG8_SB(1, 1), b3 + hstep, voffB); PG8_STAGE(PG8_SA(1, 0), a3, voffA);
            PG8_WAIT_V(8); PG8_WAIT_L(0); PG8_BAR; PG8_MMA(1, 0, At, B0); PG8_MMA(1, 1, At, B1); PG8_BAR; PG8_SCHED;
            } else {
            PG8_LDB(B0, 0, 0); PG8_SCHED; PG8_LDA(At, 0, 0); PG8_STAGE(PG8_SA(1, 1), a1 + hstep, voffA);
            PG8_WAIT_L(8); PG8_BAR; PG8_WAIT_L(0); PG8_MMA(0, 0, At, B0); PG8_BAR; PG8_SCHED;
            PG8_LDB(B1, 0, 1); PG8_STAGE(PG8_SB(0, 0), b2, voffB);
            PG8_BAR; PG8_WAIT_L(0); PG8_MMA(0, 1, At, B1); PG8_BAR;
            PG8_LDA(At, 0, 1); PG8_STAGE(PG8_SA(0, 0), a2, voffA);
            PG8_BAR; PG8_WAIT_L(0); PG8_MMA(1, 0, At, B0); PG8_BAR; PG8_SCHED;
            PG8_STAGE(PG8_SB(0, 1), b2 + hstep, voffB);
            PG8_WAIT_V(6); PG8_BAR; PG8_MMA(1, 1, At, B1); PG8_BAR;
            PG8_LDB(B0, 1, 0); PG8_SCHED; PG8_LDA(At, 1, 0); PG8_STAGE(PG8_SA(0, 1), a2 + hstep, voffA);
            PG8_WAIT_L(8); PG8_BAR; PG8_WAIT_L(0); PG8_MMA(0, 0, At, B0); PG8_BAR; PG8_SCHED;
            PG8_LDB(B1, 1, 1); PG8_STAGE(PG8_SB(1, 0), b3, voffB);
            PG8_BAR; PG8_WAIT_L(0); PG8_MMA(0, 1, At, B1); PG8_BAR;
            PG8_LDA(At, 1, 1); PG8_STAGE(PG8_SA(1, 0), a3, voffA);
            PG8_BAR; PG8_WAIT_L(0); PG8_MMA(1, 0, At, B0); PG8_BAR; PG8_SCHED;
            PG8_STAGE(PG8_SB(1, 1), b3 + hstep, voffB);
            PG8_WAIT_V(6); PG8_BAR; PG8_MMA(1, 1, At, B1); PG8_BAR;
            }
        }
        if constexpr (ALIGN_EPI) { if (wr == 0) PG8_BAR; }
        if constexpr (!Epi::AFTER_DRAIN) { E(acc, cur, wr, wc, fr, fq); S.done(cur); }
        if (!has_next) break;
#pragma unroll
        for (int a = 0; a < 2; ++a)
#pragma unroll
            for (int b = 0; b < 2; ++b)
#pragma unroll
                for (int m = 0; m < 4; ++m)
#pragma unroll
                    for (int n = 0; n < 2; ++n) acc[a][b][m][n] = (f32x4){0.f, 0.f, 0.f, 0.f};
        cur = nxt; cA = nA; cB = nB; ++ui;
        if constexpr (ALIGN_EPI) { if (wr == 1) PG8_BAR; }
    }
    PG8_WAIT_V(0);
    if constexpr (!ALIGN_EPI) { if (wr == 0) PG8_BAR; }
    PG8_BAR;
    if constexpr (Epi::AFTER_DRAIN) { E.fused(acc, cur, wr, wc, fr, fq, lds, wid, lane); S.done(cur); }
#undef PG8_SA
#undef PG8_SB
#undef PG8_STAGE
#undef PG8_LDA
#undef PG8_LDB
#undef PG8_MMA
#undef PG8_WAIT_V
#undef PG8_WAIT_L
#undef PG8_BAR
#undef PG8_SCHED
}
}
namespace att {
#define ALAS __attribute__((address_space(3)))
typedef unsigned short bf16_t;
typedef short bf16x8 __attribute__((ext_vector_type(8)));
typedef float f32x16 __attribute__((ext_vector_type(16)));
typedef float f32x4 __attribute__((ext_vector_type(4)));
typedef unsigned u32x4 __attribute__((ext_vector_type(4)));
typedef unsigned u32x2 __attribute__((ext_vector_type(2)));
constexpr int KROW = 144;
constexpr int KBUF = 64 * KROW;
constexpr int VBUF = 128 * KROW;
constexpr int L_K = 0, L_V = 2 * KBUF, L_BT = L_V + 2 * VBUF, L_END = L_BT + 512;
constexpr float LOG2E = 1.4426950408889634f;
constexpr float QSCALE = 0.125f * 1.4426950408889634f;
#define CR(r) (((r) & 3) + 8 * ((r) >> 2))
__device__ __forceinline__ unsigned cvtpk(float lo, float hi) { unsigned r; asm volatile("v_cvt_pk_bf16_f32 %0, %1, %2" : "=v"(r) : "v"(lo), "v"(hi)); return r; }
__device__ __forceinline__ float ex2(float x) { return __builtin_amdgcn_exp2f(x); }
__device__ __forceinline__ float rcpf_(float x) { return __builtin_amdgcn_rcpf(x); }

template <int DV> struct Pref { u32x4 k; u32x4 v[DV / 64]; };

template <int DV> __device__ __forceinline__ void tile_load(Pref<DV>& pf, const bf16_t* Kp, const bf16_t* Vp, int pitch, int kt, int tid) {
    const int krow = tid >> 3, kc = (tid & 7) * 8;
    pf.k = *(const u32x4*)(Kp + (size_t)(kt * 64 + krow) * pitch + kc);
#pragma unroll
    for (int i = 0; i < DV / 64; ++i) { const int c = tid + i * 512, vrow = c / (DV / 8), vc = (c % (DV / 8)) * 8;
        pf.v[i] = *(const u32x4*)(Vp + (size_t)(kt * 64 + vrow) * pitch + vc); }
}
template <int DV> __device__ __forceinline__ void tile_store(const Pref<DV>& pf, ALAS unsigned char* kbuf, ALAS unsigned char* vbuf, int tid) {
    const int krow = tid >> 3, kc = (tid & 7) * 8;
    *(ALAS u32x4*)(kbuf + krow * KROW + kc * 2) = pf.k;
#pragma unroll
    for (int i = 0; i < DV / 64; ++i) { const int c = tid + i * 512, vrow = c / (DV / 8), vc = (c % (DV / 8)) * 8;
        const int kk = vrow & 15, pos = (vrow & ~15) + 8 * ((kk >> 2) & 1) + (kk & 3) + 4 * (kk >> 3);
        ALAS unsigned char* d = vbuf + vc * KROW + pos * 2;
#pragma unroll
        for (int j = 0; j < 8; ++j) { const unsigned w = pf.v[i][j >> 1]; *(ALAS unsigned short*)(d + j * KROW) = (unsigned short)((j & 1) ? (w >> 16) : (w & 0xffffu)); } }
}

template <int DV> __device__ __forceinline__ void pv_slab(const ALAS unsigned char* vbuf, int s, u32x4 w, f32x16 (&o)[DV / 32], int l32, int hi) {
    const bf16x8 pfr = __builtin_bit_cast(bf16x8, w);
#pragma unroll
    for (int db = 0; db < DV / 32; ++db) {
        const bf16x8 vf = *(const ALAS bf16x8*)(vbuf + (db * 32 + l32) * KROW + s * 32 + hi * 16);
        o[db] = __builtin_amdgcn_mfma_f32_32x32x16_bf16(vf, pfr, o[db], 0, 0, 0); }
    if (DV > 64) __builtin_amdgcn_sched_barrier(0);
}

template <int MODE, int DV, bool MASKED>
__device__ __forceinline__ void tile_compute(const ALAS unsigned char* kbuf, const ALAS unsigned char* vbuf, const bf16x8 (&qf)[4], f32x16 (&o)[DV / 32],
                                             float& st_m, float& st_l, int lim, const ALAS float* btab, float cbias, int lane) {
    const int l32 = lane & 31, hi = lane >> 5;
    if constexpr (MODE == 0) {
        f32x16 p0, p1;
#pragma unroll
        for (int r = 0; r < 16; ++r) { p0[r] = 0.f; p1[r] = 0.f; }
        { const ALAS unsigned char* kb = kbuf + l32 * KROW + hi * 16;
#pragma unroll
          for (int d0 = 0; d0 < 4; ++d0) {
              const bf16x8 k0 = *(const ALAS bf16x8*)(kb + d0 * 32);
              const bf16x8 k1 = *(const ALAS bf16x8*)(kb + 32 * KROW + d0 * 32);
              p0 = __builtin_amdgcn_mfma_f32_32x32x16_bf16(k0, qf[d0], p0, 0, 0, 0);
              p1 = __builtin_amdgcn_mfma_f32_32x32x16_bf16(k1, qf[d0], p1, 0, 0, 0); } }
        __builtin_amdgcn_sched_barrier(0);
#pragma unroll
        for (int r = 0; r < 16; ++r) {
            float a = rcpf_(1.0f + ex2(p0[r])), b = rcpf_(1.0f + ex2(p1[r]));
            if (MASKED) { a = (CR(r) < lim) ? a : 1.0f; b = (CR(r) + 32 < lim) ? b : 1.0f; }
            p0[r] = a; p1[r] = b; }
        float g[8], hs[8], pr[8];
#pragma unroll
        for (int i = 0; i < 4; ++i) { g[i] = (p0[4 * i] * p0[4 * i + 1]) * (p0[4 * i + 2] * p0[4 * i + 3]); g[4 + i] = (p1[4 * i] * p1[4 * i + 1]) * (p1[4 * i + 2] * p1[4 * i + 3]); }
#pragma unroll
        for (int i = 0; i < 8; ++i) { const float h = __shfl_xor(g[i], 32); pr[i] = g[i] * h; hs[i] = hi ? 1.0f : h; }
        float T = st_m;
#pragma unroll
        for (int i = 7; i >= 0; --i) {
            float R = hs[i] * T; T = T * pr[i];
            if (i >= 4) { const int b = 4 * (i - 4);
                float R2 = R * p1[b + 3]; p1[b + 3] = R - R2; float R1 = R2 * p1[b + 2]; p1[b + 2] = R2 - R1; float R0 = R1 * p1[b + 1]; p1[b + 1] = R1 - R0; p1[b] = R0 - R0 * p1[b]; }
            else { const int b = 4 * i;
                float R2 = R * p0[b + 3]; p0[b + 3] = R - R2; float R1 = R2 * p0[b + 2]; p0[b + 2] = R2 - R1; float R0 = R1 * p0[b + 1]; p0[b + 1] = R1 - R0; p0[b] = R0 - R0 * p0[b]; }
        }
        st_m = T;
        __builtin_amdgcn_sched_barrier(0);
#pragma unroll
        for (int s = 0; s < 4; ++s) {
            u32x4 w;
            if (s == 0) { w.x = cvtpk(p0[0], p0[1]); w.y = cvtpk(p0[2], p0[3]); w.z = cvtpk(p0[4], p0[5]); w.w = cvtpk(p0[6], p0[7]); }
            else if (s == 1) { w.x = cvtpk(p0[8], p0[9]); w.y = cvtpk(p0[10], p0[11]); w.z = cvtpk(p0[12], p0[13]); w.w = cvtpk(p0[14], p0[15]); }
            else if (s == 2) { w.x = cvtpk(p1[0], p1[1]); w.y = cvtpk(p1[2], p1[3]); w.z = cvtpk(p1[4], p1[5]); w.w = cvtpk(p1[6], p1[7]); }
            else { w.x = cvtpk(p1[8], p1[9]); w.y = cvtpk(p1[10], p1[11]); w.z = cvtpk(p1[12], p1[13]); w.w = cvtpk(p1[14], p1[15]); }
            pv_slab<DV>(vbuf, s, w, o, l32, hi);
        }
    } else {
        const float NEG = -__builtin_inff();
#pragma unroll
        for (int hk = 0; hk < 2; ++hk) {
            f32x16 p;
#pragma unroll
            for (int r = 0; r < 16; ++r) p[r] = 0.f;
            { const ALAS unsigned char* kb = kbuf + (32 * hk + l32) * KROW + hi * 16;
#pragma unroll
              for (int d0 = 0; d0 < 4; ++d0) { const bf16x8 k0 = *(const ALAS bf16x8*)(kb + d0 * 32); p = __builtin_amdgcn_mfma_f32_32x32x16_bf16(k0, qf[d0], p, 0, 0, 0); } }
            __builtin_amdgcn_sched_barrier(0);
            if (MASKED) {
#pragma unroll
                for (int r = 0; r < 16; ++r) {
                    const int d0 = lim - 32 * hk - CR(r);
                    const float b0 = btab[min(max(d0, 0), 127)];
                    const bool v0 = (MODE == 2) ? ((unsigned)d0 < 128u) : (d0 >= 0);
                    p[r] = v0 ? p[r] + b0 : NEG; }
            } else {
#pragma unroll
                for (int r = 0; r < 16; ++r) p[r] += cbias;
            }
            float mt = fmaxf(p[0], p[1]);
#pragma unroll
            for (int r = 2; r < 16; ++r) mt = fmaxf(mt, p[r]);
            mt = fmaxf(mt, __shfl_xor(mt, 32));
            if (__any(mt > st_m)) {
                const float mn = fmaxf(st_m, mt), f = ex2(st_m - mn);
                st_l *= f; st_m = mn;
#pragma unroll
                for (int db = 0; db < DV / 32; ++db)
#pragma unroll
                    for (int r = 0; r < 16; ++r) o[db][r] *= f;
            }
            float s = 0.f;
#pragma unroll
            for (int r = 0; r < 16; ++r) { p[r] = ex2(p[r] - st_m); s += p[r]; }
            st_l += s;
            __builtin_amdgcn_sched_barrier(0);
#pragma unroll
            for (int s2 = 0; s2 < 2; ++s2) {
                u32x4 w; w.x = cvtpk(p[8 * s2], p[8 * s2 + 1]); w.y = cvtpk(p[8 * s2 + 2], p[8 * s2 + 3]); w.z = cvtpk(p[8 * s2 + 4], p[8 * s2 + 5]); w.w = cvtpk(p[8 * s2 + 6], p[8 * s2 + 7]);
                pv_slab<DV>(vbuf, 2 * hk + s2, w, o, l32, hi);
            }
        }
    }
}

template <int MODE, int DV>
__device__ __forceinline__ void attn_core(const bf16_t* Qp, const bf16_t* Kp, const bf16_t* Vp, int pitch, int q0, int kt0, int nt, int dir,
                                          ALAS unsigned char* lds, f32x16 (&o)[DV / 32], float& st_m, float& st_l) {
    int tid_ = threadIdx.x; asm volatile("" : "+v"(tid_));
    const int tid = tid_, lane = tid & 63, l32 = lane & 31, hi = lane >> 5, wid = __builtin_amdgcn_readfirstlane(tid >> 6);
    const int qw = q0 + 32 * wid, t = qw + l32;
    const ALAS float* btab = (const ALAS float*)(lds + L_BT);
    bf16x8 qf[4];
#pragma unroll
    for (int d0 = 0; d0 < 4; ++d0) qf[d0] = *(const bf16x8*)(Qp + (size_t)t * pitch + d0 * 16 + hi * 8);
#pragma unroll
    for (int db = 0; db < DV / 32; ++db)
#pragma unroll
        for (int r = 0; r < 16; ++r) o[db][r] = 0.f;
    st_m = (MODE == 0) ? 1.0f : -1e30f; st_l = 0.f;
    Pref<DV> pf;
    tile_load<DV>(pf, Kp, Vp, pitch, kt0, tid);
    tile_store<DV>(pf, lds + L_K, lds + L_V, tid);
    __syncthreads();
    const float cbias = (MODE == 1) ? btab[127] : 0.f;
    for (int it = 0; it < nt; ++it) {
        const int kt = kt0 + dir * it, cur = it & 1, kbase = kt * 64;
        if (it + 1 < nt) tile_load<DV>(pf, Kp, Vp, pitch, kt + dir, tid);
        const ALAS unsigned char* kb = lds + L_K + cur * KBUF; const ALAS unsigned char* vb = lds + L_V + cur * VBUF;
        const int lim = t - kbase - 4 * hi;
        if (MODE == 0) {
            if (kbase <= qw + 31) { if (kbase + 63 >= qw) tile_compute<0, DV, true>(kb, vb, qf, o, st_m, st_l, lim, btab, cbias, lane); else tile_compute<0, DV, false>(kb, vb, qf, o, st_m, st_l, lim, btab, cbias, lane); }
        } else if (MODE == 1) {
            if (kbase <= qw + 31) { if (qw - (kbase + 63) < 113) tile_compute<1, DV, true>(kb, vb, qf, o, st_m, st_l, lim, btab, cbias, lane); else tile_compute<1, DV, false>(kb, vb, qf, o, st_m, st_l, lim, btab, cbias, lane); }
        } else {
            if (kbase <= qw + 31 && kbase + 63 >= qw - 127) tile_compute<2, DV, true>(kb, vb, qf, o, st_m, st_l, lim, btab, cbias, lane);
        }
        if (it + 1 < nt) tile_store<DV>(pf, lds + L_K + (cur ^ 1) * KBUF, lds + L_V + (cur ^ 1) * VBUF, tid);
        __syncthreads();
    }
}
template <int DV> __device__ __forceinline__ void store_ot(const f32x16 (&o)[DV / 32], bf16_t* orow, int hi) {
#pragma unroll
    for (int db = 0; db < DV / 32; ++db)
#pragma unroll
        for (int rg = 0; rg < 4; ++rg) { u32x2 w; w.x = cvtpk(o[db][4 * rg], o[db][4 * rg + 1]); w.y = cvtpk(o[db][4 * rg + 2], o[db][4 * rg + 3]);
            *(u32x2*)(orow + 32 * db + 8 * rg + 4 * hi) = w; }
}
}
#ifndef PH_DIFF
#define PH_DIFF 1
#endif
#ifndef PH_SWA
#define PH_SWA 1
#endif
#ifndef PH_SB
#define PH_SB 1
#endif
#ifndef PH_CONV
#define PH_CONV 1
#endif
#define LAS __attribute__((address_space(3)))
typedef unsigned short bf16;
typedef float f32x4 __attribute__((ext_vector_type(4)));
typedef unsigned v4u __attribute__((ext_vector_type(4)));
typedef unsigned v2u __attribute__((ext_vector_type(2)));
constexpr int NWAVES = 8;
constexpr int SEQ = 4096, NB = 16, MTOK = NB * SEQ, DM = 1024, DFF = 2816, DUP = 2 * DFF;
constexpr int EVEN_IN = 2304, ODD_IN = 3072;
constexpr size_t MiB = 1u << 20;
constexpr size_t WS_SSQ = 1 * MiB;
constexpr size_t WS_WINE = 8 * MiB, WS_WOUTE = 17 * MiB, WS_WINO = 21 * MiB, WS_WOUTO = 33 * MiB, WS_WUP = 37 * MiB, WS_WDN = 81 * MiB;
constexpr size_t WS_XB = 104 * MiB, WS_R = 232 * MiB;
constexpr size_t WS_PROJ = WS_R, WS_AO = WS_R + 384 * MiB, WS_U = WS_R, WS_G = WS_R + 352 * MiB;
constexpr int LDS_BYTES = 147456;
constexpr int HALF_ROWS = MTOK / 2;

struct Args {
    const float* x; const float* rel_bias; const float* norm_mix; const float* norm_ffn; const float* norm_final;
    const float* w_in_even; const float* w_out_even; const float* sinks; const float* lam_q1; const float* lam_k1; const float* lam_q2; const float* lam_k2;
    const float* diff_norm; const float* w_in_odd; const float* w_out_odd; const float* ffn_up; const float* ffn_conv; const float* ffn_conv_b; const float* ffn_down;
    float* out; unsigned char* ws;
};

__device__ const unsigned char T5B[128] = {0, 1, 2, 3, 4, 5, 6, 7, 8, 9, 10, 11, 12, 13, 14, 15, 16, 16, 16, 17, 17, 18, 18, 18, 19, 19, 19, 20, 20, 20, 20, 21, 21, 21, 21, 22, 22, 22, 22, 22, 23, 23, 23, 23, 23, 23, 24, 24, 24, 24, 24, 24, 25, 25, 25, 25, 25, 25, 25, 26, 26, 26, 26, 26, 26, 26, 26, 27, 27, 27, 27, 27, 27, 27, 27, 27, 27, 28, 28, 28, 28, 28, 28, 28, 28, 28, 28, 29, 29, 29, 29, 29, 29, 29, 29, 29, 29, 29, 29, 30, 30, 30, 30, 30, 30, 30, 30, 30, 30, 30, 30, 30, 30, 31, 31, 31, 31, 31, 31, 31, 31, 31, 31, 31, 31, 31, 31, 31};

__device__ __forceinline__ float wave_sum(float v) {
#pragma unroll
    for (int o = 1; o < 64; o <<= 1) v += __shfl_xor(v, o);
    return v;
}
__device__ __forceinline__ unsigned f2bf(float f) { unsigned u = __builtin_bit_cast(unsigned, f); return (u + 0x7fffu + ((u >> 16) & 1u)) >> 16; }
__device__ __forceinline__ unsigned pk2(float lo, float hi) { return f2bf(lo) | (f2bf(hi) << 16); }

__device__ __forceinline__ void transpose_item(const float* W, int K, int N, bf16* WT, const float* gk, int a0, int a1, int b0, int b1, float cs, LAS float* scr, int item, int lane) {
    const int nblk = N / 32, kb = item / nblk, nb = item % nblk, k0 = 64 * kb, n0 = 32 * nb;
    const int nn = n0 + (lane & 31);
    const float csc = ((nn >= a0 && nn < a1) || (nn >= b0 && nn < b1)) ? cs : 1.0f;
#pragma unroll 8
    for (int i = 0; i < 32; ++i) { const int kk = 2 * i + (lane >> 5); const float gv = gk ? gk[k0 + kk] : 1.0f; scr[kk * 33 + (lane & 31)] = W[(size_t)(k0 + kk) * N + nn] * (gv * csc); }
    asm volatile("s_waitcnt lgkmcnt(0)" ::: "memory");
    const int c = lane & 7;
#pragma unroll
    for (int j = 0; j < 4; ++j) { const int n = (lane >> 3) + 8 * j; const LAS float* s = scr + (8 * c) * 33 + n;
        v4u o; o.x = pk2(s[0 * 33], s[1 * 33]); o.y = pk2(s[2 * 33], s[3 * 33]); o.z = pk2(s[4 * 33], s[5 * 33]); o.w = pk2(s[6 * 33], s[7 * 33]);
        *(v4u*)(WT + (size_t)(n0 + n) * K + k0 + 8 * c) = o; }
    asm volatile("s_waitcnt lgkmcnt(0)" ::: "memory");
}

__global__ void __launch_bounds__(NWAVES * 64, 2) mega_fwd(Args a) {
    extern __shared__ __attribute__((aligned(16))) unsigned char lds_raw[];
    cg::grid_group grid = cg::this_grid();
    LAS unsigned char* lds = (LAS unsigned char*)lds_raw;
    const int tid = threadIdx.x, lane = tid & 63, wave = __builtin_amdgcn_readfirstlane(tid >> 6);
    const int G = gridDim.x, bx = blockIdx.x;
    const int gw = bx * NWAVES + wave, NGW = G * NWAVES;
    unsigned char* ws = a.ws;
    float* ssq = (float*)(ws + WS_SSQ);
    bf16* xb = (bf16*)(ws + WS_XB);
    bf16* proj = (bf16*)(ws + WS_PROJ);
    bf16* ao = (bf16*)(ws + WS_AO);
    bf16* ubuf = (bf16*)(ws + WS_U);
    bf16* gbuf = (bf16*)(ws + WS_G);

    {
        LAS float* scr = (LAS float*)(lds + wave * 16384);
        constexpr int I_INE = 16 * (EVEN_IN / 32), I_OUT = 16 * 32, I_INO = 16 * (ODD_IN / 32), I_UP = 16 * (DUP / 32), I_DN = (DFF / 64) * 32;
        constexpr int NITEMS = 2 * I_INE + 2 * I_OUT + 2 * I_INO + 2 * I_OUT + 4 * I_UP + 4 * I_DN;
        for (int it = gw; it < NITEMS; it += NGW) {
            int r = it;
            if (r < 2 * I_INE) { const int e = r / I_INE; r -= e * I_INE;
                transpose_item(a.w_in_even + (size_t)e * DM * EVEN_IN, DM, EVEN_IN, (bf16*)(ws + WS_WINE) + (size_t)e * EVEN_IN * DM, a.norm_mix + (2 * e) * DM, 0, 512, 768, 1280, att::QSCALE, scr, r, lane); continue; }
            r -= 2 * I_INE;
            if (r < 2 * I_OUT) { const int e = r / I_OUT; r -= e * I_OUT;
                transpose_item(a.w_out_even + (size_t)e * DM * DM, DM, DM, (bf16*)(ws + WS_WOUTE) + (size_t)e * DM * DM, nullptr, 0, 0, 0, 0, 1.f, scr, r, lane); continue; }
            r -= 2 * I_OUT;
            if (r < 2 * I_INO) { const int e = r / I_INO; r -= e * I_INO;
                transpose_item(a.w_in_odd + (size_t)e * DM * ODD_IN, DM, ODD_IN, (bf16*)(ws + WS_WINO) + (size_t)e * ODD_IN * DM, a.norm_mix + (2 * e + 1) * DM, 0, 1024, 0, 0, att::QSCALE, scr, r, lane); continue; }
            r -= 2 * I_INO;
            if (r < 2 * I_OUT) { const int e = r / I_OUT; r -= e * I_OUT;
                transpose_item(a.w_out_odd + (size_t)e * DM * DM, DM, DM, (bf16*)(ws + WS_WOUTO) + (size_t)e * DM * DM, nullptr, 0, 0, 0, 0, 1.f, scr, r, lane); continue; }
            r -= 2 * I_OUT;
            if (r < 4 * I_UP) { const int e = r / I_UP; r -= e * I_UP;
                transpose_item(a.ffn_up + (size_t)e * DM * DUP, DM, DUP, (bf16*)(ws + WS_WUP) + (size_t)e * DUP * DM, a.norm_ffn + e * DM, 0, 0, 0, 0, 1.f, scr, r, lane); continue; }
            r -= 4 * I_UP;
            { const int e = r / I_DN; r -= e * I_DN;
                transpose_item(a.ffn_down + (size_t)e * DFF * DM, DFF, DM, (bf16*)(ws + WS_WDN) + (size_t)e * DM * DFF, nullptr, 0, 0, 0, 0, 1.f, scr, r, lane); }
        }
        for (int m = gw; m < MTOK; m += NGW) {
            const f32x4* xr = (const f32x4*)(a.x + (size_t)m * DM) + lane; f32x4 v[4]; float s = 0.f;
#pragma unroll
            for (int j = 0; j < 4; ++j) { v[j] = xr[64 * j]; s += (v[j][0] * v[j][0] + v[j][1] * v[j][1]) + (v[j][2] * v[j][2] + v[j][3] * v[j][3]); }
            s = wave_sum(s);
            v2u* o8 = (v2u*)(xb + (size_t)m * DM) + lane;
#pragma unroll
            for (int j = 0; j < 4; ++j) { v2u w; w.x = pk2(v[j][0], v[j][1]); w.y = pk2(v[j][2], v[j][3]); o8[64 * j] = w; }
            if (lane < 16) ssq[(size_t)m * 16 + lane] = (lane == 0) ? s : 0.f;
        }
    }
    grid.sync();

    for (int layer = 0; layer < 4; ++layer) {
        const int e = layer >> 1; const bool even = (layer & 1) == 0;
        const float* xold = (layer == 0) ? a.x : a.out;
        {
            const int N = even ? EVEN_IN : ODD_IN;
            const bf16* wt = even ? (const bf16*)(ws + WS_WINE) + (size_t)e * EVEN_IN * DM : (const bf16*)(ws + WS_WINO) + (size_t)e * ODD_IN * DM;
            pg8::Gemm g{xb, wt, MTOK, N, DM}; pg8::StaticOrder S; S.init(MTOK, N, G, bx);
            pg8::EpiScaleBf16 E{proj, N, ssq};
            pg8::gemm_phase<pg8::EpiScaleBf16, pg8::StaticOrder, true, true>(lds, g, S, E);
        }
        grid.sync();
        if (even) {
            int tq = threadIdx.x; asm volatile("" : "+v"(tq)); const int tid = tq, lane = tq & 63, l32 = lane & 31, hi = lane >> 5;
            float lam, one_m_li;
            { const float li = (layer == 0) ? 0.2f : 0.47071301839f;
              const float s1 = wave_sum(a.lam_q1[e * 64 + lane] * a.lam_k1[e * 64 + lane]), s2 = wave_sum(a.lam_q2[e * 64 + lane] * a.lam_k2[e * 64 + lane]);
              lam = __expf(s1) - __expf(s2) + li; lam = __builtin_bit_cast(float, __builtin_amdgcn_readfirstlane(__builtin_bit_cast(int, lam))); one_m_li = 1.0f - li; }
            LAS float* btab = (LAS float*)(lds + att::L_BT);

#if PH_DIFF
            for (int uidx = bx; uidx < 1024; uidx += G) {
                const int j = uidx >> 8, c = uidx & 255, bh = c >> 2, s = c & 3, b = bh >> 2, h = bh & 3;
                const int qb = (j == 0) ? s : (j == 1) ? 7 - s : (j == 2) ? 8 + s : 15 - s;
                if (tid < 128) btab[tid] = a.rel_bias[T5B[tid] * 12 + 8 + h] * att::LOG2E;
                const bf16* base = proj + (size_t)b * SEQ * EVEN_IN;
                const int q0 = qb * 256, nt = 4 * qb + 4, t = q0 + 32 * wave + l32;
                att::f32x16 o2[4]; float m2, l2; LAS unsigned* o1s = (LAS unsigned*)(lds + 57344 + wave * 8192) + lane;
                { float m1, l1;
                  att::attn_core<1, 128>(base + 768 + h * 128, base + 1280 + h * 128, base + 1792 + h * 128, EVEN_IN, q0, 0, nt, 1, lds, o2, m1, l1);
                  const float inv = __builtin_amdgcn_rcpf(l1 + __shfl_xor(l1, 32));
#pragma unroll
                  for (int db = 0; db < 4; ++db)
#pragma unroll
                      for (int k = 0; k < 8; ++k) o1s[(db * 8 + k) * 64] = att::cvtpk(o2[db][2 * k] * inv, o2[db][2 * k + 1] * inv); }
                att::attn_core<1, 128>(base + 768 + h * 128 + 64, base + 1280 + h * 128 + 64, base + 1792 + h * 128, EVEN_IN, q0, 0, nt, 1, lds, o2, m2, l2);
                { const float inv = lam * __builtin_amdgcn_rcpf(l2 + __shfl_xor(l2, 32)); float ss = 0.f;
#pragma unroll
                  for (int db = 0; db < 4; ++db)
#pragma unroll
                      for (int r = 0; r < 16; ++r) { const unsigned w = o1s[(db * 8 + (r >> 1)) * 64]; const float a1 = __uint_as_float((r & 1) ? (w & 0xffff0000u) : (w << 16));
                          const float v = a1 - inv * o2[db][r]; o2[db][r] = v; ss += v * v; }
                  ss += __shfl_xor(ss, 32);
                  const float rs = __builtin_amdgcn_rsqf(ss * (1.0f / 128.0f) + 1e-6f) * one_m_li;
                  const float* gn = a.diff_norm + e * 128;
#pragma unroll
                  for (int db = 0; db < 4; ++db)
#pragma unroll
                      for (int rg = 0; rg < 4; ++rg) { const f32x4 gv = *(const f32x4*)(gn + 32 * db + 8 * rg + 4 * hi);
#pragma unroll
                          for (int k = 0; k < 4; ++k) o2[db][4 * rg + k] *= rs * gv[k]; } }
                att::store_ot<128>(o2, ao + ((size_t)b * SEQ + t) * DM + 512 + h * 128, hi);
            }
#endif
#if PH_SWA
            for (int uidx = bx; uidx < 2048; uidx += G) {
                const int qb = uidx & 15, qh = (uidx >> 4) & 7, b = uidx >> 7, kvh = qh >> 2;
                if (tid < 128) btab[tid] = a.rel_bias[T5B[tid] * 12 + qh] * att::LOG2E;
                const bf16* base = proj + (size_t)b * SEQ * EVEN_IN;
                const int q0 = qb * 256, t = q0 + 32 * wave + l32;
                const int kt0 = (qb * 4 - 2 > 0) ? qb * 4 - 2 : 0, nt = qb * 4 + 4 - kt0;
                att::f32x16 o[2]; float m, l;
                att::attn_core<2, 64>(base + qh * 64, base + 512 + kvh * 64, base + 640 + kvh * 64, EVEN_IN, q0, kt0, nt, 1, lds, o, m, l);
                const float sk = a.sinks[e * 8 + qh] * att::LOG2E;
                const float inv = __builtin_amdgcn_rcpf(l + __shfl_xor(l, 32) + __builtin_amdgcn_exp2f(sk - m));
#pragma unroll
                for (int db = 0; db < 2; ++db)
#pragma unroll
                    for (int r = 0; r < 16; ++r) o[db][r] *= inv;
                att::store_ot<64>(o, ao + ((size_t)b * SEQ + t) * DM + qh * 64, hi);
            }
#endif
        } else {
#if PH_SB
            int tq = threadIdx.x; asm volatile("" : "+v"(tq)); const int lane = tq & 63, l32 = lane & 31, hi = lane >> 5;
            for (int uidx = bx; uidx < 4096; uidx += G) {
                const int bh = uidx & 255, qb = 15 - (uidx >> 8), b = bh >> 4, h = bh & 15;
                const bf16* base = proj + (size_t)b * SEQ * ODD_IN;
                const int q0 = qb * 256, nt = 4 * qb + 4, t = q0 + 32 * wave + l32;
                att::f32x16 o[2]; float P, dummy;
                att::attn_core<0, 64>(base + h * 64, base + 1024 + h * 64, base + 2048 + h * 64, ODD_IN, q0, nt - 1, nt, -1, lds, o, P, dummy);
                att::store_ot<64>(o, ao + ((size_t)b * SEQ + t) * DM + h * 64, hi);
            }
#endif
        }
        grid.sync();
        {
            const bf16* wt = even ? (const bf16*)(ws + WS_WOUTE) + (size_t)e * DM * DM : (const bf16*)(ws + WS_WOUTO) + (size_t)e * DM * DM;
            pg8::Gemm g{ao, wt, MTOK, DM, DM}; pg8::StaticOrder S; S.init(MTOK, DM, G, bx);
            pg8::EpiResid E{xold, a.out, xb, ssq};
            pg8::gemm_phase<pg8::EpiResid, pg8::StaticOrder, true, true>(lds, g, S, E);
        }
        grid.sync();
        const bf16* wup = (const bf16*)(ws + WS_WUP) + (size_t)layer * DUP * DM;
        const bf16* wdn = (const bf16*)(ws + WS_WDN) + (size_t)layer * DM * DFF;
        for (int half = 0; half < 2; ++half) {
            const size_t r0 = (size_t)half * HALF_ROWS;
            {
                pg8::Gemm g{xb + r0 * DM, wup, HALF_ROWS, DUP, DM}; pg8::StaticOrder S; S.init(HALF_ROWS, DUP, G, bx);
                pg8::EpiScaleBf16 E{ubuf, DUP, ssq + r0 * 16};
                pg8::gemm_phase<pg8::EpiScaleBf16, pg8::StaticOrder, true, true>(lds, g, S, E);
            }
            grid.sync();
#if PH_CONV
            {
                const float* cw = a.ffn_conv + (size_t)layer * 3 * DUP; const float* cb = a.ffn_conv_b + (size_t)layer * DUP;
                constexpr int NCC = 6, NRC = HALF_ROWS / 32;
                int tq = threadIdx.x; asm volatile("" : "+v"(tq)); const int lane = tq & 63;
                for (int it = gw; it < NCC * NRC; it += NGW) {
                    const int cc = it % NCC, rc = it / NCC, cgp = cc * 64 + lane;
                    if (cgp < DFF / 8) {
                        const int col = cgp * 8, row0 = rc * 32;
                        float wg[3][8], wv[3][8], bg[8], bv[8];
#pragma unroll
                        for (int tp = 0; tp < 3; ++tp)
#pragma unroll
                            for (int k = 0; k < 8; k += 4) { const f32x4 t1 = *(const f32x4*)(cw + tp * DUP + col + k), t2 = *(const f32x4*)(cw + tp * DUP + DFF + col + k);
#pragma unroll
                                for (int q = 0; q < 4; ++q) { wg[tp][k + q] = t1[q]; wv[tp][k + q] = t2[q]; } }
#pragma unroll
                        for (int k = 0; k < 8; k += 4) { const f32x4 t1 = *(const f32x4*)(cb + col + k), t2 = *(const f32x4*)(cb + DFF + col + k);
#pragma unroll
                            for (int q = 0; q < 4; ++q) { bg[k + q] = t1[q]; bv[k + q] = t2[q]; } }
                        float g2[8], g1[8], v2[8], v1[8];
                        const bool head = (row0 % SEQ) == 0;
                        {
                            v4u a2 = {0, 0, 0, 0}, a1 = {0, 0, 0, 0}, c2 = {0, 0, 0, 0}, c1 = {0, 0, 0, 0};
                            if (!head) { const bf16* up = ubuf + (size_t)(row0 - 2) * DUP + col; a2 = *(const v4u*)up; c2 = *(const v4u*)(up + DFF); a1 = *(const v4u*)(up + DUP); c1 = *(const v4u*)(up + DUP + DFF); }
#pragma unroll
                            for (int k = 0; k < 8; ++k) { const int sh = (k & 1) * 16;
                                g2[k] = __uint_as_float(((a2[k >> 1] >> sh) & 0xffffu) << 16); g1[k] = __uint_as_float(((a1[k >> 1] >> sh) & 0xffffu) << 16);
                                v2[k] = __uint_as_float(((c2[k >> 1] >> sh) & 0xffffu) << 16); v1[k] = __uint_as_float(((c1[k >> 1] >> sh) & 0xffffu) << 16); }
                        }
                        for (int r = 0; r < 32; ++r) {
                            const bf16* up = ubuf + (size_t)(row0 + r) * DUP + col;
                            const v4u a0 = *(const v4u*)up, c0 = *(const v4u*)(up + DFF);
                            float res[8];
#pragma unroll
                            for (int k = 0; k < 8; ++k) { const int sh = (k & 1) * 16;
                                const float g0 = __uint_as_float(((a0[k >> 1] >> sh) & 0xffffu) << 16), v0 = __uint_as_float(((c0[k >> 1] >> sh) & 0xffffu) << 16);
                                const float gg = bg[k] + wg[0][k] * g2[k] + wg[1][k] * g1[k] + wg[2][k] * g0;
                                const float vv = bv[k] + wv[0][k] * v2[k] + wv[1][k] * v1[k] + wv[2][k] * v0;
                                const float sg = gg * __builtin_amdgcn_rcpf(1.0f + __builtin_amdgcn_exp2f(-gg * att::LOG2E));
                                res[k] = sg * vv; g2[k] = g1[k]; g1[k] = g0; v2[k] = v1[k]; v1[k] = v0; }
                            v4u w; w.x = pk2(res[0], res[1]); w.y = pk2(res[2], res[3]); w.z = pk2(res[4], res[5]); w.w = pk2(res[6], res[7]);
                            *(v4u*)(gbuf + (size_t)(row0 + r) * DFF + col) = w;
                        }
                    }
                }
            }
#endif
            grid.sync();
            {
                pg8::Gemm g{gbuf, wdn, HALF_ROWS, DM, DFF}; pg8::StaticOrder S; S.init(HALF_ROWS, DM, G, bx);
                pg8::EpiResid E{a.out + r0 * DM, a.out + r0 * DM, xb + r0 * DM, ssq + r0 * 16};
                pg8::gemm_phase<pg8::EpiResid, pg8::StaticOrder, true, true>(lds, g, S, E);
            }
            if (half == 1) grid.sync();
        }
    }
    { int tq = threadIdx.x; asm volatile("" : "+v"(tq)); const int lane = tq & 63;
    for (int m = gw; m < MTOK; m += NGW) {
        f32x4* xr = (f32x4*)(a.out + (size_t)m * DM) + lane; f32x4 v[4]; float s = 0.f;
#pragma unroll
        for (int j = 0; j < 4; ++j) { v[j] = xr[64 * j]; s += (v[j][0] * v[j][0] + v[j][1] * v[j][1]) + (v[j][2] * v[j][2] + v[j][3] * v[j][3]); }
        s = wave_sum(s);
        const float rs = __builtin_amdgcn_rsqf(s * (1.0f / DM) + 1e-6f);
#pragma unroll
        for (int j = 0; j < 4; ++j) { const f32x4 gv = *((const f32x4*)a.norm_final + lane + 64 * j); xr[64 * j] = v[j] * rs * gv; }
    } }
}

extern "C" void kernel_launch(void* const* d_in, const int* in_sizes, int n_in, void* d_out, int out_size, void* d_ws, size_t ws_size, hipStream_t stream) {
    static int grid = 0;
    if (grid == 0) {
        int dev = 0, cus = 0, per_cu = 0;
        (void)hipGetDevice(&dev);
        (void)hipDeviceGetAttribute(&cus, hipDeviceAttributeMultiprocessorCount, dev);
        (void)hipFuncSetAttribute((const void*)mega_fwd, hipFuncAttributeMaxDynamicSharedMemorySize, LDS_BYTES);
        (void)hipOccupancyMaxActiveBlocksPerMultiprocessor(&per_cu, (const void*)mega_fwd, NWAVES * 64, LDS_BYTES);
        if (per_cu < 1) per_cu = 1;
        grid = cus * per_cu;
        if (n_in != 19 || ws_size < 1024 * MiB) fprintf(stderr, "kernel_launch: unexpected n_in %d / ws %zu\n", n_in, ws_size);
    }
    Args a{};
    a.x = (const float*)d_in[0]; a.rel_bias = (const float*)d_in[1]; a.norm_mix = (const float*)d_in[2]; a.norm_ffn = (const float*)d_in[3]; a.norm_final = (const float*)d_in[4];
    a.w_in_even = (const float*)d_in[5]; a.w_out_even = (const float*)d_in[6]; a.sinks = (const float*)d_in[7]; a.lam_q1 = (const float*)d_in[8]; a.lam_k1 = (const float*)d_in[9];
    a.lam_q2 = (const float*)d_in[10]; a.lam_k2 = (const float*)d_in[11]; a.diff_norm = (const float*)d_in[12]; a.w_in_odd = (const float*)d_in[13]; a.w_out_odd = (const float*)d_in[14];
    a.ffn_up = (const float*)d_in[15]; a.ffn_conv = (const float*)d_in[16]; a.ffn_conv_b = (const float*)d_in[17]; a.ffn_down = (const float*)d_in[18];
    a.out = (float*)d_out; a.ws = (unsigned char*)d_ws;
    void* args[] = {&a};
    hipError_t err = hipLaunchCooperativeKernel((const void*)mega_fwd, dim3(grid), dim3(NWAVES * 64), args, LDS_BYTES, stream);
    if (err != hipSuccess) fprintf(stderr, "kernel_launch: cooperative launch failed: %s (grid %d)\n", hipGetErrorString(err), grid);
}
```

```cpp
#include <hip/hip_runtime.h>
#include <hip/hip_cooperative_groups.h>
#include <cstdio>
#include <cstdint>
namespace cg = cooperative_groups;
namespace pg8 {
#define PG8_LAS __attribute__((address_space(3)))
typedef unsigned short bf16_t;
typedef short bf16x8 __attribute__((ext_vector_type(8)));
typedef float f32x4 __attribute__((ext_vector_type(4)));
typedef unsigned u32x4 __attribute__((ext_vector_type(4)));
constexpr int BM = 256, BK = 64, HALF = 128, HTB = HALF * BK * 2  , STAGE_BYTES = 8 * HTB, NXCD = 8, WGM = 8;

__host__ __device__ __forceinline__ int lds_byte(int r, int c) { const int st = (r >> 4) * 2 + (c >> 5), rr = r & 15, cc = c & 31, ob = rr * 64 + cc * 2; return st * 1024 + (ob ^ (((ob >> 9) & 1) << 5)); }
__host__ __device__ __forceinline__ void stage_rc(int b, int& R, int& C) { const int st = b / 1024, sb = b % 1024, swz = sb ^ (((sb >> 9) & 1) << 5); R = (st >> 1) * 16 + swz / 64; C = (st & 1) * 32 + (swz % 64) / 2; }
__host__ __device__ __forceinline__ int perm32(int rho) { const int n = rho >> 4, i = rho & 15; return 8 * (i >> 2) + 4 * n + (i & 3); }

struct Unit { int pm, pn; };
struct Gemm { const bf16_t* A; const bf16_t* Bt; int M, N, K; };

struct StaticOrder {
    int nM, nN, nwg, G, c;
    __host__ __device__ void init(int M, int N, int G_, int c_) { nM = M / BM; nN = N / BM; nwg = nM * nN; G = G_; c = c_; }
    __host__ __device__ bool next(int i, Unit& u) const {
        const long L = (long)i * G + c; if (L >= nwg) return false;
        int wgid = (int)L; { const int q = nwg / NXCD, r = nwg % NXCD, xcd = wgid % NXCD, off = wgid / NXCD; wgid = (xcd < r ? xcd * (q + 1) : r * (q + 1) + (xcd - r) * q) + off; }
        const int nig = WGM * nN, gid = wgid / nig, fm = gid * WGM, gsz = (nM - fm) < WGM ? (nM - fm) : WGM;
        u.pm = fm + ((wgid % nig) % gsz); u.pn = (wgid % nig) / gsz; return true;
    }
    __device__ __forceinline__ void a_ready(const Unit&) const {}
    __device__ __forceinline__ void done(const Unit&) const {}
};

__device__ __forceinline__ unsigned cvt_pk_bf16(float lo, float hi) { unsigned r; asm volatile("v_cvt_pk_bf16_f32 %0, %1, %2" : "=v"(r) : "v"(lo), "v"(hi)); return r; }
typedef float f32x2 __attribute__((ext_vector_type(2)));
typedef unsigned u32x2 __attribute__((ext_vector_type(2)));
constexpr float RMS_EPS = 1e-6f;
__device__ __forceinline__ float row_rstd(const float* ssq, int row) {
    const f32x4* s = (const f32x4*)(ssq + (size_t)row * 16);
    const f32x4 a = s[0], b = s[1], c = s[2], d = s[3];
    const float t = ((a[0] + a[1]) + (a[2] + a[3])) + ((b[0] + b[1]) + (b[2] + b[3])) + ((c[0] + c[1]) + (c[2] + c[3])) + ((d[0] + d[1]) + (d[2] + d[3]));
    return __builtin_amdgcn_rsqf(t * (1.0f / 1024.0f) + RMS_EPS);
}
struct EpiScaleBf16 {
    static constexpr bool PERM = true, AFTER_DRAIN = false;
    bf16_t* O; int ldc; const float* ssq;
    __device__ __forceinline__ void operator()(const f32x4 (&acc)[2][2][4][2], const Unit& u, int wr, int wc, int fr, int fq) const {
        const int row0 = u.pm * BM + wr * 64 + fr, col0 = u.pn * BM + wc * 32 + 8 * fq;
#pragma unroll
        for (int ai = 0; ai < 2; ++ai)
#pragma unroll
            for (int m = 0; m < 4; ++m) { const int row = row0 + ai * HALF + m * 16; const float rs = row_rstd(ssq, row); bf16_t* rowp = O + (size_t)row * ldc + col0;
#pragma unroll
                for (int bj = 0; bj < 2; ++bj) { const f32x4 v0 = acc[ai][bj][m][0] * rs, v1 = acc[ai][bj][m][1] * rs;
                    u32x4 w; w.x = cvt_pk_bf16(v0[0], v0[1]); w.y = cvt_pk_bf16(v0[2], v0[3]); w.z = cvt_pk_bf16(v1[0], v1[1]); w.w = cvt_pk_bf16(v1[2], v1[3]);
                    *(u32x4*)(rowp + bj * HALF) = w; }
                asm volatile("" ::: "memory"); }
    }
};
struct EpiResid {
    static constexpr bool PERM = false, AFTER_DRAIN = false;
    const float* base; float* out; bf16_t* xb; float* ssq;
    __device__ __forceinline__ void operator()(const f32x4 (&acc)[2][2][4][2], const Unit& u, int wr, int wc, int fr, int fq) const {
        const int col0 = u.pn * BM + wc * 32 + 4 * fq;
#pragma unroll
        for (int ai = 0; ai < 2; ++ai)
#pragma unroll
            for (int m = 0; m < 4; ++m) { const int row = u.pm * BM + ai * HALF + wr * 64 + m * 16 + fr; const size_t off = (size_t)row * 1024 + col0; float q = 0.f;
#pragma unroll
                for (int bj = 0; bj < 2; ++bj)
#pragma unroll
                    for (int n = 0; n < 2; ++n) { const f32x4 bs = *(const f32x4*)(base + off + bj * HALF + n * 16); const f32x4 o = bs + acc[ai][bj][m][n];
                        *(f32x4*)(out + off + bj * HALF + n * 16) = o; q += (o[0] * o[0] + o[1] * o[1]) + (o[2] * o[2] + o[3] * o[3]);
                        u32x2 w; w.x = cvt_pk_bf16(o[0], o[1]); w.y = cvt_pk_bf16(o[2], o[3]); *(u32x2*)(xb + off + bj * HALF + n * 16) = w; }
                q += __shfl_xor(q, 16); q += __shfl_xor(q, 32);
                if (fq == 0) ssq[(size_t)row * 16 + u.pn * 4 + wc] = q;
                asm volatile("" ::: "memory"); }
    }
};
template <class Epi, class Sched, bool ALIGN_EPI = false, bool SP2 = false>
__device__ __forceinline__ void gemm_phase(PG8_LAS unsigned char* lds, const Gemm g, const Sched& S, const Epi& E) {
    int tid_ = threadIdx.x; asm volatile("" : "+v"(tid_));
    const int tid = tid_, wid = __builtin_amdgcn_readfirstlane(tid >> 6), lane = tid & 63, wr = wid >> 2, wc = wid & 3, fr = lane & 15, fq = lane >> 4;
    const int K = g.K, nt = K / BK;
    unsigned voffA[2], voffB[2];
#pragma unroll
    for (int i = 0; i < 2; ++i) { int R, C; stage_rc(tid * 16 + i * 8192, R, C); const int Rb = Epi::PERM ? ((R & ~31) + perm32(R & 31)) : R;
        voffA[i] = (unsigned)(R * K + C) * 2u; voffB[i] = (unsigned)(Rb * K + C) * 2u; }
    const size_t kstep = (size_t)(BK * 2);
    const size_t hstep = (size_t)HALF * K * 2;
    const size_t tstep = 2 * hstep;
    const unsigned ldsw = (unsigned)wid * 1024u;
    const int aoff = lds_byte(wr * 64 + fr, fq * 8), boff = lds_byte(wc * 32 + fr, fq * 8);
#define PG8_SA(b, h) (((b) * 2 + (h)) * HTB)
#define PG8_SB(b, h) ((4 + (b) * 2 + (h)) * HTB)
#define PG8_STAGE(bufoff, gbase, voff) do { _Pragma("unroll") for (int _i = 0; _i < 2; ++_i) \
        __builtin_amdgcn_global_load_lds((const unsigned*)((const char*)(gbase) + (voff)[_i]), (PG8_LAS unsigned*)(lds + (bufoff) + ldsw + _i * 8192), 16, 0, 0); } while (0)
#define PG8_LDA(dst, b, h) do { _Pragma("unroll") for (int m = 0; m < 4; ++m) _Pragma("unroll") for (int k = 0; k < 2; ++k) dst[m][k] = *(const PG8_LAS bf16x8*)(lds + PG8_SA(b, h) + aoff + m * 2048 + k * 1024); } while (0)
#define PG8_LDB(dst, b, h) do { _Pragma("unroll") for (int n = 0; n < 2; ++n) _Pragma("unroll") for (int k = 0; k < 2; ++k) dst[n][k] = *(const PG8_LAS bf16x8*)(lds + PG8_SB(b, h) + boff + n * 2048 + k * 1024); } while (0)
#define PG8_MMA(ai, bj, At, Bt) do { __builtin_amdgcn_s_setprio(1); _Pragma("unroll") for (int m = 0; m < 4; ++m) _Pragma("unroll") for (int n = 0; n < 2; ++n) _Pragma("unroll") for (int k = 0; k < 2; ++k) \
        acc[ai][bj][m][n] = __builtin_amdgcn_mfma_f32_16x16x32_bf16(Bt[n][k], At[m][k], acc[ai][bj][m][n], 0, 0, 0); __builtin_amdgcn_s_setprio(0); } while (0)
#define PG8_WAIT_V(n) asm volatile("s_waitcnt vmcnt(" #n ")" ::: "memory")
#define PG8_WAIT_L(n) asm volatile("s_waitcnt lgkmcnt(" #n ")" ::: "memory")
#define PG8_BAR __builtin_amdgcn_s_barrier()
#define PG8_SCHED __builtin_amdgcn_sched_barrier(0)
    Unit cur, nxt; int ui = 0;
    if (!S.next(0, cur)) return;
    f32x4 acc[2][2][4][2];
#pragma unroll
    for (int a = 0; a < 2; ++a)
#pragma unroll
        for (int b = 0; b < 2; ++b)
#pragma unroll
            for (int m = 0; m < 4; ++m)
#pragma unroll
                for (int n = 0; n < 2; ++n) acc[a][b][m][n] = (f32x4){0.f, 0.f, 0.f, 0.f};
    bf16x8 At[4][2], B0[2][2], B1[2][2];
    const char* cA = (const char*)g.A + (size_t)cur.pm * tstep; const char* cB = (const char*)g.Bt + (size_t)cur.pn * tstep;
    S.a_ready(cur);
    if constexpr (SP2) {
        PG8_STAGE(PG8_SB(0, 0), cB, voffB); PG8_STAGE(PG8_SB(0, 1), cB + hstep, voffB); PG8_STAGE(PG8_SA(0, 0), cA, voffA); PG8_STAGE(PG8_SA(0, 1), cA + hstep, voffA);
        if (wr == 1) PG8_BAR;
        PG8_WAIT_V(2); PG8_BAR;
        PG8_STAGE(PG8_SB(1, 0), cB + kstep, voffB); PG8_STAGE(PG8_SA(1, 0), cA + kstep, voffA); PG8_STAGE(PG8_SB(1, 1), cB + hstep + kstep, voffB);
        PG8_WAIT_V(6); PG8_BAR;
    } else {
        PG8_STAGE(PG8_SB(0, 0), cB, voffB); PG8_STAGE(PG8_SA(0, 0), cA, voffA); PG8_STAGE(PG8_SB(0, 1), cB + hstep, voffB); PG8_STAGE(PG8_SA(0, 1), cA + hstep, voffA);
        if (wr == 1) PG8_BAR;
        PG8_WAIT_V(4); PG8_BAR;
        PG8_STAGE(PG8_SB(1, 0), cB + kstep, voffB); PG8_STAGE(PG8_SA(1, 0), cA + kstep, voffA); PG8_STAGE(PG8_SB(1, 1), cB + hstep + kstep, voffB);
        PG8_WAIT_V(6); PG8_BAR;
    }
    for (;;) {
        const bool has_next = S.next(ui + 1, nxt);
        const char* nA = has_next ? (const char*)g.A + (size_t)nxt.pm * tstep : cA; const char* nB = has_next ? (const char*)g.Bt + (size_t)nxt.pn * tstep : cB;
        for (int t = 0; t < nt; t += 2) {
            const bool last = (t == nt - 2);
            const char* a1 = cA + (size_t)(t + 1) * kstep;
            const char* a2 = last ? nA : cA + (size_t)(t + 2) * kstep; const char* b2 = last ? nB : cB + (size_t)(t + 2) * kstep;
            const char* a3 = a2 + kstep; const char* b3 = b2 + kstep;
            if (last && has_next) S.a_ready(nxt);
            if constexpr (SP2) {
            PG8_LDB(B0, 0, 0); PG8_LDB(B1, 0, 1); PG8_SCHED; PG8_LDA(At, 0, 0); PG8_STAGE(PG8_SA(1, 1), a1 + hstep, voffA);
            PG8_WAIT_V(8); PG8_WAIT_L(0); PG8_BAR; PG8_MMA(0, 0, At, B0); PG8_MMA(0, 1, At, B1); PG8_BAR; PG8_SCHED;
            PG8_LDA(At, 0, 1); PG8_STAGE(PG8_SB(0, 0), b2, voffB); PG8_STAGE(PG8_SB(0, 1), b2 + hstep, voffB); PG8_STAGE(PG8_SA(0, 0), a2, voffA);
            PG8_WAIT_V(8); PG8_WAIT_L(0); PG8_BAR; PG8_MMA(1, 0, At, B0); PG8_MMA(1, 1, At, B1); PG8_BAR; PG8_SCHED;
            PG8_LDB(B0, 1, 0); PG8_LDB(B1, 1, 1); PG8_SCHED; PG8_LDA(At, 1, 0); PG8_STAGE(PG8_SA(0, 1), a2 + hstep, voffA);
            PG8_WAIT_V(8); PG8_WAIT_L(0); PG8_BAR; PG8_MMA(0, 0, At, B0); PG8_MMA(0, 1, At, B1); PG8_BAR; PG8_SCHED;
            PG8_LDA(At, 1, 1); PG8_STAGE(PG8_SB(1, 0), b3, voffB); PG8_STAGE(PG8_SB(1, 1), b3 + hstep, voffB); PG8_STAGE(PG8_SA(1, 0), a3, voffA);
            PG8_WAIT_V(8); PG8_WAIT_L(0); PG8_BAR; PG8_MMA(1, 0, At, B0); PG8_MMA(1, 1, At, B1); PG8_BAR; PG8_SCHED;
            } else {
            PG8_LDB(B0, 0, 0); PG8_SCHED; PG8_LDA(At, 0, 0); PG8_STAGE(PG8_SA(1, 1), a1 + hstep, voffA);
            PG8_WAIT_L(8); PG8_BAR; PG8_WAIT_L(0); PG8_MMA(0, 0, At, B0); PG8_BAR; PG8_SCHED;
            PG8_LDB(B1, 0, 1); PG8_STAGE(PG8_SB(0, 0), b2, voffB);
            PG8_BAR; PG8_WAIT_L(0); PG8_MMA(0, 1, At, B1); PG8_BAR;
            PG8_LDA(At, 0, 1); PG8_STAGE(PG8_SA(0, 0), a2, voffA);
            PG8_BAR; PG8_WAIT_L(0); PG8_MMA(1, 0, At, B0); PG8_BAR; PG8_SCHED;
            PG8_STAGE(PG8_SB(0, 1), b2 + hstep, voffB);
            PG8_WAIT_V(6); PG8_BAR; PG8_MMA(1, 1, At, B1); PG8_BAR;
            PG8_LDB(B0, 1, 0); PG8_SCHED; PG8_LDA(At, 1, 0); PG8_STAGE(PG8_SA(0, 1), a2 + hstep, voffA);
            PG8_WAIT_L(8); PG8_BAR; PG8_WAIT_L(0); PG8_MMA(0, 0, At, B0); PG8_BAR; PG8_SCHED;
            PG8_LDB(B1, 1, 1); PG8_STAGE(PG8_SB(1, 0), b3, voffB);
            PG8_BAR; PG8_WAIT_L(0); PG8_MMA(0, 1, At, B1); PG8_BAR;
            PG8_LDA(At, 1, 1); PG8_STAGE(PG8_SA(1, 0), a3, voffA);
            PG8_BAR; PG8_WAIT_L(0); PG8_MMA(1, 0, At, B0); PG8_BAR; PG8_SCHED;
            PG8_STAGE(PG8_SB(1, 1), b3 + hstep, voffB);
            PG8_WAIT_V(6); PG8_BAR; PG8_MMA(1, 1, At, B1); PG8_BAR;
            }
        }
        if constexpr (ALIGN_EPI) { if (wr == 0) PG8_BAR; }
        if constexpr (!Epi::AFTER_DRAIN) { E(acc, cur, wr, wc, fr, fq); S.done(cur); }
        if (!has_next) break;
#pragma unroll
        for (int a = 0; a < 2; ++a)
#pragma unroll
            for (int b = 0; b < 2; ++b)
#pragma unroll
                for (int m = 0; m < 4; ++m)
#pragma unroll
                    for (int n = 0; n < 2; ++n) acc[a][b][m][n] = (f32x4){0.f, 0.f, 0.f, 0.f};
        cur = nxt; cA = nA; cB = nB; ++ui;
        if constexpr (ALIGN_EPI) { if (wr == 1) PG8_BAR; }
    }
    PG8_WAIT_V(0);
    if constexpr (!ALIGN_EPI) { if (wr == 0) PG8_BAR; }
    PG8_BAR;
    if constexpr (Epi::AFTER_DRAIN) { E.fused(acc, cur, wr, wc, fr, fq, lds, wid, lane); S.done(cur); }
#undef PG8_SA
#undef PG8_SB
#undef PG8_STAGE
#undef PG8_LDA
#undef PG8_LDB
#undef PG8_MMA
#undef PG8_WAIT_V
#undef PG8_WAIT_L
#undef PG8_BAR
#undef PG8_SCHED
}
}
namespace att {
#define ALAS __attribute__((address_space(3)))
typedef unsigned short bf16_t;
typedef short bf16x8 __attribute__((ext_vector_type(8)));
typedef float f32x16 __attribute__((ext_vector_type(16)));
typedef float f32x4 __attribute__((ext_vector_type(4)));
typedef unsigned u32x4 __attribute__((ext_vector_type(4)));
typedef unsigned u32x2 __attribute__((ext_vector_type(2)));
constexpr int KROW = 144;
constexpr int KBUF = 64 * KROW;
constexpr int VBUF = 128 * KROW;
constexpr int L_K = 0, L_V = 2 * KBUF, L_BT = L_V + 2 * VBUF, L_END = L_BT + 512;
constexpr float LOG2E = 1.4426950408889634f;
constexpr float QSCALE = 0.125f * 1.4426950408889634f;
#define CR(r) (((r) & 3) + 8 * ((r) >> 2))
__device__ __forceinline__ unsigned cvtpk(float lo, float hi) { unsigned r; asm volatile("v_cvt_pk_bf16_f32 %0, %1, %2" : "=v"(r) : "v"(lo), "v"(hi)); return r; }
__device__ __forceinline__ float ex2(float x) { return __builtin_amdgcn_exp2f(x); }
__device__ __forceinline__ float rcpf_(float x) { return __builtin_amdgcn_rcpf(x); }

template <int DV> struct Pref { u32x4 k; u32x4 v[DV / 64]; };

template <int DV> __device__ __forceinline__ void tile_load(Pref<DV>& pf, const bf16_t* Kp, const bf16_t* Vp, int pitch, int kt, int tid) {
    const int krow = tid >> 3, kc = (tid & 7) * 8;
    pf.k = *(const u32x4*)(Kp + (size_t)(kt * 64 + krow) * pitch + kc);
#pragma unroll
    for (int i = 0; i < DV / 64; ++i) { const int vrow = tid & 63, vc = ((tid >> 6) + 8 * i) * 8;
        pf.v[i] = *(const u32x4*)(Vp + (size_t)(kt * 64 + vrow) * pitch + vc); }
}
template <int DV> __device__ __forceinline__ void tile_store(const Pref<DV>& pf, ALAS unsigned char* kbuf, ALAS unsigned char* vbuf, int tid) {
    const int krow = tid >> 3, kc = (tid & 7) * 8;
    *(ALAS u32x4*)(kbuf + krow * KROW + kc * 2) = pf.k;
#pragma unroll
    for (int i = 0; i < DV / 64; ++i) { const int vrow = tid & 63, vc = ((tid >> 6) + 8 * i) * 8;
        const int kk = vrow & 15, pos = (vrow & ~15) + 8 * ((kk >> 2) & 1) + (kk & 3) + 4 * (kk >> 3);
        ALAS unsigned char* d = vbuf + vc * KROW + pos * 2;
#pragma unroll
        for (int j = 0; j < 8; ++j) { const unsigned w = pf.v[i][j >> 1]; *(ALAS unsigned short*)(d + j * KROW) = (unsigned short)((j & 1) ? (w >> 16) : (w & 0xffffu)); } }
}

template <int DV> __device__ __forceinline__ void pv_slab(const ALAS unsigned char* vbuf, int s, u32x4 w, f32x16 (&o)[DV / 32], int l32, int hi) {
    const bf16x8 pfr = __builtin_bit_cast(bf16x8, w);
#pragma unroll
    for (int db = 0; db < DV / 32; ++db) {
        const bf16x8 vf = *(const ALAS bf16x8*)(vbuf + (db * 32 + l32) * KROW + s * 32 + hi * 16);
        o[db] = __builtin_amdgcn_mfma_f32_32x32x16_bf16(vf, pfr, o[db], 0, 0, 0); }
    if (DV > 64) __builtin_amdgcn_sched_barrier(0);
}

template <int MODE, int DV, bool MASKED>
__device__ __forceinline__ void tile_compute(const ALAS unsigned char* kbuf, const ALAS unsigned char* vbuf, const bf16x8 (&qf)[4], f32x16 (&o)[DV / 32],
                                             float& st_m, float& st_l, int lim, const ALAS float* btab, float cbias, int lane) {
    const int l32 = lane & 31, hi = lane >> 5;
    if constexpr (MODE == 0) {
        f32x16 p0, p1;
#pragma unroll
        for (int r = 0; r < 16; ++r) { p0[r] = 0.f; p1[r] = 0.f; }
        { const ALAS unsigned char* kb = kbuf + l32 * KROW + hi * 16;
#pragma unroll
          for (int d0 = 0; d0 < 4; ++d0) {
              const bf16x8 k0 = *(const ALAS bf16x8*)(kb + d0 * 32);
              const bf16x8 k1 = *(const ALAS bf16x8*)(kb + 32 * KROW + d0 * 32);
              p0 = __builtin_amdgcn_mfma_f32_32x32x16_bf16(k0, qf[d0], p0, 0, 0, 0);
              p1 = __builtin_amdgcn_mfma_f32_32x32x16_bf16(k1, qf[d0], p1, 0, 0, 0); } }
        __builtin_amdgcn_sched_barrier(0);
#pragma unroll
        for (int r = 0; r < 16; ++r) {
            float a = rcpf_(1.0f + ex2(p0[r])), b = rcpf_(1.0f + ex2(p1[r]));
            if (MASKED) { a = (CR(r) < lim) ? a : 1.0f; b = (CR(r) + 32 < lim) ? b : 1.0f; }
            p0[r] = a; p1[r] = b; }
        float g[8], hs[8], pr[8];
#pragma unroll
        for (int i = 0; i < 4; ++i) { g[i] = (p0[4 * i] * p0[4 * i + 1]) * (p0[4 * i + 2] * p0[4 * i + 3]); g[4 + i] = (p1[4 * i] * p1[4 * i + 1]) * (p1[4 * i + 2] * p1[4 * i + 3]); }
#pragma unroll
        for (int i = 0; i < 8; ++i) { const float h = __shfl_xor(g[i], 32); pr[i] = g[i] * h; hs[i] = hi ? 1.0f : h; }
        float T = st_m;
#pragma unroll
        for (int i = 7; i >= 0; --i) {
            float R = hs[i] * T; T = T * pr[i];
            if (i >= 4) { const int b = 4 * (i - 4);
                float R2 = R * p1[b + 3]; p1[b + 3] = R - R2; float R1 = R2 * p1[b + 2]; p1[b + 2] = R2 - R1; float R0 = R1 * p1[b + 1]; p1[b + 1] = R1 - R0; p1[b] = R0 - R0 * p1[b]; }
            else { const int b = 4 * i;
                float R2 = R * p0[b + 3]; p0[b + 3] = R - R2; float R1 = R2 * p0[b + 2]; p0[b + 2] = R2 - R1; float R0 = R1 * p0[b + 1]; p0[b + 1] = R1 - R0; p0[b] = R0 - R0 * p0[b]; }
        }
        st_m = T;
        __builtin_amdgcn_sched_barrier(0);
#pragma unroll
        for (int s = 0; s < 4; ++s) {
            u32x4 w;
            if (s == 0) { w.x = cvtpk(p0[0], p0[1]); w.y = cvtpk(p0[2], p0[3]); w.z = cvtpk(p0[4], p0[5]); w.w = cvtpk(p0[6], p0[7]); }
            else if (s == 1) { w.x = cvtpk(p0[8], p0[9]); w.y = cvtpk(p0[10], p0[11]); w.z = cvtpk(p0[12], p0[13]); w.w = cvtpk(p0[14], p0[15]); }
            else if (s == 2) { w.x = cvtpk(p1[0], p1[1]); w.y = cvtpk(p1[2], p1[3]); w.z = cvtpk(p1[4], p1[5]); w.w = cvtpk(p1[6], p1[7]); }
            else { w.x = cvtpk(p1[8], p1[9]); w.y = cvtpk(p1[10], p1[11]); w.z = cvtpk(p1[12], p1[13]); w.w = cvtpk(p1[14], p1[15]); }
            pv_slab<DV>(vbuf, s, w, o, l32, hi);
        }
    } else {
        const float NEG = -__builtin_inff();
#pragma unroll
        for (int hk = 0; hk < 2; ++hk) {
            f32x16 p;
#pragma unroll
            for (int r = 0; r < 16; ++r) p[r] = 0.f;
            { const ALAS unsigned char* kb = kbuf + (32 * hk + l32) * KROW + hi * 16;
#pragma unroll
              for (int d0 = 0; d0 < 4; ++d0) { const bf16x8 k0 = *(const ALAS bf16x8*)(kb + d0 * 32); p = __builtin_amdgcn_mfma_f32_32x32x16_bf16(k0, qf[d0], p, 0, 0, 0); } }
            __builtin_amdgcn_sched_barrier(0);
            if (MASKED) {
#pragma unroll
                for (int r = 0; r < 16; ++r) {
                    const int d0 = lim - 32 * hk - CR(r);
                    const float b0 = btab[min(max(d0, 0), 127)];
                    const bool v0 = (MODE == 2) ? ((unsigned)d0 < 128u) : (d0 >= 0);
                    p[r] = v0 ? p[r] + b0 : NEG; }
            } else {
#pragma unroll
                for (int r = 0; r < 16; ++r) p[r] += cbias;
            }
            float mt = fmaxf(p[0], p[1]);
#pragma unroll
            for (int r = 2; r < 16; ++r) mt = fmaxf(mt, p[r]);
            mt = fmaxf(mt, __shfl_xor(mt, 32));
            if (__any(mt > st_m)) {
                const float mn = fmaxf(st_m, mt), f = ex2(st_m - mn);
                st_l *= f; st_m = mn;
#pragma unroll
                for (int db = 0; db < DV / 32; ++db)
#pragma unroll
                    for (int r = 0; r < 16; ++r) o[db][r] *= f;
            }
            float s = 0.f;
#pragma unroll
            for (int r = 0; r < 16; ++r) { p[r] = ex2(p[r] - st_m); s += p[r]; }
            st_l += s;
            __builtin_amdgcn_sched_barrier(0);
#pragma unroll
            for (int s2 = 0; s2 < 2; ++s2) {
                u32x4 w; w.x = cvtpk(p[8 * s2], p[8 * s2 + 1]); w.y = cvtpk(p[8 * s2 + 2], p[8 * s2 + 3]); w.z = cvtpk(p[8 * s2 + 4], p[8 * s2 + 5]); w.w = cvtpk(p[8 * s2 + 6], p[8 * s2 + 7]);
                pv_slab<DV>(vbuf, 2 * hk + s2, w, o, l32, hi);
            }
        }
    }
}

template <int MODE, int DV>
__device__ __forceinline__ void attn_core(const bf16_t* Qp, const bf16_t* Kp, const bf16_t* Vp, int pitch, int q0, int kt0, int nt, int dir,
                                          ALAS unsigned char* lds, f32x16 (&o)[DV / 32], float& st_m, float& st_l) {
    int tid_ = threadIdx.x; asm volatile("" : "+v"(tid_));
    const int tid = tid_, lane = tid & 63, l32 = lane & 31, hi = lane >> 5, wid = __builtin_amdgcn_readfirstlane(tid >> 6);
    const int qw = q0 + 32 * wid, t = qw + l32;
    const ALAS float* btab = (const ALAS float*)(lds + L_BT);
    bf16x8 qf[4];
#pragma unroll
    for (int d0 = 0; d0 < 4; ++d0) qf[d0] = *(const bf16x8*)(Qp + (size_t)t * pitch + d0 * 16 + hi * 8);
#pragma unroll
    for (int db = 0; db < DV / 32; ++db)
#pragma unroll
        for (int r = 0; r < 16; ++r) o[db][r] = 0.f;
    st_m = (MODE == 0) ? 1.0f : -1e30f; st_l = 0.f;
    Pref<DV> pf;
    tile_load<DV>(pf, Kp, Vp, pitch, kt0, tid);
    tile_store<DV>(pf, lds + L_K, lds + L_V, tid);
    __syncthreads();
    const float cbias = (MODE == 1) ? btab[127] : 0.f;
    for (int it = 0; it < nt; ++it) {
        const int kt = kt0 + dir * it, cur = it & 1, kbase = kt * 64;
        if (it + 1 < nt) tile_load<DV>(pf, Kp, Vp, pitch, kt + dir, tid);
        const ALAS unsigned char* kb = lds + L_K + cur * KBUF; const ALAS unsigned char* vb = lds + L_V + cur * VBUF;
        const int lim = t - kbase - 4 * hi;
        if (MODE == 0) {
            if (kbase <= qw + 31) { if (kbase + 63 >= qw) tile_compute<0, DV, true>(kb, vb, qf, o, st_m, st_l, lim, btab, cbias, lane); else tile_compute<0, DV, false>(kb, vb, qf, o, st_m, st_l, lim, btab, cbias, lane); }
        } else if (MODE == 1) {
            if (kbase <= qw + 31) { if (qw - (kbase + 63) < 113) tile_compute<1, DV, true>(kb, vb, qf, o, st_m, st_l, lim, btab, cbias, lane); else tile_compute<1, DV, false>(kb, vb, qf, o, st_m, st_l, lim, btab, cbias, lane); }
        } else {
            if (kbase <= qw + 31 && kbase + 63 >= qw - 127) tile_compute<2, DV, true>(kb, vb, qf, o, st_m, st_l, lim, btab, cbias, lane);
        }
        if (it + 1 < nt) tile_store<DV>(pf, lds + L_K + (cur ^ 1) * KBUF, lds + L_V + (cur ^ 1) * VBUF, tid);
        __syncthreads();
    }
}
template <int DV> __device__ __forceinline__ void store_ot(const f32x16 (&o)[DV / 32], bf16_t* orow, int hi) {
#pragma unroll
    for (int db = 0; db < DV / 32; ++db)
#pragma unroll
        for (int rg = 0; rg < 4; ++rg) { u32x2 w; w.x = cvtpk(o[db][4 * rg], o[db][4 * rg + 1]); w.y = cvtpk(o[db][4 * rg + 2], o[db][4 * rg + 3]);
            *(u32x2*)(orow + 32 * db + 8 * rg + 4 * hi) = w; }
}
}
#ifndef REP_INPROJ
#define REP_INPROJ 1
#endif
#ifndef REP_DIFF
#define REP_DIFF 1
#endif
#ifndef REP_SWA
#define REP_SWA 1
#endif
#ifndef REP_SB
#define REP_SB 1
#endif
#ifndef REP_UP
#define REP_UP 1
#endif
#ifndef REP_CONV
#define REP_CONV 1
#endif
#ifndef PH_DIFF
#define PH_DIFF 1
#endif
#ifndef PH_SWA
#define PH_SWA 1
#endif
#ifndef PH_SB
#define PH_SB 1
#endif
#ifndef PH_CONV
#define PH_CONV 1
#endif
#define LAS __attribute__((address_space(3)))
typedef unsigned short bf16;
typedef float f32x4 __attribute__((ext_vector_type(4)));
typedef unsigned v4u __attribute__((ext_vector_type(4)));
typedef unsigned v2u __attribute__((ext_vector_type(2)));
constexpr int NWAVES = 8;
constexpr int SEQ = 4096, NB = 16, MTOK = NB * SEQ, DM = 1024, DFF = 2816, DUP = 2 * DFF;
constexpr int EVEN_IN = 2304, ODD_IN = 3072;
constexpr size_t MiB = 1u << 20;
constexpr size_t WS_SSQ = 1 * MiB;
constexpr size_t WS_WINE = 8 * MiB, WS_WOUTE = 17 * MiB, WS_WINO = 21 * MiB, WS_WOUTO = 33 * MiB, WS_WUP = 37 * MiB, WS_WDN = 81 * MiB;
constexpr size_t WS_XB = 104 * MiB, WS_R = 232 * MiB;
constexpr size_t WS_PROJ = WS_R, WS_AO = WS_R + 384 * MiB, WS_U = WS_R, WS_G = WS_R + 352 * MiB;
constexpr int LDS_BYTES = 147456;
constexpr int HALF_ROWS = MTOK / 2;

struct Args {
    const float* x; const float* rel_bias; const float* norm_mix; const float* norm_ffn; const float* norm_final;
    const float* w_in_even; const float* w_out_even; const float* sinks; const float* lam_q1; const float* lam_k1; const float* lam_q2; const float* lam_k2;
    const float* diff_norm; const float* w_in_odd; const float* w_out_odd; const float* ffn_up; const float* ffn_conv; const float* ffn_conv_b; const float* ffn_down;
    float* out; unsigned char* ws;
};

__device__ const unsigned char T5B[128] = {0, 1, 2, 3, 4, 5, 6, 7, 8, 9, 10, 11, 12, 13, 14, 15, 16, 16, 16, 17, 17, 18, 18, 18, 19, 19, 19, 20, 20, 20, 20, 21, 21, 21, 21, 22, 22, 22, 22, 22, 23, 23, 23, 23, 23, 23, 24, 24, 24, 24, 24, 24, 25, 25, 25, 25, 25, 25, 25, 26, 26, 26, 26, 26, 26, 26, 26, 27, 27, 27, 27, 27, 27, 27, 27, 27, 27, 28, 28, 28, 28, 28, 28, 28, 28, 28, 28, 29, 29, 29, 29, 29, 29, 29, 29, 29, 29, 29, 29, 30, 30, 30, 30, 30, 30, 30, 30, 30, 30, 30, 30, 30, 30, 31, 31, 31, 31, 31, 31, 31, 31, 31, 31, 31, 31, 31, 31, 31};

__device__ __forceinline__ float wave_sum(float v) {
#pragma unroll
    for (int o = 1; o < 64; o <<= 1) v += __shfl_xor(v, o);
    return v;
}
__device__ __forceinline__ unsigned f2bf(float f) { unsigned u = __builtin_bit_cast(unsigned, f); return (u + 0x7fffu + ((u >> 16) & 1u)) >> 16; }
__device__ __forceinline__ unsigned pk2(float lo, float hi) { return f2bf(lo) | (f2bf(hi) << 16); }

__device__ __forceinline__ void transpose_item(const float* W, int K, int N, bf16* WT, const float* gk, int a0, int a1, int b0, int b1, float cs, LAS float* scr, int item, int lane) {
    const int nblk = N / 32, kb = item / nblk, nb = item % nblk, k0 = 64 * kb, n0 = 32 * nb;
    const int nn = n0 + (lane & 31);
    const float csc = ((nn >= a0 && nn < a1) || (nn >= b0 && nn < b1)) ? cs : 1.0f;
#pragma unroll 8
    for (int i = 0; i < 32; ++i) { const int kk = 2 * i + (lane >> 5); const float gv = gk ? gk[k0 + kk] : 1.0f; scr[kk * 33 + (lane & 31)] = W[(size_t)(k0 + kk) * N + nn] * (gv * csc); }
    asm volatile("s_waitcnt lgkmcnt(0)" ::: "memory");
    const int c = lane & 7;
#pragma unroll
    for (int j = 0; j < 4; ++j) { const int n = (lane >> 3) + 8 * j; const LAS float* s = scr + (8 * c) * 33 + n;
        v4u o; o.x = pk2(s[0 * 33], s[1 * 33]); o.y = pk2(s[2 * 33], s[3 * 33]); o.z = pk2(s[4 * 33], s[5 * 33]); o.w = pk2(s[6 * 33], s[7 * 33]);
        *(v4u*)(WT + (size_t)(n0 + n) * K + k0 + 8 * c) = o; }
    asm volatile("s_waitcnt lgkmcnt(0)" ::: "memory");
}

__global__ void __launch_bounds__(NWAVES * 64, 2) mega_fwd(Args a) {
    extern __shared__ __attribute__((aligned(16))) unsigned char lds_raw[];
    cg::grid_group grid = cg::this_grid();
    LAS unsigned char* lds = (LAS unsigned char*)lds_raw;
    const int tid = threadIdx.x, lane = tid & 63, wave = __builtin_amdgcn_readfirstlane(tid >> 6);
    const int G = gridDim.x, bx = blockIdx.x;
    const int gw = bx * NWAVES + wave, NGW = G * NWAVES;
    unsigned char* ws = a.ws;
    float* ssq = (float*)(ws + WS_SSQ);
    bf16* xb = (bf16*)(ws + WS_XB);
    bf16* proj = (bf16*)(ws + WS_PROJ);
    bf16* ao = (bf16*)(ws + WS_AO);
    bf16* ubuf = (bf16*)(ws + WS_U);
    bf16* gbuf = (bf16*)(ws + WS_G);

    {
        LAS float* scr = (LAS float*)(lds + wave * 16384);
        constexpr int I_INE = 16 * (EVEN_IN / 32), I_OUT = 16 * 32, I_INO = 16 * (ODD_IN / 32), I_UP = 16 * (DUP / 32), I_DN = (DFF / 64) * 32;
        constexpr int NITEMS = 2 * I_INE + 2 * I_OUT + 2 * I_INO + 2 * I_OUT + 4 * I_UP + 4 * I_DN;
        for (int it = gw; it < NITEMS; it += NGW) {
            int r = it;
            if (r < 2 * I_INE) { const int e = r / I_INE; r -= e * I_INE;
                transpose_item(a.w_in_even + (size_t)e * DM * EVEN_IN, DM, EVEN_IN, (bf16*)(ws + WS_WINE) + (size_t)e * EVEN_IN * DM, a.norm_mix + (2 * e) * DM, 0, 512, 768, 1280, att::QSCALE, scr, r, lane); continue; }
            r -= 2 * I_INE;
            if (r < 2 * I_OUT) { const int e = r / I_OUT; r -= e * I_OUT;
                transpose_item(a.w_out_even + (size_t)e * DM * DM, DM, DM, (bf16*)(ws + WS_WOUTE) + (size_t)e * DM * DM, nullptr, 0, 0, 0, 0, 1.f, scr, r, lane); continue; }
            r -= 2 * I_OUT;
            if (r < 2 * I_INO) { const int e = r / I_INO; r -= e * I_INO;
                transpose_item(a.w_in_odd + (size_t)e * DM * ODD_IN, DM, ODD_IN, (bf16*)(ws + WS_WINO) + (size_t)e * ODD_IN * DM, a.norm_mix + (2 * e + 1) * DM, 0, 1024, 0, 0, att::QSCALE, scr, r, lane); continue; }
            r -= 2 * I_INO;
            if (r < 2 * I_OUT) { const int e = r / I_OUT; r -= e * I_OUT;
                transpose_item(a.w_out_odd + (size_t)e * DM * DM, DM, DM, (bf16*)(ws + WS_WOUTO) + (size_t)e * DM * DM, nullptr, 0, 0, 0, 0, 1.f, scr, r, lane); continue; }
            r -= 2 * I_OUT;
            if (r < 4 * I_UP) { const int e = r / I_UP; r -= e * I_UP;
                transpose_item(a.ffn_up + (size_t)e * DM * DUP, DM, DUP, (bf16*)(ws + WS_WUP) + (size_t)e * DUP * DM, a.norm_ffn + e * DM, 0, 0, 0, 0, 1.f, scr, r, lane); continue; }
            r -= 4 * I_UP;
            { const int e = r / I_DN; r -= e * I_DN;
                transpose_item(a.ffn_down + (size_t)e * DFF * DM, DFF, DM, (bf16*)(ws + WS_WDN) + (size_t)e * DM * DFF, nullptr, 0, 0, 0, 0, 1.f, scr, r, lane); }
        }
        for (int m = gw; m < MTOK; m += NGW) {
            const f32x4* xr = (const f32x4*)(a.x + (size_t)m * DM) + lane; f32x4 v[4]; float s = 0.f;
#pragma unroll
            for (int j = 0; j < 4; ++j) { v[j] = xr[64 * j]; s += (v[j][0] * v[j][0] + v[j][1] * v[j][1]) + (v[j][2] * v[j][2] + v[j][3] * v[j][3]); }
            s = wave_sum(s);
            v2u* o8 = (v2u*)(xb + (size_t)m * DM) + lane;
#pragma unroll
            for (int j = 0; j < 4; ++j) { v2u w; w.x = pk2(v[j][0], v[j][1]); w.y = pk2(v[j][2], v[j][3]); o8[64 * j] = w; }
            if (lane < 16) ssq[(size_t)m * 16 + lane] = (lane == 0) ? s : 0.f;
        }
    }
    grid.sync();

    for (int layer = 0; layer < 4; ++layer) {
        const int e = layer >> 1; const bool even = (layer & 1) == 0;
        const float* xold = (layer == 0) ? a.x : a.out;
        {
            const int N = even ? EVEN_IN : ODD_IN;
            const bf16* wt = even ? (const bf16*)(ws + WS_WINE) + (size_t)e * EVEN_IN * DM : (const bf16*)(ws + WS_WINO) + (size_t)e * ODD_IN * DM;
            pg8::Gemm g{xb, wt, MTOK, N, DM}; pg8::StaticOrder S; S.init(MTOK, N, G, bx);
            pg8::EpiScaleBf16 E{proj, N, ssq};
            for (int rep_ = 0; rep_ < REP_INPROJ; ++rep_)
            pg8::gemm_phase<pg8::EpiScaleBf16, pg8::StaticOrder, true, true>(lds, g, S, E);
        }
        grid.sync();
        if (even) {
            int tq = threadIdx.x; asm volatile("" : "+v"(tq)); const int tid = tq, lane = tq & 63, l32 = lane & 31, hi = lane >> 5;
            float lam, one_m_li;
            { const float li = (layer == 0) ? 0.2f : 0.47071301839f;
              const float s1 = wave_sum(a.lam_q1[e * 64 + lane] * a.lam_k1[e * 64 + lane]), s2 = wave_sum(a.lam_q2[e * 64 + lane] * a.lam_k2[e * 64 + lane]);
              lam = __expf(s1) - __expf(s2) + li; lam = __builtin_bit_cast(float, __builtin_amdgcn_readfirstlane(__builtin_bit_cast(int, lam))); one_m_li = 1.0f - li; }
            LAS float* btab = (LAS float*)(lds + att::L_BT);

#if PH_DIFF
            for (int rep_ = 0; rep_ < REP_DIFF; ++rep_)
            for (int uidx = bx; uidx < 1024; uidx += G) {
                const int j = uidx >> 8, c = uidx & 255, bh = c >> 2, s = c & 3, b = bh >> 2, h = bh & 3;
                const int qb = (j == 0) ? s : (j == 1) ? 7 - s : (j == 2) ? 8 + s : 15 - s;
                if (tid < 128) btab[tid] = a.rel_bias[T5B[tid] * 12 + 8 + h] * att::LOG2E;
                const bf16* base = proj + (size_t)b * SEQ * EVEN_IN;
                const int q0 = qb * 256, nt = 4 * qb + 4, t = q0 + 32 * wave + l32;
                att::f32x16 o2[4]; float m2, l2; LAS unsigned* o1s = (LAS unsigned*)(lds + 57344 + wave * 8192) + lane;
                { float m1, l1;
                  att::attn_core<1, 128>(base + 768 + h * 128, base + 1280 + h * 128, base + 1792 + h * 128, EVEN_IN, q0, 0, nt, 1, lds, o2, m1, l1);
                  const float inv = __builtin_amdgcn_rcpf(l1 + __shfl_xor(l1, 32));
#pragma unroll
                  for (int db = 0; db < 4; ++db)
#pragma unroll
                      for (int k = 0; k < 8; ++k) o1s[(db * 8 + k) * 64] = att::cvtpk(o2[db][2 * k] * inv, o2[db][2 * k + 1] * inv); }
                att::attn_core<1, 128>(base + 768 + h * 128 + 64, base + 1280 + h * 128 + 64, base + 1792 + h * 128, EVEN_IN, q0, 0, nt, 1, lds, o2, m2, l2);
                { const float inv = lam * __builtin_amdgcn_rcpf(l2 + __shfl_xor(l2, 32)); float ss = 0.f;
#pragma unroll
                  for (int db = 0; db < 4; ++db)
#pragma unroll
                      for (int r = 0; r < 16; ++r) { const unsigned w = o1s[(db * 8 + (r >> 1)) * 64]; const float a1 = __uint_as_float((r & 1) ? (w & 0xffff0000u) : (w << 16));
                          const float v = a1 - inv * o2[db][r]; o2[db][r] = v; ss += v * v; }
                  ss += __shfl_xor(ss, 32);
                  const float rs = __builtin_amdgcn_rsqf(ss * (1.0f / 128.0f) + 1e-6f) * one_m_li;
                  const float* gn = a.diff_norm + e * 128;
#pragma unroll
                  for (int db = 0; db < 4; ++db)
#pragma unroll
                      for (int rg = 0; rg < 4; ++rg) { const f32x4 gv = *(const f32x4*)(gn + 32 * db + 8 * rg + 4 * hi);
#pragma unroll
                          for (int k = 0; k < 4; ++k) o2[db][4 * rg + k] *= rs * gv[k]; } }
                att::store_ot<128>(o2, ao + ((size_t)b * SEQ + t) * DM + 512 + h * 128, hi);
            }
#endif
#if PH_SWA
            for (int rep_ = 0; rep_ < REP_SWA; ++rep_)
            for (int uidx = bx; uidx < 2048; uidx += G) {
                const int qb = uidx & 15, qh = (uidx >> 4) & 7, b = uidx >> 7, kvh = qh >> 2;
                if (tid < 128) btab[tid] = a.rel_bias[T5B[tid] * 12 + qh] * att::LOG2E;
                const bf16* base = proj + (size_t)b * SEQ * EVEN_IN;
                const int q0 = qb * 256, t = q0 + 32 * wave + l32;
                const int kt0 = (qb * 4 - 2 > 0) ? qb * 4 - 2 : 0, nt = qb * 4 + 4 - kt0;
                att::f32x16 o[2]; float m, l;
                att::attn_core<2, 64>(base + qh * 64, base + 512 + kvh * 64, base + 640 + kvh * 64, EVEN_IN, q0, kt0, nt, 1, lds, o, m, l);
                const float sk = a.sinks[e * 8 + qh] * att::LOG2E;
                const float inv = __builtin_amdgcn_rcpf(l + __shfl_xor(l, 32) + __builtin_amdgcn_exp2f(sk - m));
#pragma unroll
                for (int db = 0; db < 2; ++db)
#pragma unroll
                    for (int r = 0; r < 16; ++r) o[db][r] *= inv;
                att::store_ot<64>(o, ao + ((size_t)b * SEQ + t) * DM + qh * 64, hi);
            }
#endif
        } else {
#if PH_SB
            int tq = threadIdx.x; asm volatile("" : "+v"(tq)); const int lane = tq & 63, l32 = lane & 31, hi = lane >> 5;
            for (int rep_ = 0; rep_ < REP_SB; ++rep_)
            for (int uidx = bx; uidx < 4096; uidx += G) {
                const int bh = uidx & 255, qb = 15 - (uidx >> 8), b = bh >> 4, h = bh & 15;
                const bf16* base = proj + (size_t)b * SEQ * ODD_IN;
                const int q0 = qb * 256, nt = 4 * qb + 4, t = q0 + 32 * wave + l32;
                att::f32x16 o[2]; float P, dummy;
                att::attn_core<0, 64>(base + h * 64, base + 1024 + h * 64, base + 2048 + h * 64, ODD_IN, q0, nt - 1, nt, -1, lds, o, P, dummy);
                att::store_ot<64>(o, ao + ((size_t)b * SEQ + t) * DM + h * 64, hi);
            }
#endif
        }
        grid.sync();
        {
            const bf16* wt = even ? (const bf16*)(ws + WS_WOUTE) + (size_t)e * DM * DM : (const bf16*)(ws + WS_WOUTO) + (size_t)e * DM * DM;
            pg8::Gemm g{ao, wt, MTOK, DM, DM}; pg8::StaticOrder S; S.init(MTOK, DM, G, bx);
            pg8::EpiResid E{xold, a.out, xb, ssq};
            pg8::gemm_phase<pg8::EpiResid, pg8::StaticOrder, true, true>(lds, g, S, E);
        }
        grid.sync();
        const bf16* wup = (const bf16*)(ws + WS_WUP) + (size_t)layer * DUP * DM;
        const bf16* wdn = (const bf16*)(ws + WS_WDN) + (size_t)layer * DM * DFF;
        for (int half = 0; half < 2; ++half) {
            const size_t r0 = (size_t)half * HALF_ROWS;
            {
                pg8::Gemm g{xb + r0 * DM, wup, HALF_ROWS, DUP, DM}; pg8::StaticOrder S; S.init(HALF_ROWS, DUP, G, bx);
                pg8::EpiScaleBf16 E{ubuf, DUP, ssq + r0 * 16};
                for (int rep_ = 0; rep_ < REP_UP; ++rep_)
                pg8::gemm_phase<pg8::EpiScaleBf16, pg8::StaticOrder, true, true>(lds, g, S, E);
            }
            grid.sync();
#if PH_CONV
            {
                const float* cw = a.ffn_conv + (size_t)layer * 3 * DUP; const float* cb = a.ffn_conv_b + (size_t)layer * DUP;
                constexpr int NCC = 6, NRC = HALF_ROWS / 32;
                int tq = threadIdx.x; asm volatile("" : "+v"(tq)); const int lane = tq & 63;
                for (int rep_ = 0; rep_ < REP_CONV; ++rep_)
                for (int it = gw; it < NCC * NRC; it += NGW) {
                    const int cc = it % NCC, rc = it / NCC, cgp = cc * 64 + lane;
                    if (cgp < DFF / 8) {
                        const int col = cgp * 8, row0 = rc * 32;
                        float wg[3][8], wv[3][8], bg[8], bv[8];
#pragma unroll
                        for (int tp = 0; tp < 3; ++tp)
#pragma unroll
                            for (int k = 0; k < 8; k += 4) { const f32x4 t1 = *(const f32x4*)(cw + tp * DUP + col + k), t2 = *(const f32x4*)(cw + tp * DUP + DFF + col + k);
#pragma unroll
                                for (int q = 0; q < 4; ++q) { wg[tp][k + q] = t1[q]; wv[tp][k + q] = t2[q]; } }
#pragma unroll
                        for (int k = 0; k < 8; k += 4) { const f32x4 t1 = *(const f32x4*)(cb + col + k), t2 = *(const f32x4*)(cb + DFF + col + k);
#pragma unroll
                            for (int q = 0; q < 4; ++q) { bg[k + q] = t1[q]; bv[k + q] = t2[q]; } }
                        float g2[8], g1[8], v2[8], v1[8];
                        const bool head = (row0 % SEQ) == 0;
                        {
                            v4u a2 = {0, 0, 0, 0}, a1 = {0, 0, 0, 0}, c2 = {0, 0, 0, 0}, c1 = {0, 0, 0, 0};
                            if (!head) { const bf16* up = ubuf + (size_t)(row0 - 2) * DUP + col; a2 = *(const v4u*)up; c2 = *(const v4u*)(up + DFF); a1 = *(const v4u*)(up + DUP); c1 = *(const v4u*)(up + DUP + DFF); }
#pragma unroll
                            for (int k = 0; k < 8; ++k) { const int sh = (k & 1) * 16;
                                g2[k] = __uint_as_float(((a2[k >> 1] >> sh) & 0xffffu) << 16); g1[k] = __uint_as_float(((a1[k >> 1] >> sh) & 0xffffu) << 16);
                                v2[k] = __uint_as_float(((c2[k >> 1] >> sh) & 0xffffu) << 16); v1[k] = __uint_as_float(((c1[k >> 1] >> sh) & 0xffffu) << 16); }
                        }
                        for (int r = 0; r < 32; ++r) {
                            const bf16* up = ubuf + (size_t)(row0 + r) * DUP + col;
                            const v4u a0 = *(const v4u*)up, c0 = *(const v4u*)(up + DFF);
                            float res[8];
#pragma unroll
                            for (int k = 0; k < 8; ++k) { const int sh = (k & 1) * 16;
                                const float g0 = __uint_as_float(((a0[k >> 1] >> sh) & 0xffffu) << 16), v0 = __uint_as_float(((c0[k >> 1] >> sh) & 0xffffu) << 16);
                                const float gg = bg[k] + wg[0][k] * g2[k] + wg[1][k] * g1[k] + wg[2][k] * g0;
                                const float vv = bv[k] + wv[0][k] * v2[k] + wv[1][k] * v1[k] + wv[2][k] * v0;
                                const float sg = gg * __builtin_amdgcn_rcpf(1.0f + __builtin_amdgcn_exp2f(-gg * att::LOG2E));
                                res[k] = sg * vv; g2[k] = g1[k]; g1[k] = g0; v2[k] = v1[k]; v1[k] = v0; }
                            v4u w; w.x = pk2(res[0], res[1]); w.y = pk2(res[2], res[3]); w.z = pk2(res[4], res[5]); w.w = pk2(res[6], res[7]);
                            *(v4u*)(gbuf + (size_t)(row0 + r) * DFF + col) = w;
                        }
                    }
                }
            }
#endif
            grid.sync();
            {
                pg8::Gemm g{gbuf, wdn, HALF_ROWS, DM, DFF}; pg8::StaticOrder S; S.init(HALF_ROWS, DM, G, bx);
                pg8::EpiResid E{a.out + r0 * DM, a.out + r0 * DM, xb + r0 * DM, ssq + r0 * 16};
                pg8::gemm_phase<pg8::EpiResid, pg8::StaticOrder, true, true>(lds, g, S, E);
            }
            if (half == 1) grid.sync();
        }
    }
    { int tq = threadIdx.x; asm volatile("" : "+v"(tq)); const int lane = tq & 63;
    for (int m = gw; m < MTOK; m += NGW) {
        f32x4* xr = (f32x4*)(a.out + (size_t)m * DM) + lane; f32x4 v[4]; float s = 0.f;
#pragma unroll
        for (int j = 0; j < 4; ++j) { v[j] = xr[64 * j]; s += (v[j][0] * v[j][0] + v[j][1] * v[j][1]) + (v[j][2] * v[j][2] + v[j][3] * v[j][3]); }
        s = wave_sum(s);
        const float rs = __builtin_amdgcn_rsqf(s * (1.0f / DM) + 1e-6f);
#pragma unroll
        for (int j = 0; j < 4; ++j) { const f32x4 gv = *((const f32x4*)a.norm_final + lane + 64 * j); xr[64 * j] = v[j] * rs * gv; }
    } }
}

extern "C" void kernel_launch(void* const* d_in, const int* in_sizes, int n_in, void* d_out, int out_size, void* d_ws, size_t ws_size, hipStream_t stream) {
    static int grid = 0;
    if (grid == 0) {
        int dev = 0, cus = 0, per_cu = 0;
        (void)hipGetDevice(&dev);
        (void)hipDeviceGetAttribute(&cus, hipDeviceAttributeMultiprocessorCount, dev);
        (void)hipFuncSetAttribute((const void*)mega_fwd, hipFuncAttributeMaxDynamicSharedMemorySize, LDS_BYTES);
        (void)hipOccupancyMaxActiveBlocksPerMultiprocessor(&per_cu, (const void*)mega_fwd, NWAVES * 64, LDS_BYTES);
        if (per_cu < 1) per_cu = 1;
        grid = cus * per_cu;
        if (n_in != 19 || ws_size < 1024 * MiB) fprintf(stderr, "kernel_launch: unexpected n_in %d / ws %zu\n", n_in, ws_size);
    }
    Args a{};
    a.x = (const float*)d_in[0]; a.rel_bias = (const float*)d_in[1]; a.norm_mix = (const float*)d_in[2]; a.norm_ffn = (const float*)d_in[3]; a.norm_final = (const float*)d_in[4];
    a.w_in_even = (const float*)d_in[5]; a.w_out_even = (const float*)d_in[6]; a.sinks = (const float*)d_in[7]; a.lam_q1 = (const float*)d_in[8]; a.lam_k1 = (const float*)d_in[9];
    a.lam_q2 = (const float*)d_in[10]; a.lam_k2 = (const float*)d_in[11]; a.diff_norm = (const float*)d_in[12]; a.w_in_odd = (const float*)d_in[13]; a.w_out_odd = (const float*)d_in[14];
    a.ffn_up = (const float*)d_in[15]; a.ffn_conv = (const float*)d_in[16]; a.ffn_conv_b = (const float*)d_in[17]; a.ffn_down = (const float*)d_in[18];
    a.out = (float*)d_out; a.ws = (unsigned char*)d_ws;
    void* args[] = {&a};
    hipError_t err = hipLaunchCooperativeKernel((const void*)mega_fwd, dim3(grid), dim3(NWAVES * 64), args, LDS_BYTES, stream);
    if (err != hipSuccess) fprintf(stderr, "kernel_launch: cooperative launch failed: %s (grid %d)\n", hipGetErrorString(err), grid);
}
```

```cpp
#include <hip/hip_runtime.h>
#include <hip/hip_cooperative_groups.h>
#include <cstdio>
#include <cstdint>
namespace cg = cooperative_groups;
namespace pg8 {
#define PG8_LAS __attribute__((address_space(3)))
typedef unsigned short bf16_t;
typedef short bf16x8 __attribute__((ext_vector_type(8)));
typedef float f32x4 __attribute__((ext_vector_type(4)));
typedef unsigned u32x4 __attribute__((ext_vector_type(4)));
constexpr int BM = 256, BK = 64, HALF = 128, HTB = HALF * BK * 2  , STAGE_BYTES = 8 * HTB, NXCD = 8, WGM = 8;

__host__ __device__ __forceinline__ int lds_byte(int r, int c) { const int st = (r >> 4) * 2 + (c >> 5), rr = r & 15, cc = c & 31, ob = rr * 64 + cc * 2; return st * 1024 + (ob ^ (((ob >> 9) & 1) << 5)); }
__host__ __device__ __forceinline__ void stage_rc(int b, int& R, int& C) { const int st = b / 1024, sb = b % 1024, swz = sb ^ (((sb >> 9) & 1) << 5); R = (st >> 1) * 16 + swz / 64; C = (st & 1) * 32 + (swz % 64) / 2; }
__host__ __device__ __forceinline__ int perm32(int rho) { const int n = rho >> 4, i = rho & 15; return 8 * (i >> 2) + 4 * n + (i & 3); }

struct Unit { int pm, pn; };
struct Gemm { const bf16_t* A; const bf16_t* Bt; int M, N, K; };

struct StaticOrder {
    int nM, nN, nwg, G, c;
    __host__ __device__ void init(int M, int N, int G_, int c_) { nM = M / BM; nN = N / BM; nwg = nM * nN; G = G_; c = c_; }
    __host__ __device__ bool next(int i, Unit& u) const {
        const long L = (long)i * G + c; if (L >= nwg) return false;
        int wgid = (int)L; { const int q = nwg / NXCD, r = nwg % NXCD, xcd = wgid % NXCD, off = wgid / NXCD; wgid = (xcd < r ? xcd * (q + 1) : r * (q + 1) + (xcd - r) * q) + off; }
        const int nig = WGM * nN, gid = wgid / nig, fm = gid * WGM, gsz = (nM - fm) < WGM ? (nM - fm) : WGM;
        u.pm = fm + ((wgid % nig) % gsz); u.pn = (wgid % nig) / gsz; return true;
    }
    __device__ __forceinline__ void a_ready(const Unit&) const {}
    __device__ __forceinline__ void done(const Unit&) const {}
};

__device__ __forceinline__ unsigned cvt_pk_bf16(float lo, float hi) { unsigned r; asm volatile("v_cvt_pk_bf16_f32 %0, %1, %2" : "=v"(r) : "v"(lo), "v"(hi)); return r; }
typedef float f32x2 __attribute__((ext_vector_type(2)));
typedef unsigned u32x2 __attribute__((ext_vector_type(2)));
constexpr float RMS_EPS = 1e-6f;
__device__ __forceinline__ float row_rstd(const float* ssq, int row) {
    const f32x4* s = (const f32x4*)(ssq + (size_t)row * 16);
    const f32x4 a = s[0], b = s[1], c = s[2], d = s[3];
    const float t = ((a[0] + a[1]) + (a[2] + a[3])) + ((b[0] + b[1]) + (b[2] + b[3])) + ((c[0] + c[1]) + (c[2] + c[3])) + ((d[0] + d[1]) + (d[2] + d[3]));
    return __builtin_amdgcn_rsqf(t * (1.0f / 1024.0f) + RMS_EPS);
}
struct EpiScaleBf16 {
    static constexpr bool PERM = true, AFTER_DRAIN = false;
    bf16_t* O; int ldc; const float* ssq;
    __device__ __forceinline__ void operator()(const f32x4 (&acc)[2][2][4][2], const Unit& u, int wr, int wc, int fr, int fq) const {
        const int row0 = u.pm * BM + wr * 64 + fr, col0 = u.pn * BM + wc * 32 + 8 * fq;
#pragma unroll
        for (int ai = 0; ai < 2; ++ai)
#pragma unroll
            for (int m = 0; m < 4; ++m) { const int row = row0 + ai * HALF + m * 16; const float rs = row_rstd(ssq, row); bf16_t* rowp = O + (size_t)row * ldc + col0;
#pragma unroll
                for (int bj = 0; bj < 2; ++bj) { const f32x4 v0 = acc[ai][bj][m][0] * rs, v1 = acc[ai][bj][m][1] * rs;
                    u32x4 w; w.x = cvt_pk_bf16(v0[0], v0[1]); w.y = cvt_pk_bf16(v0[2], v0[3]); w.z = cvt_pk_bf16(v1[0], v1[1]); w.w = cvt_pk_bf16(v1[2], v1[3]);
                    *(u32x4*)(rowp + bj * HALF) = w; }
                asm volatile("" ::: "memory"); }
    }
};
struct EpiResid {
    static constexpr bool PERM = false, AFTER_DRAIN = false;
    const float* base; float* out; bf16_t* xb; float* ssq;
    __device__ __forceinline__ void operator()(const f32x4 (&acc)[2][2][4][2], const Unit& u, int wr, int wc, int fr, int fq) const {
        const int col0 = u.pn * BM + wc * 32 + 4 * fq;
#pragma unroll
        for (int ai = 0; ai < 2; ++ai)
#pragma unroll
            for (int m = 0; m < 4; ++m) { const int row = u.pm * BM + ai * HALF + wr * 64 + m * 16 + fr; const size_t off = (size_t)row * 1024 + col0; float q = 0.f;
#pragma unroll
                for (int bj = 0; bj < 2; ++bj)
#pragma unroll
                    for (int n = 0; n < 2; ++n) { const f32x4 bs = *(const f32x4*)(base + off + bj * HALF + n * 16); const f32x4 o = bs + acc[ai][bj][m][n];
                        *(f32x4*)(out + off + bj * HALF + n * 16) = o; q += (o[0] * o[0] + o[1] * o[1]) + (o[2] * o[2] + o[3] * o[3]);
                        u32x2 w; w.x = cvt_pk_bf16(o[0], o[1]); w.y = cvt_pk_bf16(o[2], o[3]); *(u32x2*)(xb + off + bj * HALF + n * 16) = w; }
                q += __shfl_xor(q, 16); q += __shfl_xor(q, 32);
                if (fq == 0) ssq[(size_t)row * 16 + u.pn * 4 + wc] = q;
                asm volatile("" ::: "memory"); }
    }
};
template <class Epi, class Sched, bool ALIGN_EPI = false, bool SP2 = false>
__device__ __forceinline__ void gemm_phase(PG8_LAS unsigned char* lds, const Gemm g, const Sched& S, const Epi& E) {
    int tid_ = threadIdx.x; asm volatile("" : "+v"(tid_));
    const int tid = tid_, wid = __builtin_amdgcn_readfirstlane(tid >> 6), lane = tid & 63, wr = wid >> 2, wc = wid & 3, fr = lane & 15, fq = lane >> 4;
    const int K = g.K, nt = K / BK;
    unsigned voffA[2], voffB[2];
#pragma unroll
    for (int i = 0; i < 2; ++i) { int R, C; stage_rc(tid * 16 + i * 8192, R, C); const int Rb = Epi::PERM ? ((R & ~31) + perm32(R & 31)) : R;
        voffA[i] = (unsigned)(R * K + C) * 2u; voffB[i] = (unsigned)(Rb * K + C) * 2u; }
    const size_t kstep = (size_t)(BK * 2);
    const size_t hstep = (size_t)HALF * K * 2;
    const size_t tstep = 2 * hstep;
    const unsigned ldsw = (unsigned)wid * 1024u;
    const int aoff = lds_byte(wr * 64 + fr, fq * 8), boff = lds_byte(wc * 32 + fr, fq * 8);
#define PG8_SA(b, h) (((b) * 2 + (h)) * HTB)
#define PG8_SB(b, h) ((4 + (b) * 2 + (h)) * HTB)
#define PG8_STAGE(bufoff, gbase, voff) do { _Pragma("unroll") for (int _i = 0; _i < 2; ++_i) \
        __builtin_amdgcn_global_load_lds((const unsigned*)((const char*)(gbase) + (voff)[_i]), (PG8_LAS unsigned*)(lds + (bufoff) + ldsw + _i * 8192), 16, 0, 0); } while (0)
#define PG8_LDA(dst, b, h) do { _Pragma("unroll") for (int m = 0; m < 4; ++m) _Pragma("unroll") for (int k = 0; k < 2; ++k) dst[m][k] = *(const PG8_LAS bf16x8*)(lds + PG8_SA(b, h) + aoff + m * 2048 + k * 1024); } while (0)
#define PG8_LDB(dst, b, h) do { _Pragma("unroll") for (int n = 0; n < 2; ++n) _Pragma("unroll") for (int k = 0; k < 2; ++k) dst[n][k] = *(const PG8_LAS bf16x8*)(lds + PG8_SB(b, h) + boff + n * 2048 + k * 1024); } while (0)
#define PG8_MMA(ai, bj, At, Bt) do { __builtin_amdgcn_s_setprio(1); _Pragma("unroll") for (int m = 0; m < 4; ++m) _Pragma("unroll") for (int n = 0; n < 2; ++n) _Pragma("unroll") for (int k = 0; k < 2; ++k) \
        acc[ai][bj][m][n] = __builtin_amdgcn_mfma_f32_16x16x32_bf16(Bt[n][k], At[m][k], acc[ai][bj][m][n], 0, 0, 0); __builtin_amdgcn_s_setprio(0); } while (0)
#define PG8_WAIT_V(n) asm volatile("s_waitcnt vmcnt(" #n ")" ::: "memory")
#define PG8_WAIT_L(n) asm volatile("s_waitcnt lgkmcnt(" #n ")" ::: "memory")
#define PG8_BAR __builtin_amdgcn_s_barrier()
#define PG8_SCHED __builtin_amdgcn_sched_barrier(0)
    Unit cur, nxt; int ui = 0;
    if (!S.next(0, cur)) return;
    f32x4 acc[2][2][4][2];
#pragma unroll
    for (int a = 0; a < 2; ++a)
#pragma unroll
        for (int b = 0; b < 2; ++b)
#pragma unroll
            for (int m = 0; m < 4; ++m)
#pragma unroll
                for (int n = 0; n < 2; ++n) acc[a][b][m][n] = (f32x4){0.f, 0.f, 0.f, 0.f};
    bf16x8 At[4][2], B0[2][2], B1[2][2];
    const char* cA = (const char*)g.A + (size_t)cur.pm * tstep; const char* cB = (const char*)g.Bt + (size_t)cur.pn * tstep;
    S.a_ready(cur);
    if constexpr (SP2) {
        PG8_STAGE(PG8_SB(0, 0), cB, voffB); PG8_STAGE(PG8_SB(0, 1), cB + hstep, voffB); PG8_STAGE(PG8_SA(0, 0), cA, voffA); PG8_STAGE(PG8_SA(0, 1), cA + hstep, voffA);
        if (wr == 1) PG8_BAR;
        PG8_WAIT_V(2); PG8_BAR;
        PG8_STAGE(PG8_SB(1, 0), cB + kstep, voffB); PG8_STAGE(PG8_SA(1, 0), cA + kstep, voffA); PG8_STAGE(PG8_SB(1, 1), cB + hstep + kstep, voffB);
        PG8_WAIT_V(6); PG8_BAR;
    } else {
        PG8_STAGE(PG8_SB(0, 0), cB, voffB); PG8_STAGE(PG8_SA(0, 0), cA, voffA); PG8_STAGE(PG8_SB(0, 1), cB + hstep, voffB); PG8_STAGE(PG8_SA(0, 1), cA + hstep, voffA);
        if (wr == 1) PG8_BAR;
        PG8_WAIT_V(4); PG8_BAR;
        PG8_STAGE(PG8_SB(1, 0), cB + kstep, voffB); PG8_STAGE(PG8_SA(1, 0), cA + kstep, voffA); PG8_STAGE(PG8_SB(1, 1), cB + hstep + kstep, voffB);
        PG8_WAIT_V(6); PG8_BAR;
    }
    for (;;) {
        const bool has_next = S.next(ui + 1, nxt);
        const char* nA = has_next ? (const char*)g.A + (size_t)nxt.pm * tstep : cA; const char* nB = has_next ? (const char*)g.Bt + (size_t)nxt.pn * tstep : cB;
        for (int t = 0; t < nt; t += 2) {
            const bool last = (t == nt - 2);
            const char* a1 = cA + (size_t)(t + 1) * kstep;
            const char* a2 = last ? nA : cA + (size_t)(t + 2) * kstep; const char* b2 = last ? nB : cB + (size_t)(t + 2) * kstep;
            const char* a3 = a2 + kstep; const char* b3 = b2 + kstep;
            if (last && has_next) S.a_ready(nxt);
            if constexpr (SP2) {
            PG8_LDB(B0, 0, 0); PG8_LDB(B1, 0, 1); PG8_SCHED; PG8_LDA(At, 0, 0); PG8_STAGE(PG8_SA(1, 1), a1 + hstep, voffA);
            PG8_WAIT_V(8); PG8_WAIT_L(0); PG8_BAR; PG8_MMA(0, 0, At, B0); PG8_MMA(0, 1, At, B1); PG8_BAR; PG8_SCHED;
            PG8_LDA(At, 0, 1); PG8_STAGE(PG8_SB(0, 0), b2, voffB); PG8_STAGE(PG8_SB(0, 1), b2 + hstep, voffB); PG8_STAGE(PG8_SA(0, 0), a2, voffA);
            PG8_WAIT_V(8); PG8_WAIT_L(0); PG8_BAR; PG8_MMA(1, 0, At, B0); PG8_MMA(1, 1, At, B1); PG8_BAR; PG8_SCHED;
            PG8_LDB(B0, 1, 0); PG8_LDB(B1, 1, 1); PG8_SCHED; PG8_LDA(At, 1, 0); PG8_STAGE(PG8_SA(0, 1), a2 + hstep, voffA);
            PG8_WAIT_V(8); PG8_WAIT_L(0); PG8_BAR; PG8_MMA(0, 0, At, B0); PG8_MMA(0, 1, At, B1); PG8_BAR; PG8_SCHED;
            PG8_LDA(At, 1, 1); PG8_STAGE(PG8_SB(1, 0), b3, voffB); PG8_STAGE(PG8_SB(1, 1), b3 + hstep, voffB); PG8_STAGE(PG8_SA(1, 0), a3, voffA);
            PG8_WAIT_V(8); PG8_WAIT_L(0); PG8_BAR; PG8_MMA(1, 0, At, B0); PG8_MMA(1, 1, At, B1); PG8_BAR; PG8_SCHED;
            } else {
            PG8_LDB(B0, 0, 0); PG8_SCHED; PG8_LDA(At, 0, 0); PG8_STAGE(PG8_SA(1, 1), a1 + hstep, voffA);
            PG8_WAIT_L(8); PG8_BAR; PG8_WAIT_L(0); PG8_MMA(0, 0, At, B0); PG8_BAR; PG8_SCHED;
            PG8_LDB(B1, 0, 1); PG8_STAGE(PG8_SB(0, 0), b2, voffB);
            PG8_BAR; PG8_WAIT_L(0); PG8_MMA(0, 1, At, B1); PG8_BAR;
            PG8_LDA(At, 0, 1); PG8_STAGE(PG8_SA(0, 0), a2, voffA);
            PG8_BAR; PG8_WAIT_L(0); PG8_MMA(1, 0, At, B0); PG8_BAR; PG8_SCHED;
            PG8_STAGE(PG8_SB(0, 1), b2 + hstep, voffB);
            PG8_WAIT_V(6); PG8_BAR; PG8_MMA(1, 1, At, B1); PG8_BAR;
            PG8_LDB(B0, 1, 0); PG8_SCHED; PG8_LDA(At, 1, 0); PG8_STAGE(PG8_SA(0, 1), a2 + hstep, voffA);
            PG8_WAIT_L(8); PG8_BAR; PG8_WAIT_L(0); PG8_MMA(0, 0, At, B0); PG8_BAR; PG8_SCHED;
            PG8_LDB(B1, 1, 1); PG8_STAGE(PG8_SB(1, 0), b3, voffB);
            PG8_BAR; PG8_WAIT_L(0); PG8_MMA(0, 1, At, B1); PG8_BAR;
            PG8_LDA(At, 1, 1); PG8_STAGE(PG8_SA(1, 0), a3, voffA);
            PG8_BAR; PG8_WAIT_L(0); PG8_MMA(1, 0, At, B0); PG8_BAR; PG8_SCHED;
            PG8_STAGE(PG8_SB(1, 1), b3 + hstep, voffB);
            PG8_WAIT_V(6); PG8_BAR; PG8_MMA(1, 1, At, B1); PG8_BAR;
            }
        }
        if constexpr (ALIGN_EPI) { if (wr == 0) PG8_BAR; }
        if constexpr (!Epi::AFTER_DRAIN) { E(acc, cur, wr, wc, fr, fq); S.done(cur); }
        if (!has_next) break;
#pragma unroll
        for (int a = 0; a < 2; ++a)
#pragma unroll
            for (int b = 0; b < 2; ++b)
#pragma unroll
                for (int m = 0; m < 4; ++m)
#pragma unroll
                    for (int n = 0; n < 2; ++n) acc[a][b][m][n] = (f32x4){0.f, 0.f, 0.f, 0.f};
        cur = nxt; cA = nA; cB = nB; ++ui;
        if constexpr (ALIGN_EPI) { if (wr == 1) PG8_BAR; }
    }
    PG8_WAIT_V(0);
    if constexpr (!ALIGN_EPI) { if (wr == 0) PG8_BAR; }
    PG8_BAR;
    if constexpr (Epi::AFTER_DRAIN) { E.fused(acc, cur, wr, wc, fr, fq, lds, wid, lane); S.done(cur); }
#undef PG8_SA
#undef PG8_SB
#undef PG8_STAGE
#undef PG8_LDA
#undef PG8_LDB
#undef PG8_MMA
#undef PG8_WAIT_V
#undef PG8_WAIT_L
#undef PG8_BAR
#undef PG8_SCHED
}
}
namespace att {
#define ALAS __attribute__((address_space(3)))
typedef unsigned short bf16_t;
typedef short bf16x8 __attribute__((ext_vector_type(8)));
typedef float f32x16 __attribute__((ext_vector_type(16)));
typedef float f32x4 __attribute__((ext_vector_type(4)));
typedef unsigned u32x4 __attribute__((ext_vector_type(4)));
typedef unsigned u32x2 __attribute__((ext_vector_type(2)));
constexpr int KROW = 144;
constexpr int KBUF = 64 * KROW;
constexpr int VBUF = 128 * KROW;
constexpr int L_K = 0, L_V = 2 * KBUF, L_BT = L_V + 2 * VBUF, L_END = L_BT + 512;
constexpr float LOG2E = 1.4426950408889634f;
constexpr float QSCALE = 0.125f * 1.4426950408889634f;
#define CR(r) (((r) & 3) + 8 * ((r) >> 2))
__device__ __forceinline__ unsigned cvtpk(float lo, float hi) { unsigned r; asm volatile("v_cvt_pk_bf16_f32 %0, %1, %2" : "=v"(r) : "v"(lo), "v"(hi)); return r; }
__device__ __forceinline__ float ex2(float x) { return __builtin_amdgcn_exp2f(x); }
__device__ __forceinline__ float rcpf_(float x) { return __builtin_amdgcn_rcpf(x); }

template <int DV> struct Pref { u32x4 k; u32x4 v[DV / 64]; };

template <int DV> __device__ __forceinline__ void tile_load(Pref<DV>& pf, const bf16_t* Kp, const bf16_t* Vp, int pitch, int kt, int tid) {
    const int krow = tid >> 3, kc = (tid & 7) * 8;
    pf.k = *(const u32x4*)(Kp + (size_t)(kt * 64 + krow) * pitch + kc);
#pragma unroll
    for (int i = 0; i < DV / 64; ++i) { const int vrow = tid & 63, vc = ((tid >> 6) + 8 * i) * 8;
        pf.v[i] = *(const u32x4*)(Vp + (size_t)(kt * 64 + vrow) * pitch + vc); }
}
template <int DV> __device__ __forceinline__ void tile_store(const Pref<DV>& pf, ALAS unsigned char* kbuf, ALAS unsigned char* vbuf, int tid) {
    const int krow = tid >> 3, kc = (tid & 7) * 8;
    *(ALAS u32x4*)(kbuf + krow * KROW + kc * 2) = pf.k;
#pragma unroll
    for (int i = 0; i < DV / 64; ++i) { const int vrow = tid & 63, vc = ((tid >> 6) + 8 * i) * 8;
        const int kk = vrow & 15, pos = (vrow & ~15) + 8 * ((kk >> 2) & 1) + (kk & 3) + 4 * (kk >> 3);
        ALAS unsigned char* d = vbuf + vc * KROW + pos * 2;
#pragma unroll
        for (int j = 0; j < 8; ++j) { const unsigned w = pf.v[i][j >> 1]; *(ALAS unsigned short*)(d + j * KROW) = (unsigned short)((j & 1) ? (w >> 16) : (w & 0xffffu)); } }
}

template <int DV> __device__ __forceinline__ void pv_slab(const ALAS unsigned char* vbuf, int s, u32x4 w, f32x16 (&o)[DV / 32], int l32, int hi) {
    const bf16x8 pfr = __builtin_bit_cast(bf16x8, w);
#pragma unroll
    for (int db = 0; db < DV / 32; ++db) {
        const bf16x8 vf = *(const ALAS bf16x8*)(vbuf + (db * 32 + l32) * KROW + s * 32 + hi * 16);
        o[db] = __builtin_amdgcn_mfma_f32_32x32x16_bf16(vf, pfr, o[db], 0, 0, 0); }
    if (DV > 64) __builtin_amdgcn_sched_barrier(0);
}

template <int MODE, int DV, bool MASKED>
__device__ __forceinline__ void tile_compute(const ALAS unsigned char* kbuf, const ALAS unsigned char* vbuf, const bf16x8 (&qf)[4], f32x16 (&o)[DV / 32],
                                             float& st_m, float& st_l, int lim, const ALAS float* btab, float cbias, int lane) {
    const int l32 = lane & 31, hi = lane >> 5;
    if constexpr (MODE == 0) {
        f32x16 p0, p1;
#pragma unroll
        for (int r = 0; r < 16; ++r) { p0[r] = 0.f; p1[r] = 0.f; }
        { const ALAS unsigned char* kb = kbuf + l32 * KROW + hi * 16;
#pragma unroll
          for (int d0 = 0; d0 < 4; ++d0) {
              const bf16x8 k0 = *(const ALAS bf16x8*)(kb + d0 * 32);
              const bf16x8 k1 = *(const ALAS bf16x8*)(kb + 32 * KROW + d0 * 32);
              p0 = __builtin_amdgcn_mfma_f32_32x32x16_bf16(k0, qf[d0], p0, 0, 0, 0);
              p1 = __builtin_amdgcn_mfma_f32_32x32x16_bf16(k1, qf[d0], p1, 0, 0, 0); } }
        __builtin_amdgcn_sched_barrier(0);
#pragma unroll
        for (int r = 0; r < 16; ++r) {
            float a = rcpf_(1.0f + ex2(p0[r])), b = rcpf_(1.0f + ex2(p1[r]));
            if (MASKED) { a = (CR(r) < lim) ? a : 1.0f; b = (CR(r) + 32 < lim) ? b : 1.0f; }
            p0[r] = a; p1[r] = b; }
        float g[8], hs[8], pr[8];
#pragma unroll
        for (int i = 0; i < 4; ++i) { g[i] = (p0[4 * i] * p0[4 * i + 1]) * (p0[4 * i + 2] * p0[4 * i + 3]); g[4 + i] = (p1[4 * i] * p1[4 * i + 1]) * (p1[4 * i + 2] * p1[4 * i + 3]); }
#pragma unroll
        for (int i = 0; i < 8; ++i) { const float h = __shfl_xor(g[i], 32); pr[i] = g[i] * h; hs[i] = hi ? 1.0f : h; }
        float T = st_m;
#pragma unroll
        for (int i = 7; i >= 0; --i) {
            float R = hs[i] * T; T = T * pr[i];
            if (i >= 4) { const int b = 4 * (i - 4);
                float R2 = R * p1[b + 3]; p1[b + 3] = R - R2; float R1 = R2 * p1[b + 2]; p1[b + 2] = R2 - R1; float R0 = R1 * p1[b + 1]; p1[b + 1] = R1 - R0; p1[b] = R0 - R0 * p1[b]; }
            else { const int b = 4 * i;
                float R2 = R * p0[b + 3]; p0[b + 3] = R - R2; float R1 = R2 * p0[b + 2]; p0[b + 2] = R2 - R1; float R0 = R1 * p0[b + 1]; p0[b + 1] = R1 - R0; p0[b] = R0 - R0 * p0[b]; }
        }
        st_m = T;
        __builtin_amdgcn_sched_barrier(0);
#pragma unroll
        for (int s = 0; s < 4; ++s) {
            u32x4 w;
            if (s == 0) { w.x = cvtpk(p0[0], p0[1]); w.y = cvtpk(p0[2], p0[3]); w.z = cvtpk(p0[4], p0[5]); w.w = cvtpk(p0[6], p0[7]); }
            else if (s == 1) { w.x = cvtpk(p0[8], p0[9]); w.y = cvtpk(p0[10], p0[11]); w.z = cvtpk(p0[12], p0[13]); w.w = cvtpk(p0[14], p0[15]); }
            else if (s == 2) { w.x = cvtpk(p1[0], p1[1]); w.y = cvtpk(p1[2], p1[3]); w.z = cvtpk(p1[4], p1[5]); w.w = cvtpk(p1[6], p1[7]); }
            else { w.x = cvtpk(p1[8], p1[9]); w.y = cvtpk(p1[10], p1[11]); w.z = cvtpk(p1[12], p1[13]); w.w = cvtpk(p1[14], p1[15]); }
            pv_slab<DV>(vbuf, s, w, o, l32, hi);
        }
    } else {
        const float NEG = -__builtin_inff();
#pragma unroll
        for (int hk = 0; hk < 2; ++hk) {
            f32x16 p;
#pragma unroll
            for (int r = 0; r < 16; ++r) p[r] = 0.f;
            { const ALAS unsigned char* kb = kbuf + (32 * hk + l32) * KROW + hi * 16;
#pragma unroll
              for (int d0 = 0; d0 < 4; ++d0) { const bf16x8 k0 = *(const ALAS bf16x8*)(kb + d0 * 32); p = __builtin_amdgcn_mfma_f32_32x32x16_bf16(k0, qf[d0], p, 0, 0, 0); } }
            __builtin_amdgcn_sched_barrier(0);
            if (MASKED) {
#pragma unroll
                for (int r = 0; r < 16; ++r) {
                    const int d0 = lim - 32 * hk - CR(r);
                    const float b0 = btab[min(max(d0, 0), 127)];
                    const bool v0 = (MODE == 2) ? ((unsigned)d0 < 128u) : (d0 >= 0);
                    p[r] = v0 ? p[r] + b0 : NEG; }
            } else {
#pragma unroll
                for (int r = 0; r < 16; ++r) p[r] += cbias;
            }
            float mt = fmaxf(p[0], p[1]);
#pragma unroll
            for (int r = 2; r < 16; ++r) mt = fmaxf(mt, p[r]);
            mt = fmaxf(mt, __shfl_xor(mt, 32));
            if (__any(mt > st_m)) {
                const float mn = fmaxf(st_m, mt), f = ex2(st_m - mn);
                st_l *= f; st_m = mn;
#pragma unroll
                for (int db = 0; db < DV / 32; ++db)
#pragma unroll
                    for (int r = 0; r < 16; ++r) o[db][r] *= f;
            }
            float s = 0.f;
#pragma unroll
            for (int r = 0; r < 16; ++r) { p[r] = ex2(p[r] - st_m); s += p[r]; }
            st_l += s;
            __builtin_amdgcn_sched_barrier(0);
#pragma unroll
            for (int s2 = 0; s2 < 2; ++s2) {
                u32x4 w; w.x = cvtpk(p[8 * s2], p[8 * s2 + 1]); w.y = cvtpk(p[8 * s2 + 2], p[8 * s2 + 3]); w.z = cvtpk(p[8 * s2 + 4], p[8 * s2 + 5]); w.w = cvtpk(p[8 * s2 + 6], p[8 * s2 + 7]);
                pv_slab<DV>(vbuf, 2 * hk + s2, w, o, l32, hi);
            }
        }
    }
}

template <int MODE, int DV>
__device__ __forceinline__ void attn_core(const bf16_t* Qp, const bf16_t* Kp, const bf16_t* Vp, int pitch, int q0, int kt0, int nt, int dir,
                                          ALAS unsigned char* lds, f32x16 (&o)[DV / 32], float& st_m, float& st_l) {
    int tid_ = threadIdx.x; asm volatile("" : "+v"(tid_));
    const int tid = tid_, lane = tid & 63, l32 = lane & 31, hi = lane >> 5, wid = __builtin_amdgcn_readfirstlane(tid >> 6);
    const int qw = q0 + 32 * wid, t = qw + l32;
    const ALAS float* btab = (const ALAS float*)(lds + L_BT);
    bf16x8 qf[4];
#pragma unroll
    for (int d0 = 0; d0 < 4; ++d0) qf[d0] = *(const bf16x8*)(Qp + (size_t)t * pitch + d0 * 16 + hi * 8);
#pragma unroll
    for (int db = 0; db < DV / 32; ++db)
#pragma unroll
        for (int r = 0; r < 16; ++r) o[db][r] = 0.f;
    st_m = (MODE == 0) ? 1.0f : -1e30f; st_l = 0.f;
    Pref<DV> pf;
    tile_load<DV>(pf, Kp, Vp, pitch, kt0, tid);
    tile_store<DV>(pf, lds + L_K, lds + L_V, tid);
    __syncthreads();
    const float cbias = (MODE == 1) ? btab[127] : 0.f;
    for (int it = 0; it < nt; ++it) {
        const int kt = kt0 + dir * it, cur = it & 1, kbase = kt * 64;
        if (it + 1 < nt) tile_load<DV>(pf, Kp, Vp, pitch, kt + dir, tid);
        const ALAS unsigned char* kb = lds + L_K + cur * KBUF; const ALAS unsigned char* vb = lds + L_V + cur * VBUF;
        const int lim = t - kbase - 4 * hi;
        if (MODE == 0) {
            if (kbase <= qw + 31) { if (kbase + 63 >= qw) tile_compute<0, DV, true>(kb, vb, qf, o, st_m, st_l, lim, btab, cbias, lane); else tile_compute<0, DV, false>(kb, vb, qf, o, st_m, st_l, lim, btab, cbias, lane); }
        } else if (MODE == 1) {
            if (kbase <= qw + 31) { if (qw - (kbase + 63) < 113) tile_compute<1, DV, true>(kb, vb, qf, o, st_m, st_l, lim, btab, cbias, lane); else tile_compute<1, DV, false>(kb, vb, qf, o, st_m, st_l, lim, btab, cbias, lane); }
        } else {
            if (kbase <= qw + 31 && kbase + 63 >= qw - 127) tile_compute<2, DV, true>(kb, vb, qf, o, st_m, st_l, lim, btab, cbias, lane);
        }
        if (it + 1 < nt) tile_store<DV>(pf, lds + L_K + (cur ^ 1) * KBUF, lds + L_V + (cur ^ 1) * VBUF, tid);
        if (MODE == 0) {
            if (!__syncthreads_or(st_m != 0.0f)) break;
        } else __syncthreads();
    }
}
template <int DV> __device__ __forceinline__ void store_ot(const f32x16 (&o)[DV / 32], bf16_t* orow, int hi) {
#pragma unroll
    for (int db = 0; db < DV / 32; ++db)
#pragma unroll
        for (int rg = 0; rg < 4; ++rg) { u32x2 w; w.x = cvtpk(o[db][4 * rg], o[db][4 * rg + 1]); w.y = cvtpk(o[db][4 * rg + 2], o[db][4 * rg + 3]);
            *(u32x2*)(orow + 32 * db + 8 * rg + 4 * hi) = w; }
}
}
#ifndef REP_INPROJ
#define REP_INPROJ 1
#endif
#ifndef REP_DIFF
#define REP_DIFF 1
#endif
#ifndef REP_SWA
#define REP_SWA 1
#endif
#ifndef REP_SB
#define REP_SB 1
#endif
#ifndef REP_UP
#define REP_UP 1
#endif
#ifndef REP_CONV
#define REP_CONV 1
#endif
#ifndef PH_DIFF
#define PH_DIFF 1
#endif
#ifndef PH_SWA
#define PH_SWA 1
#endif
#ifndef PH_SB
#define PH_SB 1
#endif
#ifndef PH_CONV
#define PH_CONV 1
#endif
#define LAS __attribute__((address_space(3)))
typedef unsigned short bf16;
typedef float f32x4 __attribute__((ext_vector_type(4)));
typedef unsigned v4u __attribute__((ext_vector_type(4)));
typedef unsigned v2u __attribute__((ext_vector_type(2)));
constexpr int NWAVES = 8;
constexpr int SEQ = 4096, NB = 16, MTOK = NB * SEQ, DM = 1024, DFF = 2816, DUP = 2 * DFF;
constexpr int EVEN_IN = 2304, ODD_IN = 3072;
constexpr size_t MiB = 1u << 20;
constexpr size_t WS_SSQ = 1 * MiB;
constexpr size_t WS_WINE = 8 * MiB, WS_WOUTE = 17 * MiB, WS_WINO = 21 * MiB, WS_WOUTO = 33 * MiB, WS_WUP = 37 * MiB, WS_WDN = 81 * MiB;
constexpr size_t WS_XB = 104 * MiB, WS_R = 232 * MiB;
constexpr size_t WS_PROJ = WS_R, WS_AO = WS_R + 384 * MiB, WS_U = WS_R, WS_G = WS_R + 352 * MiB;
constexpr int LDS_BYTES = 147456;
constexpr int HALF_ROWS = MTOK / 2;

struct Args {
    const float* x; const float* rel_bias; const float* norm_mix; const float* norm_ffn; const float* norm_final;
    const float* w_in_even; const float* w_out_even; const float* sinks; const float* lam_q1; const float* lam_k1; const float* lam_q2; const float* lam_k2;
    const float* diff_norm; const float* w_in_odd; const float* w_out_odd; const float* ffn_up; const float* ffn_conv; const float* ffn_conv_b; const float* ffn_down;
    float* out; unsigned char* ws;
};

__device__ const unsigned char T5B[128] = {0, 1, 2, 3, 4, 5, 6, 7, 8, 9, 10, 11, 12, 13, 14, 15, 16, 16, 16, 17, 17, 18, 18, 18, 19, 19, 19, 20, 20, 20, 20, 21, 21, 21, 21, 22, 22, 22, 22, 22, 23, 23, 23, 23, 23, 23, 24, 24, 24, 24, 24, 24, 25, 25, 25, 25, 25, 25, 25, 26, 26, 26, 26, 26, 26, 26, 26, 27, 27, 27, 27, 27, 27, 27, 27, 27, 27, 28, 28, 28, 28, 28, 28, 28, 28, 28, 28, 29, 29, 29, 29, 29, 29, 29, 29, 29, 29, 29, 29, 30, 30, 30, 30, 30, 30, 30, 30, 30, 30, 30, 30, 30, 30, 31, 31, 31, 31, 31, 31, 31, 31, 31, 31, 31, 31, 31, 31, 31};

__device__ __forceinline__ float wave_sum(float v) {
#pragma unroll
    for (int o = 1; o < 64; o <<= 1) v += __shfl_xor(v, o);
    return v;
}
__device__ __forceinline__ unsigned f2bf(float f) { unsigned u = __builtin_bit_cast(unsigned, f); return (u + 0x7fffu + ((u >> 16) & 1u)) >> 16; }
__device__ __forceinline__ unsigned pk2(float lo, float hi) { return f2bf(lo) | (f2bf(hi) << 16); }

__device__ __forceinline__ void transpose_item(const float* W, int K, int N, bf16* WT, const float* gk, int a0, int a1, int b0, int b1, float cs, LAS float* scr, int item, int lane) {
    const int nblk = N / 32, kb = item / nblk, nb = item % nblk, k0 = 64 * kb, n0 = 32 * nb;
    const int nn = n0 + (lane & 31);
    const float csc = ((nn >= a0 && nn < a1) || (nn >= b0 && nn < b1)) ? cs : 1.0f;
#pragma unroll 8
    for (int i = 0; i < 32; ++i) { const int kk = 2 * i + (lane >> 5); const float gv = gk ? gk[k0 + kk] : 1.0f; scr[kk * 33 + (lane & 31)] = W[(size_t)(k0 + kk) * N + nn] * (gv * csc); }
    asm volatile("s_waitcnt lgkmcnt(0)" ::: "memory");
    const int c = lane & 7;
#pragma unroll
    for (int j = 0; j < 4; ++j) { const int n = (lane >> 3) + 8 * j; const LAS float* s = scr + (8 * c) * 33 + n;
        v4u o; o.x = pk2(s[0 * 33], s[1 * 33]); o.y = pk2(s[2 * 33], s[3 * 33]); o.z = pk2(s[4 * 33], s[5 * 33]); o.w = pk2(s[6 * 33], s[7 * 33]);
        *(v4u*)(WT + (size_t)(n0 + n) * K + k0 + 8 * c) = o; }
    asm volatile("s_waitcnt lgkmcnt(0)" ::: "memory");
}

__global__ void __launch_bounds__(NWAVES * 64, 2) mega_fwd(Args a) {
    extern __shared__ __attribute__((aligned(16))) unsigned char lds_raw[];
    cg::grid_group grid = cg::this_grid();
    LAS unsigned char* lds = (LAS unsigned char*)lds_raw;
    const int tid = threadIdx.x, lane = tid & 63, wave = __builtin_amdgcn_readfirstlane(tid >> 6);
    const int G = gridDim.x, bx = blockIdx.x;
    const int gw = bx * NWAVES + wave, NGW = G * NWAVES;
    unsigned char* ws = a.ws;
    float* ssq = (float*)(ws + WS_SSQ);
    bf16* xb = (bf16*)(ws + WS_XB);
    bf16* proj = (bf16*)(ws + WS_PROJ);
    bf16* ao = (bf16*)(ws + WS_AO);
    bf16* ubuf = (bf16*)(ws + WS_U);
    bf16* gbuf = (bf16*)(ws + WS_G);

    {
        LAS float* scr = (LAS float*)(lds + wave * 16384);
        constexpr int I_INE = 16 * (EVEN_IN / 32), I_OUT = 16 * 32, I_INO = 16 * (ODD_IN / 32), I_UP = 16 * (DUP / 32), I_DN = (DFF / 64) * 32;
        constexpr int NITEMS = 2 * I_INE + 2 * I_OUT + 2 * I_INO + 2 * I_OUT + 4 * I_UP + 4 * I_DN;
        for (int it = gw; it < NITEMS; it += NGW) {
            int r = it;
            if (r < 2 * I_INE) { const int e = r / I_INE; r -= e * I_INE;
                transpose_item(a.w_in_even + (size_t)e * DM * EVEN_IN, DM, EVEN_IN, (bf16*)(ws + WS_WINE) + (size_t)e * EVEN_IN * DM, a.norm_mix + (2 * e) * DM, 0, 512, 768, 1280, att::QSCALE, scr, r, lane); continue; }
            r -= 2 * I_INE;
            if (r < 2 * I_OUT) { const int e = r / I_OUT; r -= e * I_OUT;
                transpose_item(a.w_out_even + (size_t)e * DM * DM, DM, DM, (bf16*)(ws + WS_WOUTE) + (size_t)e * DM * DM, nullptr, 0, 0, 0, 0, 1.f, scr, r, lane); continue; }
            r -= 2 * I_OUT;
            if (r < 2 * I_INO) { const int e = r / I_INO; r -= e * I_INO;
                transpose_item(a.w_in_odd + (size_t)e * DM * ODD_IN, DM, ODD_IN, (bf16*)(ws + WS_WINO) + (size_t)e * ODD_IN * DM, a.norm_mix + (2 * e + 1) * DM, 0, 1024, 0, 0, att::QSCALE, scr, r, lane); continue; }
            r -= 2 * I_INO;
            if (r < 2 * I_OUT) { const int e = r / I_OUT; r -= e * I_OUT;
                transpose_item(a.w_out_odd + (size_t)e * DM * DM, DM, DM, (bf16*)(ws + WS_WOUTO) + (size_t)e * DM * DM, nullptr, 0, 0, 0, 0, 1.f, scr, r, lane); continue; }
            r -= 2 * I_OUT;
            if (r < 4 * I_UP) { const int e = r / I_UP; r -= e * I_UP;
                transpose_item(a.ffn_up + (size_t)e * DM * DUP, DM, DUP, (bf16*)(ws + WS_WUP) + (size_t)e * DUP * DM, a.norm_ffn + e * DM, 0, 0, 0, 0, 1.f, scr, r, lane); continue; }
            r -= 4 * I_UP;
            { const int e = r / I_DN; r -= e * I_DN;
                transpose_item(a.ffn_down + (size_t)e * DFF * DM, DFF, DM, (bf16*)(ws + WS_WDN) + (size_t)e * DM * DFF, nullptr, 0, 0, 0, 0, 1.f, scr, r, lane); }
        }
        for (int m = gw; m < MTOK; m += NGW) {
            const f32x4* xr = (const f32x4*)(a.x + (size_t)m * DM) + lane; f32x4 v[4]; float s = 0.f;
#pragma unroll
            for (int j = 0; j < 4; ++j) { v[j] = xr[64 * j]; s += (v[j][0] * v[j][0] + v[j][1] * v[j][1]) + (v[j][2] * v[j][2] + v[j][3] * v[j][3]); }
            s = wave_sum(s);
            v2u* o8 = (v2u*)(xb + (size_t)m * DM) + lane;
#pragma unroll
            for (int j = 0; j < 4; ++j) { v2u w; w.x = pk2(v[j][0], v[j][1]); w.y = pk2(v[j][2], v[j][3]); o8[64 * j] = w; }
            if (lane < 16) ssq[(size_t)m * 16 + lane] = (lane == 0) ? s : 0.f;
        }
    }
    grid.sync();

    for (int layer = 0; layer < 4; ++layer) {
        const int e = layer >> 1; const bool even = (layer & 1) == 0;
        const float* xold = (layer == 0) ? a.x : a.out;
        {
            const int N = even ? EVEN_IN : ODD_IN;
            const bf16* wt = even ? (const bf16*)(ws + WS_WINE) + (size_t)e * EVEN_IN * DM : (const bf16*)(ws + WS_WINO) + (size_t)e * ODD_IN * DM;
            pg8::Gemm g{xb, wt, MTOK, N, DM}; pg8::StaticOrder S; S.init(MTOK, N, G, bx);
            pg8::EpiScaleBf16 E{proj, N, ssq};
            for (int rep_ = 0; rep_ < REP_INPROJ; ++rep_)
            pg8::gemm_phase<pg8::EpiScaleBf16, pg8::StaticOrder, true, true>(lds, g, S, E);
        }
        grid.sync();
        if (even) {
            int tq = threadIdx.x; asm volatile("" : "+v"(tq)); const int tid = tq, lane = tq & 63, l32 = lane & 31, hi = lane >> 5;
            float lam, one_m_li;
            { const float li = (layer == 0) ? 0.2f : 0.47071301839f;
              const float s1 = wave_sum(a.lam_q1[e * 64 + lane] * a.lam_k1[e * 64 + lane]), s2 = wave_sum(a.lam_q2[e * 64 + lane] * a.lam_k2[e * 64 + lane]);
              lam = __expf(s1) - __expf(s2) + li; lam = __builtin_bit_cast(float, __builtin_amdgcn_readfirstlane(__builtin_bit_cast(int, lam))); one_m_li = 1.0f - li; }
            LAS float* btab = (LAS float*)(lds + att::L_BT);

#if PH_DIFF
            for (int rep_ = 0; rep_ < REP_DIFF; ++rep_)
            for (int uidx = bx; uidx < 1024; uidx += G) {
                const int j = uidx >> 8, c = uidx & 255, bh = c >> 2, s = c & 3, b = bh >> 2, h = bh & 3;
                const int qb = (j == 0) ? s : (j == 1) ? 7 - s : (j == 2) ? 8 + s : 15 - s;
                if (tid < 128) btab[tid] = a.rel_bias[T5B[tid] * 12 + 8 + h] * att::LOG2E;
                const bf16* base = proj + (size_t)b * SEQ * EVEN_IN;
                const int q0 = qb * 256, nt = 4 * qb + 4, t = q0 + 32 * wave + l32;
                att::f32x16 o2[4]; float m2, l2; LAS unsigned* o1s = (LAS unsigned*)(lds + 57344 + wave * 8192) + lane;
                { float m1, l1;
                  att::attn_core<1, 128>(base + 768 + h * 128, base + 1280 + h * 128, base + 1792 + h * 128, EVEN_IN, q0, 0, nt, 1, lds, o2, m1, l1);
                  const float inv = __builtin_amdgcn_rcpf(l1 + __shfl_xor(l1, 32));
#pragma unroll
                  for (int db = 0; db < 4; ++db)
#pragma unroll
                      for (int k = 0; k < 8; ++k) o1s[(db * 8 + k) * 64] = att::cvtpk(o2[db][2 * k] * inv, o2[db][2 * k + 1] * inv); }
                att::attn_core<1, 128>(base + 768 + h * 128 + 64, base + 1280 + h * 128 + 64, base + 1792 + h * 128, EVEN_IN, q0, 0, nt, 1, lds, o2, m2, l2);
                { const float inv = lam * __builtin_amdgcn_rcpf(l2 + __shfl_xor(l2, 32)); float ss = 0.f;
#pragma unroll
                  for (int db = 0; db < 4; ++db)
#pragma unroll
                      for (int r = 0; r < 16; ++r) { const unsigned w = o1s[(db * 8 + (r >> 1)) * 64]; const float a1 = __uint_as_float((r & 1) ? (w & 0xffff0000u) : (w << 16));
                          const float v = a1 - inv * o2[db][r]; o2[db][r] = v; ss += v * v; }
                  ss += __shfl_xor(ss, 32);
                  const float rs = __builtin_amdgcn_rsqf(ss * (1.0f / 128.0f) + 1e-6f) * one_m_li;
                  const float* gn = a.diff_norm + e * 128;
#pragma unroll
                  for (int db = 0; db < 4; ++db)
#pragma unroll
                      for (int rg = 0; rg < 4; ++rg) { const f32x4 gv = *(const f32x4*)(gn + 32 * db + 8 * rg + 4 * hi);
#pragma unroll
                          for (int k = 0; k < 4; ++k) o2[db][4 * rg + k] *= rs * gv[k]; } }
                att::store_ot<128>(o2, ao + ((size_t)b * SEQ + t) * DM + 512 + h * 128, hi);
            }
#endif
#if PH_SWA
            for (int rep_ = 0; rep_ < REP_SWA; ++rep_)
            for (int uidx = bx; uidx < 2048; uidx += G) {
                const int qb = uidx & 15, qh = (uidx >> 4) & 7, b = uidx >> 7, kvh = qh >> 2;
                if (tid < 128) btab[tid] = a.rel_bias[T5B[tid] * 12 + qh] * att::LOG2E;
                const bf16* base = proj + (size_t)b * SEQ * EVEN_IN;
                const int q0 = qb * 256, t = q0 + 32 * wave + l32;
                const int kt0 = (qb * 4 - 2 > 0) ? qb * 4 - 2 : 0, nt = qb * 4 + 4 - kt0;
                att::f32x16 o[2]; float m, l;
                att::attn_core<2, 64>(base + qh * 64, base + 512 + kvh * 64, base + 640 + kvh * 64, EVEN_IN, q0, kt0, nt, 1, lds, o, m, l);
                const float sk = a.sinks[e * 8 + qh] * att::LOG2E;
                const float inv = __builtin_amdgcn_rcpf(l + __shfl_xor(l, 32) + __builtin_amdgcn_exp2f(sk - m));
#pragma unroll
                for (int db = 0; db < 2; ++db)
#pragma unroll
                    for (int r = 0; r < 16; ++r) o[db][r] *= inv;
                att::store_ot<64>(o, ao + ((size_t)b * SEQ + t) * DM + qh * 64, hi);
            }
#endif
        } else {
#if PH_SB
            int tq = threadIdx.x; asm volatile("" : "+v"(tq)); const int lane = tq & 63, l32 = lane & 31, hi = lane >> 5;
            for (int rep_ = 0; rep_ < REP_SB; ++rep_)
            for (int uidx = bx; uidx < 4096; uidx += G) {
                const int bh = uidx & 255, qb = 15 - (uidx >> 8), b = bh >> 4, h = bh & 15;
                const bf16* base = proj + (size_t)b * SEQ * ODD_IN;
                const int q0 = qb * 256, nt = 4 * qb + 4, t = q0 + 32 * wave + l32;
                att::f32x16 o[2]; float P, dummy;
                att::attn_core<0, 64>(base + h * 64, base + 1024 + h * 64, base + 2048 + h * 64, ODD_IN, q0, nt - 1, nt, -1, lds, o, P, dummy);
                att::store_ot<64>(o, ao + ((size_t)b * SEQ + t) * DM + h * 64, hi);
            }
#endif
        }
        grid.sync();
        {
            const bf16* wt = even ? (const bf16*)(ws + WS_WOUTE) + (size_t)e * DM * DM : (const bf16*)(ws + WS_WOUTO) + (size_t)e * DM * DM;
            pg8::Gemm g{ao, wt, MTOK, DM, DM}; pg8::StaticOrder S; S.init(MTOK, DM, G, bx);
            pg8::EpiResid E{xold, a.out, xb, ssq};
            pg8::gemm_phase<pg8::EpiResid, pg8::StaticOrder, true, true>(lds, g, S, E);
        }
        grid.sync();
        const bf16* wup = (const bf16*)(ws + WS_WUP) + (size_t)layer * DUP * DM;
        const bf16* wdn = (const bf16*)(ws + WS_WDN) + (size_t)layer * DM * DFF;
        for (int half = 0; half < 2; ++half) {
            const size_t r0 = (size_t)half * HALF_ROWS;
            {
                pg8::Gemm g{xb + r0 * DM, wup, HALF_ROWS, DUP, DM}; pg8::StaticOrder S; S.init(HALF_ROWS, DUP, G, bx);
                pg8::EpiScaleBf16 E{ubuf, DUP, ssq + r0 * 16};
                for (int rep_ = 0; rep_ < REP_UP; ++rep_)
                pg8::gemm_phase<pg8::EpiScaleBf16, pg8::StaticOrder, true, true>(lds, g, S, E);
            }
            grid.sync();
#if PH_CONV
            {
                const float* cw = a.ffn_conv + (size_t)layer * 3 * DUP; const float* cb = a.ffn_conv_b + (size_t)layer * DUP;
                constexpr int NCC = 6, NRC = HALF_ROWS / 32;
                int tq = threadIdx.x; asm volatile("" : "+v"(tq)); const int lane = tq & 63;
                for (int rep_ = 0; rep_ < REP_CONV; ++rep_)
                for (int it = gw; it < NCC * NRC; it += NGW) {
                    const int cc = it % NCC, rc = it / NCC, cgp = cc * 64 + lane;
                    if (cgp < DFF / 8) {
                        const int col = cgp * 8, row0 = rc * 32;
                        float wg[3][8], wv[3][8], bg[8], bv[8];
#pragma unroll
                        for (int tp = 0; tp < 3; ++tp)
#pragma unroll
                            for (int k = 0; k < 8; k += 4) { const f32x4 t1 = *(const f32x4*)(cw + tp * DUP + col + k), t2 = *(const f32x4*)(cw + tp * DUP + DFF + col + k);
#pragma unroll
                                for (int q = 0; q < 4; ++q) { wg[tp][k + q] = t1[q]; wv[tp][k + q] = t2[q]; } }
#pragma unroll
                        for (int k = 0; k < 8; k += 4) { const f32x4 t1 = *(const f32x4*)(cb + col + k), t2 = *(const f32x4*)(cb + DFF + col + k);
#pragma unroll
                            for (int q = 0; q < 4; ++q) { bg[k + q] = t1[q]; bv[k + q] = t2[q]; } }
                        float g2[8], g1[8], v2[8], v1[8];
                        const bool head = (row0 % SEQ) == 0;
                        {
                            v4u a2 = {0, 0, 0, 0}, a1 = {0, 0, 0, 0}, c2 = {0, 0, 0, 0}, c1 = {0, 0, 0, 0};
                            if (!head) { const bf16* up = ubuf + (size_t)(row0 - 2) * DUP + col; a2 = *(const v4u*)up; c2 = *(const v4u*)(up + DFF); a1 = *(const v4u*)(up + DUP); c1 = *(const v4u*)(up + DUP + DFF); }
#pragma unroll
                            for (int k = 0; k < 8; ++k) { const int sh = (k & 1) * 16;
                                g2[k] = __uint_as_float(((a2[k >> 1] >> sh) & 0xffffu) << 16); g1[k] = __uint_as_float(((a1[k >> 1] >> sh) & 0xffffu) << 16);
                                v2[k] = __uint_as_float(((c2[k >> 1] >> sh) & 0xffffu) << 16); v1[k] = __uint_as_float(((c1[k >> 1] >> sh) & 0xffffu) << 16); }
                        }
                        for (int r = 0; r < 32; ++r) {
                            const bf16* up = ubuf + (size_t)(row0 + r) * DUP + col;
                            const v4u a0 = *(const v4u*)up, c0 = *(const v4u*)(up + DFF);
                            float res[8];
#pragma unroll
                            for (int k = 0; k < 8; ++k) { const int sh = (k & 1) * 16;
                                const float g0 = __uint_as_float(((a0[k >> 1] >> sh) & 0xffffu) << 16), v0 = __uint_as_float(((c0[k >> 1] >> sh) & 0xffffu) << 16);
                                const float gg = bg[k] + wg[0][k] * g2[k] + wg[1][k] * g1[k] + wg[2][k] * g0;
                                const float vv = bv[k] + wv[0][k] * v2[k] + wv[1][k] * v1[k] + wv[2][k] * v0;
                                const float sg = gg * __builtin_amdgcn_rcpf(1.0f + __builtin_amdgcn_exp2f(-gg * att::LOG2E));
                                res[k] = sg * vv; g2[k] = g1[k]; g1[k] = g0; v2[k] = v1[k]; v1[k] = v0; }
                            v4u w; w.x = pk2(res[0], res[1]); w.y = pk2(res[2], res[3]); w.z = pk2(res[4], res[5]); w.w = pk2(res[6], res[7]);
                            *(v4u*)(gbuf + (size_t)(row0 + r) * DFF + col) = w;
                        }
                    }
                }
            }
#endif
            grid.sync();
            {
                pg8::Gemm g{gbuf, wdn, HALF_ROWS, DM, DFF}; pg8::StaticOrder S; S.init(HALF_ROWS, DM, G, bx);
                pg8::EpiResid E{a.out + r0 * DM, a.out + r0 * DM, xb + r0 * DM, ssq + r0 * 16};
                pg8::gemm_phase<pg8::EpiResid, pg8::StaticOrder, true, true>(lds, g, S, E);
            }
            if (half == 1) grid.sync();
        }
    }
    { int tq = threadIdx.x; asm volatile("" : "+v"(tq)); const int lane = tq & 63;
    for (int m = gw; m < MTOK; m += NGW) {
        f32x4* xr = (f32x4*)(a.out + (size_t)m * DM) + lane; f32x4 v[4]; float s = 0.f;
#pragma unroll
        for (int j = 0; j < 4; ++j) { v[j] = xr[64 * j]; s += (v[j][0] * v[j][0] + v[j][1] * v[j][1]) + (v[j][2] * v[j][2] + v[j][3] * v[j][3]); }
        s = wave_sum(s);
        const float rs = __builtin_amdgcn_rsqf(s * (1.0f / DM) + 1e-6f);
#pragma unroll
        for (int j = 0; j < 4; ++j) { const f32x4 gv = *((const f32x4*)a.norm_final + lane + 64 * j); xr[64 * j] = v[j] * rs * gv; }
    } }
}

extern "C" void kernel_launch(void* const* d_in, const int* in_sizes, int n_in, void* d_out, int out_size, void* d_ws, size_t ws_size, hipStream_t stream) {
    static int grid = 0;
    if (grid == 0) {
        int dev = 0, cus = 0, per_cu = 0;
        (void)hipGetDevice(&dev);
        (void)hipDeviceGetAttribute(&cus, hipDeviceAttributeMultiprocessorCount, dev);
        (void)hipFuncSetAttribute((const void*)mega_fwd, hipFuncAttributeMaxDynamicSharedMemorySize, LDS_BYTES);
        (void)hipOccupancyMaxActiveBlocksPerMultiprocessor(&per_cu, (const void*)mega_fwd, NWAVES * 64, LDS_BYTES);
        if (per_cu < 1) per_cu = 1;
        grid = cus * per_cu;
        if (n_in != 19 || ws_size < 1024 * MiB) fprintf(stderr, "kernel_launch: unexpected n_in %d / ws %zu\n", n_in, ws_size);
    }
    Args a{};
    a.x = (const float*)d_in[0]; a.rel_bias = (const float*)d_in[1]; a.norm_mix = (const float*)d_in[2]; a.norm_ffn = (const float*)d_in[3]; a.norm_final = (const float*)d_in[4];
    a.w_in_even = (const float*)d_in[5]; a.w_out_even = (const float*)d_in[6]; a.sinks = (const float*)d_in[7]; a.lam_q1 = (const float*)d_in[8]; a.lam_k1 = (const float*)d_in[9];
    a.lam_q2 = (const float*)d_in[10]; a.lam_k2 = (const float*)d_in[11]; a.diff_norm = (const float*)d_in[12]; a.w_in_odd = (const float*)d_in[13]; a.w_out_odd = (const float*)d_in[14];
    a.ffn_up = (const float*)d_in[15]; a.ffn_conv = (const float*)d_in[16]; a.ffn_conv_b = (const float*)d_in[17]; a.ffn_down = (const float*)d_in[18];
    a.out = (float*)d_out; a.ws = (unsigned char*)d_ws;
    void* args[] = {&a};
    hipError_t err = hipLaunchCooperativeKernel((const void*)mega_fwd, dim3(grid), dim3(NWAVES * 64), args, LDS_BYTES, stream);
    if (err != hipSuccess) fprintf(stderr, "kernel_launch: cooperative launch failed: %s (grid %d)\n", hipGetErrorString(err), grid);
}
```

```cpp
#include <hip/hip_runtime.h>
#include <hip/hip_cooperative_groups.h>
#include <cstdio>
#include <cstdint>
namespace cg = cooperative_groups;
namespace pg8 {
#define PG8_LAS __attribute__((address_space(3)))
typedef unsigned short bf16_t;
typedef short bf16x8 __attribute__((ext_vector_type(8)));
typedef float f32x4 __attribute__((ext_vector_type(4)));
typedef unsigned u32x4 __attribute__((ext_vector_type(4)));
constexpr int BM = 256, BK = 64, HALF = 128, HTB = HALF * BK * 2  , STAGE_BYTES = 8 * HTB, NXCD = 8, WGM = 8;

__host__ __device__ __forceinline__ int lds_byte(int r, int c) { const int st = (r >> 4) * 2 + (c >> 5), rr = r & 15, cc = c & 31, ob = rr * 64 + cc * 2; return st * 1024 + (ob ^ (((ob >> 9) & 1) << 5)); }
__host__ __device__ __forceinline__ void stage_rc(int b, int& R, int& C) { const int st = b / 1024, sb = b % 1024, swz = sb ^ (((sb >> 9) & 1) << 5); R = (st >> 1) * 16 + swz / 64; C = (st & 1) * 32 + (swz % 64) / 2; }
__host__ __device__ __forceinline__ int perm32(int rho) { const int n = rho >> 4, i = rho & 15; return 8 * (i >> 2) + 4 * n + (i & 3); }

struct Unit { int pm, pn; };
struct Gemm { const bf16_t* A; const bf16_t* Bt; int M, N, K; };

struct StaticOrder {
    int nM, nN, nwg, G, c;
    __host__ __device__ void init(int M, int N, int G_, int c_) { nM = M / BM; nN = N / BM; nwg = nM * nN; G = G_; c = c_; }
    __host__ __device__ bool next(int i, Unit& u) const {
        const long L = (long)i * G + c; if (L >= nwg) return false;
        int wgid = (int)L; { const int q = nwg / NXCD, r = nwg % NXCD, xcd = wgid % NXCD, off = wgid / NXCD; wgid = (xcd < r ? xcd * (q + 1) : r * (q + 1) + (xcd - r) * q) + off; }
        const int nig = WGM * nN, gid = wgid / nig, fm = gid * WGM, gsz = (nM - fm) < WGM ? (nM - fm) : WGM;
        u.pm = fm + ((wgid % nig) % gsz); u.pn = (wgid % nig) / gsz; return true;
    }
    __device__ __forceinline__ void a_ready(const Unit&) const {}
    __device__ __forceinline__ void done(const Unit&) const {}
};

__device__ __forceinline__ unsigned cvt_pk_bf16(float lo, float hi) { unsigned r; asm volatile("v_cvt_pk_bf16_f32 %0, %1, %2" : "=v"(r) : "v"(lo), "v"(hi)); return r; }
typedef float f32x2 __attribute__((ext_vector_type(2)));
typedef unsigned u32x2 __attribute__((ext_vector_type(2)));
constexpr float RMS_EPS = 1e-6f;
struct EpiScaleBf16 {
    static constexpr bool PERM = true, AFTER_DRAIN = false;
    bf16_t* O; int ldc; const float* ssq;
    __device__ __forceinline__ void operator()(const f32x4 (&acc)[2][2][4][2], const Unit& u, int wr, int wc, int fr, int fq) const {
        const int row0 = u.pm * BM + wr * 64 + fr, col0 = u.pn * BM + wc * 32 + 8 * fq;
        f32x4 part[2][4];
#pragma unroll
        for (int ai = 0; ai < 2; ++ai)
#pragma unroll
            for (int m = 0; m < 4; ++m) part[ai][m] = *(const f32x4*)(ssq + (size_t)(row0 + ai * HALF + m * 16) * 16 + fq * 4);
#pragma unroll
        for (int ai = 0; ai < 2; ++ai)
#pragma unroll
            for (int m = 0; m < 4; ++m) { const int row = row0 + ai * HALF + m * 16; bf16_t* rowp = O + (size_t)row * ldc + col0;
                float t = (part[ai][m][0] + part[ai][m][1]) + (part[ai][m][2] + part[ai][m][3]);
                t += __shfl_xor(t, 16); t += __shfl_xor(t, 32);
                const float rs = __builtin_amdgcn_rsqf(t * (1.0f / 1024.0f) + RMS_EPS);
#pragma unroll
                for (int bj = 0; bj < 2; ++bj) { const f32x4 v0 = acc[ai][bj][m][0] * rs, v1 = acc[ai][bj][m][1] * rs;
                    u32x4 w; w.x = cvt_pk_bf16(v0[0], v0[1]); w.y = cvt_pk_bf16(v0[2], v0[3]); w.z = cvt_pk_bf16(v1[0], v1[1]); w.w = cvt_pk_bf16(v1[2], v1[3]);
                    *(u32x4*)(rowp + bj * HALF) = w; } }
    }
};
struct EpiResid {
    static constexpr bool PERM = false, AFTER_DRAIN = false;
    const float* base; float* out; bf16_t* xb; float* ssq;
    __device__ __forceinline__ void operator()(const f32x4 (&acc)[2][2][4][2], const Unit& u, int wr, int wc, int fr, int fq) const {
        const int col0 = u.pn * BM + wc * 32 + 4 * fq;
        const size_t off0 = (size_t)(u.pm * BM + wr * 64 + fr) * 1024 + col0;
        f32x4 nx[2][2];
#pragma unroll
        for (int bj = 0; bj < 2; ++bj)
#pragma unroll
            for (int n = 0; n < 2; ++n) nx[bj][n] = *(const f32x4*)(base + off0 + bj * HALF + n * 16);
#pragma unroll
        for (int g = 0; g < 8; ++g) { const int ai = g >> 2, m = g & 3; const int row = u.pm * BM + ai * HALF + wr * 64 + m * 16 + fr; const size_t off = (size_t)row * 1024 + col0; float q = 0.f;
            f32x4 cu[2][2];
#pragma unroll
            for (int bj = 0; bj < 2; ++bj)
#pragma unroll
                for (int n = 0; n < 2; ++n) cu[bj][n] = nx[bj][n];
            if (g < 7) { const size_t offn = off0 + (size_t)(((g + 1) >> 2) * HALF + ((g + 1) & 3) * 16) * 1024;
#pragma unroll
                for (int bj = 0; bj < 2; ++bj)
#pragma unroll
                    for (int n = 0; n < 2; ++n) nx[bj][n] = *(const f32x4*)(base + offn + bj * HALF + n * 16); }
#pragma unroll
            for (int bj = 0; bj < 2; ++bj)
#pragma unroll
                for (int n = 0; n < 2; ++n) { const f32x4 o = cu[bj][n] + acc[ai][bj][m][n];
                    *(f32x4*)(out + off + bj * HALF + n * 16) = o; q += (o[0] * o[0] + o[1] * o[1]) + (o[2] * o[2] + o[3] * o[3]);
                    u32x2 w; w.x = cvt_pk_bf16(o[0], o[1]); w.y = cvt_pk_bf16(o[2], o[3]); *(u32x2*)(xb + off + bj * HALF + n * 16) = w; }
            q += __shfl_xor(q, 16); q += __shfl_xor(q, 32);
            if (fq == 0) ssq[(size_t)row * 16 + u.pn * 4 + wc] = q;
            asm volatile("" ::: "memory"); }
    }
};
template <class Epi, class Sched, bool ALIGN_EPI = false, bool SP2 = false>
__device__ __forceinline__ void gemm_phase(PG8_LAS unsigned char* lds, const Gemm g, const Sched& S, const Epi& E) {
    int tid_ = threadIdx.x; asm volatile("" : "+v"(tid_));
    const int tid = tid_, wid = __builtin_amdgcn_readfirstlane(tid >> 6), lane = tid & 63, wr = wid >> 2, wc = wid & 3, fr = lane & 15, fq = lane >> 4;
    const int K = g.K, nt = K / BK;
    unsigned voffA[2], voffB[2];
#pragma unroll
    for (int i = 0; i < 2; ++i) { int R, C; stage_rc(tid * 16 + i * 8192, R, C); const int Rb = Epi::PERM ? ((R & ~31) + perm32(R & 31)) : R;
        voffA[i] = (unsigned)(R * K + C) * 2u; voffB[i] = (unsigned)(Rb * K + C) * 2u; }
    const size_t kstep = (size_t)(BK * 2);
    const size_t hstep = (size_t)HALF * K * 2;
    const size_t tstep = 2 * hstep;
    const unsigned ldsw = (unsigned)wid * 1024u;
    const int aoff = lds_byte(wr * 64 + fr, fq * 8), boff = lds_byte(wc * 32 + fr, fq * 8);
#define PG8_SA(b, h) (((b) * 2 + (h)) * HTB)
#define PG8_SB(b, h) ((4 + (b) * 2 + (h)) * HTB)
#define PG8_STAGE(bufoff, gbase, voff) do { _Pragma("unroll") for (int _i = 0; _i < 2; ++_i) \
        __builtin_amdgcn_global_load_lds((const unsigned*)((const char*)(gbase) + (voff)[_i]), (PG8_LAS unsigned*)(lds + (bufoff) + ldsw + _i * 8192), 16, 0, 0); } while (0)
#define PG8_LDA(dst, b, h) do { _Pragma("unroll") for (int m = 0; m < 4; ++m) _Pragma("unroll") for (int k = 0; k < 2; ++k) dst[m][k] = *(const PG8_LAS bf16x8*)(lds + PG8_SA(b, h) + aoff + m * 2048 + k * 1024); } while (0)
#define PG8_LDB(dst, b, h) do { _Pragma("unroll") for (int n = 0; n < 2; ++n) _Pragma("unroll") for (int k = 0; k < 2; ++k) dst[n][k] = *(const PG8_LAS bf16x8*)(lds + PG8_SB(b, h) + boff + n * 2048 + k * 1024); } while (0)
#define PG8_MMA(ai, bj, At, Bt) do { __builtin_amdgcn_s_setprio(1); _Pragma("unroll") for (int m = 0; m < 4; ++m) _Pragma("unroll") for (int n = 0; n < 2; ++n) _Pragma("unroll") for (int k = 0; k < 2; ++k) \
        acc[ai][bj][m][n] = __builtin_amdgcn_mfma_f32_16x16x32_bf16(Bt[n][k], At[m][k], acc[ai][bj][m][n], 0, 0, 0); __builtin_amdgcn_s_setprio(0); } while (0)
#define PG8_WAIT_V(n) asm volatile("s_waitcnt vmcnt(" #n ")" ::: "memory")
#define PG8_WAIT_L(n) asm volatile("s_waitcnt lgkmcnt(" #n ")" ::: "memory")
#define PG8_BAR __builtin_amdgcn_s_barrier()
#define PG8_SCHED __builtin_amdgcn_sched_barrier(0)
    Unit cur, nxt; int ui = 0;
    if (!S.next(0, cur)) return;
    f32x4 acc[2][2][4][2];
#pragma unroll
    for (int a = 0; a < 2; ++a)
#pragma unroll
        for (int b = 0; b < 2; ++b)
#pragma unroll
            for (int m = 0; m < 4; ++m)
#pragma unroll
                for (int n = 0; n < 2; ++n) acc[a][b][m][n] = (f32x4){0.f, 0.f, 0.f, 0.f};
    bf16x8 At[4][2], B0[2][2], B1[2][2];
    const char* cA = (const char*)g.A + (size_t)cur.pm * tstep; const char* cB = (const char*)g.Bt + (size_t)cur.pn * tstep;
    S.a_ready(cur);
    if constexpr (SP2) {
        PG8_STAGE(PG8_SB(0, 0), cB, voffB); PG8_STAGE(PG8_SB(0, 1), cB + hstep, voffB); PG8_STAGE(PG8_SA(0, 0), cA, voffA); PG8_STAGE(PG8_SA(0, 1), cA + hstep, voffA);
        if (wr == 1) PG8_BAR;
        PG8_WAIT_V(2); PG8_BAR;
        PG8_STAGE(PG8_SB(1, 0), cB + kstep, voffB); PG8_STAGE(PG8_SA(1, 0), cA + kstep, voffA); PG8_STAGE(PG8_SB(1, 1), cB + hstep + kstep, voffB);
        PG8_WAIT_V(6); PG8_BAR;
    } else {
        PG8_STAGE(PG8_SB(0, 0), cB, voffB); PG8_STAGE(PG8_SA(0, 0), cA, voffA); PG8_STAGE(PG8_SB(0, 1), cB + hstep, voffB); PG8_STAGE(PG8_SA(0, 1), cA + hstep, voffA);
        if (wr == 1) PG8_BAR;
        PG8_WAIT_V(4); PG8_BAR;
        PG8_STAGE(PG8_SB(1, 0), cB + kstep, voffB); PG8_STAGE(PG8_SA(1, 0), cA + kstep, voffA); PG8_STAGE(PG8_SB(1, 1), cB + hstep + kstep, voffB);
        PG8_WAIT_V(6); PG8_BAR;
    }
    for (;;) {
        const bool has_next = S.next(ui + 1, nxt);
        const char* nA = has_next ? (const char*)g.A + (size_t)nxt.pm * tstep : cA; const char* nB = has_next ? (const char*)g.Bt + (size_t)nxt.pn * tstep : cB;
        for (int t = 0; t < nt; t += 2) {
            const bool last = (t == nt - 2);
            const char* a1 = cA + (size_t)(t + 1) * kstep;
            const char* a2 = last ? nA : cA + (size_t)(t + 2) * kstep; const char* b2 = last ? nB : cB + (size_t)(t + 2) * kstep;
            const char* a3 = a2 + kstep; const char* b3 = b2 + kstep;
            if (last && has_next) S.a_ready(nxt);
            if constexpr (SP2) {
            PG8_LDB(B0, 0, 0); PG8_LDB(B1, 0, 1); PG8_SCHED; PG8_LDA(At, 0, 0); PG8_STAGE(PG8_SA(1, 1), a1 + hstep, voffA);
            PG8_WAIT_V(8); PG8_WAIT_L(0); PG8_BAR; PG8_MMA(0, 0, At, B0); PG8_MMA(0, 1, At, B1); PG8_BAR; PG8_SCHED;
            PG8_LDA(At, 0, 1); PG8_STAGE(PG8_SB(0, 0), b2, voffB); PG8_STAGE(PG8_SB(0, 1), b2 + hstep, voffB); PG8_STAGE(PG8_SA(0, 0), a2, voffA);
            PG8_WAIT_V(8); PG8_WAIT_L(0); PG8_BAR; PG8_MMA(1, 0, At, B0); PG8_MMA(1, 1, At, B1); PG8_BAR; PG8_SCHED;
            PG8_LDB(B0, 1, 0); PG8_LDB(B1, 1, 1); PG8_SCHED; PG8_LDA(At, 1, 0); PG8_STAGE(PG8_SA(0, 1), a2 + hstep, voffA);
            PG8_WAIT_V(8); PG8_WAIT_L(0); PG8_BAR; PG8_MMA(0, 0, At, B0); PG8_MMA(0, 1, At, B1); PG8_BAR; PG8_SCHED;
            PG8_LDA(At, 1, 1); PG8_STAGE(PG8_SB(1, 0), b3, voffB); PG8_STAGE(PG8_SB(1, 1), b3 + hstep, voffB); PG8_STAGE(PG8_SA(1, 0), a3, voffA);
            PG8_WAIT_V(8); PG8_WAIT_L(0); PG8_BAR; PG8_MMA(1, 0, At, B0); PG8_MMA(1, 1, At, B1); PG8_BAR; PG8_SCHED;
            } else {
            PG8_LDB(B0, 0, 0); PG8_SCHED; PG8_LDA(At, 0, 0); PG8_STAGE(PG8_SA(1, 1), a1 + hstep, voffA);
            PG8_WAIT_L(8); PG8_BAR; PG8_WAIT_L(0); PG8_MMA(0, 0, At, B0); PG8_BAR; PG8_SCHED;
            PG8_LDB(B1, 0, 1); PG8_STAGE(PG8_SB(0, 0), b2, voffB);
            PG8_BAR; PG8_WAIT_L(0); PG8_MMA(0, 1, At, B1); PG8_BAR;
            PG8_LDA(At, 0, 1); PG8_STAGE(PG8_SA(0, 0), a2, voffA);
            PG8_BAR; PG8_WAIT_L(0); PG8_MMA(1, 0, At, B0); PG8_BAR; PG8_SCHED;
            PG8_STAGE(PG8_SB(0, 1), b2 + hstep, voffB);
            PG8_WAIT_V(6); PG8_BAR; PG8_MMA(1, 1, At, B1); PG8_BAR;
            PG8_LDB(B0, 1, 0); PG8_SCHED; PG8_LDA(At, 1, 0); PG8_STAGE(PG8_SA(0, 1), a2 + hstep, voffA);
            PG8_WAIT_L(8); PG8_BAR; PG8_WAIT_L(0); PG8_MMA(0, 0, At, B0); PG8_BAR; PG8_SCHED;
            PG8_LDB(B1, 1, 1); PG8_STAGE(PG8_SB(1, 0), b3, voffB);
            PG8_BAR; PG8_WAIT_L(0); PG8_MMA(0, 1, At, B1); PG8_BAR;
            PG8_LDA(At, 1, 1); PG8_STAGE(PG8_SA(1, 0), a3, voffA);
            PG8_BAR; PG8_WAIT_L(0); PG8_MMA(1, 0, At, B0); PG8_BAR; PG8_SCHED;
            PG8_STAGE(PG8_SB(1, 1), b3 + hstep, voffB);
            PG8_WAIT_V(6); PG8_BAR; PG8_MMA(1, 1, At, B1); PG8_BAR;
            }
        }
        if constexpr (ALIGN_EPI) { if (wr == 0) PG8_BAR; }
        if constexpr (!Epi::AFTER_DRAIN) { E(acc, cur, wr, wc, fr, fq); S.done(cur); }
        if (!has_next) break;
#pragma unroll
        for (int a = 0; a < 2; ++a)
#pragma unroll
            for (int b = 0; b < 2; ++b)
#pragma unroll
                for (int m = 0; m < 4; ++m)
#pragma unroll
                    for (int n = 0; n < 2; ++n) acc[a][b][m][n] = (f32x4){0.f, 0.f, 0.f, 0.f};
        cur = nxt; cA = nA; cB = nB; ++ui;
        if constexpr (ALIGN_EPI) { if (wr == 1) PG8_BAR; }
    }
    PG8_WAIT_V(0);
    if constexpr (!ALIGN_EPI) { if (wr == 0) PG8_BAR; }
    PG8_BAR;
    if constexpr (Epi::AFTER_DRAIN) { E.fused(acc, cur, wr, wc, fr, fq, lds, wid, lane); S.done(cur); }
#undef PG8_SA
#undef PG8_SB
#undef PG8_STAGE
#undef PG8_LDA
#undef PG8_LDB
#undef PG8_MMA
#undef PG8_WAIT_V
#undef PG8_WAIT_L
#undef PG8_BAR
#undef PG8_SCHED
}
}
namespace att {
#define ALAS __attribute__((address_space(3)))
typedef unsigned short bf16_t;
typedef short bf16x8 __attribute__((ext_vector_type(8)));
typedef float f32x16 __attribute__((ext_vector_type(16)));
typedef float f32x4 __attribute__((ext_vector_type(4)));
typedef unsigned u32x4 __attribute__((ext_vector_type(4)));
typedef unsigned u32x2 __attribute__((ext_vector_type(2)));
constexpr int KROW = 144;
constexpr int KBUF = 64 * KROW;
constexpr int VBUF = 128 * KROW;
constexpr int L_K = 0, L_V = 2 * KBUF, L_BT = L_V + 2 * VBUF, L_END = L_BT + 512;
constexpr float LOG2E = 1.4426950408889634f;
constexpr float QSCALE = 0.125f * 1.4426950408889634f;
#define CR(r) (((r) & 3) + 8 * ((r) >> 2))
__device__ __forceinline__ unsigned cvtpk(float lo, float hi) { unsigned r; asm volatile("v_cvt_pk_bf16_f32 %0, %1, %2" : "=v"(r) : "v"(lo), "v"(hi)); return r; }
__device__ __forceinline__ float ex2(float x) { return __builtin_amdgcn_exp2f(x); }
__device__ __forceinline__ float rcpf_(float x) { return __builtin_amdgcn_rcpf(x); }

template <int DV> struct Pref { u32x4 k; u32x4 v[DV / 64]; };

template <int DV> __device__ __forceinline__ void tile_load(Pref<DV>& pf, const bf16_t* Kp, const bf16_t* Vp, int pitch, int kt, int tid) {
    const int krow = tid >> 3, kc = (tid & 7) * 8;
    pf.k = *(const u32x4*)(Kp + (size_t)(kt * 64 + krow) * pitch + kc);
#pragma unroll
    for (int i = 0; i < DV / 64; ++i) { const int vrow = tid & 63, vc = ((tid >> 6) + 8 * i) * 8;
        pf.v[i] = *(const u32x4*)(Vp + (size_t)(kt * 64 + vrow) * pitch + vc); }
}
template <int DV> __device__ __forceinline__ void tile_store(const Pref<DV>& pf, ALAS unsigned char* kbuf, ALAS unsigned char* vbuf, int tid) {
    const int krow = tid >> 3, kc = (tid & 7) * 8;
    *(ALAS u32x4*)(kbuf + krow * KROW + kc * 2) = pf.k;
#pragma unroll
    for (int i = 0; i < DV / 64; ++i) { const int vrow = tid & 63, vc = ((tid >> 6) + 8 * i) * 8;
        const int kk = vrow & 15, pos = (vrow & ~15) + 8 * ((kk >> 2) & 1) + (kk & 3) + 4 * (kk >> 3);
        ALAS unsigned char* d = vbuf + vc * KROW + pos * 2;
#pragma unroll
        for (int j = 0; j < 8; ++j) { const unsigned w = pf.v[i][j >> 1]; *(ALAS unsigned short*)(d + j * KROW) = (unsigned short)((j & 1) ? (w >> 16) : (w & 0xffffu)); } }
}

template <int DV> __device__ __forceinline__ void pv_slab(const ALAS unsigned char* vbuf, int s, u32x4 w, f32x16 (&o)[DV / 32], int l32, int hi) {
    const bf16x8 pfr = __builtin_bit_cast(bf16x8, w);
#pragma unroll
    for (int db = 0; db < DV / 32; ++db) {
        const bf16x8 vf = *(const ALAS bf16x8*)(vbuf + (db * 32 + l32) * KROW + s * 32 + hi * 16);
        o[db] = __builtin_amdgcn_mfma_f32_32x32x16_bf16(vf, pfr, o[db], 0, 0, 0); }
    if (DV > 64) __builtin_amdgcn_sched_barrier(0);
}

template <int MODE, int DV, bool MASKED>
__device__ __forceinline__ void tile_compute(const ALAS unsigned char* kbuf, const ALAS unsigned char* vbuf, const bf16x8 (&qf)[4], f32x16 (&o)[DV / 32],
                                             float& st_m, float& st_l, int lim, const ALAS float* btab, float cbias, int lane) {
    const int l32 = lane & 31, hi = lane >> 5;
    if constexpr (MODE == 0) {
        f32x16 p0, p1;
#pragma unroll
        for (int r = 0; r < 16; ++r) { p0[r] = 0.f; p1[r] = 0.f; }
        { const ALAS unsigned char* kb = kbuf + l32 * KROW + hi * 16;
#pragma unroll
          for (int d0 = 0; d0 < 4; ++d0) {
              const bf16x8 k0 = *(const ALAS bf16x8*)(kb + d0 * 32);
              const bf16x8 k1 = *(const ALAS bf16x8*)(kb + 32 * KROW + d0 * 32);
              p0 = __builtin_amdgcn_mfma_f32_32x32x16_bf16(k0, qf[d0], p0, 0, 0, 0);
              p1 = __builtin_amdgcn_mfma_f32_32x32x16_bf16(k1, qf[d0], p1, 0, 0, 0); } }
        __builtin_amdgcn_sched_barrier(0);
#pragma unroll
        for (int r = 0; r < 16; ++r) {
            float a = rcpf_(1.0f + ex2(p0[r])), b = rcpf_(1.0f + ex2(p1[r]));
            if (MASKED) { a = (CR(r) < lim) ? a : 1.0f; b = (CR(r) + 32 < lim) ? b : 1.0f; }
            p0[r] = a; p1[r] = b; }
        float g[8], hs[8], pr[8];
#pragma unroll
        for (int i = 0; i < 4; ++i) { g[i] = (p0[4 * i] * p0[4 * i + 1]) * (p0[4 * i + 2] * p0[4 * i + 3]); g[4 + i] = (p1[4 * i] * p1[4 * i + 1]) * (p1[4 * i + 2] * p1[4 * i + 3]); }
#pragma unroll
        for (int i = 0; i < 8; ++i) { const float h = __shfl_xor(g[i], 32); pr[i] = g[i] * h; hs[i] = hi ? 1.0f : h; }
        float T = st_m;
#pragma unroll
        for (int i = 7; i >= 0; --i) {
            float R = hs[i] * T; T = T * pr[i];
            if (i >= 4) { const int b = 4 * (i - 4);
                float R2 = R * p1[b + 3]; p1[b + 3] = R - R2; float R1 = R2 * p1[b + 2]; p1[b + 2] = R2 - R1; float R0 = R1 * p1[b + 1]; p1[b + 1] = R1 - R0; p1[b] = R0 - R0 * p1[b]; }
            else { const int b = 4 * i;
                float R2 = R * p0[b + 3]; p0[b + 3] = R - R2; float R1 = R2 * p0[b + 2]; p0[b + 2] = R2 - R1; float R0 = R1 * p0[b + 1]; p0[b + 1] = R1 - R0; p0[b] = R0 - R0 * p0[b]; }
        }
        st_m = T;
        __builtin_amdgcn_sched_barrier(0);
#pragma unroll
        for (int s = 0; s < 4; ++s) {
            u32x4 w;
            if (s == 0) { w.x = cvtpk(p0[0], p0[1]); w.y = cvtpk(p0[2], p0[3]); w.z = cvtpk(p0[4], p0[5]); w.w = cvtpk(p0[6], p0[7]); }
            else if (s == 1) { w.x = cvtpk(p0[8], p0[9]); w.y = cvtpk(p0[10], p0[11]); w.z = cvtpk(p0[12], p0[13]); w.w = cvtpk(p0[14], p0[15]); }
            else if (s == 2) { w.x = cvtpk(p1[0], p1[1]); w.y = cvtpk(p1[2], p1[3]); w.z = cvtpk(p1[4], p1[5]); w.w = cvtpk(p1[6], p1[7]); }
            else { w.x = cvtpk(p1[8], p1[9]); w.y = cvtpk(p1[10], p1[11]); w.z = cvtpk(p1[12], p1[13]); w.w = cvtpk(p1[14], p1[15]); }
            pv_slab<DV>(vbuf, s, w, o, l32, hi);
        }
    } else {
        const float NEG = -__builtin_inff();
#pragma unroll
        for (int hk = 0; hk < 2; ++hk) {
            f32x16 p;
#pragma unroll
            for (int r = 0; r < 16; ++r) p[r] = 0.f;
            { const ALAS unsigned char* kb = kbuf + (32 * hk + l32) * KROW + hi * 16;
#pragma unroll
              for (int d0 = 0; d0 < 4; ++d0) { const bf16x8 k0 = *(const ALAS bf16x8*)(kb + d0 * 32); p = __builtin_amdgcn_mfma_f32_32x32x16_bf16(k0, qf[d0], p, 0, 0, 0); } }
            __builtin_amdgcn_sched_barrier(0);
            if (MASKED) {
#pragma unroll
                for (int r = 0; r < 16; ++r) {
                    const int d0 = lim - 32 * hk - CR(r);
                    const float b0 = btab[min(max(d0, 0), 127)];
                    const bool v0 = (MODE == 2) ? ((unsigned)d0 < 128u) : (d0 >= 0);
                    p[r] = v0 ? p[r] + b0 : NEG; }
            } else {
#pragma unroll
                for (int r = 0; r < 16; ++r) p[r] += cbias;
            }
            float mt = fmaxf(p[0], p[1]);
#pragma unroll
            for (int r = 2; r < 16; ++r) mt = fmaxf(mt, p[r]);
            mt = fmaxf(mt, __shfl_xor(mt, 32));
            if (__any(mt > st_m)) {
                const float mn = fmaxf(st_m, mt), f = ex2(st_m - mn);
                st_l *= f; st_m = mn;
#pragma unroll
                for (int db = 0; db < DV / 32; ++db)
#pragma unroll
                    for (int r = 0; r < 16; ++r) o[db][r] *= f;
            }
            float s = 0.f;
#pragma unroll
            for (int r = 0; r < 16; ++r) { p[r] = ex2(p[r] - st_m); s += p[r]; }
            st_l += s;
            __builtin_amdgcn_sched_barrier(0);
#pragma unroll
            for (int s2 = 0; s2 < 2; ++s2) {
                u32x4 w; w.x = cvtpk(p[8 * s2], p[8 * s2 + 1]); w.y = cvtpk(p[8 * s2 + 2], p[8 * s2 + 3]); w.z = cvtpk(p[8 * s2 + 4], p[8 * s2 + 5]); w.w = cvtpk(p[8 * s2 + 6], p[8 * s2 + 7]);
                pv_slab<DV>(vbuf, 2 * hk + s2, w, o, l32, hi);
            }
        }
    }
}

template <int MODE, int DV>
__device__ __forceinline__ void attn_core(const bf16_t* Qp, const bf16_t* Kp, const bf16_t* Vp, int pitch, int q0, int kt0, int nt, int dir,
                                          ALAS unsigned char* lds, f32x16 (&o)[DV / 32], float& st_m, float& st_l) {
    int tid_ = threadIdx.x; asm volatile("" : "+v"(tid_));
    const int tid = tid_, lane = tid & 63, l32 = lane & 31, hi = lane >> 5, wid = __builtin_amdgcn_readfirstlane(tid >> 6);
    const int qw = q0 + 32 * wid, t = qw + l32;
    const ALAS float* btab = (const ALAS float*)(lds + L_BT);
    bf16x8 qf[4];
#pragma unroll
    for (int d0 = 0; d0 < 4; ++d0) qf[d0] = *(const bf16x8*)(Qp + (size_t)t * pitch + d0 * 16 + hi * 8);
#pragma unroll
    for (int db = 0; db < DV / 32; ++db)
#pragma unroll
        for (int r = 0; r < 16; ++r) o[db][r] = 0.f;
    st_m = (MODE == 0) ? 1.0f : -1e30f; st_l = 0.f;
    Pref<DV> pf;
    tile_load<DV>(pf, Kp, Vp, pitch, kt0, tid);
    tile_store<DV>(pf, lds + L_K, lds + L_V, tid);
    __syncthreads();
    const float cbias = (MODE == 1) ? btab[127] : 0.f;
    for (int it = 0; it < nt; ++it) {
        const int kt = kt0 + dir * it, cur = it & 1, kbase = kt * 64;
        if (it + 1 < nt) tile_load<DV>(pf, Kp, Vp, pitch, kt + dir, tid);
        const ALAS unsigned char* kb = lds + L_K + cur * KBUF; const ALAS unsigned char* vb = lds + L_V + cur * VBUF;
        const int lim = t - kbase - 4 * hi;
        if (MODE == 0) {
            if (kbase <= qw + 31) { if (kbase + 63 >= qw) tile_compute<0, DV, true>(kb, vb, qf, o, st_m, st_l, lim, btab, cbias, lane); else tile_compute<0, DV, false>(kb, vb, qf, o, st_m, st_l, lim, btab, cbias, lane); }
        } else if (MODE == 1) {
            if (kbase <= qw + 31) { if (qw - (kbase + 63) < 113) tile_compute<1, DV, true>(kb, vb, qf, o, st_m, st_l, lim, btab, cbias, lane); else tile_compute<1, DV, false>(kb, vb, qf, o, st_m, st_l, lim, btab, cbias, lane); }
        } else {
            if (kbase <= qw + 31 && kbase + 63 >= qw - 127) tile_compute<2, DV, true>(kb, vb, qf, o, st_m, st_l, lim, btab, cbias, lane);
        }
        if (it + 1 < nt) tile_store<DV>(pf, lds + L_K + (cur ^ 1) * KBUF, lds + L_V + (cur ^ 1) * VBUF, tid);
        if (MODE == 0) {
            if (!__syncthreads_or(st_m != 0.0f)) break;
        } else __syncthreads();
    }
}
template <int DV> __device__ __forceinline__ void store_ot(const f32x16 (&o)[DV / 32], bf16_t* orow, int hi) {
#pragma unroll
    for (int db = 0; db < DV / 32; ++db)
#pragma unroll
        for (int rg = 0; rg < 4; ++rg) { u32x2 w; w.x = cvtpk(o[db][4 * rg], o[db][4 * rg + 1]); w.y = cvtpk(o[db][4 * rg + 2], o[db][4 * rg + 3]);
            *(u32x2*)(orow + 32 * db + 8 * rg + 4 * hi) = w; }
}
}
#ifndef REP_INPROJ
#define REP_INPROJ 1
#endif
#ifndef REP_DIFF
#define REP_DIFF 1
#endif
#ifndef REP_SWA
#define REP_SWA 1
#endif
#ifndef REP_SB
#define REP_SB 1
#endif
#ifndef REP_UP
#define REP_UP 1
#endif
#ifndef REP_CONV
#define REP_CONV 1
#endif
#ifndef PH_DIFF
#define PH_DIFF 1
#endif
#ifndef PH_SWA
#define PH_SWA 1
#endif
#ifndef PH_SB
#define PH_SB 1
#endif
#ifndef PH_CONV
#define PH_CONV 1
#endif
#define LAS __attribute__((address_space(3)))
typedef unsigned short bf16;
typedef float f32x4 __attribute__((ext_vector_type(4)));
typedef unsigned v4u __attribute__((ext_vector_type(4)));
typedef unsigned v2u __attribute__((ext_vector_type(2)));
constexpr int NWAVES = 8;
constexpr int SEQ = 4096, NB = 16, MTOK = NB * SEQ, DM = 1024, DFF = 2816, DUP = 2 * DFF;
constexpr int EVEN_IN = 2304, ODD_IN = 3072;
constexpr size_t MiB = 1u << 20;
constexpr size_t WS_SSQ = 1 * MiB;
constexpr size_t WS_WINE = 8 * MiB, WS_WOUTE = 17 * MiB, WS_WINO = 21 * MiB, WS_WOUTO = 33 * MiB, WS_WUP = 37 * MiB, WS_WDN = 81 * MiB;
constexpr size_t WS_XB = 104 * MiB, WS_R = 232 * MiB;
constexpr size_t WS_PROJ = WS_R, WS_AO = WS_R + 384 * MiB, WS_U = WS_R, WS_G = WS_R + 352 * MiB;
constexpr int LDS_BYTES = 147456;
constexpr int HALF_ROWS = MTOK / 2;

struct Args {
    const float* x; const float* rel_bias; const float* norm_mix; const float* norm_ffn; const float* norm_final;
    const float* w_in_even; const float* w_out_even; const float* sinks; const float* lam_q1; const float* lam_k1; const float* lam_q2; const float* lam_k2;
    const float* diff_norm; const float* w_in_odd; const float* w_out_odd; const float* ffn_up; const float* ffn_conv; const float* ffn_conv_b; const float* ffn_down;
    float* out; unsigned char* ws;
};

__device__ const unsigned char T5B[128] = {0, 1, 2, 3, 4, 5, 6, 7, 8, 9, 10, 11, 12, 13, 14, 15, 16, 16, 16, 17, 17, 18, 18, 18, 19, 19, 19, 20, 20, 20, 20, 21, 21, 21, 21, 22, 22, 22, 22, 22, 23, 23, 23, 23, 23, 23, 24, 24, 24, 24, 24, 24, 25, 25, 25, 25, 25, 25, 25, 26, 26, 26, 26, 26, 26, 26, 26, 27, 27, 27, 27, 27, 27, 27, 27, 27, 27, 28, 28, 28, 28, 28, 28, 28, 28, 28, 28, 29, 29, 29, 29, 29, 29, 29, 29, 29, 29, 29, 29, 30, 30, 30, 30, 30, 30, 30, 30, 30, 30, 30, 30, 30, 30, 31, 31, 31, 31, 31, 31, 31, 31, 31, 31, 31, 31, 31, 31, 31};

__device__ __forceinline__ float wave_sum(float v) {
#pragma unroll
    for (int o = 1; o < 64; o <<= 1) v += __shfl_xor(v, o);
    return v;
}
__device__ __forceinline__ unsigned f2bf(float f) { unsigned u = __builtin_bit_cast(unsigned, f); return (u + 0x7fffu + ((u >> 16) & 1u)) >> 16; }
__device__ __forceinline__ unsigned pk2(float lo, float hi) { return f2bf(lo) | (f2bf(hi) << 16); }

__device__ __forceinline__ void transpose_item(const float* W, int K, int N, bf16* WT, const float* gk, int a0, int a1, int b0, int b1, float cs, LAS float* scr, int item, int lane) {
    const int nblk = N / 32, kb = item / nblk, nb = item % nblk, k0 = 64 * kb, n0 = 32 * nb;
    const int nn = n0 + (lane & 31);
    const float csc = ((nn >= a0 && nn < a1) || (nn >= b0 && nn < b1)) ? cs : 1.0f;
#pragma unroll 8
    for (int i = 0; i < 32; ++i) { const int kk = 2 * i + (lane >> 5); const float gv = gk ? gk[k0 + kk] : 1.0f; scr[kk * 33 + (lane & 31)] = W[(size_t)(k0 + kk) * N + nn] * (gv * csc); }
    asm volatile("s_waitcnt lgkmcnt(0)" ::: "memory");
    const int c = lane & 7;
#pragma unroll
    for (int j = 0; j < 4; ++j) { const int n = (lane >> 3) + 8 * j; const LAS float* s = scr + (8 * c) * 33 + n;
        v4u o; o.x = pk2(s[0 * 33], s[1 * 33]); o.y = pk2(s[2 * 33], s[3 * 33]); o.z = pk2(s[4 * 33], s[5 * 33]); o.w = pk2(s[6 * 33], s[7 * 33]);
        *(v4u*)(WT + (size_t)(n0 + n) * K + k0 + 8 * c) = o; }
    asm volatile("s_waitcnt lgkmcnt(0)" ::: "memory");
}

__global__ void __launch_bounds__(NWAVES * 64, 2) mega_fwd(Args a) {
    extern __shared__ __attribute__((aligned(16))) unsigned char lds_raw[];
    cg::grid_group grid = cg::this_grid();
    LAS unsigned char* lds = (LAS unsigned char*)lds_raw;
    const int tid = threadIdx.x, lane = tid & 63, wave = __builtin_amdgcn_readfirstlane(tid >> 6);
    const int G = gridDim.x, bx = blockIdx.x;
    const int gw = bx * NWAVES + wave, NGW = G * NWAVES;
    unsigned char* ws = a.ws;
    float* ssq = (float*)(ws + WS_SSQ);
    bf16* xb = (bf16*)(ws + WS_XB);
    bf16* proj = (bf16*)(ws + WS_PROJ);
    bf16* ao = (bf16*)(ws + WS_AO);
    bf16* ubuf = (bf16*)(ws + WS_U);
    bf16* gbuf = (bf16*)(ws + WS_G);

    {
        LAS float* scr = (LAS float*)(lds + wave * 16384);
        constexpr int I_INE = 16 * (EVEN_IN / 32), I_OUT = 16 * 32, I_INO = 16 * (ODD_IN / 32), I_UP = 16 * (DUP / 32), I_DN = (DFF / 64) * 32;
        constexpr int NITEMS = 2 * I_INE + 2 * I_OUT + 2 * I_INO + 2 * I_OUT + 4 * I_UP + 4 * I_DN;
        for (int it = gw; it < NITEMS; it += NGW) {
            int r = it;
            if (r < 2 * I_INE) { const int e = r / I_INE; r -= e * I_INE;
                transpose_item(a.w_in_even + (size_t)e * DM * EVEN_IN, DM, EVEN_IN, (bf16*)(ws + WS_WINE) + (size_t)e * EVEN_IN * DM, a.norm_mix + (2 * e) * DM, 0, 512, 768, 1280, att::QSCALE, scr, r, lane); continue; }
            r -= 2 * I_INE;
            if (r < 2 * I_OUT) { const int e = r / I_OUT; r -= e * I_OUT;
                transpose_item(a.w_out_even + (size_t)e * DM * DM, DM, DM, (bf16*)(ws + WS_WOUTE) + (size_t)e * DM * DM, nullptr, 0, 0, 0, 0, 1.f, scr, r, lane); continue; }
            r -= 2 * I_OUT;
            if (r < 2 * I_INO) { const int e = r / I_INO; r -= e * I_INO;
                transpose_item(a.w_in_odd + (size_t)e * DM * ODD_IN, DM, ODD_IN, (bf16*)(ws + WS_WINO) + (size_t)e * ODD_IN * DM, a.norm_mix + (2 * e + 1) * DM, 0, 1024, 0, 0, att::QSCALE, scr, r, lane); continue; }
            r -= 2 * I_INO;
            if (r < 2 * I_OUT) { const int e = r / I_OUT; r -= e * I_OUT;
                transpose_item(a.w_out_odd + (size_t)e * DM * DM, DM, DM, (bf16*)(ws + WS_WOUTO) + (size_t)e * DM * DM, nullptr, 0, 0, 0, 0, 1.f, scr, r, lane); continue; }
            r -= 2 * I_OUT;
            if (r < 4 * I_UP) { const int e = r / I_UP; r -= e * I_UP;
                transpose_item(a.ffn_up + (size_t)e * DM * DUP, DM, DUP, (bf16*)(ws + WS_WUP) + (size_t)e * DUP * DM, a.norm_ffn + e * DM, 0, 0, 0, 0, 1.f, scr, r, lane); continue; }
            r -= 4 * I_UP;
            { const int e = r / I_DN; r -= e * I_DN;
                transpose_item(a.ffn_down + (size_t)e * DFF * DM, DFF, DM, (bf16*)(ws + WS_WDN) + (size_t)e * DM * DFF, nullptr, 0, 0, 0, 0, 1.f, scr, r, lane); }
        }
        for (int m = gw; m < MTOK; m += NGW) {
            const f32x4* xr = (const f32x4*)(a.x + (size_t)m * DM) + lane; f32x4 v[4]; float s = 0.f;
#pragma unroll
            for (int j = 0; j < 4; ++j) { v[j] = xr[64 * j]; s += (v[j][0] * v[j][0] + v[j][1] * v[j][1]) + (v[j][2] * v[j][2] + v[j][3] * v[j][3]); }
            s = wave_sum(s);
            v2u* o8 = (v2u*)(xb + (size_t)m * DM) + lane;
#pragma unroll
            for (int j = 0; j < 4; ++j) { v2u w; w.x = pk2(v[j][0], v[j][1]); w.y = pk2(v[j][2], v[j][3]); o8[64 * j] = w; }
            if (lane < 16) ssq[(size_t)m * 16 + lane] = (lane == 0) ? s : 0.f;
        }
    }
    grid.sync();

    for (int layer = 0; layer < 4; ++layer) {
        const int e = layer >> 1; const bool even = (layer & 1) == 0;
        const float* xold = (layer == 0) ? a.x : a.out;
        {
            const int N = even ? EVEN_IN : ODD_IN;
            const bf16* wt = even ? (const bf16*)(ws + WS_WINE) + (size_t)e * EVEN_IN * DM : (const bf16*)(ws + WS_WINO) + (size_t)e * ODD_IN * DM;
            pg8::Gemm g{xb, wt, MTOK, N, DM}; pg8::StaticOrder S; S.init(MTOK, N, G, bx);
            pg8::EpiScaleBf16 E{proj, N, ssq};
            for (int rep_ = 0; rep_ < REP_INPROJ; ++rep_)
            pg8::gemm_phase<pg8::EpiScaleBf16, pg8::StaticOrder, true, true>(lds, g, S, E);
        }
        grid.sync();
        if (even) {
            int tq = threadIdx.x; asm volatile("" : "+v"(tq)); const int tid = tq, lane = tq & 63, l32 = lane & 31, hi = lane >> 5;
            float lam, one_m_li;
            { const float li = (layer == 0) ? 0.2f : 0.47071301839f;
              const float s1 = wave_sum(a.lam_q1[e * 64 + lane] * a.lam_k1[e * 64 + lane]), s2 = wave_sum(a.lam_q2[e * 64 + lane] * a.lam_k2[e * 64 + lane]);
              lam = __expf(s1) - __expf(s2) + li; lam = __builtin_bit_cast(float, __builtin_amdgcn_readfirstlane(__builtin_bit_cast(int, lam))); one_m_li = 1.0f - li; }
            LAS float* btab = (LAS float*)(lds + att::L_BT);

#if PH_DIFF
            for (int rep_ = 0; rep_ < REP_DIFF; ++rep_)
            for (int uidx = bx; uidx < 1024; uidx += G) {
                const int j = uidx >> 8, c = uidx & 255, bh = c >> 2, s = c & 3, b = bh >> 2, h = bh & 3;
                const int qb = (j == 0) ? s : (j == 1) ? 7 - s : (j == 2) ? 8 + s : 15 - s;
                if (tid < 128) btab[tid] = a.rel_bias[T5B[tid] * 12 + 8 + h] * att::LOG2E;
                const bf16* base = proj + (size_t)b * SEQ * EVEN_IN;
                const int q0 = qb * 256, nt = 4 * qb + 4, t = q0 + 32 * wave + l32;
                att::f32x16 o2[4]; float m2, l2; LAS unsigned* o1s = (LAS unsigned*)(lds + 57344 + wave * 8192) + lane;
                { float m1, l1;
                  att::attn_core<1, 128>(base + 768 + h * 128, base + 1280 + h * 128, base + 1792 + h * 128, EVEN_IN, q0, 0, nt, 1, lds, o2, m1, l1);
                  const float inv = __builtin_amdgcn_rcpf(l1 + __shfl_xor(l1, 32));
#pragma unroll
                  for (int db = 0; db < 4; ++db)
#pragma unroll
                      for (int k = 0; k < 8; ++k) o1s[(db * 8 + k) * 64] = att::cvtpk(o2[db][2 * k] * inv, o2[db][2 * k + 1] * inv); }
                att::attn_core<1, 128>(base + 768 + h * 128 + 64, base + 1280 + h * 128 + 64, base + 1792 + h * 128, EVEN_IN, q0, 0, nt, 1, lds, o2, m2, l2);
                { const float inv = lam * __builtin_amdgcn_rcpf(l2 + __shfl_xor(l2, 32)); float ss = 0.f;
#pragma unroll
                  for (int db = 0; db < 4; ++db)
#pragma unroll
                      for (int r = 0; r < 16; ++r) { const unsigned w = o1s[(db * 8 + (r >> 1)) * 64]; const float a1 = __uint_as_float((r & 1) ? (w & 0xffff0000u) : (w << 16));
                          const float v = a1 - inv * o2[db][r]; o2[db][r] = v; ss += v * v; }
                  ss += __shfl_xor(ss, 32);
                  const float rs = __builtin_amdgcn_rsqf(ss * (1.0f / 128.0f) + 1e-6f) * one_m_li;
                  const float* gn = a.diff_norm + e * 128;
#pragma unroll
                  for (int db = 0; db < 4; ++db)
#pragma unroll
                      for (int rg = 0; rg < 4; ++rg) { const f32x4 gv = *(const f32x4*)(gn + 32 * db + 8 * rg + 4 * hi);
#pragma unroll
                          for (int k = 0; k < 4; ++k) o2[db][4 * rg + k] *= rs * gv[k]; } }
                att::store_ot<128>(o2, ao + ((size_t)b * SEQ + t) * DM + 512 + h * 128, hi);
            }
#endif
#if PH_SWA
            for (int rep_ = 0; rep_ < REP_SWA; ++rep_)
            for (int uidx = bx; uidx < 2048; uidx += G) {
                const int qb = uidx & 15, qh = (uidx >> 4) & 7, b = uidx >> 7, kvh = qh >> 2;
                if (tid < 128) btab[tid] = a.rel_bias[T5B[tid] * 12 + qh] * att::LOG2E;
                const bf16* base = proj + (size_t)b * SEQ * EVEN_IN;
                const int q0 = qb * 256, t = q0 + 32 * wave + l32;
                const int kt0 = (qb * 4 - 2 > 0) ? qb * 4 - 2 : 0, nt = qb * 4 + 4 - kt0;
                att::f32x16 o[2]; float m, l;
                att::attn_core<2, 64>(base + qh * 64, base + 512 + kvh * 64, base + 640 + kvh * 64, EVEN_IN, q0, kt0, nt, 1, lds, o, m, l);
                const float sk = a.sinks[e * 8 + qh] * att::LOG2E;
                const float inv = __builtin_amdgcn_rcpf(l + __shfl_xor(l, 32) + __builtin_amdgcn_exp2f(sk - m));
#pragma unroll
                for (int db = 0; db < 2; ++db)
#pragma unroll
                    for (int r = 0; r < 16; ++r) o[db][r] *= inv;
                att::store_ot<64>(o, ao + ((size_t)b * SEQ + t) * DM + qh * 64, hi);
            }
#endif
        } else {
#if PH_SB
            int tq = threadIdx.x; asm volatile("" : "+v"(tq)); const int lane = tq & 63, l32 = lane & 31, hi = lane >> 5;
            for (int rep_ = 0; rep_ < REP_SB; ++rep_)
            for (int uidx = bx; uidx < 4096; uidx += G) {
                const int bh = uidx & 255, qb = 15 - (uidx >> 8), b = bh >> 4, h = bh & 15;
                const bf16* base = proj + (size_t)b * SEQ * ODD_IN;
                const int q0 = qb * 256, nt = 4 * qb + 4, t = q0 + 32 * wave + l32;
                att::f32x16 o[2]; float P, dummy;
                att::attn_core<0, 64>(base + h * 64, base + 1024 + h * 64, base + 2048 + h * 64, ODD_IN, q0, nt - 1, nt, -1, lds, o, P, dummy);
                att::store_ot<64>(o, ao + ((size_t)b * SEQ + t) * DM + h * 64, hi);
            }
#endif
        }
        grid.sync();
        {
            const bf16* wt = even ? (const bf16*)(ws + WS_WOUTE) + (size_t)e * DM * DM : (const bf16*)(ws + WS_WOUTO) + (size_t)e * DM * DM;
            pg8::Gemm g{ao, wt, MTOK, DM, DM}; pg8::StaticOrder S; S.init(MTOK, DM, G, bx);
            pg8::EpiResid E{xold, a.out, xb, ssq};
            pg8::gemm_phase<pg8::EpiResid, pg8::StaticOrder, true, true>(lds, g, S, E);
        }
        grid.sync();
        const bf16* wup = (const bf16*)(ws + WS_WUP) + (size_t)layer * DUP * DM;
        const bf16* wdn = (const bf16*)(ws + WS_WDN) + (size_t)layer * DM * DFF;
        for (int half = 0; half < 2; ++half) {
            const size_t r0 = (size_t)half * HALF_ROWS;
            {
                pg8::Gemm g{xb + r0 * DM, wup, HALF_ROWS, DUP, DM}; pg8::StaticOrder S; S.init(HALF_ROWS, DUP, G, bx);
                pg8::EpiScaleBf16 E{ubuf, DUP, ssq + r0 * 16};
                for (int rep_ = 0; rep_ < REP_UP; ++rep_)
                pg8::gemm_phase<pg8::EpiScaleBf16, pg8::StaticOrder, true, true>(lds, g, S, E);
            }
            grid.sync();
#if PH_CONV
            {
                const float* cw = a.ffn_conv + (size_t)layer * 3 * DUP; const float* cb = a.ffn_conv_b + (size_t)layer * DUP;
                constexpr int NCC = 6, NRC = HALF_ROWS / 32;
                int tq = threadIdx.x; asm volatile("" : "+v"(tq)); const int lane = tq & 63;
                for (int rep_ = 0; rep_ < REP_CONV; ++rep_)
                for (int it = gw; it < NCC * NRC; it += NGW) {
                    const int cc = it % NCC, rc = it / NCC, cgp = cc * 64 + lane;
                    if (cgp < DFF / 8) {
                        const int col = cgp * 8, row0 = rc * 32;
                        float wg[3][8], wv[3][8], bg[8], bv[8];
#pragma unroll
                        for (int tp = 0; tp < 3; ++tp)
#pragma unroll
                            for (int k = 0; k < 8; k += 4) { const f32x4 t1 = *(const f32x4*)(cw + tp * DUP + col + k), t2 = *(const f32x4*)(cw + tp * DUP + DFF + col + k);
#pragma unroll
                                for (int q = 0; q < 4; ++q) { wg[tp][k + q] = t1[q]; wv[tp][k + q] = t2[q]; } }
#pragma unroll
                        for (int k = 0; k < 8; k += 4) { const f32x4 t1 = *(const f32x4*)(cb + col + k), t2 = *(const f32x4*)(cb + DFF + col + k);
#pragma unroll
                            for (int q = 0; q < 4; ++q) { bg[k + q] = t1[q]; bv[k + q] = t2[q]; } }
                        float g2[8], g1[8], v2[8], v1[8];
                        const bool head = (row0 % SEQ) == 0;
                        {
                            v4u a2 = {0, 0, 0, 0}, a1 = {0, 0, 0, 0}, c2 = {0, 0, 0, 0}, c1 = {0, 0, 0, 0};
                            if (!head) { const bf16* up = ubuf + (size_t)(row0 - 2) * DUP + col; a2 = *(const v4u*)up; c2 = *(const v4u*)(up + DFF); a1 = *(const v4u*)(up + DUP); c1 = *(const v4u*)(up + DUP + DFF); }
#pragma unroll
                            for (int k = 0; k < 8; ++k) { const int sh = (k & 1) * 16;
                                g2[k] = __uint_as_float(((a2[k >> 1] >> sh) & 0xffffu) << 16); g1[k] = __uint_as_float(((a1[k >> 1] >> sh) & 0xffffu) << 16);
                                v2[k] = __uint_as_float(((c2[k >> 1] >> sh) & 0xffffu) << 16); v1[k] = __uint_as_float(((c1[k >> 1] >> sh) & 0xffffu) << 16); }
                        }
                        for (int r = 0; r < 32; ++r) {
                            const bf16* up = ubuf + (size_t)(row0 + r) * DUP + col;
                            const v4u a0 = *(const v4u*)up, c0 = *(const v4u*)(up + DFF);
                            float res[8];
#pragma unroll
                            for (int k = 0; k < 8; ++k) { const int sh = (k & 1) * 16;
                                const float g0 = __uint_as_float(((a0[k >> 1] >> sh) & 0xffffu) << 16), v0 = __uint_as_float(((c0[k >> 1] >> sh) & 0xffffu) << 16);
                                const float gg = bg[k] + wg[0][k] * g2[k] + wg[1][k] * g1[k] + wg[2][k] * g0;
                                const float vv = bv[k] + wv[0][k] * v2[k] + wv[1][k] * v1[k] + wv[2][k] * v0;
                                const float sg = gg * __builtin_amdgcn_rcpf(1.0f + __builtin_amdgcn_exp2f(-gg * att::LOG2E));
                                res[k] = sg * vv; g2[k] = g1[k]; g1[k] = g0; v2[k] = v1[k]; v1[k] = v0; }
                            v4u w; w.x = pk2(res[0], res[1]); w.y = pk2(res[2], res[3]); w.z = pk2(res[4], res[5]); w.w = pk2(res[6], res[7]);
                            *(v4u*)(gbuf + (size_t)(row0 + r) * DFF + col) = w;
                        }
                    }
                }
            }
#endif
            grid.sync();
            {
                pg8::Gemm g{gbuf, wdn, HALF_ROWS, DM, DFF}; pg8::StaticOrder S; S.init(HALF_ROWS, DM, G, bx);
                pg8::EpiResid E{a.out + r0 * DM, a.out + r0 * DM, xb + r0 * DM, ssq + r0 * 16};
                pg8::gemm_phase<pg8::EpiResid, pg8::StaticOrder, true, true>(lds, g, S, E);
            }
            if (half == 1) grid.sync();
        }
    }
    { int tq = threadIdx.x; asm volatile("" : "+v"(tq)); const int lane = tq & 63;
    for (int m = gw; m < MTOK; m += NGW) {
        f32x4* xr = (f32x4*)(a.out + (size_t)m * DM) + lane; f32x4 v[4]; float s = 0.f;
#pragma unroll
        for (int j = 0; j < 4; ++j) { v[j] = xr[64 * j]; s += (v[j][0] * v[j][0] + v[j][1] * v[j][1]) + (v[j][2] * v[j][2] + v[j][3] * v[j][3]); }
        s = wave_sum(s);
        const float rs = __builtin_amdgcn_rsqf(s * (1.0f / DM) + 1e-6f);
#pragma unroll
        for (int j = 0; j < 4; ++j) { const f32x4 gv = *((const f32x4*)a.norm_final + lane + 64 * j); xr[64 * j] = v[j] * rs * gv; }
    } }
}

extern "C" void kernel_launch(void* const* d_in, const int* in_sizes, int n_in, void* d_out, int out_size, void* d_ws, size_t ws_size, hipStream_t stream) {
    static int grid = 0;
    if (grid == 0) {
        int dev = 0, cus = 0, per_cu = 0;
        (void)hipGetDevice(&dev);
        (void)hipDeviceGetAttribute(&cus, hipDeviceAttributeMultiprocessorCount, dev);
        (void)hipFuncSetAttribute((const void*)mega_fwd, hipFuncAttributeMaxDynamicSharedMemorySize, LDS_BYTES);
        (void)hipOccupancyMaxActiveBlocksPerMultiprocessor(&per_cu, (const void*)mega_fwd, NWAVES * 64, LDS_BYTES);
        if (per_cu < 1) per_cu = 1;
        grid = cus * per_cu;
        if (n_in != 19 || ws_size < 1024 * MiB) fprintf(stderr, "kernel_launch: unexpected n_in %d / ws %zu\n", n_in, ws_size);
    }
    Args a{};
    a.x = (const float*)d_in[0]; a.rel_bias = (const float*)d_in[1]; a.norm_mix = (const float*)d_in[2]; a.norm_ffn = (const float*)d_in[3]; a.norm_final = (const float*)d_in[4];
    a.w_in_even = (const float*)d_in[5]; a.w_out_even = (const float*)d_in[6]; a.sinks = (const float*)d_in[7]; a.lam_q1 = (const float*)d_in[8]; a.lam_k1 = (const float*)d_in[9];
    a.lam_q2 = (const float*)d_in[10]; a.lam_k2 = (const float*)d_in[11]; a.diff_norm = (const float*)d_in[12]; a.w_in_odd = (const float*)d_in[13]; a.w_out_odd = (const float*)d_in[14];
    a.ffn_up = (const float*)d_in[15]; a.ffn_conv = (const float*)d_in[16]; a.ffn_conv_b = (const float*)d_in[17]; a.ffn_down = (const float*)d_in[18];
    a.out = (float*)d_out; a.ws = (unsigned char*)d_ws;
    void* args[] = {&a};
    hipError_t err = hipLaunchCooperativeKernel((const void*)mega_fwd, dim3(grid), dim3(NWAVES * 64), args, LDS_BYTES, stream);
    if (err != hipSuccess) fprintf(stderr, "kernel_launch: cooperative launch failed: %s (grid %d)\n", hipGetErrorString(err), grid);
}
```

```cpp
#include <hip/hip_runtime.h>
#include <hip/hip_cooperative_groups.h>
#include <cstdio>
#include <cstdint>
namespace cg = cooperative_groups;
namespace pg8 {
#define PG8_LAS __attribute__((address_space(3)))
typedef unsigned short bf16_t;
typedef short bf16x8 __attribute__((ext_vector_type(8)));
typedef float f32x4 __attribute__((ext_vector_type(4)));
typedef unsigned u32x4 __attribute__((ext_vector_type(4)));
constexpr int BM = 256, BK = 64, HALF = 128, HTB = HALF * BK * 2  , STAGE_BYTES = 8 * HTB, NXCD = 8, WGM = 8;

__host__ __device__ __forceinline__ int lds_byte(int r, int c) { const int st = (r >> 4) * 2 + (c >> 5), rr = r & 15, cc = c & 31, ob = rr * 64 + cc * 2; return st * 1024 + (ob ^ (((ob >> 9) & 1) << 5)); }
__host__ __device__ __forceinline__ void stage_rc(int b, int& R, int& C) { const int st = b / 1024, sb = b % 1024, swz = sb ^ (((sb >> 9) & 1) << 5); R = (st >> 1) * 16 + swz / 64; C = (st & 1) * 32 + (swz % 64) / 2; }
__host__ __device__ __forceinline__ int perm32(int rho) { const int n = rho >> 4, i = rho & 15; return 8 * (i >> 2) + 4 * n + (i & 3); }

struct Unit { int pm, pn; };
struct Gemm { const bf16_t* A; const bf16_t* Bt; int M, N, K; };

struct StaticOrder {
    int nM, nN, nwg, G, c;
    __host__ __device__ void init(int M, int N, int G_, int c_) { nM = M / BM; nN = N / BM; nwg = nM * nN; G = G_; c = c_; }
    __host__ __device__ bool next(int i, Unit& u) const {
        const long L = (long)i * G + c; if (L >= nwg) return false;
        int wgid = (int)L; { const int q = nwg / NXCD, r = nwg % NXCD, xcd = wgid % NXCD, off = wgid / NXCD; wgid = (xcd < r ? xcd * (q + 1) : r * (q + 1) + (xcd - r) * q) + off; }
        const int nig = WGM * nN, gid = wgid / nig, fm = gid * WGM, gsz = (nM - fm) < WGM ? (nM - fm) : WGM;
        u.pm = fm + ((wgid % nig) % gsz); u.pn = (wgid % nig) / gsz; return true;
    }
    __device__ __forceinline__ void a_ready(const Unit&) const {}
    __device__ __forceinline__ void done(const Unit&) const {}
};

__device__ __forceinline__ unsigned cvt_pk_bf16(float lo, float hi) { unsigned r; asm volatile("v_cvt_pk_bf16_f32 %0, %1, %2" : "=v"(r) : "v"(lo), "v"(hi)); return r; }
typedef float f32x2 __attribute__((ext_vector_type(2)));
typedef unsigned u32x2 __attribute__((ext_vector_type(2)));
constexpr float RMS_EPS = 1e-6f;
struct EpiScaleBf16 {
    static constexpr bool PERM = true, AFTER_DRAIN = false;
    bf16_t* O; int ldc; const float* ssq;
    __device__ __forceinline__ void operator()(const f32x4 (&acc)[2][2][4][2], const Unit& u, int wr, int wc, int fr, int fq) const {
        const int row0 = u.pm * BM + wr * 64 + fr, col0 = u.pn * BM + wc * 32 + 8 * fq;
        f32x4 part[2][4];
#pragma unroll
        for (int ai = 0; ai < 2; ++ai)
#pragma unroll
            for (int m = 0; m < 4; ++m) part[ai][m] = *(const f32x4*)(ssq + (size_t)(row0 + ai * HALF + m * 16) * 16 + fq * 4);
#pragma unroll
        for (int ai = 0; ai < 2; ++ai)
#pragma unroll
            for (int m = 0; m < 4; ++m) { const int row = row0 + ai * HALF + m * 16; bf16_t* rowp = O + (size_t)row * ldc + col0;
                float t = (part[ai][m][0] + part[ai][m][1]) + (part[ai][m][2] + part[ai][m][3]);
                t += __shfl_xor(t, 16); t += __shfl_xor(t, 32);
                const float rs = __builtin_amdgcn_rsqf(t * (1.0f / 1024.0f) + RMS_EPS);
#pragma unroll
                for (int bj = 0; bj < 2; ++bj) { const f32x4 v0 = acc[ai][bj][m][0] * rs, v1 = acc[ai][bj][m][1] * rs;
                    u32x4 w; w.x = cvt_pk_bf16(v0[0], v0[1]); w.y = cvt_pk_bf16(v0[2], v0[3]); w.z = cvt_pk_bf16(v1[0], v1[1]); w.w = cvt_pk_bf16(v1[2], v1[3]);
                    *(u32x4*)(rowp + bj * HALF) = w; } }
    }
};
struct EpiResid {
    static constexpr bool PERM = false, AFTER_DRAIN = false;
    const float* base; float* out; bf16_t* xb; float* ssq;
    __device__ __forceinline__ void operator()(const f32x4 (&acc)[2][2][4][2], const Unit& u, int wr, int wc, int fr, int fq) const {
        const int col0 = u.pn * BM + wc * 32 + 4 * fq;
        const size_t off0 = (size_t)(u.pm * BM + wr * 64 + fr) * 1024 + col0;
        f32x4 nx[2][2];
#pragma unroll
        for (int bj = 0; bj < 2; ++bj)
#pragma unroll
            for (int n = 0; n < 2; ++n) nx[bj][n] = *(const f32x4*)(base + off0 + bj * HALF + n * 16);
#pragma unroll
        for (int g = 0; g < 8; ++g) { const int ai = g >> 2, m = g & 3; const int row = u.pm * BM + ai * HALF + wr * 64 + m * 16 + fr; const size_t off = (size_t)row * 1024 + col0; float q = 0.f;
            f32x4 cu[2][2];
#pragma unroll
            for (int bj = 0; bj < 2; ++bj)
#pragma unroll
                for (int n = 0; n < 2; ++n) cu[bj][n] = nx[bj][n];
            if (g < 7) { const size_t offn = off0 + (size_t)(((g + 1) >> 2) * HALF + ((g + 1) & 3) * 16) * 1024;
#pragma unroll
                for (int bj = 0; bj < 2; ++bj)
#pragma unroll
                    for (int n = 0; n < 2; ++n) nx[bj][n] = *(const f32x4*)(base + offn + bj * HALF + n * 16); }
#pragma unroll
            for (int bj = 0; bj < 2; ++bj)
#pragma unroll
                for (int n = 0; n < 2; ++n) { const f32x4 o = cu[bj][n] + acc[ai][bj][m][n];
                    *(f32x4*)(out + off + bj * HALF + n * 16) = o; q += (o[0] * o[0] + o[1] * o[1]) + (o[2] * o[2] + o[3] * o[3]);
                    u32x2 w; w.x = cvt_pk_bf16(o[0], o[1]); w.y = cvt_pk_bf16(o[2], o[3]); *(u32x2*)(xb + off + bj * HALF + n * 16) = w; }
            q += __shfl_xor(q, 16); q += __shfl_xor(q, 32);
            if (fq == 0) ssq[(size_t)row * 16 + u.pn * 4 + wc] = q;
            asm volatile("" ::: "memory"); }
    }
};
template <class Epi, class Sched, bool ALIGN_EPI = false, bool SP2 = false>
__device__ __forceinline__ void gemm_phase(PG8_LAS unsigned char* lds, const Gemm g, const Sched& S, const Epi& E) {
    int tid_ = threadIdx.x; asm volatile("" : "+v"(tid_));
    const int tid = tid_, wid = __builtin_amdgcn_readfirstlane(tid >> 6), lane = tid & 63, wr = wid >> 2, wc = wid & 3, fr = lane & 15, fq = lane >> 4;
    const int K = g.K, nt = K / BK;
    unsigned voffA[2], voffB[2];
#pragma unroll
    for (int i = 0; i < 2; ++i) { int R, C; stage_rc(tid * 16 + i * 8192, R, C); const int Rb = Epi::PERM ? ((R & ~31) + perm32(R & 31)) : R;
        voffA[i] = (unsigned)(R * K + C) * 2u; voffB[i] = (unsigned)(Rb * K + C) * 2u; }
    const size_t kstep = (size_t)(BK * 2);
    const size_t hstep = (size_t)HALF * K * 2;
    const size_t tstep = 2 * hstep;
    const unsigned ldsw = (unsigned)wid * 1024u;
    const int aoff = lds_byte(wr * 64 + fr, fq * 8), boff = lds_byte(wc * 32 + fr, fq * 8);
#define PG8_SA(b, h) (((b) * 2 + (h)) * HTB)
#define PG8_SB(b, h) ((4 + (b) * 2 + (h)) * HTB)
#define PG8_STAGE(bufoff, gbase, voff) do { _Pragma("unroll") for (int _i = 0; _i < 2; ++_i) \
        __builtin_amdgcn_global_load_lds((const unsigned*)((const char*)(gbase) + (voff)[_i]), (PG8_LAS unsigned*)(lds + (bufoff) + ldsw + _i * 8192), 16, 0, 0); } while (0)
#define PG8_LDA(dst, b, h) do { _Pragma("unroll") for (int m = 0; m < 4; ++m) _Pragma("unroll") for (int k = 0; k < 2; ++k) dst[m][k] = *(const PG8_LAS bf16x8*)(lds + PG8_SA(b, h) + aoff + m * 2048 + k * 1024); } while (0)
#define PG8_LDB(dst, b, h) do { _Pragma("unroll") for (int n = 0; n < 2; ++n) _Pragma("unroll") for (int k = 0; k < 2; ++k) dst[n][k] = *(const PG8_LAS bf16x8*)(lds + PG8_SB(b, h) + boff + n * 2048 + k * 1024); } while (0)
#define PG8_MMA(ai, bj, At, Bt) do { __builtin_amdgcn_s_setprio(1); _Pragma("unroll") for (int m = 0; m < 4; ++m) _Pragma("unroll") for (int n = 0; n < 2; ++n) _Pragma("unroll") for (int k = 0; k < 2; ++k) \
        acc[ai][bj][m][n] = __builtin_amdgcn_mfma_f32_16x16x32_bf16(Bt[n][k], At[m][k], acc[ai][bj][m][n], 0, 0, 0); __builtin_amdgcn_s_setprio(0); } while (0)
#define PG8_WAIT_V(n) asm volatile("s_waitcnt vmcnt(" #n ")" ::: "memory")
#define PG8_WAIT_L(n) asm volatile("s_waitcnt lgkmcnt(" #n ")" ::: "memory")
#define PG8_BAR __builtin_amdgcn_s_barrier()
#define PG8_SCHED __builtin_amdgcn_sched_barrier(0)
    Unit cur, nxt; int ui = 0;
    if (!S.next(0, cur)) return;
    f32x4 acc[2][2][4][2];
#pragma unroll
    for (int a = 0; a < 2; ++a)
#pragma unroll
        for (int b = 0; b < 2; ++b)
#pragma unroll
            for (int m = 0; m < 4; ++m)
#pragma unroll
                for (int n = 0; n < 2; ++n) acc[a][b][m][n] = (f32x4){0.f, 0.f, 0.f, 0.f};
    bf16x8 At[4][2], B0[2][2], B1[2][2];
    const char* cA = (const char*)g.A + (size_t)cur.pm * tstep; const char* cB = (const char*)g.Bt + (size_t)cur.pn * tstep;
    S.a_ready(cur);
    if constexpr (SP2) {
        PG8_STAGE(PG8_SB(0, 0), cB, voffB); PG8_STAGE(PG8_SB(0, 1), cB + hstep, voffB); PG8_STAGE(PG8_SA(0, 0), cA, voffA); PG8_STAGE(PG8_SA(0, 1), cA + hstep, voffA);
        if (wr == 1) PG8_BAR;
        PG8_WAIT_V(2); PG8_BAR;
        PG8_STAGE(PG8_SB(1, 0), cB + kstep, voffB); PG8_STAGE(PG8_SA(1, 0), cA + kstep, voffA); PG8_STAGE(PG8_SB(1, 1), cB + hstep + kstep, voffB);
        PG8_WAIT_V(6); PG8_BAR;
    } else {
        PG8_STAGE(PG8_SB(0, 0), cB, voffB); PG8_STAGE(PG8_SA(0, 0), cA, voffA); PG8_STAGE(PG8_SB(0, 1), cB + hstep, voffB); PG8_STAGE(PG8_SA(0, 1), cA + hstep, voffA);
        if (wr == 1) PG8_BAR;
        PG8_WAIT_V(4); PG8_BAR;
        PG8_STAGE(PG8_SB(1, 0), cB + kstep, voffB); PG8_STAGE(PG8_SA(1, 0), cA + kstep, voffA); PG8_STAGE(PG8_SB(1, 1), cB + hstep + kstep, voffB);
        PG8_WAIT_V(6); PG8_BAR;
    }
    for (;;) {
        const bool has_next = S.next(ui + 1, nxt);
        const char* nA = has_next ? (const char*)g.A + (size_t)nxt.pm * tstep : cA; const char* nB = has_next ? (const char*)g.Bt + (size_t)nxt.pn * tstep : cB;
        for (int t = 0; t < nt; t += 2) {
            const bool last = (t == nt - 2);
            const char* a1 = cA + (size_t)(t + 1) * kstep;
            const char* a2 = last ? nA : cA + (size_t)(t + 2) * kstep; const char* b2 = last ? nB : cB + (size_t)(t + 2) * kstep;
            const char* a3 = a2 + kstep; const char* b3 = b2 + kstep;
            if (last && has_next) S.a_ready(nxt);
            if constexpr (SP2) {
            PG8_LDB(B0, 0, 0); PG8_LDB(B1, 0, 1); PG8_SCHED; PG8_LDA(At, 0, 0); PG8_STAGE(PG8_SA(1, 1), a1 + hstep, voffA);
            PG8_WAIT_V(8); PG8_WAIT_L(0); PG8_BAR; PG8_MMA(0, 0, At, B0); PG8_MMA(0, 1, At, B1); PG8_BAR; PG8_SCHED;
            PG8_LDA(At, 0, 1); PG8_STAGE(PG8_SB(0, 0), b2, voffB); PG8_STAGE(PG8_SB(0, 1), b2 + hstep, voffB); PG8_STAGE(PG8_SA(0, 0), a2, voffA);
            PG8_WAIT_V(8); PG8_WAIT_L(0); PG8_BAR; PG8_MMA(1, 0, At, B0); PG8_MMA(1, 1, At, B1); PG8_BAR; PG8_SCHED;
            PG8_LDB(B0, 1, 0); PG8_LDB(B1, 1, 1); PG8_SCHED; PG8_LDA(At, 1, 0); PG8_STAGE(PG8_SA(0, 1), a2 + hstep, voffA);
            PG8_WAIT_V(8); PG8_WAIT_L(0); PG8_BAR; PG8_MMA(0, 0, At, B0); PG8_MMA(0, 1, At, B1); PG8_BAR; PG8_SCHED;
            PG8_LDA(At, 1, 1); PG8_STAGE(PG8_SB(1, 0), b3, voffB); PG8_STAGE(PG8_SB(1, 1), b3 + hstep, voffB); PG8_STAGE(PG8_SA(1, 0), a3, voffA);
            PG8_WAIT_V(8); PG8_WAIT_L(0); PG8_BAR; PG8_MMA(1, 0, At, B0); PG8_MMA(1, 1, At, B1); PG8_BAR; PG8_SCHED;
            } else {
            PG8_LDB(B0, 0, 0); PG8_SCHED; PG8_LDA(At, 0, 0); PG8_STAGE(PG8_SA(1, 1), a1 + hstep, voffA);
            PG8_WAIT_L(8); PG8_BAR; PG8_WAIT_L(0); PG8_MMA(0, 0, At, B0); PG8_BAR; PG8_SCHED;
            PG8_LDB(B1, 0, 1); PG8_STAGE(PG8_SB(0, 0), b2, voffB);
            PG8_BAR; PG8_WAIT_L(0); PG8_MMA(0, 1, At, B1); PG8_BAR;
            PG8_LDA(At, 0, 1); PG8_STAGE(PG8_SA(0, 0), a2, voffA);
            PG8_BAR; PG8_WAIT_L(0); PG8_MMA(1, 0, At, B0); PG8_BAR; PG8_SCHED;
            PG8_STAGE(PG8_SB(0, 1), b2 + hstep, voffB);
            PG8_WAIT_V(6); PG8_BAR; PG8_MMA(1, 1, At, B1); PG8_BAR;
            PG8_LDB(B0, 1, 0); PG8_SCHED; PG8_LDA(At, 1, 0); PG8_STAGE(PG8_SA(0, 1), a2 + hstep, voffA);
            PG8_WAIT_L(8); PG8_BAR; PG8_WAIT_L(0); PG8_MMA(0, 0, At, B0); PG8_BAR; PG8_SCHED;
            PG8_LDB(B1, 1, 1); PG8_STAGE(PG8_SB(1, 0), b3, voffB);
            PG8_BAR; PG8_WAIT_L(0); PG8_MMA(0, 1, At, B1); PG8_BAR;
            PG8_LDA(At, 1, 1); PG8_STAGE(PG8_SA(1, 0), a3, voffA);
            PG8_BAR; PG8_WAIT_L(0); PG8_MMA(1, 0, At, B0); PG8_BAR; PG8_SCHED;
            PG8_STAGE(PG8_SB(1, 1), b3 + hstep, voffB);
            PG8_WAIT_V(6); PG8_BAR; PG8_MMA(1, 1, At, B1); PG8_BAR;
            }
        }
        if constexpr (ALIGN_EPI) { if (wr == 0) PG8_BAR; }
        if constexpr (!Epi::AFTER_DRAIN) { E(acc, cur, wr, wc, fr, fq); S.done(cur); }
        if (!has_next) break;
#pragma unroll
        for (int a = 0; a < 2; ++a)
#pragma unroll
            for (int b = 0; b < 2; ++b)
#pragma unroll
                for (int m = 0; m < 4; ++m)
#pragma unroll
                    for (int n = 0; n < 2; ++n) acc[a][b][m][n] = (f32x4){0.f, 0.f, 0.f, 0.f};
        cur = nxt; cA = nA; cB = nB; ++ui;
        if constexpr (ALIGN_EPI) { if (wr == 1) PG8_BAR; }
    }
    PG8_WAIT_V(0);
    if constexpr (!ALIGN_EPI) { if (wr == 0) PG8_BAR; }
    PG8_BAR;
    if constexpr (Epi::AFTER_DRAIN) { E.fused(acc, cur, wr, wc, fr, fq, lds, wid, lane); S.done(cur); }
#undef PG8_SA
#undef PG8_SB
#undef PG8_STAGE
#undef PG8_LDA
#undef PG8_LDB
#undef PG8_MMA
#undef PG8_WAIT_V
#undef PG8_WAIT_L
#undef PG8_BAR
#undef PG8_SCHED
}
}
namespace att {
#define ALAS __attribute__((address_space(3)))
typedef unsigned short bf16_t;
typedef short bf16x8 __attribute__((ext_vector_type(8)));
typedef float f32x16 __attribute__((ext_vector_type(16)));
typedef float f32x4 __attribute__((ext_vector_type(4)));
typedef unsigned u32x4 __attribute__((ext_vector_type(4)));
typedef unsigned u32x2 __attribute__((ext_vector_type(2)));
constexpr int KROW = 144;
constexpr int KBUF = 64 * KROW;
constexpr int VBUF = 128 * KROW;
constexpr int L_K = 0, L_V = 2 * KBUF, L_BT = L_V + 2 * VBUF, L_END = L_BT + 512;
constexpr float LOG2E = 1.4426950408889634f;
constexpr float QSCALE = 0.125f * 1.4426950408889634f;
#define CR(r) (((r) & 3) + 8 * ((r) >> 2))
__device__ __forceinline__ unsigned cvtpk(float lo, float hi) { unsigned r; asm volatile("v_cvt_pk_bf16_f32 %0, %1, %2" : "=v"(r) : "v"(lo), "v"(hi)); return r; }
__device__ __forceinline__ float ex2(float x) { return __builtin_amdgcn_exp2f(x); }
__device__ __forceinline__ float rcpf_(float x) { return __builtin_amdgcn_rcpf(x); }

template <int DV> struct Pref { u32x4 k; u32x4 v[DV / 64]; };

template <int DV> __device__ __forceinline__ void tile_load(Pref<DV>& pf, const bf16_t* Kp, const bf16_t* Vp, int pitch, int kt, int tid) {
    const int krow = tid >> 3, kc = (tid & 7) * 8;
    pf.k = *(const u32x4*)(Kp + (size_t)(kt * 64 + krow) * pitch + kc);
#pragma unroll
    for (int i = 0; i < DV / 64; ++i) { const int vrow = tid & 63, vc = ((tid >> 6) + 8 * i) * 8;
        pf.v[i] = *(const u32x4*)(Vp + (size_t)(kt * 64 + vrow) * pitch + vc); }
}
template <int DV> __device__ __forceinline__ void tile_store(const Pref<DV>& pf, ALAS unsigned char* kbuf, ALAS unsigned char* vbuf, int tid) {
    const int krow = tid >> 3, kc = (tid & 7) * 8;
    *(ALAS u32x4*)(kbuf + krow * KROW + kc * 2) = pf.k;
#pragma unroll
    for (int i = 0; i < DV / 64; ++i) { const int vrow = tid & 63, vc = ((tid >> 6) + 8 * i) * 8;
        const int kk = vrow & 15, pos = (vrow & ~15) + 8 * ((kk >> 2) & 1) + (kk & 3) + 4 * (kk >> 3);
        ALAS unsigned char* d = vbuf + vc * KROW + pos * 2;
#pragma unroll
        for (int j = 0; j < 8; ++j) { const unsigned w = pf.v[i][j >> 1]; *(ALAS unsigned short*)(d + j * KROW) = (unsigned short)((j & 1) ? (w >> 16) : (w & 0xffffu)); } }
}

template <int DV> __device__ __forceinline__ void pv_slab(const ALAS unsigned char* vbuf, int s, u32x4 w, f32x16 (&o)[DV / 32], int l32, int hi) {
    const bf16x8 pfr = __builtin_bit_cast(bf16x8, w);
#pragma unroll
    for (int db = 0; db < DV / 32; ++db) {
        const bf16x8 vf = *(const ALAS bf16x8*)(vbuf + (db * 32 + l32) * KROW + s * 32 + hi * 16);
        o[db] = __builtin_amdgcn_mfma_f32_32x32x16_bf16(vf, pfr, o[db], 0, 0, 0); }
    if (DV > 64) __builtin_amdgcn_sched_barrier(0);
}

template <int MODE, int DV, bool MASKED>
__device__ __forceinline__ void tile_compute(const ALAS unsigned char* kbuf, const ALAS unsigned char* vbuf, const bf16x8 (&qf)[4], f32x16 (&o)[DV / 32],
                                             float& st_m, float& st_l, int lim, const ALAS float* btab, float cbias, int lane) {
    const int l32 = lane & 31, hi = lane >> 5;
    if constexpr (MODE == 0) {
        f32x16 p0, p1;
#pragma unroll
        for (int r = 0; r < 16; ++r) { p0[r] = 0.f; p1[r] = 0.f; }
        { const ALAS unsigned char* kb = kbuf + l32 * KROW + hi * 16;
#pragma unroll
          for (int d0 = 0; d0 < 4; ++d0) {
              const bf16x8 k0 = *(const ALAS bf16x8*)(kb + d0 * 32);
              const bf16x8 k1 = *(const ALAS bf16x8*)(kb + 32 * KROW + d0 * 32);
              p0 = __builtin_amdgcn_mfma_f32_32x32x16_bf16(k0, qf[d0], p0, 0, 0, 0);
              p1 = __builtin_amdgcn_mfma_f32_32x32x16_bf16(k1, qf[d0], p1, 0, 0, 0); } }
        __builtin_amdgcn_sched_barrier(0);
#pragma unroll
        for (int r = 0; r < 16; ++r) {
            float a = rcpf_(1.0f + ex2(p0[r])), b = rcpf_(1.0f + ex2(p1[r]));
            if (MASKED) { a = (CR(r) < lim) ? a : 1.0f; b = (CR(r) + 32 < lim) ? b : 1.0f; }
            p0[r] = a; p1[r] = b; }
        float g[8], hs[8], pr[8];
#pragma unroll
        for (int i = 0; i < 4; ++i) { g[i] = (p0[4 * i] * p0[4 * i + 1]) * (p0[4 * i + 2] * p0[4 * i + 3]); g[4 + i] = (p1[4 * i] * p1[4 * i + 1]) * (p1[4 * i + 2] * p1[4 * i + 3]); }
#pragma unroll
        for (int i = 0; i < 8; ++i) { const float h = __shfl_xor(g[i], 32); pr[i] = g[i] * h; hs[i] = hi ? 1.0f : h; }
        float T = st_m;
#pragma unroll
        for (int i = 7; i >= 0; --i) {
            float R = hs[i] * T; T = T * pr[i];
            if (i >= 4) { const int b = 4 * (i - 4);
                float R2 = R * p1[b + 3]; p1[b + 3] = R - R2; float R1 = R2 * p1[b + 2]; p1[b + 2] = R2 - R1; float R0 = R1 * p1[b + 1]; p1[b + 1] = R1 - R0; p1[b] = R0 - R0 * p1[b]; }
            else { const int b = 4 * i;
                float R2 = R * p0[b + 3]; p0[b + 3] = R - R2; float R1 = R2 * p0[b + 2]; p0[b + 2] = R2 - R1; float R0 = R1 * p0[b + 1]; p0[b + 1] = R1 - R0; p0[b] = R0 - R0 * p0[b]; }
        }
        st_m = T;
        __builtin_amdgcn_sched_barrier(0);
#pragma unroll
        for (int s = 0; s < 4; ++s) {
            u32x4 w;
            if (s == 0) { w.x = cvtpk(p0[0], p0[1]); w.y = cvtpk(p0[2], p0[3]); w.z = cvtpk(p0[4], p0[5]); w.w = cvtpk(p0[6], p0[7]); }
            else if (s == 1) { w.x = cvtpk(p0[8], p0[9]); w.y = cvtpk(p0[10], p0[11]); w.z = cvtpk(p0[12], p0[13]); w.w = cvtpk(p0[14], p0[15]); }
            else if (s == 2) { w.x = cvtpk(p1[0], p1[1]); w.y = cvtpk(p1[2], p1[3]); w.z = cvtpk(p1[4], p1[5]); w.w = cvtpk(p1[6], p1[7]); }
            else { w.x = cvtpk(p1[8], p1[9]); w.y = cvtpk(p1[10], p1[11]); w.z = cvtpk(p1[12], p1[13]); w.w = cvtpk(p1[14], p1[15]); }
            pv_slab<DV>(vbuf, s, w, o, l32, hi);
        }
    } else {
        const float NEG = -__builtin_inff();
#pragma unroll
        for (int hk = 0; hk < 2; ++hk) {
            f32x16 p;
#pragma unroll
            for (int r = 0; r < 16; ++r) p[r] = 0.f;
            { const ALAS unsigned char* kb = kbuf + (32 * hk + l32) * KROW + hi * 16;
#pragma unroll
              for (int d0 = 0; d0 < 4; ++d0) { const bf16x8 k0 = *(const ALAS bf16x8*)(kb + d0 * 32); p = __builtin_amdgcn_mfma_f32_32x32x16_bf16(k0, qf[d0], p, 0, 0, 0); } }
            __builtin_amdgcn_sched_barrier(0);
            if (MASKED) {
#pragma unroll
                for (int r = 0; r < 16; ++r) {
                    const int d0 = lim - 32 * hk - CR(r);
                    const float b0 = btab[min(max(d0, 0), 127)];
                    const bool v0 = (MODE == 2) ? ((unsigned)d0 < 128u) : (d0 >= 0);
                    p[r] = v0 ? p[r] + b0 : NEG; }
            } else {
#pragma unroll
                for (int r = 0; r < 16; ++r) p[r] += cbias;
            }
            float mt = fmaxf(p[0], p[1]);
#pragma unroll
            for (int r = 2; r < 16; ++r) mt = fmaxf(mt, p[r]);
            mt = fmaxf(mt, __shfl_xor(mt, 32));
            if (__any(mt > st_m)) {
                const float mn = fmaxf(st_m, mt), f = ex2(st_m - mn);
                st_l *= f; st_m = mn;
#pragma unroll
                for (int db = 0; db < DV / 32; ++db)
#pragma unroll
                    for (int r = 0; r < 16; ++r) o[db][r] *= f;
            }
            float s = 0.f;
#pragma unroll
            for (int r = 0; r < 16; ++r) { p[r] = ex2(p[r] - st_m); s += p[r]; }
            st_l += s;
            __builtin_amdgcn_sched_barrier(0);
#pragma unroll
            for (int s2 = 0; s2 < 2; ++s2) {
                u32x4 w; w.x = cvtpk(p[8 * s2], p[8 * s2 + 1]); w.y = cvtpk(p[8 * s2 + 2], p[8 * s2 + 3]); w.z = cvtpk(p[8 * s2 + 4], p[8 * s2 + 5]); w.w = cvtpk(p[8 * s2 + 6], p[8 * s2 + 7]);
                pv_slab<DV>(vbuf, 2 * hk + s2, w, o, l32, hi);
            }
        }
    }
}

template <int MODE, int DV>
__device__ __forceinline__ void attn_core(const bf16_t* Qp, const bf16_t* Kp, const bf16_t* Vp, int pitch, int q0, int kt0, int nt, int dir,
                                          ALAS unsigned char* lds, f32x16 (&o)[DV / 32], float& st_m, float& st_l) {
    int tid_ = threadIdx.x; asm volatile("" : "+v"(tid_));
    const int tid = tid_, lane = tid & 63, l32 = lane & 31, hi = lane >> 5, wid = __builtin_amdgcn_readfirstlane(tid >> 6);
    const int qw = q0 + 32 * wid, t = qw + l32;
    const ALAS float* btab = (const ALAS float*)(lds + L_BT);
    bf16x8 qf[4];
#pragma unroll
    for (int d0 = 0; d0 < 4; ++d0) qf[d0] = *(const bf16x8*)(Qp + (size_t)t * pitch + d0 * 16 + hi * 8);
#pragma unroll
    for (int db = 0; db < DV / 32; ++db)
#pragma unroll
        for (int r = 0; r < 16; ++r) o[db][r] = 0.f;
    st_m = (MODE == 0) ? 1.0f : -1e30f; st_l = 0.f;
    Pref<DV> pf;
    tile_load<DV>(pf, Kp, Vp, pitch, kt0, tid);
    tile_store<DV>(pf, lds + L_K, lds + L_V, tid);
    __syncthreads();
    const float cbias = (MODE == 1) ? btab[127] : 0.f;
    for (int it = 0; it < nt; ++it) {
        const int kt = kt0 + dir * it, cur = it & 1, kbase = kt * 64;
        if (it + 1 < nt) tile_load<DV>(pf, Kp, Vp, pitch, kt + dir, tid);
        const ALAS unsigned char* kb = lds + L_K + cur * KBUF; const ALAS unsigned char* vb = lds + L_V + cur * VBUF;
        const int lim = t - kbase - 4 * hi;
        if (MODE == 0) {
            if (kbase <= qw + 31) { if (kbase + 63 >= qw) tile_compute<0, DV, true>(kb, vb, qf, o, st_m, st_l, lim, btab, cbias, lane); else tile_compute<0, DV, false>(kb, vb, qf, o, st_m, st_l, lim, btab, cbias, lane); }
        } else if (MODE == 1) {
            if (kbase <= qw + 31) { if (qw - (kbase + 63) < 113) tile_compute<1, DV, true>(kb, vb, qf, o, st_m, st_l, lim, btab, cbias, lane); else tile_compute<1, DV, false>(kb, vb, qf, o, st_m, st_l, lim, btab, cbias, lane); }
        } else {
            if (kbase <= qw + 31 && kbase + 63 >= qw - 127) tile_compute<2, DV, true>(kb, vb, qf, o, st_m, st_l, lim, btab, cbias, lane);
        }
        if (it + 1 < nt) tile_store<DV>(pf, lds + L_K + (cur ^ 1) * KBUF, lds + L_V + (cur ^ 1) * VBUF, tid);
        if (MODE == 0) {
            if (!__syncthreads_or(st_m != 0.0f)) break;
        } else __syncthreads();
    }
}
template <int DV> __device__ __forceinline__ void store_ot(const f32x16 (&o)[DV / 32], bf16_t* orow, int hi) {
#pragma unroll
    for (int db = 0; db < DV / 32; ++db)
#pragma unroll
        for (int rg = 0; rg < 4; ++rg) { u32x2 w; w.x = cvtpk(o[db][4 * rg], o[db][4 * rg + 1]); w.y = cvtpk(o[db][4 * rg + 2], o[db][4 * rg + 3]);
            *(u32x2*)(orow + 32 * db + 8 * rg + 4 * hi) = w; }
}
}
#ifndef REP_INPROJ
#define REP_INPROJ 1
#endif
#ifndef REP_DIFF
#define REP_DIFF 1
#endif
#ifndef REP_SWA
#define REP_SWA 1
#endif
#ifndef REP_SB
#define REP_SB 1
#endif
#ifndef REP_UP
#define REP_UP 1
#endif
#ifndef REP_CONV
#define REP_CONV 1
#endif
#ifndef PH_DIFF
#define PH_DIFF 1
#endif
#ifndef PH_SWA
#define PH_SWA 1
#endif
#ifndef PH_SB
#define PH_SB 1
#endif
#ifndef PH_CONV
#define PH_CONV 1
#endif
#define LAS __attribute__((address_space(3)))
typedef unsigned short bf16;
typedef float f32x4 __attribute__((ext_vector_type(4)));
typedef unsigned v4u __attribute__((ext_vector_type(4)));
typedef unsigned v2u __attribute__((ext_vector_type(2)));
constexpr int NWAVES = 8;
constexpr int SEQ = 4096, NB = 16, MTOK = NB * SEQ, DM = 1024, DFF = 2816, DUP = 2 * DFF;
constexpr int EVEN_IN = 2304, ODD_IN = 3072;
constexpr size_t MiB = 1u << 20;
constexpr size_t WS_SSQ = 1 * MiB;
constexpr size_t WS_WINE = 8 * MiB, WS_WOUTE = 17 * MiB, WS_WINO = 21 * MiB, WS_WOUTO = 33 * MiB, WS_WUP = 37 * MiB, WS_WDN = 81 * MiB;
constexpr size_t WS_XB = 104 * MiB, WS_R = 232 * MiB;
constexpr size_t WS_PROJ = WS_R, WS_AO = WS_R + 384 * MiB, WS_U = WS_R, WS_G = WS_R + 352 * MiB;
constexpr int LDS_BYTES = 147456, LDS_MISC = 139264;
constexpr int HALF_ROWS = MTOK / 2;

struct Args {
    const float* x; const float* rel_bias; const float* norm_mix; const float* norm_ffn; const float* norm_final;
    const float* w_in_even; const float* w_out_even; const float* sinks; const float* lam_q1; const float* lam_k1; const float* lam_q2; const float* lam_k2;
    const float* diff_norm; const float* w_in_odd; const float* w_out_odd; const float* ffn_up; const float* ffn_conv; const float* ffn_conv_b; const float* ffn_down;
    float* out; unsigned char* ws;
};

__device__ const unsigned char T5B[128] = {0, 1, 2, 3, 4, 5, 6, 7, 8, 9, 10, 11, 12, 13, 14, 15, 16, 16, 16, 17, 17, 18, 18, 18, 19, 19, 19, 20, 20, 20, 20, 21, 21, 21, 21, 22, 22, 22, 22, 22, 23, 23, 23, 23, 23, 23, 24, 24, 24, 24, 24, 24, 25, 25, 25, 25, 25, 25, 25, 26, 26, 26, 26, 26, 26, 26, 26, 27, 27, 27, 27, 27, 27, 27, 27, 27, 27, 28, 28, 28, 28, 28, 28, 28, 28, 28, 28, 29, 29, 29, 29, 29, 29, 29, 29, 29, 29, 29, 29, 30, 30, 30, 30, 30, 30, 30, 30, 30, 30, 30, 30, 30, 30, 31, 31, 31, 31, 31, 31, 31, 31, 31, 31, 31, 31, 31, 31, 31};

__device__ __forceinline__ float wave_sum(float v) {
#pragma unroll
    for (int o = 1; o < 64; o <<= 1) v += __shfl_xor(v, o);
    return v;
}
__device__ __forceinline__ unsigned f2bf(float f) { unsigned u = __builtin_bit_cast(unsigned, f); return (u + 0x7fffu + ((u >> 16) & 1u)) >> 16; }
__device__ __forceinline__ unsigned pk2(float lo, float hi) { return f2bf(lo) | (f2bf(hi) << 16); }

__device__ __forceinline__ void transpose_item(const float* W, int K, int N, bf16* WT, const float* gk, int a0, int a1, int b0, int b1, float cs, LAS float* scr, int item, int lane) {
    const int nblk = N / 32, kb = item / nblk, nb = item % nblk, k0 = 64 * kb, n0 = 32 * nb;
    const int nn = n0 + (lane & 31);
    const float csc = ((nn >= a0 && nn < a1) || (nn >= b0 && nn < b1)) ? cs : 1.0f;
#pragma unroll 8
    for (int i = 0; i < 32; ++i) { const int kk = 2 * i + (lane >> 5); const float gv = gk ? gk[k0 + kk] : 1.0f; scr[kk * 33 + (lane & 31)] = W[(size_t)(k0 + kk) * N + nn] * (gv * csc); }
    asm volatile("s_waitcnt lgkmcnt(0)" ::: "memory");
    const int c = lane & 7;
#pragma unroll
    for (int j = 0; j < 4; ++j) { const int n = (lane >> 3) + 8 * j; const LAS float* s = scr + (8 * c) * 33 + n;
        v4u o; o.x = pk2(s[0 * 33], s[1 * 33]); o.y = pk2(s[2 * 33], s[3 * 33]); o.z = pk2(s[4 * 33], s[5 * 33]); o.w = pk2(s[6 * 33], s[7 * 33]);
        *(v4u*)(WT + (size_t)(n0 + n) * K + k0 + 8 * c) = o; }
    asm volatile("s_waitcnt lgkmcnt(0)" ::: "memory");
}

#define XB_TMO      128
#define XB_XCNT(j)  (256  + 64 * (j))
#define XB_XSUB(j)  (1280 + 64 * (j))
#define XB_XGEN(j)  (2304 + 64 * (j))
#define XB_TOP      3328
#define XB_TOPGEN   3392
#define XCD_BAR_WORDS 3456
#define XB_SPIN_CAP (1u << 18)

__device__ __forceinline__ unsigned xb_ld(unsigned* p)              { return __hip_atomic_load(p, __ATOMIC_RELAXED, __HIP_MEMORY_SCOPE_AGENT); }
__device__ __forceinline__ unsigned xb_add(unsigned* p, unsigned v) { return __hip_atomic_fetch_add(p, v, __ATOMIC_RELAXED, __HIP_MEMORY_SCOPE_AGENT); }
__device__ __forceinline__ unsigned xb_xcc_id() { return (unsigned)__builtin_amdgcn_s_getreg((3 << 11) | 20) & 0xFu; }
#define XB_SPIN(cond, bar) do { unsigned _sp = 0; while (cond) { __builtin_amdgcn_s_sleep(1); \
    if ((++_sp & 255u) == 0u) { if (xb_ld(&(bar)[XB_TMO])) break; if (_sp > XB_SPIN_CAP) { atomicAdd(&(bar)[XB_TMO], 1u); break; } } } } while (0)

struct XcdBarrier {
    unsigned* bar; unsigned x;
    volatile LAS unsigned* st;
};

__device__ __forceinline__ XcdBarrier xcd_barrier_post(unsigned* bar, volatile LAS unsigned* st) {
    XcdBarrier b; b.bar = bar; b.x = xb_xcc_id(); b.st = st;
    if (threadIdx.x == 0) (void)xb_add(&bar[XB_XCNT(b.x)], 1u);
    return b;
}
__device__ __forceinline__ void xcd_barrier_complete(unsigned* bar, unsigned x, unsigned& nloc, unsigned& nx) {
    const unsigned G = gridDim.x * gridDim.y * gridDim.z;
    unsigned sum, cnt, mine, sp = 0u;
    for (;;) {
        sum = 0u; cnt = 0u; mine = 0u;
#pragma unroll
        for (unsigned j = 0; j < 16; ++j) { const unsigned c = xb_ld(&bar[XB_XCNT(j)]); sum += c; cnt += (c > 0u) ? 1u : 0u; mine = (j == x) ? c : mine; }
        if (sum == G) break;
        __builtin_amdgcn_s_sleep(1);
        if ((++sp & 255u) == 0u) { if (xb_ld(&bar[XB_TMO])) break; if (sp > XB_SPIN_CAP) { atomicAdd(&bar[XB_TMO], 1u); break; } }
    }
    nloc = mine > 0u ? mine : 1u; nx = cnt > 0u ? cnt : 1u;
}

__device__ __forceinline__ void xcd_barrier(const XcdBarrier& b) {
    asm volatile("s_waitcnt vmcnt(0)" ::: "memory");
    __syncthreads();
    if (threadIdx.x == 0) {
        unsigned* bar = b.bar;
        __builtin_amdgcn_s_waitcnt(0);
        unsigned nloc = b.st[0], nx = b.st[1];
        if (nloc == 0u) { xcd_barrier_complete(bar, b.x, nloc, nx); b.st[0] = nloc; b.st[1] = nx; }
        const unsigned old = xb_add(&bar[XB_XSUB(b.x)], 1u);
        const unsigned gen = old / nloc;
        if (old + 1u == (gen + 1u) * nloc) {
            __builtin_amdgcn_fence(__ATOMIC_RELEASE, "agent");
            asm volatile("s_waitcnt vmcnt(0)" ::: "memory");
            const unsigned og = xb_add(&bar[XB_TOP], 1u);
            const unsigned tg = og / nx;
            if (og + 1u == (tg + 1u) * nx) xb_add(&bar[XB_TOPGEN], 1u);
            else XB_SPIN(xb_ld(&bar[XB_TOPGEN]) == tg, bar);
            __builtin_amdgcn_fence(__ATOMIC_ACQUIRE, "agent");
            xb_add(&bar[XB_XGEN(b.x)], 1u);
            asm volatile("s_waitcnt vmcnt(0)" ::: "memory");
        } else {
            XB_SPIN(xb_ld(&bar[XB_XGEN(b.x)]) == gen, bar);
            __builtin_amdgcn_fence(__ATOMIC_ACQUIRE, "agent");
            asm volatile("s_waitcnt vmcnt(0)" ::: "memory");
        }
    }
    __syncthreads();
}

__global__ void __launch_bounds__(NWAVES * 64, 2) mega_fwd(Args a) {
    extern __shared__ __attribute__((aligned(16))) unsigned char lds_raw[];
    cg::grid_group grid = cg::this_grid();
    LAS unsigned char* lds = (LAS unsigned char*)lds_raw;
    const int tid = threadIdx.x, lane = tid & 63, wave = __builtin_amdgcn_readfirstlane(tid >> 6);
    const int G = gridDim.x, bx = blockIdx.x;
    const int gw = bx * NWAVES + wave, NGW = G * NWAVES;
    unsigned char* ws = a.ws;
    float* ssq = (float*)(ws + WS_SSQ);
    bf16* xb = (bf16*)(ws + WS_XB);
    bf16* proj = (bf16*)(ws + WS_PROJ);
    bf16* ao = (bf16*)(ws + WS_AO);
    bf16* ubuf = (bf16*)(ws + WS_U);
    bf16* gbuf = (bf16*)(ws + WS_G);

    if (bx == 0) for (int i = tid; i < XCD_BAR_WORDS; i += NWAVES * 64) ((unsigned*)ws)[i] = 0u;
    if (tid < 2) ((LAS unsigned*)(lds + LDS_MISC))[tid] = 0u;
    {
        LAS float* scr = (LAS float*)(lds + wave * 16384);
        constexpr int I_INE = 16 * (EVEN_IN / 32), I_OUT = 16 * 32, I_INO = 16 * (ODD_IN / 32), I_UP = 16 * (DUP / 32), I_DN = (DFF / 64) * 32;
        constexpr int NITEMS = 2 * I_INE + 2 * I_OUT + 2 * I_INO + 2 * I_OUT + 4 * I_UP + 4 * I_DN;
        for (int it = gw; it < NITEMS; it += NGW) {
            int r = it;
            if (r < 2 * I_INE) { const int e = r / I_INE; r -= e * I_INE;
                transpose_item(a.w_in_even + (size_t)e * DM * EVEN_IN, DM, EVEN_IN, (bf16*)(ws + WS_WINE) + (size_t)e * EVEN_IN * DM, a.norm_mix + (2 * e) * DM, 0, 512, 768, 1280, att::QSCALE, scr, r, lane); continue; }
            r -= 2 * I_INE;
            if (r < 2 * I_OUT) { const int e = r / I_OUT; r -= e * I_OUT;
                transpose_item(a.w_out_even + (size_t)e * DM * DM, DM, DM, (bf16*)(ws + WS_WOUTE) + (size_t)e * DM * DM, nullptr, 0, 0, 0, 0, 1.f, scr, r, lane); continue; }
            r -= 2 * I_OUT;
            if (r < 2 * I_INO) { const int e = r / I_INO; r -= e * I_INO;
                transpose_item(a.w_in_odd + (size_t)e * DM * ODD_IN, DM, ODD_IN, (bf16*)(ws + WS_WINO) + (size_t)e * ODD_IN * DM, a.norm_mix + (2 * e + 1) * DM, 0, 1024, 0, 0, att::QSCALE, scr, r, lane); continue; }
            r -= 2 * I_INO;
            if (r < 2 * I_OUT) { const int e = r / I_OUT; r -= e * I_OUT;
                transpose_item(a.w_out_odd + (size_t)e * DM * DM, DM, DM, (bf16*)(ws + WS_WOUTO) + (size_t)e * DM * DM, nullptr, 0, 0, 0, 0, 1.f, scr, r, lane); continue; }
            r -= 2 * I_OUT;
            if (r < 4 * I_UP) { const int e = r / I_UP; r -= e * I_UP;
                transpose_item(a.ffn_up + (size_t)e * DM * DUP, DM, DUP, (bf16*)(ws + WS_WUP) + (size_t)e * DUP * DM, a.norm_ffn + e * DM, 0, 0, 0, 0, 1.f, scr, r, lane); continue; }
            r -= 4 * I_UP;
            { const int e = r / I_DN; r -= e * I_DN;
                transpose_item(a.ffn_down + (size_t)e * DFF * DM, DFF, DM, (bf16*)(ws + WS_WDN) + (size_t)e * DM * DFF, nullptr, 0, 0, 0, 0, 1.f, scr, r, lane); }
        }
        for (int m = gw; m < MTOK; m += NGW) {
            const f32x4* xr = (const f32x4*)(a.x + (size_t)m * DM) + lane; f32x4 v[4]; float s = 0.f;
#pragma unroll
            for (int j = 0; j < 4; ++j) { v[j] = xr[64 * j]; s += (v[j][0] * v[j][0] + v[j][1] * v[j][1]) + (v[j][2] * v[j][2] + v[j][3] * v[j][3]); }
            s = wave_sum(s);
            v2u* o8 = (v2u*)(xb + (size_t)m * DM) + lane;
#pragma unroll
            for (int j = 0; j < 4; ++j) { v2u w; w.x = pk2(v[j][0], v[j][1]); w.y = pk2(v[j][2], v[j][3]); o8[64 * j] = w; }
            if (lane < 16) ssq[(size_t)m * 16 + lane] = (lane == 0) ? s : 0.f;
        }
    }
    grid.sync();
    const XcdBarrier xbar = xcd_barrier_post((unsigned*)ws, (volatile LAS unsigned*)(lds + LDS_MISC));

    for (int layer = 0; layer < 4; ++layer) {
        const int e = layer >> 1; const bool even = (layer & 1) == 0;
        const float* xold = (layer == 0) ? a.x : a.out;
        {
            const int N = even ? EVEN_IN : ODD_IN;
            const bf16* wt = even ? (const bf16*)(ws + WS_WINE) + (size_t)e * EVEN_IN * DM : (const bf16*)(ws + WS_WINO) + (size_t)e * ODD_IN * DM;
            pg8::Gemm g{xb, wt, MTOK, N, DM}; pg8::StaticOrder S; S.init(MTOK, N, G, bx);
            pg8::EpiScaleBf16 E{proj, N, ssq};
            for (int rep_ = 0; rep_ < REP_INPROJ; ++rep_)
            pg8::gemm_phase<pg8::EpiScaleBf16, pg8::StaticOrder, true, true>(lds, g, S, E);
        }
        xcd_barrier(xbar);
        if (even) {
            int tq = threadIdx.x; asm volatile("" : "+v"(tq)); const int tid = tq, lane = tq & 63, l32 = lane & 31, hi = lane >> 5;
            float lam, one_m_li;
            { const float li = (layer == 0) ? 0.2f : 0.47071301839f;
              const float s1 = wave_sum(a.lam_q1[e * 64 + lane] * a.lam_k1[e * 64 + lane]), s2 = wave_sum(a.lam_q2[e * 64 + lane] * a.lam_k2[e * 64 + lane]);
              lam = __expf(s1) - __expf(s2) + li; lam = __builtin_bit_cast(float, __builtin_amdgcn_readfirstlane(__builtin_bit_cast(int, lam))); one_m_li = 1.0f - li; }
            LAS float* btab = (LAS float*)(lds + att::L_BT);

#if PH_DIFF
            for (int rep_ = 0; rep_ < REP_DIFF; ++rep_)
            for (int uidx = bx; uidx < 1024; uidx += G) {
                const int j = uidx >> 8, c = uidx & 255, bh = c >> 2, s = c & 3, b = bh >> 2, h = bh & 3;
                const int qb = (j == 0) ? s : (j == 1) ? 7 - s : (j == 2) ? 8 + s : 15 - s;
                if (tid < 128) btab[tid] = a.rel_bias[T5B[tid] * 12 + 8 + h] * att::LOG2E;
                const bf16* base = proj + (size_t)b * SEQ * EVEN_IN;
                const int q0 = qb * 256, nt = 4 * qb + 4, t = q0 + 32 * wave + l32;
                att::f32x16 o2[4]; float m2, l2; LAS unsigned* o1s = (LAS unsigned*)(lds + 57344 + wave * 8192) + lane;
                { float m1, l1;
                  att::attn_core<1, 128>(base + 768 + h * 128, base + 1280 + h * 128, base + 1792 + h * 128, EVEN_IN, q0, 0, nt, 1, lds, o2, m1, l1);
                  const float inv = __builtin_amdgcn_rcpf(l1 + __shfl_xor(l1, 32));
#pragma unroll
                  for (int db = 0; db < 4; ++db)
#pragma unroll
                      for (int k = 0; k < 8; ++k) o1s[(db * 8 + k) * 64] = att::cvtpk(o2[db][2 * k] * inv, o2[db][2 * k + 1] * inv); }
                att::attn_core<1, 128>(base + 768 + h * 128 + 64, base + 1280 + h * 128 + 64, base + 1792 + h * 128, EVEN_IN, q0, 0, nt, 1, lds, o2, m2, l2);
                { const float inv = lam * __builtin_amdgcn_rcpf(l2 + __shfl_xor(l2, 32)); float ss = 0.f;
#pragma unroll
                  for (int db = 0; db < 4; ++db)
#pragma unroll
                      for (int r = 0; r < 16; ++r) { const unsigned w = o1s[(db * 8 + (r >> 1)) * 64]; const float a1 = __uint_as_float((r & 1) ? (w & 0xffff0000u) : (w << 16));
                          const float v = a1 - inv * o2[db][r]; o2[db][r] = v; ss += v * v; }
                  ss += __shfl_xor(ss, 32);
                  const float rs = __builtin_amdgcn_rsqf(ss * (1.0f / 128.0f) + 1e-6f) * one_m_li;
                  const float* gn = a.diff_norm + e * 128;
#pragma unroll
                  for (int db = 0; db < 4; ++db)
#pragma unroll
                      for (int rg = 0; rg < 4; ++rg) { const f32x4 gv = *(const f32x4*)(gn + 32 * db + 8 * rg + 4 * hi);
#pragma unroll
                          for (int k = 0; k < 4; ++k) o2[db][4 * rg + k] *= rs * gv[k]; } }
                att::store_ot<128>(o2, ao + ((size_t)b * SEQ + t) * DM + 512 + h * 128, hi);
            }
#endif
#if PH_SWA
            for (int rep_ = 0; rep_ < REP_SWA; ++rep_)
            for (int uidx = bx; uidx < 2048; uidx += G) {
                const int qb = uidx & 15, qh = (uidx >> 4) & 7, b = uidx >> 7, kvh = qh >> 2;
                if (tid < 128) btab[tid] = a.rel_bias[T5B[tid] * 12 + qh] * att::LOG2E;
                const bf16* base = proj + (size_t)b * SEQ * EVEN_IN;
                const int q0 = qb * 256, t = q0 + 32 * wave + l32;
                const int kt0 = (qb * 4 - 2 > 0) ? qb * 4 - 2 : 0, nt = qb * 4 + 4 - kt0;
                att::f32x16 o[2]; float m, l;
                att::attn_core<2, 64>(base + qh * 64, base + 512 + kvh * 64, base + 640 + kvh * 64, EVEN_IN, q0, kt0, nt, 1, lds, o, m, l);
                const float sk = a.sinks[e * 8 + qh] * att::LOG2E;
                const float inv = __builtin_amdgcn_rcpf(l + __shfl_xor(l, 32) + __builtin_amdgcn_exp2f(sk - m));
#pragma unroll
                for (int db = 0; db < 2; ++db)
#pragma unroll
                    for (int r = 0; r < 16; ++r) o[db][r] *= inv;
                att::store_ot<64>(o, ao + ((size_t)b * SEQ + t) * DM + qh * 64, hi);
            }
#endif
        } else {
#if PH_SB
            int tq = threadIdx.x; asm volatile("" : "+v"(tq)); const int lane = tq & 63, l32 = lane & 31, hi = lane >> 5;
            for (int rep_ = 0; rep_ < REP_SB; ++rep_)
            for (int uidx = bx; uidx < 4096; uidx += G) {
                const int bh = uidx & 255, qb = 15 - (uidx >> 8), b = bh >> 4, h = bh & 15;
                const bf16* base = proj + (size_t)b * SEQ * ODD_IN;
                const int q0 = qb * 256, nt = 4 * qb + 4, t = q0 + 32 * wave + l32;
                att::f32x16 o[2]; float P, dummy;
                att::attn_core<0, 64>(base + h * 64, base + 1024 + h * 64, base + 2048 + h * 64, ODD_IN, q0, nt - 1, nt, -1, lds, o, P, dummy);
                att::store_ot<64>(o, ao + ((size_t)b * SEQ + t) * DM + h * 64, hi);
            }
#endif
        }
        xcd_barrier(xbar);
        {
            const bf16* wt = even ? (const bf16*)(ws + WS_WOUTE) + (size_t)e * DM * DM : (const bf16*)(ws + WS_WOUTO) + (size_t)e * DM * DM;
            pg8::Gemm g{ao, wt, MTOK, DM, DM}; pg8::StaticOrder S; S.init(MTOK, DM, G, bx);
            pg8::EpiResid E{xold, a.out, xb, ssq};
            pg8::gemm_phase<pg8::EpiResid, pg8::StaticOrder, true, true>(lds, g, S, E);
        }
        xcd_barrier(xbar);
        const bf16* wup = (const bf16*)(ws + WS_WUP) + (size_t)layer * DUP * DM;
        const bf16* wdn = (const bf16*)(ws + WS_WDN) + (size_t)layer * DM * DFF;
        for (int half = 0; half < 2; ++half) {
            const size_t r0 = (size_t)half * HALF_ROWS;
            {
                pg8::Gemm g{xb + r0 * DM, wup, HALF_ROWS, DUP, DM}; pg8::StaticOrder S; S.init(HALF_ROWS, DUP, G, bx);
                pg8::EpiScaleBf16 E{ubuf, DUP, ssq + r0 * 16};
                for (int rep_ = 0; rep_ < REP_UP; ++rep_)
                pg8::gemm_phase<pg8::EpiScaleBf16, pg8::StaticOrder, true, true>(lds, g, S, E);
            }
            xcd_barrier(xbar);
#if PH_CONV
            {
                const float* cw = a.ffn_conv + (size_t)layer * 3 * DUP; const float* cb = a.ffn_conv_b + (size_t)layer * DUP;
                constexpr int NCC = 6, NRC = HALF_ROWS / 32;
                int tq = threadIdx.x; asm volatile("" : "+v"(tq)); const int lane = tq & 63;
                for (int rep_ = 0; rep_ < REP_CONV; ++rep_)
                for (int it = gw; it < NCC * NRC; it += NGW) {
                    const int cc = it % NCC, rc = it / NCC, cgp = cc * 64 + lane;
                    if (cgp < DFF / 8) {
                        const int col = cgp * 8, row0 = rc * 32;
                        float wg[3][8], wv[3][8], bg[8], bv[8];
#pragma unroll
                        for (int tp = 0; tp < 3; ++tp)
#pragma unroll
                            for (int k = 0; k < 8; k += 4) { const f32x4 t1 = *(const f32x4*)(cw + tp * DUP + col + k), t2 = *(const f32x4*)(cw + tp * DUP + DFF + col + k);
#pragma unroll
                                for (int q = 0; q < 4; ++q) { wg[tp][k + q] = t1[q]; wv[tp][k + q] = t2[q]; } }
#pragma unroll
                        for (int k = 0; k < 8; k += 4) { const f32x4 t1 = *(const f32x4*)(cb + col + k), t2 = *(const f32x4*)(cb + DFF + col + k);
#pragma unroll
                            for (int q = 0; q < 4; ++q) { bg[k + q] = t1[q]; bv[k + q] = t2[q]; } }
                        float g2[8], g1[8], v2[8], v1[8];
                        const bool head = (row0 % SEQ) == 0;
                        {
                            v4u a2 = {0, 0, 0, 0}, a1 = {0, 0, 0, 0}, c2 = {0, 0, 0, 0}, c1 = {0, 0, 0, 0};
                            if (!head) { const bf16* up = ubuf + (size_t)(row0 - 2) * DUP + col; a2 = *(const v4u*)up; c2 = *(const v4u*)(up + DFF); a1 = *(const v4u*)(up + DUP); c1 = *(const v4u*)(up + DUP + DFF); }
#pragma unroll
                            for (int k = 0; k < 8; ++k) { const int sh = (k & 1) * 16;
                                g2[k] = __uint_as_float(((a2[k >> 1] >> sh) & 0xffffu) << 16); g1[k] = __uint_as_float(((a1[k >> 1] >> sh) & 0xffffu) << 16);
                                v2[k] = __uint_as_float(((c2[k >> 1] >> sh) & 0xffffu) << 16); v1[k] = __uint_as_float(((c1[k >> 1] >> sh) & 0xffffu) << 16); }
                        }
                        for (int r = 0; r < 32; ++r) {
                            const bf16* up = ubuf + (size_t)(row0 + r) * DUP + col;
                            const v4u a0 = *(const v4u*)up, c0 = *(const v4u*)(up + DFF);
                            float res[8];
#pragma unroll
                            for (int k = 0; k < 8; ++k) { const int sh = (k & 1) * 16;
                                const float g0 = __uint_as_float(((a0[k >> 1] >> sh) & 0xffffu) << 16), v0 = __uint_as_float(((c0[k >> 1] >> sh) & 0xffffu) << 16);
                                const float gg = bg[k] + wg[0][k] * g2[k] + wg[1][k] * g1[k] + wg[2][k] * g0;
                                const float vv = bv[k] + wv[0][k] * v2[k] + wv[1][k] * v1[k] + wv[2][k] * v0;
                                const float sg = gg * __builtin_amdgcn_rcpf(1.0f + __builtin_amdgcn_exp2f(-gg * att::LOG2E));
                                res[k] = sg * vv; g2[k] = g1[k]; g1[k] = g0; v2[k] = v1[k]; v1[k] = v0; }
                            v4u w; w.x = pk2(res[0], res[1]); w.y = pk2(res[2], res[3]); w.z = pk2(res[4], res[5]); w.w = pk2(res[6], res[7]);
                            *(v4u*)(gbuf + (size_t)(row0 + r) * DFF + col) = w;
                        }
                    }
                }
            }
#endif
            xcd_barrier(xbar);
            {
                pg8::Gemm g{gbuf, wdn, HALF_ROWS, DM, DFF}; pg8::StaticOrder S; S.init(HALF_ROWS, DM, G, bx);
                pg8::EpiResid E{a.out + r0 * DM, a.out + r0 * DM, xb + r0 * DM, ssq + r0 * 16};
                pg8::gemm_phase<pg8::EpiResid, pg8::StaticOrder, true, true>(lds, g, S, E);
            }
            if (half == 1) xcd_barrier(xbar);
        }
    }
    { int tq = threadIdx.x; asm volatile("" : "+v"(tq)); const int lane = tq & 63;
    for (int m = gw; m < MTOK; m += NGW) {
        f32x4* xr = (f32x4*)(a.out + (size_t)m * DM) + lane; f32x4 v[4]; float s = 0.f;
#pragma unroll
        for (int j = 0; j < 4; ++j) { v[j] = xr[64 * j]; s += (v[j][0] * v[j][0] + v[j][1] * v[j][1]) + (v[j][2] * v[j][2] + v[j][3] * v[j][3]); }
        s = wave_sum(s);
        const float rs = __builtin_amdgcn_rsqf(s * (1.0f / DM) + 1e-6f);
#pragma unroll
        for (int j = 0; j < 4; ++j) { const f32x4 gv = *((const f32x4*)a.norm_final + lane + 64 * j); xr[64 * j] = v[j] * rs * gv; }
    } }
}

extern "C" void kernel_launch(void* const* d_in, const int* in_sizes, int n_in, void* d_out, int out_size, void* d_ws, size_t ws_size, hipStream_t stream) {
    static int grid = 0;
    if (grid == 0) {
        int dev = 0, cus = 0, per_cu = 0;
        (void)hipGetDevice(&dev);
        (void)hipDeviceGetAttribute(&cus, hipDeviceAttributeMultiprocessorCount, dev);
        (void)hipFuncSetAttribute((const void*)mega_fwd, hipFuncAttributeMaxDynamicSharedMemorySize, LDS_BYTES);
        (void)hipOccupancyMaxActiveBlocksPerMultiprocessor(&per_cu, (const void*)mega_fwd, NWAVES * 64, LDS_BYTES);
        if (per_cu < 1) per_cu = 1;
        grid = cus * per_cu;
        if (n_in != 19 || ws_size < 1024 * MiB) fprintf(stderr, "kernel_launch: unexpected n_in %d / ws %zu\n", n_in, ws_size);
    }
    Args a{};
    a.x = (const float*)d_in[0]; a.rel_bias = (const float*)d_in[1]; a.norm_mix = (const float*)d_in[2]; a.norm_ffn = (const float*)d_in[3]; a.norm_final = (const float*)d_in[4];
    a.w_in_even = (const float*)d_in[5]; a.w_out_even = (const float*)d_in[6]; a.sinks = (const float*)d_in[7]; a.lam_q1 = (const float*)d_in[8]; a.lam_k1 = (const float*)d_in[9];
    a.lam_q2 = (const float*)d_in[10]; a.lam_k2 = (const float*)d_in[11]; a.diff_norm = (const float*)d_in[12]; a.w_in_odd = (const float*)d_in[13]; a.w_out_odd = (const float*)d_in[14];
    a.ffn_up = (const float*)d_in[15]; a.ffn_conv = (const float*)d_in[16]; a.ffn_conv_b = (const float*)d_in[17]; a.ffn_down = (const float*)d_in[18];
    a.out = (float*)d_out; a.ws = (unsigned char*)d_ws;
    void* args[] = {&a};
    hipError_t err = hipLaunchCooperativeKernel((const void*)mega_fwd, dim3(grid), dim3(NWAVES * 64), args, LDS_BYTES, stream);
    if (err != hipSuccess) fprintf(stderr, "kernel_launch: cooperative launch failed: %s (grid %d)\n", hipGetErrorString(err), grid);
}
```

```cpp
#include <hip/hip_runtime.h>
#include <hip/hip_cooperative_groups.h>
#include <cstdio>
#include <cstdint>
namespace cg = cooperative_groups;
namespace pg8 {
#define PG8_LAS __attribute__((address_space(3)))
typedef unsigned short bf16_t;
typedef short bf16x8 __attribute__((ext_vector_type(8)));
typedef float f32x4 __attribute__((ext_vector_type(4)));
typedef unsigned u32x4 __attribute__((ext_vector_type(4)));
constexpr int BM = 256, BK = 64, HALF = 128, HTB = HALF * BK * 2  , STAGE_BYTES = 8 * HTB, NXCD = 8, WGM = 8;

__host__ __device__ __forceinline__ int lds_byte(int r, int c) { const int st = (r >> 4) * 2 + (c >> 5), rr = r & 15, cc = c & 31, ob = rr * 64 + cc * 2; return st * 1024 + (ob ^ (((ob >> 9) & 1) << 5)); }
__host__ __device__ __forceinline__ void stage_rc(int b, int& R, int& C) { const int st = b / 1024, sb = b % 1024, swz = sb ^ (((sb >> 9) & 1) << 5); R = (st >> 1) * 16 + swz / 64; C = (st & 1) * 32 + (swz % 64) / 2; }
__host__ __device__ __forceinline__ int perm32(int rho) { const int n = rho >> 4, i = rho & 15; return 8 * (i >> 2) + 4 * n + (i & 3); }

struct Unit { int pm, pn; };
struct Gemm { const bf16_t* A; const bf16_t* Bt; int M, N, K; };

struct StaticOrder {
    int nM, nN, nwg, G, c;
    __host__ __device__ void init(int M, int N, int G_, int c_) { nM = M / BM; nN = N / BM; nwg = nM * nN; G = G_; c = c_; }
    __host__ __device__ bool next(int i, Unit& u) const {
        const long L = (long)i * G + c; if (L >= nwg) return false;
        int wgid = (int)L; { const int q = nwg / NXCD, r = nwg % NXCD, xcd = wgid % NXCD, off = wgid / NXCD; wgid = (xcd < r ? xcd * (q + 1) : r * (q + 1) + (xcd - r) * q) + off; }
        const int nig = WGM * nN, gid = wgid / nig, fm = gid * WGM, gsz = (nM - fm) < WGM ? (nM - fm) : WGM;
        u.pm = fm + ((wgid % nig) % gsz); u.pn = (wgid % nig) / gsz; return true;
    }
    __device__ __forceinline__ void a_ready(const Unit&) const {}
    __device__ __forceinline__ void done(const Unit&) const {}
};

__device__ __forceinline__ unsigned cvt_pk_bf16(float lo, float hi) { unsigned r; asm volatile("v_cvt_pk_bf16_f32 %0, %1, %2" : "=v"(r) : "v"(lo), "v"(hi)); return r; }
typedef float f32x2 __attribute__((ext_vector_type(2)));
typedef unsigned u32x2 __attribute__((ext_vector_type(2)));
constexpr float RMS_EPS = 1e-6f;
struct EpiScaleBf16 {
    static constexpr bool PERM = true, AFTER_DRAIN = false;
    bf16_t* O; int ldc; const float* ssq;
    __device__ __forceinline__ void operator()(const f32x4 (&acc)[2][2][4][2], const Unit& u, int wr, int wc, int fr, int fq) const {
        const int row0 = u.pm * BM + wr * 64 + fr, col0 = u.pn * BM + wc * 32 + 8 * fq;
        f32x4 part[2][4];
#pragma unroll
        for (int ai = 0; ai < 2; ++ai)
#pragma unroll
            for (int m = 0; m < 4; ++m) part[ai][m] = *(const f32x4*)(ssq + (size_t)(row0 + ai * HALF + m * 16) * 16 + fq * 4);
#pragma unroll
        for (int ai = 0; ai < 2; ++ai)
#pragma unroll
            for (int m = 0; m < 4; ++m) { const int row = row0 + ai * HALF + m * 16; bf16_t* rowp = O + (size_t)row * ldc + col0;
                float t = (part[ai][m][0] + part[ai][m][1]) + (part[ai][m][2] + part[ai][m][3]);
                t += __shfl_xor(t, 16); t += __shfl_xor(t, 32);
                const float rs = __builtin_amdgcn_rsqf(t * (1.0f / 1024.0f) + RMS_EPS);
#pragma unroll
                for (int bj = 0; bj < 2; ++bj) { const f32x4 v0 = acc[ai][bj][m][0] * rs, v1 = acc[ai][bj][m][1] * rs;
                    u32x4 w; w.x = cvt_pk_bf16(v0[0], v0[1]); w.y = cvt_pk_bf16(v0[2], v0[3]); w.z = cvt_pk_bf16(v1[0], v1[1]); w.w = cvt_pk_bf16(v1[2], v1[3]);
                    *(u32x4*)(rowp + bj * HALF) = w; } }
    }
};
struct EpiResid {
    static constexpr bool PERM = true, AFTER_DRAIN = false;
    const float* base; float* out; bf16_t* xb; float* ssq;
    __device__ __forceinline__ void operator()(const f32x4 (&acc)[2][2][4][2], const Unit& u, int wr, int wc, int fr, int fq) const {
        const int col0 = u.pn * BM + wc * 32 + 8 * fq;
        const size_t off0 = (size_t)(u.pm * BM + wr * 64 + fr) * 1024 + col0;
        f32x4 nx[2][2][2];
#pragma unroll
        for (int g = 0; g < 2; ++g) { const size_t offn = off0 + (size_t)(g * 16) * 1024;
#pragma unroll
            for (int bj = 0; bj < 2; ++bj)
#pragma unroll
                for (int n = 0; n < 2; ++n) nx[g][bj][n] = *(const f32x4*)(base + offn + bj * HALF + n * 4); }
        asm volatile("" ::: "memory");
#pragma unroll
        for (int g = 0; g < 8; ++g) { const int ai = g >> 2, m = g & 3; const int row = u.pm * BM + ai * HALF + wr * 64 + m * 16 + fr; const size_t off = (size_t)row * 1024 + col0; float q = 0.f;
            f32x4 cu[2][2];
#pragma unroll
            for (int bj = 0; bj < 2; ++bj)
#pragma unroll
                for (int n = 0; n < 2; ++n) cu[bj][n] = nx[g & 1][bj][n];
            if (g < 6) { const size_t offn = off0 + (size_t)(((g + 2) >> 2) * HALF + ((g + 2) & 3) * 16) * 1024;
#pragma unroll
                for (int bj = 0; bj < 2; ++bj)
#pragma unroll
                    for (int n = 0; n < 2; ++n) nx[g & 1][bj][n] = *(const f32x4*)(base + offn + bj * HALF + n * 4); }
#pragma unroll
            for (int bj = 0; bj < 2; ++bj) { const f32x4 o0 = cu[bj][0] + acc[ai][bj][m][0], o1 = cu[bj][1] + acc[ai][bj][m][1];
                *(f32x4*)(out + off + bj * HALF) = o0; *(f32x4*)(out + off + bj * HALF + 4) = o1;
                q += ((o0[0] * o0[0] + o0[1] * o0[1]) + (o0[2] * o0[2] + o0[3] * o0[3])) + ((o1[0] * o1[0] + o1[1] * o1[1]) + (o1[2] * o1[2] + o1[3] * o1[3]));
                u32x4 w; w.x = cvt_pk_bf16(o0[0], o0[1]); w.y = cvt_pk_bf16(o0[2], o0[3]); w.z = cvt_pk_bf16(o1[0], o1[1]); w.w = cvt_pk_bf16(o1[2], o1[3]);
                *(u32x4*)(xb + off + bj * HALF) = w; }
            q += __shfl_xor(q, 16); q += __shfl_xor(q, 32);
            if (fq == 0) ssq[(size_t)row * 16 + u.pn * 4 + wc] = q;
            asm volatile("" ::: "memory"); }
    }
};
template <class Epi, class Sched, bool ALIGN_EPI = false, bool SP2 = false>
__device__ __forceinline__ void gemm_phase(PG8_LAS unsigned char* lds, const Gemm g, const Sched& S, const Epi& E) {
    int tid_ = threadIdx.x; asm volatile("" : "+v"(tid_));
    const int tid = tid_, wid = __builtin_amdgcn_readfirstlane(tid >> 6), lane = tid & 63, wr = wid >> 2, wc = wid & 3, fr = lane & 15, fq = lane >> 4;
    const int K = g.K, nt = K / BK;
    unsigned voffA[2], voffB[2];
#pragma unroll
    for (int i = 0; i < 2; ++i) { int R, C; stage_rc(tid * 16 + i * 8192, R, C); const int Rb = Epi::PERM ? ((R & ~31) + perm32(R & 31)) : R;
        voffA[i] = (unsigned)(R * K + C) * 2u; voffB[i] = (unsigned)(Rb * K + C) * 2u; }
    const size_t kstep = (size_t)(BK * 2);
    const size_t hstep = (size_t)HALF * K * 2;
    const size_t tstep = 2 * hstep;
    const unsigned ldsw = (unsigned)wid * 1024u;
    const int aoff = lds_byte(wr * 64 + fr, fq * 8), boff = lds_byte(wc * 32 + fr, fq * 8);
#define PG8_SA(b, h) (((b) * 2 + (h)) * HTB)
#define PG8_SB(b, h) ((4 + (b) * 2 + (h)) * HTB)
#define PG8_STAGE(bufoff, gbase, voff) do { _Pragma("unroll") for (int _i = 0; _i < 2; ++_i) \
        __builtin_amdgcn_global_load_lds((const unsigned*)((const char*)(gbase) + (voff)[_i]), (PG8_LAS unsigned*)(lds + (bufoff) + ldsw + _i * 8192), 16, 0, 0); } while (0)
#define PG8_LDA(dst, b, h) do { _Pragma("unroll") for (int m = 0; m < 4; ++m) _Pragma("unroll") for (int k = 0; k < 2; ++k) dst[m][k] = *(const PG8_LAS bf16x8*)(lds + PG8_SA(b, h) + aoff + m * 2048 + k * 1024); } while (0)
#define PG8_LDB(dst, b, h) do { _Pragma("unroll") for (int n = 0; n < 2; ++n) _Pragma("unroll") for (int k = 0; k < 2; ++k) dst[n][k] = *(const PG8_LAS bf16x8*)(lds + PG8_SB(b, h) + boff + n * 2048 + k * 1024); } while (0)
#define PG8_MMA(ai, bj, At, Bt) do { __builtin_amdgcn_s_setprio(1); _Pragma("unroll") for (int m = 0; m < 4; ++m) _Pragma("unroll") for (int n = 0; n < 2; ++n) _Pragma("unroll") for (int k = 0; k < 2; ++k) \
        acc[ai][bj][m][n] = __builtin_amdgcn_mfma_f32_16x16x32_bf16(Bt[n][k], At[m][k], acc[ai][bj][m][n], 0, 0, 0); __builtin_amdgcn_s_setprio(0); } while (0)
#define PG8_WAIT_V(n) asm volatile("s_waitcnt vmcnt(" #n ")" ::: "memory")
#define PG8_WAIT_L(n) asm volatile("s_waitcnt lgkmcnt(" #n ")" ::: "memory")
#define PG8_BAR __builtin_amdgcn_s_barrier()
#define PG8_SCHED __builtin_amdgcn_sched_barrier(0)
    Unit cur, nxt; int ui = 0;
    if (!S.next(0, cur)) return;
    f32x4 acc[2][2][4][2];
#pragma unroll
    for (int a = 0; a < 2; ++a)
#pragma unroll
        for (int b = 0; b < 2; ++b)
#pragma unroll
            for (int m = 0; m < 4; ++m)
#pragma unroll
                for (int n = 0; n < 2; ++n) acc[a][b][m][n] = (f32x4){0.f, 0.f, 0.f, 0.f};
    bf16x8 At[4][2], B0[2][2], B1[2][2];
    const char* cA = (const char*)g.A + (size_t)cur.pm * tstep; const char* cB = (const char*)g.Bt + (size_t)cur.pn * tstep;
    S.a_ready(cur);
    if constexpr (SP2) {
        PG8_STAGE(PG8_SB(0, 0), cB, voffB); PG8_STAGE(PG8_SB(0, 1), cB + hstep, voffB); PG8_STAGE(PG8_SA(0, 0), cA, voffA); PG8_STAGE(PG8_SA(0, 1), cA + hstep, voffA);
        if (wr == 1) PG8_BAR;
        PG8_WAIT_V(2); PG8_BAR;
        PG8_STAGE(PG8_SB(1, 0), cB + kstep, voffB); PG8_STAGE(PG8_SA(1, 0), cA + kstep, voffA); PG8_STAGE(PG8_SB(1, 1), cB + hstep + kstep, voffB);
        PG8_WAIT_V(6); PG8_BAR;
    } else {
        PG8_STAGE(PG8_SB(0, 0), cB, voffB); PG8_STAGE(PG8_SA(0, 0), cA, voffA); PG8_STAGE(PG8_SB(0, 1), cB + hstep, voffB); PG8_STAGE(PG8_SA(0, 1), cA + hstep, voffA);
        if (wr == 1) PG8_BAR;
        PG8_WAIT_V(4); PG8_BAR;
        PG8_STAGE(PG8_SB(1, 0), cB + kstep, voffB); PG8_STAGE(PG8_SA(1, 0), cA + kstep, voffA); PG8_STAGE(PG8_SB(1, 1), cB + hstep + kstep, voffB);
        PG8_WAIT_V(6); PG8_BAR;
    }
    for (;;) {
        const bool has_next = S.next(ui + 1, nxt);
        const char* nA = has_next ? (const char*)g.A + (size_t)nxt.pm * tstep : cA; const char* nB = has_next ? (const char*)g.Bt + (size_t)nxt.pn * tstep : cB;
        for (int t = 0; t < nt; t += 2) {
            const bool last = (t == nt - 2);
            const char* a1 = cA + (size_t)(t + 1) * kstep;
            const char* a2 = last ? nA : cA + (size_t)(t + 2) * kstep; const char* b2 = last ? nB : cB + (size_t)(t + 2) * kstep;
            const char* a3 = a2 + kstep; const char* b3 = b2 + kstep;
            if (last && has_next) S.a_ready(nxt);
            if constexpr (SP2) {
            PG8_LDB(B0, 0, 0); PG8_LDB(B1, 0, 1); PG8_SCHED; PG8_LDA(At, 0, 0); PG8_STAGE(PG8_SA(1, 1), a1 + hstep, voffA);
            PG8_WAIT_V(8); PG8_WAIT_L(0); PG8_BAR; PG8_MMA(0, 0, At, B0); PG8_MMA(0, 1, At, B1); PG8_BAR; PG8_SCHED;
            PG8_LDA(At, 0, 1); PG8_STAGE(PG8_SB(0, 0), b2, voffB); PG8_STAGE(PG8_SB(0, 1), b2 + hstep, voffB); PG8_STAGE(PG8_SA(0, 0), a2, voffA);
            PG8_WAIT_V(8); PG8_WAIT_L(0); PG8_BAR; PG8_MMA(1, 0, At, B0); PG8_MMA(1, 1, At, B1); PG8_BAR; PG8_SCHED;
            PG8_LDB(B0, 1, 0); PG8_LDB(B1, 1, 1); PG8_SCHED; PG8_LDA(At, 1, 0); PG8_STAGE(PG8_SA(0, 1), a2 + hstep, voffA);
            PG8_WAIT_V(8); PG8_WAIT_L(0); PG8_BAR; PG8_MMA(0, 0, At, B0); PG8_MMA(0, 1, At, B1); PG8_BAR; PG8_SCHED;
            PG8_LDA(At, 1, 1); PG8_STAGE(PG8_SB(1, 0), b3, voffB); PG8_STAGE(PG8_SB(1, 1), b3 + hstep, voffB); PG8_STAGE(PG8_SA(1, 0), a3, voffA);
            PG8_WAIT_V(8); PG8_WAIT_L(0); PG8_BAR; PG8_MMA(1, 0, At, B0); PG8_MMA(1, 1, At, B1); PG8_BAR; PG8_SCHED;
            } else {
            PG8_LDB(B0, 0, 0); PG8_SCHED; PG8_LDA(At, 0, 0); PG8_STAGE(PG8_SA(1, 1), a1 + hstep, voffA);
            PG8_WAIT_L(8); PG8_BAR; PG8_WAIT_L(0); PG8_MMA(0, 0, At, B0); PG8_BAR; PG8_SCHED;
            PG8_LDB(B1, 0, 1); PG8_STAGE(PG8_SB(0, 0), b2, voffB);
            PG8_BAR; PG8_WAIT_L(0); PG8_MMA(0, 1, At, B1); PG8_BAR;
            PG8_LDA(At, 0, 1); PG8_STAGE(PG8_SA(0, 0), a2, voffA);
            PG8_BAR; PG8_WAIT_L(0); PG8_MMA(1, 0, At, B0); PG8_BAR; PG8_SCHED;
            PG8_STAGE(PG8_SB(0, 1), b2 + hstep, voffB);
            PG8_WAIT_V(6); PG8_BAR; PG8_MMA(1, 1, At, B1); PG8_BAR;
            PG8_LDB(B0, 1, 0); PG8_SCHED; PG8_LDA(At, 1, 0); PG8_STAGE(PG8_SA(0, 1), a2 + hstep, voffA);
            PG8_WAIT_L(8); PG8_BAR; PG8_WAIT_L(0); PG8_MMA(0, 0, At, B0); PG8_BAR; PG8_SCHED;
            PG8_LDB(B1, 1, 1); PG8_STAGE(PG8_SB(1, 0), b3, voffB);
            PG8_BAR; PG8_WAIT_L(0); PG8_MMA(0, 1, At, B1); PG8_BAR;
            PG8_LDA(At, 1, 1); PG8_STAGE(PG8_SA(1, 0), a3, voffA);
            PG8_BAR; PG8_WAIT_L(0); PG8_MMA(1, 0, At, B0); PG8_BAR; PG8_SCHED;
            PG8_STAGE(PG8_SB(1, 1), b3 + hstep, voffB);
            PG8_WAIT_V(6); PG8_BAR; PG8_MMA(1, 1, At, B1); PG8_BAR;
            }
        }
        if constexpr (ALIGN_EPI) { if (wr == 0) PG8_BAR; }
        if constexpr (!Epi::AFTER_DRAIN) { E(acc, cur, wr, wc, fr, fq); S.done(cur); }
        if (!has_next) break;
#pragma unroll
        for (int a = 0; a < 2; ++a)
#pragma unroll
            for (int b = 0; b < 2; ++b)
#pragma unroll
                for (int m = 0; m < 4; ++m)
#pragma unroll
                    for (int n = 0; n < 2; ++n) acc[a][b][m][n] = (f32x4){0.f, 0.f, 0.f, 0.f};
        cur = nxt; cA = nA; cB = nB; ++ui;
        if constexpr (ALIGN_EPI) { if (wr == 1) PG8_BAR; }
    }
    PG8_WAIT_V(0);
    if constexpr (!ALIGN_EPI) { if (wr == 0) PG8_BAR; }
    PG8_BAR;
    if constexpr (Epi::AFTER_DRAIN) { E.fused(acc, cur, wr, wc, fr, fq, lds, wid, lane); S.done(cur); }
#undef PG8_SA
#undef PG8_SB
#undef PG8_STAGE
#undef PG8_LDA
#undef PG8_LDB
#undef PG8_MMA
#undef PG8_WAIT_V
#undef PG8_WAIT_L
#undef PG8_BAR
#undef PG8_SCHED
}
}
namespace att {
#define ALAS __attribute__((address_space(3)))
typedef unsigned short bf16_t;
typedef short bf16x8 __attribute__((ext_vector_type(8)));
typedef float f32x16 __attribute__((ext_vector_type(16)));
typedef float f32x4 __attribute__((ext_vector_type(4)));
typedef unsigned u32x4 __attribute__((ext_vector_type(4)));
typedef unsigned u32x2 __attribute__((ext_vector_type(2)));
constexpr int KROW = 144;
constexpr int KBUF = 64 * KROW;
constexpr int VBUF = 64 * 320;
template <int DV> struct VRow { static constexpr int B = (DV == 128) ? 320 : 192; };
constexpr int L_K = 0, L_V = 2 * KBUF, L_BT = L_V + 2 * VBUF, L_END = L_BT + 512;
constexpr int L_O1 = L_END;
constexpr int L_QS = L_O1 + 65536;
constexpr float LOG2E = 1.4426950408889634f;
constexpr float QSCALE = 0.125f * 1.4426950408889634f;
#define CR(r) (((r) & 3) + 8 * ((r) >> 2))
__device__ __forceinline__ unsigned cvtpk(float lo, float hi) { unsigned r; asm volatile("v_cvt_pk_bf16_f32 %0, %1, %2" : "=v"(r) : "v"(lo), "v"(hi)); return r; }
__device__ __forceinline__ float ex2(float x) { return __builtin_amdgcn_exp2f(x); }
__device__ __forceinline__ float rcpf_(float x) { return __builtin_amdgcn_rcpf(x); }

typedef short v4i16_t __attribute__((ext_vector_type(4)));
__device__ __forceinline__ v4i16_t vtr(const ALAS unsigned char* p) { return __builtin_amdgcn_ds_read_tr16_b64_v4i16((ALAS v4i16_t*)p); }
template <int DV> __device__ __forceinline__ bf16x8 vfrag(const ALAS unsigned char* vb, int s, int db) {
    const v4i16_t lo = vtr(vb + (16 * s) * VRow<DV>::B + 64 * db), hi4 = vtr(vb + (16 * s + 8) * VRow<DV>::B + 64 * db);
    return __builtin_shufflevector(lo, hi4, 0, 1, 2, 3, 4, 5, 6, 7);
}
template <int DV> __device__ __forceinline__ int vtr_lane_off(int lane) { return (4 * (lane >> 5) + ((lane & 15) >> 2)) * VRow<DV>::B + (16 * ((lane >> 4) & 1) + 4 * (lane & 3)) * 2; }
__device__ __forceinline__ float pair_max(float x) { auto rr = __builtin_amdgcn_permlane32_swap(__float_as_uint(x), __float_as_uint(x), false, false); return fmaxf(__uint_as_float(rr[0]), __uint_as_float(rr[1])); }
template <int DV> struct Pref { u32x4 k; u32x4 v[DV / 64]; };

template <int DV> __device__ __forceinline__ void tile_load(Pref<DV>& pf, const bf16_t* Kp, const bf16_t* Vp, int pitch, int kt, int tid) {
    const int krow = tid >> 3, kc = (tid & 7) * 8;
    pf.k = *(const u32x4*)(Kp + (size_t)(kt * 64 + krow) * pitch + kc);
#pragma unroll
    for (int i = 0; i < DV / 64; ++i) { const int c = tid + i * 512, vrow = c / (DV / 8), vc = (c % (DV / 8)) * 8;
        pf.v[i] = *(const u32x4*)(Vp + (size_t)(kt * 64 + vrow) * pitch + vc); }
}
template <int DV> __device__ __forceinline__ void tile_store(const Pref<DV>& pf, ALAS unsigned char* kbuf, ALAS unsigned char* vbuf, int tid) {
    const int krow = tid >> 3, kc = (tid & 7) * 8;
    *(ALAS u32x4*)(kbuf + krow * KROW + kc * 2) = pf.k;
#pragma unroll
    for (int i = 0; i < DV / 64; ++i) { const int c = tid + i * 512, vrow = c / (DV / 8), vc = (c % (DV / 8)) * 8;
        *(ALAS u32x4*)(vbuf + vrow * VRow<DV>::B + vc * 2) = pf.v[i]; }
}

template <int DV> __device__ __forceinline__ void pv_slab(const ALAS unsigned char* vbuf, int s, u32x4 w, f32x16 (&o)[DV / 32], int l32, int hi) {
    const bf16x8 pfr = __builtin_bit_cast(bf16x8, w);
#pragma unroll
    for (int db = 0; db < DV / 32; ++db) {
        const bf16x8 vf = vfrag<DV>(vbuf + vtr_lane_off<DV>(l32 + 32 * hi), s, db);
        o[db] = __builtin_amdgcn_mfma_f32_32x32x16_bf16(vf, pfr, o[db], 0, 0, 0); }
    if (DV > 64) __builtin_amdgcn_sched_barrier(0);
}

template <int MODE, int DV, bool MASKED>
__device__ __forceinline__ void tile_compute(const ALAS unsigned char* kbuf, const ALAS unsigned char* vbuf, const bf16x8 (&qf)[4], f32x16 (&o)[DV / 32],
                                             float& st_m, float& st_l, int lim, const ALAS float* btab, float cbias, int lane) {
    const int l32 = lane & 31, hi = lane >> 5;
    if constexpr (MODE == 0) {
        f32x16 p0, p1;
#pragma unroll
        for (int r = 0; r < 16; ++r) { p0[r] = 0.f; p1[r] = 0.f; }
        { const ALAS unsigned char* kb = kbuf + l32 * KROW + hi * 16;
#pragma unroll
          for (int d0 = 0; d0 < 4; ++d0) {
              const bf16x8 k0 = *(const ALAS bf16x8*)(kb + d0 * 32);
              const bf16x8 k1 = *(const ALAS bf16x8*)(kb + 32 * KROW + d0 * 32);
              p0 = __builtin_amdgcn_mfma_f32_32x32x16_bf16(k0, qf[d0], p0, 0, 0, 0);
              p1 = __builtin_amdgcn_mfma_f32_32x32x16_bf16(k1, qf[d0], p1, 0, 0, 0); } }
        __builtin_amdgcn_sched_barrier(0);
#pragma unroll
        for (int r = 0; r < 16; ++r) {
            float a = rcpf_(1.0f + ex2(p0[r])), b = rcpf_(1.0f + ex2(p1[r]));
            if (MASKED) { a = (CR(r) < lim) ? a : 1.0f; b = (CR(r) + 32 < lim) ? b : 1.0f; }
            p0[r] = a; p1[r] = b; }
        float g[8], hs[8], pr[8];
#pragma unroll
        for (int i = 0; i < 4; ++i) { g[i] = (p0[4 * i] * p0[4 * i + 1]) * (p0[4 * i + 2] * p0[4 * i + 3]); g[4 + i] = (p1[4 * i] * p1[4 * i + 1]) * (p1[4 * i + 2] * p1[4 * i + 3]); }
#pragma unroll
        for (int i = 0; i < 8; ++i) { auto rr = __builtin_amdgcn_permlane32_swap(__float_as_uint(g[i]), __float_as_uint(g[i]), false, false);
            pr[i] = __uint_as_float(rr[0]) * __uint_as_float(rr[1]); hs[i] = hi ? 1.0f : __uint_as_float(rr[1]); }
        float T = st_m;
#pragma unroll
        for (int i = 7; i >= 0; --i) {
            float R = hs[i] * T; T = T * pr[i];
            if (i >= 4) { const int b = 4 * (i - 4);
                float R2 = R * p1[b + 3]; p1[b + 3] = R - R2; float R1 = R2 * p1[b + 2]; p1[b + 2] = R2 - R1; float R0 = R1 * p1[b + 1]; p1[b + 1] = R1 - R0; p1[b] = R0 - R0 * p1[b]; }
            else { const int b = 4 * i;
                float R2 = R * p0[b + 3]; p0[b + 3] = R - R2; float R1 = R2 * p0[b + 2]; p0[b + 2] = R2 - R1; float R0 = R1 * p0[b + 1]; p0[b + 1] = R1 - R0; p0[b] = R0 - R0 * p0[b]; }
        }
        st_m = T;
        __builtin_amdgcn_sched_barrier(0);
#pragma unroll
        for (int s = 0; s < 4; ++s) {
            u32x4 w;
            if (s == 0) { w.x = cvtpk(p0[0], p0[1]); w.y = cvtpk(p0[2], p0[3]); w.z = cvtpk(p0[4], p0[5]); w.w = cvtpk(p0[6], p0[7]); }
            else if (s == 1) { w.x = cvtpk(p0[8], p0[9]); w.y = cvtpk(p0[10], p0[11]); w.z = cvtpk(p0[12], p0[13]); w.w = cvtpk(p0[14], p0[15]); }
            else if (s == 2) { w.x = cvtpk(p1[0], p1[1]); w.y = cvtpk(p1[2], p1[3]); w.z = cvtpk(p1[4], p1[5]); w.w = cvtpk(p1[6], p1[7]); }
            else { w.x = cvtpk(p1[8], p1[9]); w.y = cvtpk(p1[10], p1[11]); w.z = cvtpk(p1[12], p1[13]); w.w = cvtpk(p1[14], p1[15]); }
            pv_slab<DV>(vbuf, s, w, o, l32, hi);
        }
    } else {
        const float NEG = -__builtin_inff();
#pragma unroll
        for (int hk = 0; hk < 2; ++hk) {
            f32x16 p;
            const bool fresh = (st_m == NEG);
            const float mbase = fresh ? 0.f : st_m;
            { const float ini = (MASKED ? 0.f : cbias) - mbase;
#pragma unroll
              for (int r = 0; r < 16; ++r) p[r] = ini; }
            { const ALAS unsigned char* kb = kbuf + (32 * hk + l32) * KROW + hi * 16;
#pragma unroll
              for (int d0 = 0; d0 < 4; ++d0) { const bf16x8 k0 = *(const ALAS bf16x8*)(kb + d0 * 32); p = __builtin_amdgcn_mfma_f32_32x32x16_bf16(k0, qf[d0], p, 0, 0, 0); } }
            if (MASKED) {
                float bv[16];
#pragma unroll
                for (int r = 0; r < 16; ++r) { const int d0 = lim - 32 * hk - CR(r); bv[r] = btab[min(max(d0, 0), 127)]; }
#pragma unroll
                for (int r = 0; r < 16; ++r) asm volatile("" : "+v"(bv[r]));
#pragma unroll
                for (int r = 0; r < 16; ++r) {
                    const int d0 = lim - 32 * hk - CR(r);
                    const bool v0 = (MODE == 2) ? ((unsigned)d0 < 128u) : (d0 >= 0);
                    p[r] = v0 ? p[r] + bv[r] : NEG; }
            }
            float mt = fmaxf(p[0], p[1]);
#pragma unroll
            for (int r = 2; r < 16; ++r) mt = fmaxf(mt, p[r]);
            mt = fmaxf(mt, __shfl_xor(mt, 32));
            const bool need = fresh ? (mt > NEG) : (mt > 0.f);
            if (__any(need)) {
                const float dl = need ? mt : 0.f, f = fresh ? 1.0f : ex2(-dl);
                st_l *= f; st_m = need ? mbase + dl : st_m;
#pragma unroll
                for (int r = 0; r < 16; ++r) p[r] -= dl;
#pragma unroll
                for (int db = 0; db < DV / 32; ++db)
#pragma unroll
                    for (int r = 0; r < 16; ++r) o[db][r] *= f;
            }
            float s = 0.f;
#pragma unroll
            for (int r = 0; r < 16; ++r) { p[r] = ex2(p[r]); s += p[r]; }
            st_l += s;
#pragma unroll
            for (int s2 = 0; s2 < 2; ++s2) {
                u32x4 w; w.x = cvtpk(p[8 * s2], p[8 * s2 + 1]); w.y = cvtpk(p[8 * s2 + 2], p[8 * s2 + 3]); w.z = cvtpk(p[8 * s2 + 4], p[8 * s2 + 5]); w.w = cvtpk(p[8 * s2 + 6], p[8 * s2 + 7]);
                pv_slab<DV>(vbuf, 2 * hk + s2, w, o, l32, hi);
            }
        }
    }
}

template <int MODE, int DV>
__device__ __forceinline__ void attn_core(const bf16_t* Qp, const bf16_t* Kp, const bf16_t* Vp, int pitch, int q0, int kt0, int nt, int dir,
                                          ALAS unsigned char* lds, f32x16 (&o)[DV / 32], float& st_m, float& st_l) {
    int tid_ = threadIdx.x; asm volatile("" : "+v"(tid_));
    const int tid = tid_, lane = tid & 63, l32 = lane & 31, hi = lane >> 5, wid = __builtin_amdgcn_readfirstlane(tid >> 6);
    const int qw = q0 + 32 * wid, t = qw + l32;
    const ALAS float* btab = (const ALAS float*)(lds + L_BT);
    bf16x8 qf[4];
#pragma unroll
    for (int d0 = 0; d0 < 4; ++d0) qf[d0] = *(const bf16x8*)(Qp + (size_t)t * pitch + d0 * 16 + hi * 8);
#pragma unroll
    for (int db = 0; db < DV / 32; ++db)
#pragma unroll
        for (int r = 0; r < 16; ++r) o[db][r] = 0.f;
    st_m = (MODE == 0) ? 1.0f : -__builtin_inff(); st_l = 0.f;
    Pref<DV> pf;
    tile_load<DV>(pf, Kp, Vp, pitch, kt0, tid);
    tile_store<DV>(pf, lds + L_K, lds + L_V, tid);
    __syncthreads();
    const float cbias = (MODE == 1) ? btab[127] : 0.f;
    for (int it = 0; it < nt; ++it) {
        const int kt = kt0 + dir * it, cur = it & 1, kbase = kt * 64;
        tile_load<DV>(pf, Kp, Vp, pitch, (it + 1 < nt) ? kt + dir : kt, tid);
        const ALAS unsigned char* kb = lds + L_K + cur * KBUF; const ALAS unsigned char* vb = lds + L_V + cur * VBUF;
        const int lim = t - kbase - 4 * hi;
        if (MODE == 0) {
            if (kbase <= qw + 31) { if (kbase + 63 >= qw) tile_compute<0, DV, true>(kb, vb, qf, o, st_m, st_l, lim, btab, cbias, lane); else tile_compute<0, DV, false>(kb, vb, qf, o, st_m, st_l, lim, btab, cbias, lane); }
        } else if (MODE == 1) {
            if (kbase <= qw + 31) { if (qw - (kbase + 63) < 113) tile_compute<1, DV, true>(kb, vb, qf, o, st_m, st_l, lim, btab, cbias, lane); else tile_compute<1, DV, false>(kb, vb, qf, o, st_m, st_l, lim, btab, cbias, lane); }
        } else {
            if (kbase <= qw + 31 && kbase + 63 >= qw - 127) tile_compute<2, DV, true>(kb, vb, qf, o, st_m, st_l, lim, btab, cbias, lane);
        }
        if (it + 1 < nt) tile_store<DV>(pf, lds + L_K + (cur ^ 1) * KBUF, lds + L_V + (cur ^ 1) * VBUF, tid);
        if (MODE == 0) {
            if (!__syncthreads_or(st_m != 0.0f)) break;
        } else __syncthreads();
    }
}
template <int MODE, int DV>
__device__ __forceinline__ void attn_core_pp(const bf16_t* Qp, const bf16_t* Kp, const bf16_t* Vp, int pitch, int q0, int kt0, int nt,
                                             ALAS unsigned char* lds, f32x16 (&o)[DV / 32], float& st_m, float& st_l) {
    int tid_ = threadIdx.x; asm volatile("" : "+v"(tid_));
    const int tid = tid_, lane = tid & 63, l32 = lane & 31, hi = lane >> 5, wid = __builtin_amdgcn_readfirstlane(tid >> 6), grp = wid >> 2;
    const int qw = q0 + 32 * wid, t = qw + l32;
    const ALAS float* btab = (const ALAS float*)(lds + L_BT);
    const float NEG = -__builtin_inff();
    bf16x8 qf[4];
#pragma unroll
    for (int d0 = 0; d0 < 4; ++d0) qf[d0] = *(const bf16x8*)(Qp + (size_t)t * pitch + d0 * 16 + hi * 8);
    ALAS unsigned char* qst = lds + L_QS + wid * 3072 + lane * 16;
    if (DV == 128) {
#pragma unroll
        for (int d0 = 1; d0 < 4; ++d0) *(ALAS bf16x8*)(qst + (d0 - 1) * 1024) = qf[d0];
    }
#pragma unroll
    for (int db = 0; db < DV / 32; ++db)
#pragma unroll
        for (int r = 0; r < 16; ++r) o[db][r] = 0.f;
    st_m = NEG; st_l = 0.f;
    Pref<DV> pf;
    tile_load<DV>(pf, Kp, Vp, pitch, kt0, tid);
    tile_store<DV>(pf, lds + L_K, lds + L_V, tid);
    if (nt > 1) { tile_load<DV>(pf, Kp, Vp, pitch, kt0 + 1, tid); tile_store<DV>(pf, lds + L_K + KBUF, lds + L_V + VBUF, tid); }
    tile_load<DV>(pf, Kp, Vp, pitch, kt0 + min(2, nt - 1), tid);
    __syncthreads();
    const float cbias = (MODE == 1) ? btab[127] : 0.f;
    f32x16 p; u32x4 pw0, pw1;
#pragma unroll
    for (int r = 0; r < 16; ++r) p[r] = 0.f;
    pw0 = (u32x4){0u, 0u, 0u, 0u}; pw1 = pw0;
#define PP_MASKED(ti) ((MODE == 1) ? (qw - ((kt0 + (ti)) * 64 + 63) < 113) : true)
#define PP_QK(ti, hk) do { \
        const float mbase_ = (st_m == NEG) ? 0.f : st_m; const float ini_ = (PP_MASKED(ti) ? 0.f : cbias) - mbase_; \
        _Pragma("unroll") for (int r = 0; r < 16; ++r) p[r] = ini_; \
        const ALAS unsigned char* kb_ = lds + L_K + ((ti) & 1) * KBUF + (32 * (hk) + l32) * KROW + hi * 16; \
        _Pragma("unroll") for (int d0 = 0; d0 < 4; ++d0) { const bf16x8 k0_ = *(const ALAS bf16x8*)(kb_ + d0 * 32); \
            const bf16x8 qv_ = (DV == 128 && d0 > 0) ? *(const ALAS bf16x8*)(qst + (d0 - 1) * 1024) : qf[d0]; \
            p = __builtin_amdgcn_mfma_f32_32x32x16_bf16(k0_, qv_, p, 0, 0, 0); } } while (0)
#define PP_PVQK(tv, hv, tk, hq) do { \
        const ALAS unsigned char* vb_ = lds + L_V + ((tv) & 1) * VBUF + vtr_lane_off<DV>(lane); \
        const ALAS unsigned char* kb_ = lds + L_K + ((tk) & 1) * KBUF + (32 * (hq) + l32) * KROW + hi * 16; \
        bf16x8 vf_[DV / 32][2], kf_[4], qv_[4]; \
        _Pragma("unroll") for (int db = 0; db < DV / 32; ++db) { vf_[db][0] = vfrag<DV>(vb_, 2 * (hv), db); vf_[db][1] = vfrag<DV>(vb_, 2 * (hv) + 1, db); } \
        _Pragma("unroll") for (int d0 = 0; d0 < 4; ++d0) { kf_[d0] = *(const ALAS bf16x8*)(kb_ + d0 * 32); qv_[d0] = (DV == 128 && d0 > 0) ? *(const ALAS bf16x8*)(qst + (d0 - 1) * 1024) : qf[d0]; } \
        const bf16x8 pa_ = __builtin_bit_cast(bf16x8, pw0), pb_ = __builtin_bit_cast(bf16x8, pw1); \
        _Pragma("unroll") for (int db = 0; db < DV / 32; ++db) o[db] = __builtin_amdgcn_mfma_f32_32x32x16_bf16(vf_[db][0], pa_, o[db], 0, 0, 0); \
        const float mbase_ = (st_m == NEG) ? 0.f : st_m; const float ini_ = (PP_MASKED(tk) ? 0.f : cbias) - mbase_; \
        _Pragma("unroll") for (int r = 0; r < 16; ++r) p[r] = ini_; \
        _Pragma("unroll") for (int db = 0; db < DV / 32; ++db) o[db] = __builtin_amdgcn_mfma_f32_32x32x16_bf16(vf_[db][1], pb_, o[db], 0, 0, 0); \
        _Pragma("unroll") for (int d0 = 0; d0 < 4; ++d0) p = __builtin_amdgcn_mfma_f32_32x32x16_bf16(kf_[d0], qv_[d0], p, 0, 0, 0); } while (0)
#define PP_SM(ti, hk) do { \
        if (PP_MASKED(ti)) { const int lim_ = t - (kt0 + (ti)) * 64 - 4 * hi - 32 * (hk); \
            _Pragma("unroll") for (int g8 = 0; g8 < 16; g8 += 8) { float bv_[8]; \
                _Pragma("unroll") for (int r = 0; r < 8; ++r) { const int d0 = lim_ - CR(g8 + r); bv_[r] = btab[min(max(d0, 0), 127)]; } \
                _Pragma("unroll") for (int r = 0; r < 8; ++r) asm volatile("" : "+v"(bv_[r])); \
                _Pragma("unroll") for (int r = 0; r < 8; ++r) { const int d0 = lim_ - CR(g8 + r); const bool v0 = (MODE == 2) ? ((unsigned)d0 < 128u) : (d0 >= 0); p[g8 + r] = v0 ? p[g8 + r] + bv_[r] : NEG; } } } \
        const bool fresh_ = (st_m == NEG); const float mb_ = fresh_ ? 0.f : st_m; \
        float mt_ = fmaxf(p[0], p[1]); \
        _Pragma("unroll") for (int r = 2; r < 16; ++r) mt_ = fmaxf(mt_, p[r]); \
        mt_ = pair_max(mt_); \
        const bool need_ = fresh_ ? (mt_ > NEG) : (mt_ > 0.f); \
        if (__any(need_)) { const float dl_ = need_ ? mt_ : 0.f, f_ = fresh_ ? 1.0f : ex2(-dl_); \
            st_l *= f_; st_m = need_ ? mb_ + dl_ : st_m; \
            _Pragma("unroll") for (int r = 0; r < 16; ++r) p[r] -= dl_; \
            _Pragma("unroll") for (int db = 0; db < DV / 32; ++db) _Pragma("unroll") for (int r = 0; r < 16; ++r) o[db][r] *= f_; } \
        float sm_ = 0.f; \
        _Pragma("unroll") for (int r = 0; r < 16; ++r) { p[r] = ex2(p[r]); sm_ += p[r]; } \
        st_l += sm_; \
        pw0.x = cvtpk(p[0], p[1]); pw0.y = cvtpk(p[2], p[3]); pw0.z = cvtpk(p[4], p[5]); pw0.w = cvtpk(p[6], p[7]); \
        pw1.x = cvtpk(p[8], p[9]); pw1.y = cvtpk(p[10], p[11]); pw1.z = cvtpk(p[12], p[13]); pw1.w = cvtpk(p[14], p[15]); } while (0)
#define PP_STAGE(u) do { const int u_ = (u); if (u_ >= 2 && u_ < nt) tile_store<DV>(pf, lds + L_K + (u_ & 1) * KBUF, lds + L_V + (u_ & 1) * VBUF, tid); \
        tile_load<DV>(pf, Kp, Vp, pitch, kt0 + min(max(u_ + 1, 2), nt - 1), tid); } while (0)
#define PP_BAR() asm volatile("s_waitcnt lgkmcnt(0)\n\ts_barrier" ::: "memory")
    if (grp == 0) {
        PP_QK(0, 0); PP_BAR();
        for (int ti = 0; ti < nt; ++ti) {
            PP_SM(ti, 0); PP_BAR();
            PP_PVQK(ti, 0, ti, 1); PP_STAGE(ti + 1); PP_BAR();
            PP_SM(ti, 1); PP_BAR();
            PP_PVQK(ti, 1, ti + 1, 0); PP_BAR();
        }
        PP_BAR();
    } else {
        PP_BAR();
        PP_QK(0, 0); PP_BAR();
        for (int ti = 0; ti < nt; ++ti) {
            PP_SM(ti, 0); PP_STAGE(ti + 1); PP_BAR();
            PP_PVQK(ti, 0, ti, 1); PP_BAR();
            PP_SM(ti, 1); PP_BAR();
            PP_PVQK(ti, 1, ti + 1, 0); PP_BAR();
        }
    }
#undef PP_MASKED
#undef PP_QK
#undef PP_PVQK
#undef PP_SM
#undef PP_STAGE
#undef PP_BAR
}
template <int DV> __device__ __forceinline__ void store_ot(const f32x16 (&o)[DV / 32], bf16_t* orow, int hi) {
#pragma unroll
    for (int db = 0; db < DV / 32; ++db)
#pragma unroll
        for (int rg = 0; rg < 4; ++rg) { u32x2 w; w.x = cvtpk(o[db][4 * rg], o[db][4 * rg + 1]); w.y = cvtpk(o[db][4 * rg + 2], o[db][4 * rg + 3]);
            *(u32x2*)(orow + 32 * db + 8 * rg + 4 * hi) = w; }
}
}
#ifndef REP_OUT
#define REP_OUT 1
#endif
#ifndef REP_DOWN
#define REP_DOWN 1
#endif
#ifndef REP_INPROJ
#define REP_INPROJ 1
#endif
#ifndef REP_DIFF
#define REP_DIFF 1
#endif
#ifndef REP_SWA
#define REP_SWA 1
#endif
#ifndef REP_SB
#define REP_SB 1
#endif
#ifndef REP_UP
#define REP_UP 1
#endif
#ifndef REP_CONV
#define REP_CONV 1
#endif
#ifndef PH_DIFF
#define PH_DIFF 1
#endif
#ifndef PH_SWA
#define PH_SWA 1
#endif
#ifndef PH_SB
#define PH_SB 1
#endif
#ifndef PH_CONV
#define PH_CONV 1
#endif
#define LAS __attribute__((address_space(3)))
typedef unsigned short bf16;
typedef float f32x4 __attribute__((ext_vector_type(4)));
typedef unsigned v4u __attribute__((ext_vector_type(4)));
typedef unsigned v2u __attribute__((ext_vector_type(2)));
constexpr int NWAVES = 8;
constexpr int SEQ = 4096, NB = 16, MTOK = NB * SEQ, DM = 1024, DFF = 2816, DUP = 2 * DFF;
constexpr int EVEN_IN = 2304, ODD_IN = 3072;
constexpr size_t MiB = 1u << 20;
constexpr size_t WS_SSQ = 1 * MiB;
constexpr size_t WS_WINE = 8 * MiB, WS_WOUTE = 17 * MiB, WS_WINO = 21 * MiB, WS_WOUTO = 33 * MiB, WS_WUP = 37 * MiB, WS_WDN = 81 * MiB;
constexpr size_t WS_XB = 104 * MiB, WS_R = 232 * MiB;
constexpr size_t WS_PROJ = WS_R, WS_AO = WS_R + 384 * MiB, WS_U = WS_R, WS_G = WS_R + 352 * MiB;
constexpr int LDS_MISC = 150528, LDS_BYTES = 151552;
static_assert(att::L_QS + 8 * 3072 <= LDS_MISC, "LDS map");
constexpr int HALF_ROWS = MTOK / 2;

struct Args {
    const float* x; const float* rel_bias; const float* norm_mix; const float* norm_ffn; const float* norm_final;
    const float* w_in_even; const float* w_out_even; const float* sinks; const float* lam_q1; const float* lam_k1; const float* lam_q2; const float* lam_k2;
    const float* diff_norm; const float* w_in_odd; const float* w_out_odd; const float* ffn_up; const float* ffn_conv; const float* ffn_conv_b; const float* ffn_down;
    float* out; unsigned char* ws;
};

__device__ const unsigned char T5B[128] = {0, 1, 2, 3, 4, 5, 6, 7, 8, 9, 10, 11, 12, 13, 14, 15, 16, 16, 16, 17, 17, 18, 18, 18, 19, 19, 19, 20, 20, 20, 20, 21, 21, 21, 21, 22, 22, 22, 22, 22, 23, 23, 23, 23, 23, 23, 24, 24, 24, 24, 24, 24, 25, 25, 25, 25, 25, 25, 25, 26, 26, 26, 26, 26, 26, 26, 26, 27, 27, 27, 27, 27, 27, 27, 27, 27, 27, 28, 28, 28, 28, 28, 28, 28, 28, 28, 28, 29, 29, 29, 29, 29, 29, 29, 29, 29, 29, 29, 29, 30, 30, 30, 30, 30, 30, 30, 30, 30, 30, 30, 30, 30, 30, 31, 31, 31, 31, 31, 31, 31, 31, 31, 31, 31, 31, 31, 31, 31};

__device__ __forceinline__ float wave_sum(float v) {
#pragma unroll
    for (int o = 1; o < 64; o <<= 1) v += __shfl_xor(v, o);
    return v;
}
__device__ __forceinline__ unsigned f2bf(float f) { unsigned u = __builtin_bit_cast(unsigned, f); return (u + 0x7fffu + ((u >> 16) & 1u)) >> 16; }
__device__ __forceinline__ unsigned pk2(float lo, float hi) { return f2bf(lo) | (f2bf(hi) << 16); }

__device__ __forceinline__ void transpose_item(const float* W, int K, int N, bf16* WT, const float* gk, int a0, int a1, int b0, int b1, float cs, LAS float* scr, int item, int lane) {
    const int nblk = N / 32, kb = item / nblk, nb = item % nblk, k0 = 64 * kb, n0 = 32 * nb;
    const int nn = n0 + (lane & 31);
    const float csc = ((nn >= a0 && nn < a1) || (nn >= b0 && nn < b1)) ? cs : 1.0f;
#pragma unroll 8
    for (int i = 0; i < 32; ++i) { const int kk = 2 * i + (lane >> 5); const float gv = gk ? gk[k0 + kk] : 1.0f; scr[kk * 33 + (lane & 31)] = W[(size_t)(k0 + kk) * N + nn] * (gv * csc); }
    asm volatile("s_waitcnt lgkmcnt(0)" ::: "memory");
    const int c = lane & 7;
#pragma unroll
    for (int j = 0; j < 4; ++j) { const int n = (lane >> 3) + 8 * j; const LAS float* s = scr + (8 * c) * 33 + n;
        v4u o; o.x = pk2(s[0 * 33], s[1 * 33]); o.y = pk2(s[2 * 33], s[3 * 33]); o.z = pk2(s[4 * 33], s[5 * 33]); o.w = pk2(s[6 * 33], s[7 * 33]);
        *(v4u*)(WT + (size_t)(n0 + n) * K + k0 + 8 * c) = o; }
    asm volatile("s_waitcnt lgkmcnt(0)" ::: "memory");
}

#define XB_TMO      128
#define XB_XCNT(j)  (256  + 64 * (j))
#define XB_XSUB(j)  (1280 + 64 * (j))
#define XB_XGEN(j)  (2304 + 64 * (j))
#define XB_TOP      3328
#define XB_TOPGEN   3392
#define XCD_BAR_WORDS 3456
#define XB_SPIN_CAP (1u << 18)

__device__ __forceinline__ unsigned xb_ld(unsigned* p)              { return __hip_atomic_load(p, __ATOMIC_RELAXED, __HIP_MEMORY_SCOPE_AGENT); }
__device__ __forceinline__ unsigned xb_add(unsigned* p, unsigned v) { return __hip_atomic_fetch_add(p, v, __ATOMIC_RELAXED, __HIP_MEMORY_SCOPE_AGENT); }
__device__ __forceinline__ unsigned xb_xcc_id() { return (unsigned)__builtin_amdgcn_s_getreg((3 << 11) | 20) & 0xFu; }
#define XB_SPIN(cond, bar) do { unsigned _sp = 0; while (cond) { __builtin_amdgcn_s_sleep(1); \
    if ((++_sp & 255u) == 0u) { if (xb_ld(&(bar)[XB_TMO])) break; if (_sp > XB_SPIN_CAP) { atomicAdd(&(bar)[XB_TMO], 1u); break; } } } } while (0)

struct XcdBarrier {
    unsigned* bar; unsigned x;
    volatile LAS unsigned* st;
};

__device__ __forceinline__ XcdBarrier xcd_barrier_post(unsigned* bar, volatile LAS unsigned* st) {
    XcdBarrier b; b.bar = bar; b.x = xb_xcc_id(); b.st = st;
    if (threadIdx.x == 0) (void)xb_add(&bar[XB_XCNT(b.x)], 1u);
    return b;
}
__device__ __forceinline__ void xcd_barrier_complete(unsigned* bar, unsigned x, unsigned& nloc, unsigned& nx) {
    const unsigned G = gridDim.x * gridDim.y * gridDim.z;
    unsigned sum, cnt, mine, sp = 0u;
    for (;;) {
        sum = 0u; cnt = 0u; mine = 0u;
#pragma unroll
        for (unsigned j = 0; j < 16; ++j) { const unsigned c = xb_ld(&bar[XB_XCNT(j)]); sum += c; cnt += (c > 0u) ? 1u : 0u; mine = (j == x) ? c : mine; }
        if (sum == G) break;
        __builtin_amdgcn_s_sleep(1);
        if ((++sp & 255u) == 0u) { if (xb_ld(&bar[XB_TMO])) break; if (sp > XB_SPIN_CAP) { atomicAdd(&bar[XB_TMO], 1u); break; } }
    }
    nloc = mine > 0u ? mine : 1u; nx = cnt > 0u ? cnt : 1u;
}

__device__ __forceinline__ void xcd_barrier(const XcdBarrier& b) {
    asm volatile("s_waitcnt vmcnt(0)" ::: "memory");
    __syncthreads();
    if (threadIdx.x == 0) {
        unsigned* bar = b.bar;
        __builtin_amdgcn_s_waitcnt(0);
        unsigned nloc = b.st[0], nx = b.st[1];
        if (nloc == 0u) { xcd_barrier_complete(bar, b.x, nloc, nx); b.st[0] = nloc; b.st[1] = nx; }
        const unsigned old = xb_add(&bar[XB_XSUB(b.x)], 1u);
        const unsigned gen = old / nloc;
        if (old + 1u == (gen + 1u) * nloc) {
            __builtin_amdgcn_fence(__ATOMIC_RELEASE, "agent");
            asm volatile("s_waitcnt vmcnt(0)" ::: "memory");
            const unsigned og = xb_add(&bar[XB_TOP], 1u);
            const unsigned tg = og / nx;
            if (og + 1u == (tg + 1u) * nx) xb_add(&bar[XB_TOPGEN], 1u);
            else XB_SPIN(xb_ld(&bar[XB_TOPGEN]) == tg, bar);
            __builtin_amdgcn_fence(__ATOMIC_ACQUIRE, "agent");
            xb_add(&bar[XB_XGEN(b.x)], 1u);
            asm volatile("s_waitcnt vmcnt(0)" ::: "memory");
        } else {
            XB_SPIN(xb_ld(&bar[XB_XGEN(b.x)]) == gen, bar);
            __builtin_amdgcn_fence(__ATOMIC_ACQUIRE, "agent");
            asm volatile("s_waitcnt vmcnt(0)" ::: "memory");
        }
    }
    __syncthreads();
}

__global__ void __launch_bounds__(NWAVES * 64, 2) mega_fwd(Args a) {
    extern __shared__ __attribute__((aligned(16))) unsigned char lds_raw[];
    cg::grid_group grid = cg::this_grid();
    LAS unsigned char* lds = (LAS unsigned char*)lds_raw;
    const int tid = threadIdx.x, lane = tid & 63, wave = __builtin_amdgcn_readfirstlane(tid >> 6);
    const int G = gridDim.x, bx = blockIdx.x;
    const int gw = bx * NWAVES + wave, NGW = G * NWAVES;
    unsigned char* ws = a.ws;
    float* ssq = (float*)(ws + WS_SSQ);
    bf16* xb = (bf16*)(ws + WS_XB);
    bf16* proj = (bf16*)(ws + WS_PROJ);
    bf16* ao = (bf16*)(ws + WS_AO);
    bf16* ubuf = (bf16*)(ws + WS_U);
    bf16* gbuf = (bf16*)(ws + WS_G);

    if (bx == 0) for (int i = tid; i < XCD_BAR_WORDS; i += NWAVES * 64) ((unsigned*)ws)[i] = 0u;
    if (tid < 2) ((LAS unsigned*)(lds + LDS_MISC))[tid] = 0u;
    {
        LAS float* scr = (LAS float*)(lds + wave * 16384);
        constexpr int I_INE = 16 * (EVEN_IN / 32), I_OUT = 16 * 32, I_INO = 16 * (ODD_IN / 32), I_UP = 16 * (DUP / 32), I_DN = (DFF / 64) * 32;
        constexpr int NITEMS = 2 * I_INE + 2 * I_OUT + 2 * I_INO + 2 * I_OUT + 4 * I_UP + 4 * I_DN;
        for (int it = gw; it < NITEMS; it += NGW) {
            int r = it;
            if (r < 2 * I_INE) { const int e = r / I_INE; r -= e * I_INE;
                transpose_item(a.w_in_even + (size_t)e * DM * EVEN_IN, DM, EVEN_IN, (bf16*)(ws + WS_WINE) + (size_t)e * EVEN_IN * DM, a.norm_mix + (2 * e) * DM, 0, 512, 768, 1280, att::QSCALE, scr, r, lane); continue; }
            r -= 2 * I_INE;
            if (r < 2 * I_OUT) { const int e = r / I_OUT; r -= e * I_OUT;
                transpose_item(a.w_out_even + (size_t)e * DM * DM, DM, DM, (bf16*)(ws + WS_WOUTE) + (size_t)e * DM * DM, nullptr, 0, 0, 0, 0, 1.f, scr, r, lane); continue; }
            r -= 2 * I_OUT;
            if (r < 2 * I_INO) { const int e = r / I_INO; r -= e * I_INO;
                transpose_item(a.w_in_odd + (size_t)e * DM * ODD_IN, DM, ODD_IN, (bf16*)(ws + WS_WINO) + (size_t)e * ODD_IN * DM, a.norm_mix + (2 * e + 1) * DM, 0, 1024, 0, 0, att::QSCALE, scr, r, lane); continue; }
            r -= 2 * I_INO;
            if (r < 2 * I_OUT) { const int e = r / I_OUT; r -= e * I_OUT;
                transpose_item(a.w_out_odd + (size_t)e * DM * DM, DM, DM, (bf16*)(ws + WS_WOUTO) + (size_t)e * DM * DM, nullptr, 0, 0, 0, 0, 1.f, scr, r, lane); continue; }
            r -= 2 * I_OUT;
            if (r < 4 * I_UP) { const int e = r / I_UP; r -= e * I_UP;
                transpose_item(a.ffn_up + (size_t)e * DM * DUP, DM, DUP, (bf16*)(ws + WS_WUP) + (size_t)e * DUP * DM, a.norm_ffn + e * DM, 0, 0, 0, 0, 1.f, scr, r, lane); continue; }
            r -= 4 * I_UP;
            { const int e = r / I_DN; r -= e * I_DN;
                transpose_item(a.ffn_down + (size_t)e * DFF * DM, DFF, DM, (bf16*)(ws + WS_WDN) + (size_t)e * DM * DFF, nullptr, 0, 0, 0, 0, 1.f, scr, r, lane); }
        }
        for (int m = gw; m < MTOK; m += NGW) {
            const f32x4* xr = (const f32x4*)(a.x + (size_t)m * DM) + lane; f32x4 v[4]; float s = 0.f;
#pragma unroll
            for (int j = 0; j < 4; ++j) { v[j] = xr[64 * j]; s += (v[j][0] * v[j][0] + v[j][1] * v[j][1]) + (v[j][2] * v[j][2] + v[j][3] * v[j][3]); }
            s = wave_sum(s);
            v2u* o8 = (v2u*)(xb + (size_t)m * DM) + lane;
#pragma unroll
            for (int j = 0; j < 4; ++j) { v2u w; w.x = pk2(v[j][0], v[j][1]); w.y = pk2(v[j][2], v[j][3]); o8[64 * j] = w; }
            if (lane < 16) ssq[(size_t)m * 16 + lane] = (lane == 0) ? s : 0.f;
        }
    }
    grid.sync();
    const XcdBarrier xbar = xcd_barrier_post((unsigned*)ws, (volatile LAS unsigned*)(lds + LDS_MISC));

    for (int layer = 0; layer < 4; ++layer) {
        const int e = layer >> 1; const bool even = (layer & 1) == 0;
        const float* xold = (layer == 0) ? a.x : a.out;
        {
            const int N = even ? EVEN_IN : ODD_IN;
            const bf16* wt = even ? (const bf16*)(ws + WS_WINE) + (size_t)e * EVEN_IN * DM : (const bf16*)(ws + WS_WINO) + (size_t)e * ODD_IN * DM;
            pg8::Gemm g{xb, wt, MTOK, N, DM}; pg8::StaticOrder S; S.init(MTOK, N, G, bx);
            pg8::EpiScaleBf16 E{proj, N, ssq};
            for (int rep_ = 0; rep_ < REP_INPROJ; ++rep_)
            pg8::gemm_phase<pg8::EpiScaleBf16, pg8::StaticOrder, true, true>(lds, g, S, E);
        }
        xcd_barrier(xbar);
        if (even) {
            int tq = threadIdx.x; asm volatile("" : "+v"(tq)); const int tid = tq, lane = tq & 63, l32 = lane & 31, hi = lane >> 5;
            float lam, one_m_li;
            { const float li = (layer == 0) ? 0.2f : 0.47071301839f;
              const float s1 = wave_sum(a.lam_q1[e * 64 + lane] * a.lam_k1[e * 64 + lane]), s2 = wave_sum(a.lam_q2[e * 64 + lane] * a.lam_k2[e * 64 + lane]);
              lam = __expf(s1) - __expf(s2) + li; lam = __builtin_bit_cast(float, __builtin_amdgcn_readfirstlane(__builtin_bit_cast(int, lam))); one_m_li = __builtin_bit_cast(float, __builtin_amdgcn_readfirstlane(__builtin_bit_cast(int, 1.0f - li))); }
            LAS float* btab = (LAS float*)(lds + att::L_BT);

#if PH_DIFF
            for (int rep_ = 0; rep_ < REP_DIFF; ++rep_)
            for (int uidx = bx; uidx < 1024; uidx += G) {
                const int j = uidx >> 8, c = uidx & 255, bh = c >> 2, s = c & 3, b = bh >> 2, h = bh & 3;
                const int qb = (j == 0) ? s : (j == 1) ? 7 - s : (j == 2) ? 8 + s : 15 - s;
                { int tb = threadIdx.x; asm volatile("" : "+v"(tb)); if (tb < 128) btab[tb] = a.rel_bias[T5B[tb] * 12 + 8 + h] * att::LOG2E; }
                const bf16* base = proj + (size_t)b * SEQ * EVEN_IN;
                const int q0 = qb * 256, nt = 4 * qb + 4, t = q0 + 32 * wave + l32;
                att::f32x16 o2[4]; float m2, l2; LAS unsigned* o1s = (LAS unsigned*)(lds + att::L_O1 + wave * 8192) + lane;
                { float m1, l1;
                  att::attn_core_pp<1, 128>(base + 768 + h * 128, base + 1280 + h * 128, base + 1792 + h * 128, EVEN_IN, q0, 0, nt, lds, o2, m1, l1);
                  const float inv = __builtin_amdgcn_rcpf(l1 + __shfl_xor(l1, 32));
#pragma unroll
                  for (int db = 0; db < 4; ++db)
#pragma unroll
                      for (int k = 0; k < 8; ++k) o1s[(db * 8 + k) * 64] = att::cvtpk(o2[db][2 * k] * inv, o2[db][2 * k + 1] * inv); }
                att::attn_core_pp<1, 128>(base + 768 + h * 128 + 64, base + 1280 + h * 128 + 64, base + 1792 + h * 128, EVEN_IN, q0, 0, nt, lds, o2, m2, l2);
                { const float inv = lam * __builtin_amdgcn_rcpf(l2 + __shfl_xor(l2, 32)); float ss = 0.f;
#pragma unroll
                  for (int db = 0; db < 4; ++db)
#pragma unroll
                      for (int r = 0; r < 16; ++r) { const unsigned w = o1s[(db * 8 + (r >> 1)) * 64]; const float a1 = __uint_as_float((r & 1) ? (w & 0xffff0000u) : (w << 16));
                          const float v = a1 - inv * o2[db][r]; o2[db][r] = v; ss += v * v; }
                  ss += __shfl_xor(ss, 32);
                  const float rs = __builtin_amdgcn_rsqf(ss * (1.0f / 128.0f) + 1e-6f) * one_m_li;
                  const float* gn = a.diff_norm + e * 128;
#pragma unroll
                  for (int db = 0; db < 4; ++db)
#pragma unroll
                      for (int rg = 0; rg < 4; ++rg) { const f32x4 gv = *(const f32x4*)(gn + 32 * db + 8 * rg + 4 * hi);
#pragma unroll
                          for (int k = 0; k < 4; ++k) o2[db][4 * rg + k] *= rs * gv[k]; } }
                { int tb = threadIdx.x; asm volatile("" : "+v"(tb)); const int t2 = q0 + 32 * (tb >> 6) + (tb & 31);
                  att::store_ot<128>(o2, ao + ((size_t)b * SEQ + t2) * DM + 512 + h * 128, (tb >> 5) & 1); }
            }
#endif
#if PH_SWA
            for (int rep_ = 0; rep_ < REP_SWA; ++rep_)
            for (int uidx = bx; uidx < 2048; uidx += G) {
                const int qb = uidx & 15, qh = (uidx >> 4) & 7, b = uidx >> 7, kvh = qh >> 2;
                { int tb = threadIdx.x; asm volatile("" : "+v"(tb)); if (tb < 128) btab[tb] = a.rel_bias[T5B[tb] * 12 + qh] * att::LOG2E; }
                const bf16* base = proj + (size_t)b * SEQ * EVEN_IN;
                const int q0 = qb * 256, t = q0 + 32 * wave + l32;
                const int kt0 = (qb * 4 - 2 > 0) ? qb * 4 - 2 : 0, nt = qb * 4 + 4 - kt0;
                att::f32x16 o[2]; float m, l;
                att::attn_core_pp<2, 64>(base + qh * 64, base + 512 + kvh * 64, base + 640 + kvh * 64, EVEN_IN, q0, kt0, nt, lds, o, m, l);
                const float sk = a.sinks[e * 8 + qh] * att::LOG2E;
                const float inv = __builtin_amdgcn_rcpf(l + __shfl_xor(l, 32) + __builtin_amdgcn_exp2f(sk - m));
#pragma unroll
                for (int db = 0; db < 2; ++db)
#pragma unroll
                    for (int r = 0; r < 16; ++r) o[db][r] *= inv;
                att::store_ot<64>(o, ao + ((size_t)b * SEQ + t) * DM + qh * 64, hi);
            }
#endif
        } else {
#if PH_SB
            int tq = threadIdx.x; asm volatile("" : "+v"(tq)); const int lane = tq & 63, l32 = lane & 31, hi = lane >> 5;
            for (int rep_ = 0; rep_ < REP_SB; ++rep_)
            for (int uidx = bx; uidx < 4096; uidx += G) {
                const int bh = uidx & 255, qb = 15 - (uidx >> 8), b = bh >> 4, h = bh & 15;
                const bf16* base = proj + (size_t)b * SEQ * ODD_IN;
                const int q0 = qb * 256, nt = 4 * qb + 4, t = q0 + 32 * wave + l32;
                att::f32x16 o[2]; float P, dummy;
                att::attn_core<0, 64>(base + h * 64, base + 1024 + h * 64, base + 2048 + h * 64, ODD_IN, q0, nt - 1, nt, -1, lds, o, P, dummy);
                att::store_ot<64>(o, ao + ((size_t)b * SEQ + t) * DM + h * 64, hi);
            }
#endif
        }
        xcd_barrier(xbar);
        {
            const bf16* wt = even ? (const bf16*)(ws + WS_WOUTE) + (size_t)e * DM * DM : (const bf16*)(ws + WS_WOUTO) + (size_t)e * DM * DM;
            pg8::Gemm g{ao, wt, MTOK, DM, DM}; pg8::StaticOrder S; S.init(MTOK, DM, G, bx);
#if REP_OUT > 1
            { pg8::EpiResid Ed{xold, (float*)(ws + WS_PROJ), (bf16*)(ws + WS_PROJ + 256 * MiB), (float*)(ws + 800 * MiB)};
              pg8::gemm_phase<pg8::EpiResid, pg8::StaticOrder, true, true>(lds, g, S, Ed); }
#endif
            pg8::EpiResid E{xold, a.out, xb, ssq};
            pg8::gemm_phase<pg8::EpiResid, pg8::StaticOrder, true, true>(lds, g, S, E);
        }
        xcd_barrier(xbar);
        const bf16* wup = (const bf16*)(ws + WS_WUP) + (size_t)layer * DUP * DM;
        const bf16* wdn = (const bf16*)(ws + WS_WDN) + (size_t)layer * DM * DFF;
        for (int half = 0; half < 2; ++half) {
            const size_t r0 = (size_t)half * HALF_ROWS;
            {
                pg8::Gemm g{xb + r0 * DM, wup, HALF_ROWS, DUP, DM}; pg8::StaticOrder S; S.init(HALF_ROWS, DUP, G, bx);
                pg8::EpiScaleBf16 E{ubuf, DUP, ssq + r0 * 16};
                for (int rep_ = 0; rep_ < REP_UP; ++rep_)
                pg8::gemm_phase<pg8::EpiScaleBf16, pg8::StaticOrder, true, true>(lds, g, S, E);
            }
            xcd_barrier(xbar);
#if PH_CONV
            {
                const float* cw = a.ffn_conv + (size_t)layer * 3 * DUP; const float* cb = a.ffn_conv_b + (size_t)layer * DUP;
                constexpr int NCC = 6, NRC = HALF_ROWS / 32;
                int tq = threadIdx.x; asm volatile("" : "+v"(tq)); const int lane = tq & 63;
                for (int rep_ = 0; rep_ < REP_CONV; ++rep_)
                for (int it = gw; it < NCC * NRC; it += NGW) {
                    const int cc = it % NCC, rc = it / NCC, cgp = cc * 64 + lane;
                    if (cgp < DFF / 8) {
                        const int col = cgp * 8, row0 = rc * 32;
                        float wg[3][8], wv[3][8], bg[8], bv[8];
#pragma unroll
                        for (int tp = 0; tp < 3; ++tp)
#pragma unroll
                            for (int k = 0; k < 8; k += 4) { const f32x4 t1 = *(const f32x4*)(cw + tp * DUP + col + k), t2 = *(const f32x4*)(cw + tp * DUP + DFF + col + k);
#pragma unroll
                                for (int q = 0; q < 4; ++q) { wg[tp][k + q] = t1[q]; wv[tp][k + q] = t2[q]; } }
#pragma unroll
                        for (int k = 0; k < 8; k += 4) { const f32x4 t1 = *(const f32x4*)(cb + col + k), t2 = *(const f32x4*)(cb + DFF + col + k);
#pragma unroll
                            for (int q = 0; q < 4; ++q) { bg[k + q] = t1[q]; bv[k + q] = t2[q]; } }
                        float g2[8], g1[8], v2[8], v1[8];
                        const bool head = (row0 % SEQ) == 0;
                        {
                            v4u a2 = {0, 0, 0, 0}, a1 = {0, 0, 0, 0}, c2 = {0, 0, 0, 0}, c1 = {0, 0, 0, 0};
                            if (!head) { const bf16* up = ubuf + (size_t)(row0 - 2) * DUP + col; a2 = *(const v4u*)up; c2 = *(const v4u*)(up + DFF); a1 = *(const v4u*)(up + DUP); c1 = *(const v4u*)(up + DUP + DFF); }
#pragma unroll
                            for (int k = 0; k < 8; ++k) { const int sh = (k & 1) * 16;
                                g2[k] = __uint_as_float(((a2[k >> 1] >> sh) & 0xffffu) << 16); g1[k] = __uint_as_float(((a1[k >> 1] >> sh) & 0xffffu) << 16);
                                v2[k] = __uint_as_float(((c2[k >> 1] >> sh) & 0xffffu) << 16); v1[k] = __uint_as_float(((c1[k >> 1] >> sh) & 0xffffu) << 16); }
                        }
                        for (int r = 0; r < 32; ++r) {
                            const bf16* up = ubuf + (size_t)(row0 + r) * DUP + col;
                            const v4u a0 = *(const v4u*)up, c0 = *(const v4u*)(up + DFF);
                            float res[8];
#pragma unroll
                            for (int k = 0; k < 8; ++k) { const int sh = (k & 1) * 16;
                                const float g0 = __uint_as_float(((a0[k >> 1] >> sh) & 0xffffu) << 16), v0 = __uint_as_float(((c0[k >> 1] >> sh) & 0xffffu) << 16);
                                const float gg = bg[k] + wg[0][k] * g2[k] + wg[1][k] * g1[k] + wg[2][k] * g0;
                                const float vv = bv[k] + wv[0][k] * v2[k] + wv[1][k] * v1[k] + wv[2][k] * v0;
                                const float sg = gg * __builtin_amdgcn_rcpf(1.0f + __builtin_amdgcn_exp2f(-gg * att::LOG2E));
                                res[k] = sg * vv; g2[k] = g1[k]; g1[k] = g0; v2[k] = v1[k]; v1[k] = v0; }
                            v4u w; w.x = pk2(res[0], res[1]); w.y = pk2(res[2], res[3]); w.z = pk2(res[4], res[5]); w.w = pk2(res[6], res[7]);
                            *(v4u*)(gbuf + (size_t)(row0 + r) * DFF + col) = w;
                        }
                    }
                }
            }
#endif
            xcd_barrier(xbar);
            {
                pg8::Gemm g{gbuf, wdn, HALF_ROWS, DM, DFF}; pg8::StaticOrder S; S.init(HALF_ROWS, DM, G, bx);
#if REP_DOWN > 1
                { pg8::EpiResid Ed{a.out + r0 * DM, (float*)(ws + 760 * MiB), (bf16*)(ws + 888 * MiB), (float*)(ws + 960 * MiB)};
                  pg8::gemm_phase<pg8::EpiResid, pg8::StaticOrder, true, true>(lds, g, S, Ed); }
#endif
                pg8::EpiResid E{a.out + r0 * DM, a.out + r0 * DM, xb + r0 * DM, ssq + r0 * 16};
                pg8::gemm_phase<pg8::EpiResid, pg8::StaticOrder, true, true>(lds, g, S, E);
            }
            if (half == 1) xcd_barrier(xbar);
        }
    }
    { int tq = threadIdx.x; asm volatile("" : "+v"(tq)); const int lane = tq & 63;
    for (int m = gw; m < MTOK; m += NGW) {
        f32x4* xr = (f32x4*)(a.out + (size_t)m * DM) + lane; f32x4 v[4]; float s = 0.f;
#pragma unroll
        for (int j = 0; j < 4; ++j) { v[j] = xr[64 * j]; s += (v[j][0] * v[j][0] + v[j][1] * v[j][1]) + (v[j][2] * v[j][2] + v[j][3] * v[j][3]); }
        s = wave_sum(s);
        const float rs = __builtin_amdgcn_rsqf(s * (1.0f / DM) + 1e-6f);
#pragma unroll
        for (int j = 0; j < 4; ++j) { const f32x4 gv = *((const f32x4*)a.norm_final + lane + 64 * j); xr[64 * j] = v[j] * rs * gv; }
    } }
}

extern "C" void kernel_launch(void* const* d_in, const int* in_sizes, int n_in, void* d_out, int out_size, void* d_ws, size_t ws_size, hipStream_t stream) {
    static int grid = 0;
    if (grid == 0) {
        int dev = 0, cus = 0, per_cu = 0;
        (void)hipGetDevice(&dev);
        (void)hipDeviceGetAttribute(&cus, hipDeviceAttributeMultiprocessorCount, dev);
        (void)hipFuncSetAttribute((const void*)mega_fwd, hipFuncAttributeMaxDynamicSharedMemorySize, LDS_BYTES);
        (void)hipOccupancyMaxActiveBlocksPerMultiprocessor(&per_cu, (const void*)mega_fwd, NWAVES * 64, LDS_BYTES);
        if (per_cu < 1) per_cu = 1;
        grid = cus * per_cu;
        if (n_in != 19 || ws_size < 1024 * MiB) fprintf(stderr, "kernel_launch: unexpected n_in %d / ws %zu\n", n_in, ws_size);
    }
    Args a{};
    a.x = (const float*)d_in[0]; a.rel_bias = (const float*)d_in[1]; a.norm_mix = (const float*)d_in[2]; a.norm_ffn = (const float*)d_in[3]; a.norm_final = (const float*)d_in[4];
    a.w_in_even = (const float*)d_in[5]; a.w_out_even = (const float*)d_in[6]; a.sinks = (const float*)d_in[7]; a.lam_q1 = (const float*)d_in[8]; a.lam_k1 = (const float*)d_in[9];
    a.lam_q2 = (const float*)d_in[10]; a.lam_k2 = (const float*)d_in[11]; a.diff_norm = (const float*)d_in[12]; a.w_in_odd = (const float*)d_in[13]; a.w_out_odd = (const float*)d_in[14];
    a.ffn_up = (const float*)d_in[15]; a.ffn_conv = (const float*)d_in[16]; a.ffn_conv_b = (const float*)d_in[17]; a.ffn_down = (const float*)d_in[18];
    a.out = (float*)d_out; a.ws = (unsigned char*)d_ws;
    void* args[] = {&a};
    hipError_t err = hipLaunchCooperativeKernel((const void*)mega_fwd, dim3(grid), dim3(NWAVES * 64), args, LDS_BYTES, stream);
    if (err != hipSuccess) fprintf(stderr, "kernel_launch: cooperative launch failed: %s (grid %d)\n", hipGetErrorString(err), grid);
}
```

```cpp
#include <hip/hip_runtime.h>
#include <hip/hip_cooperative_groups.h>
#include <cstdio>
#include <cstdint>
namespace cg = cooperative_groups;
namespace pg8 {
#define PG8_LAS __attribute__((address_space(3)))
typedef unsigned short bf16_t;
typedef short bf16x8 __attribute__((ext_vector_type(8)));
typedef float f32x4 __attribute__((ext_vector_type(4)));
typedef unsigned u32x4 __attribute__((ext_vector_type(4)));
constexpr int BM = 256, BK = 64, HALF = 128, HTB = HALF * BK * 2  , STAGE_BYTES = 8 * HTB, NXCD = 8, WGM = 8;

__host__ __device__ __forceinline__ int lds_byte(int r, int c) { const int st = (r >> 4) * 2 + (c >> 5), rr = r & 15, cc = c & 31, ob = rr * 64 + cc * 2; return st * 1024 + (ob ^ (((ob >> 9) & 1) << 5)); }
__host__ __device__ __forceinline__ void stage_rc(int b, int& R, int& C) { const int st = b / 1024, sb = b % 1024, swz = sb ^ (((sb >> 9) & 1) << 5); R = (st >> 1) * 16 + swz / 64; C = (st & 1) * 32 + (swz % 64) / 2; }
__host__ __device__ __forceinline__ int perm32(int rho) { const int n = rho >> 4, i = rho & 15; return 8 * (i >> 2) + 4 * n + (i & 3); }

struct Unit { int pm, pn; };
struct Gemm { const bf16_t* A; const bf16_t* Bt; int M, N, K; };

struct StaticOrder {
    int nM, nN, nwg, G, c;
    __host__ __device__ void init(int M, int N, int G_, int c_) { nM = M / BM; nN = N / BM; nwg = nM * nN; G = G_; c = c_; }
    __host__ __device__ bool next(int i, Unit& u) const {
        const long L = (long)i * G + c; if (L >= nwg) return false;
        int wgid = (int)L; { const int q = nwg / NXCD, r = nwg % NXCD, xcd = wgid % NXCD, off = wgid / NXCD; wgid = (xcd < r ? xcd * (q + 1) : r * (q + 1) + (xcd - r) * q) + off; }
        const int nig = WGM * nN, gid = wgid / nig, fm = gid * WGM, gsz = (nM - fm) < WGM ? (nM - fm) : WGM;
        u.pm = fm + ((wgid % nig) % gsz); u.pn = (wgid % nig) / gsz; return true;
    }
    __device__ __forceinline__ void a_ready(const Unit&) const {}
    __device__ __forceinline__ void done(const Unit&) const {}
};

__device__ __forceinline__ unsigned cvt_pk_bf16(float lo, float hi) { unsigned r; asm volatile("v_cvt_pk_bf16_f32 %0, %1, %2" : "=v"(r) : "v"(lo), "v"(hi)); return r; }
typedef float f32x2 __attribute__((ext_vector_type(2)));
typedef unsigned u32x2 __attribute__((ext_vector_type(2)));
constexpr float RMS_EPS = 1e-6f;
struct EpiScaleBf16 {
    static constexpr bool PERM = true, AFTER_DRAIN = false;
    bf16_t* O; int ldc; const float* ssq;
    __device__ __forceinline__ void operator()(const f32x4 (&acc)[2][2][4][2], const Unit& u, int wr, int wc, int fr, int fq) const {
        const int row0 = u.pm * BM + wr * 64 + fr, col0 = u.pn * BM + wc * 32 + 8 * fq;
        f32x4 part[2][4];
#pragma unroll
        for (int ai = 0; ai < 2; ++ai)
#pragma unroll
            for (int m = 0; m < 4; ++m) part[ai][m] = *(const f32x4*)(ssq + (size_t)(row0 + ai * HALF + m * 16) * 16 + fq * 4);
#pragma unroll
        for (int ai = 0; ai < 2; ++ai)
#pragma unroll
            for (int m = 0; m < 4; ++m) { const int row = row0 + ai * HALF + m * 16; bf16_t* rowp = O + (size_t)row * ldc + col0;
                float t = (part[ai][m][0] + part[ai][m][1]) + (part[ai][m][2] + part[ai][m][3]);
                t += __shfl_xor(t, 16); t += __shfl_xor(t, 32);
                const float rs = __builtin_amdgcn_rsqf(t * (1.0f / 1024.0f) + RMS_EPS);
#pragma unroll
                for (int bj = 0; bj < 2; ++bj) { const f32x4 v0 = acc[ai][bj][m][0] * rs, v1 = acc[ai][bj][m][1] * rs;
                    u32x4 w; w.x = cvt_pk_bf16(v0[0], v0[1]); w.y = cvt_pk_bf16(v0[2], v0[3]); w.z = cvt_pk_bf16(v1[0], v1[1]); w.w = cvt_pk_bf16(v1[2], v1[3]);
                    *(u32x4*)(rowp + bj * HALF) = w; } }
    }
};
struct EpiResid {
    static constexpr bool PERM = true, AFTER_DRAIN = false;
    const float* base; float* out; bf16_t* xb; float* ssq;
    __device__ __forceinline__ void operator()(const f32x4 (&acc)[2][2][4][2], const Unit& u, int wr, int wc, int fr, int fq) const {
        const int col0 = u.pn * BM + wc * 32 + 8 * fq;
        const size_t off0 = (size_t)(u.pm * BM + wr * 64 + fr) * 1024 + col0;
        f32x4 nx[2][2][2];
#pragma unroll
        for (int g = 0; g < 2; ++g) { const size_t offn = off0 + (size_t)(g * 16) * 1024;
#pragma unroll
            for (int bj = 0; bj < 2; ++bj)
#pragma unroll
                for (int n = 0; n < 2; ++n) nx[g][bj][n] = *(const f32x4*)(base + offn + bj * HALF + n * 4); }
        asm volatile("" ::: "memory");
#pragma unroll
        for (int g = 0; g < 8; ++g) { const int ai = g >> 2, m = g & 3; const int row = u.pm * BM + ai * HALF + wr * 64 + m * 16 + fr; const size_t off = (size_t)row * 1024 + col0; float q = 0.f;
            f32x4 cu[2][2];
#pragma unroll
            for (int bj = 0; bj < 2; ++bj)
#pragma unroll
                for (int n = 0; n < 2; ++n) cu[bj][n] = nx[g & 1][bj][n];
            if (g < 6) { const size_t offn = off0 + (size_t)(((g + 2) >> 2) * HALF + ((g + 2) & 3) * 16) * 1024;
#pragma unroll
                for (int bj = 0; bj < 2; ++bj)
#pragma unroll
                    for (int n = 0; n < 2; ++n) nx[g & 1][bj][n] = *(const f32x4*)(base + offn + bj * HALF + n * 4); }
#pragma unroll
            for (int bj = 0; bj < 2; ++bj) { const f32x4 o0 = cu[bj][0] + acc[ai][bj][m][0], o1 = cu[bj][1] + acc[ai][bj][m][1];
                *(f32x4*)(out + off + bj * HALF) = o0; *(f32x4*)(out + off + bj * HALF + 4) = o1;
                q += ((o0[0] * o0[0] + o0[1] * o0[1]) + (o0[2] * o0[2] + o0[3] * o0[3])) + ((o1[0] * o1[0] + o1[1] * o1[1]) + (o1[2] * o1[2] + o1[3] * o1[3]));
                u32x4 w; w.x = cvt_pk_bf16(o0[0], o0[1]); w.y = cvt_pk_bf16(o0[2], o0[3]); w.z = cvt_pk_bf16(o1[0], o1[1]); w.w = cvt_pk_bf16(o1[2], o1[3]);
                *(u32x4*)(xb + off + bj * HALF) = w; }
            q += __shfl_xor(q, 16); q += __shfl_xor(q, 32);
            if (fq == 0) ssq[(size_t)row * 16 + u.pn * 4 + wc] = q;
            asm volatile("" ::: "memory"); }
    }
};
template <class Epi, class Sched, bool ALIGN_EPI = false, bool SP2 = false>
__device__ __forceinline__ void gemm_phase(PG8_LAS unsigned char* lds, const Gemm g, const Sched& S, const Epi& E) {
    int tid_ = threadIdx.x; asm volatile("" : "+v"(tid_));
    const int tid = tid_, wid = __builtin_amdgcn_readfirstlane(tid >> 6), lane = tid & 63, wr = wid >> 2, wc = wid & 3, fr = lane & 15, fq = lane >> 4;
    const int K = g.K, nt = K / BK;
    unsigned voffA[2], voffB[2];
#pragma unroll
    for (int i = 0; i < 2; ++i) { int R, C; stage_rc(tid * 16 + i * 8192, R, C); const int Rb = Epi::PERM ? ((R & ~31) + perm32(R & 31)) : R;
        voffA[i] = (unsigned)(R * K + C) * 2u; voffB[i] = (unsigned)(Rb * K + C) * 2u; }
    const size_t kstep = (size_t)(BK * 2);
    const size_t hstep = (size_t)HALF * K * 2;
    const size_t tstep = 2 * hstep;
    const unsigned ldsw = (unsigned)wid * 1024u;
    const int aoff = lds_byte(wr * 64 + fr, fq * 8), boff = lds_byte(wc * 32 + fr, fq * 8);
#define PG8_SA(b, h) (((b) * 2 + (h)) * HTB)
#define PG8_SB(b, h) ((4 + (b) * 2 + (h)) * HTB)
#define PG8_STAGE(bufoff, gbase, voff) do { _Pragma("unroll") for (int _i = 0; _i < 2; ++_i) \
        __builtin_amdgcn_global_load_lds((const unsigned*)((const char*)(gbase) + (voff)[_i]), (PG8_LAS unsigned*)(lds + (bufoff) + ldsw + _i * 8192), 16, 0, 0); } while (0)
#define PG8_LDA(dst, b, h) do { _Pragma("unroll") for (int m = 0; m < 4; ++m) _Pragma("unroll") for (int k = 0; k < 2; ++k) dst[m][k] = *(const PG8_LAS bf16x8*)(lds + PG8_SA(b, h) + aoff + m * 2048 + k * 1024); } while (0)
#define PG8_LDB(dst, b, h) do { _Pragma("unroll") for (int n = 0; n < 2; ++n) _Pragma("unroll") for (int k = 0; k < 2; ++k) dst[n][k] = *(const PG8_LAS bf16x8*)(lds + PG8_SB(b, h) + boff + n * 2048 + k * 1024); } while (0)
#define PG8_MMA(ai, bj, At, Bt) do { __builtin_amdgcn_s_setprio(1); _Pragma("unroll") for (int m = 0; m < 4; ++m) _Pragma("unroll") for (int n = 0; n < 2; ++n) _Pragma("unroll") for (int k = 0; k < 2; ++k) \
        acc[ai][bj][m][n] = __builtin_amdgcn_mfma_f32_16x16x32_bf16(Bt[n][k], At[m][k], acc[ai][bj][m][n], 0, 0, 0); __builtin_amdgcn_s_setprio(0); } while (0)
#define PG8_WAIT_V(n) asm volatile("s_waitcnt vmcnt(" #n ")" ::: "memory")
#define PG8_WAIT_L(n) asm volatile("s_waitcnt lgkmcnt(" #n ")" ::: "memory")
#define PG8_BAR __builtin_amdgcn_s_barrier()
#define PG8_SCHED __builtin_amdgcn_sched_barrier(0)
    Unit cur, nxt; int ui = 0;
    if (!S.next(0, cur)) return;
    f32x4 acc[2][2][4][2];
#pragma unroll
    for (int a = 0; a < 2; ++a)
#pragma unroll
        for (int b = 0; b < 2; ++b)
#pragma unroll
            for (int m = 0; m < 4; ++m)
#pragma unroll
                for (int n = 0; n < 2; ++n) acc[a][b][m][n] = (f32x4){0.f, 0.f, 0.f, 0.f};
    bf16x8 At[4][2], B0[2][2], B1[2][2];
    const char* cA = (const char*)g.A + (size_t)cur.pm * tstep; const char* cB = (const char*)g.Bt + (size_t)cur.pn * tstep;
    S.a_ready(cur);
    if constexpr (SP2) {
        PG8_STAGE(PG8_SB(0, 0), cB, voffB); PG8_STAGE(PG8_SB(0, 1), cB + hstep, voffB); PG8_STAGE(PG8_SA(0, 0), cA, voffA); PG8_STAGE(PG8_SA(0, 1), cA + hstep, voffA);
        if (wr == 1) PG8_BAR;
        PG8_WAIT_V(2); PG8_BAR;
        PG8_STAGE(PG8_SB(1, 0), cB + kstep, voffB); PG8_STAGE(PG8_SA(1, 0), cA + kstep, voffA); PG8_STAGE(PG8_SB(1, 1), cB + hstep + kstep, voffB);
        PG8_WAIT_V(6); PG8_BAR;
    } else {
        PG8_STAGE(PG8_SB(0, 0), cB, voffB); PG8_STAGE(PG8_SA(0, 0), cA, voffA); PG8_STAGE(PG8_SB(0, 1), cB + hstep, voffB); PG8_STAGE(PG8_SA(0, 1), cA + hstep, voffA);
        if (wr == 1) PG8_BAR;
        PG8_WAIT_V(4); PG8_BAR;
        PG8_STAGE(PG8_SB(1, 0), cB + kstep, voffB); PG8_STAGE(PG8_SA(1, 0), cA + kstep, voffA); PG8_STAGE(PG8_SB(1, 1), cB + hstep + kstep, voffB);
        PG8_WAIT_V(6); PG8_BAR;
    }
    for (;;) {
        const bool has_next = S.next(ui + 1, nxt);
        const char* nA = has_next ? (const char*)g.A + (size_t)nxt.pm * tstep : cA; const char* nB = has_next ? (const char*)g.Bt + (size_t)nxt.pn * tstep : cB;
        for (int t = 0; t < nt; t += 2) {
            const bool last = (t == nt - 2);
            const char* a1 = cA + (size_t)(t + 1) * kstep;
            const char* a2 = last ? nA : cA + (size_t)(t + 2) * kstep; const char* b2 = last ? nB : cB + (size_t)(t + 2) * kstep;
            const char* a3 = a2 + kstep; const char* b3 = b2 + kstep;
            if (last && has_next) S.a_ready(nxt);
            if constexpr (SP2) {
            PG8_LDB(B0, 0, 0); PG8_LDB(B1, 0, 1); PG8_SCHED; PG8_LDA(At, 0, 0); PG8_STAGE(PG8_SA(1, 1), a1 + hstep, voffA);
            PG8_WAIT_V(8); PG8_WAIT_L(0); PG8_BAR; PG8_MMA(0, 0, At, B0); PG8_MMA(0, 1, At, B1); PG8_BAR; PG8_SCHED;
            PG8_LDA(At, 0, 1); PG8_STAGE(PG8_SB(0, 0), b2, voffB); PG8_STAGE(PG8_SB(0, 1), b2 + hstep, voffB); PG8_STAGE(PG8_SA(0, 0), a2, voffA);
            PG8_WAIT_V(8); PG8_WAIT_L(0); PG8_BAR; PG8_MMA(1, 0, At, B0); PG8_MMA(1, 1, At, B1); PG8_BAR; PG8_SCHED;
            PG8_LDB(B0, 1, 0); PG8_LDB(B1, 1, 1); PG8_SCHED; PG8_LDA(At, 1, 0); PG8_STAGE(PG8_SA(0, 1), a2 + hstep, voffA);
            PG8_WAIT_V(8); PG8_WAIT_L(0); PG8_BAR; PG8_MMA(0, 0, At, B0); PG8_MMA(0, 1, At, B1); PG8_BAR; PG8_SCHED;
            PG8_LDA(At, 1, 1); PG8_STAGE(PG8_SB(1, 0), b3, voffB); PG8_STAGE(PG8_SB(1, 1), b3 + hstep, voffB); PG8_STAGE(PG8_SA(1, 0), a3, voffA);
            PG8_WAIT_V(8); PG8_WAIT_L(0); PG8_BAR; PG8_MMA(1, 0, At, B0); PG8_MMA(1, 1, At, B1); PG8_BAR; PG8_SCHED;
            } else {
            PG8_LDB(B0, 0, 0); PG8_SCHED; PG8_LDA(At, 0, 0); PG8_STAGE(PG8_SA(1, 1), a1 + hstep, voffA);
            PG8_WAIT_L(8); PG8_BAR; PG8_WAIT_L(0); PG8_MMA(0, 0, At, B0); PG8_BAR; PG8_SCHED;
            PG8_LDB(B1, 0, 1); PG8_STAGE(PG8_SB(0, 0), b2, voffB);
            PG8_BAR; PG8_WAIT_L(0); PG8_MMA(0, 1, At, B1); PG8_BAR;
            PG8_LDA(At, 0, 1); PG8_STAGE(PG8_SA(0, 0), a2, voffA);
            PG8_BAR; PG8_WAIT_L(0); PG8_MMA(1, 0, At, B0); PG8_BAR; PG8_SCHED;
            PG8_STAGE(PG8_SB(0, 1), b2 + hstep, voffB);
            PG8_WAIT_V(6); PG8_BAR; PG8_MMA(1, 1, At, B1); PG8_BAR;
            PG8_LDB(B0, 1, 0); PG8_SCHED; PG8_LDA(At, 1, 0); PG8_STAGE(PG8_SA(0, 1), a2 + hstep, voffA);
            PG8_WAIT_L(8); PG8_BAR; PG8_WAIT_L(0); PG8_MMA(0, 0, At, B0); PG8_BAR; PG8_SCHED;
            PG8_LDB(B1, 1, 1); PG8_STAGE(PG8_SB(1, 0), b3, voffB);
            PG8_BAR; PG8_WAIT_L(0); PG8_MMA(0, 1, At, B1); PG8_BAR;
            PG8_LDA(At, 1, 1); PG8_STAGE(PG8_SA(1, 0), a3, voffA);
            PG8_BAR; PG8_WAIT_L(0); PG8_MMA(1, 0, At, B0); PG8_BAR; PG8_SCHED;
            PG8_STAGE(PG8_SB(1, 1), b3 + hstep, voffB);
            PG8_WAIT_V(6); PG8_BAR; PG8_MMA(1, 1, At, B1); PG8_BAR;
            }
        }
        if constexpr (ALIGN_EPI) { if (wr == 0) PG8_BAR; }
        if constexpr (!Epi::AFTER_DRAIN) { E(acc, cur, wr, wc, fr, fq); S.done(cur); }
        if (!has_next) break;
#pragma unroll
        for (int a = 0; a < 2; ++a)
#pragma unroll
            for (int b = 0; b < 2; ++b)
#pragma unroll
                for (int m = 0; m < 4; ++m)
#pragma unroll
                    for (int n = 0; n < 2; ++n) acc[a][b][m][n] = (f32x4){0.f, 0.f, 0.f, 0.f};
        cur = nxt; cA = nA; cB = nB; ++ui;
        if constexpr (ALIGN_EPI) { if (wr == 1) PG8_BAR; }
    }
    PG8_WAIT_V(0);
    if constexpr (!ALIGN_EPI) { if (wr == 0) PG8_BAR; }
    PG8_BAR;
    if constexpr (Epi::AFTER_DRAIN) { E.fused(acc, cur, wr, wc, fr, fq, lds, wid, lane); S.done(cur); }
#undef PG8_SA
#undef PG8_SB
#undef PG8_STAGE
#undef PG8_LDA
#undef PG8_LDB
#undef PG8_MMA
#undef PG8_WAIT_V
#undef PG8_WAIT_L
#undef PG8_BAR
#undef PG8_SCHED
}
}
namespace att {
#define ALAS __attribute__((address_space(3)))
typedef unsigned short bf16_t;
typedef short bf16x8 __attribute__((ext_vector_type(8)));
typedef float f32x16 __attribute__((ext_vector_type(16)));
typedef float f32x4 __attribute__((ext_vector_type(4)));
typedef unsigned u32x4 __attribute__((ext_vector_type(4)));
typedef unsigned u32x2 __attribute__((ext_vector_type(2)));
constexpr int KROW = 144;
constexpr int KBUF = 64 * KROW;
constexpr int VBUF = 64 * 320;
template <int DV> struct VRow { static constexpr int B = (DV == 128) ? 320 : 192; };
constexpr int L_K = 0, L_V = 2 * KBUF, L_BT = L_V + 2 * VBUF, L_END = L_BT + 512;
constexpr int L_O1 = L_END;
constexpr int L_QS = L_O1 + 65536;
constexpr float LOG2E = 1.4426950408889634f;
constexpr float QSCALE = 0.125f * 1.4426950408889634f;
#define CR(r) (((r) & 3) + 8 * ((r) >> 2))
__device__ __forceinline__ unsigned cvtpk(float lo, float hi) { unsigned r; asm volatile("v_cvt_pk_bf16_f32 %0, %1, %2" : "=v"(r) : "v"(lo), "v"(hi)); return r; }
__device__ __forceinline__ float ex2(float x) { return __builtin_amdgcn_exp2f(x); }
__device__ __forceinline__ float rcpf_(float x) { return __builtin_amdgcn_rcpf(x); }

typedef short v4i16_t __attribute__((ext_vector_type(4)));
__device__ __forceinline__ v4i16_t vtr(const ALAS unsigned char* p) { return __builtin_amdgcn_ds_read_tr16_b64_v4i16((ALAS v4i16_t*)p); }
template <int DV> __device__ __forceinline__ bf16x8 vfrag(const ALAS unsigned char* vb, int s, int db) {
    const v4i16_t lo = vtr(vb + (16 * s) * VRow<DV>::B + 64 * db), hi4 = vtr(vb + (16 * s + 8) * VRow<DV>::B + 64 * db);
    return __builtin_shufflevector(lo, hi4, 0, 1, 2, 3, 4, 5, 6, 7);
}
template <int DV> __device__ __forceinline__ int vtr_lane_off(int lane) { return (4 * (lane >> 5) + ((lane & 15) >> 2)) * VRow<DV>::B + (16 * ((lane >> 4) & 1) + 4 * (lane & 3)) * 2; }
__device__ __forceinline__ float pair_max(float x) { auto rr = __builtin_amdgcn_permlane32_swap(__float_as_uint(x), __float_as_uint(x), false, false); return fmaxf(__uint_as_float(rr[0]), __uint_as_float(rr[1])); }
template <int DV> struct Pref { u32x4 k; u32x4 v[DV / 64]; };

template <int DV> __device__ __forceinline__ void tile_load(Pref<DV>& pf, const bf16_t* Kp, const bf16_t* Vp, int pitch, int kt, int tid) {
    const int krow = tid >> 3, kc = (tid & 7) * 8;
    pf.k = *(const u32x4*)(Kp + (size_t)(kt * 64 + krow) * pitch + kc);
#pragma unroll
    for (int i = 0; i < DV / 64; ++i) { const int c = tid + i * 512, vrow = c / (DV / 8), vc = (c % (DV / 8)) * 8;
        pf.v[i] = *(const u32x4*)(Vp + (size_t)(kt * 64 + vrow) * pitch + vc); }
}
template <int DV> __device__ __forceinline__ void tile_store(const Pref<DV>& pf, ALAS unsigned char* kbuf, ALAS unsigned char* vbuf, int tid) {
    const int krow = tid >> 3, kc = (tid & 7) * 8;
    *(ALAS u32x4*)(kbuf + krow * KROW + kc * 2) = pf.k;
#pragma unroll
    for (int i = 0; i < DV / 64; ++i) { const int c = tid + i * 512, vrow = c / (DV / 8), vc = (c % (DV / 8)) * 8;
        *(ALAS u32x4*)(vbuf + vrow * VRow<DV>::B + vc * 2) = pf.v[i]; }
}

template <int DV> __device__ __forceinline__ void pv_slab(const ALAS unsigned char* vbuf, int s, u32x4 w, f32x16 (&o)[DV / 32], int l32, int hi) {
    const bf16x8 pfr = __builtin_bit_cast(bf16x8, w);
#pragma unroll
    for (int db = 0; db < DV / 32; ++db) {
        const bf16x8 vf = vfrag<DV>(vbuf + vtr_lane_off<DV>(l32 + 32 * hi), s, db);
        o[db] = __builtin_amdgcn_mfma_f32_32x32x16_bf16(vf, pfr, o[db], 0, 0, 0); }
    if (DV > 64) __builtin_amdgcn_sched_barrier(0);
}

template <int MODE, int DV, bool MASKED>
__device__ __forceinline__ void tile_compute(const ALAS unsigned char* kbuf, const ALAS unsigned char* vbuf, const bf16x8 (&qf)[4], f32x16 (&o)[DV / 32],
                                             float& st_m, float& st_l, int lim, const ALAS float* btab, float cbias, int lane) {
    const int l32 = lane & 31, hi = lane >> 5;
    if constexpr (MODE == 0) {
        f32x16 p0, p1;
#pragma unroll
        for (int r = 0; r < 16; ++r) { p0[r] = 0.f; p1[r] = 0.f; }
        { const ALAS unsigned char* kb = kbuf + l32 * KROW + hi * 16;
#pragma unroll
          for (int d0 = 0; d0 < 4; ++d0) {
              const bf16x8 k0 = *(const ALAS bf16x8*)(kb + d0 * 32);
              const bf16x8 k1 = *(const ALAS bf16x8*)(kb + 32 * KROW + d0 * 32);
              p0 = __builtin_amdgcn_mfma_f32_32x32x16_bf16(k0, qf[d0], p0, 0, 0, 0);
              p1 = __builtin_amdgcn_mfma_f32_32x32x16_bf16(k1, qf[d0], p1, 0, 0, 0); } }
        __builtin_amdgcn_sched_barrier(0);
#pragma unroll
        for (int r = 0; r < 16; ++r) {
            float a = rcpf_(1.0f + ex2(p0[r])), b = rcpf_(1.0f + ex2(p1[r]));
            if (MASKED) { a = (CR(r) < lim) ? a : 1.0f; b = (CR(r) + 32 < lim) ? b : 1.0f; }
            p0[r] = a; p1[r] = b; }
        float g[8], hs[8], pr[8];
#pragma unroll
        for (int i = 0; i < 4; ++i) { g[i] = (p0[4 * i] * p0[4 * i + 1]) * (p0[4 * i + 2] * p0[4 * i + 3]); g[4 + i] = (p1[4 * i] * p1[4 * i + 1]) * (p1[4 * i + 2] * p1[4 * i + 3]); }
#pragma unroll
        for (int i = 0; i < 8; ++i) { auto rr = __builtin_amdgcn_permlane32_swap(__float_as_uint(g[i]), __float_as_uint(g[i]), false, false);
            pr[i] = __uint_as_float(rr[0]) * __uint_as_float(rr[1]); hs[i] = hi ? 1.0f : __uint_as_float(rr[1]); }
        float T = st_m;
#pragma unroll
        for (int i = 7; i >= 0; --i) {
            float R = hs[i] * T; T = T * pr[i];
            if (i >= 4) { const int b = 4 * (i - 4);
                float R2 = R * p1[b + 3]; p1[b + 3] = R - R2; float R1 = R2 * p1[b + 2]; p1[b + 2] = R2 - R1; float R0 = R1 * p1[b + 1]; p1[b + 1] = R1 - R0; p1[b] = R0 - R0 * p1[b]; }
            else { const int b = 4 * i;
                float R2 = R * p0[b + 3]; p0[b + 3] = R - R2; float R1 = R2 * p0[b + 2]; p0[b + 2] = R2 - R1; float R0 = R1 * p0[b + 1]; p0[b + 1] = R1 - R0; p0[b] = R0 - R0 * p0[b]; }
        }
        st_m = T;
        __builtin_amdgcn_sched_barrier(0);
#pragma unroll
        for (int s = 0; s < 4; ++s) {
            u32x4 w;
            if (s == 0) { w.x = cvtpk(p0[0], p0[1]); w.y = cvtpk(p0[2], p0[3]); w.z = cvtpk(p0[4], p0[5]); w.w = cvtpk(p0[6], p0[7]); }
            else if (s == 1) { w.x = cvtpk(p0[8], p0[9]); w.y = cvtpk(p0[10], p0[11]); w.z = cvtpk(p0[12], p0[13]); w.w = cvtpk(p0[14], p0[15]); }
            else if (s == 2) { w.x = cvtpk(p1[0], p1[1]); w.y = cvtpk(p1[2], p1[3]); w.z = cvtpk(p1[4], p1[5]); w.w = cvtpk(p1[6], p1[7]); }
            else { w.x = cvtpk(p1[8], p1[9]); w.y = cvtpk(p1[10], p1[11]); w.z = cvtpk(p1[12], p1[13]); w.w = cvtpk(p1[14], p1[15]); }
            pv_slab<DV>(vbuf, s, w, o, l32, hi);
        }
    } else {
        const float NEG = -__builtin_inff();
#pragma unroll
        for (int hk = 0; hk < 2; ++hk) {
            f32x16 p;
            const bool fresh = (st_m == NEG);
            const float mbase = fresh ? 0.f : st_m;
            { const float ini = (MASKED ? 0.f : cbias) - mbase;
#pragma unroll
              for (int r = 0; r < 16; ++r) p[r] = ini; }
            { const ALAS unsigned char* kb = kbuf + (32 * hk + l32) * KROW + hi * 16;
#pragma unroll
              for (int d0 = 0; d0 < 4; ++d0) { const bf16x8 k0 = *(const ALAS bf16x8*)(kb + d0 * 32); p = __builtin_amdgcn_mfma_f32_32x32x16_bf16(k0, qf[d0], p, 0, 0, 0); } }
            if (MASKED) {
                float bv[16];
#pragma unroll
                for (int r = 0; r < 16; ++r) { const int d0 = lim - 32 * hk - CR(r); bv[r] = btab[min(max(d0, 0), 127)]; }
#pragma unroll
                for (int r = 0; r < 16; ++r) asm volatile("" : "+v"(bv[r]));
#pragma unroll
                for (int r = 0; r < 16; ++r) {
                    const int d0 = lim - 32 * hk - CR(r);
                    const bool v0 = (MODE == 2) ? ((unsigned)d0 < 128u) : (d0 >= 0);
                    p[r] = v0 ? p[r] + bv[r] : NEG; }
            }
            float mt = fmaxf(p[0], p[1]);
#pragma unroll
            for (int r = 2; r < 16; ++r) mt = fmaxf(mt, p[r]);
            mt = fmaxf(mt, __shfl_xor(mt, 32));
            const bool need = fresh ? (mt > NEG) : (mt > 0.f);
            if (__any(need)) {
                const float dl = need ? mt : 0.f, f = fresh ? 1.0f : ex2(-dl);
                st_l *= f; st_m = need ? mbase + dl : st_m;
#pragma unroll
                for (int r = 0; r < 16; ++r) p[r] -= dl;
#pragma unroll
                for (int db = 0; db < DV / 32; ++db)
#pragma unroll
                    for (int r = 0; r < 16; ++r) o[db][r] *= f;
            }
            float s = 0.f;
#pragma unroll
            for (int r = 0; r < 16; ++r) { p[r] = ex2(p[r]); s += p[r]; }
            st_l += s;
#pragma unroll
            for (int s2 = 0; s2 < 2; ++s2) {
                u32x4 w; w.x = cvtpk(p[8 * s2], p[8 * s2 + 1]); w.y = cvtpk(p[8 * s2 + 2], p[8 * s2 + 3]); w.z = cvtpk(p[8 * s2 + 4], p[8 * s2 + 5]); w.w = cvtpk(p[8 * s2 + 6], p[8 * s2 + 7]);
                pv_slab<DV>(vbuf, 2 * hk + s2, w, o, l32, hi);
            }
        }
    }
}

template <int MODE, int DV>
__device__ __forceinline__ void attn_core(const bf16_t* Qp, const bf16_t* Kp, const bf16_t* Vp, int pitch, int q0, int kt0, int nt, int dir,
                                          ALAS unsigned char* lds, f32x16 (&o)[DV / 32], float& st_m, float& st_l) {
    int tid_ = threadIdx.x; asm volatile("" : "+v"(tid_));
    const int tid = tid_, lane = tid & 63, l32 = lane & 31, hi = lane >> 5, wid = __builtin_amdgcn_readfirstlane(tid >> 6);
    const int qw = q0 + 32 * wid, t = qw + l32;
    const ALAS float* btab = (const ALAS float*)(lds + L_BT);
    bf16x8 qf[4];
#pragma unroll
    for (int d0 = 0; d0 < 4; ++d0) qf[d0] = *(const bf16x8*)(Qp + (size_t)t * pitch + d0 * 16 + hi * 8);
#pragma unroll
    for (int db = 0; db < DV / 32; ++db)
#pragma unroll
        for (int r = 0; r < 16; ++r) o[db][r] = 0.f;
    st_m = (MODE == 0) ? 1.0f : -__builtin_inff(); st_l = 0.f;
    Pref<DV> pfA, pfB;
    tile_load<DV>(pfA, Kp, Vp, pitch, kt0, tid);
    tile_load<DV>(pfB, Kp, Vp, pitch, kt0 + dir * min(1, nt - 1), tid);
    tile_store<DV>(pfA, lds + L_K, lds + L_V, tid);
    __syncthreads();
    const float cbias = (MODE == 1) ? btab[127] : 0.f;
    bool done = false;
#define AC_STEP(it_, PFN, PFS) do { \
        const int it = (it_), kt = kt0 + dir * it, cur = it & 1, kbase = kt * 64; \
        tile_load<DV>(PFN, Kp, Vp, pitch, kt0 + dir * min(it + 2, nt - 1), tid);        \
        const ALAS unsigned char* kb = lds + L_K + cur * KBUF; const ALAS unsigned char* vb = lds + L_V + cur * VBUF; \
        const int lim = t - kbase - 4 * hi; \
        if (MODE == 0) { \
            if (kbase <= qw + 31 && __any(st_m != 0.0f)) { if (kbase + 63 >= qw) tile_compute<0, DV, true>(kb, vb, qf, o, st_m, st_l, lim, btab, cbias, lane); else tile_compute<0, DV, false>(kb, vb, qf, o, st_m, st_l, lim, btab, cbias, lane); } \
        } else if (MODE == 1) { \
            if (kbase <= qw + 31) { if (qw - (kbase + 63) < 113) tile_compute<1, DV, true>(kb, vb, qf, o, st_m, st_l, lim, btab, cbias, lane); else tile_compute<1, DV, false>(kb, vb, qf, o, st_m, st_l, lim, btab, cbias, lane); } \
        } else { \
            if (kbase <= qw + 31 && kbase + 63 >= qw - 127) tile_compute<2, DV, true>(kb, vb, qf, o, st_m, st_l, lim, btab, cbias, lane); \
        } \
        if (it + 1 < nt) tile_store<DV>(PFS, lds + L_K + (cur ^ 1) * KBUF, lds + L_V + (cur ^ 1) * VBUF, tid);     \
        if (MODE == 0) { \
              \
            if (!__syncthreads_or(st_m != 0.0f)) done = true; \
        } else __syncthreads(); } while (0)
    for (int it2 = 0; it2 < nt && !done; it2 += 2) {
        AC_STEP(it2, pfA, pfB);
        if (done) break;
        AC_STEP(it2 + 1, pfB, pfA);
    }
#undef AC_STEP
}
template <int MODE, int DV>
__device__ __forceinline__ void attn_core_pp(const bf16_t* Qp, const bf16_t* Kp, const bf16_t* Vp, int pitch, int q0, int kt0, int nt,
                                             ALAS unsigned char* lds, f32x16 (&o)[DV / 32], float& st_m, float& st_l) {
    int tid_ = threadIdx.x; asm volatile("" : "+v"(tid_));
    const int tid = tid_, lane = tid & 63, l32 = lane & 31, hi = lane >> 5, wid = __builtin_amdgcn_readfirstlane(tid >> 6), grp = wid >> 2;
    const int qw = q0 + 32 * wid, t = qw + l32;
    const ALAS float* btab = (const ALAS float*)(lds + L_BT);
    const float NEG = -__builtin_inff();
    bf16x8 qf[4];
#pragma unroll
    for (int d0 = 0; d0 < 4; ++d0) qf[d0] = *(const bf16x8*)(Qp + (size_t)t * pitch + d0 * 16 + hi * 8);
    ALAS unsigned char* qst = lds + L_QS + wid * 3072 + lane * 16;
    if (DV == 128) {
#pragma unroll
        for (int d0 = 1; d0 < 4; ++d0) *(ALAS bf16x8*)(qst + (d0 - 1) * 1024) = qf[d0];
    }
#pragma unroll
    for (int db = 0; db < DV / 32; ++db)
#pragma unroll
        for (int r = 0; r < 16; ++r) o[db][r] = 0.f;
    st_m = NEG; st_l = 0.f;
    Pref<DV> pfA, pfB;
    tile_load<DV>(pfA, Kp, Vp, pitch, kt0, tid);
    tile_load<DV>(pfB, Kp, Vp, pitch, kt0 + 1, tid);
    tile_store<DV>(pfA, lds + L_K, lds + L_V, tid);
    tile_store<DV>(pfB, lds + L_K + KBUF, lds + L_V + VBUF, tid);
    tile_load<DV>(pfA, Kp, Vp, pitch, kt0 + min(2, nt - 1), tid);
    tile_load<DV>(pfB, Kp, Vp, pitch, kt0 + min(3, nt - 1), tid);
    __syncthreads();
    const float cbias = (MODE == 1) ? btab[127] : 0.f;
    f32x16 p; u32x4 pw0, pw1;
#pragma unroll
    for (int r = 0; r < 16; ++r) p[r] = 0.f;
    pw0 = (u32x4){0u, 0u, 0u, 0u}; pw1 = pw0;
#define PP_MASKED(ti) ((MODE == 1) ? (qw - ((kt0 + (ti)) * 64 + 63) < 113) : true)
#define PP_QK(ti, hk) do { \
        const float mbase_ = (st_m == NEG) ? 0.f : st_m; const float ini_ = (PP_MASKED(ti) ? 0.f : cbias) - mbase_; \
        _Pragma("unroll") for (int r = 0; r < 16; ++r) p[r] = ini_; \
        const ALAS unsigned char* kb_ = lds + L_K + ((ti) & 1) * KBUF + (32 * (hk) + l32) * KROW + hi * 16; \
        _Pragma("unroll") for (int d0 = 0; d0 < 4; ++d0) { const bf16x8 k0_ = *(const ALAS bf16x8*)(kb_ + d0 * 32); \
            const bf16x8 qv_ = (DV == 128 && d0 > 0) ? *(const ALAS bf16x8*)(qst + (d0 - 1) * 1024) : qf[d0]; \
            p = __builtin_amdgcn_mfma_f32_32x32x16_bf16(k0_, qv_, p, 0, 0, 0); } } while (0)
#define PP_PVQK(tv, hv, tk, hq) do { \
        const ALAS unsigned char* vb_ = lds + L_V + ((tv) & 1) * VBUF + vtr_lane_off<DV>(lane); \
        const ALAS unsigned char* kb_ = lds + L_K + ((tk) & 1) * KBUF + (32 * (hq) + l32) * KROW + hi * 16; \
        bf16x8 vf_[DV / 32][2], kf_[4], qv_[4]; \
        _Pragma("unroll") for (int db = 0; db < DV / 32; ++db) { vf_[db][0] = vfrag<DV>(vb_, 2 * (hv), db); vf_[db][1] = vfrag<DV>(vb_, 2 * (hv) + 1, db); } \
        _Pragma("unroll") for (int d0 = 0; d0 < 4; ++d0) { kf_[d0] = *(const ALAS bf16x8*)(kb_ + d0 * 32); qv_[d0] = (DV == 128 && d0 > 0) ? *(const ALAS bf16x8*)(qst + (d0 - 1) * 1024) : qf[d0]; } \
        const bf16x8 pa_ = __builtin_bit_cast(bf16x8, pw0), pb_ = __builtin_bit_cast(bf16x8, pw1); \
        _Pragma("unroll") for (int db = 0; db < DV / 32; ++db) o[db] = __builtin_amdgcn_mfma_f32_32x32x16_bf16(vf_[db][0], pa_, o[db], 0, 0, 0); \
        const float mbase_ = (st_m == NEG) ? 0.f : st_m; const float ini_ = (PP_MASKED(tk) ? 0.f : cbias) - mbase_; \
        _Pragma("unroll") for (int r = 0; r < 16; ++r) p[r] = ini_; \
        _Pragma("unroll") for (int db = 0; db < DV / 32; ++db) o[db] = __builtin_amdgcn_mfma_f32_32x32x16_bf16(vf_[db][1], pb_, o[db], 0, 0, 0); \
        _Pragma("unroll") for (int d0 = 0; d0 < 4; ++d0) p = __builtin_amdgcn_mfma_f32_32x32x16_bf16(kf_[d0], qv_[d0], p, 0, 0, 0); } while (0)
#define PP_SM(ti, hk) do { \
        if (PP_MASKED(ti)) { const int lim_ = t - (kt0 + (ti)) * 64 - 4 * hi - 32 * (hk); \
            _Pragma("unroll") for (int g8 = 0; g8 < 16; g8 += 8) { float bv_[8]; \
                _Pragma("unroll") for (int r = 0; r < 8; ++r) { const int d0 = lim_ - CR(g8 + r); bv_[r] = btab[min(max(d0, 0), 127)]; } \
                _Pragma("unroll") for (int r = 0; r < 8; ++r) asm volatile("" : "+v"(bv_[r])); \
                _Pragma("unroll") for (int r = 0; r < 8; ++r) { const int d0 = lim_ - CR(g8 + r); const bool v0 = (MODE == 2) ? ((unsigned)d0 < 128u) : (d0 >= 0); p[g8 + r] = v0 ? p[g8 + r] + bv_[r] : NEG; } } } \
        const bool fresh_ = (st_m == NEG); const float mb_ = fresh_ ? 0.f : st_m; \
        float mt_ = fmaxf(p[0], p[1]); \
        _Pragma("unroll") for (int r = 2; r < 16; ++r) mt_ = fmaxf(mt_, p[r]); \
        mt_ = pair_max(mt_); \
        const bool need_ = fresh_ ? (mt_ > NEG) : (mt_ > 0.f); \
        if (__any(need_)) { const float dl_ = need_ ? mt_ : 0.f, f_ = fresh_ ? 1.0f : ex2(-dl_); \
            st_l *= f_; st_m = need_ ? mb_ + dl_ : st_m; \
            _Pragma("unroll") for (int r = 0; r < 16; ++r) p[r] -= dl_; \
            _Pragma("unroll") for (int db = 0; db < DV / 32; ++db) _Pragma("unroll") for (int r = 0; r < 16; ++r) o[db][r] *= f_; } \
        float sm_ = 0.f; \
        _Pragma("unroll") for (int r = 0; r < 16; ++r) { p[r] = ex2(p[r]); sm_ += p[r]; } \
        st_l += sm_; \
        pw0.x = cvtpk(p[0], p[1]); pw0.y = cvtpk(p[2], p[3]); pw0.z = cvtpk(p[4], p[5]); pw0.w = cvtpk(p[6], p[7]); \
        pw1.x = cvtpk(p[8], p[9]); pw1.y = cvtpk(p[10], p[11]); pw1.z = cvtpk(p[12], p[13]); pw1.w = cvtpk(p[14], p[15]); } while (0)
#define PP_STAGE(u, PF) do { const int u_ = (u); if (u_ >= 2 && u_ < nt) tile_store<DV>(PF, lds + L_K + (u_ & 1) * KBUF, lds + L_V + (u_ & 1) * VBUF, tid); \
        tile_load<DV>(PF, Kp, Vp, pitch, kt0 + min(u_ + 2, nt - 1), tid); } while (0)
#define PP_BAR() asm volatile("s_waitcnt lgkmcnt(0)\n\ts_barrier" ::: "memory")
    if (grp == 0) {
        PP_QK(0, 0); PP_BAR();
        for (int ti = 0; ti < nt; ti += 2) {
            PP_SM(ti, 0); PP_BAR();
            PP_PVQK(ti, 0, ti, 1); PP_STAGE(ti + 1, pfB); PP_BAR();
            PP_SM(ti, 1); PP_BAR();
            PP_PVQK(ti, 1, ti + 1, 0); PP_BAR();
            PP_SM(ti + 1, 0); PP_BAR();
            PP_PVQK(ti + 1, 0, ti + 1, 1); PP_STAGE(ti + 2, pfA); PP_BAR();
            PP_SM(ti + 1, 1); PP_BAR();
            PP_PVQK(ti + 1, 1, ti + 2, 0); PP_BAR();
        }
        PP_BAR();
    } else {
        PP_BAR();
        PP_QK(0, 0); PP_BAR();
        for (int ti = 0; ti < nt; ti += 2) {
            PP_SM(ti, 0); PP_STAGE(ti + 1, pfB); PP_BAR();
            PP_PVQK(ti, 0, ti, 1); PP_BAR();
            PP_SM(ti, 1); PP_BAR();
            PP_PVQK(ti, 1, ti + 1, 0); PP_BAR();
            PP_SM(ti + 1, 0); PP_STAGE(ti + 2, pfA); PP_BAR();
            PP_PVQK(ti + 1, 0, ti + 1, 1); PP_BAR();
            PP_SM(ti + 1, 1); PP_BAR();
            PP_PVQK(ti + 1, 1, ti + 2, 0); PP_BAR();
        }
    }
#undef PP_MASKED
#undef PP_QK
#undef PP_PVQK
#undef PP_SM
#undef PP_STAGE
#undef PP_BAR
}
template <int DV> __device__ __forceinline__ void store_ot(const f32x16 (&o)[DV / 32], bf16_t* orow, int hi) {
#pragma unroll
    for (int db = 0; db < DV / 32; ++db)
#pragma unroll
        for (int rg = 0; rg < 4; ++rg) { u32x2 w; w.x = cvtpk(o[db][4 * rg], o[db][4 * rg + 1]); w.y = cvtpk(o[db][4 * rg + 2], o[db][4 * rg + 3]);
            *(u32x2*)(orow + 32 * db + 8 * rg + 4 * hi) = w; }
}
}
#ifndef REP_OUT
#define REP_OUT 1
#endif
#ifndef REP_DOWN
#define REP_DOWN 1
#endif
#ifndef REP_INPROJ
#define REP_INPROJ 1
#endif
#ifndef REP_DIFF
#define REP_DIFF 1
#endif
#ifndef REP_SWA
#define REP_SWA 1
#endif
#ifndef REP_SB
#define REP_SB 1
#endif
#ifndef REP_UP
#define REP_UP 1
#endif
#ifndef REP_CONV
#define REP_CONV 1
#endif
#ifndef PH_DIFF
#define PH_DIFF 1
#endif
#ifndef PH_SWA
#define PH_SWA 1
#endif
#ifndef PH_SB
#define PH_SB 1
#endif
#ifndef PH_CONV
#define PH_CONV 1
#endif
#define LAS __attribute__((address_space(3)))
typedef unsigned short bf16;
typedef float f32x4 __attribute__((ext_vector_type(4)));
typedef unsigned v4u __attribute__((ext_vector_type(4)));
typedef unsigned v2u __attribute__((ext_vector_type(2)));
constexpr int NWAVES = 8;
constexpr int SEQ = 4096, NB = 16, MTOK = NB * SEQ, DM = 1024, DFF = 2816, DUP = 2 * DFF;
constexpr int EVEN_IN = 2304, ODD_IN = 3072;
constexpr size_t MiB = 1u << 20;
constexpr size_t WS_SSQ = 1 * MiB;
constexpr size_t WS_WINE = 8 * MiB, WS_WOUTE = 17 * MiB, WS_WINO = 21 * MiB, WS_WOUTO = 33 * MiB, WS_WUP = 37 * MiB, WS_WDN = 81 * MiB;
constexpr size_t WS_XB = 104 * MiB, WS_R = 232 * MiB;
constexpr size_t WS_PROJ = WS_R, WS_AO = WS_R + 384 * MiB, WS_U = WS_R, WS_G = WS_R + 352 * MiB;
constexpr int LDS_MISC = 150528, LDS_BYTES = 151552;
static_assert(att::L_QS + 8 * 3072 <= LDS_MISC, "LDS map");
constexpr int HALF_ROWS = MTOK / 2;

struct Args {
    const float* x; const float* rel_bias; const float* norm_mix; const float* norm_ffn; const float* norm_final;
    const float* w_in_even; const float* w_out_even; const float* sinks; const float* lam_q1; const float* lam_k1; const float* lam_q2; const float* lam_k2;
    const float* diff_norm; const float* w_in_odd; const float* w_out_odd; const float* ffn_up; const float* ffn_conv; const float* ffn_conv_b; const float* ffn_down;
    float* out; unsigned char* ws;
};

__device__ const unsigned char T5B[128] = {0, 1, 2, 3, 4, 5, 6, 7, 8, 9, 10, 11, 12, 13, 14, 15, 16, 16, 16, 17, 17, 18, 18, 18, 19, 19, 19, 20, 20, 20, 20, 21, 21, 21, 21, 22, 22, 22, 22, 22, 23, 23, 23, 23, 23, 23, 24, 24, 24, 24, 24, 24, 25, 25, 25, 25, 25, 25, 25, 26, 26, 26, 26, 26, 26, 26, 26, 27, 27, 27, 27, 27, 27, 27, 27, 27, 27, 28, 28, 28, 28, 28, 28, 28, 28, 28, 28, 29, 29, 29, 29, 29, 29, 29, 29, 29, 29, 29, 29, 30, 30, 30, 30, 30, 30, 30, 30, 30, 30, 30, 30, 30, 30, 31, 31, 31, 31, 31, 31, 31, 31, 31, 31, 31, 31, 31, 31, 31};

__device__ __forceinline__ float wave_sum(float v) {
#pragma unroll
    for (int o = 1; o < 64; o <<= 1) v += __shfl_xor(v, o);
    return v;
}
__device__ __forceinline__ unsigned f2bf(float f) { unsigned u = __builtin_bit_cast(unsigned, f); return (u + 0x7fffu + ((u >> 16) & 1u)) >> 16; }
__device__ __forceinline__ unsigned pk2(float lo, float hi) { return f2bf(lo) | (f2bf(hi) << 16); }

__device__ __forceinline__ void transpose_item(const float* W, int K, int N, bf16* WT, const float* gk, int a0, int a1, int b0, int b1, float cs, LAS float* scr, int item, int lane) {
    const int nblk = N / 32, kb = item / nblk, nb = item % nblk, k0 = 64 * kb, n0 = 32 * nb;
    const int nn = n0 + (lane & 31);
    const float csc = ((nn >= a0 && nn < a1) || (nn >= b0 && nn < b1)) ? cs : 1.0f;
#pragma unroll 8
    for (int i = 0; i < 32; ++i) { const int kk = 2 * i + (lane >> 5); const float gv = gk ? gk[k0 + kk] : 1.0f; scr[kk * 33 + (lane & 31)] = W[(size_t)(k0 + kk) * N + nn] * (gv * csc); }
    asm volatile("s_waitcnt lgkmcnt(0)" ::: "memory");
    const int c = lane & 7;
#pragma unroll
    for (int j = 0; j < 4; ++j) { const int n = (lane >> 3) + 8 * j; const LAS float* s = scr + (8 * c) * 33 + n;
        v4u o; o.x = pk2(s[0 * 33], s[1 * 33]); o.y = pk2(s[2 * 33], s[3 * 33]); o.z = pk2(s[4 * 33], s[5 * 33]); o.w = pk2(s[6 * 33], s[7 * 33]);
        *(v4u*)(WT + (size_t)(n0 + n) * K + k0 + 8 * c) = o; }
    asm volatile("s_waitcnt lgkmcnt(0)" ::: "memory");
}

#define XB_TMO      128
#define XB_XCNT(j)  (256  + 64 * (j))
#define XB_XSUB(j)  (1280 + 64 * (j))
#define XB_XGEN(j)  (2304 + 64 * (j))
#define XB_TOP      3328
#define XB_TOPGEN   3392
#define XCD_BAR_WORDS 3456
#define XB_SPIN_CAP (1u << 18)

__device__ __forceinline__ unsigned xb_ld(unsigned* p)              { return __hip_atomic_load(p, __ATOMIC_RELAXED, __HIP_MEMORY_SCOPE_AGENT); }
__device__ __forceinline__ unsigned xb_add(unsigned* p, unsigned v) { return __hip_atomic_fetch_add(p, v, __ATOMIC_RELAXED, __HIP_MEMORY_SCOPE_AGENT); }
__device__ __forceinline__ unsigned xb_xcc_id() { return (unsigned)__builtin_amdgcn_s_getreg((3 << 11) | 20) & 0xFu; }
#define XB_SPIN(cond, bar) do { unsigned _sp = 0; while (cond) { __builtin_amdgcn_s_sleep(1); \
    if ((++_sp & 255u) == 0u) { if (xb_ld(&(bar)[XB_TMO])) break; if (_sp > XB_SPIN_CAP) { atomicAdd(&(bar)[XB_TMO], 1u); break; } } } } while (0)

struct XcdBarrier {
    unsigned* bar; unsigned x;
    volatile LAS unsigned* st;
};

__device__ __forceinline__ XcdBarrier xcd_barrier_post(unsigned* bar, volatile LAS unsigned* st) {
    XcdBarrier b; b.bar = bar; b.x = xb_xcc_id(); b.st = st;
    if (threadIdx.x == 0) (void)xb_add(&bar[XB_XCNT(b.x)], 1u);
    return b;
}
__device__ __forceinline__ void xcd_barrier_complete(unsigned* bar, unsigned x, unsigned& nloc, unsigned& nx) {
    const unsigned G = gridDim.x * gridDim.y * gridDim.z;
    unsigned sum, cnt, mine, sp = 0u;
    for (;;) {
        sum = 0u; cnt = 0u; mine = 0u;
#pragma unroll
        for (unsigned j = 0; j < 16; ++j) { const unsigned c = xb_ld(&bar[XB_XCNT(j)]); sum += c; cnt += (c > 0u) ? 1u : 0u; mine = (j == x) ? c : mine; }
        if (sum == G) break;
        __builtin_amdgcn_s_sleep(1);
        if ((++sp & 255u) == 0u) { if (xb_ld(&bar[XB_TMO])) break; if (sp > XB_SPIN_CAP) { atomicAdd(&bar[XB_TMO], 1u); break; } }
    }
    nloc = mine > 0u ? mine : 1u; nx = cnt > 0u ? cnt : 1u;
}

__device__ __forceinline__ void xcd_barrier(const XcdBarrier& b) {
    asm volatile("s_waitcnt vmcnt(0)" ::: "memory");
    __syncthreads();
    if (threadIdx.x == 0) {
        unsigned* bar = b.bar;
        __builtin_amdgcn_s_waitcnt(0);
        unsigned nloc = b.st[0], nx = b.st[1];
        if (nloc == 0u) { xcd_barrier_complete(bar, b.x, nloc, nx); b.st[0] = nloc; b.st[1] = nx; }
        const unsigned old = xb_add(&bar[XB_XSUB(b.x)], 1u);
        const unsigned gen = old / nloc;
        if (old + 1u == (gen + 1u) * nloc) {
            __builtin_amdgcn_fence(__ATOMIC_RELEASE, "agent");
            asm volatile("s_waitcnt vmcnt(0)" ::: "memory");
            const unsigned og = xb_add(&bar[XB_TOP], 1u);
            const unsigned tg = og / nx;
            if (og + 1u == (tg + 1u) * nx) xb_add(&bar[XB_TOPGEN], 1u);
            else XB_SPIN(xb_ld(&bar[XB_TOPGEN]) == tg, bar);
            __builtin_amdgcn_fence(__ATOMIC_ACQUIRE, "agent");
            xb_add(&bar[XB_XGEN(b.x)], 1u);
            asm volatile("s_waitcnt vmcnt(0)" ::: "memory");
        } else {
            XB_SPIN(xb_ld(&bar[XB_XGEN(b.x)]) == gen, bar);
            __builtin_amdgcn_fence(__ATOMIC_ACQUIRE, "agent");
            asm volatile("s_waitcnt vmcnt(0)" ::: "memory");
        }
    }
    __syncthreads();
}

__global__ void __launch_bounds__(NWAVES * 64, 2) mega_fwd(Args a) {
    extern __shared__ __attribute__((aligned(16))) unsigned char lds_raw[];
    cg::grid_group grid = cg::this_grid();
    LAS unsigned char* lds = (LAS unsigned char*)lds_raw;
    const int tid = threadIdx.x, lane = tid & 63, wave = __builtin_amdgcn_readfirstlane(tid >> 6);
    const int G = gridDim.x, bx = blockIdx.x;
    const int gw = bx * NWAVES + wave, NGW = G * NWAVES;
    unsigned char* ws = a.ws;
    float* ssq = (float*)(ws + WS_SSQ);
    bf16* xb = (bf16*)(ws + WS_XB);
    bf16* proj = (bf16*)(ws + WS_PROJ);
    bf16* ao = (bf16*)(ws + WS_AO);
    bf16* ubuf = (bf16*)(ws + WS_U);
    bf16* gbuf = (bf16*)(ws + WS_G);

    if (bx == 0) for (int i = tid; i < XCD_BAR_WORDS; i += NWAVES * 64) ((unsigned*)ws)[i] = 0u;
    if (tid < 2) ((LAS unsigned*)(lds + LDS_MISC))[tid] = 0u;
    {
        LAS float* scr = (LAS float*)(lds + wave * 16384);
        constexpr int I_INE = 16 * (EVEN_IN / 32), I_OUT = 16 * 32, I_INO = 16 * (ODD_IN / 32), I_UP = 16 * (DUP / 32), I_DN = (DFF / 64) * 32;
        constexpr int NITEMS = 2 * I_INE + 2 * I_OUT + 2 * I_INO + 2 * I_OUT + 4 * I_UP + 4 * I_DN;
        for (int it = gw; it < NITEMS; it += NGW) {
            int r = it;
            if (r < 2 * I_INE) { const int e = r / I_INE; r -= e * I_INE;
                transpose_item(a.w_in_even + (size_t)e * DM * EVEN_IN, DM, EVEN_IN, (bf16*)(ws + WS_WINE) + (size_t)e * EVEN_IN * DM, a.norm_mix + (2 * e) * DM, 0, 512, 768, 1280, att::QSCALE, scr, r, lane); continue; }
            r -= 2 * I_INE;
            if (r < 2 * I_OUT) { const int e = r / I_OUT; r -= e * I_OUT;
                transpose_item(a.w_out_even + (size_t)e * DM * DM, DM, DM, (bf16*)(ws + WS_WOUTE) + (size_t)e * DM * DM, nullptr, 0, 0, 0, 0, 1.f, scr, r, lane); continue; }
            r -= 2 * I_OUT;
            if (r < 2 * I_INO) { const int e = r / I_INO; r -= e * I_INO;
                transpose_item(a.w_in_odd + (size_t)e * DM * ODD_IN, DM, ODD_IN, (bf16*)(ws + WS_WINO) + (size_t)e * ODD_IN * DM, a.norm_mix + (2 * e + 1) * DM, 0, 1024, 0, 0, att::QSCALE, scr, r, lane); continue; }
            r -= 2 * I_INO;
            if (r < 2 * I_OUT) { const int e = r / I_OUT; r -= e * I_OUT;
                transpose_item(a.w_out_odd + (size_t)e * DM * DM, DM, DM, (bf16*)(ws + WS_WOUTO) + (size_t)e * DM * DM, nullptr, 0, 0, 0, 0, 1.f, scr, r, lane); continue; }
            r -= 2 * I_OUT;
            if (r < 4 * I_UP) { const int e = r / I_UP; r -= e * I_UP;
                transpose_item(a.ffn_up + (size_t)e * DM * DUP, DM, DUP, (bf16*)(ws + WS_WUP) + (size_t)e * DUP * DM, a.norm_ffn + e * DM, 0, 0, 0, 0, 1.f, scr, r, lane); continue; }
            r -= 4 * I_UP;
            { const int e = r / I_DN; r -= e * I_DN;
                transpose_item(a.ffn_down + (size_t)e * DFF * DM, DFF, DM, (bf16*)(ws + WS_WDN) + (size_t)e * DM * DFF, nullptr, 0, 0, 0, 0, 1.f, scr, r, lane); }
        }
        for (int m = gw; m < MTOK; m += NGW) {
            const f32x4* xr = (const f32x4*)(a.x + (size_t)m * DM) + lane; f32x4 v[4]; float s = 0.f;
#pragma unroll
            for (int j = 0; j < 4; ++j) { v[j] = xr[64 * j]; s += (v[j][0] * v[j][0] + v[j][1] * v[j][1]) + (v[j][2] * v[j][2] + v[j][3] * v[j][3]); }
            s = wave_sum(s);
            v2u* o8 = (v2u*)(xb + (size_t)m * DM) + lane;
#pragma unroll
            for (int j = 0; j < 4; ++j) { v2u w; w.x = pk2(v[j][0], v[j][1]); w.y = pk2(v[j][2], v[j][3]); o8[64 * j] = w; }
            if (lane < 16) ssq[(size_t)m * 16 + lane] = (lane == 0) ? s : 0.f;
        }
    }
    grid.sync();
    const XcdBarrier xbar = xcd_barrier_post((unsigned*)ws, (volatile LAS unsigned*)(lds + LDS_MISC));

    for (int layer = 0; layer < 4; ++layer) {
        const int e = layer >> 1; const bool even = (layer & 1) == 0;
        const float* xold = (layer == 0) ? a.x : a.out;
        {
            const int N = even ? EVEN_IN : ODD_IN;
            const bf16* wt = even ? (const bf16*)(ws + WS_WINE) + (size_t)e * EVEN_IN * DM : (const bf16*)(ws + WS_WINO) + (size_t)e * ODD_IN * DM;
            pg8::Gemm g{xb, wt, MTOK, N, DM}; pg8::StaticOrder S; S.init(MTOK, N, G, bx);
            pg8::EpiScaleBf16 E{proj, N, ssq};
            for (int rep_ = 0; rep_ < REP_INPROJ; ++rep_)
            pg8::gemm_phase<pg8::EpiScaleBf16, pg8::StaticOrder, true, true>(lds, g, S, E);
        }
        xcd_barrier(xbar);
        if (even) {
            int tq = threadIdx.x; asm volatile("" : "+v"(tq)); const int tid = tq, lane = tq & 63, l32 = lane & 31, hi = lane >> 5;
            float lam, one_m_li;
            { const float li = (layer == 0) ? 0.2f : 0.47071301839f;
              const float s1 = wave_sum(a.lam_q1[e * 64 + lane] * a.lam_k1[e * 64 + lane]), s2 = wave_sum(a.lam_q2[e * 64 + lane] * a.lam_k2[e * 64 + lane]);
              lam = __expf(s1) - __expf(s2) + li; lam = __builtin_bit_cast(float, __builtin_amdgcn_readfirstlane(__builtin_bit_cast(int, lam))); one_m_li = __builtin_bit_cast(float, __builtin_amdgcn_readfirstlane(__builtin_bit_cast(int, 1.0f - li))); }
            LAS float* btab = (LAS float*)(lds + att::L_BT);

#if PH_DIFF
            for (int rep_ = 0; rep_ < REP_DIFF; ++rep_)
            for (int uidx = bx; uidx < 1024; uidx += G) {
                const int j = uidx >> 8, c = uidx & 255, bh = c >> 2, s = c & 3, b = bh >> 2, h = bh & 3;
                const int qb = (j == 0) ? s : (j == 1) ? 7 - s : (j == 2) ? 8 + s : 15 - s;
                { int tb = threadIdx.x; asm volatile("" : "+v"(tb)); if (tb < 128) btab[tb] = a.rel_bias[T5B[tb] * 12 + 8 + h] * att::LOG2E; }
                const bf16* base = proj + (size_t)b * SEQ * EVEN_IN;
                const int q0 = qb * 256, nt = 4 * qb + 4, t = q0 + 32 * wave + l32;
                att::f32x16 o2[4]; float m2, l2; LAS unsigned* o1s = (LAS unsigned*)(lds + att::L_O1 + wave * 8192) + lane;
                { float m1, l1;
                  att::attn_core_pp<1, 128>(base + 768 + h * 128, base + 1280 + h * 128, base + 1792 + h * 128, EVEN_IN, q0, 0, nt, lds, o2, m1, l1);
                  const float inv = __builtin_amdgcn_rcpf(l1 + __shfl_xor(l1, 32));
#pragma unroll
                  for (int db = 0; db < 4; ++db)
#pragma unroll
                      for (int k = 0; k < 8; ++k) o1s[(db * 8 + k) * 64] = att::cvtpk(o2[db][2 * k] * inv, o2[db][2 * k + 1] * inv); }
                att::attn_core_pp<1, 128>(base + 768 + h * 128 + 64, base + 1280 + h * 128 + 64, base + 1792 + h * 128, EVEN_IN, q0, 0, nt, lds, o2, m2, l2);
                { const float inv = lam * __builtin_amdgcn_rcpf(l2 + __shfl_xor(l2, 32)); float ss = 0.f;
#pragma unroll
                  for (int db = 0; db < 4; ++db)
#pragma unroll
                      for (int r = 0; r < 16; ++r) { const unsigned w = o1s[(db * 8 + (r >> 1)) * 64]; const float a1 = __uint_as_float((r & 1) ? (w & 0xffff0000u) : (w << 16));
                          const float v = a1 - inv * o2[db][r]; o2[db][r] = v; ss += v * v; }
                  ss += __shfl_xor(ss, 32);
                  const float rs = __builtin_amdgcn_rsqf(ss * (1.0f / 128.0f) + 1e-6f) * one_m_li;
                  const float* gn = a.diff_norm + e * 128;
#pragma unroll
                  for (int db = 0; db < 4; ++db)
#pragma unroll
                      for (int rg = 0; rg < 4; ++rg) { const f32x4 gv = *(const f32x4*)(gn + 32 * db + 8 * rg + 4 * hi);
#pragma unroll
                          for (int k = 0; k < 4; ++k) o2[db][4 * rg + k] *= rs * gv[k]; } }
                { int tb = threadIdx.x; asm volatile("" : "+v"(tb)); const int t2 = q0 + 32 * (tb >> 6) + (tb & 31);
                  att::store_ot<128>(o2, ao + ((size_t)b * SEQ + t2) * DM + 512 + h * 128, (tb >> 5) & 1); }
            }
#endif
#if PH_SWA
            for (int rep_ = 0; rep_ < REP_SWA; ++rep_)
            for (int uidx = bx; uidx < 2048; uidx += G) {
                const int qb = uidx & 15, qh = (uidx >> 4) & 7, b = uidx >> 7, kvh = qh >> 2;
                { int tb = threadIdx.x; asm volatile("" : "+v"(tb)); if (tb < 128) btab[tb] = a.rel_bias[T5B[tb] * 12 + qh] * att::LOG2E; }
                const bf16* base = proj + (size_t)b * SEQ * EVEN_IN;
                const int q0 = qb * 256, t = q0 + 32 * wave + l32;
                const int kt0 = (qb * 4 - 2 > 0) ? qb * 4 - 2 : 0, nt = qb * 4 + 4 - kt0;
                att::f32x16 o[2]; float m, l;
                att::attn_core_pp<2, 64>(base + qh * 64, base + 512 + kvh * 64, base + 640 + kvh * 64, EVEN_IN, q0, kt0, nt, lds, o, m, l);
                const float sk = a.sinks[e * 8 + qh] * att::LOG2E;
                const float inv = __builtin_amdgcn_rcpf(l + __shfl_xor(l, 32) + __builtin_amdgcn_exp2f(sk - m));
#pragma unroll
                for (int db = 0; db < 2; ++db)
#pragma unroll
                    for (int r = 0; r < 16; ++r) o[db][r] *= inv;
                att::store_ot<64>(o, ao + ((size_t)b * SEQ + t) * DM + qh * 64, hi);
            }
#endif
        } else {
#if PH_SB
            int tq = threadIdx.x; asm volatile("" : "+v"(tq)); const int lane = tq & 63, l32 = lane & 31, hi = lane >> 5;
            for (int rep_ = 0; rep_ < REP_SB; ++rep_)
            for (int uidx = bx; uidx < 4096; uidx += G) {
                const int bh = uidx & 255, qb = 15 - (uidx >> 8), b = bh >> 4, h = bh & 15;
                const bf16* base = proj + (size_t)b * SEQ * ODD_IN;
                const int q0 = qb * 256, nt = 4 * qb + 4, t = q0 + 32 * wave + l32;
                att::f32x16 o[2]; float P, dummy;
                att::attn_core<0, 64>(base + h * 64, base + 1024 + h * 64, base + 2048 + h * 64, ODD_IN, q0, nt - 1, nt, -1, lds, o, P, dummy);
                att::store_ot<64>(o, ao + ((size_t)b * SEQ + t) * DM + h * 64, hi);
            }
#endif
        }
        xcd_barrier(xbar);
        {
            const bf16* wt = even ? (const bf16*)(ws + WS_WOUTE) + (size_t)e * DM * DM : (const bf16*)(ws + WS_WOUTO) + (size_t)e * DM * DM;
            pg8::Gemm g{ao, wt, MTOK, DM, DM}; pg8::StaticOrder S; S.init(MTOK, DM, G, bx);
#if REP_OUT > 1
            { pg8::EpiResid Ed{xold, (float*)(ws + WS_PROJ), (bf16*)(ws + WS_PROJ + 256 * MiB), (float*)(ws + 800 * MiB)};
              pg8::gemm_phase<pg8::EpiResid, pg8::StaticOrder, true, true>(lds, g, S, Ed); }
#endif
            pg8::EpiResid E{xold, a.out, xb, ssq};
            pg8::gemm_phase<pg8::EpiResid, pg8::StaticOrder, true, true>(lds, g, S, E);
        }
        xcd_barrier(xbar);
        const bf16* wup = (const bf16*)(ws + WS_WUP) + (size_t)layer * DUP * DM;
        const bf16* wdn = (const bf16*)(ws + WS_WDN) + (size_t)layer * DM * DFF;
        for (int half = 0; half < 2; ++half) {
            const size_t r0 = (size_t)half * HALF_ROWS;
            {
                pg8::Gemm g{xb + r0 * DM, wup, HALF_ROWS, DUP, DM}; pg8::StaticOrder S; S.init(HALF_ROWS, DUP, G, bx);
                pg8::EpiScaleBf16 E{ubuf, DUP, ssq + r0 * 16};
                for (int rep_ = 0; rep_ < REP_UP; ++rep_)
                pg8::gemm_phase<pg8::EpiScaleBf16, pg8::StaticOrder, true, true>(lds, g, S, E);
            }
            xcd_barrier(xbar);
#if PH_CONV
            {
                const float* cw = a.ffn_conv + (size_t)layer * 3 * DUP; const float* cb = a.ffn_conv_b + (size_t)layer * DUP;
                constexpr int NCC = 6, NRC = HALF_ROWS / 32;
                int tq = threadIdx.x; asm volatile("" : "+v"(tq)); const int lane = tq & 63;
                for (int rep_ = 0; rep_ < REP_CONV; ++rep_)
                for (int it = gw; it < NCC * NRC; it += NGW) {
                    const int cc = it % NCC, rc = it / NCC, cgp = cc * 64 + lane;
                    if (cgp < DFF / 8) {
                        const int col = cgp * 8, row0 = rc * 32;
                        float wg[3][8], wv[3][8], bg[8], bv[8];
#pragma unroll
                        for (int tp = 0; tp < 3; ++tp)
#pragma unroll
                            for (int k = 0; k < 8; k += 4) { const f32x4 t1 = *(const f32x4*)(cw + tp * DUP + col + k), t2 = *(const f32x4*)(cw + tp * DUP + DFF + col + k);
#pragma unroll
                                for (int q = 0; q < 4; ++q) { wg[tp][k + q] = t1[q]; wv[tp][k + q] = t2[q]; } }
#pragma unroll
                        for (int k = 0; k < 8; k += 4) { const f32x4 t1 = *(const f32x4*)(cb + col + k), t2 = *(const f32x4*)(cb + DFF + col + k);
#pragma unroll
                            for (int q = 0; q < 4; ++q) { bg[k + q] = t1[q]; bv[k + q] = t2[q]; } }
                        float g2[8], g1[8], v2[8], v1[8];
                        const bool head = (row0 % SEQ) == 0;
                        {
                            v4u a2 = {0, 0, 0, 0}, a1 = {0, 0, 0, 0}, c2 = {0, 0, 0, 0}, c1 = {0, 0, 0, 0};
                            if (!head) { const bf16* up = ubuf + (size_t)(row0 - 2) * DUP + col; a2 = *(const v4u*)up; c2 = *(const v4u*)(up + DFF); a1 = *(const v4u*)(up + DUP); c1 = *(const v4u*)(up + DUP + DFF); }
#pragma unroll
                            for (int k = 0; k < 8; ++k) { const int sh = (k & 1) * 16;
                                g2[k] = __uint_as_float(((a2[k >> 1] >> sh) & 0xffffu) << 16); g1[k] = __uint_as_float(((a1[k >> 1] >> sh) & 0xffffu) << 16);
                                v2[k] = __uint_as_float(((c2[k >> 1] >> sh) & 0xffffu) << 16); v1[k] = __uint_as_float(((c1[k >> 1] >> sh) & 0xffffu) << 16); }
                        }
                        for (int r = 0; r < 32; ++r) {
                            const bf16* up = ubuf + (size_t)(row0 + r) * DUP + col;
                            const v4u a0 = *(const v4u*)up, c0 = *(const v4u*)(up + DFF);
                            float res[8];
#pragma unroll
                            for (int k = 0; k < 8; ++k) { const int sh = (k & 1) * 16;
                                const float g0 = __uint_as_float(((a0[k >> 1] >> sh) & 0xffffu) << 16), v0 = __uint_as_float(((c0[k >> 1] >> sh) & 0xffffu) << 16);
                                const float gg = bg[k] + wg[0][k] * g2[k] + wg[1][k] * g1[k] + wg[2][k] * g0;
                                const float vv = bv[k] + wv[0][k] * v2[k] + wv[1][k] * v1[k] + wv[2][k] * v0;
                                const float sg = gg * __builtin_amdgcn_rcpf(1.0f + __builtin_amdgcn_exp2f(-gg * att::LOG2E));
                                res[k] = sg * vv; g2[k] = g1[k]; g1[k] = g0; v2[k] = v1[k]; v1[k] = v0; }
                            v4u w; w.x = pk2(res[0], res[1]); w.y = pk2(res[2], res[3]); w.z = pk2(res[4], res[5]); w.w = pk2(res[6], res[7]);
                            *(v4u*)(gbuf + (size_t)(row0 + r) * DFF + col) = w;
                        }
                    }
                }
            }
#endif
            xcd_barrier(xbar);
            {
                pg8::Gemm g{gbuf, wdn, HALF_ROWS, DM, DFF}; pg8::StaticOrder S; S.init(HALF_ROWS, DM, G, bx);
#if REP_DOWN > 1
                { pg8::EpiResid Ed{a.out + r0 * DM, (float*)(ws + 760 * MiB), (bf16*)(ws + 888 * MiB), (float*)(ws + 960 * MiB)};
                  pg8::gemm_phase<pg8::EpiResid, pg8::StaticOrder, true, true>(lds, g, S, Ed); }
#endif
                pg8::EpiResid E{a.out + r0 * DM, a.out + r0 * DM, xb + r0 * DM, ssq + r0 * 16};
                pg8::gemm_phase<pg8::EpiResid, pg8::StaticOrder, true, true>(lds, g, S, E);
            }
            if (half == 1) xcd_barrier(xbar);
        }
    }
    { int tq = threadIdx.x; asm volatile("" : "+v"(tq)); const int lane = tq & 63;
    for (int m = gw; m < MTOK; m += NGW) {
        f32x4* xr = (f32x4*)(a.out + (size_t)m * DM) + lane; f32x4 v[4]; float s = 0.f;
#pragma unroll
        for (int j = 0; j < 4; ++j) { v[j] = xr[64 * j]; s += (v[j][0] * v[j][0] + v[j][1] * v[j][1]) + (v[j][2] * v[j][2] + v[j][3] * v[j][3]); }
        s = wave_sum(s);
        const float rs = __builtin_amdgcn_rsqf(s * (1.0f / DM) + 1e-6f);
#pragma unroll
        for (int j = 0; j < 4; ++j) { const f32x4 gv = *((const f32x4*)a.norm_final + lane + 64 * j); xr[64 * j] = v[j] * rs * gv; }
    } }
}

extern "C" void kernel_launch(void* const* d_in, const int* in_sizes, int n_in, void* d_out, int out_size, void* d_ws, size_t ws_size, hipStream_t stream) {
    static int grid = 0;
    if (grid == 0) {
        int dev = 0, cus = 0, per_cu = 0;
        (void)hipGetDevice(&dev);
        (void)hipDeviceGetAttribute(&cus, hipDeviceAttributeMultiprocessorCount, dev);
        (void)hipFuncSetAttribute((const void*)mega_fwd, hipFuncAttributeMaxDynamicSharedMemorySize, LDS_BYTES);
        (void)hipOccupancyMaxActiveBlocksPerMultiprocessor(&per_cu, (const void*)mega_fwd, NWAVES * 64, LDS_BYTES);
        if (per_cu < 1) per_cu = 1;
        grid = cus * per_cu;
        if (n_in != 19 || ws_size < 1024 * MiB) fprintf(stderr, "kernel_launch: unexpected n_in %d / ws %zu\n", n_in, ws_size);
    }
    Args a{};
    a.x = (const float*)d_in[0]; a.rel_bias = (const float*)d_in[1]; a.norm_mix = (const float*)d_in[2]; a.norm_ffn = (const float*)d_in[3]; a.norm_final = (const float*)d_in[4];
    a.w_in_even = (const float*)d_in[5]; a.w_out_even = (const float*)d_in[6]; a.sinks = (const float*)d_in[7]; a.lam_q1 = (const float*)d_in[8]; a.lam_k1 = (const float*)d_in[9];
    a.lam_q2 = (const float*)d_in[10]; a.lam_k2 = (const float*)d_in[11]; a.diff_norm = (const float*)d_in[12]; a.w_in_odd = (const float*)d_in[13]; a.w_out_odd = (const float*)d_in[14];
    a.ffn_up = (const float*)d_in[15]; a.ffn_conv = (const float*)d_in[16]; a.ffn_conv_b = (const float*)d_in[17]; a.ffn_down = (const float*)d_in[18];
    a.out = (float*)d_out; a.ws = (unsigned char*)d_ws;
    void* args[] = {&a};
    hipError_t err = hipLaunchCooperativeKernel((const void*)mega_fwd, dim3(grid), dim3(NWAVES * 64), args, LDS_BYTES, stream);
    if (err != hipSuccess) fprintf(stderr, "kernel_launch: cooperative launch failed: %s (grid %d)\n", hipGetErrorString(err), grid);
}
```

```cpp
#include <hip/hip_runtime.h>
#include <hip/hip_cooperative_groups.h>
#include <cstdio>
#include <cstdint>
namespace cg = cooperative_groups;
namespace pg8 {
#define PG8_LAS __attribute__((address_space(3)))
typedef unsigned short bf16_t;
typedef short bf16x8 __attribute__((ext_vector_type(8)));
typedef float f32x4 __attribute__((ext_vector_type(4)));
typedef unsigned u32x4 __attribute__((ext_vector_type(4)));
constexpr int BM = 256, BK = 64, HALF = 128, HTB = HALF * BK * 2  , STAGE_BYTES = 8 * HTB, NXCD = 8, WGM = 8;

__host__ __device__ __forceinline__ int lds_byte(int r, int c) { const int st = (r >> 4) * 2 + (c >> 5), rr = r & 15, cc = c & 31, ob = rr * 64 + cc * 2; return st * 1024 + (ob ^ (((ob >> 9) & 1) << 5)); }
__host__ __device__ __forceinline__ void stage_rc(int b, int& R, int& C) { const int st = b / 1024, sb = b % 1024, swz = sb ^ (((sb >> 9) & 1) << 5); R = (st >> 1) * 16 + swz / 64; C = (st & 1) * 32 + (swz % 64) / 2; }
__host__ __device__ __forceinline__ int perm32(int rho) { const int n = rho >> 4, i = rho & 15; return 8 * (i >> 2) + 4 * n + (i & 3); }

struct Unit { int pm, pn; };
struct Gemm { const bf16_t* A; const bf16_t* Bt; int M, N, K; };

struct StaticOrder {
    int nM, nN, nwg, G, c;
    __host__ __device__ void init(int M, int N, int G_, int c_) { nM = M / BM; nN = N / BM; nwg = nM * nN; G = G_; c = c_; }
    __host__ __device__ bool next(int i, Unit& u) const {
        const long L = (long)i * G + c; if (L >= nwg) return false;
        int wgid = (int)L; { const int q = nwg / NXCD, r = nwg % NXCD, xcd = wgid % NXCD, off = wgid / NXCD; wgid = (xcd < r ? xcd * (q + 1) : r * (q + 1) + (xcd - r) * q) + off; }
        const int nig = WGM * nN, gid = wgid / nig, fm = gid * WGM, gsz = (nM - fm) < WGM ? (nM - fm) : WGM;
        u.pm = fm + ((wgid % nig) % gsz); u.pn = (wgid % nig) / gsz; return true;
    }
    __device__ __forceinline__ void a_ready(const Unit&) const {}
    __device__ __forceinline__ void done(const Unit&) const {}
};

__device__ __forceinline__ unsigned cvt_pk_bf16(float lo, float hi) { unsigned r; asm volatile("v_cvt_pk_bf16_f32 %0, %1, %2" : "=v"(r) : "v"(lo), "v"(hi)); return r; }
typedef float f32x2 __attribute__((ext_vector_type(2)));
typedef unsigned u32x2 __attribute__((ext_vector_type(2)));
constexpr float RMS_EPS = 1e-6f;
struct EpiScaleBf16 {
    static constexpr bool PERM = true, AFTER_DRAIN = false;
    bf16_t* O; int ldc; const float* ssq;
    __device__ __forceinline__ void operator()(const f32x4 (&acc)[2][2][4][2], const Unit& u, int wr, int wc, int fr, int fq) const {
        const int row0 = u.pm * BM + wr * 64 + fr, col0 = u.pn * BM + wc * 32 + 8 * fq;
        f32x4 part[2][4];
#pragma unroll
        for (int ai = 0; ai < 2; ++ai)
#pragma unroll
            for (int m = 0; m < 4; ++m) part[ai][m] = *(const f32x4*)(ssq + (size_t)(row0 + ai * HALF + m * 16) * 16 + fq * 4);
#pragma unroll
        for (int ai = 0; ai < 2; ++ai)
#pragma unroll
            for (int m = 0; m < 4; ++m) { const int row = row0 + ai * HALF + m * 16; bf16_t* rowp = O + (size_t)row * ldc + col0;
                float t = (part[ai][m][0] + part[ai][m][1]) + (part[ai][m][2] + part[ai][m][3]);
                t += __shfl_xor(t, 16); t += __shfl_xor(t, 32);
                const float rs = __builtin_amdgcn_rsqf(t * (1.0f / 1024.0f) + RMS_EPS);
#pragma unroll
                for (int bj = 0; bj < 2; ++bj) { const f32x4 v0 = acc[ai][bj][m][0] * rs, v1 = acc[ai][bj][m][1] * rs;
                    u32x4 w; w.x = cvt_pk_bf16(v0[0], v0[1]); w.y = cvt_pk_bf16(v0[2], v0[3]); w.z = cvt_pk_bf16(v1[0], v1[1]); w.w = cvt_pk_bf16(v1[2], v1[3]);
                    *(u32x4*)(rowp + bj * HALF) = w; } }
    }
};
struct EpiResid {
    static constexpr bool PERM = true, AFTER_DRAIN = false;
    const float* base; float* out; bf16_t* xb; float* ssq;
    __device__ __forceinline__ void operator()(const f32x4 (&acc)[2][2][4][2], const Unit& u, int wr, int wc, int fr, int fq) const {
        const int col0 = u.pn * BM + wc * 32 + 8 * fq;
        const size_t off0 = (size_t)(u.pm * BM + wr * 64 + fr) * 1024 + col0;
        f32x4 nx[2][2][2];
#pragma unroll
        for (int g = 0; g < 2; ++g) { const size_t offn = off0 + (size_t)(g * 16) * 1024;
#pragma unroll
            for (int bj = 0; bj < 2; ++bj)
#pragma unroll
                for (int n = 0; n < 2; ++n) nx[g][bj][n] = *(const f32x4*)(base + offn + bj * HALF + n * 4); }
        asm volatile("" ::: "memory");
#pragma unroll
        for (int g = 0; g < 8; ++g) { const int ai = g >> 2, m = g & 3; const int row = u.pm * BM + ai * HALF + wr * 64 + m * 16 + fr; const size_t off = (size_t)row * 1024 + col0; float q = 0.f;
            f32x4 cu[2][2];
#pragma unroll
            for (int bj = 0; bj < 2; ++bj)
#pragma unroll
                for (int n = 0; n < 2; ++n) cu[bj][n] = nx[g & 1][bj][n];
            if (g < 6) { const size_t offn = off0 + (size_t)(((g + 2) >> 2) * HALF + ((g + 2) & 3) * 16) * 1024;
#pragma unroll
                for (int bj = 0; bj < 2; ++bj)
#pragma unroll
                    for (int n = 0; n < 2; ++n) nx[g & 1][bj][n] = *(const f32x4*)(base + offn + bj * HALF + n * 4); }
#pragma unroll
            for (int bj = 0; bj < 2; ++bj) { const f32x4 o0 = cu[bj][0] + acc[ai][bj][m][0], o1 = cu[bj][1] + acc[ai][bj][m][1];
                *(f32x4*)(out + off + bj * HALF) = o0; *(f32x4*)(out + off + bj * HALF + 4) = o1;
                q += ((o0[0] * o0[0] + o0[1] * o0[1]) + (o0[2] * o0[2] + o0[3] * o0[3])) + ((o1[0] * o1[0] + o1[1] * o1[1]) + (o1[2] * o1[2] + o1[3] * o1[3]));
                u32x4 w; w.x = cvt_pk_bf16(o0[0], o0[1]); w.y = cvt_pk_bf16(o0[2], o0[3]); w.z = cvt_pk_bf16(o1[0], o1[1]); w.w = cvt_pk_bf16(o1[2], o1[3]);
                *(u32x4*)(xb + off + bj * HALF) = w; }
            q += __shfl_xor(q, 16); q += __shfl_xor(q, 32);
            if (fq == 0) ssq[(size_t)row * 16 + u.pn * 4 + wc] = q;
            asm volatile("" ::: "memory"); }
    }
};

struct EpiResidB {
    static constexpr bool PERM = true, AFTER_DRAIN = false;
    const bf16_t* base; bf16_t* xb; float* ssq;
    __device__ __forceinline__ void operator()(const f32x4 (&acc)[2][2][4][2], const Unit& u, int wr, int wc, int fr, int fq) const {
        const int col0 = u.pn * BM + wc * 32 + 8 * fq;
        const size_t off0 = (size_t)(u.pm * BM + wr * 64 + fr) * 1024 + col0;
        u32x4 nx[2][2];
#pragma unroll
        for (int g = 0; g < 2; ++g)
#pragma unroll
            for (int bj = 0; bj < 2; ++bj) nx[g][bj] = *(const u32x4*)(base + off0 + (size_t)(g * 16) * 1024 + bj * HALF);
        asm volatile("" ::: "memory");
#pragma unroll
        for (int g = 0; g < 8; ++g) { const int ai = g >> 2, m = g & 3; const int row = u.pm * BM + ai * HALF + wr * 64 + m * 16 + fr; const size_t off = (size_t)row * 1024 + col0; float q = 0.f;
            u32x4 cu[2];
#pragma unroll
            for (int bj = 0; bj < 2; ++bj) cu[bj] = nx[g & 1][bj];
            if (g < 6) { const size_t offn = off0 + (size_t)(((g + 2) >> 2) * HALF + ((g + 2) & 3) * 16) * 1024;
#pragma unroll
                for (int bj = 0; bj < 2; ++bj) nx[g & 1][bj] = *(const u32x4*)(base + offn + bj * HALF); }
#pragma unroll
            for (int bj = 0; bj < 2; ++bj) {
                f32x4 o0, o1;
                o0[0] = __uint_as_float(cu[bj].x << 16) + acc[ai][bj][m][0][0]; o0[1] = __uint_as_float(cu[bj].x & 0xffff0000u) + acc[ai][bj][m][0][1];
                o0[2] = __uint_as_float(cu[bj].y << 16) + acc[ai][bj][m][0][2]; o0[3] = __uint_as_float(cu[bj].y & 0xffff0000u) + acc[ai][bj][m][0][3];
                o1[0] = __uint_as_float(cu[bj].z << 16) + acc[ai][bj][m][1][0]; o1[1] = __uint_as_float(cu[bj].z & 0xffff0000u) + acc[ai][bj][m][1][1];
                o1[2] = __uint_as_float(cu[bj].w << 16) + acc[ai][bj][m][1][2]; o1[3] = __uint_as_float(cu[bj].w & 0xffff0000u) + acc[ai][bj][m][1][3];
                q += ((o0[0] * o0[0] + o0[1] * o0[1]) + (o0[2] * o0[2] + o0[3] * o0[3])) + ((o1[0] * o1[0] + o1[1] * o1[1]) + (o1[2] * o1[2] + o1[3] * o1[3]));
                u32x4 w; w.x = cvt_pk_bf16(o0[0], o0[1]); w.y = cvt_pk_bf16(o0[2], o0[3]); w.z = cvt_pk_bf16(o1[0], o1[1]); w.w = cvt_pk_bf16(o1[2], o1[3]);
                *(u32x4*)(xb + off + bj * HALF) = w; }
            q += __shfl_xor(q, 16); q += __shfl_xor(q, 32);
            if (fq == 0) ssq[(size_t)row * 16 + u.pn * 4 + wc] = q;
            asm volatile("" ::: "memory"); }
    }
};
template <class Epi, class Sched, bool ALIGN_EPI = false, bool SP2 = false>
__device__ __forceinline__ void gemm_phase(PG8_LAS unsigned char* lds, const Gemm g, const Sched& S, const Epi& E) {
    int tid_ = threadIdx.x; asm volatile("" : "+v"(tid_));
    const int tid = tid_, wid = __builtin_amdgcn_readfirstlane(tid >> 6), lane = tid & 63, wr = wid >> 2, wc = wid & 3, fr = lane & 15, fq = lane >> 4;
    const int K = g.K, nt = K / BK;
    unsigned voffA[2], voffB[2];
#pragma unroll
    for (int i = 0; i < 2; ++i) { int R, C; stage_rc(tid * 16 + i * 8192, R, C); const int Rb = Epi::PERM ? ((R & ~31) + perm32(R & 31)) : R;
        voffA[i] = (unsigned)(R * K + C) * 2u; voffB[i] = (unsigned)(Rb * K + C) * 2u; }
    const size_t kstep = (size_t)(BK * 2);
    const size_t hstep = (size_t)HALF * K * 2;
    const size_t tstep = 2 * hstep;
    const unsigned ldsw = (unsigned)wid * 1024u;
    const int aoff = lds_byte(wr * 64 + fr, fq * 8), boff = lds_byte(wc * 32 + fr, fq * 8);
#define PG8_SA(b, h) (((b) * 2 + (h)) * HTB)
#define PG8_SB(b, h) ((4 + (b) * 2 + (h)) * HTB)
#define PG8_STAGE(bufoff, gbase, voff) do { _Pragma("unroll") for (int _i = 0; _i < 2; ++_i) \
        __builtin_amdgcn_global_load_lds((const unsigned*)((const char*)(gbase) + (voff)[_i]), (PG8_LAS unsigned*)(lds + (bufoff) + ldsw + _i * 8192), 16, 0, 0); } while (0)
#define PG8_LDA(dst, b, h) do { _Pragma("unroll") for (int m = 0; m < 4; ++m) _Pragma("unroll") for (int k = 0; k < 2; ++k) dst[m][k] = *(const PG8_LAS bf16x8*)(lds + PG8_SA(b, h) + aoff + m * 2048 + k * 1024); } while (0)
#define PG8_LDB(dst, b, h) do { _Pragma("unroll") for (int n = 0; n < 2; ++n) _Pragma("unroll") for (int k = 0; k < 2; ++k) dst[n][k] = *(const PG8_LAS bf16x8*)(lds + PG8_SB(b, h) + boff + n * 2048 + k * 1024); } while (0)
#define PG8_MMA(ai, bj, At, Bt) do { __builtin_amdgcn_s_setprio(1); _Pragma("unroll") for (int m = 0; m < 4; ++m) _Pragma("unroll") for (int n = 0; n < 2; ++n) _Pragma("unroll") for (int k = 0; k < 2; ++k) \
        acc[ai][bj][m][n] = __builtin_amdgcn_mfma_f32_16x16x32_bf16(Bt[n][k], At[m][k], acc[ai][bj][m][n], 0, 0, 0); __builtin_amdgcn_s_setprio(0); } while (0)
#define PG8_WAIT_V(n) asm volatile("s_waitcnt vmcnt(" #n ")" ::: "memory")
#define PG8_WAIT_L(n) asm volatile("s_waitcnt lgkmcnt(" #n ")" ::: "memory")
#define PG8_BAR __builtin_amdgcn_s_barrier()
#define PG8_SCHED __builtin_amdgcn_sched_barrier(0)
    Unit cur, nxt; int ui = 0;
    if (!S.next(0, cur)) return;
    f32x4 acc[2][2][4][2];
#pragma unroll
    for (int a = 0; a < 2; ++a)
#pragma unroll
        for (int b = 0; b < 2; ++b)
#pragma unroll
            for (int m = 0; m < 4; ++m)
#pragma unroll
                for (int n = 0; n < 2; ++n) acc[a][b][m][n] = (f32x4){0.f, 0.f, 0.f, 0.f};
    bf16x8 At[4][2], B0[2][2], B1[2][2];
    const char* cA = (const char*)g.A + (size_t)cur.pm * tstep; const char* cB = (const char*)g.Bt + (size_t)cur.pn * tstep;
    S.a_ready(cur);
    if constexpr (SP2) {
        PG8_STAGE(PG8_SB(0, 0), cB, voffB); PG8_STAGE(PG8_SB(0, 1), cB + hstep, voffB); PG8_STAGE(PG8_SA(0, 0), cA, voffA); PG8_STAGE(PG8_SA(0, 1), cA + hstep, voffA);
        if (wr == 1) PG8_BAR;
        PG8_WAIT_V(2); PG8_BAR;
        PG8_STAGE(PG8_SB(1, 0), cB + kstep, voffB); PG8_STAGE(PG8_SA(1, 0), cA + kstep, voffA); PG8_STAGE(PG8_SB(1, 1), cB + hstep + kstep, voffB);
        PG8_WAIT_V(6); PG8_BAR;
    } else {
        PG8_STAGE(PG8_SB(0, 0), cB, voffB); PG8_STAGE(PG8_SA(0, 0), cA, voffA); PG8_STAGE(PG8_SB(0, 1), cB + hstep, voffB); PG8_STAGE(PG8_SA(0, 1), cA + hstep, voffA);
        if (wr == 1) PG8_BAR;
        PG8_WAIT_V(4); PG8_BAR;
        PG8_STAGE(PG8_SB(1, 0), cB + kstep, voffB); PG8_STAGE(PG8_SA(1, 0), cA + kstep, voffA); PG8_STAGE(PG8_SB(1, 1), cB + hstep + kstep, voffB);
        PG8_WAIT_V(6); PG8_BAR;
    }
    for (;;) {
        const bool has_next = S.next(ui + 1, nxt);
        const char* nA = has_next ? (const char*)g.A + (size_t)nxt.pm * tstep : cA; const char* nB = has_next ? (const char*)g.Bt + (size_t)nxt.pn * tstep : cB;
        for (int t = 0; t < nt; t += 2) {
            const bool last = (t == nt - 2);
            const char* a1 = cA + (size_t)(t + 1) * kstep;
            const char* a2 = last ? nA : cA + (size_t)(t + 2) * kstep; const char* b2 = last ? nB : cB + (size_t)(t + 2) * kstep;
            const char* a3 = a2 + kstep; const char* b3 = b2 + kstep;
            if (last && has_next) S.a_ready(nxt);
            if constexpr (SP2) {
            PG8_LDB(B0, 0, 0); PG8_LDB(B1, 0, 1); PG8_SCHED; PG8_LDA(At, 0, 0); PG8_STAGE(PG8_SA(1, 1), a1 + hstep, voffA);
            PG8_WAIT_V(8); PG8_WAIT_L(0); PG8_BAR; PG8_MMA(0, 0, At, B0); PG8_MMA(0, 1, At, B1); PG8_BAR; PG8_SCHED;
            PG8_LDA(At, 0, 1); PG8_STAGE(PG8_SB(0, 0), b2, voffB); PG8_STAGE(PG8_SB(0, 1), b2 + hstep, voffB); PG8_STAGE(PG8_SA(0, 0), a2, voffA);
            PG8_WAIT_V(8); PG8_WAIT_L(0); PG8_BAR; PG8_MMA(1, 0, At, B0); PG8_MMA(1, 1, At, B1); PG8_BAR; PG8_SCHED;
            PG8_LDB(B0, 1, 0); PG8_LDB(B1, 1, 1); PG8_SCHED; PG8_LDA(At, 1, 0); PG8_STAGE(PG8_SA(0, 1), a2 + hstep, voffA);
            PG8_WAIT_V(8); PG8_WAIT_L(0); PG8_BAR; PG8_MMA(0, 0, At, B0); PG8_MMA(0, 1, At, B1); PG8_BAR; PG8_SCHED;
            PG8_LDA(At, 1, 1); PG8_STAGE(PG8_SB(1, 0), b3, voffB); PG8_STAGE(PG8_SB(1, 1), b3 + hstep, voffB); PG8_STAGE(PG8_SA(1, 0), a3, voffA);
            PG8_WAIT_V(8); PG8_WAIT_L(0); PG8_BAR; PG8_MMA(1, 0, At, B0); PG8_MMA(1, 1, At, B1); PG8_BAR; PG8_SCHED;
            } else {
            PG8_LDB(B0, 0, 0); PG8_SCHED; PG8_LDA(At, 0, 0); PG8_STAGE(PG8_SA(1, 1), a1 + hstep, voffA);
            PG8_WAIT_L(8); PG8_BAR; PG8_WAIT_L(0); PG8_MMA(0, 0, At, B0); PG8_BAR; PG8_SCHED;
            PG8_LDB(B1, 0, 1); PG8_STAGE(PG8_SB(0, 0), b2, voffB);
            PG8_BAR; PG8_WAIT_L(0); PG8_MMA(0, 1, At, B1); PG8_BAR;
            PG8_LDA(At, 0, 1); PG8_STAGE(PG8_SA(0, 0), a2, voffA);
            PG8_BAR; PG8_WAIT_L(0); PG8_MMA(1, 0, At, B0); PG8_BAR; PG8_SCHED;
            PG8_STAGE(PG8_SB(0, 1), b2 + hstep, voffB);
            PG8_WAIT_V(6); PG8_BAR; PG8_MMA(1, 1, At, B1); PG8_BAR;
            PG8_LDB(B0, 1, 0); PG8_SCHED; PG8_LDA(At, 1, 0); PG8_STAGE(PG8_SA(0, 1), a2 + hstep, voffA);
            PG8_WAIT_L(8); PG8_BAR; PG8_WAIT_L(0); PG8_MMA(0, 0, At, B0); PG8_BAR; PG8_SCHED;
            PG8_LDB(B1, 1, 1); PG8_STAGE(PG8_SB(1, 0), b3, voffB);
            PG8_BAR; PG8_WAIT_L(0); PG8_MMA(0, 1, At, B1); PG8_BAR;
            PG8_LDA(At, 1, 1); PG8_STAGE(PG8_SA(1, 0), a3, voffA);
            PG8_BAR; PG8_WAIT_L(0); PG8_MMA(1, 0, At, B0); PG8_BAR; PG8_SCHED;
            PG8_STAGE(PG8_SB(1, 1), b3 + hstep, voffB);
            PG8_WAIT_V(6); PG8_BAR; PG8_MMA(1, 1, At, B1); PG8_BAR;
            }
        }
        if constexpr (ALIGN_EPI) { if (wr == 0) PG8_BAR; }
        if constexpr (!Epi::AFTER_DRAIN) { E(acc, cur, wr, wc, fr, fq); S.done(cur); }
        if (!has_next) break;
#pragma unroll
        for (int a = 0; a < 2; ++a)
#pragma unroll
            for (int b = 0; b < 2; ++b)
#pragma unroll
                for (int m = 0; m < 4; ++m)
#pragma unroll
                    for (int n = 0; n < 2; ++n) acc[a][b][m][n] = (f32x4){0.f, 0.f, 0.f, 0.f};
        cur = nxt; cA = nA; cB = nB; ++ui;
        if constexpr (ALIGN_EPI) { if (wr == 1) PG8_BAR; }
    }
    PG8_WAIT_V(0);
    if constexpr (!ALIGN_EPI) { if (wr == 0) PG8_BAR; }
    PG8_BAR;
    if constexpr (Epi::AFTER_DRAIN) { E.fused(acc, cur, wr, wc, fr, fq, lds, wid, lane); S.done(cur); }
#undef PG8_SA
#undef PG8_SB
#undef PG8_STAGE
#undef PG8_LDA
#undef PG8_LDB
#undef PG8_MMA
#undef PG8_WAIT_V
#undef PG8_WAIT_L
#undef PG8_BAR
#undef PG8_SCHED
}
}
namespace att {
#define ALAS __attribute__((address_space(3)))
typedef unsigned short bf16_t;
typedef short bf16x8 __attribute__((ext_vector_type(8)));
typedef float f32x16 __attribute__((ext_vector_type(16)));
typedef float f32x4 __attribute__((ext_vector_type(4)));
typedef unsigned u32x4 __attribute__((ext_vector_type(4)));
typedef unsigned u32x2 __attribute__((ext_vector_type(2)));
constexpr int KROW = 144;
constexpr int KBUF = 64 * KROW;
constexpr int VBUF = 64 * 320;
template <int DV> struct VRow { static constexpr int B = (DV == 128) ? 320 : 192; };
constexpr int L_K = 0, L_V = 2 * KBUF, L_BT = L_V + 2 * VBUF, L_END = L_BT + 512;
constexpr int L_O1 = L_END;
constexpr int L_QS = L_O1 + 65536;
constexpr float LOG2E = 1.4426950408889634f;
constexpr float QSCALE = 0.125f * 1.4426950408889634f;
#define CR(r) (((r) & 3) + 8 * ((r) >> 2))
typedef float f32x2_t __attribute__((ext_vector_type(2))); typedef __bf16 bf16x2_t __attribute__((ext_vector_type(2)));
__device__ __forceinline__ unsigned cvtpk(float lo, float hi) { f32x2_t v = {lo, hi}; bf16x2_t b = __builtin_convertvector(v, bf16x2_t); return __builtin_bit_cast(unsigned, b); }
__device__ __forceinline__ float ex2(float x) { return __builtin_amdgcn_exp2f(x); }
__device__ __forceinline__ float rcpf_(float x) { return __builtin_amdgcn_rcpf(x); }

typedef short v4i16_t __attribute__((ext_vector_type(4)));
__device__ __forceinline__ v4i16_t vtr(const ALAS unsigned char* p) { return __builtin_amdgcn_ds_read_tr16_b64_v4i16((ALAS v4i16_t*)p); }
template <int DV> __device__ __forceinline__ bf16x8 vfrag(const ALAS unsigned char* vb, int s, int db) {
    const v4i16_t lo = vtr(vb + (16 * s) * VRow<DV>::B + 64 * db), hi4 = vtr(vb + (16 * s + 8) * VRow<DV>::B + 64 * db);
    return __builtin_shufflevector(lo, hi4, 0, 1, 2, 3, 4, 5, 6, 7);
}
template <int DV> __device__ __forceinline__ int vtr_lane_off(int lane) { return (4 * (lane >> 5) + ((lane & 15) >> 2)) * VRow<DV>::B + (16 * ((lane >> 4) & 1) + 4 * (lane & 3)) * 2; }
__device__ __forceinline__ float pair_max(float x) { auto rr = __builtin_amdgcn_permlane32_swap(__float_as_uint(x), __float_as_uint(x), false, false); return fmaxf(__uint_as_float(rr[0]), __uint_as_float(rr[1])); }
template <int DV> struct Pref { u32x4 k; u32x4 v[DV / 64]; };

template <int DV> __device__ __forceinline__ void tile_load(Pref<DV>& pf, const bf16_t* Kp, const bf16_t* Vp, int pitch, int kt, int tid) {
    const int krow = tid >> 3, kc = (tid & 7) * 8;
    pf.k = *(const u32x4*)(Kp + (size_t)(kt * 64 + krow) * pitch + kc);
#pragma unroll
    for (int i = 0; i < DV / 64; ++i) { const int c = tid + i * 512, vrow = c / (DV / 8), vc = (c % (DV / 8)) * 8;
        pf.v[i] = *(const u32x4*)(Vp + (size_t)(kt * 64 + vrow) * pitch + vc); }
}
template <int DV> __device__ __forceinline__ void tile_store(const Pref<DV>& pf, ALAS unsigned char* kbuf, ALAS unsigned char* vbuf, int tid) {
    const int krow = tid >> 3, kc = (tid & 7) * 8;
    *(ALAS u32x4*)(kbuf + krow * KROW + kc * 2) = pf.k;
#pragma unroll
    for (int i = 0; i < DV / 64; ++i) { const int c = tid + i * 512, vrow = c / (DV / 8), vc = (c % (DV / 8)) * 8;
        *(ALAS u32x4*)(vbuf + vrow * VRow<DV>::B + vc * 2) = pf.v[i]; }
}

template <int DV> __device__ __forceinline__ void pv_slab(const ALAS unsigned char* vbuf, int s, u32x4 w, f32x16 (&o)[DV / 32], int l32, int hi) {
    const bf16x8 pfr = __builtin_bit_cast(bf16x8, w);
#pragma unroll
    for (int db = 0; db < DV / 32; ++db) {
        const bf16x8 vf = vfrag<DV>(vbuf + vtr_lane_off<DV>(l32 + 32 * hi), s, db);
        o[db] = __builtin_amdgcn_mfma_f32_32x32x16_bf16(vf, pfr, o[db], 0, 0, 0); }
    if (DV > 64) __builtin_amdgcn_sched_barrier(0);
}

template <int MODE, int DV, bool MASKED>
__device__ __forceinline__ void tile_compute(const ALAS unsigned char* kbuf, const ALAS unsigned char* vbuf, const bf16x8 (&qf)[4], f32x16 (&o)[DV / 32],
                                             float& st_m, float& st_l, int lim, const ALAS float* btab, float cbias, int lane) {
    const int l32 = lane & 31, hi = lane >> 5;
    if constexpr (MODE == 0) {
        f32x16 p0, p1;
#pragma unroll
        for (int r = 0; r < 16; ++r) { p0[r] = 0.f; p1[r] = 0.f; }
        { const ALAS unsigned char* kb = kbuf + l32 * KROW + hi * 16;
#pragma unroll
          for (int d0 = 0; d0 < 4; ++d0) {
              const bf16x8 k0 = *(const ALAS bf16x8*)(kb + d0 * 32);
              const bf16x8 k1 = *(const ALAS bf16x8*)(kb + 32 * KROW + d0 * 32);
              p0 = __builtin_amdgcn_mfma_f32_32x32x16_bf16(k0, qf[d0], p0, 0, 0, 0);
              p1 = __builtin_amdgcn_mfma_f32_32x32x16_bf16(k1, qf[d0], p1, 0, 0, 0); } }
        __builtin_amdgcn_sched_barrier(0);
#pragma unroll
        for (int r = 0; r < 16; ++r) {
            float a = rcpf_(1.0f + ex2(p0[r])), b = rcpf_(1.0f + ex2(p1[r]));
            if (MASKED) { a = (CR(r) < lim) ? a : 1.0f; b = (CR(r) + 32 < lim) ? b : 1.0f; }
            p0[r] = a; p1[r] = b; }
        float g[8], hs[8], pr[8];
#pragma unroll
        for (int i = 0; i < 4; ++i) { g[i] = (p0[4 * i] * p0[4 * i + 1]) * (p0[4 * i + 2] * p0[4 * i + 3]); g[4 + i] = (p1[4 * i] * p1[4 * i + 1]) * (p1[4 * i + 2] * p1[4 * i + 3]); }
#pragma unroll
        for (int i = 0; i < 8; ++i) { auto rr = __builtin_amdgcn_permlane32_swap(__float_as_uint(g[i]), __float_as_uint(g[i]), false, false);
            pr[i] = __uint_as_float(rr[0]) * __uint_as_float(rr[1]); hs[i] = hi ? 1.0f : __uint_as_float(rr[1]); }
        float T = st_m;
#pragma unroll
        for (int i = 7; i >= 0; --i) {
            float R = hs[i] * T; T = T * pr[i];
            if (i >= 4) { const int b = 4 * (i - 4);
                float R2 = R * p1[b + 3]; p1[b + 3] = R - R2; float R1 = R2 * p1[b + 2]; p1[b + 2] = R2 - R1; float R0 = R1 * p1[b + 1]; p1[b + 1] = R1 - R0; p1[b] = R0 - R0 * p1[b]; }
            else { const int b = 4 * i;
                float R2 = R * p0[b + 3]; p0[b + 3] = R - R2; float R1 = R2 * p0[b + 2]; p0[b + 2] = R2 - R1; float R0 = R1 * p0[b + 1]; p0[b + 1] = R1 - R0; p0[b] = R0 - R0 * p0[b]; }
        }
        st_m = T;
        __builtin_amdgcn_sched_barrier(0);
#pragma unroll
        for (int s = 0; s < 4; ++s) {
            u32x4 w;
            if (s == 0) { w.x = cvtpk(p0[0], p0[1]); w.y = cvtpk(p0[2], p0[3]); w.z = cvtpk(p0[4], p0[5]); w.w = cvtpk(p0[6], p0[7]); }
            else if (s == 1) { w.x = cvtpk(p0[8], p0[9]); w.y = cvtpk(p0[10], p0[11]); w.z = cvtpk(p0[12], p0[13]); w.w = cvtpk(p0[14], p0[15]); }
            else if (s == 2) { w.x = cvtpk(p1[0], p1[1]); w.y = cvtpk(p1[2], p1[3]); w.z = cvtpk(p1[4], p1[5]); w.w = cvtpk(p1[6], p1[7]); }
            else { w.x = cvtpk(p1[8], p1[9]); w.y = cvtpk(p1[10], p1[11]); w.z = cvtpk(p1[12], p1[13]); w.w = cvtpk(p1[14], p1[15]); }
            pv_slab<DV>(vbuf, s, w, o, l32, hi);
        }
    } else {
        const float NEG = -__builtin_inff();
#pragma unroll
        for (int hk = 0; hk < 2; ++hk) {
            f32x16 p;
            const bool fresh = (st_m == NEG);
            const float mbase = fresh ? 0.f : st_m;
            { const float ini = (MASKED ? 0.f : cbias) - mbase;
#pragma unroll
              for (int r = 0; r < 16; ++r) p[r] = ini; }
            { const ALAS unsigned char* kb = kbuf + (32 * hk + l32) * KROW + hi * 16;
#pragma unroll
              for (int d0 = 0; d0 < 4; ++d0) { const bf16x8 k0 = *(const ALAS bf16x8*)(kb + d0 * 32); p = __builtin_amdgcn_mfma_f32_32x32x16_bf16(k0, qf[d0], p, 0, 0, 0); } }
            if (MASKED) {
                float bv[16];
#pragma unroll
                for (int r = 0; r < 16; ++r) { const int d0 = lim - 32 * hk - CR(r); bv[r] = btab[min(max(d0, 0), 127)]; }
#pragma unroll
                for (int r = 0; r < 16; ++r) asm volatile("" : "+v"(bv[r]));
#pragma unroll
                for (int r = 0; r < 16; ++r) {
                    const int d0 = lim - 32 * hk - CR(r);
                    const bool v0 = (MODE == 2) ? ((unsigned)d0 < 128u) : (d0 >= 0);
                    p[r] = v0 ? p[r] + bv[r] : NEG; }
            }
            float mt = fmaxf(p[0], p[1]);
#pragma unroll
            for (int r = 2; r < 16; ++r) mt = fmaxf(mt, p[r]);
            mt = fmaxf(mt, __shfl_xor(mt, 32));
            const bool need = fresh ? (mt > NEG) : (mt > 0.f);
            if (__any(need)) {
                const float dl = need ? mt : 0.f, f = fresh ? 1.0f : ex2(-dl);
                st_l *= f; st_m = need ? mbase + dl : st_m;
#pragma unroll
                for (int r = 0; r < 16; ++r) p[r] -= dl;
#pragma unroll
                for (int db = 0; db < DV / 32; ++db)
#pragma unroll
                    for (int r = 0; r < 16; ++r) o[db][r] *= f;
            }
            float s = 0.f;
#pragma unroll
            for (int r = 0; r < 16; ++r) { p[r] = ex2(p[r]); s += p[r]; }
            st_l += s;
#pragma unroll
            for (int s2 = 0; s2 < 2; ++s2) {
                u32x4 w; w.x = cvtpk(p[8 * s2], p[8 * s2 + 1]); w.y = cvtpk(p[8 * s2 + 2], p[8 * s2 + 3]); w.z = cvtpk(p[8 * s2 + 4], p[8 * s2 + 5]); w.w = cvtpk(p[8 * s2 + 6], p[8 * s2 + 7]);
                pv_slab<DV>(vbuf, 2 * hk + s2, w, o, l32, hi);
            }
        }
    }
}

template <int MODE, int DV>
__device__ __forceinline__ void attn_core(const bf16_t* Qp, const bf16_t* Kp, const bf16_t* Vp, int pitch, int q0, int kt0, int nt, int dir,
                                          ALAS unsigned char* lds, f32x16 (&o)[DV / 32], float& st_m, float& st_l) {
    int tid_ = threadIdx.x; asm volatile("" : "+v"(tid_));
    const int tid = tid_, lane = tid & 63, l32 = lane & 31, hi = lane >> 5, wid = __builtin_amdgcn_readfirstlane(tid >> 6);
    const int qw = q0 + 32 * wid, t = qw + l32;
    const ALAS float* btab = (const ALAS float*)(lds + L_BT);
    bf16x8 qf[4];
#pragma unroll
    for (int d0 = 0; d0 < 4; ++d0) qf[d0] = *(const bf16x8*)(Qp + (size_t)t * pitch + d0 * 16 + hi * 8);
#pragma unroll
    for (int db = 0; db < DV / 32; ++db)
#pragma unroll
        for (int r = 0; r < 16; ++r) o[db][r] = 0.f;
    st_m = (MODE == 0) ? 1.0f : -__builtin_inff(); st_l = 0.f;
    Pref<DV> pfA, pfB;
    tile_load<DV>(pfA, Kp, Vp, pitch, kt0, tid);
    tile_load<DV>(pfB, Kp, Vp, pitch, kt0 + dir * min(1, nt - 1), tid);
    tile_store<DV>(pfA, lds + L_K, lds + L_V, tid);
    __syncthreads();
    const float cbias = (MODE == 1) ? btab[127] : 0.f;
    bool done = false;
#define AC_STEP(it_, PFN, PFS) do { \
        const int it = (it_), kt = kt0 + dir * it, cur = it & 1, kbase = kt * 64; \
        tile_load<DV>(PFN, Kp, Vp, pitch, kt0 + dir * min(it + 2, nt - 1), tid);        \
        const ALAS unsigned char* kb = lds + L_K + cur * KBUF; const ALAS unsigned char* vb = lds + L_V + cur * VBUF; \
        const int lim = t - kbase - 4 * hi; \
        if (MODE == 0) { \
            if (kbase <= qw + 31 && __any(st_m != 0.0f)) { if (kbase + 63 >= qw) tile_compute<0, DV, true>(kb, vb, qf, o, st_m, st_l, lim, btab, cbias, lane); else tile_compute<0, DV, false>(kb, vb, qf, o, st_m, st_l, lim, btab, cbias, lane); } \
        } else if (MODE == 1) { \
            if (kbase <= qw + 31) { if (qw - (kbase + 63) < 113) tile_compute<1, DV, true>(kb, vb, qf, o, st_m, st_l, lim, btab, cbias, lane); else tile_compute<1, DV, false>(kb, vb, qf, o, st_m, st_l, lim, btab, cbias, lane); } \
        } else { \
            if (kbase <= qw + 31 && kbase + 63 >= qw - 127) tile_compute<2, DV, true>(kb, vb, qf, o, st_m, st_l, lim, btab, cbias, lane); \
        } \
        if (it + 1 < nt) tile_store<DV>(PFS, lds + L_K + (cur ^ 1) * KBUF, lds + L_V + (cur ^ 1) * VBUF, tid);     \
        if (MODE == 0) { \
              \
            if (!__syncthreads_or(st_m != 0.0f)) done = true; \
        } else __syncthreads(); } while (0)
    for (int it2 = 0; it2 < nt && !done; it2 += 2) {
        AC_STEP(it2, pfA, pfB);
        if (done) break;
        AC_STEP(it2 + 1, pfB, pfA);
    }
#undef AC_STEP
}
template <int MODE, int DV>
__device__ __forceinline__ void attn_core_pp(const bf16_t* Qp, const bf16_t* Kp, const bf16_t* Vp, int pitch, int q0, int kt0, int nt,
                                             ALAS unsigned char* lds, f32x16 (&o)[DV / 32], float& st_m, float& st_l) {
    int tid_ = threadIdx.x; asm volatile("" : "+v"(tid_));
    const int tid = tid_, lane = tid & 63, l32 = lane & 31, hi = lane >> 5, wid = __builtin_amdgcn_readfirstlane(tid >> 6), grp = wid >> 2;
    const int qw = q0 + 32 * wid, t = qw + l32;
    const ALAS float* btab = (const ALAS float*)(lds + L_BT);
    const float NEG = -__builtin_inff();
    bf16x8 qf[4];
#pragma unroll
    for (int d0 = 0; d0 < 4; ++d0) qf[d0] = *(const bf16x8*)(Qp + (size_t)t * pitch + d0 * 16 + hi * 8);
    ALAS unsigned char* qst = lds + L_QS + wid * 3072 + lane * 16;
    if (DV == 128) {
#pragma unroll
        for (int d0 = 1; d0 < 4; ++d0) *(ALAS bf16x8*)(qst + (d0 - 1) * 1024) = qf[d0];
    }
#pragma unroll
    for (int db = 0; db < DV / 32; ++db)
#pragma unroll
        for (int r = 0; r < 16; ++r) o[db][r] = 0.f;
    st_m = NEG; st_l = 0.f;
    Pref<DV> pfA, pfB;
    tile_load<DV>(pfA, Kp, Vp, pitch, kt0, tid);
    tile_load<DV>(pfB, Kp, Vp, pitch, kt0 + 1, tid);
    tile_store<DV>(pfA, lds + L_K, lds + L_V, tid);
    tile_store<DV>(pfB, lds + L_K + KBUF, lds + L_V + VBUF, tid);
    tile_load<DV>(pfA, Kp, Vp, pitch, kt0 + min(2, nt - 1), tid);
    tile_load<DV>(pfB, Kp, Vp, pitch, kt0 + min(3, nt - 1), tid);
    __syncthreads();
    const float cbias = (MODE == 1) ? btab[127] : 0.f;
    f32x16 p; u32x4 pw0, pw1;
#pragma unroll
    for (int r = 0; r < 16; ++r) p[r] = 0.f;
    pw0 = (u32x4){0u, 0u, 0u, 0u}; pw1 = pw0;
#define PP_MASKED(ti) ((MODE == 1) ? (qw - ((kt0 + (ti)) * 64 + 63) < 113) : true)
#define PP_QK(ti, hk) do { \
        const float mbase_ = (st_m == NEG) ? 0.f : st_m; const float ini_ = (PP_MASKED(ti) ? 0.f : cbias) - mbase_; \
        _Pragma("unroll") for (int r = 0; r < 16; ++r) p[r] = ini_; \
        const ALAS unsigned char* kb_ = lds + L_K + ((ti) & 1) * KBUF + (32 * (hk) + l32) * KROW + hi * 16; \
        _Pragma("unroll") for (int d0 = 0; d0 < 4; ++d0) { const bf16x8 k0_ = *(const ALAS bf16x8*)(kb_ + d0 * 32); \
            const bf16x8 qv_ = (DV == 128 && d0 > 0) ? *(const ALAS bf16x8*)(qst + (d0 - 1) * 1024) : qf[d0]; \
            p = __builtin_amdgcn_mfma_f32_32x32x16_bf16(k0_, qv_, p, 0, 0, 0); } } while (0)
#define PP_PVQK(tv, hv, tk, hq) do { \
        const ALAS unsigned char* vb_ = lds + L_V + ((tv) & 1) * VBUF + vtr_lane_off<DV>(lane); \
        const ALAS unsigned char* kb_ = lds + L_K + ((tk) & 1) * KBUF + (32 * (hq) + l32) * KROW + hi * 16; \
        bf16x8 vf_[DV / 32][2], kf_[4], qv_[4]; \
        _Pragma("unroll") for (int db = 0; db < DV / 32; ++db) { vf_[db][0] = vfrag<DV>(vb_, 2 * (hv), db); vf_[db][1] = vfrag<DV>(vb_, 2 * (hv) + 1, db); } \
        _Pragma("unroll") for (int d0 = 0; d0 < 4; ++d0) { kf_[d0] = *(const ALAS bf16x8*)(kb_ + d0 * 32); qv_[d0] = (DV == 128 && d0 > 0) ? *(const ALAS bf16x8*)(qst + (d0 - 1) * 1024) : qf[d0]; } \
        const bf16x8 pa_ = __builtin_bit_cast(bf16x8, pw0), pb_ = __builtin_bit_cast(bf16x8, pw1); \
        _Pragma("unroll") for (int db = 0; db < DV / 32; ++db) o[db] = __builtin_amdgcn_mfma_f32_32x32x16_bf16(vf_[db][0], pa_, o[db], 0, 0, 0); \
        const float mbase_ = (st_m == NEG) ? 0.f : st_m; const float ini_ = (PP_MASKED(tk) ? 0.f : cbias) - mbase_; \
        _Pragma("unroll") for (int r = 0; r < 16; ++r) p[r] = ini_; \
        _Pragma("unroll") for (int db = 0; db < DV / 32; ++db) o[db] = __builtin_amdgcn_mfma_f32_32x32x16_bf16(vf_[db][1], pb_, o[db], 0, 0, 0); \
        _Pragma("unroll") for (int d0 = 0; d0 < 4; ++d0) p = __builtin_amdgcn_mfma_f32_32x32x16_bf16(kf_[d0], qv_[d0], p, 0, 0, 0); } while (0)
#define PP_SM(ti, hk) do { \
        if (PP_MASKED(ti)) { const int lim_ = t - (kt0 + (ti)) * 64 - 4 * hi - 32 * (hk); \
            _Pragma("unroll") for (int g8 = 0; g8 < 16; g8 += 8) { float bv_[8]; \
                _Pragma("unroll") for (int r = 0; r < 8; ++r) { const int d0 = lim_ - CR(g8 + r); bv_[r] = btab[min(max(d0, 0), 127)]; } \
                _Pragma("unroll") for (int r = 0; r < 8; ++r) asm volatile("" : "+v"(bv_[r])); \
                _Pragma("unroll") for (int r = 0; r < 8; ++r) { const int d0 = lim_ - CR(g8 + r); const bool v0 = (MODE == 2) ? ((unsigned)d0 < 128u) : (d0 >= 0); p[g8 + r] = v0 ? p[g8 + r] + bv_[r] : NEG; } } } \
        const bool fresh_ = (st_m == NEG); const float mb_ = fresh_ ? 0.f : st_m; \
        float mt_; { const float a0_ = fmaxf(fmaxf(p[0], p[1]), p[2]), a1_ = fmaxf(fmaxf(p[3], p[4]), p[5]), a2_ = fmaxf(fmaxf(p[6], p[7]), p[8]), a3_ = fmaxf(fmaxf(p[9], p[10]), p[11]), a4_ = fmaxf(fmaxf(p[12], p[13]), p[14]); \
            mt_ = fmaxf(fmaxf(fmaxf(a0_, a1_), a2_), fmaxf(fmaxf(a3_, a4_), p[15])); }        \
        mt_ = pair_max(mt_); \
        const bool need_ = fresh_ ? (mt_ > NEG) : (mt_ > 0.f); \
        if (__any(need_)) { const float dl_ = need_ ? mt_ : 0.f, f_ = fresh_ ? 1.0f : ex2(-dl_); \
            st_l *= f_; st_m = need_ ? mb_ + dl_ : st_m; \
            _Pragma("unroll") for (int r = 0; r < 16; ++r) p[r] -= dl_; \
            _Pragma("unroll") for (int db = 0; db < DV / 32; ++db) _Pragma("unroll") for (int r = 0; r < 16; ++r) o[db][r] *= f_; } \
        _Pragma("unroll") for (int r = 0; r < 16; ++r) p[r] = ex2(p[r]); \
        st_l += ((p[0] + p[1]) + (p[2] + p[3])) + ((p[4] + p[5]) + (p[6] + p[7])) + (((p[8] + p[9]) + (p[10] + p[11])) + ((p[12] + p[13]) + (p[14] + p[15]))); \
        pw0.x = cvtpk(p[0], p[1]); pw0.y = cvtpk(p[2], p[3]); pw0.z = cvtpk(p[4], p[5]); pw0.w = cvtpk(p[6], p[7]); \
        pw1.x = cvtpk(p[8], p[9]); pw1.y = cvtpk(p[10], p[11]); pw1.z = cvtpk(p[12], p[13]); pw1.w = cvtpk(p[14], p[15]); } while (0)
#define PP_STAGE(u, PF) do { const int u_ = (u); if (u_ >= 2 && u_ < nt) tile_store<DV>(PF, lds + L_K + (u_ & 1) * KBUF, lds + L_V + (u_ & 1) * VBUF, tid); \
        tile_load<DV>(PF, Kp, Vp, pitch, kt0 + min(u_ + 2, nt - 1), tid); } while (0)
#define PP_BAR() asm volatile("s_waitcnt lgkmcnt(0)\n\ts_barrier" ::: "memory")
    if (grp == 1) __builtin_amdgcn_s_setprio(1);
    if (grp == 0) {
        PP_QK(0, 0); PP_BAR();
        for (int ti = 0; ti < nt; ti += 2) {
            PP_SM(ti, 0); PP_BAR();
            PP_PVQK(ti, 0, ti, 1); PP_STAGE(ti + 1, pfB); PP_BAR();
            PP_SM(ti, 1); PP_BAR();
            PP_PVQK(ti, 1, ti + 1, 0); PP_BAR();
            PP_SM(ti + 1, 0); PP_BAR();
            PP_PVQK(ti + 1, 0, ti + 1, 1); PP_STAGE(ti + 2, pfA); PP_BAR();
            PP_SM(ti + 1, 1); PP_BAR();
            PP_PVQK(ti + 1, 1, ti + 2, 0); PP_BAR();
        }
        PP_BAR();
    } else {
        PP_BAR();
        PP_QK(0, 0); PP_BAR();
        for (int ti = 0; ti < nt; ti += 2) {
            PP_SM(ti, 0); PP_STAGE(ti + 1, pfB); PP_BAR();
            PP_PVQK(ti, 0, ti, 1); PP_BAR();
            PP_SM(ti, 1); PP_BAR();
            PP_PVQK(ti, 1, ti + 1, 0); PP_BAR();
            PP_SM(ti + 1, 0); PP_STAGE(ti + 2, pfA); PP_BAR();
            PP_PVQK(ti + 1, 0, ti + 1, 1); PP_BAR();
            PP_SM(ti + 1, 1); PP_BAR();
            PP_PVQK(ti + 1, 1, ti + 2, 0); PP_BAR();
        }
    }
    __builtin_amdgcn_s_setprio(0);
#undef PP_MASKED
#undef PP_QK
#undef PP_PVQK
#undef PP_SM
#undef PP_STAGE
#undef PP_BAR
}
template <int DV> __device__ __forceinline__ void store_ot(const f32x16 (&o)[DV / 32], bf16_t* orow, int hi) {
#pragma unroll
    for (int db = 0; db < DV / 32; ++db)
#pragma unroll
        for (int rg = 0; rg < 4; ++rg) { u32x2 w; w.x = cvtpk(o[db][4 * rg], o[db][4 * rg + 1]); w.y = cvtpk(o[db][4 * rg + 2], o[db][4 * rg + 3]);
            *(u32x2*)(orow + 32 * db + 8 * rg + 4 * hi) = w; }
}
}
#ifndef RESID_BF16
#define RESID_BF16 1
#endif
#ifndef OUT_STAGGER_TICKS
#define OUT_STAGGER_TICKS 0
#endif
#ifndef OUT_STAGGER_GROUPS
#define OUT_STAGGER_GROUPS 2
#endif
#ifndef REP_OUT
#define REP_OUT 1
#endif
#ifndef REP_DOWN
#define REP_DOWN 1
#endif
#ifndef REP_INPROJ
#define REP_INPROJ 1
#endif
#ifndef REP_DIFF
#define REP_DIFF 1
#endif
#ifndef REP_SWA
#define REP_SWA 1
#endif
#ifndef REP_SB
#define REP_SB 1
#endif
#ifndef REP_UP
#define REP_UP 1
#endif
#ifndef REP_CONV
#define REP_CONV 1
#endif
#ifndef PH_DIFF
#define PH_DIFF 1
#endif
#ifndef PH_SWA
#define PH_SWA 1
#endif
#ifndef PH_SB
#define PH_SB 1
#endif
#ifndef PH_CONV
#define PH_CONV 1
#endif
#define LAS __attribute__((address_space(3)))
typedef unsigned short bf16;
typedef float f32x4 __attribute__((ext_vector_type(4)));
typedef unsigned v4u __attribute__((ext_vector_type(4)));
typedef unsigned v2u __attribute__((ext_vector_type(2)));
constexpr int NWAVES = 8;
constexpr int SEQ = 4096, NB = 16, MTOK = NB * SEQ, DM = 1024, DFF = 2816, DUP = 2 * DFF;
constexpr int EVEN_IN = 2304, ODD_IN = 3072;
constexpr size_t MiB = 1u << 20;
constexpr size_t WS_SSQ = 1 * MiB;
constexpr size_t WS_WINE = 8 * MiB, WS_WOUTE = 17 * MiB, WS_WINO = 21 * MiB, WS_WOUTO = 33 * MiB, WS_WUP = 37 * MiB, WS_WDN = 81 * MiB;
constexpr size_t WS_XB = 104 * MiB, WS_R = 232 * MiB;
constexpr size_t WS_PROJ = WS_R, WS_AO = WS_R + 384 * MiB, WS_U = WS_R, WS_G = WS_R + 352 * MiB;
constexpr int LDS_MISC = 150528, LDS_BYTES = 151552;
static_assert(att::L_QS + 8 * 3072 <= LDS_MISC, "LDS map");
constexpr int HALF_ROWS = MTOK / 2;

struct Args {
    const float* x; const float* rel_bias; const float* norm_mix; const float* norm_ffn; const float* norm_final;
    const float* w_in_even; const float* w_out_even; const float* sinks; const float* lam_q1; const float* lam_k1; const float* lam_q2; const float* lam_k2;
    const float* diff_norm; const float* w_in_odd; const float* w_out_odd; const float* ffn_up; const float* ffn_conv; const float* ffn_conv_b; const float* ffn_down;
    float* out; unsigned char* ws;
};

__device__ const unsigned char T5B[128] = {0, 1, 2, 3, 4, 5, 6, 7, 8, 9, 10, 11, 12, 13, 14, 15, 16, 16, 16, 17, 17, 18, 18, 18, 19, 19, 19, 20, 20, 20, 20, 21, 21, 21, 21, 22, 22, 22, 22, 22, 23, 23, 23, 23, 23, 23, 24, 24, 24, 24, 24, 24, 25, 25, 25, 25, 25, 25, 25, 26, 26, 26, 26, 26, 26, 26, 26, 27, 27, 27, 27, 27, 27, 27, 27, 27, 27, 28, 28, 28, 28, 28, 28, 28, 28, 28, 28, 29, 29, 29, 29, 29, 29, 29, 29, 29, 29, 29, 29, 30, 30, 30, 30, 30, 30, 30, 30, 30, 30, 30, 30, 30, 30, 31, 31, 31, 31, 31, 31, 31, 31, 31, 31, 31, 31, 31, 31, 31};

__device__ __forceinline__ float wave_sum(float v) {
#pragma unroll
    for (int o = 1; o < 64; o <<= 1) v += __shfl_xor(v, o);
    return v;
}
__device__ __forceinline__ unsigned f2bf(float f) { unsigned u = __builtin_bit_cast(unsigned, f); return (u + 0x7fffu + ((u >> 16) & 1u)) >> 16; }
__device__ __forceinline__ unsigned pk2(float lo, float hi) { return f2bf(lo) | (f2bf(hi) << 16); }

__device__ __forceinline__ void transpose_item(const float* W, int K, int N, bf16* WT, const float* gk, int a0, int a1, int b0, int b1, float cs, LAS float* scr, int item, int lane) {
    const int nblk = N / 32, kb = item / nblk, nb = item % nblk, k0 = 64 * kb, n0 = 32 * nb;
    const int nn = n0 + (lane & 31);
    const float csc = ((nn >= a0 && nn < a1) || (nn >= b0 && nn < b1)) ? cs : 1.0f;
#pragma unroll 8
    for (int i = 0; i < 32; ++i) { const int kk = 2 * i + (lane >> 5); const float gv = gk ? gk[k0 + kk] : 1.0f; scr[kk * 33 + (lane & 31)] = W[(size_t)(k0 + kk) * N + nn] * (gv * csc); }
    asm volatile("s_waitcnt lgkmcnt(0)" ::: "memory");
    const int c = lane & 7;
#pragma unroll
    for (int j = 0; j < 4; ++j) { const int n = (lane >> 3) + 8 * j; const LAS float* s = scr + (8 * c) * 33 + n;
        v4u o; o.x = pk2(s[0 * 33], s[1 * 33]); o.y = pk2(s[2 * 33], s[3 * 33]); o.z = pk2(s[4 * 33], s[5 * 33]); o.w = pk2(s[6 * 33], s[7 * 33]);
        *(v4u*)(WT + (size_t)(n0 + n) * K + k0 + 8 * c) = o; }
    asm volatile("s_waitcnt lgkmcnt(0)" ::: "memory");
}

#define XB_TMO      128
#define XB_XCNT(j)  (256  + 64 * (j))
#define XB_XSUB(j)  (1280 + 64 * (j))
#define XB_XGEN(j)  (2304 + 64 * (j))
#define XB_TOP      3328
#define XB_TOPGEN   3392
#define XCD_BAR_WORDS 3456
#define XB_SPIN_CAP (1u << 18)

__device__ __forceinline__ unsigned xb_ld(unsigned* p)              { return __hip_atomic_load(p, __ATOMIC_RELAXED, __HIP_MEMORY_SCOPE_AGENT); }
__device__ __forceinline__ unsigned xb_add(unsigned* p, unsigned v) { return __hip_atomic_fetch_add(p, v, __ATOMIC_RELAXED, __HIP_MEMORY_SCOPE_AGENT); }
__device__ __forceinline__ unsigned xb_xcc_id() { return (unsigned)__builtin_amdgcn_s_getreg((3 << 11) | 20) & 0xFu; }
#define XB_SPIN(cond, bar) do { unsigned _sp = 0; while (cond) { __builtin_amdgcn_s_sleep(1); \
    if ((++_sp & 255u) == 0u) { if (xb_ld(&(bar)[XB_TMO])) break; if (_sp > XB_SPIN_CAP) { atomicAdd(&(bar)[XB_TMO], 1u); break; } } } } while (0)

struct XcdBarrier {
    unsigned* bar; unsigned x;
    volatile LAS unsigned* st;
};

__device__ __forceinline__ XcdBarrier xcd_barrier_post(unsigned* bar, volatile LAS unsigned* st) {
    XcdBarrier b; b.bar = bar; b.x = xb_xcc_id(); b.st = st;
    if (threadIdx.x == 0) (void)xb_add(&bar[XB_XCNT(b.x)], 1u);
    return b;
}
__device__ __forceinline__ void xcd_barrier_complete(unsigned* bar, unsigned x, unsigned& nloc, unsigned& nx) {
    const unsigned G = gridDim.x * gridDim.y * gridDim.z;
    unsigned sum, cnt, mine, sp = 0u;
    for (;;) {
        sum = 0u; cnt = 0u; mine = 0u;
#pragma unroll
        for (unsigned j = 0; j < 16; ++j) { const unsigned c = xb_ld(&bar[XB_XCNT(j)]); sum += c; cnt += (c > 0u) ? 1u : 0u; mine = (j == x) ? c : mine; }
        if (sum == G) break;
        __builtin_amdgcn_s_sleep(1);
        if ((++sp & 255u) == 0u) { if (xb_ld(&bar[XB_TMO])) break; if (sp > XB_SPIN_CAP) { atomicAdd(&bar[XB_TMO], 1u); break; } }
    }
    nloc = mine > 0u ? mine : 1u; nx = cnt > 0u ? cnt : 1u;
}

__device__ __forceinline__ void xcd_barrier(const XcdBarrier& b) {
    asm volatile("s_waitcnt vmcnt(0)" ::: "memory");
    __syncthreads();
    if (threadIdx.x == 0) {
        unsigned* bar = b.bar;
        __builtin_amdgcn_s_waitcnt(0);
        unsigned nloc = b.st[0], nx = b.st[1];
        if (nloc == 0u) { xcd_barrier_complete(bar, b.x, nloc, nx); b.st[0] = nloc; b.st[1] = nx; }
        const unsigned old = xb_add(&bar[XB_XSUB(b.x)], 1u);
        const unsigned gen = old / nloc;
        if (old + 1u == (gen + 1u) * nloc) {
            __builtin_amdgcn_fence(__ATOMIC_RELEASE, "agent");
            asm volatile("s_waitcnt vmcnt(0)" ::: "memory");
            const unsigned og = xb_add(&bar[XB_TOP], 1u);
            const unsigned tg = og / nx;
            if (og + 1u == (tg + 1u) * nx) xb_add(&bar[XB_TOPGEN], 1u);
            else XB_SPIN(xb_ld(&bar[XB_TOPGEN]) == tg, bar);
            __builtin_amdgcn_fence(__ATOMIC_ACQUIRE, "agent");
            xb_add(&bar[XB_XGEN(b.x)], 1u);
            asm volatile("s_waitcnt vmcnt(0)" ::: "memory");
        } else {
            XB_SPIN(xb_ld(&bar[XB_XGEN(b.x)]) == gen, bar);
            __builtin_amdgcn_fence(__ATOMIC_ACQUIRE, "agent");
            asm volatile("s_waitcnt vmcnt(0)" ::: "memory");
        }
    }
    __syncthreads();
}

__global__ void __launch_bounds__(NWAVES * 64, 2) mega_fwd(Args a) {
    extern __shared__ __attribute__((aligned(16))) unsigned char lds_raw[];
    cg::grid_group grid = cg::this_grid();
    LAS unsigned char* lds = (LAS unsigned char*)lds_raw;
    const int tid = threadIdx.x, lane = tid & 63, wave = __builtin_amdgcn_readfirstlane(tid >> 6);
    const int G = gridDim.x, bx = blockIdx.x;
    const int gw = bx * NWAVES + wave, NGW = G * NWAVES;
    unsigned char* ws = a.ws;
    float* ssq = (float*)(ws + WS_SSQ);
    bf16* xb = (bf16*)(ws + WS_XB);
    bf16* proj = (bf16*)(ws + WS_PROJ);
    bf16* ao = (bf16*)(ws + WS_AO);
    bf16* ubuf = (bf16*)(ws + WS_U);
    bf16* gbuf = (bf16*)(ws + WS_G);

    if (bx == 0) for (int i = tid; i < XCD_BAR_WORDS; i += NWAVES * 64) ((unsigned*)ws)[i] = 0u;
    if (tid < 2) ((LAS unsigned*)(lds + LDS_MISC))[tid] = 0u;
    {
        LAS float* scr = (LAS float*)(lds + wave * 16384);
        constexpr int I_INE = 16 * (EVEN_IN / 32), I_OUT = 16 * 32, I_INO = 16 * (ODD_IN / 32), I_UP = 16 * (DUP / 32), I_DN = (DFF / 64) * 32;
        constexpr int NITEMS = 2 * I_INE + 2 * I_OUT + 2 * I_INO + 2 * I_OUT + 4 * I_UP + 4 * I_DN;
        for (int it = gw; it < NITEMS; it += NGW) {
            int r = it;
            if (r < 2 * I_INE) { const int e = r / I_INE; r -= e * I_INE;
                transpose_item(a.w_in_even + (size_t)e * DM * EVEN_IN, DM, EVEN_IN, (bf16*)(ws + WS_WINE) + (size_t)e * EVEN_IN * DM, a.norm_mix + (2 * e) * DM, 0, 512, 768, 1280, att::QSCALE, scr, r, lane); continue; }
            r -= 2 * I_INE;
            if (r < 2 * I_OUT) { const int e = r / I_OUT; r -= e * I_OUT;
                transpose_item(a.w_out_even + (size_t)e * DM * DM, DM, DM, (bf16*)(ws + WS_WOUTE) + (size_t)e * DM * DM, nullptr, 0, 0, 0, 0, 1.f, scr, r, lane); continue; }
            r -= 2 * I_OUT;
            if (r < 2 * I_INO) { const int e = r / I_INO; r -= e * I_INO;
                transpose_item(a.w_in_odd + (size_t)e * DM * ODD_IN, DM, ODD_IN, (bf16*)(ws + WS_WINO) + (size_t)e * ODD_IN * DM, a.norm_mix + (2 * e + 1) * DM, 0, 1024, 0, 0, att::QSCALE, scr, r, lane); continue; }
            r -= 2 * I_INO;
            if (r < 2 * I_OUT) { const int e = r / I_OUT; r -= e * I_OUT;
                transpose_item(a.w_out_odd + (size_t)e * DM * DM, DM, DM, (bf16*)(ws + WS_WOUTO) + (size_t)e * DM * DM, nullptr, 0, 0, 0, 0, 1.f, scr, r, lane); continue; }
            r -= 2 * I_OUT;
            if (r < 4 * I_UP) { const int e = r / I_UP; r -= e * I_UP;
                transpose_item(a.ffn_up + (size_t)e * DM * DUP, DM, DUP, (bf16*)(ws + WS_WUP) + (size_t)e * DUP * DM, a.norm_ffn + e * DM, 0, 0, 0, 0, 1.f, scr, r, lane); continue; }
            r -= 4 * I_UP;
            { const int e = r / I_DN; r -= e * I_DN;
                transpose_item(a.ffn_down + (size_t)e * DFF * DM, DFF, DM, (bf16*)(ws + WS_WDN) + (size_t)e * DM * DFF, nullptr, 0, 0, 0, 0, 1.f, scr, r, lane); }
        }
        for (int m0 = 2 * gw; m0 < MTOK; m0 += 2 * NGW) {
            f32x4 v[2][4];
#pragma unroll
            for (int h2 = 0; h2 < 2; ++h2) { const f32x4* xr = (const f32x4*)(a.x + (size_t)(m0 + h2) * DM) + lane;
#pragma unroll
                for (int j = 0; j < 4; ++j) v[h2][j] = __builtin_nontemporal_load(xr + 64 * j); }
#pragma unroll
            for (int h2 = 0; h2 < 2; ++h2) { const int m = m0 + h2; float s = 0.f;
#pragma unroll
                for (int j = 0; j < 4; ++j) s += (v[h2][j][0] * v[h2][j][0] + v[h2][j][1] * v[h2][j][1]) + (v[h2][j][2] * v[h2][j][2] + v[h2][j][3] * v[h2][j][3]);
                s = wave_sum(s);
                v2u* o8 = (v2u*)(xb + (size_t)m * DM) + lane;
#pragma unroll
                for (int j = 0; j < 4; ++j) { v2u w; w.x = pk2(v[h2][j][0], v[h2][j][1]); w.y = pk2(v[h2][j][2], v[h2][j][3]); o8[64 * j] = w; }
                if (lane < 16) ssq[(size_t)m * 16 + lane] = (lane == 0) ? s : 0.f; }
        }
    }
    grid.sync();
    const XcdBarrier xbar = xcd_barrier_post((unsigned*)ws, (volatile LAS unsigned*)(lds + LDS_MISC));

    for (int layer = 0; layer < 4; ++layer) {
        const int e = layer >> 1; const bool even = (layer & 1) == 0;
        const float* xold = (layer == 0) ? a.x : a.out;
        {
            const int N = even ? EVEN_IN : ODD_IN;
            const bf16* wt = even ? (const bf16*)(ws + WS_WINE) + (size_t)e * EVEN_IN * DM : (const bf16*)(ws + WS_WINO) + (size_t)e * ODD_IN * DM;
            pg8::Gemm g{xb, wt, MTOK, N, DM}; pg8::StaticOrder S; S.init(MTOK, N, G, bx);
            pg8::EpiScaleBf16 E{proj, N, ssq};
            for (int rep_ = 0; rep_ < REP_INPROJ; ++rep_)
            pg8::gemm_phase<pg8::EpiScaleBf16, pg8::StaticOrder, true, true>(lds, g, S, E);
        }
        xcd_barrier(xbar);
        if (even) {
            int tq = threadIdx.x; asm volatile("" : "+v"(tq)); const int tid = tq, lane = tq & 63, l32 = lane & 31, hi = lane >> 5;
            float lam, one_m_li;
            { const float li = (layer == 0) ? 0.2f : 0.47071301839f;
              const float s1 = wave_sum(a.lam_q1[e * 64 + lane] * a.lam_k1[e * 64 + lane]), s2 = wave_sum(a.lam_q2[e * 64 + lane] * a.lam_k2[e * 64 + lane]);
              lam = __expf(s1) - __expf(s2) + li; lam = __builtin_bit_cast(float, __builtin_amdgcn_readfirstlane(__builtin_bit_cast(int, lam))); one_m_li = __builtin_bit_cast(float, __builtin_amdgcn_readfirstlane(__builtin_bit_cast(int, 1.0f - li))); }
            LAS float* btab = (LAS float*)(lds + att::L_BT);

#if PH_DIFF
            for (int rep_ = 0; rep_ < REP_DIFF; ++rep_)
            for (int uidx = bx; uidx < 1024; uidx += G) {
                const int j = uidx >> 8, c = uidx & 255, bh = c >> 2, s = c & 3, b = bh >> 2, h = bh & 3;
                const int qb = (j == 0) ? s : (j == 1) ? 7 - s : (j == 2) ? 8 + s : 15 - s;
                { int tb = threadIdx.x; asm volatile("" : "+v"(tb)); if (tb < 128) btab[tb] = a.rel_bias[T5B[tb] * 12 + 8 + h] * att::LOG2E; }
                const bf16* base = proj + (size_t)b * SEQ * EVEN_IN;
                const int q0 = qb * 256, nt = 4 * qb + 4, t = q0 + 32 * wave + l32;
                att::f32x16 o2[4]; float m2, l2; LAS unsigned* o1s = (LAS unsigned*)(lds + att::L_O1 + wave * 8192) + lane;
                { float m1, l1;
                  att::attn_core_pp<1, 128>(base + 768 + h * 128, base + 1280 + h * 128, base + 1792 + h * 128, EVEN_IN, q0, 0, nt, lds, o2, m1, l1);
                  const float inv = __builtin_amdgcn_rcpf(l1 + __shfl_xor(l1, 32));
#pragma unroll
                  for (int db = 0; db < 4; ++db)
#pragma unroll
                      for (int k = 0; k < 8; ++k) o1s[(db * 8 + k) * 64] = att::cvtpk(o2[db][2 * k] * inv, o2[db][2 * k + 1] * inv); }
                att::attn_core_pp<1, 128>(base + 768 + h * 128 + 64, base + 1280 + h * 128 + 64, base + 1792 + h * 128, EVEN_IN, q0, 0, nt, lds, o2, m2, l2);
                { const float inv = lam * __builtin_amdgcn_rcpf(l2 + __shfl_xor(l2, 32)); float ss = 0.f;
#pragma unroll
                  for (int db = 0; db < 4; ++db)
#pragma unroll
                      for (int r = 0; r < 16; ++r) { const unsigned w = o1s[(db * 8 + (r >> 1)) * 64]; const float a1 = __uint_as_float((r & 1) ? (w & 0xffff0000u) : (w << 16));
                          const float v = a1 - inv * o2[db][r]; o2[db][r] = v; ss += v * v; }
                  ss += __shfl_xor(ss, 32);
                  const float rs = __builtin_amdgcn_rsqf(ss * (1.0f / 128.0f) + 1e-6f) * one_m_li;
                  const float* gn = a.diff_norm + e * 128;
#pragma unroll
                  for (int db = 0; db < 4; ++db)
#pragma unroll
                      for (int rg = 0; rg < 4; ++rg) { const f32x4 gv = *(const f32x4*)(gn + 32 * db + 8 * rg + 4 * hi);
#pragma unroll
                          for (int k = 0; k < 4; ++k) o2[db][4 * rg + k] *= rs * gv[k]; } }
                { int tb = threadIdx.x; asm volatile("" : "+v"(tb)); const int t2 = q0 + 32 * (tb >> 6) + (tb & 31);
                  att::store_ot<128>(o2, ao + ((size_t)b * SEQ + t2) * DM + 512 + h * 128, (tb >> 5) & 1); }
            }
#endif
#if PH_SWA
            for (int rep_ = 0; rep_ < REP_SWA; ++rep_)
            for (int uidx = bx; uidx < 2048; uidx += G) {
                const int qb = uidx & 15, qh = (uidx >> 4) & 7, b = uidx >> 7, kvh = qh >> 2;
                { int tb = threadIdx.x; asm volatile("" : "+v"(tb)); if (tb < 128) btab[tb] = a.rel_bias[T5B[tb] * 12 + qh] * att::LOG2E; }
                const bf16* base = proj + (size_t)b * SEQ * EVEN_IN;
                const int q0 = qb * 256, t = q0 + 32 * wave + l32;
                const int kt0 = (qb * 4 - 2 > 0) ? qb * 4 - 2 : 0, nt = qb * 4 + 4 - kt0;
                att::f32x16 o[2]; float m, l;
                att::attn_core_pp<2, 64>(base + qh * 64, base + 512 + kvh * 64, base + 640 + kvh * 64, EVEN_IN, q0, kt0, nt, lds, o, m, l);
                const float sk = a.sinks[e * 8 + qh] * att::LOG2E;
                const float inv = __builtin_amdgcn_rcpf(l + __shfl_xor(l, 32) + __builtin_amdgcn_exp2f(sk - m));
#pragma unroll
                for (int db = 0; db < 2; ++db)
#pragma unroll
                    for (int r = 0; r < 16; ++r) o[db][r] *= inv;
                att::store_ot<64>(o, ao + ((size_t)b * SEQ + t) * DM + qh * 64, hi);
            }
#endif
        } else {
#if PH_SB
            int tq = threadIdx.x; asm volatile("" : "+v"(tq)); const int lane = tq & 63, l32 = lane & 31, hi = lane >> 5;
            for (int rep_ = 0; rep_ < REP_SB; ++rep_)
            for (int uidx = bx; uidx < 4096; uidx += G) {
                const int bh = uidx & 255, qb = 15 - (uidx >> 8), b = bh >> 4, h = bh & 15;
                const bf16* base = proj + (size_t)b * SEQ * ODD_IN;
                const int q0 = qb * 256, nt = 4 * qb + 4, t = q0 + 32 * wave + l32;
                att::f32x16 o[2]; float P, dummy;
                att::attn_core<0, 64>(base + h * 64, base + 1024 + h * 64, base + 2048 + h * 64, ODD_IN, q0, nt - 1, nt, -1, lds, o, P, dummy);
                att::store_ot<64>(o, ao + ((size_t)b * SEQ + t) * DM + h * 64, hi);
            }
#endif
        }
        xcd_barrier(xbar);
        {
            const bf16* wt = even ? (const bf16*)(ws + WS_WOUTE) + (size_t)e * DM * DM : (const bf16*)(ws + WS_WOUTO) + (size_t)e * DM * DM;
            pg8::Gemm g{ao, wt, MTOK, DM, DM}; pg8::StaticOrder S; S.init(MTOK, DM, G, bx);
#if OUT_STAGGER_TICKS > 0
            { const unsigned long long t0 = __builtin_amdgcn_s_memrealtime(); const unsigned long long dly = (unsigned long long)(((bx >> 3) & (OUT_STAGGER_GROUPS - 1)) * OUT_STAGGER_TICKS);
              while (__builtin_amdgcn_s_memrealtime() - t0 < dly) __builtin_amdgcn_s_sleep(8); }
#endif
#if REP_OUT == 2
            { pg8::EpiResid Ed{xold, (float*)(ws + WS_PROJ), (bf16*)(ws + WS_PROJ + 256 * MiB), (float*)(ws + 800 * MiB)};
              pg8::gemm_phase<pg8::EpiResid, pg8::StaticOrder, true, true>(lds, g, S, Ed); }
#elif REP_OUT == 3
            { pg8::EpiScaleBf16 Ed{(bf16*)(ws + WS_PROJ), DM, ssq};
              pg8::gemm_phase<pg8::EpiScaleBf16, pg8::StaticOrder, true, true>(lds, g, S, Ed); }
#endif
#if RESID_BF16
            pg8::EpiResidB E{xb, xb, ssq};
            pg8::gemm_phase<pg8::EpiResidB, pg8::StaticOrder, true, true>(lds, g, S, E);
#else
            pg8::EpiResid E{xold, a.out, xb, ssq};
            pg8::gemm_phase<pg8::EpiResid, pg8::StaticOrder, true, true>(lds, g, S, E);
#endif
        }
        xcd_barrier(xbar);
        const bf16* wup = (const bf16*)(ws + WS_WUP) + (size_t)layer * DUP * DM;
        const bf16* wdn = (const bf16*)(ws + WS_WDN) + (size_t)layer * DM * DFF;
        for (int half = 0; half < 2; ++half) {
            const size_t r0 = (size_t)half * HALF_ROWS;
            {
                pg8::Gemm g{xb + r0 * DM, wup, HALF_ROWS, DUP, DM}; pg8::StaticOrder S; S.init(HALF_ROWS, DUP, G, bx);
                pg8::EpiScaleBf16 E{ubuf, DUP, ssq + r0 * 16};
                for (int rep_ = 0; rep_ < REP_UP; ++rep_)
                pg8::gemm_phase<pg8::EpiScaleBf16, pg8::StaticOrder, true, true>(lds, g, S, E);
            }
            xcd_barrier(xbar);
#if PH_CONV
            {
                const float* cw = a.ffn_conv + (size_t)layer * 3 * DUP; const float* cb = a.ffn_conv_b + (size_t)layer * DUP;
                constexpr int NCC = 6, NRC = HALF_ROWS / 32;
                int tq = threadIdx.x; asm volatile("" : "+v"(tq)); const int lane = tq & 63;
                for (int rep_ = 0; rep_ < REP_CONV; ++rep_)
                for (int it = gw; it < NCC * NRC; it += NGW) {
                    const int cc = it % NCC, rc = it / NCC, cgp = cc * 64 + lane;
                    if (cgp < DFF / 8) {
                        const int col = cgp * 8, row0 = rc * 32;
                        float wg[3][8], wv[3][8], bg[8], bv[8];
#pragma unroll
                        for (int tp = 0; tp < 3; ++tp)
#pragma unroll
                            for (int k = 0; k < 8; k += 4) { const f32x4 t1 = *(const f32x4*)(cw + tp * DUP + col + k), t2 = *(const f32x4*)(cw + tp * DUP + DFF + col + k);
#pragma unroll
                                for (int q = 0; q < 4; ++q) { wg[tp][k + q] = t1[q]; wv[tp][k + q] = t2[q]; } }
#pragma unroll
                        for (int k = 0; k < 8; k += 4) { const f32x4 t1 = *(const f32x4*)(cb + col + k), t2 = *(const f32x4*)(cb + DFF + col + k);
#pragma unroll
                            for (int q = 0; q < 4; ++q) { bg[k + q] = t1[q]; bv[k + q] = t2[q]; } }
                        float g2[8], g1[8], v2[8], v1[8];
                        const bool head = (row0 % SEQ) == 0;
                        {
                            v4u a2 = {0, 0, 0, 0}, a1 = {0, 0, 0, 0}, c2 = {0, 0, 0, 0}, c1 = {0, 0, 0, 0};
                            if (!head) { const bf16* up = ubuf + (size_t)(row0 - 2) * DUP + col; a2 = *(const v4u*)up; c2 = *(const v4u*)(up + DFF); a1 = *(const v4u*)(up + DUP); c1 = *(const v4u*)(up + DUP + DFF); }
#pragma unroll
                            for (int k = 0; k < 8; ++k) { const int sh = (k & 1) * 16;
                                g2[k] = __uint_as_float(((a2[k >> 1] >> sh) & 0xffffu) << 16); g1[k] = __uint_as_float(((a1[k >> 1] >> sh) & 0xffffu) << 16);
                                v2[k] = __uint_as_float(((c2[k >> 1] >> sh) & 0xffffu) << 16); v1[k] = __uint_as_float(((c1[k >> 1] >> sh) & 0xffffu) << 16); }
                        }
                        for (int r4 = 0; r4 < 32; r4 += 8) {
                            v4u av[8], cv[8];
#pragma unroll
                            for (int rr = 0; rr < 8; ++rr) { const bf16* up = ubuf + (size_t)(row0 + r4 + rr) * DUP + col;
                                av[rr] = __builtin_nontemporal_load((const v4u*)up); cv[rr] = __builtin_nontemporal_load((const v4u*)(up + DFF)); }
#pragma unroll
                            for (int rr = 0; rr < 8; ++rr) {
                                const v4u a0 = av[rr], c0 = cv[rr];
                                float res[8];
#pragma unroll
                                for (int k = 0; k < 8; ++k) { const int sh = (k & 1) * 16;
                                    const float g0 = __uint_as_float(((a0[k >> 1] >> sh) & 0xffffu) << 16), v0 = __uint_as_float(((c0[k >> 1] >> sh) & 0xffffu) << 16);
                                    const float gg = bg[k] + wg[0][k] * g2[k] + wg[1][k] * g1[k] + wg[2][k] * g0;
                                    const float vv = bv[k] + wv[0][k] * v2[k] + wv[1][k] * v1[k] + wv[2][k] * v0;
                                    const float sg = gg * __builtin_amdgcn_rcpf(1.0f + __builtin_amdgcn_exp2f(-gg * att::LOG2E));
                                    res[k] = sg * vv; g2[k] = g1[k]; g1[k] = g0; v2[k] = v1[k]; v1[k] = v0; }
                                v4u w; w.x = pk2(res[0], res[1]); w.y = pk2(res[2], res[3]); w.z = pk2(res[4], res[5]); w.w = pk2(res[6], res[7]);
                                *(v4u*)(gbuf + (size_t)(row0 + r4 + rr) * DFF + col) = w;
                            }
                        }
                    }
                }
            }
#endif
            xcd_barrier(xbar);
            {
                pg8::Gemm g{gbuf, wdn, HALF_ROWS, DM, DFF}; pg8::StaticOrder S; S.init(HALF_ROWS, DM, G, bx);
#if REP_DOWN > 1
                { pg8::EpiResid Ed{a.out + r0 * DM, (float*)(ws + 760 * MiB), (bf16*)(ws + 888 * MiB), (float*)(ws + 960 * MiB)};
                  pg8::gemm_phase<pg8::EpiResid, pg8::StaticOrder, true, true>(lds, g, S, Ed); }
#endif
#if RESID_BF16
                pg8::EpiResidB E{xb + r0 * DM, xb + r0 * DM, ssq + r0 * 16};
                pg8::gemm_phase<pg8::EpiResidB, pg8::StaticOrder, true, true>(lds, g, S, E);
#else
                pg8::EpiResid E{a.out + r0 * DM, a.out + r0 * DM, xb + r0 * DM, ssq + r0 * 16};
                pg8::gemm_phase<pg8::EpiResid, pg8::StaticOrder, true, true>(lds, g, S, E);
#endif
            }
            if (half == 1) xcd_barrier(xbar);
        }
    }
    { int tq = threadIdx.x; asm volatile("" : "+v"(tq)); const int lane = tq & 63;
    for (int m = gw; m < MTOK; m += NGW) {
        f32x4* xr = (f32x4*)(a.out + (size_t)m * DM) + lane; f32x4 v[4]; float s = 0.f;
#if RESID_BF16
        const v2u* xin = (const v2u*)(xb + (size_t)m * DM) + lane;
#pragma unroll
        for (int j = 0; j < 4; ++j) { const v2u w = xin[64 * j]; v[j][0] = __uint_as_float(w.x << 16); v[j][1] = __uint_as_float(w.x & 0xffff0000u); v[j][2] = __uint_as_float(w.y << 16); v[j][3] = __uint_as_float(w.y & 0xffff0000u);
            s += (v[j][0] * v[j][0] + v[j][1] * v[j][1]) + (v[j][2] * v[j][2] + v[j][3] * v[j][3]); }
#else
#pragma unroll
        for (int j = 0; j < 4; ++j) { v[j] = xr[64 * j]; s += (v[j][0] * v[j][0] + v[j][1] * v[j][1]) + (v[j][2] * v[j][2] + v[j][3] * v[j][3]); }
#endif
        s = wave_sum(s);
        const float rs = __builtin_amdgcn_rsqf(s * (1.0f / DM) + 1e-6f);
#pragma unroll
        for (int j = 0; j < 4; ++j) { const f32x4 gv = *((const f32x4*)a.norm_final + lane + 64 * j); xr[64 * j] = v[j] * rs * gv; }
    } }
}

extern "C" void kernel_launch(void* const* d_in, const int* in_sizes, int n_in, void* d_out, int out_size, void* d_ws, size_t ws_size, hipStream_t stream) {
    static int grid = 0;
    if (grid == 0) {
        int dev = 0, cus = 0, per_cu = 0;
        (void)hipGetDevice(&dev);
        (void)hipDeviceGetAttribute(&cus, hipDeviceAttributeMultiprocessorCount, dev);
        (void)hipFuncSetAttribute((const void*)mega_fwd, hipFuncAttributeMaxDynamicSharedMemorySize, LDS_BYTES);
        (void)hipOccupancyMaxActiveBlocksPerMultiprocessor(&per_cu, (const void*)mega_fwd, NWAVES * 64, LDS_BYTES);
        if (per_cu < 1) per_cu = 1;
        grid = cus * per_cu;
        if (n_in != 19 || ws_size < 1024 * MiB) fprintf(stderr, "kernel_launch: unexpected n_in %d / ws %zu\n", n_in, ws_size);
    }
    Args a{};
    a.x = (const float*)d_in[0]; a.rel_bias = (const float*)d_in[1]; a.norm_mix = (const float*)d_in[2]; a.norm_ffn = (const float*)d_in[3]; a.norm_final = (const float*)d_in[4];
    a.w_in_even = (const float*)d_in[5]; a.w_out_even = (const float*)d_in[6]; a.sinks = (const float*)d_in[7]; a.lam_q1 = (const float*)d_in[8]; a.lam_k1 = (const float*)d_in[9];
    a.lam_q2 = (const float*)d_in[10]; a.lam_k2 = (const float*)d_in[11]; a.diff_norm = (const float*)d_in[12]; a.w_in_odd = (const float*)d_in[13]; a.w_out_odd = (const float*)d_in[14];
    a.ffn_up = (const float*)d_in[15]; a.ffn_conv = (const float*)d_in[16]; a.ffn_conv_b = (const float*)d_in[17]; a.ffn_down = (const float*)d_in[18];
    a.out = (float*)d_out; a.ws = (unsigned char*)d_ws;
    void* args[] = {&a};
    hipError_t err = hipLaunchCooperativeKernel((const void*)mega_fwd, dim3(grid), dim3(NWAVES * 64), args, LDS_BYTES, stream);
    if (err != hipSuccess) fprintf(stderr, "kernel_launch: cooperative launch failed: %s (grid %d)\n", hipGetErrorString(err), grid);
}
```

```cpp
#include <hip/hip_runtime.h>
#include <hip/hip_cooperative_groups.h>
#include <cstdio>
#include <cstdint>
namespace cg = cooperative_groups;
namespace pg8 {
#define PG8_LAS __attribute__((address_space(3)))
typedef unsigned short bf16_t;
typedef short bf16x8 __attribute__((ext_vector_type(8)));
typedef float f32x4 __attribute__((ext_vector_type(4)));
typedef unsigned u32x4 __attribute__((ext_vector_type(4)));
constexpr int BM = 256, BK = 64, HALF = 128, HTB = HALF * BK * 2  , STAGE_BYTES = 8 * HTB, NXCD = 8, WGM = 8;

__host__ __device__ __forceinline__ int lds_byte(int r, int c) { const int st = (r >> 4) * 2 + (c >> 5), rr = r & 15, cc = c & 31, ob = rr * 64 + cc * 2; return st * 1024 + (ob ^ (((ob >> 9) & 1) << 5)); }
__host__ __device__ __forceinline__ void stage_rc(int b, int& R, int& C) { const int st = b / 1024, sb = b % 1024, swz = sb ^ (((sb >> 9) & 1) << 5); R = (st >> 1) * 16 + swz / 64; C = (st & 1) * 32 + (swz % 64) / 2; }
__host__ __device__ __forceinline__ int perm32(int rho) { const int n = rho >> 4, i = rho & 15; return 8 * (i >> 2) + 4 * n + (i & 3); }

struct Unit { int pm, pn; };
struct Gemm { const bf16_t* A; const bf16_t* Bt; int M, N, K; };

struct StaticOrder {
    int nM, nN, nwg, G, c;
    __host__ __device__ void init(int M, int N, int G_, int c_) { nM = M / BM; nN = N / BM; nwg = nM * nN; G = G_; c = c_; }
    __host__ __device__ bool next(int i, Unit& u) const {
        const long L = (long)i * G + c; if (L >= nwg) return false;
        int wgid = (int)L; { const int q = nwg / NXCD, r = nwg % NXCD, xcd = wgid % NXCD, off = wgid / NXCD; wgid = (xcd < r ? xcd * (q + 1) : r * (q + 1) + (xcd - r) * q) + off; }
        const int nig = WGM * nN, gid = wgid / nig, fm = gid * WGM, gsz = (nM - fm) < WGM ? (nM - fm) : WGM;
        u.pm = fm + ((wgid % nig) % gsz); u.pn = (wgid % nig) / gsz; return true;
    }
    __device__ __forceinline__ void a_ready(const Unit&) const {}
    __device__ __forceinline__ void done(const Unit&) const {}
};

__device__ __forceinline__ unsigned cvt_pk_bf16(float lo, float hi) { unsigned r; asm volatile("v_cvt_pk_bf16_f32 %0, %1, %2" : "=v"(r) : "v"(lo), "v"(hi)); return r; }
typedef float f32x2 __attribute__((ext_vector_type(2)));
typedef unsigned u32x2 __attribute__((ext_vector_type(2)));
constexpr float RMS_EPS = 1e-6f;
struct EpiScaleBf16 {
    static constexpr bool PERM = true, AFTER_DRAIN = false;
    bf16_t* O; int ldc; const float* ssq;
    __device__ __forceinline__ void operator()(const f32x4 (&acc)[2][2][4][2], const Unit& u, int wr, int wc, int fr, int fq) const {
        const int row0 = u.pm * BM + wr * 64 + fr, col0 = u.pn * BM + wc * 32 + 8 * fq;
        f32x4 part[2][4];
#pragma unroll
        for (int ai = 0; ai < 2; ++ai)
#pragma unroll
            for (int m = 0; m < 4; ++m) part[ai][m] = *(const f32x4*)(ssq + (size_t)(row0 + ai * HALF + m * 16) * 16 + fq * 4);
#pragma unroll
        for (int ai = 0; ai < 2; ++ai)
#pragma unroll
            for (int m = 0; m < 4; ++m) { const int row = row0 + ai * HALF + m * 16; bf16_t* rowp = O + (size_t)row * ldc + col0;
                float t = (part[ai][m][0] + part[ai][m][1]) + (part[ai][m][2] + part[ai][m][3]);
                t += __shfl_xor(t, 16); t += __shfl_xor(t, 32);
                const float rs = __builtin_amdgcn_rsqf(t * (1.0f / 1024.0f) + RMS_EPS);
#pragma unroll
                for (int bj = 0; bj < 2; ++bj) { const f32x4 v0 = acc[ai][bj][m][0] * rs, v1 = acc[ai][bj][m][1] * rs;
                    u32x4 w; w.x = cvt_pk_bf16(v0[0], v0[1]); w.y = cvt_pk_bf16(v0[2], v0[3]); w.z = cvt_pk_bf16(v1[0], v1[1]); w.w = cvt_pk_bf16(v1[2], v1[3]);
                    *(u32x4*)(rowp + bj * HALF) = w; } }
    }
};
struct EpiResid {
    static constexpr bool PERM = true, AFTER_DRAIN = false;
    const float* base; float* out; bf16_t* xb; float* ssq;
    __device__ __forceinline__ void operator()(const f32x4 (&acc)[2][2][4][2], const Unit& u, int wr, int wc, int fr, int fq) const {
        const int col0 = u.pn * BM + wc * 32 + 8 * fq;
        const size_t off0 = (size_t)(u.pm * BM + wr * 64 + fr) * 1024 + col0;
        f32x4 nx[2][2][2];
#pragma unroll
        for (int g = 0; g < 2; ++g) { const size_t offn = off0 + (size_t)(g * 16) * 1024;
#pragma unroll
            for (int bj = 0; bj < 2; ++bj)
#pragma unroll
                for (int n = 0; n < 2; ++n) nx[g][bj][n] = *(const f32x4*)(base + offn + bj * HALF + n * 4); }
        asm volatile("" ::: "memory");
#pragma unroll
        for (int g = 0; g < 8; ++g) { const int ai = g >> 2, m = g & 3; const int row = u.pm * BM + ai * HALF + wr * 64 + m * 16 + fr; const size_t off = (size_t)row * 1024 + col0; float q = 0.f;
            f32x4 cu[2][2];
#pragma unroll
            for (int bj = 0; bj < 2; ++bj)
#pragma unroll
                for (int n = 0; n < 2; ++n) cu[bj][n] = nx[g & 1][bj][n];
            if (g < 6) { const size_t offn = off0 + (size_t)(((g + 2) >> 2) * HALF + ((g + 2) & 3) * 16) * 1024;
#pragma unroll
                for (int bj = 0; bj < 2; ++bj)
#pragma unroll
                    for (int n = 0; n < 2; ++n) nx[g & 1][bj][n] = *(const f32x4*)(base + offn + bj * HALF + n * 4); }
#pragma unroll
            for (int bj = 0; bj < 2; ++bj) { const f32x4 o0 = cu[bj][0] + acc[ai][bj][m][0], o1 = cu[bj][1] + acc[ai][bj][m][1];
                *(f32x4*)(out + off + bj * HALF) = o0; *(f32x4*)(out + off + bj * HALF + 4) = o1;
                q += ((o0[0] * o0[0] + o0[1] * o0[1]) + (o0[2] * o0[2] + o0[3] * o0[3])) + ((o1[0] * o1[0] + o1[1] * o1[1]) + (o1[2] * o1[2] + o1[3] * o1[3]));
                u32x4 w; w.x = cvt_pk_bf16(o0[0], o0[1]); w.y = cvt_pk_bf16(o0[2], o0[3]); w.z = cvt_pk_bf16(o1[0], o1[1]); w.w = cvt_pk_bf16(o1[2], o1[3]);
                *(u32x4*)(xb + off + bj * HALF) = w; }
            q += __shfl_xor(q, 16); q += __shfl_xor(q, 32);
            if (fq == 0) ssq[(size_t)row * 16 + u.pn * 4 + wc] = q;
            asm volatile("" ::: "memory"); }
    }
};

struct EpiResidB {
    static constexpr bool PERM = true, AFTER_DRAIN = false;
    const bf16_t* base; bf16_t* xb; float* ssq;
    __device__ __forceinline__ void operator()(const f32x4 (&acc)[2][2][4][2], const Unit& u, int wr, int wc, int fr, int fq) const {
        const int col0 = u.pn * BM + wc * 32 + 8 * fq;
        const size_t off0 = (size_t)(u.pm * BM + wr * 64 + fr) * 1024 + col0;
        u32x4 nx[2][2];
#pragma unroll
        for (int g = 0; g < 2; ++g)
#pragma unroll
            for (int bj = 0; bj < 2; ++bj) nx[g][bj] = *(const u32x4*)(base + off0 + (size_t)(g * 16) * 1024 + bj * HALF);
        asm volatile("" ::: "memory");
#pragma unroll
        for (int g = 0; g < 8; ++g) { const int ai = g >> 2, m = g & 3; const int row = u.pm * BM + ai * HALF + wr * 64 + m * 16 + fr; const size_t off = (size_t)row * 1024 + col0; float q = 0.f;
            u32x4 cu[2];
#pragma unroll
            for (int bj = 0; bj < 2; ++bj) cu[bj] = nx[g & 1][bj];
            if (g < 6) { const size_t offn = off0 + (size_t)(((g + 2) >> 2) * HALF + ((g + 2) & 3) * 16) * 1024;
#pragma unroll
                for (int bj = 0; bj < 2; ++bj) nx[g & 1][bj] = *(const u32x4*)(base + offn + bj * HALF); }
#pragma unroll
            for (int bj = 0; bj < 2; ++bj) {
                f32x4 o0, o1;
                o0[0] = __uint_as_float(cu[bj].x << 16) + acc[ai][bj][m][0][0]; o0[1] = __uint_as_float(cu[bj].x & 0xffff0000u) + acc[ai][bj][m][0][1];
                o0[2] = __uint_as_float(cu[bj].y << 16) + acc[ai][bj][m][0][2]; o0[3] = __uint_as_float(cu[bj].y & 0xffff0000u) + acc[ai][bj][m][0][3];
                o1[0] = __uint_as_float(cu[bj].z << 16) + acc[ai][bj][m][1][0]; o1[1] = __uint_as_float(cu[bj].z & 0xffff0000u) + acc[ai][bj][m][1][1];
                o1[2] = __uint_as_float(cu[bj].w << 16) + acc[ai][bj][m][1][2]; o1[3] = __uint_as_float(cu[bj].w & 0xffff0000u) + acc[ai][bj][m][1][3];
                q += ((o0[0] * o0[0] + o0[1] * o0[1]) + (o0[2] * o0[2] + o0[3] * o0[3])) + ((o1[0] * o1[0] + o1[1] * o1[1]) + (o1[2] * o1[2] + o1[3] * o1[3]));
                u32x4 w; w.x = cvt_pk_bf16(o0[0], o0[1]); w.y = cvt_pk_bf16(o0[2], o0[3]); w.z = cvt_pk_bf16(o1[0], o1[1]); w.w = cvt_pk_bf16(o1[2], o1[3]);
                *(u32x4*)(xb + off + bj * HALF) = w; }
            q += __shfl_xor(q, 16); q += __shfl_xor(q, 32);
            if (fq == 0) ssq[(size_t)row * 16 + u.pn * 4 + wc] = q;
            asm volatile("" ::: "memory"); }
    }
};
template <class Epi, class Sched, bool ALIGN_EPI = false, bool SP2 = false>
__device__ __forceinline__ void gemm_phase(PG8_LAS unsigned char* lds, const Gemm g, const Sched& S, const Epi& E) {
    int tid_ = threadIdx.x; asm volatile("" : "+v"(tid_));
    const int tid = tid_, wid = __builtin_amdgcn_readfirstlane(tid >> 6), lane = tid & 63, wr = wid >> 2, wc = wid & 3, fr = lane & 15, fq = lane >> 4;
    const int K = g.K, nt = K / BK;
    unsigned voffA[2], voffB[2];
#pragma unroll
    for (int i = 0; i < 2; ++i) { int R, C; stage_rc(tid * 16 + i * 8192, R, C); const int Rb = Epi::PERM ? ((R & ~31) + perm32(R & 31)) : R;
        voffA[i] = (unsigned)(R * K + C) * 2u; voffB[i] = (unsigned)(Rb * K + C) * 2u; }
    const size_t kstep = (size_t)(BK * 2);
    const size_t hstep = (size_t)HALF * K * 2;
    const size_t tstep = 2 * hstep;
    const unsigned ldsw = (unsigned)wid * 1024u;
    const int aoff = lds_byte(wr * 64 + fr, fq * 8), boff = lds_byte(wc * 32 + fr, fq * 8);
#define PG8_SA(b, h) (((b) * 2 + (h)) * HTB)
#define PG8_SB(b, h) ((4 + (b) * 2 + (h)) * HTB)
#define PG8_STAGE(bufoff, gbase, voff) do { _Pragma("unroll") for (int _i = 0; _i < 2; ++_i) \
        __builtin_amdgcn_global_load_lds((const unsigned*)((const char*)(gbase) + (voff)[_i]), (PG8_LAS unsigned*)(lds + (bufoff) + ldsw + _i * 8192), 16, 0, 0); } while (0)
#define PG8_LDA(dst, b, h) do { _Pragma("unroll") for (int m = 0; m < 4; ++m) _Pragma("unroll") for (int k = 0; k < 2; ++k) dst[m][k] = *(const PG8_LAS bf16x8*)(lds + PG8_SA(b, h) + aoff + m * 2048 + k * 1024); } while (0)
#define PG8_LDB(dst, b, h) do { _Pragma("unroll") for (int n = 0; n < 2; ++n) _Pragma("unroll") for (int k = 0; k < 2; ++k) dst[n][k] = *(const PG8_LAS bf16x8*)(lds + PG8_SB(b, h) + boff + n * 2048 + k * 1024); } while (0)
#define PG8_MMA(ai, bj, At, Bt) do { __builtin_amdgcn_s_setprio(1); _Pragma("unroll") for (int m = 0; m < 4; ++m) _Pragma("unroll") for (int n = 0; n < 2; ++n) _Pragma("unroll") for (int k = 0; k < 2; ++k) \
        acc[ai][bj][m][n] = __builtin_amdgcn_mfma_f32_16x16x32_bf16(Bt[n][k], At[m][k], acc[ai][bj][m][n], 0, 0, 0); __builtin_amdgcn_s_setprio(0); } while (0)
#define PG8_WAIT_V(n) asm volatile("s_waitcnt vmcnt(" #n ")" ::: "memory")
#define PG8_WAIT_L(n) asm volatile("s_waitcnt lgkmcnt(" #n ")" ::: "memory")
#define PG8_BAR __builtin_amdgcn_s_barrier()
#define PG8_SCHED __builtin_amdgcn_sched_barrier(0)
    Unit cur, nxt; int ui = 0;
    if (!S.next(0, cur)) return;
    f32x4 acc[2][2][4][2];
#pragma unroll
    for (int a = 0; a < 2; ++a)
#pragma unroll
        for (int b = 0; b < 2; ++b)
#pragma unroll
            for (int m = 0; m < 4; ++m)
#pragma unroll
                for (int n = 0; n < 2; ++n) acc[a][b][m][n] = (f32x4){0.f, 0.f, 0.f, 0.f};
    bf16x8 At[4][2], B0[2][2], B1[2][2];
    const char* cA = (const char*)g.A + (size_t)cur.pm * tstep; const char* cB = (const char*)g.Bt + (size_t)cur.pn * tstep;
    S.a_ready(cur);
    if constexpr (SP2) {
        PG8_STAGE(PG8_SB(0, 0), cB, voffB); PG8_STAGE(PG8_SB(0, 1), cB + hstep, voffB); PG8_STAGE(PG8_SA(0, 0), cA, voffA); PG8_STAGE(PG8_SA(0, 1), cA + hstep, voffA);
        if (wr == 1) PG8_BAR;
        PG8_WAIT_V(2); PG8_BAR;
        PG8_STAGE(PG8_SB(1, 0), cB + kstep, voffB); PG8_STAGE(PG8_SA(1, 0), cA + kstep, voffA); PG8_STAGE(PG8_SB(1, 1), cB + hstep + kstep, voffB);
        PG8_WAIT_V(6); PG8_BAR;
    } else {
        PG8_STAGE(PG8_SB(0, 0), cB, voffB); PG8_STAGE(PG8_SA(0, 0), cA, voffA); PG8_STAGE(PG8_SB(0, 1), cB + hstep, voffB); PG8_STAGE(PG8_SA(0, 1), cA + hstep, voffA);
        if (wr == 1) PG8_BAR;
        PG8_WAIT_V(4); PG8_BAR;
        PG8_STAGE(PG8_SB(1, 0), cB + kstep, voffB); PG8_STAGE(PG8_SA(1, 0), cA + kstep, voffA); PG8_STAGE(PG8_SB(1, 1), cB + hstep + kstep, voffB);
        PG8_WAIT_V(6); PG8_BAR;
    }
    for (;;) {
        const bool has_next = S.next(ui + 1, nxt);
        const char* nA = has_next ? (const char*)g.A + (size_t)nxt.pm * tstep : cA; const char* nB = has_next ? (const char*)g.Bt + (size_t)nxt.pn * tstep : cB;
        for (int t = 0; t < nt; t += 2) {
            const bool last = (t == nt - 2);
            const char* a1 = cA + (size_t)(t + 1) * kstep;
            const char* a2 = last ? nA : cA + (size_t)(t + 2) * kstep; const char* b2 = last ? nB : cB + (size_t)(t + 2) * kstep;
            const char* a3 = a2 + kstep; const char* b3 = b2 + kstep;
            if (last && has_next) S.a_ready(nxt);
            if constexpr (SP2) {
            PG8_LDB(B0, 0, 0); PG8_LDB(B1, 0, 1); PG8_SCHED; PG8_LDA(At, 0, 0); PG8_STAGE(PG8_SA(1, 1), a1 + hstep, voffA);
            PG8_WAIT_V(8); PG8_WAIT_L(0); PG8_BAR; PG8_MMA(0, 0, At, B0); PG8_MMA(0, 1, At, B1); PG8_BAR; PG8_SCHED;
            PG8_LDA(At, 0, 1); PG8_STAGE(PG8_SB(0, 0), b2, voffB); PG8_STAGE(PG8_SB(0, 1), b2 + hstep, voffB); PG8_STAGE(PG8_SA(0, 0), a2, voffA);
            PG8_WAIT_V(8); PG8_WAIT_L(0); PG8_BAR; PG8_MMA(1, 0, At, B0); PG8_MMA(1, 1, At, B1); PG8_BAR; PG8_SCHED;
            PG8_LDB(B0, 1, 0); PG8_LDB(B1, 1, 1); PG8_SCHED; PG8_LDA(At, 1, 0); PG8_STAGE(PG8_SA(0, 1), a2 + hstep, voffA);
            PG8_WAIT_V(8); PG8_WAIT_L(0); PG8_BAR; PG8_MMA(0, 0, At, B0); PG8_MMA(0, 1, At, B1); PG8_BAR; PG8_SCHED;
            PG8_LDA(At, 1, 1); PG8_STAGE(PG8_SB(1, 0), b3, voffB); PG8_STAGE(PG8_SB(1, 1), b3 + hstep, voffB); PG8_STAGE(PG8_SA(1, 0), a3, voffA);
            PG8_WAIT_V(8); PG8_WAIT_L(0); PG8_BAR; PG8_MMA(1, 0, At, B0); PG8_MMA(1, 1, At, B1); PG8_BAR; PG8_SCHED;
            } else {
            PG8_LDB(B0, 0, 0); PG8_SCHED; PG8_LDA(At, 0, 0); PG8_STAGE(PG8_SA(1, 1), a1 + hstep, voffA);
            PG8_WAIT_L(8); PG8_BAR; PG8_WAIT_L(0); PG8_MMA(0, 0, At, B0); PG8_BAR; PG8_SCHED;
            PG8_LDB(B1, 0, 1); PG8_STAGE(PG8_SB(0, 0), b2, voffB);
            PG8_BAR; PG8_WAIT_L(0); PG8_MMA(0, 1, At, B1); PG8_BAR;
            PG8_LDA(At, 0, 1); PG8_STAGE(PG8_SA(0, 0), a2, voffA);
            PG8_BAR; PG8_WAIT_L(0); PG8_MMA(1, 0, At, B0); PG8_BAR; PG8_SCHED;
            PG8_STAGE(PG8_SB(0, 1), b2 + hstep, voffB);
            PG8_WAIT_V(6); PG8_BAR; PG8_MMA(1, 1, At, B1); PG8_BAR;
            PG8_LDB(B0, 1, 0); PG8_SCHED; PG8_LDA(At, 1, 0); PG8_STAGE(PG8_SA(0, 1), a2 + hstep, voffA);
            PG8_WAIT_L(8); PG8_BAR; PG8_WAIT_L(0); PG8_MMA(0, 0, At, B0); PG8_BAR; PG8_SCHED;
            PG8_LDB(B1, 1, 1); PG8_STAGE(PG8_SB(1, 0), b3, voffB);
            PG8_BAR; PG8_WAIT_L(0); PG8_MMA(0, 1, At, B1); PG8_BAR;
            PG8_LDA(At, 1, 1); PG8_STAGE(PG8_SA(1, 0), a3, voffA);
            PG8_BAR; PG8_WAIT_L(0); PG8_MMA(1, 0, At, B0); PG8_BAR; PG8_SCHED;
            PG8_STAGE(PG8_SB(1, 1), b3 + hstep, voffB);
            PG8_WAIT_V(6); PG8_BAR; PG8_MMA(1, 1, At, B1); PG8_BAR;
            }
        }
        if constexpr (ALIGN_EPI) { if (wr == 0) PG8_BAR; }
        if constexpr (!Epi::AFTER_DRAIN) { E(acc, cur, wr, wc, fr, fq); S.done(cur); }
        if (!has_next) break;
#pragma unroll
        for (int a = 0; a < 2; ++a)
#pragma unroll
            for (int b = 0; b < 2; ++b)
#pragma unroll
                for (int m = 0; m < 4; ++m)
#pragma unroll
                    for (int n = 0; n < 2; ++n) acc[a][b][m][n] = (f32x4){0.f, 0.f, 0.f, 0.f};
        cur = nxt; cA = nA; cB = nB; ++ui;
        if constexpr (ALIGN_EPI) { if (wr == 1) PG8_BAR; }
    }
    PG8_WAIT_V(0);
    if constexpr (!ALIGN_EPI) { if (wr == 0) PG8_BAR; }
    PG8_BAR;
    if constexpr (Epi::AFTER_DRAIN) { E.fused(acc, cur, wr, wc, fr, fq, lds, wid, lane); S.done(cur); }
#undef PG8_SA
#undef PG8_SB
#undef PG8_STAGE
#undef PG8_LDA
#undef PG8_LDB
#undef PG8_MMA
#undef PG8_WAIT_V
#undef PG8_WAIT_L
#undef PG8_BAR
#undef PG8_SCHED
}
}
namespace att {
#define ALAS __attribute__((address_space(3)))
typedef unsigned short bf16_t;
typedef short bf16x8 __attribute__((ext_vector_type(8)));
typedef float f32x16 __attribute__((ext_vector_type(16)));
typedef float f32x4 __attribute__((ext_vector_type(4)));
typedef unsigned u32x4 __attribute__((ext_vector_type(4)));
typedef unsigned u32x2 __attribute__((ext_vector_type(2)));
constexpr int KROW = 144;
constexpr int KBUF = 64 * KROW;
constexpr int VBUF = 64 * 320;
template <int DV> struct VRow { static constexpr int B = (DV == 128) ? 320 : 192; };
constexpr int L_K = 0, L_V = 2 * KBUF, L_BT = L_V + 2 * VBUF, L_END = L_BT + 512;
constexpr int L_O1 = L_END;
constexpr int L_QS = L_O1 + 65536;
constexpr float LOG2E = 1.4426950408889634f;
constexpr float QSCALE = 0.125f * 1.4426950408889634f;
#define CR(r) (((r) & 3) + 8 * ((r) >> 2))
typedef float f32x2_t __attribute__((ext_vector_type(2))); typedef __bf16 bf16x2_t __attribute__((ext_vector_type(2)));
__device__ __forceinline__ unsigned cvtpk(float lo, float hi) { f32x2_t v = {lo, hi}; bf16x2_t b = __builtin_convertvector(v, bf16x2_t); return __builtin_bit_cast(unsigned, b); }
__device__ __forceinline__ unsigned cvtpk_a(float lo, float hi) { unsigned r; asm volatile("v_cvt_pk_bf16_f32 %0, %1, %2" : "=v"(r) : "v"(lo), "v"(hi)); return r; }
__device__ __forceinline__ float ex2(float x) { return __builtin_amdgcn_exp2f(x); }
__device__ __forceinline__ float rcpf_(float x) { return __builtin_amdgcn_rcpf(x); }

typedef short v4i16_t __attribute__((ext_vector_type(4)));
__device__ __forceinline__ v4i16_t vtr(const ALAS unsigned char* p) { return __builtin_amdgcn_ds_read_tr16_b64_v4i16((ALAS v4i16_t*)p); }
template <int DV> __device__ __forceinline__ bf16x8 vfrag(const ALAS unsigned char* vb, int s, int db) {
    const v4i16_t lo = vtr(vb + (16 * s) * VRow<DV>::B + 64 * db), hi4 = vtr(vb + (16 * s + 8) * VRow<DV>::B + 64 * db);
    return __builtin_shufflevector(lo, hi4, 0, 1, 2, 3, 4, 5, 6, 7);
}
template <int DV> __device__ __forceinline__ int vtr_lane_off(int lane) { return (4 * (lane >> 5) + ((lane & 15) >> 2)) * VRow<DV>::B + (16 * ((lane >> 4) & 1) + 4 * (lane & 3)) * 2; }
__device__ __forceinline__ float pair_max(float x) { auto rr = __builtin_amdgcn_permlane32_swap(__float_as_uint(x), __float_as_uint(x), false, false); return fmaxf(__uint_as_float(rr[0]), __uint_as_float(rr[1])); }
template <int DV> struct Pref { u32x4 k; u32x4 v[DV / 64]; };

template <int DV> __device__ __forceinline__ void tile_load(Pref<DV>& pf, const bf16_t* Kp, const bf16_t* Vp, int pitch, int kt, int tid) {
    const int krow = tid >> 3, kc = (tid & 7) * 8;
    pf.k = *(const u32x4*)(Kp + (size_t)(kt * 64 + krow) * pitch + kc);
#pragma unroll
    for (int i = 0; i < DV / 64; ++i) { const int c = tid + i * 512, vrow = c / (DV / 8), vc = (c % (DV / 8)) * 8;
        pf.v[i] = *(const u32x4*)(Vp + (size_t)(kt * 64 + vrow) * pitch + vc); }
}
template <int DV> __device__ __forceinline__ void tile_store(const Pref<DV>& pf, ALAS unsigned char* kbuf, ALAS unsigned char* vbuf, int tid) {
    const int krow = tid >> 3, kc = (tid & 7) * 8;
    *(ALAS u32x4*)(kbuf + krow * KROW + kc * 2) = pf.k;
#pragma unroll
    for (int i = 0; i < DV / 64; ++i) { const int c = tid + i * 512, vrow = c / (DV / 8), vc = (c % (DV / 8)) * 8;
        *(ALAS u32x4*)(vbuf + vrow * VRow<DV>::B + vc * 2) = pf.v[i]; }
}

template <int DV> __device__ __forceinline__ void pv_slab(const ALAS unsigned char* vbuf, int s, u32x4 w, f32x16 (&o)[DV / 32], int l32, int hi) {
    const bf16x8 pfr = __builtin_bit_cast(bf16x8, w);
#pragma unroll
    for (int db = 0; db < DV / 32; ++db) {
        const bf16x8 vf = vfrag<DV>(vbuf + vtr_lane_off<DV>(l32 + 32 * hi), s, db);
        o[db] = __builtin_amdgcn_mfma_f32_32x32x16_bf16(vf, pfr, o[db], 0, 0, 0); }
    if (DV > 64) __builtin_amdgcn_sched_barrier(0);
}

template <int MODE, int DV, bool MASKED>
__device__ __forceinline__ void tile_compute(const ALAS unsigned char* kbuf, const ALAS unsigned char* vbuf, const bf16x8 (&qf)[4], f32x16 (&o)[DV / 32],
                                             float& st_m, float& st_l, int lim, const ALAS float* btab, float cbias, int lane) {
    const int l32 = lane & 31, hi = lane >> 5;
    if constexpr (MODE == 0) {
        f32x16 p0, p1;
#pragma unroll
        for (int r = 0; r < 16; ++r) { p0[r] = 0.f; p1[r] = 0.f; }
        { const ALAS unsigned char* kb = kbuf + l32 * KROW + hi * 16;
#pragma unroll
          for (int d0 = 0; d0 < 4; ++d0) {
              const bf16x8 k0 = *(const ALAS bf16x8*)(kb + d0 * 32);
              const bf16x8 k1 = *(const ALAS bf16x8*)(kb + 32 * KROW + d0 * 32);
              p0 = __builtin_amdgcn_mfma_f32_32x32x16_bf16(k0, qf[d0], p0, 0, 0, 0);
              p1 = __builtin_amdgcn_mfma_f32_32x32x16_bf16(k1, qf[d0], p1, 0, 0, 0); } }
        __builtin_amdgcn_sched_barrier(0);
#pragma unroll
        for (int r = 0; r < 16; ++r) {
            float a = rcpf_(1.0f + ex2(p0[r])), b = rcpf_(1.0f + ex2(p1[r]));
            if (MASKED) { a = (CR(r) < lim) ? a : 1.0f; b = (CR(r) + 32 < lim) ? b : 1.0f; }
            p0[r] = a; p1[r] = b; }
        float g[8], hs[8], pr[8];
#pragma unroll
        for (int i = 0; i < 4; ++i) { g[i] = (p0[4 * i] * p0[4 * i + 1]) * (p0[4 * i + 2] * p0[4 * i + 3]); g[4 + i] = (p1[4 * i] * p1[4 * i + 1]) * (p1[4 * i + 2] * p1[4 * i + 3]); }
#pragma unroll
        for (int i = 0; i < 8; ++i) { auto rr = __builtin_amdgcn_permlane32_swap(__float_as_uint(g[i]), __float_as_uint(g[i]), false, false);
            pr[i] = __uint_as_float(rr[0]) * __uint_as_float(rr[1]); hs[i] = hi ? 1.0f : __uint_as_float(rr[1]); }
        float T = st_m;
#pragma unroll
        for (int i = 7; i >= 0; --i) {
            float R = hs[i] * T; T = T * pr[i];
            if (i >= 4) { const int b = 4 * (i - 4);
                float R2 = R * p1[b + 3]; p1[b + 3] = R - R2; float R1 = R2 * p1[b + 2]; p1[b + 2] = R2 - R1; float R0 = R1 * p1[b + 1]; p1[b + 1] = R1 - R0; p1[b] = R0 - R0 * p1[b]; }
            else { const int b = 4 * i;
                float R2 = R * p0[b + 3]; p0[b + 3] = R - R2; float R1 = R2 * p0[b + 2]; p0[b + 2] = R2 - R1; float R0 = R1 * p0[b + 1]; p0[b + 1] = R1 - R0; p0[b] = R0 - R0 * p0[b]; }
        }
        st_m = T;
        __builtin_amdgcn_sched_barrier(0);
#pragma unroll
        for (int s = 0; s < 4; ++s) {
            u32x4 w;
            if (s == 0) { w.x = cvtpk(p0[0], p0[1]); w.y = cvtpk(p0[2], p0[3]); w.z = cvtpk(p0[4], p0[5]); w.w = cvtpk(p0[6], p0[7]); }
            else if (s == 1) { w.x = cvtpk(p0[8], p0[9]); w.y = cvtpk(p0[10], p0[11]); w.z = cvtpk(p0[12], p0[13]); w.w = cvtpk(p0[14], p0[15]); }
            else if (s == 2) { w.x = cvtpk(p1[0], p1[1]); w.y = cvtpk(p1[2], p1[3]); w.z = cvtpk(p1[4], p1[5]); w.w = cvtpk(p1[6], p1[7]); }
            else { w.x = cvtpk(p1[8], p1[9]); w.y = cvtpk(p1[10], p1[11]); w.z = cvtpk(p1[12], p1[13]); w.w = cvtpk(p1[14], p1[15]); }
            pv_slab<DV>(vbuf, s, w, o, l32, hi);
        }
    } else {
        const float NEG = -__builtin_inff();
#pragma unroll
        for (int hk = 0; hk < 2; ++hk) {
            f32x16 p;
            const bool fresh = (st_m == NEG);
            const float mbase = fresh ? 0.f : st_m;
            { const float ini = (MASKED ? 0.f : cbias) - mbase;
#pragma unroll
              for (int r = 0; r < 16; ++r) p[r] = ini; }
            { const ALAS unsigned char* kb = kbuf + (32 * hk + l32) * KROW + hi * 16;
#pragma unroll
              for (int d0 = 0; d0 < 4; ++d0) { const bf16x8 k0 = *(const ALAS bf16x8*)(kb + d0 * 32); p = __builtin_amdgcn_mfma_f32_32x32x16_bf16(k0, qf[d0], p, 0, 0, 0); } }
            if (MASKED) {
                float bv[16];
#pragma unroll
                for (int r = 0; r < 16; ++r) { const int d0 = lim - 32 * hk - CR(r); bv[r] = btab[min(max(d0, 0), 127)]; }
#pragma unroll
                for (int r = 0; r < 16; ++r) asm volatile("" : "+v"(bv[r]));
#pragma unroll
                for (int r = 0; r < 16; ++r) {
                    const int d0 = lim - 32 * hk - CR(r);
                    const bool v0 = (MODE == 2) ? ((unsigned)d0 < 128u) : (d0 >= 0);
                    p[r] = v0 ? p[r] + bv[r] : NEG; }
            }
            float mt = fmaxf(p[0], p[1]);
#pragma unroll
            for (int r = 2; r < 16; ++r) mt = fmaxf(mt, p[r]);
            mt = fmaxf(mt, __shfl_xor(mt, 32));
            const bool need = fresh ? (mt > NEG) : (mt > 0.f);
            if (__any(need)) {
                const float dl = need ? mt : 0.f, f = fresh ? 1.0f : ex2(-dl);
                st_l *= f; st_m = need ? mbase + dl : st_m;
#pragma unroll
                for (int r = 0; r < 16; ++r) p[r] -= dl;
#pragma unroll
                for (int db = 0; db < DV / 32; ++db)
#pragma unroll
                    for (int r = 0; r < 16; ++r) o[db][r] *= f;
            }
            float s = 0.f;
#pragma unroll
            for (int r = 0; r < 16; ++r) { p[r] = ex2(p[r]); s += p[r]; }
            st_l += s;
#pragma unroll
            for (int s2 = 0; s2 < 2; ++s2) {
                u32x4 w; w.x = cvtpk(p[8 * s2], p[8 * s2 + 1]); w.y = cvtpk(p[8 * s2 + 2], p[8 * s2 + 3]); w.z = cvtpk(p[8 * s2 + 4], p[8 * s2 + 5]); w.w = cvtpk(p[8 * s2 + 6], p[8 * s2 + 7]);
                pv_slab<DV>(vbuf, 2 * hk + s2, w, o, l32, hi);
            }
        }
    }
}

template <int MODE, int DV>
__device__ __forceinline__ void attn_core(const bf16_t* Qp, const bf16_t* Kp, const bf16_t* Vp, int pitch, int q0, int kt0, int nt, int dir,
                                          ALAS unsigned char* lds, f32x16 (&o)[DV / 32], float& st_m, float& st_l) {
    int tid_ = threadIdx.x; asm volatile("" : "+v"(tid_));
    const int tid = tid_, lane = tid & 63, l32 = lane & 31, hi = lane >> 5, wid = __builtin_amdgcn_readfirstlane(tid >> 6);
    const int qw = q0 + 32 * wid, t = qw + l32;
    const ALAS float* btab = (const ALAS float*)(lds + L_BT);
    bf16x8 qf[4];
#pragma unroll
    for (int d0 = 0; d0 < 4; ++d0) qf[d0] = *(const bf16x8*)(Qp + (size_t)t * pitch + d0 * 16 + hi * 8);
#pragma unroll
    for (int db = 0; db < DV / 32; ++db)
#pragma unroll
        for (int r = 0; r < 16; ++r) o[db][r] = 0.f;
    st_m = (MODE == 0) ? 1.0f : -__builtin_inff(); st_l = 0.f;
    Pref<DV> pfA, pfB;
    tile_load<DV>(pfA, Kp, Vp, pitch, kt0, tid);
    tile_load<DV>(pfB, Kp, Vp, pitch, kt0 + dir * min(1, nt - 1), tid);
    tile_store<DV>(pfA, lds + L_K, lds + L_V, tid);
    __syncthreads();
    const float cbias = (MODE == 1) ? btab[127] : 0.f;
    bool done = false;
#define AC_STEP(it_, PFN, PFS) do { \
        const int it = (it_), kt = kt0 + dir * it, cur = it & 1, kbase = kt * 64; \
        tile_load<DV>(PFN, Kp, Vp, pitch, kt0 + dir * min(it + 2, nt - 1), tid);        \
        const ALAS unsigned char* kb = lds + L_K + cur * KBUF; const ALAS unsigned char* vb = lds + L_V + cur * VBUF; \
        const int lim = t - kbase - 4 * hi; \
        if (MODE == 0) { \
            if (kbase <= qw + 31 && __any(st_m != 0.0f)) { if (kbase + 63 >= qw) tile_compute<0, DV, true>(kb, vb, qf, o, st_m, st_l, lim, btab, cbias, lane); else tile_compute<0, DV, false>(kb, vb, qf, o, st_m, st_l, lim, btab, cbias, lane); } \
        } else if (MODE == 1) { \
            if (kbase <= qw + 31) { if (qw - (kbase + 63) < 113) tile_compute<1, DV, true>(kb, vb, qf, o, st_m, st_l, lim, btab, cbias, lane); else tile_compute<1, DV, false>(kb, vb, qf, o, st_m, st_l, lim, btab, cbias, lane); } \
        } else { \
            if (kbase <= qw + 31 && kbase + 63 >= qw - 127) tile_compute<2, DV, true>(kb, vb, qf, o, st_m, st_l, lim, btab, cbias, lane); \
        } \
        if (it + 1 < nt) tile_store<DV>(PFS, lds + L_K + (cur ^ 1) * KBUF, lds + L_V + (cur ^ 1) * VBUF, tid);     \
        if (MODE == 0) { \
              \
            if (!__syncthreads_or(st_m != 0.0f)) done = true; \
        } else __syncthreads(); } while (0)
    for (int it2 = 0; it2 < nt && !done; it2 += 2) {
        AC_STEP(it2, pfA, pfB);
        if (done) break;
        AC_STEP(it2 + 1, pfB, pfA);
    }
#undef AC_STEP
}
template <int MODE, int DV>
__device__ __forceinline__ void attn_core_pp(const bf16_t* Qp, const bf16_t* Kp, const bf16_t* Vp, int pitch, int q0, int kt0, int nt,
                                             ALAS unsigned char* lds, f32x16 (&o)[DV / 32], float& st_m, float& st_l) {
    int tid_ = threadIdx.x; asm volatile("" : "+v"(tid_));
    const int tid = tid_, lane = tid & 63, l32 = lane & 31, hi = lane >> 5, wid = __builtin_amdgcn_readfirstlane(tid >> 6), grp = wid >> 2;
    const int qw = q0 + 32 * wid, t = qw + l32;
    const ALAS float* btab = (const ALAS float*)(lds + L_BT);
    const float NEG = -__builtin_inff();
    bf16x8 qf[4];
#pragma unroll
    for (int d0 = 0; d0 < 4; ++d0) qf[d0] = *(const bf16x8*)(Qp + (size_t)t * pitch + d0 * 16 + hi * 8);
    ALAS unsigned char* qst = lds + L_QS + wid * 3072 + lane * 16;
    if (DV == 128) {
#pragma unroll
        for (int d0 = 1; d0 < 4; ++d0) *(ALAS bf16x8*)(qst + (d0 - 1) * 1024) = qf[d0];
    }
#pragma unroll
    for (int db = 0; db < DV / 32; ++db)
#pragma unroll
        for (int r = 0; r < 16; ++r) o[db][r] = 0.f;
    st_m = NEG; st_l = 0.f;
    Pref<DV> pfA, pfB;
    tile_load<DV>(pfA, Kp, Vp, pitch, kt0, tid);
    tile_load<DV>(pfB, Kp, Vp, pitch, kt0 + 1, tid);
    tile_store<DV>(pfA, lds + L_K, lds + L_V, tid);
    tile_store<DV>(pfB, lds + L_K + KBUF, lds + L_V + VBUF, tid);
    tile_load<DV>(pfA, Kp, Vp, pitch, kt0 + min(2, nt - 1), tid);
    tile_load<DV>(pfB, Kp, Vp, pitch, kt0 + min(3, nt - 1), tid);
    __syncthreads();
    const float cbias = (MODE == 1) ? btab[127] : 0.f;
    f32x16 p; u32x4 pw0, pw1;
#pragma unroll
    for (int r = 0; r < 16; ++r) p[r] = 0.f;
    pw0 = (u32x4){0u, 0u, 0u, 0u}; pw1 = pw0;
#define PP_MASKED(ti) ((MODE == 1) ? (qw - ((kt0 + (ti)) * 64 + 63) < 113) : true)
#define PP_QK(ti, hk) do { \
        const float mbase_ = (st_m == NEG) ? 0.f : st_m; const float ini_ = (PP_MASKED(ti) ? 0.f : cbias) - mbase_; \
        _Pragma("unroll") for (int r = 0; r < 16; ++r) p[r] = ini_; \
        const ALAS unsigned char* kb_ = lds + L_K + ((ti) & 1) * KBUF + (32 * (hk) + l32) * KROW + hi * 16; \
        _Pragma("unroll") for (int d0 = 0; d0 < 4; ++d0) { const bf16x8 k0_ = *(const ALAS bf16x8*)(kb_ + d0 * 32); \
            const bf16x8 qv_ = (DV == 128 && d0 > 0) ? *(const ALAS bf16x8*)(qst + (d0 - 1) * 1024) : qf[d0]; \
            p = __builtin_amdgcn_mfma_f32_32x32x16_bf16(k0_, qv_, p, 0, 0, 0); } } while (0)
#define PP_PVQK(tv, hv, tk, hq) do { \
        const ALAS unsigned char* vb_ = lds + L_V + ((tv) & 1) * VBUF + vtr_lane_off<DV>(lane); \
        const ALAS unsigned char* kb_ = lds + L_K + ((tk) & 1) * KBUF + (32 * (hq) + l32) * KROW + hi * 16; \
        bf16x8 vf_[DV / 32][2], kf_[4], qv_[4]; \
        _Pragma("unroll") for (int db = 0; db < DV / 32; ++db) { vf_[db][0] = vfrag<DV>(vb_, 2 * (hv), db); vf_[db][1] = vfrag<DV>(vb_, 2 * (hv) + 1, db); } \
        _Pragma("unroll") for (int d0 = 0; d0 < 4; ++d0) { kf_[d0] = *(const ALAS bf16x8*)(kb_ + d0 * 32); qv_[d0] = (DV == 128 && d0 > 0) ? *(const ALAS bf16x8*)(qst + (d0 - 1) * 1024) : qf[d0]; } \
        const bf16x8 pa_ = __builtin_bit_cast(bf16x8, pw0), pb_ = __builtin_bit_cast(bf16x8, pw1); \
        _Pragma("unroll") for (int db = 0; db < DV / 32; ++db) o[db] = __builtin_amdgcn_mfma_f32_32x32x16_bf16(vf_[db][0], pa_, o[db], 0, 0, 0); \
        const float mbase_ = (st_m == NEG) ? 0.f : st_m; const float ini_ = (PP_MASKED(tk) ? 0.f : cbias) - mbase_; \
        _Pragma("unroll") for (int r = 0; r < 16; ++r) p[r] = ini_; \
        _Pragma("unroll") for (int db = 0; db < DV / 32; ++db) o[db] = __builtin_amdgcn_mfma_f32_32x32x16_bf16(vf_[db][1], pb_, o[db], 0, 0, 0); \
        _Pragma("unroll") for (int d0 = 0; d0 < 4; ++d0) p = __builtin_amdgcn_mfma_f32_32x32x16_bf16(kf_[d0], qv_[d0], p, 0, 0, 0); } while (0)
#define PP_SM(ti, hk) do { \
        if (PP_MASKED(ti)) { const int lim_ = t - (kt0 + (ti)) * 64 - 4 * hi - 32 * (hk); \
            _Pragma("unroll") for (int g8 = 0; g8 < 16; g8 += 8) { float bv_[8]; \
                _Pragma("unroll") for (int r = 0; r < 8; ++r) { const int d0 = lim_ - CR(g8 + r); bv_[r] = btab[min(max(d0, 0), 127)]; } \
                _Pragma("unroll") for (int r = 0; r < 8; ++r) asm volatile("" : "+v"(bv_[r])); \
                _Pragma("unroll") for (int r = 0; r < 8; ++r) { const int d0 = lim_ - CR(g8 + r); const bool v0 = (MODE == 2) ? ((unsigned)d0 < 128u) : (d0 >= 0); p[g8 + r] = v0 ? p[g8 + r] + bv_[r] : NEG; } } } \
        const bool fresh_ = (st_m == NEG); const float mb_ = fresh_ ? 0.f : st_m; \
        float mt_; { const float a0_ = fmaxf(fmaxf(p[0], p[1]), p[2]), a1_ = fmaxf(fmaxf(p[3], p[4]), p[5]), a2_ = fmaxf(fmaxf(p[6], p[7]), p[8]), a3_ = fmaxf(fmaxf(p[9], p[10]), p[11]), a4_ = fmaxf(fmaxf(p[12], p[13]), p[14]); \
            mt_ = fmaxf(fmaxf(fmaxf(a0_, a1_), a2_), fmaxf(fmaxf(a3_, a4_), p[15])); }        \
        mt_ = pair_max(mt_); \
        const bool need_ = fresh_ ? (mt_ > NEG) : (mt_ > 0.f); \
        if (__any(need_)) { const float dl_ = need_ ? mt_ : 0.f, f_ = fresh_ ? 1.0f : ex2(-dl_); \
            st_l *= f_; st_m = need_ ? mb_ + dl_ : st_m; \
            _Pragma("unroll") for (int r = 0; r < 16; ++r) p[r] -= dl_; \
            _Pragma("unroll") for (int db = 0; db < DV / 32; ++db) _Pragma("unroll") for (int r = 0; r < 16; ++r) o[db][r] *= f_; } \
        _Pragma("unroll") for (int r = 0; r < 16; ++r) p[r] = ex2(p[r]); \
        st_l += ((p[0] + p[1]) + (p[2] + p[3])) + ((p[4] + p[5]) + (p[6] + p[7])) + (((p[8] + p[9]) + (p[10] + p[11])) + ((p[12] + p[13]) + (p[14] + p[15]))); \
        pw0.x = cvtpk_a(p[0], p[1]); pw0.y = cvtpk_a(p[2], p[3]); pw0.z = cvtpk_a(p[4], p[5]); pw0.w = cvtpk_a(p[6], p[7]); \
        pw1.x = cvtpk_a(p[8], p[9]); pw1.y = cvtpk_a(p[10], p[11]); pw1.z = cvtpk_a(p[12], p[13]); pw1.w = cvtpk_a(p[14], p[15]); } while (0)
#define PP_STAGE(u, PF) do { const int u_ = (u); if (u_ >= 2 && u_ < nt) tile_store<DV>(PF, lds + L_K + (u_ & 1) * KBUF, lds + L_V + (u_ & 1) * VBUF, tid); \
        tile_load<DV>(PF, Kp, Vp, pitch, kt0 + min(u_ + 2, nt - 1), tid); } while (0)
#define PP_BAR() asm volatile("s_waitcnt lgkmcnt(0)\n\ts_barrier" ::: "memory")
    if (grp == 1) __builtin_amdgcn_s_setprio(1);
    if (grp == 0) {
        PP_QK(0, 0); PP_BAR();
        for (int ti = 0; ti < nt; ti += 2) {
            PP_SM(ti, 0); PP_BAR();
            PP_PVQK(ti, 0, ti, 1); PP_STAGE(ti + 1, pfB); PP_BAR();
            PP_SM(ti, 1); PP_BAR();
            PP_PVQK(ti, 1, ti + 1, 0); PP_BAR();
            PP_SM(ti + 1, 0); PP_BAR();
            PP_PVQK(ti + 1, 0, ti + 1, 1); PP_STAGE(ti + 2, pfA); PP_BAR();
            PP_SM(ti + 1, 1); PP_BAR();
            PP_PVQK(ti + 1, 1, ti + 2, 0); PP_BAR();
        }
        PP_BAR();
    } else {
        PP_BAR();
        PP_QK(0, 0); PP_BAR();
        for (int ti = 0; ti < nt; ti += 2) {
            PP_SM(ti, 0); PP_STAGE(ti + 1, pfB); PP_BAR();
            PP_PVQK(ti, 0, ti, 1); PP_BAR();
            PP_SM(ti, 1); PP_BAR();
            PP_PVQK(ti, 1, ti + 1, 0); PP_BAR();
            PP_SM(ti + 1, 0); PP_STAGE(ti + 2, pfA); PP_BAR();
            PP_PVQK(ti + 1, 0, ti + 1, 1); PP_BAR();
            PP_SM(ti + 1, 1); PP_BAR();
            PP_PVQK(ti + 1, 1, ti + 2, 0); PP_BAR();
        }
    }
    __builtin_amdgcn_s_setprio(0);
#undef PP_MASKED
#undef PP_QK
#undef PP_PVQK
#undef PP_SM
#undef PP_STAGE
#undef PP_BAR
}
template <int DV> __device__ __forceinline__ void store_ot(const f32x16 (&o)[DV / 32], bf16_t* orow, int hi) {
#pragma unroll
    for (int db = 0; db < DV / 32; ++db)
#pragma unroll
        for (int rg = 0; rg < 4; ++rg) { u32x2 w; w.x = cvtpk_a(o[db][4 * rg], o[db][4 * rg + 1]); w.y = cvtpk_a(o[db][4 * rg + 2], o[db][4 * rg + 3]);
            *(u32x2*)(orow + 32 * db + 8 * rg + 4 * hi) = w; }
}
}
#ifndef RESID_BF16
#define RESID_BF16 1
#endif
#ifndef OUT_STAGGER_TICKS
#define OUT_STAGGER_TICKS 0
#endif
#ifndef OUT_STAGGER_GROUPS
#define OUT_STAGGER_GROUPS 2
#endif
#ifndef REP_OUT
#define REP_OUT 1
#endif
#ifndef REP_DOWN
#define REP_DOWN 1
#endif
#ifndef REP_INPROJ
#define REP_INPROJ 1
#endif
#ifndef REP_DIFF
#define REP_DIFF 1
#endif
#ifndef REP_SWA
#define REP_SWA 1
#endif
#ifndef REP_SB
#define REP_SB 1
#endif
#ifndef REP_UP
#define REP_UP 1
#endif
#ifndef REP_CONV
#define REP_CONV 1
#endif
#ifndef PH_DIFF
#define PH_DIFF 1
#endif
#ifndef PH_SWA
#define PH_SWA 1
#endif
#ifndef PH_SB
#define PH_SB 1
#endif
#ifndef PH_CONV
#define PH_CONV 1
#endif
#define LAS __attribute__((address_space(3)))
typedef unsigned short bf16;
typedef float f32x4 __attribute__((ext_vector_type(4)));
typedef unsigned v4u __attribute__((ext_vector_type(4)));
typedef unsigned v2u __attribute__((ext_vector_type(2)));
constexpr int NWAVES = 8;
constexpr int SEQ = 4096, NB = 16, MTOK = NB * SEQ, DM = 1024, DFF = 2816, DUP = 2 * DFF;
constexpr int EVEN_IN = 2304, ODD_IN = 3072;
constexpr size_t MiB = 1u << 20;
constexpr size_t WS_SSQ = 1 * MiB;
constexpr size_t WS_WINE = 8 * MiB, WS_WOUTE = 17 * MiB, WS_WINO = 21 * MiB, WS_WOUTO = 33 * MiB, WS_WUP = 37 * MiB, WS_WDN = 81 * MiB;
constexpr size_t WS_XB = 104 * MiB, WS_R = 232 * MiB;
constexpr size_t WS_PROJ = WS_R, WS_AO = WS_R + 384 * MiB, WS_U = WS_R, WS_G = WS_R + 352 * MiB;
constexpr int LDS_MISC = 150528, LDS_BYTES = 151552;
static_assert(att::L_QS + 8 * 3072 <= LDS_MISC, "LDS map");
constexpr int HALF_ROWS = MTOK / 2;

struct Args {
    const float* x; const float* rel_bias; const float* norm_mix; const float* norm_ffn; const float* norm_final;
    const float* w_in_even; const float* w_out_even; const float* sinks; const float* lam_q1; const float* lam_k1; const float* lam_q2; const float* lam_k2;
    const float* diff_norm; const float* w_in_odd; const float* w_out_odd; const float* ffn_up; const float* ffn_conv; const float* ffn_conv_b; const float* ffn_down;
    float* out; unsigned char* ws;
};

__device__ const unsigned char T5B[128] = {0, 1, 2, 3, 4, 5, 6, 7, 8, 9, 10, 11, 12, 13, 14, 15, 16, 16, 16, 17, 17, 18, 18, 18, 19, 19, 19, 20, 20, 20, 20, 21, 21, 21, 21, 22, 22, 22, 22, 22, 23, 23, 23, 23, 23, 23, 24, 24, 24, 24, 24, 24, 25, 25, 25, 25, 25, 25, 25, 26, 26, 26, 26, 26, 26, 26, 26, 27, 27, 27, 27, 27, 27, 27, 27, 27, 27, 28, 28, 28, 28, 28, 28, 28, 28, 28, 28, 29, 29, 29, 29, 29, 29, 29, 29, 29, 29, 29, 29, 30, 30, 30, 30, 30, 30, 30, 30, 30, 30, 30, 30, 30, 30, 31, 31, 31, 31, 31, 31, 31, 31, 31, 31, 31, 31, 31, 31, 31};

__device__ __forceinline__ float wave_sum(float v) {
#pragma unroll
    for (int o = 1; o < 64; o <<= 1) v += __shfl_xor(v, o);
    return v;
}
__device__ __forceinline__ unsigned f2bf(float f) { unsigned u = __builtin_bit_cast(unsigned, f); return (u + 0x7fffu + ((u >> 16) & 1u)) >> 16; }
__device__ __forceinline__ unsigned pk2(float lo, float hi) { return f2bf(lo) | (f2bf(hi) << 16); }

__device__ __forceinline__ void transpose_item(const float* W, int K, int N, bf16* WT, const float* gk, int a0, int a1, int b0, int b1, float cs, LAS float* scr, int item, int lane) {
    const int nblk = N / 32, kb = item / nblk, nb = item % nblk, k0 = 64 * kb, n0 = 32 * nb;
    const int nn = n0 + (lane & 31);
    const float csc = ((nn >= a0 && nn < a1) || (nn >= b0 && nn < b1)) ? cs : 1.0f;
#pragma unroll 8
    for (int i = 0; i < 32; ++i) { const int kk = 2 * i + (lane >> 5); const float gv = gk ? gk[k0 + kk] : 1.0f; scr[kk * 33 + (lane & 31)] = W[(size_t)(k0 + kk) * N + nn] * (gv * csc); }
    asm volatile("s_waitcnt lgkmcnt(0)" ::: "memory");
    const int c = lane & 7;
#pragma unroll
    for (int j = 0; j < 4; ++j) { const int n = (lane >> 3) + 8 * j; const LAS float* s = scr + (8 * c) * 33 + n;
        v4u o; o.x = pk2(s[0 * 33], s[1 * 33]); o.y = pk2(s[2 * 33], s[3 * 33]); o.z = pk2(s[4 * 33], s[5 * 33]); o.w = pk2(s[6 * 33], s[7 * 33]);
        *(v4u*)(WT + (size_t)(n0 + n) * K + k0 + 8 * c) = o; }
    asm volatile("s_waitcnt lgkmcnt(0)" ::: "memory");
}

#define XB_TMO      128
#define XB_XCNT(j)  (256  + 64 * (j))
#define XB_XSUB(j)  (1280 + 64 * (j))
#define XB_XGEN(j)  (2304 + 64 * (j))
#define XB_TOP      3328
#define XB_TOPGEN   3392
#define XCD_BAR_WORDS 3456
#define XB_SPIN_CAP (1u << 18)

__device__ __forceinline__ unsigned xb_ld(unsigned* p)              { return __hip_atomic_load(p, __ATOMIC_RELAXED, __HIP_MEMORY_SCOPE_AGENT); }
__device__ __forceinline__ unsigned xb_add(unsigned* p, unsigned v) { return __hip_atomic_fetch_add(p, v, __ATOMIC_RELAXED, __HIP_MEMORY_SCOPE_AGENT); }
__device__ __forceinline__ unsigned xb_xcc_id() { return (unsigned)__builtin_amdgcn_s_getreg((3 << 11) | 20) & 0xFu; }
#define XB_SPIN(cond, bar) do { unsigned _sp = 0; while (cond) { __builtin_amdgcn_s_sleep(1); \
    if ((++_sp & 255u) == 0u) { if (xb_ld(&(bar)[XB_TMO])) break; if (_sp > XB_SPIN_CAP) { atomicAdd(&(bar)[XB_TMO], 1u); break; } } } } while (0)

struct XcdBarrier {
    unsigned* bar; unsigned x;
    volatile LAS unsigned* st;
};

__device__ __forceinline__ XcdBarrier xcd_barrier_post(unsigned* bar, volatile LAS unsigned* st) {
    XcdBarrier b; b.bar = bar; b.x = xb_xcc_id(); b.st = st;
    if (threadIdx.x == 0) (void)xb_add(&bar[XB_XCNT(b.x)], 1u);
    return b;
}
__device__ __forceinline__ void xcd_barrier_complete(unsigned* bar, unsigned x, unsigned& nloc, unsigned& nx) {
    const unsigned G = gridDim.x * gridDim.y * gridDim.z;
    unsigned sum, cnt, mine, sp = 0u;
    for (;;) {
        sum = 0u; cnt = 0u; mine = 0u;
#pragma unroll
        for (unsigned j = 0; j < 16; ++j) { const unsigned c = xb_ld(&bar[XB_XCNT(j)]); sum += c; cnt += (c > 0u) ? 1u : 0u; mine = (j == x) ? c : mine; }
        if (sum == G) break;
        __builtin_amdgcn_s_sleep(1);
        if ((++sp & 255u) == 0u) { if (xb_ld(&bar[XB_TMO])) break; if (sp > XB_SPIN_CAP) { atomicAdd(&bar[XB_TMO], 1u); break; } }
    }
    nloc = mine > 0u ? mine : 1u; nx = cnt > 0u ? cnt : 1u;
}

__device__ __forceinline__ void xcd_barrier(const XcdBarrier& b) {
    asm volatile("s_waitcnt vmcnt(0)" ::: "memory");
    __syncthreads();
    if (threadIdx.x == 0) {
        unsigned* bar = b.bar;
        __builtin_amdgcn_s_waitcnt(0);
        unsigned nloc = b.st[0], nx = b.st[1];
        if (nloc == 0u) { xcd_barrier_complete(bar, b.x, nloc, nx); b.st[0] = nloc; b.st[1] = nx; }
        const unsigned old = xb_add(&bar[XB_XSUB(b.x)], 1u);
        const unsigned gen = old / nloc;
        if (old + 1u == (gen + 1u) * nloc) {
            __builtin_amdgcn_fence(__ATOMIC_RELEASE, "agent");
            asm volatile("s_waitcnt vmcnt(0)" ::: "memory");
            const unsigned og = xb_add(&bar[XB_TOP], 1u);
            const unsigned tg = og / nx;
            if (og + 1u == (tg + 1u) * nx) xb_add(&bar[XB_TOPGEN], 1u);
            else XB_SPIN(xb_ld(&bar[XB_TOPGEN]) == tg, bar);
            __builtin_amdgcn_fence(__ATOMIC_ACQUIRE, "agent");
            xb_add(&bar[XB_XGEN(b.x)], 1u);
            asm volatile("s_waitcnt vmcnt(0)" ::: "memory");
        } else {
            XB_SPIN(xb_ld(&bar[XB_XGEN(b.x)]) == gen, bar);
            __builtin_amdgcn_fence(__ATOMIC_ACQUIRE, "agent");
            asm volatile("s_waitcnt vmcnt(0)" ::: "memory");
        }
    }
    __syncthreads();
}

__global__ void __launch_bounds__(NWAVES * 64, 2) mega_fwd(Args a) {
    extern __shared__ __attribute__((aligned(16))) unsigned char lds_raw[];
    cg::grid_group grid = cg::this_grid();
    LAS unsigned char* lds = (LAS unsigned char*)lds_raw;
    const int tid = threadIdx.x, lane = tid & 63, wave = __builtin_amdgcn_readfirstlane(tid >> 6);
    const int G = gridDim.x, bx = blockIdx.x;
    const int gw = bx * NWAVES + wave, NGW = G * NWAVES;
    unsigned char* ws = a.ws;
    float* ssq = (float*)(ws + WS_SSQ);
    bf16* xb = (bf16*)(ws + WS_XB);
    bf16* proj = (bf16*)(ws + WS_PROJ);
    bf16* ao = (bf16*)(ws + WS_AO);
    bf16* ubuf = (bf16*)(ws + WS_U);
    bf16* gbuf = (bf16*)(ws + WS_G);

    if (bx == 0) for (int i = tid; i < XCD_BAR_WORDS; i += NWAVES * 64) ((unsigned*)ws)[i] = 0u;
    if (tid < 2) ((LAS unsigned*)(lds + LDS_MISC))[tid] = 0u;
    {
        LAS float* scr = (LAS float*)(lds + wave * 16384);
        constexpr int I_INE = 16 * (EVEN_IN / 32), I_OUT = 16 * 32, I_INO = 16 * (ODD_IN / 32), I_UP = 16 * (DUP / 32), I_DN = (DFF / 64) * 32;
        constexpr int NITEMS = 2 * I_INE + 2 * I_OUT + 2 * I_INO + 2 * I_OUT + 4 * I_UP + 4 * I_DN;
        for (int it = gw; it < NITEMS; it += NGW) {
            int r = it;
            if (r < 2 * I_INE) { const int e = r / I_INE; r -= e * I_INE;
                transpose_item(a.w_in_even + (size_t)e * DM * EVEN_IN, DM, EVEN_IN, (bf16*)(ws + WS_WINE) + (size_t)e * EVEN_IN * DM, a.norm_mix + (2 * e) * DM, 0, 512, 768, 1280, att::QSCALE, scr, r, lane); continue; }
            r -= 2 * I_INE;
            if (r < 2 * I_OUT) { const int e = r / I_OUT; r -= e * I_OUT;
                transpose_item(a.w_out_even + (size_t)e * DM * DM, DM, DM, (bf16*)(ws + WS_WOUTE) + (size_t)e * DM * DM, nullptr, 0, 0, 0, 0, 1.f, scr, r, lane); continue; }
            r -= 2 * I_OUT;
            if (r < 2 * I_INO) { const int e = r / I_INO; r -= e * I_INO;
                transpose_item(a.w_in_odd + (size_t)e * DM * ODD_IN, DM, ODD_IN, (bf16*)(ws + WS_WINO) + (size_t)e * ODD_IN * DM, a.norm_mix + (2 * e + 1) * DM, 0, 1024, 0, 0, att::QSCALE, scr, r, lane); continue; }
            r -= 2 * I_INO;
            if (r < 2 * I_OUT) { const int e = r / I_OUT; r -= e * I_OUT;
                transpose_item(a.w_out_odd + (size_t)e * DM * DM, DM, DM, (bf16*)(ws + WS_WOUTO) + (size_t)e * DM * DM, nullptr, 0, 0, 0, 0, 1.f, scr, r, lane); continue; }
            r -= 2 * I_OUT;
            if (r < 4 * I_UP) { const int e = r / I_UP; r -= e * I_UP;
                transpose_item(a.ffn_up + (size_t)e * DM * DUP, DM, DUP, (bf16*)(ws + WS_WUP) + (size_t)e * DUP * DM, a.norm_ffn + e * DM, 0, 0, 0, 0, 1.f, scr, r, lane); continue; }
            r -= 4 * I_UP;
            { const int e = r / I_DN; r -= e * I_DN;
                transpose_item(a.ffn_down + (size_t)e * DFF * DM, DFF, DM, (bf16*)(ws + WS_WDN) + (size_t)e * DM * DFF, nullptr, 0, 0, 0, 0, 1.f, scr, r, lane); }
        }
        for (int m0 = 2 * gw; m0 < MTOK; m0 += 2 * NGW) {
            f32x4 v[2][4];
#pragma unroll
            for (int h2 = 0; h2 < 2; ++h2) { const f32x4* xr = (const f32x4*)(a.x + (size_t)(m0 + h2) * DM) + lane;
#pragma unroll
                for (int j = 0; j < 4; ++j) v[h2][j] = __builtin_nontemporal_load(xr + 64 * j); }
#pragma unroll
            for (int h2 = 0; h2 < 2; ++h2) { const int m = m0 + h2; float s = 0.f;
#pragma unroll
                for (int j = 0; j < 4; ++j) s += (v[h2][j][0] * v[h2][j][0] + v[h2][j][1] * v[h2][j][1]) + (v[h2][j][2] * v[h2][j][2] + v[h2][j][3] * v[h2][j][3]);
                s = wave_sum(s);
                v2u* o8 = (v2u*)(xb + (size_t)m * DM) + lane;
#pragma unroll
                for (int j = 0; j < 4; ++j) { v2u w; w.x = pk2(v[h2][j][0], v[h2][j][1]); w.y = pk2(v[h2][j][2], v[h2][j][3]); o8[64 * j] = w; }
                if (lane < 16) ssq[(size_t)m * 16 + lane] = (lane == 0) ? s : 0.f; }
        }
    }
    grid.sync();
    const XcdBarrier xbar = xcd_barrier_post((unsigned*)ws, (volatile LAS unsigned*)(lds + LDS_MISC));

    for (int layer = 0; layer < 4; ++layer) {
        const int e = layer >> 1; const bool even = (layer & 1) == 0;
        const float* xold = (layer == 0) ? a.x : a.out;
        {
            const int N = even ? EVEN_IN : ODD_IN;
            const bf16* wt = even ? (const bf16*)(ws + WS_WINE) + (size_t)e * EVEN_IN * DM : (const bf16*)(ws + WS_WINO) + (size_t)e * ODD_IN * DM;
            pg8::Gemm g{xb, wt, MTOK, N, DM}; pg8::StaticOrder S; S.init(MTOK, N, G, bx);
            pg8::EpiScaleBf16 E{proj, N, ssq};
            for (int rep_ = 0; rep_ < REP_INPROJ; ++rep_)
            pg8::gemm_phase<pg8::EpiScaleBf16, pg8::StaticOrder, true, true>(lds, g, S, E);
        }
        xcd_barrier(xbar);
        if (even) {
            int tq = threadIdx.x; asm volatile("" : "+v"(tq)); const int tid = tq, lane = tq & 63, l32 = lane & 31, hi = lane >> 5;
            float lam, one_m_li;
            { const float li = (layer == 0) ? 0.2f : 0.47071301839f;
              const float s1 = wave_sum(a.lam_q1[e * 64 + lane] * a.lam_k1[e * 64 + lane]), s2 = wave_sum(a.lam_q2[e * 64 + lane] * a.lam_k2[e * 64 + lane]);
              lam = __expf(s1) - __expf(s2) + li; lam = __builtin_bit_cast(float, __builtin_amdgcn_readfirstlane(__builtin_bit_cast(int, lam))); one_m_li = __builtin_bit_cast(float, __builtin_amdgcn_readfirstlane(__builtin_bit_cast(int, 1.0f - li))); }
            LAS float* btab = (LAS float*)(lds + att::L_BT);

#if PH_DIFF
            for (int rep_ = 0; rep_ < REP_DIFF; ++rep_)
            for (int uidx = bx; uidx < 1024; uidx += G) {
                const int j = uidx >> 8, c = uidx & 255, bh = c >> 2, s = c & 3, b = bh >> 2, h = bh & 3;
                const int qb = (j == 0) ? s : (j == 1) ? 7 - s : (j == 2) ? 8 + s : 15 - s;
                { int tb = threadIdx.x; asm volatile("" : "+v"(tb)); if (tb < 128) btab[tb] = a.rel_bias[T5B[tb] * 12 + 8 + h] * att::LOG2E; }
                const bf16* base = proj + (size_t)b * SEQ * EVEN_IN;
                const int q0 = qb * 256, nt = 4 * qb + 4, t = q0 + 32 * wave + l32;
                att::f32x16 o2[4]; float m2, l2; LAS unsigned* o1s = (LAS unsigned*)(lds + att::L_O1 + wave * 8192) + lane;
                { float m1, l1;
                  att::attn_core_pp<1, 128>(base + 768 + h * 128, base + 1280 + h * 128, base + 1792 + h * 128, EVEN_IN, q0, 0, nt, lds, o2, m1, l1);
                  const float inv = __builtin_amdgcn_rcpf(l1 + __shfl_xor(l1, 32));
#pragma unroll
                  for (int db = 0; db < 4; ++db)
#pragma unroll
                      for (int k = 0; k < 8; ++k) o1s[(db * 8 + k) * 64] = att::cvtpk(o2[db][2 * k] * inv, o2[db][2 * k + 1] * inv); }
                att::attn_core_pp<1, 128>(base + 768 + h * 128 + 64, base + 1280 + h * 128 + 64, base + 1792 + h * 128, EVEN_IN, q0, 0, nt, lds, o2, m2, l2);
                { const float inv = lam * __builtin_amdgcn_rcpf(l2 + __shfl_xor(l2, 32)); float ss = 0.f;
#pragma unroll
                  for (int db = 0; db < 4; ++db)
#pragma unroll
                      for (int r = 0; r < 16; ++r) { const unsigned w = o1s[(db * 8 + (r >> 1)) * 64]; const float a1 = __uint_as_float((r & 1) ? (w & 0xffff0000u) : (w << 16));
                          const float v = a1 - inv * o2[db][r]; o2[db][r] = v; ss += v * v; }
                  ss += __shfl_xor(ss, 32);
                  const float rs = __builtin_amdgcn_rsqf(ss * (1.0f / 128.0f) + 1e-6f) * one_m_li;
                  const float* gn = a.diff_norm + e * 128;
#pragma unroll
                  for (int db = 0; db < 4; ++db)
#pragma unroll
                      for (int rg = 0; rg < 4; ++rg) { const f32x4 gv = *(const f32x4*)(gn + 32 * db + 8 * rg + 4 * hi);
#pragma unroll
                          for (int k = 0; k < 4; ++k) o2[db][4 * rg + k] *= rs * gv[k]; } }
                { int tb = threadIdx.x; asm volatile("" : "+v"(tb)); const int t2 = q0 + 32 * (tb >> 6) + (tb & 31);
                  att::store_ot<128>(o2, ao + ((size_t)b * SEQ + t2) * DM + 512 + h * 128, (tb >> 5) & 1); }
            }
#endif
#if PH_SWA
            for (int rep_ = 0; rep_ < REP_SWA; ++rep_)
            for (int uidx = bx; uidx < 2048; uidx += G) {
                const int qb = uidx & 15, qh = (uidx >> 4) & 7, b = uidx >> 7, kvh = qh >> 2;
                { int tb = threadIdx.x; asm volatile("" : "+v"(tb)); if (tb < 128) btab[tb] = a.rel_bias[T5B[tb] * 12 + qh] * att::LOG2E; }
                const bf16* base = proj + (size_t)b * SEQ * EVEN_IN;
                const int q0 = qb * 256, t = q0 + 32 * wave + l32;
                const int kt0 = (qb * 4 - 2 > 0) ? qb * 4 - 2 : 0, nt = qb * 4 + 4 - kt0;
                att::f32x16 o[2]; float m, l;
                att::attn_core_pp<2, 64>(base + qh * 64, base + 512 + kvh * 64, base + 640 + kvh * 64, EVEN_IN, q0, kt0, nt, lds, o, m, l);
                const float sk = a.sinks[e * 8 + qh] * att::LOG2E;
                const float inv = __builtin_amdgcn_rcpf(l + __shfl_xor(l, 32) + __builtin_amdgcn_exp2f(sk - m));
#pragma unroll
                for (int db = 0; db < 2; ++db)
#pragma unroll
                    for (int r = 0; r < 16; ++r) o[db][r] *= inv;
                att::store_ot<64>(o, ao + ((size_t)b * SEQ + t) * DM + qh * 64, hi);
            }
#endif
        } else {
#if PH_SB
            int tq = threadIdx.x; asm volatile("" : "+v"(tq)); const int lane = tq & 63, l32 = lane & 31, hi = lane >> 5;
            for (int rep_ = 0; rep_ < REP_SB; ++rep_)
            for (int uidx = bx; uidx < 4096; uidx += G) {
                const int bh = uidx & 255, qb = 15 - (uidx >> 8), b = bh >> 4, h = bh & 15;
                const bf16* base = proj + (size_t)b * SEQ * ODD_IN;
                const int q0 = qb * 256, nt = 4 * qb + 4, t = q0 + 32 * wave + l32;
                att::f32x16 o[2]; float P, dummy;
                att::attn_core<0, 64>(base + h * 64, base + 1024 + h * 64, base + 2048 + h * 64, ODD_IN, q0, nt - 1, nt, -1, lds, o, P, dummy);
                att::store_ot<64>(o, ao + ((size_t)b * SEQ + t) * DM + h * 64, hi);
            }
#endif
        }
        xcd_barrier(xbar);
        {
            const bf16* wt = even ? (const bf16*)(ws + WS_WOUTE) + (size_t)e * DM * DM : (const bf16*)(ws + WS_WOUTO) + (size_t)e * DM * DM;
            pg8::Gemm g{ao, wt, MTOK, DM, DM}; pg8::StaticOrder S; S.init(MTOK, DM, G, bx);
#if OUT_STAGGER_TICKS > 0
            { const unsigned long long t0 = __builtin_amdgcn_s_memrealtime(); const unsigned long long dly = (unsigned long long)(((bx >> 3) & (OUT_STAGGER_GROUPS - 1)) * OUT_STAGGER_TICKS);
              while (__builtin_amdgcn_s_memrealtime() - t0 < dly) __builtin_amdgcn_s_sleep(8); }
#endif
#if REP_OUT == 2
            { pg8::EpiResid Ed{xold, (float*)(ws + WS_PROJ), (bf16*)(ws + WS_PROJ + 256 * MiB), (float*)(ws + 800 * MiB)};
              pg8::gemm_phase<pg8::EpiResid, pg8::StaticOrder, true, true>(lds, g, S, Ed); }
#elif REP_OUT == 3
            { pg8::EpiScaleBf16 Ed{(bf16*)(ws + WS_PROJ), DM, ssq};
              pg8::gemm_phase<pg8::EpiScaleBf16, pg8::StaticOrder, true, true>(lds, g, S, Ed); }
#endif
#if RESID_BF16
            pg8::EpiResidB E{xb, xb, ssq};
            pg8::gemm_phase<pg8::EpiResidB, pg8::StaticOrder, true, true>(lds, g, S, E);
#else
            pg8::EpiResid E{xold, a.out, xb, ssq};
            pg8::gemm_phase<pg8::EpiResid, pg8::StaticOrder, true, true>(lds, g, S, E);
#endif
        }
        xcd_barrier(xbar);
        const bf16* wup = (const bf16*)(ws + WS_WUP) + (size_t)layer * DUP * DM;
        const bf16* wdn = (const bf16*)(ws + WS_WDN) + (size_t)layer * DM * DFF;
        for (int half = 0; half < 2; ++half) {
            const size_t r0 = (size_t)half * HALF_ROWS;
            {
                pg8::Gemm g{xb + r0 * DM, wup, HALF_ROWS, DUP, DM}; pg8::StaticOrder S; S.init(HALF_ROWS, DUP, G, bx);
                pg8::EpiScaleBf16 E{ubuf, DUP, ssq + r0 * 16};
                for (int rep_ = 0; rep_ < REP_UP; ++rep_)
                pg8::gemm_phase<pg8::EpiScaleBf16, pg8::StaticOrder, true, true>(lds, g, S, E);
            }
            xcd_barrier(xbar);
#if PH_CONV
            {
                const float* cw = a.ffn_conv + (size_t)layer * 3 * DUP; const float* cb = a.ffn_conv_b + (size_t)layer * DUP;
                constexpr int NCC = 6, NRC = HALF_ROWS / 32;
                int tq = threadIdx.x; asm volatile("" : "+v"(tq)); const int lane = tq & 63;
                for (int rep_ = 0; rep_ < REP_CONV; ++rep_)
                for (int it = gw; it < NCC * NRC; it += NGW) {
                    const int cc = it % NCC, rc = it / NCC, cgp = cc * 64 + lane;
                    if (cgp < DFF / 8) {
                        const int col = cgp * 8, row0 = rc * 32;
                        float wg[3][8], wv[3][8], bg[8], bv[8];
#pragma unroll
                        for (int tp = 0; tp < 3; ++tp)
#pragma unroll
                            for (int k = 0; k < 8; k += 4) { const f32x4 t1 = *(const f32x4*)(cw + tp * DUP + col + k), t2 = *(const f32x4*)(cw + tp * DUP + DFF + col + k);
#pragma unroll
                                for (int q = 0; q < 4; ++q) { wg[tp][k + q] = t1[q]; wv[tp][k + q] = t2[q]; } }
#pragma unroll
                        for (int k = 0; k < 8; k += 4) { const f32x4 t1 = *(const f32x4*)(cb + col + k), t2 = *(const f32x4*)(cb + DFF + col + k);
#pragma unroll
                            for (int q = 0; q < 4; ++q) { bg[k + q] = t1[q]; bv[k + q] = t2[q]; } }
                        float g2[8], g1[8], v2[8], v1[8];
                        const bool head = (row0 % SEQ) == 0;
                        {
                            v4u a2 = {0, 0, 0, 0}, a1 = {0, 0, 0, 0}, c2 = {0, 0, 0, 0}, c1 = {0, 0, 0, 0};
                            if (!head) { const bf16* up = ubuf + (size_t)(row0 - 2) * DUP + col; a2 = *(const v4u*)up; c2 = *(const v4u*)(up + DFF); a1 = *(const v4u*)(up + DUP); c1 = *(const v4u*)(up + DUP + DFF); }
#pragma unroll
                            for (int k = 0; k < 8; ++k) { const int sh = (k & 1) * 16;
                                g2[k] = __uint_as_float(((a2[k >> 1] >> sh) & 0xffffu) << 16); g1[k] = __uint_as_float(((a1[k >> 1] >> sh) & 0xffffu) << 16);
                                v2[k] = __uint_as_float(((c2[k >> 1] >> sh) & 0xffffu) << 16); v1[k] = __uint_as_float(((c1[k >> 1] >> sh) & 0xffffu) << 16); }
                        }
                        for (int r4 = 0; r4 < 32; r4 += 8) {
                            v4u av[8], cv[8];
#pragma unroll
                            for (int rr = 0; rr < 8; ++rr) { const bf16* up = ubuf + (size_t)(row0 + r4 + rr) * DUP + col;
                                av[rr] = __builtin_nontemporal_load((const v4u*)up); cv[rr] = __builtin_nontemporal_load((const v4u*)(up + DFF)); }
#pragma unroll
                            for (int rr = 0; rr < 8; ++rr) {
                                const v4u a0 = av[rr], c0 = cv[rr];
                                float res[8];
#pragma unroll
                                for (int k = 0; k < 8; ++k) { const int sh = (k & 1) * 16;
                                    const float g0 = __uint_as_float(((a0[k >> 1] >> sh) & 0xffffu) << 16), v0 = __uint_as_float(((c0[k >> 1] >> sh) & 0xffffu) << 16);
                                    const float gg = bg[k] + wg[0][k] * g2[k] + wg[1][k] * g1[k] + wg[2][k] * g0;
                                    const float vv = bv[k] + wv[0][k] * v2[k] + wv[1][k] * v1[k] + wv[2][k] * v0;
                                    const float sg = gg * __builtin_amdgcn_rcpf(1.0f + __builtin_amdgcn_exp2f(-gg * att::LOG2E));
                                    res[k] = sg * vv; g2[k] = g1[k]; g1[k] = g0; v2[k] = v1[k]; v1[k] = v0; }
                                v4u w; w.x = pk2(res[0], res[1]); w.y = pk2(res[2], res[3]); w.z = pk2(res[4], res[5]); w.w = pk2(res[6], res[7]);
                                *(v4u*)(gbuf + (size_t)(row0 + r4 + rr) * DFF + col) = w;
                            }
                        }
                    }
                }
            }
#endif
            xcd_barrier(xbar);
            {
                pg8::Gemm g{gbuf, wdn, HALF_ROWS, DM, DFF}; pg8::StaticOrder S; S.init(HALF_ROWS, DM, G, bx);
#if REP_DOWN > 1
                { pg8::EpiResid Ed{a.out + r0 * DM, (float*)(ws + 760 * MiB), (bf16*)(ws + 888 * MiB), (float*)(ws + 960 * MiB)};
                  pg8::gemm_phase<pg8::EpiResid, pg8::StaticOrder, true, true>(lds, g, S, Ed); }
#endif
#if RESID_BF16
                pg8::EpiResidB E{xb + r0 * DM, xb + r0 * DM, ssq + r0 * 16};
                pg8::gemm_phase<pg8::EpiResidB, pg8::StaticOrder, true, true>(lds, g, S, E);
#else
                pg8::EpiResid E{a.out + r0 * DM, a.out + r0 * DM, xb + r0 * DM, ssq + r0 * 16};
                pg8::gemm_phase<pg8::EpiResid, pg8::StaticOrder, true, true>(lds, g, S, E);
#endif
            }
            if (half == 1) xcd_barrier(xbar);
        }
    }
    { int tq = threadIdx.x; asm volatile("" : "+v"(tq)); const int lane = tq & 63;
    for (int m = gw; m < MTOK; m += NGW) {
        f32x4* xr = (f32x4*)(a.out + (size_t)m * DM) + lane; f32x4 v[4]; float s = 0.f;
#if RESID_BF16
        const v2u* xin = (const v2u*)(xb + (size_t)m * DM) + lane;
#pragma unroll
        for (int j = 0; j < 4; ++j) { const v2u w = xin[64 * j]; v[j][0] = __uint_as_float(w.x << 16); v[j][1] = __uint_as_float(w.x & 0xffff0000u); v[j][2] = __uint_as_float(w.y << 16); v[j][3] = __uint_as_float(w.y & 0xffff0000u);
            s += (v[j][0] * v[j][0] + v[j][1] * v[j][1]) + (v[j][2] * v[j][2] + v[j][3] * v[j][3]); }
#else
#pragma unroll
        for (int j = 0; j < 4; ++j) { v[j] = xr[64 * j]; s += (v[j][0] * v[j][0] + v[j][1] * v[j][1]) + (v[j][2] * v[j][2] + v[j][3] * v[j][3]); }
#endif
        s = wave_sum(s);
        const float rs = __builtin_amdgcn_rsqf(s * (1.0f / DM) + 1e-6f);
#pragma unroll
        for (int j = 0; j < 4; ++j) { const f32x4 gv = *((const f32x4*)a.norm_final + lane + 64 * j); xr[64 * j] = v[j] * rs * gv; }
    } }
}

extern "C" void kernel_launch(void* const* d_in, const int* in_sizes, int n_in, void* d_out, int out_size, void* d_ws, size_t ws_size, hipStream_t stream) {
    static int grid = 0;
    if (grid == 0) {
        int dev = 0, cus = 0, per_cu = 0;
        (void)hipGetDevice(&dev);
        (void)hipDeviceGetAttribute(&cus, hipDeviceAttributeMultiprocessorCount, dev);
        (void)hipFuncSetAttribute((const void*)mega_fwd, hipFuncAttributeMaxDynamicSharedMemorySize, LDS_BYTES);
        (void)hipOccupancyMaxActiveBlocksPerMultiprocessor(&per_cu, (const void*)mega_fwd, NWAVES * 64, LDS_BYTES);
        if (per_cu < 1) per_cu = 1;
        grid = cus * per_cu;
        if (n_in != 19 || ws_size < 1024 * MiB) fprintf(stderr, "kernel_launch: unexpected n_in %d / ws %zu\n", n_in, ws_size);
    }
    Args a{};
    a.x = (const float*)d_in[0]; a.rel_bias = (const float*)d_in[1]; a.norm_mix = (const float*)d_in[2]; a.norm_ffn = (const float*)d_in[3]; a.norm_final = (const float*)d_in[4];
    a.w_in_even = (const float*)d_in[5]; a.w_out_even = (const float*)d_in[6]; a.sinks = (const float*)d_in[7]; a.lam_q1 = (const float*)d_in[8]; a.lam_k1 = (const float*)d_in[9];
    a.lam_q2 = (const float*)d_in[10]; a.lam_k2 = (const float*)d_in[11]; a.diff_norm = (const float*)d_in[12]; a.w_in_odd = (const float*)d_in[13]; a.w_out_odd = (const float*)d_in[14];
    a.ffn_up = (const float*)d_in[15]; a.ffn_conv = (const float*)d_in[16]; a.ffn_conv_b = (const float*)d_in[17]; a.ffn_down = (const float*)d_in[18];
    a.out = (float*)d_out; a.ws = (unsigned char*)d_ws;
    void* args[] = {&a};
    hipError_t err = hipLaunchCooperativeKernel((const void*)mega_fwd, dim3(grid), dim3(NWAVES * 64), args, LDS_BYTES, stream);
    if (err != hipSuccess) fprintf(stderr, "kernel_launch: cooperative launch failed: %s (grid %d)\n", hipGetErrorString(err), grid);
}
```

```cpp
#include <hip/hip_runtime.h>
#include <hip/hip_cooperative_groups.h>
#include <cstdio>
#include <cstdint>
namespace cg = cooperative_groups;
namespace pg8 {
#define PG8_LAS __attribute__((address_space(3)))
typedef unsigned short bf16_t;
typedef short bf16x8 __attribute__((ext_vector_type(8)));
typedef float f32x4 __attribute__((ext_vector_type(4)));
typedef unsigned u32x4 __attribute__((ext_vector_type(4)));
constexpr int BM = 256, BK = 64, HALF = 128, HTB = HALF * BK * 2  , STAGE_BYTES = 8 * HTB, NXCD = 8, WGM = 8;

__host__ __device__ __forceinline__ int lds_byte(int r, int c) { const int st = (r >> 4) * 2 + (c >> 5), rr = r & 15, cc = c & 31, ob = rr * 64 + cc * 2; return st * 1024 + (ob ^ (((ob >> 9) & 1) << 5)); }
__host__ __device__ __forceinline__ void stage_rc(int b, int& R, int& C) { const int st = b / 1024, sb = b % 1024, swz = sb ^ (((sb >> 9) & 1) << 5); R = (st >> 1) * 16 + swz / 64; C = (st & 1) * 32 + (swz % 64) / 2; }
__host__ __device__ __forceinline__ int perm32(int rho) { const int n = rho >> 4, i = rho & 15; return 8 * (i >> 2) + 4 * n + (i & 3); }

struct Unit { int pm, pn; };
struct Gemm { const bf16_t* A; const bf16_t* Bt; int M, N, K; };

struct StaticOrder {
    int nM, nN, nwg, G, c;
    __host__ __device__ void init(int M, int N, int G_, int c_) { nM = M / BM; nN = N / BM; nwg = nM * nN; G = G_; c = c_; }
    __host__ __device__ bool next(int i, Unit& u) const {
        const long L = (long)i * G + c; if (L >= nwg) return false;
        int wgid = (int)L; { const int q = nwg / NXCD, r = nwg % NXCD, xcd = wgid % NXCD, off = wgid / NXCD; wgid = (xcd < r ? xcd * (q + 1) : r * (q + 1) + (xcd - r) * q) + off; }
        const int nig = WGM * nN, gid = wgid / nig, fm = gid * WGM, gsz = (nM - fm) < WGM ? (nM - fm) : WGM;
        u.pm = fm + ((wgid % nig) % gsz); u.pn = (wgid % nig) / gsz; return true;
    }
    __device__ __forceinline__ void a_ready(const Unit&) const {}
    __device__ __forceinline__ void done(const Unit&) const {}
};

__device__ __forceinline__ unsigned cvt_pk_bf16(float lo, float hi) { unsigned r; asm volatile("v_cvt_pk_bf16_f32 %0, %1, %2" : "=v"(r) : "v"(lo), "v"(hi)); return r; }
typedef float f32x2 __attribute__((ext_vector_type(2)));
typedef unsigned u32x2 __attribute__((ext_vector_type(2)));
constexpr float RMS_EPS = 1e-6f;
struct EpiScaleBf16 {
    static constexpr bool PERM = true, AFTER_DRAIN = false;
    bf16_t* O; int ldc; const float* ssq;
    __device__ __forceinline__ void operator()(const f32x4 (&acc)[2][2][4][2], const Unit& u, int wr, int wc, int fr, int fq) const {
        const int row0 = u.pm * BM + wr * 64 + fr, col0 = u.pn * BM + wc * 32 + 8 * fq;
        f32x4 part[2][4];
#pragma unroll
        for (int ai = 0; ai < 2; ++ai)
#pragma unroll
            for (int m = 0; m < 4; ++m) part[ai][m] = *(const f32x4*)(ssq + (size_t)(row0 + ai * HALF + m * 16) * 16 + fq * 4);
#pragma unroll
        for (int ai = 0; ai < 2; ++ai)
#pragma unroll
            for (int m = 0; m < 4; ++m) { const int row = row0 + ai * HALF + m * 16; bf16_t* rowp = O + (size_t)row * ldc + col0;
                float t = (part[ai][m][0] + part[ai][m][1]) + (part[ai][m][2] + part[ai][m][3]);
                t += __shfl_xor(t, 16); t += __shfl_xor(t, 32);
                const float rs = __builtin_amdgcn_rsqf(t * (1.0f / 1024.0f) + RMS_EPS);
#pragma unroll
                for (int bj = 0; bj < 2; ++bj) { const f32x4 v0 = acc[ai][bj][m][0] * rs, v1 = acc[ai][bj][m][1] * rs;
                    u32x4 w; w.x = cvt_pk_bf16(v0[0], v0[1]); w.y = cvt_pk_bf16(v0[2], v0[3]); w.z = cvt_pk_bf16(v1[0], v1[1]); w.w = cvt_pk_bf16(v1[2], v1[3]);
                    *(u32x4*)(rowp + bj * HALF) = w; } }
    }
};
struct EpiResid {
    static constexpr bool PERM = true, AFTER_DRAIN = false;
    const float* base; float* out; bf16_t* xb; float* ssq;
    __device__ __forceinline__ void operator()(const f32x4 (&acc)[2][2][4][2], const Unit& u, int wr, int wc, int fr, int fq) const {
        const int col0 = u.pn * BM + wc * 32 + 8 * fq;
        const size_t off0 = (size_t)(u.pm * BM + wr * 64 + fr) * 1024 + col0;
        f32x4 nx[2][2][2];
#pragma unroll
        for (int g = 0; g < 2; ++g) { const size_t offn = off0 + (size_t)(g * 16) * 1024;
#pragma unroll
            for (int bj = 0; bj < 2; ++bj)
#pragma unroll
                for (int n = 0; n < 2; ++n) nx[g][bj][n] = *(const f32x4*)(base + offn + bj * HALF + n * 4); }
        asm volatile("" ::: "memory");
#pragma unroll
        for (int g = 0; g < 8; ++g) { const int ai = g >> 2, m = g & 3; const int row = u.pm * BM + ai * HALF + wr * 64 + m * 16 + fr; const size_t off = (size_t)row * 1024 + col0; float q = 0.f;
            f32x4 cu[2][2];
#pragma unroll
            for (int bj = 0; bj < 2; ++bj)
#pragma unroll
                for (int n = 0; n < 2; ++n) cu[bj][n] = nx[g & 1][bj][n];
            if (g < 6) { const size_t offn = off0 + (size_t)(((g + 2) >> 2) * HALF + ((g + 2) & 3) * 16) * 1024;
#pragma unroll
                for (int bj = 0; bj < 2; ++bj)
#pragma unroll
                    for (int n = 0; n < 2; ++n) nx[g & 1][bj][n] = *(const f32x4*)(base + offn + bj * HALF + n * 4); }
#pragma unroll
            for (int bj = 0; bj < 2; ++bj) { const f32x4 o0 = cu[bj][0] + acc[ai][bj][m][0], o1 = cu[bj][1] + acc[ai][bj][m][1];
                *(f32x4*)(out + off + bj * HALF) = o0; *(f32x4*)(out + off + bj * HALF + 4) = o1;
                q += ((o0[0] * o0[0] + o0[1] * o0[1]) + (o0[2] * o0[2] + o0[3] * o0[3])) + ((o1[0] * o1[0] + o1[1] * o1[1]) + (o1[2] * o1[2] + o1[3] * o1[3]));
                u32x4 w; w.x = cvt_pk_bf16(o0[0], o0[1]); w.y = cvt_pk_bf16(o0[2], o0[3]); w.z = cvt_pk_bf16(o1[0], o1[1]); w.w = cvt_pk_bf16(o1[2], o1[3]);
                *(u32x4*)(xb + off + bj * HALF) = w; }
            q += __shfl_xor(q, 16); q += __shfl_xor(q, 32);
            if (fq == 0) ssq[(size_t)row * 16 + u.pn * 4 + wc] = q;
            asm volatile("" ::: "memory"); }
    }
};

struct EpiResidB {
    static constexpr bool PERM = true, AFTER_DRAIN = false;
    const bf16_t* base; bf16_t* xb; float* ssq;
    __device__ __forceinline__ void operator()(const f32x4 (&acc)[2][2][4][2], const Unit& u, int wr, int wc, int fr, int fq) const {
        const int col0 = u.pn * BM + wc * 32 + 8 * fq;
        const size_t off0 = (size_t)(u.pm * BM + wr * 64 + fr) * 1024 + col0;
        u32x4 nx[2][2];
#pragma unroll
        for (int g = 0; g < 2; ++g)
#pragma unroll
            for (int bj = 0; bj < 2; ++bj) nx[g][bj] = *(const u32x4*)(base + off0 + (size_t)(g * 16) * 1024 + bj * HALF);
        asm volatile("" ::: "memory");
#pragma unroll
        for (int g = 0; g < 8; ++g) { const int ai = g >> 2, m = g & 3; const int row = u.pm * BM + ai * HALF + wr * 64 + m * 16 + fr; const size_t off = (size_t)row * 1024 + col0; float q = 0.f;
            u32x4 cu[2];
#pragma unroll
            for (int bj = 0; bj < 2; ++bj) cu[bj] = nx[g & 1][bj];
            if (g < 6) { const size_t offn = off0 + (size_t)(((g + 2) >> 2) * HALF + ((g + 2) & 3) * 16) * 1024;
#pragma unroll
                for (int bj = 0; bj < 2; ++bj) nx[g & 1][bj] = *(const u32x4*)(base + offn + bj * HALF); }
#pragma unroll
            for (int bj = 0; bj < 2; ++bj) {
                f32x4 o0, o1;
                o0[0] = __uint_as_float(cu[bj].x << 16) + acc[ai][bj][m][0][0]; o0[1] = __uint_as_float(cu[bj].x & 0xffff0000u) + acc[ai][bj][m][0][1];
                o0[2] = __uint_as_float(cu[bj].y << 16) + acc[ai][bj][m][0][2]; o0[3] = __uint_as_float(cu[bj].y & 0xffff0000u) + acc[ai][bj][m][0][3];
                o1[0] = __uint_as_float(cu[bj].z << 16) + acc[ai][bj][m][1][0]; o1[1] = __uint_as_float(cu[bj].z & 0xffff0000u) + acc[ai][bj][m][1][1];
                o1[2] = __uint_as_float(cu[bj].w << 16) + acc[ai][bj][m][1][2]; o1[3] = __uint_as_float(cu[bj].w & 0xffff0000u) + acc[ai][bj][m][1][3];
                q += ((o0[0] * o0[0] + o0[1] * o0[1]) + (o0[2] * o0[2] + o0[3] * o0[3])) + ((o1[0] * o1[0] + o1[1] * o1[1]) + (o1[2] * o1[2] + o1[3] * o1[3]));
                u32x4 w; w.x = cvt_pk_bf16(o0[0], o0[1]); w.y = cvt_pk_bf16(o0[2], o0[3]); w.z = cvt_pk_bf16(o1[0], o1[1]); w.w = cvt_pk_bf16(o1[2], o1[3]);
                *(u32x4*)(xb + off + bj * HALF) = w; }
            q += __shfl_xor(q, 16); q += __shfl_xor(q, 32);
            if (fq == 0) ssq[(size_t)row * 16 + u.pn * 4 + wc] = q;
            asm volatile("" ::: "memory"); }
    }
};
template <class Epi, class Sched, bool ALIGN_EPI = false, bool SP2 = false>
__device__ __forceinline__ void gemm_phase(PG8_LAS unsigned char* lds, const Gemm g, const Sched& S, const Epi& E) {
    int tid_ = threadIdx.x; asm volatile("" : "+v"(tid_));
    const int tid = tid_, wid = __builtin_amdgcn_readfirstlane(tid >> 6), lane = tid & 63, wr = wid >> 2, wc = wid & 3, fr = lane & 15, fq = lane >> 4;
    const int K = g.K, nt = K / BK;
    unsigned voffA[2], voffB[2];
#pragma unroll
    for (int i = 0; i < 2; ++i) { int R, C; stage_rc(tid * 16 + i * 8192, R, C); const int Rb = Epi::PERM ? ((R & ~31) + perm32(R & 31)) : R;
        voffA[i] = (unsigned)(R * K + C) * 2u; voffB[i] = (unsigned)(Rb * K + C) * 2u; }
    const size_t kstep = (size_t)(BK * 2);
    const size_t hstep = (size_t)HALF * K * 2;
    const size_t tstep = 2 * hstep;
    const unsigned ldsw = (unsigned)wid * 1024u;
    const int aoff = lds_byte(wr * 64 + fr, fq * 8), boff = lds_byte(wc * 32 + fr, fq * 8);
#define PG8_SA(b, h) (((b) * 2 + (h)) * HTB)
#define PG8_SB(b, h) ((4 + (b) * 2 + (h)) * HTB)
#define PG8_STAGE(bufoff, gbase, voff) do { _Pragma("unroll") for (int _i = 0; _i < 2; ++_i) \
        __builtin_amdgcn_global_load_lds((const unsigned*)((const char*)(gbase) + (voff)[_i]), (PG8_LAS unsigned*)(lds + (bufoff) + ldsw + _i * 8192), 16, 0, 0); } while (0)
#define PG8_LDA(dst, b, h) do { _Pragma("unroll") for (int m = 0; m < 4; ++m) _Pragma("unroll") for (int k = 0; k < 2; ++k) dst[m][k] = *(const PG8_LAS bf16x8*)(lds + PG8_SA(b, h) + aoff + m * 2048 + k * 1024); } while (0)
#define PG8_LDB(dst, b, h) do { _Pragma("unroll") for (int n = 0; n < 2; ++n) _Pragma("unroll") for (int k = 0; k < 2; ++k) dst[n][k] = *(const PG8_LAS bf16x8*)(lds + PG8_SB(b, h) + boff + n * 2048 + k * 1024); } while (0)
#define PG8_MMA(ai, bj, At, Bt) do { __builtin_amdgcn_s_setprio(1); _Pragma("unroll") for (int m = 0; m < 4; ++m) _Pragma("unroll") for (int n = 0; n < 2; ++n) _Pragma("unroll") for (int k = 0; k < 2; ++k) \
        acc[ai][bj][m][n] = __builtin_amdgcn_mfma_f32_16x16x32_bf16(Bt[n][k], At[m][k], acc[ai][bj][m][n], 0, 0, 0); __builtin_amdgcn_s_setprio(0); } while (0)
#define PG8_WAIT_V(n) asm volatile("s_waitcnt vmcnt(" #n ")" ::: "memory")
#define PG8_WAIT_L(n) asm volatile("s_waitcnt lgkmcnt(" #n ")" ::: "memory")
#define PG8_BAR __builtin_amdgcn_s_barrier()
#define PG8_SCHED __builtin_amdgcn_sched_barrier(0)
    Unit cur, nxt; int ui = 0;
    if (!S.next(0, cur)) return;
    f32x4 acc[2][2][4][2];
#pragma unroll
    for (int a = 0; a < 2; ++a)
#pragma unroll
        for (int b = 0; b < 2; ++b)
#pragma unroll
            for (int m = 0; m < 4; ++m)
#pragma unroll
                for (int n = 0; n < 2; ++n) acc[a][b][m][n] = (f32x4){0.f, 0.f, 0.f, 0.f};
    bf16x8 At[4][2], B0[2][2], B1[2][2];
    const char* cA = (const char*)g.A + (size_t)cur.pm * tstep; const char* cB = (const char*)g.Bt + (size_t)cur.pn * tstep;
    S.a_ready(cur);
    if constexpr (SP2) {
        PG8_STAGE(PG8_SB(0, 0), cB, voffB); PG8_STAGE(PG8_SB(0, 1), cB + hstep, voffB); PG8_STAGE(PG8_SA(0, 0), cA, voffA); PG8_STAGE(PG8_SA(0, 1), cA + hstep, voffA);
        if (wr == 1) PG8_BAR;
        PG8_WAIT_V(2); PG8_BAR;
        PG8_STAGE(PG8_SB(1, 0), cB + kstep, voffB); PG8_STAGE(PG8_SA(1, 0), cA + kstep, voffA); PG8_STAGE(PG8_SB(1, 1), cB + hstep + kstep, voffB);
        PG8_WAIT_V(6); PG8_BAR;
    } else {
        PG8_STAGE(PG8_SB(0, 0), cB, voffB); PG8_STAGE(PG8_SA(0, 0), cA, voffA); PG8_STAGE(PG8_SB(0, 1), cB + hstep, voffB); PG8_STAGE(PG8_SA(0, 1), cA + hstep, voffA);
        if (wr == 1) PG8_BAR;
        PG8_WAIT_V(4); PG8_BAR;
        PG8_STAGE(PG8_SB(1, 0), cB + kstep, voffB); PG8_STAGE(PG8_SA(1, 0), cA + kstep, voffA); PG8_STAGE(PG8_SB(1, 1), cB + hstep + kstep, voffB);
        PG8_WAIT_V(6); PG8_BAR;
    }
    for (;;) {
        const bool has_next = S.next(ui + 1, nxt);
        const char* nA = has_next ? (const char*)g.A + (size_t)nxt.pm * tstep : cA; const char* nB = has_next ? (const char*)g.Bt + (size_t)nxt.pn * tstep : cB;
        for (int t = 0; t < nt; t += 2) {
            const bool last = (t == nt - 2);
            const char* a1 = cA + (size_t)(t + 1) * kstep;
            const char* a2 = last ? nA : cA + (size_t)(t + 2) * kstep; const char* b2 = last ? nB : cB + (size_t)(t + 2) * kstep;
            const char* a3 = a2 + kstep; const char* b3 = b2 + kstep;
            if (last && has_next) S.a_ready(nxt);
            if constexpr (SP2) {
            PG8_LDB(B0, 0, 0); PG8_LDB(B1, 0, 1); PG8_SCHED; PG8_LDA(At, 0, 0); PG8_STAGE(PG8_SA(1, 1), a1 + hstep, voffA);
            PG8_WAIT_V(8); PG8_WAIT_L(0); PG8_BAR; PG8_MMA(0, 0, At, B0); PG8_MMA(0, 1, At, B1); PG8_BAR; PG8_SCHED;
            PG8_LDA(At, 0, 1); PG8_STAGE(PG8_SB(0, 0), b2, voffB); PG8_STAGE(PG8_SB(0, 1), b2 + hstep, voffB); PG8_STAGE(PG8_SA(0, 0), a2, voffA);
            PG8_WAIT_V(8); PG8_WAIT_L(0); PG8_BAR; PG8_MMA(1, 0, At, B0); PG8_MMA(1, 1, At, B1); PG8_BAR; PG8_SCHED;
            PG8_LDB(B0, 1, 0); PG8_LDB(B1, 1, 1); PG8_SCHED; PG8_LDA(At, 1, 0); PG8_STAGE(PG8_SA(0, 1), a2 + hstep, voffA);
            PG8_WAIT_V(8); PG8_WAIT_L(0); PG8_BAR; PG8_MMA(0, 0, At, B0); PG8_MMA(0, 1, At, B1); PG8_BAR; PG8_SCHED;
            PG8_LDA(At, 1, 1); PG8_STAGE(PG8_SB(1, 0), b3, voffB); PG8_STAGE(PG8_SB(1, 1), b3 + hstep, voffB); PG8_STAGE(PG8_SA(1, 0), a3, voffA);
            PG8_WAIT_V(8); PG8_WAIT_L(0); PG8_BAR; PG8_MMA(1, 0, At, B0); PG8_MMA(1, 1, At, B1); PG8_BAR; PG8_SCHED;
            } else {
            PG8_LDB(B0, 0, 0); PG8_SCHED; PG8_LDA(At, 0, 0); PG8_STAGE(PG8_SA(1, 1), a1 + hstep, voffA);
            PG8_WAIT_L(8); PG8_BAR; PG8_WAIT_L(0); PG8_MMA(0, 0, At, B0); PG8_BAR; PG8_SCHED;
            PG8_LDB(B1, 0, 1); PG8_STAGE(PG8_SB(0, 0), b2, voffB);
            PG8_BAR; PG8_WAIT_L(0); PG8_MMA(0, 1, At, B1); PG8_BAR;
            PG8_LDA(At, 0, 1); PG8_STAGE(PG8_SA(0, 0), a2, voffA);
            PG8_BAR; PG8_WAIT_L(0); PG8_MMA(1, 0, At, B0); PG8_BAR; PG8_SCHED;
            PG8_STAGE(PG8_SB(0, 1), b2 + hstep, voffB);
            PG8_WAIT_V(6); PG8_BAR; PG8_MMA(1, 1, At, B1); PG8_BAR;
            PG8_LDB(B0, 1, 0); PG8_SCHED; PG8_LDA(At, 1, 0); PG8_STAGE(PG8_SA(0, 1), a2 + hstep, voffA);
            PG8_WAIT_L(8); PG8_BAR; PG8_WAIT_L(0); PG8_MMA(0, 0, At, B0); PG8_BAR; PG8_SCHED;
            PG8_LDB(B1, 1, 1); PG8_STAGE(PG8_SB(1, 0), b3, voffB);
            PG8_BAR; PG8_WAIT_L(0); PG8_MMA(0, 1, At, B1); PG8_BAR;
            PG8_LDA(At, 1, 1); PG8_STAGE(PG8_SA(1, 0), a3, voffA);
            PG8_BAR; PG8_WAIT_L(0); PG8_MMA(1, 0, At, B0); PG8_BAR; PG8_SCHED;
            PG8_STAGE(PG8_SB(1, 1), b3 + hstep, voffB);
            PG8_WAIT_V(6); PG8_BAR; PG8_MMA(1, 1, At, B1); PG8_BAR;
            }
        }
        if constexpr (ALIGN_EPI) { if (wr == 0) PG8_BAR; }
        if constexpr (!Epi::AFTER_DRAIN) { E(acc, cur, wr, wc, fr, fq); S.done(cur); }
        if (!has_next) break;
#pragma unroll
        for (int a = 0; a < 2; ++a)
#pragma unroll
            for (int b = 0; b < 2; ++b)
#pragma unroll
                for (int m = 0; m < 4; ++m)
#pragma unroll
                    for (int n = 0; n < 2; ++n) acc[a][b][m][n] = (f32x4){0.f, 0.f, 0.f, 0.f};
        cur = nxt; cA = nA; cB = nB; ++ui;
        if constexpr (ALIGN_EPI) { if (wr == 1) PG8_BAR; }
    }
    PG8_WAIT_V(0);
    if constexpr (!ALIGN_EPI) { if (wr == 0) PG8_BAR; }
    PG8_BAR;
    if constexpr (Epi::AFTER_DRAIN) { E.fused(acc, cur, wr, wc, fr, fq, lds, wid, lane); S.done(cur); }
#undef PG8_SA
#undef PG8_SB
#undef PG8_STAGE
#undef PG8_LDA
#undef PG8_LDB
#undef PG8_MMA
#undef PG8_WAIT_V
#undef PG8_WAIT_L
#undef PG8_BAR
#undef PG8_SCHED
}
}
namespace att {
#define ALAS __attribute__((address_space(3)))
typedef unsigned short bf16_t;
typedef short bf16x8 __attribute__((ext_vector_type(8)));
typedef float f32x16 __attribute__((ext_vector_type(16)));
typedef float f32x4 __attribute__((ext_vector_type(4)));
typedef unsigned u32x4 __attribute__((ext_vector_type(4)));
typedef unsigned u32x2 __attribute__((ext_vector_type(2)));
constexpr int KROW = 144;
constexpr int KBUF = 64 * KROW;
constexpr int VBUF = 64 * 320;
template <int DV> struct VRow { static constexpr int B = (DV == 128) ? 320 : 192; };
constexpr int L_K = 0, L_V = 2 * KBUF, L_BT = L_V + 2 * VBUF, L_END = L_BT + 512;
constexpr int L_O1 = L_END;
constexpr int L_QS = L_O1 + 65536;
constexpr float LOG2E = 1.4426950408889634f;
constexpr float QSCALE = 0.125f * 1.4426950408889634f;
#define CR(r) (((r) & 3) + 8 * ((r) >> 2))
typedef float f32x2_t __attribute__((ext_vector_type(2))); typedef __bf16 bf16x2_t __attribute__((ext_vector_type(2)));
__device__ __forceinline__ unsigned cvtpk(float lo, float hi) { f32x2_t v = {lo, hi}; bf16x2_t b = __builtin_convertvector(v, bf16x2_t); return __builtin_bit_cast(unsigned, b); }
__device__ __forceinline__ unsigned cvtpk_a(float lo, float hi) { unsigned r; asm volatile("v_cvt_pk_bf16_f32 %0, %1, %2" : "=v"(r) : "v"(lo), "v"(hi)); return r; }
__device__ __forceinline__ float ex2(float x) { return __builtin_amdgcn_exp2f(x); }
__device__ __forceinline__ float rcpf_(float x) { return __builtin_amdgcn_rcpf(x); }

typedef short v4i16_t __attribute__((ext_vector_type(4)));
__device__ __forceinline__ v4i16_t vtr(const ALAS unsigned char* p) { return __builtin_amdgcn_ds_read_tr16_b64_v4i16((ALAS v4i16_t*)p); }
template <int DV> __device__ __forceinline__ bf16x8 vfrag(const ALAS unsigned char* vb, int s, int db) {
    const v4i16_t lo = vtr(vb + (16 * s) * VRow<DV>::B + 64 * db), hi4 = vtr(vb + (16 * s + 8) * VRow<DV>::B + 64 * db);
    return __builtin_shufflevector(lo, hi4, 0, 1, 2, 3, 4, 5, 6, 7);
}
template <int DV> __device__ __forceinline__ int vtr_lane_off(int lane) { return (4 * (lane >> 5) + ((lane & 15) >> 2)) * VRow<DV>::B + (16 * ((lane >> 4) & 1) + 4 * (lane & 3)) * 2; }
__device__ __forceinline__ float pair_max(float x) { auto rr = __builtin_amdgcn_permlane32_swap(__float_as_uint(x), __float_as_uint(x), false, false); return fmaxf(__uint_as_float(rr[0]), __uint_as_float(rr[1])); }
template <int DV> struct Pref { u32x4 k; u32x4 v[DV / 64]; };

template <int DV> __device__ __forceinline__ void tile_load(Pref<DV>& pf, const bf16_t* Kp, const bf16_t* Vp, int pitch, int kt, int tid) {
    const int krow = tid >> 3, kc = (tid & 7) * 8;
    pf.k = *(const u32x4*)(Kp + (size_t)(kt * 64 + krow) * pitch + kc);
#pragma unroll
    for (int i = 0; i < DV / 64; ++i) { const int c = tid + i * 512, vrow = c / (DV / 8), vc = (c % (DV / 8)) * 8;
        pf.v[i] = *(const u32x4*)(Vp + (size_t)(kt * 64 + vrow) * pitch + vc); }
}
template <int DV> __device__ __forceinline__ void tile_store(const Pref<DV>& pf, ALAS unsigned char* kbuf, ALAS unsigned char* vbuf, int tid) {
    const int krow = tid >> 3, kc = (tid & 7) * 8;
    *(ALAS u32x4*)(kbuf + krow * KROW + kc * 2) = pf.k;
#pragma unroll
    for (int i = 0; i < DV / 64; ++i) { const int c = tid + i * 512, vrow = c / (DV / 8), vc = (c % (DV / 8)) * 8;
        *(ALAS u32x4*)(vbuf + vrow * VRow<DV>::B + vc * 2) = pf.v[i]; }
}

template <int DV> __device__ __forceinline__ void pv_slab(const ALAS unsigned char* vbuf, int s, u32x4 w, f32x16 (&o)[DV / 32], int l32, int hi) {
    const bf16x8 pfr = __builtin_bit_cast(bf16x8, w);
#pragma unroll
    for (int db = 0; db < DV / 32; ++db) {
        const bf16x8 vf = vfrag<DV>(vbuf + vtr_lane_off<DV>(l32 + 32 * hi), s, db);
        o[db] = __builtin_amdgcn_mfma_f32_32x32x16_bf16(vf, pfr, o[db], 0, 0, 0); }
    if (DV > 64) __builtin_amdgcn_sched_barrier(0);
}

template <int MODE, int DV, bool MASKED>
__device__ __forceinline__ void tile_compute(const ALAS unsigned char* kbuf, const ALAS unsigned char* vbuf, const bf16x8 (&qf)[4], f32x16 (&o)[DV / 32],
                                             float& st_m, float& st_l, int lim, const ALAS float* btab, float cbias, int lane) {
    const int l32 = lane & 31, hi = lane >> 5;
    if constexpr (MODE == 0) {
        f32x16 p0, p1;
#pragma unroll
        for (int r = 0; r < 16; ++r) { p0[r] = 0.f; p1[r] = 0.f; }
        { const ALAS unsigned char* kb = kbuf + l32 * KROW + hi * 16;
#pragma unroll
          for (int d0 = 0; d0 < 4; ++d0) {
              const bf16x8 k0 = *(const ALAS bf16x8*)(kb + d0 * 32);
              const bf16x8 k1 = *(const ALAS bf16x8*)(kb + 32 * KROW + d0 * 32);
              p0 = __builtin_amdgcn_mfma_f32_32x32x16_bf16(k0, qf[d0], p0, 0, 0, 0);
              p1 = __builtin_amdgcn_mfma_f32_32x32x16_bf16(k1, qf[d0], p1, 0, 0, 0); } }
        __builtin_amdgcn_sched_barrier(0);
#pragma unroll
        for (int r = 0; r < 16; ++r) {
            float a = rcpf_(1.0f + ex2(p0[r])), b = rcpf_(1.0f + ex2(p1[r]));
            if (MASKED) { a = (CR(r) < lim) ? a : 1.0f; b = (CR(r) + 32 < lim) ? b : 1.0f; }
            p0[r] = a; p1[r] = b; }
        float g[8], hs[8], pr[8];
#pragma unroll
        for (int i = 0; i < 4; ++i) { g[i] = (p0[4 * i] * p0[4 * i + 1]) * (p0[4 * i + 2] * p0[4 * i + 3]); g[4 + i] = (p1[4 * i] * p1[4 * i + 1]) * (p1[4 * i + 2] * p1[4 * i + 3]); }
#pragma unroll
        for (int i = 0; i < 8; ++i) { auto rr = __builtin_amdgcn_permlane32_swap(__float_as_uint(g[i]), __float_as_uint(g[i]), false, false);
            pr[i] = __uint_as_float(rr[0]) * __uint_as_float(rr[1]); hs[i] = hi ? 1.0f : __uint_as_float(rr[1]); }
        float T = st_m;
#pragma unroll
        for (int i = 7; i >= 0; --i) {
            float R = hs[i] * T; T = T * pr[i];
            if (i >= 4) { const int b = 4 * (i - 4);
                float R2 = R * p1[b + 3]; p1[b + 3] = R - R2; float R1 = R2 * p1[b + 2]; p1[b + 2] = R2 - R1; float R0 = R1 * p1[b + 1]; p1[b + 1] = R1 - R0; p1[b] = R0 - R0 * p1[b]; }
            else { const int b = 4 * i;
                float R2 = R * p0[b + 3]; p0[b + 3] = R - R2; float R1 = R2 * p0[b + 2]; p0[b + 2] = R2 - R1; float R0 = R1 * p0[b + 1]; p0[b + 1] = R1 - R0; p0[b] = R0 - R0 * p0[b]; }
        }
        st_m = T;
        __builtin_amdgcn_sched_barrier(0);
#pragma unroll
        for (int s = 0; s < 4; ++s) {
            u32x4 w;
            if (s == 0) { w.x = cvtpk(p0[0], p0[1]); w.y = cvtpk(p0[2], p0[3]); w.z = cvtpk(p0[4], p0[5]); w.w = cvtpk(p0[6], p0[7]); }
            else if (s == 1) { w.x = cvtpk(p0[8], p0[9]); w.y = cvtpk(p0[10], p0[11]); w.z = cvtpk(p0[12], p0[13]); w.w = cvtpk(p0[14], p0[15]); }
            else if (s == 2) { w.x = cvtpk(p1[0], p1[1]); w.y = cvtpk(p1[2], p1[3]); w.z = cvtpk(p1[4], p1[5]); w.w = cvtpk(p1[6], p1[7]); }
            else { w.x = cvtpk(p1[8], p1[9]); w.y = cvtpk(p1[10], p1[11]); w.z = cvtpk(p1[12], p1[13]); w.w = cvtpk(p1[14], p1[15]); }
            pv_slab<DV>(vbuf, s, w, o, l32, hi);
        }
    } else {
        const float NEG = -__builtin_inff();
#pragma unroll
        for (int hk = 0; hk < 2; ++hk) {
            f32x16 p;
            const bool fresh = (st_m == NEG);
            const float mbase = fresh ? 0.f : st_m;
            { const float ini = (MASKED ? 0.f : cbias) - mbase;
#pragma unroll
              for (int r = 0; r < 16; ++r) p[r] = ini; }
            { const ALAS unsigned char* kb = kbuf + (32 * hk + l32) * KROW + hi * 16;
#pragma unroll
              for (int d0 = 0; d0 < 4; ++d0) { const bf16x8 k0 = *(const ALAS bf16x8*)(kb + d0 * 32); p = __builtin_amdgcn_mfma_f32_32x32x16_bf16(k0, qf[d0], p, 0, 0, 0); } }
            if (MASKED) {
                float bv[16];
#pragma unroll
                for (int r = 0; r < 16; ++r) { const int d0 = lim - 32 * hk - CR(r); bv[r] = btab[min(max(d0, 0), 127)]; }
#pragma unroll
                for (int r = 0; r < 16; ++r) asm volatile("" : "+v"(bv[r]));
#pragma unroll
                for (int r = 0; r < 16; ++r) {
                    const int d0 = lim - 32 * hk - CR(r);
                    const bool v0 = (MODE == 2) ? ((unsigned)d0 < 128u) : (d0 >= 0);
                    p[r] = v0 ? p[r] + bv[r] : NEG; }
            }
            float mt = fmaxf(p[0], p[1]);
#pragma unroll
            for (int r = 2; r < 16; ++r) mt = fmaxf(mt, p[r]);
            mt = fmaxf(mt, __shfl_xor(mt, 32));
            const bool need = fresh ? (mt > NEG) : (mt > 0.f);
            if (__any(need)) {
                const float dl = need ? mt : 0.f, f = fresh ? 1.0f : ex2(-dl);
                st_l *= f; st_m = need ? mbase + dl : st_m;
#pragma unroll
                for (int r = 0; r < 16; ++r) p[r] -= dl;
#pragma unroll
                for (int db = 0; db < DV / 32; ++db)
#pragma unroll
                    for (int r = 0; r < 16; ++r) o[db][r] *= f;
            }
            float s = 0.f;
#pragma unroll
            for (int r = 0; r < 16; ++r) { p[r] = ex2(p[r]); s += p[r]; }
            st_l += s;
#pragma unroll
            for (int s2 = 0; s2 < 2; ++s2) {
                u32x4 w; w.x = cvtpk(p[8 * s2], p[8 * s2 + 1]); w.y = cvtpk(p[8 * s2 + 2], p[8 * s2 + 3]); w.z = cvtpk(p[8 * s2 + 4], p[8 * s2 + 5]); w.w = cvtpk(p[8 * s2 + 6], p[8 * s2 + 7]);
                pv_slab<DV>(vbuf, 2 * hk + s2, w, o, l32, hi);
            }
        }
    }
}

template <int MODE, int DV>
__device__ __forceinline__ void attn_core(const bf16_t* Qp, const bf16_t* Kp, const bf16_t* Vp, int pitch, int q0, int kt0, int nt, int dir,
                                          ALAS unsigned char* lds, f32x16 (&o)[DV / 32], float& st_m, float& st_l) {
    int tid_ = threadIdx.x; asm volatile("" : "+v"(tid_));
    const int tid = tid_, lane = tid & 63, l32 = lane & 31, hi = lane >> 5, wid = __builtin_amdgcn_readfirstlane(tid >> 6);
    const int qw = q0 + 32 * wid, t = qw + l32;
    const ALAS float* btab = (const ALAS float*)(lds + L_BT);
    bf16x8 qf[4];
#pragma unroll
    for (int d0 = 0; d0 < 4; ++d0) qf[d0] = *(const bf16x8*)(Qp + (size_t)t * pitch + d0 * 16 + hi * 8);
#pragma unroll
    for (int db = 0; db < DV / 32; ++db)
#pragma unroll
        for (int r = 0; r < 16; ++r) o[db][r] = 0.f;
    st_m = (MODE == 0) ? 1.0f : -__builtin_inff(); st_l = 0.f;
    Pref<DV> pfA, pfB;
    tile_load<DV>(pfA, Kp, Vp, pitch, kt0, tid);
    tile_load<DV>(pfB, Kp, Vp, pitch, kt0 + dir * min(1, nt - 1), tid);
    tile_store<DV>(pfA, lds + L_K, lds + L_V, tid);
    __syncthreads();
    const float cbias = (MODE == 1) ? btab[127] : 0.f;
    bool done = false;
#define AC_STEP(it_, PFN, PFS) do { \
        const int it = (it_), kt = kt0 + dir * it, cur = it & 1, kbase = kt * 64; \
        tile_load<DV>(PFN, Kp, Vp, pitch, kt0 + dir * min(it + 2, nt - 1), tid);        \
        const ALAS unsigned char* kb = lds + L_K + cur * KBUF; const ALAS unsigned char* vb = lds + L_V + cur * VBUF; \
        const int lim = t - kbase - 4 * hi; \
        if (MODE == 0) { \
            if (kbase <= qw + 31 && __any(st_m != 0.0f)) { if (kbase + 63 >= qw) tile_compute<0, DV, true>(kb, vb, qf, o, st_m, st_l, lim, btab, cbias, lane); else tile_compute<0, DV, false>(kb, vb, qf, o, st_m, st_l, lim, btab, cbias, lane); } \
        } else if (MODE == 1) { \
            if (kbase <= qw + 31) { if (qw - (kbase + 63) < 113) tile_compute<1, DV, true>(kb, vb, qf, o, st_m, st_l, lim, btab, cbias, lane); else tile_compute<1, DV, false>(kb, vb, qf, o, st_m, st_l, lim, btab, cbias, lane); } \
        } else { \
            if (kbase <= qw + 31 && kbase + 63 >= qw - 127) tile_compute<2, DV, true>(kb, vb, qf, o, st_m, st_l, lim, btab, cbias, lane); \
        } \
        if (it + 1 < nt) tile_store<DV>(PFS, lds + L_K + (cur ^ 1) * KBUF, lds + L_V + (cur ^ 1) * VBUF, tid);     \
        if (MODE == 0) { \
              \
            if (!__syncthreads_or(st_m != 0.0f)) done = true; \
        } else __syncthreads(); } while (0)
    for (int it2 = 0; it2 < nt && !done; it2 += 2) {
        AC_STEP(it2, pfA, pfB);
        if (done) break;
        AC_STEP(it2 + 1, pfB, pfA);
    }
#undef AC_STEP
}
template <int MODE, int DV>
__device__ __forceinline__ void attn_core_pp(const bf16_t* Qp, const bf16_t* Kp, const bf16_t* Vp, int pitch, int q0, int kt0, int nt,
                                             ALAS unsigned char* lds, f32x16 (&o)[DV / 32], float& st_m, float& st_l) {
    int tid_ = threadIdx.x; asm volatile("" : "+v"(tid_));
    const int tid = tid_, lane = tid & 63, l32 = lane & 31, hi = lane >> 5, wid = __builtin_amdgcn_readfirstlane(tid >> 6), grp = wid >> 2;
    const int qw = q0 + 32 * wid, t = qw + l32;
    const ALAS float* btab = (const ALAS float*)(lds + L_BT);
    const float NEG = -__builtin_inff();
    bf16x8 qf[4];
#pragma unroll
    for (int d0 = 0; d0 < 4; ++d0) qf[d0] = *(const bf16x8*)(Qp + (size_t)t * pitch + d0 * 16 + hi * 8);
    ALAS unsigned char* qst = lds + L_QS + wid * 3072 + lane * 16;
    if (DV == 128) {
#pragma unroll
        for (int d0 = 1; d0 < 4; ++d0) *(ALAS bf16x8*)(qst + (d0 - 1) * 1024) = qf[d0];
    }
#pragma unroll
    for (int db = 0; db < DV / 32; ++db)
#pragma unroll
        for (int r = 0; r < 16; ++r) o[db][r] = 0.f;
    st_m = NEG; st_l = 0.f;
    Pref<DV> pfA, pfB;
    tile_load<DV>(pfA, Kp, Vp, pitch, kt0, tid);
    tile_load<DV>(pfB, Kp, Vp, pitch, kt0 + 1, tid);
    tile_store<DV>(pfA, lds + L_K, lds + L_V, tid);
    tile_store<DV>(pfB, lds + L_K + KBUF, lds + L_V + VBUF, tid);
    tile_load<DV>(pfA, Kp, Vp, pitch, kt0 + min(2, nt - 1), tid);
    tile_load<DV>(pfB, Kp, Vp, pitch, kt0 + min(3, nt - 1), tid);
    __syncthreads();
    const float cbias = (MODE == 1) ? btab[127] : 0.f;
    f32x16 p; u32x4 pw0, pw1;
#pragma unroll
    for (int r = 0; r < 16; ++r) p[r] = 0.f;
    pw0 = (u32x4){0u, 0u, 0u, 0u}; pw1 = pw0;
#define PP_MASKED(ti) ((MODE == 1) ? (qw - ((kt0 + (ti)) * 64 + 63) < 113) : true)
#define PP_PART(ti) ((MODE != 2) || ((kt0 + (ti)) * 64 <= qw + 31 && (kt0 + (ti)) * 64 + 63 >= qw - 127))
#define PP_QK(ti, hk) do { \
        const float mbase_ = (st_m == NEG) ? 0.f : st_m; const float ini_ = (PP_MASKED(ti) ? 0.f : cbias) - mbase_; \
        _Pragma("unroll") for (int r = 0; r < 16; ++r) p[r] = ini_; \
        const ALAS unsigned char* kb_ = lds + L_K + ((ti) & 1) * KBUF + (32 * (hk) + l32) * KROW + hi * 16; \
        _Pragma("unroll") for (int d0 = 0; d0 < 4; ++d0) { const bf16x8 k0_ = *(const ALAS bf16x8*)(kb_ + d0 * 32); \
            const bf16x8 qv_ = (DV == 128 && d0 > 0) ? *(const ALAS bf16x8*)(qst + (d0 - 1) * 1024) : qf[d0]; \
            p = __builtin_amdgcn_mfma_f32_32x32x16_bf16(k0_, qv_, p, 0, 0, 0); } } while (0)
#define PP_PVQK(tv, hv, tk, hq) do { \
        const ALAS unsigned char* vb_ = lds + L_V + ((tv) & 1) * VBUF + vtr_lane_off<DV>(lane); \
        const ALAS unsigned char* kb_ = lds + L_K + ((tk) & 1) * KBUF + (32 * (hq) + l32) * KROW + hi * 16; \
        if (PP_PART(tv)) { \
            bf16x8 vf_[DV / 32][2]; \
            _Pragma("unroll") for (int db = 0; db < DV / 32; ++db) { vf_[db][0] = vfrag<DV>(vb_, 2 * (hv), db); vf_[db][1] = vfrag<DV>(vb_, 2 * (hv) + 1, db); } \
            const bf16x8 pa_ = __builtin_bit_cast(bf16x8, pw0), pb_ = __builtin_bit_cast(bf16x8, pw1); \
            _Pragma("unroll") for (int db = 0; db < DV / 32; ++db) o[db] = __builtin_amdgcn_mfma_f32_32x32x16_bf16(vf_[db][0], pa_, o[db], 0, 0, 0); \
            _Pragma("unroll") for (int db = 0; db < DV / 32; ++db) o[db] = __builtin_amdgcn_mfma_f32_32x32x16_bf16(vf_[db][1], pb_, o[db], 0, 0, 0); } \
        if (PP_PART(tk)) { \
            bf16x8 kf_[4], qv_[4]; \
            _Pragma("unroll") for (int d0 = 0; d0 < 4; ++d0) { kf_[d0] = *(const ALAS bf16x8*)(kb_ + d0 * 32); qv_[d0] = (DV == 128 && d0 > 0) ? *(const ALAS bf16x8*)(qst + (d0 - 1) * 1024) : qf[d0]; } \
            const float mbase_ = (st_m == NEG) ? 0.f : st_m; const float ini_ = (PP_MASKED(tk) ? 0.f : cbias) - mbase_; \
            _Pragma("unroll") for (int r = 0; r < 16; ++r) p[r] = ini_; \
            _Pragma("unroll") for (int d0 = 0; d0 < 4; ++d0) p = __builtin_amdgcn_mfma_f32_32x32x16_bf16(kf_[d0], qv_[d0], p, 0, 0, 0); } } while (0)
#define PP_SM(ti, hk) do { if (PP_PART(ti)) { \
        if (PP_MASKED(ti)) { const int lim_ = t - (kt0 + (ti)) * 64 - 4 * hi - 32 * (hk); \
            _Pragma("unroll") for (int g8 = 0; g8 < 16; g8 += 8) { float bv_[8]; \
                _Pragma("unroll") for (int r = 0; r < 8; ++r) { const int d0 = lim_ - CR(g8 + r); bv_[r] = btab[min(max(d0, 0), 127)]; } \
                _Pragma("unroll") for (int r = 0; r < 8; ++r) asm volatile("" : "+v"(bv_[r])); \
                _Pragma("unroll") for (int r = 0; r < 8; ++r) { const int d0 = lim_ - CR(g8 + r); const bool v0 = (MODE == 2) ? ((unsigned)d0 < 128u) : (d0 >= 0); p[g8 + r] = v0 ? p[g8 + r] + bv_[r] : NEG; } } } \
        const bool fresh_ = (st_m == NEG); const float mb_ = fresh_ ? 0.f : st_m; \
        float mt_; { const float a0_ = fmaxf(fmaxf(p[0], p[1]), p[2]), a1_ = fmaxf(fmaxf(p[3], p[4]), p[5]), a2_ = fmaxf(fmaxf(p[6], p[7]), p[8]), a3_ = fmaxf(fmaxf(p[9], p[10]), p[11]), a4_ = fmaxf(fmaxf(p[12], p[13]), p[14]); \
            mt_ = fmaxf(fmaxf(fmaxf(a0_, a1_), a2_), fmaxf(fmaxf(a3_, a4_), p[15])); }        \
        mt_ = pair_max(mt_); \
        const bool need_ = fresh_ ? (mt_ > NEG) : (mt_ > 0.f); \
        if (__any(need_)) { const float dl_ = need_ ? mt_ : 0.f, f_ = fresh_ ? 1.0f : ex2(-dl_); \
            st_l *= f_; st_m = need_ ? mb_ + dl_ : st_m; \
            _Pragma("unroll") for (int r = 0; r < 16; ++r) p[r] -= dl_; \
            _Pragma("unroll") for (int db = 0; db < DV / 32; ++db) _Pragma("unroll") for (int r = 0; r < 16; ++r) o[db][r] *= f_; } \
        _Pragma("unroll") for (int r = 0; r < 16; ++r) p[r] = ex2(p[r]); \
        st_l += ((p[0] + p[1]) + (p[2] + p[3])) + ((p[4] + p[5]) + (p[6] + p[7])) + (((p[8] + p[9]) + (p[10] + p[11])) + ((p[12] + p[13]) + (p[14] + p[15]))); \
        pw0.x = cvtpk_a(p[0], p[1]); pw0.y = cvtpk_a(p[2], p[3]); pw0.z = cvtpk_a(p[4], p[5]); pw0.w = cvtpk_a(p[6], p[7]); \
        pw1.x = cvtpk_a(p[8], p[9]); pw1.y = cvtpk_a(p[10], p[11]); pw1.z = cvtpk_a(p[12], p[13]); pw1.w = cvtpk_a(p[14], p[15]); } } while (0)
#define PP_STAGE(u, PF) do { const int u_ = (u); if (u_ >= 2 && u_ < nt) tile_store<DV>(PF, lds + L_K + (u_ & 1) * KBUF, lds + L_V + (u_ & 1) * VBUF, tid); \
        tile_load<DV>(PF, Kp, Vp, pitch, kt0 + min(u_ + 2, nt - 1), tid); } while (0)
#define PP_BAR() asm volatile("s_waitcnt lgkmcnt(0)\n\ts_barrier" ::: "memory")
    if (grp == 1) __builtin_amdgcn_s_setprio(1);
    if (grp == 0) {
        PP_QK(0, 0); PP_BAR();
        for (int ti = 0; ti < nt; ti += 2) {
            PP_SM(ti, 0); PP_BAR();
            PP_PVQK(ti, 0, ti, 1); PP_STAGE(ti + 1, pfB); PP_BAR();
            PP_SM(ti, 1); PP_BAR();
            PP_PVQK(ti, 1, ti + 1, 0); PP_BAR();
            PP_SM(ti + 1, 0); PP_BAR();
            PP_PVQK(ti + 1, 0, ti + 1, 1); PP_STAGE(ti + 2, pfA); PP_BAR();
            PP_SM(ti + 1, 1); PP_BAR();
            PP_PVQK(ti + 1, 1, ti + 2, 0); PP_BAR();
        }
        PP_BAR();
    } else {
        PP_BAR();
        PP_QK(0, 0); PP_BAR();
        for (int ti = 0; ti < nt; ti += 2) {
            PP_SM(ti, 0); PP_STAGE(ti + 1, pfB); PP_BAR();
            PP_PVQK(ti, 0, ti, 1); PP_BAR();
            PP_SM(ti, 1); PP_BAR();
            PP_PVQK(ti, 1, ti + 1, 0); PP_BAR();
            PP_SM(ti + 1, 0); PP_STAGE(ti + 2, pfA); PP_BAR();
            PP_PVQK(ti + 1, 0, ti + 1, 1); PP_BAR();
            PP_SM(ti + 1, 1); PP_BAR();
            PP_PVQK(ti + 1, 1, ti + 2, 0); PP_BAR();
        }
    }
    __builtin_amdgcn_s_setprio(0);
#undef PP_MASKED
#undef PP_PART
#undef PP_QK
#undef PP_PVQK
#undef PP_SM
#undef PP_STAGE
#undef PP_BAR
}
template <int DV> __device__ __forceinline__ void store_ot(const f32x16 (&o)[DV / 32], bf16_t* orow, int hi) {
#pragma unroll
    for (int db = 0; db < DV / 32; ++db)
#pragma unroll
        for (int rg = 0; rg < 4; ++rg) { u32x2 w; w.x = cvtpk_a(o[db][4 * rg], o[db][4 * rg + 1]); w.y = cvtpk_a(o[db][4 * rg + 2], o[db][4 * rg + 3]);
            *(u32x2*)(orow + 32 * db + 8 * rg + 4 * hi) = w; }
}
}
#ifndef RESID_BF16
#define RESID_BF16 1
#endif
#ifndef OUT_STAGGER_TICKS
#define OUT_STAGGER_TICKS 0
#endif
#ifndef OUT_STAGGER_GROUPS
#define OUT_STAGGER_GROUPS 2
#endif
#ifndef REP_OUT
#define REP_OUT 1
#endif
#ifndef REP_DOWN
#define REP_DOWN 1
#endif
#ifndef REP_INPROJ
#define REP_INPROJ 1
#endif
#ifndef REP_DIFF
#define REP_DIFF 1
#endif
#ifndef REP_SWA
#define REP_SWA 1
#endif
#ifndef REP_SB
#define REP_SB 1
#endif
#ifndef REP_UP
#define REP_UP 1
#endif
#ifndef REP_CONV
#define REP_CONV 1
#endif
#ifndef PH_DIFF
#define PH_DIFF 1
#endif
#ifndef PH_SWA
#define PH_SWA 1
#endif
#ifndef PH_SB
#define PH_SB 1
#endif
#ifndef PH_CONV
#define PH_CONV 1
#endif
#define LAS __attribute__((address_space(3)))
typedef unsigned short bf16;
typedef float f32x4 __attribute__((ext_vector_type(4)));
typedef unsigned v4u __attribute__((ext_vector_type(4)));
typedef unsigned v2u __attribute__((ext_vector_type(2)));
constexpr int NWAVES = 8;
constexpr int SEQ = 4096, NB = 16, MTOK = NB * SEQ, DM = 1024, DFF = 2816, DUP = 2 * DFF;
constexpr int EVEN_IN = 2304, ODD_IN = 3072;
constexpr size_t MiB = 1u << 20;
constexpr size_t WS_SSQ = 1 * MiB;
constexpr size_t WS_WINE = 8 * MiB, WS_WOUTE = 17 * MiB, WS_WINO = 21 * MiB, WS_WOUTO = 33 * MiB, WS_WUP = 37 * MiB, WS_WDN = 81 * MiB;
constexpr size_t WS_XB = 104 * MiB, WS_R = 232 * MiB;
constexpr size_t WS_PROJ = WS_R, WS_AO = WS_R + 384 * MiB, WS_U = WS_R, WS_G = WS_R + 352 * MiB;
constexpr int LDS_MISC = 150528, LDS_BYTES = 151552;
static_assert(att::L_QS + 8 * 3072 <= LDS_MISC, "LDS map");
constexpr int HALF_ROWS = MTOK / 2;

struct Args {
    const float* x; const float* rel_bias; const float* norm_mix; const float* norm_ffn; const float* norm_final;
    const float* w_in_even; const float* w_out_even; const float* sinks; const float* lam_q1; const float* lam_k1; const float* lam_q2; const float* lam_k2;
    const float* diff_norm; const float* w_in_odd; const float* w_out_odd; const float* ffn_up; const float* ffn_conv; const float* ffn_conv_b; const float* ffn_down;
    float* out; unsigned char* ws;
};

__device__ const unsigned char T5B[128] = {0, 1, 2, 3, 4, 5, 6, 7, 8, 9, 10, 11, 12, 13, 14, 15, 16, 16, 16, 17, 17, 18, 18, 18, 19, 19, 19, 20, 20, 20, 20, 21, 21, 21, 21, 22, 22, 22, 22, 22, 23, 23, 23, 23, 23, 23, 24, 24, 24, 24, 24, 24, 25, 25, 25, 25, 25, 25, 25, 26, 26, 26, 26, 26, 26, 26, 26, 27, 27, 27, 27, 27, 27, 27, 27, 27, 27, 28, 28, 28, 28, 28, 28, 28, 28, 28, 28, 29, 29, 29, 29, 29, 29, 29, 29, 29, 29, 29, 29, 30, 30, 30, 30, 30, 30, 30, 30, 30, 30, 30, 30, 30, 30, 31, 31, 31, 31, 31, 31, 31, 31, 31, 31, 31, 31, 31, 31, 31};

__device__ __forceinline__ float wave_sum(float v) {
#pragma unroll
    for (int o = 1; o < 64; o <<= 1) v += __shfl_xor(v, o);
    return v;
}
__device__ __forceinline__ unsigned f2bf(float f) { unsigned u = __builtin_bit_cast(unsigned, f); return (u + 0x7fffu + ((u >> 16) & 1u)) >> 16; }
__device__ __forceinline__ unsigned pk2(float lo, float hi) { return f2bf(lo) | (f2bf(hi) << 16); }

__device__ __forceinline__ void transpose_item(const float* W, int K, int N, bf16* WT, const float* gk, int a0, int a1, int b0, int b1, float cs, LAS float* scr, int item, int lane) {
    const int nblk = N / 32, kb = item / nblk, nb = item % nblk, k0 = 64 * kb, n0 = 32 * nb;
    const int nn = n0 + (lane & 31);
    const float csc = ((nn >= a0 && nn < a1) || (nn >= b0 && nn < b1)) ? cs : 1.0f;
#pragma unroll 8
    for (int i = 0; i < 32; ++i) { const int kk = 2 * i + (lane >> 5); const float gv = gk ? gk[k0 + kk] : 1.0f; scr[kk * 33 + (lane & 31)] = W[(size_t)(k0 + kk) * N + nn] * (gv * csc); }
    asm volatile("s_waitcnt lgkmcnt(0)" ::: "memory");
    const int c = lane & 7;
#pragma unroll
    for (int j = 0; j < 4; ++j) { const int n = (lane >> 3) + 8 * j; const LAS float* s = scr + (8 * c) * 33 + n;
        v4u o; o.x = pk2(s[0 * 33], s[1 * 33]); o.y = pk2(s[2 * 33], s[3 * 33]); o.z = pk2(s[4 * 33], s[5 * 33]); o.w = pk2(s[6 * 33], s[7 * 33]);
        *(v4u*)(WT + (size_t)(n0 + n) * K + k0 + 8 * c) = o; }
    asm volatile("s_waitcnt lgkmcnt(0)" ::: "memory");
}

#define XB_TMO      128
#define XB_XCNT(j)  (256  + 64 * (j))
#define XB_XSUB(j)  (1280 + 64 * (j))
#define XB_XGEN(j)  (2304 + 64 * (j))
#define XB_TOP      3328
#define XB_TOPGEN   3392
#define XCD_BAR_WORDS 3456
#define XB_SPIN_CAP (1u << 18)

__device__ __forceinline__ unsigned xb_ld(unsigned* p)              { return __hip_atomic_load(p, __ATOMIC_RELAXED, __HIP_MEMORY_SCOPE_AGENT); }
__device__ __forceinline__ unsigned xb_add(unsigned* p, unsigned v) { return __hip_atomic_fetch_add(p, v, __ATOMIC_RELAXED, __HIP_MEMORY_SCOPE_AGENT); }
__device__ __forceinline__ unsigned xb_xcc_id() { return (unsigned)__builtin_amdgcn_s_getreg((3 << 11) | 20) & 0xFu; }
#define XB_SPIN(cond, bar) do { unsigned _sp = 0; while (cond) { __builtin_amdgcn_s_sleep(1); \
    if ((++_sp & 255u) == 0u) { if (xb_ld(&(bar)[XB_TMO])) break; if (_sp > XB_SPIN_CAP) { atomicAdd(&(bar)[XB_TMO], 1u); break; } } } } while (0)

struct XcdBarrier {
    unsigned* bar; unsigned x;
    volatile LAS unsigned* st;
};

__device__ __forceinline__ XcdBarrier xcd_barrier_post(unsigned* bar, volatile LAS unsigned* st) {
    XcdBarrier b; b.bar = bar; b.x = xb_xcc_id(); b.st = st;
    if (threadIdx.x == 0) (void)xb_add(&bar[XB_XCNT(b.x)], 1u);
    return b;
}
__device__ __forceinline__ void xcd_barrier_complete(unsigned* bar, unsigned x, unsigned& nloc, unsigned& nx) {
    const unsigned G = gridDim.x * gridDim.y * gridDim.z;
    unsigned sum, cnt, mine, sp = 0u;
    for (;;) {
        sum = 0u; cnt = 0u; mine = 0u;
#pragma unroll
        for (unsigned j = 0; j < 16; ++j) { const unsigned c = xb_ld(&bar[XB_XCNT(j)]); sum += c; cnt += (c > 0u) ? 1u : 0u; mine = (j == x) ? c : mine; }
        if (sum == G) break;
        __builtin_amdgcn_s_sleep(1);
        if ((++sp & 255u) == 0u) { if (xb_ld(&bar[XB_TMO])) break; if (sp > XB_SPIN_CAP) { atomicAdd(&bar[XB_TMO], 1u); break; } }
    }
    nloc = mine > 0u ? mine : 1u; nx = cnt > 0u ? cnt : 1u;
}

__device__ __forceinline__ void xcd_barrier(const XcdBarrier& b) {
    asm volatile("s_waitcnt vmcnt(0)" ::: "memory");
    __syncthreads();
    if (threadIdx.x == 0) {
        unsigned* bar = b.bar;
        __builtin_amdgcn_s_waitcnt(0);
        unsigned nloc = b.st[0], nx = b.st[1];
        if (nloc == 0u) { xcd_barrier_complete(bar, b.x, nloc, nx); b.st[0] = nloc; b.st[1] = nx; }
        const unsigned old = xb_add(&bar[XB_XSUB(b.x)], 1u);
        const unsigned gen = old / nloc;
        if (old + 1u == (gen + 1u) * nloc) {
            __builtin_amdgcn_fence(__ATOMIC_RELEASE, "agent");
            asm volatile("s_waitcnt vmcnt(0)" ::: "memory");
            const unsigned og = xb_add(&bar[XB_TOP], 1u);
            const unsigned tg = og / nx;
            if (og + 1u == (tg + 1u) * nx) xb_add(&bar[XB_TOPGEN], 1u);
            else XB_SPIN(xb_ld(&bar[XB_TOPGEN]) == tg, bar);
            __builtin_amdgcn_fence(__ATOMIC_ACQUIRE, "agent");
            xb_add(&bar[XB_XGEN(b.x)], 1u);
            asm volatile("s_waitcnt vmcnt(0)" ::: "memory");
        } else {
            XB_SPIN(xb_ld(&bar[XB_XGEN(b.x)]) == gen, bar);
            __builtin_amdgcn_fence(__ATOMIC_ACQUIRE, "agent");
            asm volatile("s_waitcnt vmcnt(0)" ::: "memory");
        }
    }
    __syncthreads();
}

__global__ void __launch_bounds__(NWAVES * 64, 2) mega_fwd(Args a) {
    extern __shared__ __attribute__((aligned(16))) unsigned char lds_raw[];
    cg::grid_group grid = cg::this_grid();
    LAS unsigned char* lds = (LAS unsigned char*)lds_raw;
    const int tid = threadIdx.x, lane = tid & 63, wave = __builtin_amdgcn_readfirstlane(tid >> 6);
    const int G = gridDim.x, bx = blockIdx.x;
    const int gw = bx * NWAVES + wave, NGW = G * NWAVES;
    unsigned char* ws = a.ws;
    float* ssq = (float*)(ws + WS_SSQ);
    bf16* xb = (bf16*)(ws + WS_XB);
    bf16* proj = (bf16*)(ws + WS_PROJ);
    bf16* ao = (bf16*)(ws + WS_AO);
    bf16* ubuf = (bf16*)(ws + WS_U);
    bf16* gbuf = (bf16*)(ws + WS_G);

    if (bx == 0) for (int i = tid; i < XCD_BAR_WORDS; i += NWAVES * 64) ((unsigned*)ws)[i] = 0u;
    if (tid < 2) ((LAS unsigned*)(lds + LDS_MISC))[tid] = 0u;
    {
        LAS float* scr = (LAS float*)(lds + wave * 16384);
        constexpr int I_INE = 16 * (EVEN_IN / 32), I_OUT = 16 * 32, I_INO = 16 * (ODD_IN / 32), I_UP = 16 * (DUP / 32), I_DN = (DFF / 64) * 32;
        constexpr int NITEMS = 2 * I_INE + 2 * I_OUT + 2 * I_INO + 2 * I_OUT + 4 * I_UP + 4 * I_DN;
        for (int it = gw; it < NITEMS; it += NGW) {
            int r = it;
            if (r < 2 * I_INE) { const int e = r / I_INE; r -= e * I_INE;
                transpose_item(a.w_in_even + (size_t)e * DM * EVEN_IN, DM, EVEN_IN, (bf16*)(ws + WS_WINE) + (size_t)e * EVEN_IN * DM, a.norm_mix + (2 * e) * DM, 0, 512, 768, 1280, att::QSCALE, scr, r, lane); continue; }
            r -= 2 * I_INE;
            if (r < 2 * I_OUT) { const int e = r / I_OUT; r -= e * I_OUT;
                transpose_item(a.w_out_even + (size_t)e * DM * DM, DM, DM, (bf16*)(ws + WS_WOUTE) + (size_t)e * DM * DM, nullptr, 0, 0, 0, 0, 1.f, scr, r, lane); continue; }
            r -= 2 * I_OUT;
            if (r < 2 * I_INO) { const int e = r / I_INO; r -= e * I_INO;
                transpose_item(a.w_in_odd + (size_t)e * DM * ODD_IN, DM, ODD_IN, (bf16*)(ws + WS_WINO) + (size_t)e * ODD_IN * DM, a.norm_mix + (2 * e + 1) * DM, 0, 1024, 0, 0, att::QSCALE, scr, r, lane); continue; }
            r -= 2 * I_INO;
            if (r < 2 * I_OUT) { const int e = r / I_OUT; r -= e * I_OUT;
                transpose_item(a.w_out_odd + (size_t)e * DM * DM, DM, DM, (bf16*)(ws + WS_WOUTO) + (size_t)e * DM * DM, nullptr, 0, 0, 0, 0, 1.f, scr, r, lane); continue; }
            r -= 2 * I_OUT;
            if (r < 4 * I_UP) { const int e = r / I_UP; r -= e * I_UP;
                transpose_item(a.ffn_up + (size_t)e * DM * DUP, DM, DUP, (bf16*)(ws + WS_WUP) + (size_t)e * DUP * DM, a.norm_ffn + e * DM, 0, 0, 0, 0, 1.f, scr, r, lane); continue; }
            r -= 4 * I_UP;
            { const int e = r / I_DN; r -= e * I_DN;
                transpose_item(a.ffn_down + (size_t)e * DFF * DM, DFF, DM, (bf16*)(ws + WS_WDN) + (size_t)e * DM * DFF, nullptr, 0, 0, 0, 0, 1.f, scr, r, lane); }
        }
        for (int m0 = 2 * gw; m0 < MTOK; m0 += 2 * NGW) {
            f32x4 v[2][4];
#pragma unroll
            for (int h2 = 0; h2 < 2; ++h2) { const f32x4* xr = (const f32x4*)(a.x + (size_t)(m0 + h2) * DM) + lane;
#pragma unroll
                for (int j = 0; j < 4; ++j) v[h2][j] = __builtin_nontemporal_load(xr + 64 * j); }
#pragma unroll
            for (int h2 = 0; h2 < 2; ++h2) { const int m = m0 + h2; float s = 0.f;
#pragma unroll
                for (int j = 0; j < 4; ++j) s += (v[h2][j][0] * v[h2][j][0] + v[h2][j][1] * v[h2][j][1]) + (v[h2][j][2] * v[h2][j][2] + v[h2][j][3] * v[h2][j][3]);
                s = wave_sum(s);
                v2u* o8 = (v2u*)(xb + (size_t)m * DM) + lane;
#pragma unroll
                for (int j = 0; j < 4; ++j) { v2u w; w.x = pk2(v[h2][j][0], v[h2][j][1]); w.y = pk2(v[h2][j][2], v[h2][j][3]); o8[64 * j] = w; }
                if (lane < 16) ssq[(size_t)m * 16 + lane] = (lane == 0) ? s : 0.f; }
        }
    }
    grid.sync();
    const XcdBarrier xbar = xcd_barrier_post((unsigned*)ws, (volatile LAS unsigned*)(lds + LDS_MISC));

    for (int layer = 0; layer < 4; ++layer) {
        const int e = layer >> 1; const bool even = (layer & 1) == 0;
        const float* xold = (layer == 0) ? a.x : a.out;
        {
            const int N = even ? EVEN_IN : ODD_IN;
            const bf16* wt = even ? (const bf16*)(ws + WS_WINE) + (size_t)e * EVEN_IN * DM : (const bf16*)(ws + WS_WINO) + (size_t)e * ODD_IN * DM;
            pg8::Gemm g{xb, wt, MTOK, N, DM}; pg8::StaticOrder S; S.init(MTOK, N, G, bx);
            pg8::EpiScaleBf16 E{proj, N, ssq};
            for (int rep_ = 0; rep_ < REP_INPROJ; ++rep_)
            pg8::gemm_phase<pg8::EpiScaleBf16, pg8::StaticOrder, true, true>(lds, g, S, E);
        }
        xcd_barrier(xbar);
        if (even) {
            int tq = threadIdx.x; asm volatile("" : "+v"(tq)); const int tid = tq, lane = tq & 63, l32 = lane & 31, hi = lane >> 5;
            float lam, one_m_li;
            { const float li = (layer == 0) ? 0.2f : 0.47071301839f;
              const float s1 = wave_sum(a.lam_q1[e * 64 + lane] * a.lam_k1[e * 64 + lane]), s2 = wave_sum(a.lam_q2[e * 64 + lane] * a.lam_k2[e * 64 + lane]);
              lam = __expf(s1) - __expf(s2) + li; lam = __builtin_bit_cast(float, __builtin_amdgcn_readfirstlane(__builtin_bit_cast(int, lam))); one_m_li = __builtin_bit_cast(float, __builtin_amdgcn_readfirstlane(__builtin_bit_cast(int, 1.0f - li))); }
            LAS float* btab = (LAS float*)(lds + att::L_BT);

#if PH_DIFF
            for (int rep_ = 0; rep_ < REP_DIFF; ++rep_)
            for (int uidx = bx; uidx < 1024; uidx += G) {
                const int j = uidx >> 8, c = uidx & 255, bh = c >> 2, s = c & 3, b = bh >> 2, h = bh & 3;
                const int qb = (j == 0) ? s : (j == 1) ? 7 - s : (j == 2) ? 8 + s : 15 - s;
                { int tb = threadIdx.x; asm volatile("" : "+v"(tb)); if (tb < 128) btab[tb] = a.rel_bias[T5B[tb] * 12 + 8 + h] * att::LOG2E; }
                const bf16* base = proj + (size_t)b * SEQ * EVEN_IN;
                const int q0 = qb * 256, nt = 4 * qb + 4, t = q0 + 32 * wave + l32;
                att::f32x16 o2[4]; float m2, l2; LAS unsigned* o1s = (LAS unsigned*)(lds + att::L_O1 + wave * 8192) + lane;
                { float m1, l1;
                  att::attn_core_pp<1, 128>(base + 768 + h * 128, base + 1280 + h * 128, base + 1792 + h * 128, EVEN_IN, q0, 0, nt, lds, o2, m1, l1);
                  const float inv = __builtin_amdgcn_rcpf(l1 + __shfl_xor(l1, 32));
#pragma unroll
                  for (int db = 0; db < 4; ++db)
#pragma unroll
                      for (int k = 0; k < 8; ++k) o1s[(db * 8 + k) * 64] = att::cvtpk(o2[db][2 * k] * inv, o2[db][2 * k + 1] * inv); }
                att::attn_core_pp<1, 128>(base + 768 + h * 128 + 64, base + 1280 + h * 128 + 64, base + 1792 + h * 128, EVEN_IN, q0, 0, nt, lds, o2, m2, l2);
                { const float inv = lam * __builtin_amdgcn_rcpf(l2 + __shfl_xor(l2, 32)); float ss = 0.f;
#pragma unroll
                  for (int db = 0; db < 4; ++db)
#pragma unroll
                      for (int r = 0; r < 16; ++r) { const unsigned w = o1s[(db * 8 + (r >> 1)) * 64]; const float a1 = __uint_as_float((r & 1) ? (w & 0xffff0000u) : (w << 16));
                          const float v = a1 - inv * o2[db][r]; o2[db][r] = v; ss += v * v; }
                  ss += __shfl_xor(ss, 32);
                  const float rs = __builtin_amdgcn_rsqf(ss * (1.0f / 128.0f) + 1e-6f) * one_m_li;
                  const float* gn = a.diff_norm + e * 128;
#pragma unroll
                  for (int db = 0; db < 4; ++db)
#pragma unroll
                      for (int rg = 0; rg < 4; ++rg) { const f32x4 gv = *(const f32x4*)(gn + 32 * db + 8 * rg + 4 * hi);
#pragma unroll
                          for (int k = 0; k < 4; ++k) o2[db][4 * rg + k] *= rs * gv[k]; } }
                { int tb = threadIdx.x; asm volatile("" : "+v"(tb)); const int t2 = q0 + 32 * (tb >> 6) + (tb & 31);
                  att::store_ot<128>(o2, ao + ((size_t)b * SEQ + t2) * DM + 512 + h * 128, (tb >> 5) & 1); }
            }
#endif
#if PH_SWA
            for (int rep_ = 0; rep_ < REP_SWA; ++rep_)
            for (int uidx = bx; uidx < 2048; uidx += G) {
                const int qb = uidx & 15, qh = (uidx >> 4) & 7, b = uidx >> 7, kvh = qh >> 2;
                { int tb = threadIdx.x; asm volatile("" : "+v"(tb)); if (tb < 128) btab[tb] = a.rel_bias[T5B[tb] * 12 + qh] * att::LOG2E; }
                const bf16* base = proj + (size_t)b * SEQ * EVEN_IN;
                const int q0 = qb * 256, t = q0 + 32 * wave + l32;
                const int kt0 = (qb * 4 - 2 > 0) ? qb * 4 - 2 : 0, nt = qb * 4 + 4 - kt0;
                att::f32x16 o[2]; float m, l;
                att::attn_core_pp<2, 64>(base + qh * 64, base + 512 + kvh * 64, base + 640 + kvh * 64, EVEN_IN, q0, kt0, nt, lds, o, m, l);
                const float sk = a.sinks[e * 8 + qh] * att::LOG2E;
                const float inv = __builtin_amdgcn_rcpf(l + __shfl_xor(l, 32) + __builtin_amdgcn_exp2f(sk - m));
#pragma unroll
                for (int db = 0; db < 2; ++db)
#pragma unroll
                    for (int r = 0; r < 16; ++r) o[db][r] *= inv;
                att::store_ot<64>(o, ao + ((size_t)b * SEQ + t) * DM + qh * 64, hi);
            }
#endif
        } else {
#if PH_SB
            int tq = threadIdx.x; asm volatile("" : "+v"(tq)); const int lane = tq & 63, l32 = lane & 31, hi = lane >> 5;
            for (int rep_ = 0; rep_ < REP_SB; ++rep_)
            for (int uidx = bx; uidx < 4096; uidx += G) {
                const int bh = uidx & 255, qb = 15 - (uidx >> 8), b = bh >> 4, h = bh & 15;
                const bf16* base = proj + (size_t)b * SEQ * ODD_IN;
                const int q0 = qb * 256, nt = 4 * qb + 4, t = q0 + 32 * wave + l32;
                att::f32x16 o[2]; float P, dummy;
                att::attn_core<0, 64>(base + h * 64, base + 1024 + h * 64, base + 2048 + h * 64, ODD_IN, q0, nt - 1, nt, -1, lds, o, P, dummy);
                att::store_ot<64>(o, ao + ((size_t)b * SEQ + t) * DM + h * 64, hi);
            }
#endif
        }
        xcd_barrier(xbar);
        {
            const bf16* wt = even ? (const bf16*)(ws + WS_WOUTE) + (size_t)e * DM * DM : (const bf16*)(ws + WS_WOUTO) + (size_t)e * DM * DM;
            pg8::Gemm g{ao, wt, MTOK, DM, DM}; pg8::StaticOrder S; S.init(MTOK, DM, G, bx);
#if OUT_STAGGER_TICKS > 0
            { const unsigned long long t0 = __builtin_amdgcn_s_memrealtime(); const unsigned long long dly = (unsigned long long)(((bx >> 3) & (OUT_STAGGER_GROUPS - 1)) * OUT_STAGGER_TICKS);
              while (__builtin_amdgcn_s_memrealtime() - t0 < dly) __builtin_amdgcn_s_sleep(8); }
#endif
#if REP_OUT == 2
            { pg8::EpiResid Ed{xold, (float*)(ws + WS_PROJ), (bf16*)(ws + WS_PROJ + 256 * MiB), (float*)(ws + 800 * MiB)};
              pg8::gemm_phase<pg8::EpiResid, pg8::StaticOrder, true, true>(lds, g, S, Ed); }
#elif REP_OUT == 3
            { pg8::EpiScaleBf16 Ed{(bf16*)(ws + WS_PROJ), DM, ssq};
              pg8::gemm_phase<pg8::EpiScaleBf16, pg8::StaticOrder, true, true>(lds, g, S, Ed); }
#endif
#if RESID_BF16
            pg8::EpiResidB E{xb, xb, ssq};
            pg8::gemm_phase<pg8::EpiResidB, pg8::StaticOrder, true, true>(lds, g, S, E);
#else
            pg8::EpiResid E{xold, a.out, xb, ssq};
            pg8::gemm_phase<pg8::EpiResid, pg8::StaticOrder, true, true>(lds, g, S, E);
#endif
        }
        xcd_barrier(xbar);
        const bf16* wup = (const bf16*)(ws + WS_WUP) + (size_t)layer * DUP * DM;
        const bf16* wdn = (const bf16*)(ws + WS_WDN) + (size_t)layer * DM * DFF;
        for (int half = 0; half < 2; ++half) {
            const size_t r0 = (size_t)half * HALF_ROWS;
            {
                pg8::Gemm g{xb + r0 * DM, wup, HALF_ROWS, DUP, DM}; pg8::StaticOrder S; S.init(HALF_ROWS, DUP, G, bx);
                pg8::EpiScaleBf16 E{ubuf, DUP, ssq + r0 * 16};
                for (int rep_ = 0; rep_ < REP_UP; ++rep_)
                pg8::gemm_phase<pg8::EpiScaleBf16, pg8::StaticOrder, true, true>(lds, g, S, E);
            }
            xcd_barrier(xbar);
#if PH_CONV
            {
                const float* cw = a.ffn_conv + (size_t)layer * 3 * DUP; const float* cb = a.ffn_conv_b + (size_t)layer * DUP;
                constexpr int NCC = 6, NRC = HALF_ROWS / 32;
                int tq = threadIdx.x; asm volatile("" : "+v"(tq)); const int lane = tq & 63;
                for (int rep_ = 0; rep_ < REP_CONV; ++rep_)
                for (int it = gw; it < NCC * NRC; it += NGW) {
                    const int cc = it % NCC, rc = it / NCC, cgp = cc * 64 + lane;
                    if (cgp < DFF / 8) {
                        const int col = cgp * 8, row0 = rc * 32;
                        float wg[3][8], wv[3][8], bg[8], bv[8];
#pragma unroll
                        for (int tp = 0; tp < 3; ++tp)
#pragma unroll
                            for (int k = 0; k < 8; k += 4) { const f32x4 t1 = *(const f32x4*)(cw + tp * DUP + col + k), t2 = *(const f32x4*)(cw + tp * DUP + DFF + col + k);
#pragma unroll
                                for (int q = 0; q < 4; ++q) { wg[tp][k + q] = t1[q]; wv[tp][k + q] = t2[q]; } }
#pragma unroll
                        for (int k = 0; k < 8; k += 4) { const f32x4 t1 = *(const f32x4*)(cb + col + k), t2 = *(const f32x4*)(cb + DFF + col + k);
#pragma unroll
                            for (int q = 0; q < 4; ++q) { bg[k + q] = t1[q]; bv[k + q] = t2[q]; } }
                        float g2[8], g1[8], v2[8], v1[8];
                        const bool head = (row0 % SEQ) == 0;
                        {
                            v4u a2 = {0, 0, 0, 0}, a1 = {0, 0, 0, 0}, c2 = {0, 0, 0, 0}, c1 = {0, 0, 0, 0};
                            if (!head) { const bf16* up = ubuf + (size_t)(row0 - 2) * DUP + col; a2 = *(const v4u*)up; c2 = *(const v4u*)(up + DFF); a1 = *(const v4u*)(up + DUP); c1 = *(const v4u*)(up + DUP + DFF); }
#pragma unroll
                            for (int k = 0; k < 8; ++k) { const int sh = (k & 1) * 16;
                                g2[k] = __uint_as_float(((a2[k >> 1] >> sh) & 0xffffu) << 16); g1[k] = __uint_as_float(((a1[k >> 1] >> sh) & 0xffffu) << 16);
                                v2[k] = __uint_as_float(((c2[k >> 1] >> sh) & 0xffffu) << 16); v1[k] = __uint_as_float(((c1[k >> 1] >> sh) & 0xffffu) << 16); }
                        }
                        for (int r4 = 0; r4 < 32; r4 += 8) {
                            v4u av[8], cv[8];
#pragma unroll
                            for (int rr = 0; rr < 8; ++rr) { const bf16* up = ubuf + (size_t)(row0 + r4 + rr) * DUP + col;
                                av[rr] = __builtin_nontemporal_load((const v4u*)up); cv[rr] = __builtin_nontemporal_load((const v4u*)(up + DFF)); }
#pragma unroll
                            for (int rr = 0; rr < 8; ++rr) {
                                const v4u a0 = av[rr], c0 = cv[rr];
                                float res[8];
#pragma unroll
                                for (int k = 0; k < 8; ++k) { const int sh = (k & 1) * 16;
                                    const float g0 = __uint_as_float(((a0[k >> 1] >> sh) & 0xffffu) << 16), v0 = __uint_as_float(((c0[k >> 1] >> sh) & 0xffffu) << 16);
                                    const float gg = bg[k] + wg[0][k] * g2[k] + wg[1][k] * g1[k] + wg[2][k] * g0;
                                    const float vv = bv[k] + wv[0][k] * v2[k] + wv[1][k] * v1[k] + wv[2][k] * v0;
                                    const float sg = gg * __builtin_amdgcn_rcpf(1.0f + __builtin_amdgcn_exp2f(-gg * att::LOG2E));
                                    res[k] = sg * vv; g2[k] = g1[k]; g1[k] = g0; v2[k] = v1[k]; v1[k] = v0; }
                                v4u w; w.x = pk2(res[0], res[1]); w.y = pk2(res[2], res[3]); w.z = pk2(res[4], res[5]); w.w = pk2(res[6], res[7]);
                                *(v4u*)(gbuf + (size_t)(row0 + r4 + rr) * DFF + col) = w;
                            }
                        }
                    }
                }
            }
#endif
            xcd_barrier(xbar);
            {
                pg8::Gemm g{gbuf, wdn, HALF_ROWS, DM, DFF}; pg8::StaticOrder S; S.init(HALF_ROWS, DM, G, bx);
#if REP_DOWN > 1
                { pg8::EpiResid Ed{a.out + r0 * DM, (float*)(ws + 760 * MiB), (bf16*)(ws + 888 * MiB), (float*)(ws + 960 * MiB)};
                  pg8::gemm_phase<pg8::EpiResid, pg8::StaticOrder, true, true>(lds, g, S, Ed); }
#endif
#if RESID_BF16
                pg8::EpiResidB E{xb + r0 * DM, xb + r0 * DM, ssq + r0 * 16};
                pg8::gemm_phase<pg8::EpiResidB, pg8::StaticOrder, true, true>(lds, g, S, E);
#else
                pg8::EpiResid E{a.out + r0 * DM, a.out + r0 * DM, xb + r0 * DM, ssq + r0 * 16};
                pg8::gemm_phase<pg8::EpiResid, pg8::StaticOrder, true, true>(lds, g, S, E);
#endif
            }
            if (half == 1) xcd_barrier(xbar);
        }
    }
    { int tq = threadIdx.x; asm volatile("" : "+v"(tq)); const int lane = tq & 63;
    for (int m = gw; m < MTOK; m += NGW) {
        f32x4* xr = (f32x4*)(a.out + (size_t)m * DM) + lane; f32x4 v[4]; float s = 0.f;
#if RESID_BF16
        const v2u* xin = (const v2u*)(xb + (size_t)m * DM) + lane;
#pragma unroll
        for (int j = 0; j < 4; ++j) { const v2u w = xin[64 * j]; v[j][0] = __uint_as_float(w.x << 16); v[j][1] = __uint_as_float(w.x & 0xffff0000u); v[j][2] = __uint_as_float(w.y << 16); v[j][3] = __uint_as_float(w.y & 0xffff0000u);
            s += (v[j][0] * v[j][0] + v[j][1] * v[j][1]) + (v[j][2] * v[j][2] + v[j][3] * v[j][3]); }
#else
#pragma unroll
        for (int j = 0; j < 4; ++j) { v[j] = xr[64 * j]; s += (v[j][0] * v[j][0] + v[j][1] * v[j][1]) + (v[j][2] * v[j][2] + v[j][3] * v[j][3]); }
#endif
        s = wave_sum(s);
        const float rs = __builtin_amdgcn_rsqf(s * (1.0f / DM) + 1e-6f);
#pragma unroll
        for (int j = 0; j < 4; ++j) { const f32x4 gv = *((const f32x4*)a.norm_final + lane + 64 * j); xr[64 * j] = v[j] * rs * gv; }
    } }
}

extern "C" void kernel_launch(void* const* d_in, const int* in_sizes, int n_in, void* d_out, int out_size, void* d_ws, size_t ws_size, hipStream_t stream) {
    static int grid = 0;
    if (grid == 0) {
        int dev = 0, cus = 0, per_cu = 0;
        (void)hipGetDevice(&dev);
        (void)hipDeviceGetAttribute(&cus, hipDeviceAttributeMultiprocessorCount, dev);
        (void)hipFuncSetAttribute((const void*)mega_fwd, hipFuncAttributeMaxDynamicSharedMemorySize, LDS_BYTES);
        (void)hipOccupancyMaxActiveBlocksPerMultiprocessor(&per_cu, (const void*)mega_fwd, NWAVES * 64, LDS_BYTES);
        if (per_cu < 1) per_cu = 1;
        grid = cus * per_cu;
        if (n_in != 19 || ws_size < 1024 * MiB) fprintf(stderr, "kernel_launch: unexpected n_in %d / ws %zu\n", n_in, ws_size);
    }
    Args a{};
    a.x = (const float*)d_in[0]; a.rel_bias = (const float*)d_in[1]; a.norm_mix = (const float*)d_in[2]; a.norm_ffn = (const float*)d_in[3]; a.norm_final = (const float*)d_in[4];
    a.w_in_even = (const float*)d_in[5]; a.w_out_even = (const float*)d_in[6]; a.sinks = (const float*)d_in[7]; a.lam_q1 = (const float*)d_in[8]; a.lam_k1 = (const float*)d_in[9];
    a.lam_q2 = (const float*)d_in[10]; a.lam_k2 = (const float*)d_in[11]; a.diff_norm = (const float*)d_in[12]; a.w_in_odd = (const float*)d_in[13]; a.w_out_odd = (const float*)d_in[14];
    a.ffn_up = (const float*)d_in[15]; a.ffn_conv = (const float*)d_in[16]; a.ffn_conv_b = (const float*)d_in[17]; a.ffn_down = (const float*)d_in[18];
    a.out = (float*)d_out; a.ws = (unsigned char*)d_ws;
    void* args[] = {&a};
    hipError_t err = hipLaunchCooperativeKernel((const void*)mega_fwd, dim3(grid), dim3(NWAVES * 64), args, LDS_BYTES, stream);
    if (err != hipSuccess) fprintf(stderr, "kernel_launch: cooperative launch failed: %s (grid %d)\n", hipGetErrorString(err), grid);
}
```

```cpp
#include <hip/hip_runtime.h>
#include <hip/hip_cooperative_groups.h>
#include <cstdio>
#include <cstdint>
namespace cg = cooperative_groups;
namespace pg8 {
#define PG8_LAS __attribute__((address_space(3)))
typedef unsigned short bf16_t;
typedef short bf16x8 __attribute__((ext_vector_type(8)));
typedef float f32x4 __attribute__((ext_vector_type(4)));
typedef unsigned u32x4 __attribute__((ext_vector_type(4)));
constexpr int BM = 256, BK = 64, HALF = 128, HTB = HALF * BK * 2  , STAGE_BYTES = 8 * HTB, NXCD = 8, WGM = 8;

__host__ __device__ __forceinline__ int lds_byte(int r, int c) { const int st = (r >> 4) * 2 + (c >> 5), rr = r & 15, cc = c & 31, ob = rr * 64 + cc * 2; return st * 1024 + (ob ^ (((ob >> 9) & 1) << 5)); }
__host__ __device__ __forceinline__ void stage_rc(int b, int& R, int& C) { const int st = b / 1024, sb = b % 1024, swz = sb ^ (((sb >> 9) & 1) << 5); R = (st >> 1) * 16 + swz / 64; C = (st & 1) * 32 + (swz % 64) / 2; }
__host__ __device__ __forceinline__ int perm32(int rho) { const int n = rho >> 4, i = rho & 15; return 8 * (i >> 2) + 4 * n + (i & 3); }

struct Unit { int pm, pn; };
struct Gemm { const bf16_t* A; const bf16_t* Bt; int M, N, K; };

struct StaticOrder {
    int nM, nN, nwg, G, c;
    __host__ __device__ void init(int M, int N, int G_, int c_) { nM = M / BM; nN = N / BM; nwg = nM * nN; G = G_; c = c_; }
    __host__ __device__ bool next(int i, Unit& u) const {
        const long L = (long)i * G + c; if (L >= nwg) return false;
        int wgid = (int)L; { const int q = nwg / NXCD, r = nwg % NXCD, xcd = wgid % NXCD, off = wgid / NXCD; wgid = (xcd < r ? xcd * (q + 1) : r * (q + 1) + (xcd - r) * q) + off; }
        const int nig = WGM * nN, gid = wgid / nig, fm = gid * WGM, gsz = (nM - fm) < WGM ? (nM - fm) : WGM;
        u.pm = fm + ((wgid % nig) % gsz); u.pn = (wgid % nig) / gsz; return true;
    }
    __device__ __forceinline__ void a_ready(const Unit&) const {}
    __device__ __forceinline__ void done(const Unit&) const {}
};

__device__ __forceinline__ unsigned cvt_pk_bf16(float lo, float hi) { unsigned r; asm volatile("v_cvt_pk_bf16_f32 %0, %1, %2" : "=v"(r) : "v"(lo), "v"(hi)); return r; }
typedef float f32x2 __attribute__((ext_vector_type(2)));
typedef unsigned u32x2 __attribute__((ext_vector_type(2)));
constexpr float RMS_EPS = 1e-6f;
struct EpiScaleBf16 {
    static constexpr bool PERM = true, AFTER_DRAIN = false;
    bf16_t* O; int ldc; const float* ssq;
    __device__ __forceinline__ void operator()(const f32x4 (&acc)[2][2][4][2], const Unit& u, int wr, int wc, int fr, int fq) const {
        const int row0 = u.pm * BM + wr * 64 + fr, col0 = u.pn * BM + wc * 32 + 8 * fq;
        f32x4 part[2][4];
#pragma unroll
        for (int ai = 0; ai < 2; ++ai)
#pragma unroll
            for (int m = 0; m < 4; ++m) part[ai][m] = *(const f32x4*)(ssq + (size_t)(row0 + ai * HALF + m * 16) * 16 + fq * 4);
#pragma unroll
        for (int ai = 0; ai < 2; ++ai)
#pragma unroll
            for (int m = 0; m < 4; ++m) { const int row = row0 + ai * HALF + m * 16; bf16_t* rowp = O + (size_t)row * ldc + col0;
                float t = (part[ai][m][0] + part[ai][m][1]) + (part[ai][m][2] + part[ai][m][3]);
                t += __shfl_xor(t, 16); t += __shfl_xor(t, 32);
                const float rs = __builtin_amdgcn_rsqf(t * (1.0f / 1024.0f) + RMS_EPS);
#pragma unroll
                for (int bj = 0; bj < 2; ++bj) { const f32x4 v0 = acc[ai][bj][m][0] * rs, v1 = acc[ai][bj][m][1] * rs;
                    u32x4 w; w.x = cvt_pk_bf16(v0[0], v0[1]); w.y = cvt_pk_bf16(v0[2], v0[3]); w.z = cvt_pk_bf16(v1[0], v1[1]); w.w = cvt_pk_bf16(v1[2], v1[3]);
                    *(u32x4*)(rowp + bj * HALF) = w; } }
    }
};
struct EpiResid {
    static constexpr bool PERM = true, AFTER_DRAIN = false;
    const float* base; float* out; bf16_t* xb; float* ssq;
    __device__ __forceinline__ void operator()(const f32x4 (&acc)[2][2][4][2], const Unit& u, int wr, int wc, int fr, int fq) const {
        const int col0 = u.pn * BM + wc * 32 + 8 * fq;
        const size_t off0 = (size_t)(u.pm * BM + wr * 64 + fr) * 1024 + col0;
        f32x4 nx[2][2][2];
#pragma unroll
        for (int g = 0; g < 2; ++g) { const size_t offn = off0 + (size_t)(g * 16) * 1024;
#pragma unroll
            for (int bj = 0; bj < 2; ++bj)
#pragma unroll
                for (int n = 0; n < 2; ++n) nx[g][bj][n] = *(const f32x4*)(base + offn + bj * HALF + n * 4); }
        asm volatile("" ::: "memory");
#pragma unroll
        for (int g = 0; g < 8; ++g) { const int ai = g >> 2, m = g & 3; const int row = u.pm * BM + ai * HALF + wr * 64 + m * 16 + fr; const size_t off = (size_t)row * 1024 + col0; float q = 0.f;
            f32x4 cu[2][2];
#pragma unroll
            for (int bj = 0; bj < 2; ++bj)
#pragma unroll
                for (int n = 0; n < 2; ++n) cu[bj][n] = nx[g & 1][bj][n];
            if (g < 6) { const size_t offn = off0 + (size_t)(((g + 2) >> 2) * HALF + ((g + 2) & 3) * 16) * 1024;
#pragma unroll
                for (int bj = 0; bj < 2; ++bj)
#pragma unroll
                    for (int n = 0; n < 2; ++n) nx[g & 1][bj][n] = *(const f32x4*)(base + offn + bj * HALF + n * 4); }
#pragma unroll
            for (int bj = 0; bj < 2; ++bj) { const f32x4 o0 = cu[bj][0] + acc[ai][bj][m][0], o1 = cu[bj][1] + acc[ai][bj][m][1];
                *(f32x4*)(out + off + bj * HALF) = o0; *(f32x4*)(out + off + bj * HALF + 4) = o1;
                q += ((o0[0] * o0[0] + o0[1] * o0[1]) + (o0[2] * o0[2] + o0[3] * o0[3])) + ((o1[0] * o1[0] + o1[1] * o1[1]) + (o1[2] * o1[2] + o1[3] * o1[3]));
                u32x4 w; w.x = cvt_pk_bf16(o0[0], o0[1]); w.y = cvt_pk_bf16(o0[2], o0[3]); w.z = cvt_pk_bf16(o1[0], o1[1]); w.w = cvt_pk_bf16(o1[2], o1[3]);
                *(u32x4*)(xb + off + bj * HALF) = w; }
            q += __shfl_xor(q, 16); q += __shfl_xor(q, 32);
            if (fq == 0) ssq[(size_t)row * 16 + u.pn * 4 + wc] = q;
            asm volatile("" ::: "memory"); }
    }
};

struct EpiResidB {
    static constexpr bool PERM = true, AFTER_DRAIN = false;
    const bf16_t* base; bf16_t* xb; float* ssq;
    __device__ __forceinline__ void operator()(const f32x4 (&acc)[2][2][4][2], const Unit& u, int wr, int wc, int fr, int fq) const {
        const int col0 = u.pn * BM + wc * 32 + 8 * fq;
        const size_t off0 = (size_t)(u.pm * BM + wr * 64 + fr) * 1024 + col0;
        u32x4 nx[2][2];
#pragma unroll
        for (int g = 0; g < 2; ++g)
#pragma unroll
            for (int bj = 0; bj < 2; ++bj) nx[g][bj] = *(const u32x4*)(base + off0 + (size_t)(g * 16) * 1024 + bj * HALF);
        asm volatile("" ::: "memory");
#pragma unroll
        for (int g = 0; g < 8; ++g) { const int ai = g >> 2, m = g & 3; const int row = u.pm * BM + ai * HALF + wr * 64 + m * 16 + fr; const size_t off = (size_t)row * 1024 + col0; float q = 0.f;
            u32x4 cu[2];
#pragma unroll
            for (int bj = 0; bj < 2; ++bj) cu[bj] = nx[g & 1][bj];
            if (g < 6) { const size_t offn = off0 + (size_t)(((g + 2) >> 2) * HALF + ((g + 2) & 3) * 16) * 1024;
#pragma unroll
                for (int bj = 0; bj < 2; ++bj) nx[g & 1][bj] = *(const u32x4*)(base + offn + bj * HALF); }
#pragma unroll
            for (int bj = 0; bj < 2; ++bj) {
                f32x4 o0, o1;
                o0[0] = __uint_as_float(cu[bj].x << 16) + acc[ai][bj][m][0][0]; o0[1] = __uint_as_float(cu[bj].x & 0xffff0000u) + acc[ai][bj][m][0][1];
                o0[2] = __uint_as_float(cu[bj].y << 16) + acc[ai][bj][m][0][2]; o0[3] = __uint_as_float(cu[bj].y & 0xffff0000u) + acc[ai][bj][m][0][3];
                o1[0] = __uint_as_float(cu[bj].z << 16) + acc[ai][bj][m][1][0]; o1[1] = __uint_as_float(cu[bj].z & 0xffff0000u) + acc[ai][bj][m][1][1];
                o1[2] = __uint_as_float(cu[bj].w << 16) + acc[ai][bj][m][1][2]; o1[3] = __uint_as_float(cu[bj].w & 0xffff0000u) + acc[ai][bj][m][1][3];
                q += ((o0[0] * o0[0] + o0[1] * o0[1]) + (o0[2] * o0[2] + o0[3] * o0[3])) + ((o1[0] * o1[0] + o1[1] * o1[1]) + (o1[2] * o1[2] + o1[3] * o1[3]));
                u32x4 w; w.x = cvt_pk_bf16(o0[0], o0[1]); w.y = cvt_pk_bf16(o0[2], o0[3]); w.z = cvt_pk_bf16(o1[0], o1[1]); w.w = cvt_pk_bf16(o1[2], o1[3]);
                *(u32x4*)(xb + off + bj * HALF) = w; }
            q += __shfl_xor(q, 16); q += __shfl_xor(q, 32);
            if (fq == 0) ssq[(size_t)row * 16 + u.pn * 4 + wc] = q;
            asm volatile("" ::: "memory"); }
    }
};
template <class Epi, class Sched, bool ALIGN_EPI = false, bool SP2 = false>
__device__ __forceinline__ void gemm_phase(PG8_LAS unsigned char* lds, const Gemm g, const Sched& S, const Epi& E) {
    int tid_ = threadIdx.x; asm volatile("" : "+v"(tid_));
    const int tid = tid_, wid = __builtin_amdgcn_readfirstlane(tid >> 6), lane = tid & 63, wr = wid >> 2, wc = wid & 3, fr = lane & 15, fq = lane >> 4;
    const int K = g.K, nt = K / BK;
    unsigned voffA[2], voffB[2];
#pragma unroll
    for (int i = 0; i < 2; ++i) { int R, C; stage_rc(tid * 16 + i * 8192, R, C); const int Rb = Epi::PERM ? ((R & ~31) + perm32(R & 31)) : R;
        voffA[i] = (unsigned)(R * K + C) * 2u; voffB[i] = (unsigned)(Rb * K + C) * 2u; }
    const size_t kstep = (size_t)(BK * 2);
    const size_t hstep = (size_t)HALF * K * 2;
    const size_t tstep = 2 * hstep;
    const unsigned ldsw = (unsigned)wid * 1024u;
    const int aoff = lds_byte(wr * 64 + fr, fq * 8), boff = lds_byte(wc * 32 + fr, fq * 8);
#define PG8_SA(b, h) (((b) * 2 + (h)) * HTB)
#define PG8_SB(b, h) ((4 + (b) * 2 + (h)) * HTB)
#define PG8_STAGE(bufoff, gbase, voff) do { _Pragma("unroll") for (int _i = 0; _i < 2; ++_i) \
        __builtin_amdgcn_global_load_lds((const unsigned*)((const char*)(gbase) + (voff)[_i]), (PG8_LAS unsigned*)(lds + (bufoff) + ldsw + _i * 8192), 16, 0, 0); } while (0)
#define PG8_LDA(dst, b, h) do { _Pragma("unroll") for (int m = 0; m < 4; ++m) _Pragma("unroll") for (int k = 0; k < 2; ++k) dst[m][k] = *(const PG8_LAS bf16x8*)(lds + PG8_SA(b, h) + aoff + m * 2048 + k * 1024); } while (0)
#define PG8_LDB(dst, b, h) do { _Pragma("unroll") for (int n = 0; n < 2; ++n) _Pragma("unroll") for (int k = 0; k < 2; ++k) dst[n][k] = *(const PG8_LAS bf16x8*)(lds + PG8_SB(b, h) + boff + n * 2048 + k * 1024); } while (0)
#define PG8_MMA(ai, bj, At, Bt) do { __builtin_amdgcn_s_setprio(1); _Pragma("unroll") for (int m = 0; m < 4; ++m) _Pragma("unroll") for (int n = 0; n < 2; ++n) _Pragma("unroll") for (int k = 0; k < 2; ++k) \
        acc[ai][bj][m][n] = __builtin_amdgcn_mfma_f32_16x16x32_bf16(Bt[n][k], At[m][k], acc[ai][bj][m][n], 0, 0, 0); __builtin_amdgcn_s_setprio(0); } while (0)
#define PG8_WAIT_V(n) asm volatile("s_waitcnt vmcnt(" #n ")" ::: "memory")
#define PG8_WAIT_L(n) asm volatile("s_waitcnt lgkmcnt(" #n ")" ::: "memory")
#define PG8_BAR __builtin_amdgcn_s_barrier()
#define PG8_SCHED __builtin_amdgcn_sched_barrier(0)
    Unit cur, nxt; int ui = 0;
    if (!S.next(0, cur)) return;
    f32x4 acc[2][2][4][2];
#pragma unroll
    for (int a = 0; a < 2; ++a)
#pragma unroll
        for (int b = 0; b < 2; ++b)
#pragma unroll
            for (int m = 0; m < 4; ++m)
#pragma unroll
                for (int n = 0; n < 2; ++n) acc[a][b][m][n] = (f32x4){0.f, 0.f, 0.f, 0.f};
    bf16x8 At[4][2], B0[2][2], B1[2][2];
    const char* cA = (const char*)g.A + (size_t)cur.pm * tstep; const char* cB = (const char*)g.Bt + (size_t)cur.pn * tstep;
    S.a_ready(cur);
    if constexpr (SP2) {
        PG8_STAGE(PG8_SB(0, 0), cB, voffB); PG8_STAGE(PG8_SB(0, 1), cB + hstep, voffB); PG8_STAGE(PG8_SA(0, 0), cA, voffA); PG8_STAGE(PG8_SA(0, 1), cA + hstep, voffA);
        if (wr == 1) PG8_BAR;
        PG8_WAIT_V(2); PG8_BAR;
        PG8_STAGE(PG8_SB(1, 0), cB + kstep, voffB); PG8_STAGE(PG8_SA(1, 0), cA + kstep, voffA); PG8_STAGE(PG8_SB(1, 1), cB + hstep + kstep, voffB);
        PG8_WAIT_V(6); PG8_BAR;
    } else {
        PG8_STAGE(PG8_SB(0, 0), cB, voffB); PG8_STAGE(PG8_SA(0, 0), cA, voffA); PG8_STAGE(PG8_SB(0, 1), cB + hstep, voffB); PG8_STAGE(PG8_SA(0, 1), cA + hstep, voffA);
        if (wr == 1) PG8_BAR;
        PG8_WAIT_V(4); PG8_BAR;
        PG8_STAGE(PG8_SB(1, 0), cB + kstep, voffB); PG8_STAGE(PG8_SA(1, 0), cA + kstep, voffA); PG8_STAGE(PG8_SB(1, 1), cB + hstep + kstep, voffB);
        PG8_WAIT_V(6); PG8_BAR;
    }
    for (;;) {
        const bool has_next = S.next(ui + 1, nxt);
        const char* nA = has_next ? (const char*)g.A + (size_t)nxt.pm * tstep : cA; const char* nB = has_next ? (const char*)g.Bt + (size_t)nxt.pn * tstep : cB;
        for (int t = 0; t < nt; t += 2) {
            const bool last = (t == nt - 2);
            const char* a1 = cA + (size_t)(t + 1) * kstep;
            const char* a2 = last ? nA : cA + (size_t)(t + 2) * kstep; const char* b2 = last ? nB : cB + (size_t)(t + 2) * kstep;
            const char* a3 = a2 + kstep; const char* b3 = b2 + kstep;
            if (last && has_next) S.a_ready(nxt);
            if constexpr (SP2) {
            PG8_LDB(B0, 0, 0); PG8_LDB(B1, 0, 1); PG8_SCHED; PG8_LDA(At, 0, 0); PG8_STAGE(PG8_SA(1, 1), a1 + hstep, voffA);
            PG8_WAIT_V(8); PG8_WAIT_L(0); PG8_BAR; PG8_MMA(0, 0, At, B0); PG8_MMA(0, 1, At, B1); PG8_BAR; PG8_SCHED;
            PG8_LDA(At, 0, 1); PG8_STAGE(PG8_SB(0, 0), b2, voffB); PG8_STAGE(PG8_SB(0, 1), b2 + hstep, voffB); PG8_STAGE(PG8_SA(0, 0), a2, voffA);
            PG8_WAIT_V(8); PG8_WAIT_L(0); PG8_BAR; PG8_MMA(1, 0, At, B0); PG8_MMA(1, 1, At, B1); PG8_BAR; PG8_SCHED;
            PG8_LDB(B0, 1, 0); PG8_LDB(B1, 1, 1); PG8_SCHED; PG8_LDA(At, 1, 0); PG8_STAGE(PG8_SA(0, 1), a2 + hstep, voffA);
            PG8_WAIT_V(8); PG8_WAIT_L(0); PG8_BAR; PG8_MMA(0, 0, At, B0); PG8_MMA(0, 1, At, B1); PG8_BAR; PG8_SCHED;
            PG8_LDA(At, 1, 1); PG8_STAGE(PG8_SB(1, 0), b3, voffB); PG8_STAGE(PG8_SB(1, 1), b3 + hstep, voffB); PG8_STAGE(PG8_SA(1, 0), a3, voffA);
            PG8_WAIT_V(8); PG8_WAIT_L(0); PG8_BAR; PG8_MMA(1, 0, At, B0); PG8_MMA(1, 1, At, B1); PG8_BAR; PG8_SCHED;
            } else {
            PG8_LDB(B0, 0, 0); PG8_SCHED; PG8_LDA(At, 0, 0); PG8_STAGE(PG8_SA(1, 1), a1 + hstep, voffA);
            PG8_WAIT_L(8); PG8_BAR; PG8_WAIT_L(0); PG8_MMA(0, 0, At, B0); PG8_BAR; PG8_SCHED;
            PG8_LDB(B1, 0, 1); PG8_STAGE(PG8_SB(0, 0), b2, voffB);
            PG8_BAR; PG8_WAIT_L(0); PG8_MMA(0, 1, At, B1); PG8_BAR;
            PG8_LDA(At, 0, 1); PG8_STAGE(PG8_SA(0, 0), a2, voffA);
            PG8_BAR; PG8_WAIT_L(0); PG8_MMA(1, 0, At, B0); PG8_BAR; PG8_SCHED;
            PG8_STAGE(PG8_SB(0, 1), b2 + hstep, voffB);
            PG8_WAIT_V(6); PG8_BAR; PG8_MMA(1, 1, At, B1); PG8_BAR;
            PG8_LDB(B0, 1, 0); PG8_SCHED; PG8_LDA(At, 1, 0); PG8_STAGE(PG8_SA(0, 1), a2 + hstep, voffA);
            PG8_WAIT_L(8); PG8_BAR; PG8_WAIT_L(0); PG8_MMA(0, 0, At, B0); PG8_BAR; PG8_SCHED;
            PG8_LDB(B1, 1, 1); PG8_STAGE(PG8_SB(1, 0), b3, voffB);
            PG8_BAR; PG8_WAIT_L(0); PG8_MMA(0, 1, At, B1); PG8_BAR;
            PG8_LDA(At, 1, 1); PG8_STAGE(PG8_SA(1, 0), a3, voffA);
            PG8_BAR; PG8_WAIT_L(0); PG8_MMA(1, 0, At, B0); PG8_BAR; PG8_SCHED;
            PG8_STAGE(PG8_SB(1, 1), b3 + hstep, voffB);
            PG8_WAIT_V(6); PG8_BAR; PG8_MMA(1, 1, At, B1); PG8_BAR;
            }
        }
        if constexpr (ALIGN_EPI) { if (wr == 0) PG8_BAR; }
        if constexpr (!Epi::AFTER_DRAIN) { E(acc, cur, wr, wc, fr, fq); S.done(cur); }
        if (!has_next) break;
#pragma unroll
        for (int a = 0; a < 2; ++a)
#pragma unroll
            for (int b = 0; b < 2; ++b)
#pragma unroll
                for (int m = 0; m < 4; ++m)
#pragma unroll
                    for (int n = 0; n < 2; ++n) acc[a][b][m][n] = (f32x4){0.f, 0.f, 0.f, 0.f};
        cur = nxt; cA = nA; cB = nB; ++ui;
        if constexpr (ALIGN_EPI) { if (wr == 1) PG8_BAR; }
    }
    PG8_WAIT_V(0);
    if constexpr (!ALIGN_EPI) { if (wr == 0) PG8_BAR; }
    PG8_BAR;
    if constexpr (Epi::AFTER_DRAIN) { E.fused(acc, cur, wr, wc, fr, fq, lds, wid, lane); S.done(cur); }
#undef PG8_SA
#undef PG8_SB
#undef PG8_STAGE
#undef PG8_LDA
#undef PG8_LDB
#undef PG8_MMA
#undef PG8_WAIT_V
#undef PG8_WAIT_L
#undef PG8_BAR
#undef PG8_SCHED
}
}
namespace att {
#define ALAS __attribute__((address_space(3)))
typedef unsigned short bf16_t;
typedef short bf16x8 __attribute__((ext_vector_type(8)));
typedef float f32x16 __attribute__((ext_vector_type(16)));
typedef float f32x4 __attribute__((ext_vector_type(4)));
typedef unsigned u32x4 __attribute__((ext_vector_type(4)));
typedef unsigned u32x2 __attribute__((ext_vector_type(2)));
constexpr int KROW = 144;
constexpr int KBUF = 64 * KROW;
constexpr int VBUF = 64 * 320;
template <int DV> struct VRow { static constexpr int B = (DV == 128) ? 320 : 192; };
constexpr int L_K = 0, L_V = 2 * KBUF, L_BT = L_V + 2 * VBUF, L_END = L_BT + 2048;
constexpr int L_O1 = L_END;
constexpr int L_QS = L_O1 + 65536;
constexpr float LOG2E = 1.4426950408889634f;
constexpr float QSCALE = 0.125f * 1.4426950408889634f;
#define CR(r) (((r) & 3) + 8 * ((r) >> 2))
typedef float f32x2_t __attribute__((ext_vector_type(2))); typedef __bf16 bf16x2_t __attribute__((ext_vector_type(2)));
__device__ __forceinline__ unsigned cvtpk(float lo, float hi) { f32x2_t v = {lo, hi}; bf16x2_t b = __builtin_convertvector(v, bf16x2_t); return __builtin_bit_cast(unsigned, b); }
__device__ __forceinline__ unsigned cvtpk_a(float lo, float hi) { unsigned r; asm volatile("v_cvt_pk_bf16_f32 %0, %1, %2" : "=v"(r) : "v"(lo), "v"(hi)); return r; }
__device__ __forceinline__ float ex2(float x) { return __builtin_amdgcn_exp2f(x); }
__device__ __forceinline__ float rcpf_(float x) { return __builtin_amdgcn_rcpf(x); }

typedef short v4i16_t __attribute__((ext_vector_type(4)));
__device__ __forceinline__ v4i16_t vtr(const ALAS unsigned char* p) { return __builtin_amdgcn_ds_read_tr16_b64_v4i16((ALAS v4i16_t*)p); }
template <int DV> __device__ __forceinline__ bf16x8 vfrag(const ALAS unsigned char* vb, int s, int db) {
    const v4i16_t lo = vtr(vb + (16 * s) * VRow<DV>::B + 64 * db), hi4 = vtr(vb + (16 * s + 8) * VRow<DV>::B + 64 * db);
    return __builtin_shufflevector(lo, hi4, 0, 1, 2, 3, 4, 5, 6, 7);
}
template <int DV> __device__ __forceinline__ int vtr_lane_off(int lane) { return (4 * (lane >> 5) + ((lane & 15) >> 2)) * VRow<DV>::B + (16 * ((lane >> 4) & 1) + 4 * (lane & 3)) * 2; }
__device__ __forceinline__ float pair_max(float x) { auto rr = __builtin_amdgcn_permlane32_swap(__float_as_uint(x), __float_as_uint(x), false, false); return fmaxf(__uint_as_float(rr[0]), __uint_as_float(rr[1])); }
template <int DV> struct Pref { u32x4 k; u32x4 v[DV / 64]; };

template <int DV> __device__ __forceinline__ void tile_load(Pref<DV>& pf, const bf16_t* Kp, const bf16_t* Vp, int pitch, int kt, int tid) {
    const int krow = tid >> 3, kc = (tid & 7) * 8;
    pf.k = *(const u32x4*)(Kp + (size_t)(kt * 64 + krow) * pitch + kc);
#pragma unroll
    for (int i = 0; i < DV / 64; ++i) { const int c = tid + i * 512, vrow = c / (DV / 8), vc = (c % (DV / 8)) * 8;
        pf.v[i] = *(const u32x4*)(Vp + (size_t)(kt * 64 + vrow) * pitch + vc); }
}
template <int DV> __device__ __forceinline__ void tile_store(const Pref<DV>& pf, ALAS unsigned char* kbuf, ALAS unsigned char* vbuf, int tid) {
    const int krow = tid >> 3, kc = (tid & 7) * 8;
    *(ALAS u32x4*)(kbuf + krow * KROW + kc * 2) = pf.k;
#pragma unroll
    for (int i = 0; i < DV / 64; ++i) { const int c = tid + i * 512, vrow = c / (DV / 8), vc = (c % (DV / 8)) * 8;
        *(ALAS u32x4*)(vbuf + vrow * VRow<DV>::B + vc * 2) = pf.v[i]; }
}

template <int DV> __device__ __forceinline__ void pv_slab(const ALAS unsigned char* vbuf, int s, u32x4 w, f32x16 (&o)[DV / 32], int l32, int hi) {
    const bf16x8 pfr = __builtin_bit_cast(bf16x8, w);
#pragma unroll
    for (int db = 0; db < DV / 32; ++db) {
        const bf16x8 vf = vfrag<DV>(vbuf + vtr_lane_off<DV>(l32 + 32 * hi), s, db);
        o[db] = __builtin_amdgcn_mfma_f32_32x32x16_bf16(vf, pfr, o[db], 0, 0, 0); }
    if (DV > 64) __builtin_amdgcn_sched_barrier(0);
}

template <int MODE, int DV, bool MASKED>
__device__ __forceinline__ void tile_compute(const ALAS unsigned char* kbuf, const ALAS unsigned char* vbuf, const bf16x8 (&qf)[4], f32x16 (&o)[DV / 32],
                                             float& st_m, float& st_l, int lim, const ALAS float* btab, float cbias, int lane) {
    const int l32 = lane & 31, hi = lane >> 5;
    if constexpr (MODE == 0) {
        f32x16 p0, p1;
#pragma unroll
        for (int r = 0; r < 16; ++r) { p0[r] = 0.f; p1[r] = 0.f; }
        { const ALAS unsigned char* kb = kbuf + l32 * KROW + hi * 16;
#pragma unroll
          for (int d0 = 0; d0 < 4; ++d0) {
              const bf16x8 k0 = *(const ALAS bf16x8*)(kb + d0 * 32);
              const bf16x8 k1 = *(const ALAS bf16x8*)(kb + 32 * KROW + d0 * 32);
              p0 = __builtin_amdgcn_mfma_f32_32x32x16_bf16(k0, qf[d0], p0, 0, 0, 0);
              p1 = __builtin_amdgcn_mfma_f32_32x32x16_bf16(k1, qf[d0], p1, 0, 0, 0); } }
        __builtin_amdgcn_sched_barrier(0);
#pragma unroll
        for (int r = 0; r < 16; ++r) {
            float a = rcpf_(1.0f + ex2(p0[r])), b = rcpf_(1.0f + ex2(p1[r]));
            if (MASKED) { a = (CR(r) < lim) ? a : 1.0f; b = (CR(r) + 32 < lim) ? b : 1.0f; }
            p0[r] = a; p1[r] = b; }
        float g[8], hs[8], pr[8];
#pragma unroll
        for (int i = 0; i < 4; ++i) { g[i] = (p0[4 * i] * p0[4 * i + 1]) * (p0[4 * i + 2] * p0[4 * i + 3]); g[4 + i] = (p1[4 * i] * p1[4 * i + 1]) * (p1[4 * i + 2] * p1[4 * i + 3]); }
#pragma unroll
        for (int i = 0; i < 8; ++i) { auto rr = __builtin_amdgcn_permlane32_swap(__float_as_uint(g[i]), __float_as_uint(g[i]), false, false);
            pr[i] = __uint_as_float(rr[0]) * __uint_as_float(rr[1]); hs[i] = hi ? 1.0f : __uint_as_float(rr[1]); }
        float T = st_m;
#pragma unroll
        for (int i = 7; i >= 0; --i) {
            float R = hs[i] * T; T = T * pr[i];
            if (i >= 4) { const int b = 4 * (i - 4);
                float R2 = R * p1[b + 3]; p1[b + 3] = R - R2; float R1 = R2 * p1[b + 2]; p1[b + 2] = R2 - R1; float R0 = R1 * p1[b + 1]; p1[b + 1] = R1 - R0; p1[b] = R0 - R0 * p1[b]; }
            else { const int b = 4 * i;
                float R2 = R * p0[b + 3]; p0[b + 3] = R - R2; float R1 = R2 * p0[b + 2]; p0[b + 2] = R2 - R1; float R0 = R1 * p0[b + 1]; p0[b + 1] = R1 - R0; p0[b] = R0 - R0 * p0[b]; }
        }
        st_m = T;
        __builtin_amdgcn_sched_barrier(0);
#pragma unroll
        for (int s = 0; s < 4; ++s) {
            u32x4 w;
            if (s == 0) { w.x = cvtpk(p0[0], p0[1]); w.y = cvtpk(p0[2], p0[3]); w.z = cvtpk(p0[4], p0[5]); w.w = cvtpk(p0[6], p0[7]); }
            else if (s == 1) { w.x = cvtpk(p0[8], p0[9]); w.y = cvtpk(p0[10], p0[11]); w.z = cvtpk(p0[12], p0[13]); w.w = cvtpk(p0[14], p0[15]); }
            else if (s == 2) { w.x = cvtpk(p1[0], p1[1]); w.y = cvtpk(p1[2], p1[3]); w.z = cvtpk(p1[4], p1[5]); w.w = cvtpk(p1[6], p1[7]); }
            else { w.x = cvtpk(p1[8], p1[9]); w.y = cvtpk(p1[10], p1[11]); w.z = cvtpk(p1[12], p1[13]); w.w = cvtpk(p1[14], p1[15]); }
            pv_slab<DV>(vbuf, s, w, o, l32, hi);
        }
    } else {
        const float NEG = -__builtin_inff();
#pragma unroll
        for (int hk = 0; hk < 2; ++hk) {
            f32x16 p;
            const bool fresh = (st_m == NEG);
            const float mbase = fresh ? 0.f : st_m;
            { const float ini = (MASKED ? 0.f : cbias) - mbase;
#pragma unroll
              for (int r = 0; r < 16; ++r) p[r] = ini; }
            { const ALAS unsigned char* kb = kbuf + (32 * hk + l32) * KROW + hi * 16;
#pragma unroll
              for (int d0 = 0; d0 < 4; ++d0) { const bf16x8 k0 = *(const ALAS bf16x8*)(kb + d0 * 32); p = __builtin_amdgcn_mfma_f32_32x32x16_bf16(k0, qf[d0], p, 0, 0, 0); } }
            if (MASKED) {
                float bv[16];
#pragma unroll
                for (int r = 0; r < 16; ++r) { const int d0 = lim - 32 * hk - CR(r); bv[r] = btab[min(max(d0, 0), 127)]; }
#pragma unroll
                for (int r = 0; r < 16; ++r) asm volatile("" : "+v"(bv[r]));
#pragma unroll
                for (int r = 0; r < 16; ++r) {
                    const int d0 = lim - 32 * hk - CR(r);
                    const bool v0 = (MODE == 2) ? ((unsigned)d0 < 128u) : (d0 >= 0);
                    p[r] = v0 ? p[r] + bv[r] : NEG; }
            }
            float mt = fmaxf(p[0], p[1]);
#pragma unroll
            for (int r = 2; r < 16; ++r) mt = fmaxf(mt, p[r]);
            mt = fmaxf(mt, __shfl_xor(mt, 32));
            const bool need = fresh ? (mt > NEG) : (mt > 0.f);
            if (__any(need)) {
                const float dl = need ? mt : 0.f, f = fresh ? 1.0f : ex2(-dl);
                st_l *= f; st_m = need ? mbase + dl : st_m;
#pragma unroll
                for (int r = 0; r < 16; ++r) p[r] -= dl;
#pragma unroll
                for (int db = 0; db < DV / 32; ++db)
#pragma unroll
                    for (int r = 0; r < 16; ++r) o[db][r] *= f;
            }
            float s = 0.f;
#pragma unroll
            for (int r = 0; r < 16; ++r) { p[r] = ex2(p[r]); s += p[r]; }
            st_l += s;
#pragma unroll
            for (int s2 = 0; s2 < 2; ++s2) {
                u32x4 w; w.x = cvtpk(p[8 * s2], p[8 * s2 + 1]); w.y = cvtpk(p[8 * s2 + 2], p[8 * s2 + 3]); w.z = cvtpk(p[8 * s2 + 4], p[8 * s2 + 5]); w.w = cvtpk(p[8 * s2 + 6], p[8 * s2 + 7]);
                pv_slab<DV>(vbuf, 2 * hk + s2, w, o, l32, hi);
            }
        }
    }
}

template <int MODE, int DV>
__device__ __forceinline__ void attn_core(const bf16_t* Qp, const bf16_t* Kp, const bf16_t* Vp, int pitch, int q0, int kt0, int nt, int dir,
                                          ALAS unsigned char* lds, f32x16 (&o)[DV / 32], float& st_m, float& st_l) {
    int tid_ = threadIdx.x; asm volatile("" : "+v"(tid_));
    const int tid = tid_, lane = tid & 63, l32 = lane & 31, hi = lane >> 5, wid = __builtin_amdgcn_readfirstlane(tid >> 6);
    const int qw = q0 + 32 * wid, t = qw + l32;
    const ALAS float* btab = (const ALAS float*)(lds + L_BT);
    bf16x8 qf[4];
#pragma unroll
    for (int d0 = 0; d0 < 4; ++d0) qf[d0] = *(const bf16x8*)(Qp + (size_t)t * pitch + d0 * 16 + hi * 8);
#pragma unroll
    for (int db = 0; db < DV / 32; ++db)
#pragma unroll
        for (int r = 0; r < 16; ++r) o[db][r] = 0.f;
    st_m = (MODE == 0) ? 1.0f : -__builtin_inff(); st_l = 0.f;
    Pref<DV> pfA, pfB;
    tile_load<DV>(pfA, Kp, Vp, pitch, kt0, tid);
    tile_load<DV>(pfB, Kp, Vp, pitch, kt0 + dir * min(1, nt - 1), tid);
    tile_store<DV>(pfA, lds + L_K, lds + L_V, tid);
    __syncthreads();
    const float cbias = (MODE == 1) ? btab[127] : 0.f;
    bool done = false;
#define AC_STEP(it_, PFN, PFS) do { \
        const int it = (it_), kt = kt0 + dir * it, cur = it & 1, kbase = kt * 64; \
        tile_load<DV>(PFN, Kp, Vp, pitch, kt0 + dir * min(it + 2, nt - 1), tid);        \
        const ALAS unsigned char* kb = lds + L_K + cur * KBUF; const ALAS unsigned char* vb = lds + L_V + cur * VBUF; \
        const int lim = t - kbase - 4 * hi; \
        if (MODE == 0) { \
            if (kbase <= qw + 31 && __any(st_m != 0.0f)) { if (kbase + 63 >= qw) tile_compute<0, DV, true>(kb, vb, qf, o, st_m, st_l, lim, btab, cbias, lane); else tile_compute<0, DV, false>(kb, vb, qf, o, st_m, st_l, lim, btab, cbias, lane); } \
        } else if (MODE == 1) { \
            if (kbase <= qw + 31) { if (qw - (kbase + 63) < 113) tile_compute<1, DV, true>(kb, vb, qf, o, st_m, st_l, lim, btab, cbias, lane); else tile_compute<1, DV, false>(kb, vb, qf, o, st_m, st_l, lim, btab, cbias, lane); } \
        } else { \
            if (kbase <= qw + 31 && kbase + 63 >= qw - 127) tile_compute<2, DV, true>(kb, vb, qf, o, st_m, st_l, lim, btab, cbias, lane); \
        } \
        if (it + 1 < nt) tile_store<DV>(PFS, lds + L_K + (cur ^ 1) * KBUF, lds + L_V + (cur ^ 1) * VBUF, tid);     \
        if (MODE == 0) { \
              \
            if (!__syncthreads_or(st_m != 0.0f)) done = true; \
        } else __syncthreads(); } while (0)
    for (int it2 = 0; it2 < nt && !done; it2 += 2) {
        AC_STEP(it2, pfA, pfB);
        if (done) break;
        AC_STEP(it2 + 1, pfB, pfA);
    }
#undef AC_STEP
}
template <int MODE, int DV>
__device__ __forceinline__ void attn_core_pp(const bf16_t* Qp, const bf16_t* Kp, const bf16_t* Vp, int pitch, int q0, int kt0, int nt,
                                             ALAS unsigned char* lds, f32x16 (&o)[DV / 32], float& st_m, float& st_l) {
    int tid_ = threadIdx.x; asm volatile("" : "+v"(tid_));
    const int tid = tid_, lane = tid & 63, l32 = lane & 31, hi = lane >> 5, wid = __builtin_amdgcn_readfirstlane(tid >> 6), grp = wid >> 2;
    const int qw = q0 + 32 * wid, t = qw + l32;
    const ALAS float* btab = (const ALAS float*)(lds + L_BT);
    const float NEG = -__builtin_inff();
    bf16x8 qf[4];
#pragma unroll
    for (int d0 = 0; d0 < 4; ++d0) qf[d0] = *(const bf16x8*)(Qp + (size_t)t * pitch + d0 * 16 + hi * 8);
    ALAS unsigned char* qst = lds + L_QS + wid * 3072 + lane * 16;
    if (DV == 128) {
#pragma unroll
        for (int d0 = 1; d0 < 4; ++d0) *(ALAS bf16x8*)(qst + (d0 - 1) * 1024) = qf[d0];
    }
#pragma unroll
    for (int db = 0; db < DV / 32; ++db)
#pragma unroll
        for (int r = 0; r < 16; ++r) o[db][r] = 0.f;
    st_m = NEG; st_l = 0.f;
    Pref<DV> pfA, pfB;
    tile_load<DV>(pfA, Kp, Vp, pitch, kt0, tid);
    tile_load<DV>(pfB, Kp, Vp, pitch, kt0 + 1, tid);
    tile_store<DV>(pfA, lds + L_K, lds + L_V, tid);
    tile_store<DV>(pfB, lds + L_K + KBUF, lds + L_V + VBUF, tid);
    tile_load<DV>(pfA, Kp, Vp, pitch, kt0 + min(2, nt - 1), tid);
    tile_load<DV>(pfB, Kp, Vp, pitch, kt0 + min(3, nt - 1), tid);
    __syncthreads();
    const float cbias = (MODE == 1) ? btab[256 + 127] : 0.f;
    f32x16 p; u32x4 pw0, pw1;
#pragma unroll
    for (int r = 0; r < 16; ++r) p[r] = 0.f;
    pw0 = (u32x4){0u, 0u, 0u, 0u}; pw1 = pw0;
#define PP_MASKED(ti) ((MODE == 1) ? (qw - ((kt0 + (ti)) * 64 + 63) < 113) : true)
#define PP_PART(ti) ((MODE != 2) || ((kt0 + (ti)) * 64 <= qw + 31 && (kt0 + (ti)) * 64 + 63 >= qw - 127))
#define PP_QK(ti, hk) do { \
        const float mbase_ = (st_m == NEG) ? 0.f : st_m; const float ini_ = (PP_MASKED(ti) ? 0.f : cbias) - mbase_; \
        _Pragma("unroll") for (int r = 0; r < 16; ++r) p[r] = ini_; \
        const ALAS unsigned char* kb_ = lds + L_K + ((ti) & 1) * KBUF + (32 * (hk) + l32) * KROW + hi * 16; \
        _Pragma("unroll") for (int d0 = 0; d0 < 4; ++d0) { const bf16x8 k0_ = *(const ALAS bf16x8*)(kb_ + d0 * 32); \
            const bf16x8 qv_ = (DV == 128 && d0 > 0) ? *(const ALAS bf16x8*)(qst + (d0 - 1) * 1024) : qf[d0]; \
            p = __builtin_amdgcn_mfma_f32_32x32x16_bf16(k0_, qv_, p, 0, 0, 0); } } while (0)
#define PP_PVQK(tv, hv, tk, hq) do { \
        const ALAS unsigned char* vb_ = lds + L_V + ((tv) & 1) * VBUF + vtr_lane_off<DV>(lane); \
        const ALAS unsigned char* kb_ = lds + L_K + ((tk) & 1) * KBUF + (32 * (hq) + l32) * KROW + hi * 16; \
        if (PP_PART(tv)) { \
            bf16x8 vf_[DV / 32][2]; \
            _Pragma("unroll") for (int db = 0; db < DV / 32; ++db) { vf_[db][0] = vfrag<DV>(vb_, 2 * (hv), db); vf_[db][1] = vfrag<DV>(vb_, 2 * (hv) + 1, db); } \
            const bf16x8 pa_ = __builtin_bit_cast(bf16x8, pw0), pb_ = __builtin_bit_cast(bf16x8, pw1); \
            _Pragma("unroll") for (int db = 0; db < DV / 32; ++db) o[db] = __builtin_amdgcn_mfma_f32_32x32x16_bf16(vf_[db][0], pa_, o[db], 0, 0, 0); \
            _Pragma("unroll") for (int db = 0; db < DV / 32; ++db) o[db] = __builtin_amdgcn_mfma_f32_32x32x16_bf16(vf_[db][1], pb_, o[db], 0, 0, 0); } \
        if (PP_PART(tk)) { \
            bf16x8 kf_[4], qv_[4]; \
            _Pragma("unroll") for (int d0 = 0; d0 < 4; ++d0) { kf_[d0] = *(const ALAS bf16x8*)(kb_ + d0 * 32); qv_[d0] = (DV == 128 && d0 > 0) ? *(const ALAS bf16x8*)(qst + (d0 - 1) * 1024) : qf[d0]; } \
            const float mbase_ = (st_m == NEG) ? 0.f : st_m; const float ini_ = (PP_MASKED(tk) ? 0.f : cbias) - mbase_; \
            _Pragma("unroll") for (int r = 0; r < 16; ++r) p[r] = ini_; \
            _Pragma("unroll") for (int d0 = 0; d0 < 4; ++d0) p = __builtin_amdgcn_mfma_f32_32x32x16_bf16(kf_[d0], qv_[d0], p, 0, 0, 0); } } while (0)
#define PP_SM(ti, hk) do { if (PP_PART(ti)) { \
        if (PP_MASKED(ti)) { const int lim_ = t - (kt0 + (ti)) * 64 - 4 * hi - 32 * (hk); \
            const ALAS float* bp_ = btab + (lim_ + 256 - 27);            \
            float bv_[16]; \
            _Pragma("unroll") for (int r = 0; r < 16; ++r) bv_[r] = bp_[27 - CR(r)]; \
            _Pragma("unroll") for (int r = 0; r < 16; ++r) p[r] += bv_[r]; } \
        const bool fresh_ = (st_m == NEG); const float mb_ = fresh_ ? 0.f : st_m; \
        float mt_; { const float a0_ = fmaxf(fmaxf(p[0], p[1]), p[2]), a1_ = fmaxf(fmaxf(p[3], p[4]), p[5]), a2_ = fmaxf(fmaxf(p[6], p[7]), p[8]), a3_ = fmaxf(fmaxf(p[9], p[10]), p[11]), a4_ = fmaxf(fmaxf(p[12], p[13]), p[14]); \
            mt_ = fmaxf(fmaxf(fmaxf(a0_, a1_), a2_), fmaxf(fmaxf(a3_, a4_), p[15])); }        \
        mt_ = pair_max(mt_); \
        const bool need_ = fresh_ ? (mt_ > NEG) : (mt_ > 0.f); \
        if (__any(need_)) { const float dl_ = need_ ? mt_ : 0.f, f_ = fresh_ ? 1.0f : ex2(-dl_); \
            st_l *= f_; st_m = need_ ? mb_ + dl_ : st_m; \
            _Pragma("unroll") for (int r = 0; r < 16; ++r) p[r] -= dl_; \
            _Pragma("unroll") for (int db = 0; db < DV / 32; ++db) _Pragma("unroll") for (int r = 0; r < 16; ++r) o[db][r] *= f_; } \
        _Pragma("unroll") for (int r = 0; r < 16; ++r) p[r] = ex2(p[r]); \
        st_l += ((p[0] + p[1]) + (p[2] + p[3])) + ((p[4] + p[5]) + (p[6] + p[7])) + (((p[8] + p[9]) + (p[10] + p[11])) + ((p[12] + p[13]) + (p[14] + p[15]))); \
        pw0.x = cvtpk_a(p[0], p[1]); pw0.y = cvtpk_a(p[2], p[3]); pw0.z = cvtpk_a(p[4], p[5]); pw0.w = cvtpk_a(p[6], p[7]); \
        pw1.x = cvtpk_a(p[8], p[9]); pw1.y = cvtpk_a(p[10], p[11]); pw1.z = cvtpk_a(p[12], p[13]); pw1.w = cvtpk_a(p[14], p[15]); } } while (0)
#define PP_STAGE(u, PF) do { const int u_ = (u); if (u_ >= 2 && u_ < nt) tile_store<DV>(PF, lds + L_K + (u_ & 1) * KBUF, lds + L_V + (u_ & 1) * VBUF, tid); \
        tile_load<DV>(PF, Kp, Vp, pitch, kt0 + min(u_ + 2, nt - 1), tid); } while (0)
#define PP_BAR() asm volatile("s_waitcnt lgkmcnt(0)\n\ts_barrier" ::: "memory")
    if (grp == 1) __builtin_amdgcn_s_setprio(1);
    if (grp == 0) {
        PP_QK(0, 0); PP_BAR();
        for (int ti = 0; ti < nt; ti += 2) {
            PP_SM(ti, 0); PP_BAR();
            PP_PVQK(ti, 0, ti, 1); PP_STAGE(ti + 1, pfB); PP_BAR();
            PP_SM(ti, 1); PP_BAR();
            PP_PVQK(ti, 1, ti + 1, 0); PP_BAR();
            PP_SM(ti + 1, 0); PP_BAR();
            PP_PVQK(ti + 1, 0, ti + 1, 1); PP_STAGE(ti + 2, pfA); PP_BAR();
            PP_SM(ti + 1, 1); PP_BAR();
            PP_PVQK(ti + 1, 1, ti + 2, 0); PP_BAR();
        }
        PP_BAR();
    } else {
        PP_BAR();
        PP_QK(0, 0); PP_BAR();
        for (int ti = 0; ti < nt; ti += 2) {
            PP_SM(ti, 0); PP_STAGE(ti + 1, pfB); PP_BAR();
            PP_PVQK(ti, 0, ti, 1); PP_BAR();
            PP_SM(ti, 1); PP_BAR();
            PP_PVQK(ti, 1, ti + 1, 0); PP_BAR();
            PP_SM(ti + 1, 0); PP_STAGE(ti + 2, pfA); PP_BAR();
            PP_PVQK(ti + 1, 0, ti + 1, 1); PP_BAR();
            PP_SM(ti + 1, 1); PP_BAR();
            PP_PVQK(ti + 1, 1, ti + 2, 0); PP_BAR();
        }
    }
    __builtin_amdgcn_s_setprio(0);
#undef PP_MASKED
#undef PP_PART
#undef PP_QK
#undef PP_PVQK
#undef PP_SM
#undef PP_STAGE
#undef PP_BAR
}
template <int DV> __device__ __forceinline__ void store_ot(const f32x16 (&o)[DV / 32], bf16_t* orow, int hi) {
#pragma unroll
    for (int db = 0; db < DV / 32; ++db)
#pragma unroll
        for (int rg = 0; rg < 4; ++rg) { u32x2 w; w.x = cvtpk_a(o[db][4 * rg], o[db][4 * rg + 1]); w.y = cvtpk_a(o[db][4 * rg + 2], o[db][4 * rg + 3]);
            *(u32x2*)(orow + 32 * db + 8 * rg + 4 * hi) = w; }
}
}
#ifndef RESID_BF16
#define RESID_BF16 1
#endif
#ifndef OUT_STAGGER_TICKS
#define OUT_STAGGER_TICKS 0
#endif
#ifndef OUT_STAGGER_GROUPS
#define OUT_STAGGER_GROUPS 2
#endif
#ifndef REP_OUT
#define REP_OUT 1
#endif
#ifndef REP_DOWN
#define REP_DOWN 1
#endif
#ifndef REP_INPROJ
#define REP_INPROJ 1
#endif
#ifndef REP_DIFF
#define REP_DIFF 1
#endif
#ifndef REP_SWA
#define REP_SWA 1
#endif
#ifndef REP_SB
#define REP_SB 1
#endif
#ifndef REP_UP
#define REP_UP 1
#endif
#ifndef REP_CONV
#define REP_CONV 1
#endif
#ifndef PH_DIFF
#define PH_DIFF 1
#endif
#ifndef PH_SWA
#define PH_SWA 1
#endif
#ifndef PH_SB
#define PH_SB 1
#endif
#ifndef PH_CONV
#define PH_CONV 1
#endif
#define LAS __attribute__((address_space(3)))
typedef unsigned short bf16;
typedef float f32x4 __attribute__((ext_vector_type(4)));
typedef unsigned v4u __attribute__((ext_vector_type(4)));
typedef unsigned v2u __attribute__((ext_vector_type(2)));
constexpr int NWAVES = 8;
constexpr int SEQ = 4096, NB = 16, MTOK = NB * SEQ, DM = 1024, DFF = 2816, DUP = 2 * DFF;
constexpr int EVEN_IN = 2304, ODD_IN = 3072;
constexpr size_t MiB = 1u << 20;
constexpr size_t WS_SSQ = 1 * MiB;
constexpr size_t WS_WINE = 8 * MiB, WS_WOUTE = 17 * MiB, WS_WINO = 21 * MiB, WS_WOUTO = 33 * MiB, WS_WUP = 37 * MiB, WS_WDN = 81 * MiB;
constexpr size_t WS_XB = 104 * MiB, WS_R = 232 * MiB;
constexpr size_t WS_PROJ = WS_R, WS_AO = WS_R + 384 * MiB, WS_U = WS_R, WS_G = WS_R + 352 * MiB;
constexpr int LDS_MISC = 152576, LDS_BYTES = 153600;
static_assert(att::L_QS + 8 * 3072 <= LDS_MISC, "LDS map");
constexpr int HALF_ROWS = MTOK / 2;

struct Args {
    const float* x; const float* rel_bias; const float* norm_mix; const float* norm_ffn; const float* norm_final;
    const float* w_in_even; const float* w_out_even; const float* sinks; const float* lam_q1; const float* lam_k1; const float* lam_q2; const float* lam_k2;
    const float* diff_norm; const float* w_in_odd; const float* w_out_odd; const float* ffn_up; const float* ffn_conv; const float* ffn_conv_b; const float* ffn_down;
    float* out; unsigned char* ws;
};

__device__ const unsigned char T5B[128] = {0, 1, 2, 3, 4, 5, 6, 7, 8, 9, 10, 11, 12, 13, 14, 15, 16, 16, 16, 17, 17, 18, 18, 18, 19, 19, 19, 20, 20, 20, 20, 21, 21, 21, 21, 22, 22, 22, 22, 22, 23, 23, 23, 23, 23, 23, 24, 24, 24, 24, 24, 24, 25, 25, 25, 25, 25, 25, 25, 26, 26, 26, 26, 26, 26, 26, 26, 27, 27, 27, 27, 27, 27, 27, 27, 27, 27, 28, 28, 28, 28, 28, 28, 28, 28, 28, 28, 29, 29, 29, 29, 29, 29, 29, 29, 29, 29, 29, 29, 30, 30, 30, 30, 30, 30, 30, 30, 30, 30, 30, 30, 30, 30, 31, 31, 31, 31, 31, 31, 31, 31, 31, 31, 31, 31, 31, 31, 31};

__device__ __forceinline__ float wave_sum(float v) {
#pragma unroll
    for (int o = 1; o < 64; o <<= 1) v += __shfl_xor(v, o);
    return v;
}
__device__ __forceinline__ unsigned f2bf(float f) { unsigned u = __builtin_bit_cast(unsigned, f); return (u + 0x7fffu + ((u >> 16) & 1u)) >> 16; }
__device__ __forceinline__ unsigned pk2(float lo, float hi) { return f2bf(lo) | (f2bf(hi) << 16); }

__device__ __forceinline__ void transpose_item(const float* W, int K, int N, bf16* WT, const float* gk, int a0, int a1, int b0, int b1, float cs, LAS float* scr, int item, int lane) {
    const int nblk = N / 32, kb = item / nblk, nb = item % nblk, k0 = 64 * kb, n0 = 32 * nb;
    const int nn = n0 + (lane & 31);
    const float csc = ((nn >= a0 && nn < a1) || (nn >= b0 && nn < b1)) ? cs : 1.0f;
#pragma unroll 8
    for (int i = 0; i < 32; ++i) { const int kk = 2 * i + (lane >> 5); const float gv = gk ? gk[k0 + kk] : 1.0f; scr[kk * 33 + (lane & 31)] = W[(size_t)(k0 + kk) * N + nn] * (gv * csc); }
    asm volatile("s_waitcnt lgkmcnt(0)" ::: "memory");
    const int c = lane & 7;
#pragma unroll
    for (int j = 0; j < 4; ++j) { const int n = (lane >> 3) + 8 * j; const LAS float* s = scr + (8 * c) * 33 + n;
        v4u o; o.x = pk2(s[0 * 33], s[1 * 33]); o.y = pk2(s[2 * 33], s[3 * 33]); o.z = pk2(s[4 * 33], s[5 * 33]); o.w = pk2(s[6 * 33], s[7 * 33]);
        *(v4u*)(WT + (size_t)(n0 + n) * K + k0 + 8 * c) = o; }
    asm volatile("s_waitcnt lgkmcnt(0)" ::: "memory");
}

#define XB_TMO      128
#define XB_XCNT(j)  (256  + 64 * (j))
#define XB_XSUB(j)  (1280 + 64 * (j))
#define XB_XGEN(j)  (2304 + 64 * (j))
#define XB_TOP      3328
#define XB_TOPGEN   3392
#define XCD_BAR_WORDS 3456
#define XB_SPIN_CAP (1u << 18)

__device__ __forceinline__ unsigned xb_ld(unsigned* p)              { return __hip_atomic_load(p, __ATOMIC_RELAXED, __HIP_MEMORY_SCOPE_AGENT); }
__device__ __forceinline__ unsigned xb_add(unsigned* p, unsigned v) { return __hip_atomic_fetch_add(p, v, __ATOMIC_RELAXED, __HIP_MEMORY_SCOPE_AGENT); }
__device__ __forceinline__ unsigned xb_xcc_id() { return (unsigned)__builtin_amdgcn_s_getreg((3 << 11) | 20) & 0xFu; }
#define XB_SPIN(cond, bar) do { unsigned _sp = 0; while (cond) { __builtin_amdgcn_s_sleep(1); \
    if ((++_sp & 255u) == 0u) { if (xb_ld(&(bar)[XB_TMO])) break; if (_sp > XB_SPIN_CAP) { atomicAdd(&(bar)[XB_TMO], 1u); break; } } } } while (0)

struct XcdBarrier {
    unsigned* bar; unsigned x;
    volatile LAS unsigned* st;
};

__device__ __forceinline__ XcdBarrier xcd_barrier_post(unsigned* bar, volatile LAS unsigned* st) {
    XcdBarrier b; b.bar = bar; b.x = xb_xcc_id(); b.st = st;
    if (threadIdx.x == 0) (void)xb_add(&bar[XB_XCNT(b.x)], 1u);
    return b;
}
__device__ __forceinline__ void xcd_barrier_complete(unsigned* bar, unsigned x, unsigned& nloc, unsigned& nx) {
    const unsigned G = gridDim.x * gridDim.y * gridDim.z;
    unsigned sum, cnt, mine, sp = 0u;
    for (;;) {
        sum = 0u; cnt = 0u; mine = 0u;
#pragma unroll
        for (unsigned j = 0; j < 16; ++j) { const unsigned c = xb_ld(&bar[XB_XCNT(j)]); sum += c; cnt += (c > 0u) ? 1u : 0u; mine = (j == x) ? c : mine; }
        if (sum == G) break;
        __builtin_amdgcn_s_sleep(1);
        if ((++sp & 255u) == 0u) { if (xb_ld(&bar[XB_TMO])) break; if (sp > XB_SPIN_CAP) { atomicAdd(&bar[XB_TMO], 1u); break; } }
    }
    nloc = mine > 0u ? mine : 1u; nx = cnt > 0u ? cnt : 1u;
}

__device__ __forceinline__ void xcd_barrier(const XcdBarrier& b) {
    asm volatile("s_waitcnt vmcnt(0)" ::: "memory");
    __syncthreads();
    if (threadIdx.x == 0) {
        unsigned* bar = b.bar;
        __builtin_amdgcn_s_waitcnt(0);
        unsigned nloc = b.st[0], nx = b.st[1];
        if (nloc == 0u) { xcd_barrier_complete(bar, b.x, nloc, nx); b.st[0] = nloc; b.st[1] = nx; }
        const unsigned old = xb_add(&bar[XB_XSUB(b.x)], 1u);
        const unsigned gen = old / nloc;
        if (old + 1u == (gen + 1u) * nloc) {
            __builtin_amdgcn_fence(__ATOMIC_RELEASE, "agent");
            asm volatile("s_waitcnt vmcnt(0)" ::: "memory");
            const unsigned og = xb_add(&bar[XB_TOP], 1u);
            const unsigned tg = og / nx;
            if (og + 1u == (tg + 1u) * nx) xb_add(&bar[XB_TOPGEN], 1u);
            else XB_SPIN(xb_ld(&bar[XB_TOPGEN]) == tg, bar);
            __builtin_amdgcn_fence(__ATOMIC_ACQUIRE, "agent");
            xb_add(&bar[XB_XGEN(b.x)], 1u);
            asm volatile("s_waitcnt vmcnt(0)" ::: "memory");
        } else {
            XB_SPIN(xb_ld(&bar[XB_XGEN(b.x)]) == gen, bar);
            __builtin_amdgcn_fence(__ATOMIC_ACQUIRE, "agent");
            asm volatile("s_waitcnt vmcnt(0)" ::: "memory");
        }
    }
    __syncthreads();
}

__global__ void __launch_bounds__(NWAVES * 64, 2) mega_fwd(Args a) {
    extern __shared__ __attribute__((aligned(16))) unsigned char lds_raw[];
    cg::grid_group grid = cg::this_grid();
    LAS unsigned char* lds = (LAS unsigned char*)lds_raw;
    const int tid = threadIdx.x, lane = tid & 63, wave = __builtin_amdgcn_readfirstlane(tid >> 6);
    const int G = gridDim.x, bx = blockIdx.x;
    const int gw = bx * NWAVES + wave, NGW = G * NWAVES;
    unsigned char* ws = a.ws;
    float* ssq = (float*)(ws + WS_SSQ);
    bf16* xb = (bf16*)(ws + WS_XB);
    bf16* proj = (bf16*)(ws + WS_PROJ);
    bf16* ao = (bf16*)(ws + WS_AO);
    bf16* ubuf = (bf16*)(ws + WS_U);
    bf16* gbuf = (bf16*)(ws + WS_G);

    if (bx == 0) for (int i = tid; i < XCD_BAR_WORDS; i += NWAVES * 64) ((unsigned*)ws)[i] = 0u;
    if (tid < 2) ((LAS unsigned*)(lds + LDS_MISC))[tid] = 0u;
    {
        LAS float* scr = (LAS float*)(lds + wave * 16384);
        constexpr int I_INE = 16 * (EVEN_IN / 32), I_OUT = 16 * 32, I_INO = 16 * (ODD_IN / 32), I_UP = 16 * (DUP / 32), I_DN = (DFF / 64) * 32;
        constexpr int NITEMS = 2 * I_INE + 2 * I_OUT + 2 * I_INO + 2 * I_OUT + 4 * I_UP + 4 * I_DN;
        for (int it = gw; it < NITEMS; it += NGW) {
            int r = it;
            if (r < 2 * I_INE) { const int e = r / I_INE; r -= e * I_INE;
                transpose_item(a.w_in_even + (size_t)e * DM * EVEN_IN, DM, EVEN_IN, (bf16*)(ws + WS_WINE) + (size_t)e * EVEN_IN * DM, a.norm_mix + (2 * e) * DM, 0, 512, 768, 1280, att::QSCALE, scr, r, lane); continue; }
            r -= 2 * I_INE;
            if (r < 2 * I_OUT) { const int e = r / I_OUT; r -= e * I_OUT;
                transpose_item(a.w_out_even + (size_t)e * DM * DM, DM, DM, (bf16*)(ws + WS_WOUTE) + (size_t)e * DM * DM, nullptr, 0, 0, 0, 0, 1.f, scr, r, lane); continue; }
            r -= 2 * I_OUT;
            if (r < 2 * I_INO) { const int e = r / I_INO; r -= e * I_INO;
                transpose_item(a.w_in_odd + (size_t)e * DM * ODD_IN, DM, ODD_IN, (bf16*)(ws + WS_WINO) + (size_t)e * ODD_IN * DM, a.norm_mix + (2 * e + 1) * DM, 0, 1024, 0, 0, att::QSCALE, scr, r, lane); continue; }
            r -= 2 * I_INO;
            if (r < 2 * I_OUT) { const int e = r / I_OUT; r -= e * I_OUT;
                transpose_item(a.w_out_odd + (size_t)e * DM * DM, DM, DM, (bf16*)(ws + WS_WOUTO) + (size_t)e * DM * DM, nullptr, 0, 0, 0, 0, 1.f, scr, r, lane); continue; }
            r -= 2 * I_OUT;
            if (r < 4 * I_UP) { const int e = r / I_UP; r -= e * I_UP;
                transpose_item(a.ffn_up + (size_t)e * DM * DUP, DM, DUP, (bf16*)(ws + WS_WUP) + (size_t)e * DUP * DM, a.norm_ffn + e * DM, 0, 0, 0, 0, 1.f, scr, r, lane); continue; }
            r -= 4 * I_UP;
            { const int e = r / I_DN; r -= e * I_DN;
                transpose_item(a.ffn_down + (size_t)e * DFF * DM, DFF, DM, (bf16*)(ws + WS_WDN) + (size_t)e * DM * DFF, nullptr, 0, 0, 0, 0, 1.f, scr, r, lane); }
        }
        for (int m0 = 2 * gw; m0 < MTOK; m0 += 2 * NGW) {
            f32x4 v[2][4];
#pragma unroll
            for (int h2 = 0; h2 < 2; ++h2) { const f32x4* xr = (const f32x4*)(a.x + (size_t)(m0 + h2) * DM) + lane;
#pragma unroll
                for (int j = 0; j < 4; ++j) v[h2][j] = __builtin_nontemporal_load(xr + 64 * j); }
#pragma unroll
            for (int h2 = 0; h2 < 2; ++h2) { const int m = m0 + h2; float s = 0.f;
#pragma unroll
                for (int j = 0; j < 4; ++j) s += (v[h2][j][0] * v[h2][j][0] + v[h2][j][1] * v[h2][j][1]) + (v[h2][j][2] * v[h2][j][2] + v[h2][j][3] * v[h2][j][3]);
                s = wave_sum(s);
                v2u* o8 = (v2u*)(xb + (size_t)m * DM) + lane;
#pragma unroll
                for (int j = 0; j < 4; ++j) { v2u w; w.x = pk2(v[h2][j][0], v[h2][j][1]); w.y = pk2(v[h2][j][2], v[h2][j][3]); o8[64 * j] = w; }
                if (lane < 16) ssq[(size_t)m * 16 + lane] = (lane == 0) ? s : 0.f; }
        }
    }
    grid.sync();
    const XcdBarrier xbar = xcd_barrier_post((unsigned*)ws, (volatile LAS unsigned*)(lds + LDS_MISC));

    for (int layer = 0; layer < 4; ++layer) {
        const int e = layer >> 1; const bool even = (layer & 1) == 0;
        const float* xold = (layer == 0) ? a.x : a.out;
        {
            const int N = even ? EVEN_IN : ODD_IN;
            const bf16* wt = even ? (const bf16*)(ws + WS_WINE) + (size_t)e * EVEN_IN * DM : (const bf16*)(ws + WS_WINO) + (size_t)e * ODD_IN * DM;
            pg8::Gemm g{xb, wt, MTOK, N, DM}; pg8::StaticOrder S; S.init(MTOK, N, G, bx);
            pg8::EpiScaleBf16 E{proj, N, ssq};
            for (int rep_ = 0; rep_ < REP_INPROJ; ++rep_)
            pg8::gemm_phase<pg8::EpiScaleBf16, pg8::StaticOrder, true, true>(lds, g, S, E);
        }
        xcd_barrier(xbar);
        if (even) {
            int tq = threadIdx.x; asm volatile("" : "+v"(tq)); const int tid = tq, lane = tq & 63, l32 = lane & 31, hi = lane >> 5;
            float lam, one_m_li;
            { const float li = (layer == 0) ? 0.2f : 0.47071301839f;
              const float s1 = wave_sum(a.lam_q1[e * 64 + lane] * a.lam_k1[e * 64 + lane]), s2 = wave_sum(a.lam_q2[e * 64 + lane] * a.lam_k2[e * 64 + lane]);
              lam = __expf(s1) - __expf(s2) + li; lam = __builtin_bit_cast(float, __builtin_amdgcn_readfirstlane(__builtin_bit_cast(int, lam))); one_m_li = __builtin_bit_cast(float, __builtin_amdgcn_readfirstlane(__builtin_bit_cast(int, 1.0f - li))); }
            LAS float* btab = (LAS float*)(lds + att::L_BT);

#if PH_DIFF
            for (int rep_ = 0; rep_ < REP_DIFF; ++rep_)
            for (int uidx = bx; uidx < 1024; uidx += G) {
                const int j = uidx >> 8, c = uidx & 255, bh = c >> 2, s = c & 3, b = bh >> 2, h = bh & 3;
                const int qb = (j == 0) ? s : (j == 1) ? 7 - s : (j == 2) ? 8 + s : 15 - s;
                { int tb = threadIdx.x; asm volatile("" : "+v"(tb)); const int dd = tb - 256;
                  btab[tb] = (dd < 0) ? -__builtin_inff() : a.rel_bias[T5B[dd < 127 ? dd : 127] * 12 + 8 + h] * att::LOG2E; }
                const bf16* base = proj + (size_t)b * SEQ * EVEN_IN;
                const int q0 = qb * 256, nt = 4 * qb + 4, t = q0 + 32 * wave + l32;
                att::f32x16 o2[4]; float m2, l2; LAS unsigned* o1s = (LAS unsigned*)(lds + att::L_O1 + wave * 8192) + lane;
                { float m1, l1;
                  att::attn_core_pp<1, 128>(base + 768 + h * 128, base + 1280 + h * 128, base + 1792 + h * 128, EVEN_IN, q0, 0, nt, lds, o2, m1, l1);
                  const float inv = __builtin_amdgcn_rcpf(l1 + __shfl_xor(l1, 32));
#pragma unroll
                  for (int db = 0; db < 4; ++db)
#pragma unroll
                      for (int k = 0; k < 8; ++k) o1s[(db * 8 + k) * 64] = att::cvtpk(o2[db][2 * k] * inv, o2[db][2 * k + 1] * inv); }
                att::attn_core_pp<1, 128>(base + 768 + h * 128 + 64, base + 1280 + h * 128 + 64, base + 1792 + h * 128, EVEN_IN, q0, 0, nt, lds, o2, m2, l2);
                { const float inv = lam * __builtin_amdgcn_rcpf(l2 + __shfl_xor(l2, 32)); float ss = 0.f;
#pragma unroll
                  for (int db = 0; db < 4; ++db)
#pragma unroll
                      for (int r = 0; r < 16; ++r) { const unsigned w = o1s[(db * 8 + (r >> 1)) * 64]; const float a1 = __uint_as_float((r & 1) ? (w & 0xffff0000u) : (w << 16));
                          const float v = a1 - inv * o2[db][r]; o2[db][r] = v; ss += v * v; }
                  ss += __shfl_xor(ss, 32);
                  const float rs = __builtin_amdgcn_rsqf(ss * (1.0f / 128.0f) + 1e-6f) * one_m_li;
                  const float* gn = a.diff_norm + e * 128;
#pragma unroll
                  for (int db = 0; db < 4; ++db)
#pragma unroll
                      for (int rg = 0; rg < 4; ++rg) { const f32x4 gv = *(const f32x4*)(gn + 32 * db + 8 * rg + 4 * hi);
#pragma unroll
                          for (int k = 0; k < 4; ++k) o2[db][4 * rg + k] *= rs * gv[k]; } }
                { int tb = threadIdx.x; asm volatile("" : "+v"(tb)); const int t2 = q0 + 32 * (tb >> 6) + (tb & 31);
                  att::store_ot<128>(o2, ao + ((size_t)b * SEQ + t2) * DM + 512 + h * 128, (tb >> 5) & 1); }
            }
#endif
#if PH_SWA
            for (int rep_ = 0; rep_ < REP_SWA; ++rep_)
            for (int uidx = bx; uidx < 2048; uidx += G) {
                const int qb = uidx & 15, qh = (uidx >> 4) & 7, b = uidx >> 7, kvh = qh >> 2;
                { int tb = threadIdx.x; asm volatile("" : "+v"(tb)); const int dd = tb - 256;
                  btab[tb] = (dd < 0 || dd >= 128) ? -__builtin_inff() : a.rel_bias[T5B[dd] * 12 + qh] * att::LOG2E; }
                const bf16* base = proj + (size_t)b * SEQ * EVEN_IN;
                const int q0 = qb * 256, t = q0 + 32 * wave + l32;
                const int kt0 = (qb * 4 - 2 > 0) ? qb * 4 - 2 : 0, nt = qb * 4 + 4 - kt0;
                att::f32x16 o[2]; float m, l;
                att::attn_core_pp<2, 64>(base + qh * 64, base + 512 + kvh * 64, base + 640 + kvh * 64, EVEN_IN, q0, kt0, nt, lds, o, m, l);
                const float sk = a.sinks[e * 8 + qh] * att::LOG2E;
                const float inv = __builtin_amdgcn_rcpf(l + __shfl_xor(l, 32) + __builtin_amdgcn_exp2f(sk - m));
#pragma unroll
                for (int db = 0; db < 2; ++db)
#pragma unroll
                    for (int r = 0; r < 16; ++r) o[db][r] *= inv;
                att::store_ot<64>(o, ao + ((size_t)b * SEQ + t) * DM + qh * 64, hi);
            }
#endif
        } else {
#if PH_SB
            int tq = threadIdx.x; asm volatile("" : "+v"(tq)); const int lane = tq & 63, l32 = lane & 31, hi = lane >> 5;
            for (int rep_ = 0; rep_ < REP_SB; ++rep_)
            for (int uidx = bx; uidx < 4096; uidx += G) {
                const int bh = uidx & 255, qb = 15 - (uidx >> 8), b = bh >> 4, h = bh & 15;
                const bf16* base = proj + (size_t)b * SEQ * ODD_IN;
                const int q0 = qb * 256, nt = 4 * qb + 4, t = q0 + 32 * wave + l32;
                att::f32x16 o[2]; float P, dummy;
                att::attn_core<0, 64>(base + h * 64, base + 1024 + h * 64, base + 2048 + h * 64, ODD_IN, q0, nt - 1, nt, -1, lds, o, P, dummy);
                att::store_ot<64>(o, ao + ((size_t)b * SEQ + t) * DM + h * 64, hi);
            }
#endif
        }
        xcd_barrier(xbar);
        {
            const bf16* wt = even ? (const bf16*)(ws + WS_WOUTE) + (size_t)e * DM * DM : (const bf16*)(ws + WS_WOUTO) + (size_t)e * DM * DM;
            pg8::Gemm g{ao, wt, MTOK, DM, DM}; pg8::StaticOrder S; S.init(MTOK, DM, G, bx);
#if OUT_STAGGER_TICKS > 0
            { const unsigned long long t0 = __builtin_amdgcn_s_memrealtime(); const unsigned long long dly = (unsigned long long)(((bx >> 3) & (OUT_STAGGER_GROUPS - 1)) * OUT_STAGGER_TICKS);
              while (__builtin_amdgcn_s_memrealtime() - t0 < dly) __builtin_amdgcn_s_sleep(8); }
#endif
#if REP_OUT == 2
            { pg8::EpiResid Ed{xold, (float*)(ws + WS_PROJ), (bf16*)(ws + WS_PROJ + 256 * MiB), (float*)(ws + 800 * MiB)};
              pg8::gemm_phase<pg8::EpiResid, pg8::StaticOrder, true, true>(lds, g, S, Ed); }
#elif REP_OUT == 3
            { pg8::EpiScaleBf16 Ed{(bf16*)(ws + WS_PROJ), DM, ssq};
              pg8::gemm_phase<pg8::EpiScaleBf16, pg8::StaticOrder, true, true>(lds, g, S, Ed); }
#endif
#if RESID_BF16
            pg8::EpiResidB E{xb, xb, ssq};
            pg8::gemm_phase<pg8::EpiResidB, pg8::StaticOrder, true, true>(lds, g, S, E);
#else
            pg8::EpiResid E{xold, a.out, xb, ssq};
            pg8::gemm_phase<pg8::EpiResid, pg8::StaticOrder, true, true>(lds, g, S, E);
#endif
        }
        xcd_barrier(xbar);
        const bf16* wup = (const bf16*)(ws + WS_WUP) + (size_t)layer * DUP * DM;
        const bf16* wdn = (const bf16*)(ws + WS_WDN) + (size_t)layer * DM * DFF;
        for (int half = 0; half < 2; ++half) {
            const size_t r0 = (size_t)half * HALF_ROWS;
            {
                pg8::Gemm g{xb + r0 * DM, wup, HALF_ROWS, DUP, DM}; pg8::StaticOrder S; S.init(HALF_ROWS, DUP, G, bx);
                pg8::EpiScaleBf16 E{ubuf, DUP, ssq + r0 * 16};
                for (int rep_ = 0; rep_ < REP_UP; ++rep_)
                pg8::gemm_phase<pg8::EpiScaleBf16, pg8::StaticOrder, true, true>(lds, g, S, E);
            }
            xcd_barrier(xbar);
#if PH_CONV
            {
                const float* cw = a.ffn_conv + (size_t)layer * 3 * DUP; const float* cb = a.ffn_conv_b + (size_t)layer * DUP;
                constexpr int NCC = 6, NRC = HALF_ROWS / 32;
                int tq = threadIdx.x; asm volatile("" : "+v"(tq)); const int lane = tq & 63;
                for (int rep_ = 0; rep_ < REP_CONV; ++rep_)
                for (int it = gw; it < NCC * NRC; it += NGW) {
                    const int cc = it % NCC, rc = it / NCC, cgp = cc * 64 + lane;
                    if (cgp < DFF / 8) {
                        const int col = cgp * 8, row0 = rc * 32;
                        float wg[3][8], wv[3][8], bg[8], bv[8];
#pragma unroll
                        for (int tp = 0; tp < 3; ++tp)
#pragma unroll
                            for (int k = 0; k < 8; k += 4) { const f32x4 t1 = *(const f32x4*)(cw + tp * DUP + col + k), t2 = *(const f32x4*)(cw + tp * DUP + DFF + col + k);
#pragma unroll
                                for (int q = 0; q < 4; ++q) { wg[tp][k + q] = t1[q]; wv[tp][k + q] = t2[q]; } }
#pragma unroll
                        for (int k = 0; k < 8; k += 4) { const f32x4 t1 = *(const f32x4*)(cb + col + k), t2 = *(const f32x4*)(cb + DFF + col + k);
#pragma unroll
                            for (int q = 0; q < 4; ++q) { bg[k + q] = t1[q]; bv[k + q] = t2[q]; } }
                        float g2[8], g1[8], v2[8], v1[8];
                        const bool head = (row0 % SEQ) == 0;
                        {
                            v4u a2 = {0, 0, 0, 0}, a1 = {0, 0, 0, 0}, c2 = {0, 0, 0, 0}, c1 = {0, 0, 0, 0};
                            if (!head) { const bf16* up = ubuf + (size_t)(row0 - 2) * DUP + col; a2 = *(const v4u*)up; c2 = *(const v4u*)(up + DFF); a1 = *(const v4u*)(up + DUP); c1 = *(const v4u*)(up + DUP + DFF); }
#pragma unroll
                            for (int k = 0; k < 8; ++k) { const int sh = (k & 1) * 16;
                                g2[k] = __uint_as_float(((a2[k >> 1] >> sh) & 0xffffu) << 16); g1[k] = __uint_as_float(((a1[k >> 1] >> sh) & 0xffffu) << 16);
                                v2[k] = __uint_as_float(((c2[k >> 1] >> sh) & 0xffffu) << 16); v1[k] = __uint_as_float(((c1[k >> 1] >> sh) & 0xffffu) << 16); }
                        }
                        for (int r4 = 0; r4 < 32; r4 += 8) {
                            v4u av[8], cv[8];
#pragma unroll
                            for (int rr = 0; rr < 8; ++rr) { const bf16* up = ubuf + (size_t)(row0 + r4 + rr) * DUP + col;
                                av[rr] = __builtin_nontemporal_load((const v4u*)up); cv[rr] = __builtin_nontemporal_load((const v4u*)(up + DFF)); }
#pragma unroll
                            for (int rr = 0; rr < 8; ++rr) {
                                const v4u a0 = av[rr], c0 = cv[rr];
                                float res[8];
#pragma unroll
                                for (int k = 0; k < 8; ++k) { const int sh = (k & 1) * 16;
                                    const float g0 = __uint_as_float(((a0[k >> 1] >> sh) & 0xffffu) << 16), v0 = __uint_as_float(((c0[k >> 1] >> sh) & 0xffffu) << 16);
                                    const float gg = bg[k] + wg[0][k] * g2[k] + wg[1][k] * g1[k] + wg[2][k] * g0;
                                    const float vv = bv[k] + wv[0][k] * v2[k] + wv[1][k] * v1[k] + wv[2][k] * v0;
                                    const float sg = gg * __builtin_amdgcn_rcpf(1.0f + __builtin_amdgcn_exp2f(-gg * att::LOG2E));
                                    res[k] = sg * vv; g2[k] = g1[k]; g1[k] = g0; v2[k] = v1[k]; v1[k] = v0; }
                                v4u w; w.x = pk2(res[0], res[1]); w.y = pk2(res[2], res[3]); w.z = pk2(res[4], res[5]); w.w = pk2(res[6], res[7]);
                                *(v4u*)(gbuf + (size_t)(row0 + r4 + rr) * DFF + col) = w;
                            }
                        }
                    }
                }
            }
#endif
            xcd_barrier(xbar);
            {
                pg8::Gemm g{gbuf, wdn, HALF_ROWS, DM, DFF}; pg8::StaticOrder S; S.init(HALF_ROWS, DM, G, bx);
#if REP_DOWN > 1
                { pg8::EpiResid Ed{a.out + r0 * DM, (float*)(ws + 760 * MiB), (bf16*)(ws + 888 * MiB), (float*)(ws + 960 * MiB)};
                  pg8::gemm_phase<pg8::EpiResid, pg8::StaticOrder, true, true>(lds, g, S, Ed); }
#endif
#if RESID_BF16
                pg8::EpiResidB E{xb + r0 * DM, xb + r0 * DM, ssq + r0 * 16};
                pg8::gemm_phase<pg8::EpiResidB, pg8::StaticOrder, true, true>(lds, g, S, E);
#else
                pg8::EpiResid E{a.out + r0 * DM, a.out + r0 * DM, xb + r0 * DM, ssq + r0 * 16};
                pg8::gemm_phase<pg8::EpiResid, pg8::StaticOrder, true, true>(lds, g, S, E);
#endif
            }
            if (half == 1) xcd_barrier(xbar);
        }
    }
    { int tq = threadIdx.x; asm volatile("" : "+v"(tq)); const int lane = tq & 63;
    for (int m = gw; m < MTOK; m += NGW) {
        f32x4* xr = (f32x4*)(a.out + (size_t)m * DM) + lane; f32x4 v[4]; float s = 0.f;
#if RESID_BF16
        const v2u* xin = (const v2u*)(xb + (size_t)m * DM) + lane;
#pragma unroll
        for (int j = 0; j < 4; ++j) { const v2u w = xin[64 * j]; v[j][0] = __uint_as_float(w.x << 16); v[j][1] = __uint_as_float(w.x & 0xffff0000u); v[j][2] = __uint_as_float(w.y << 16); v[j][3] = __uint_as_float(w.y & 0xffff0000u);
            s += (v[j][0] * v[j][0] + v[j][1] * v[j][1]) + (v[j][2] * v[j][2] + v[j][3] * v[j][3]); }
#else
#pragma unroll
        for (int j = 0; j < 4; ++j) { v[j] = xr[64 * j]; s += (v[j][0] * v[j][0] + v[j][1] * v[j][1]) + (v[j][2] * v[j][2] + v[j][3] * v[j][3]); }
#endif
        s = wave_sum(s);
        const float rs = __builtin_amdgcn_rsqf(s * (1.0f / DM) + 1e-6f);
#pragma unroll
        for (int j = 0; j < 4; ++j) { const f32x4 gv = *((const f32x4*)a.norm_final + lane + 64 * j); xr[64 * j] = v[j] * rs * gv; }
    } }
}

extern "C" void kernel_launch(void* const* d_in, const int* in_sizes, int n_in, void* d_out, int out_size, void* d_ws, size_t ws_size, hipStream_t stream) {
    static int grid = 0;
    if (grid == 0) {
        int dev = 0, cus = 0, per_cu = 0;
        (void)hipGetDevice(&dev);
        (void)hipDeviceGetAttribute(&cus, hipDeviceAttributeMultiprocessorCount, dev);
        (void)hipFuncSetAttribute((const void*)mega_fwd, hipFuncAttributeMaxDynamicSharedMemorySize, LDS_BYTES);
        (void)hipOccupancyMaxActiveBlocksPerMultiprocessor(&per_cu, (const void*)mega_fwd, NWAVES * 64, LDS_BYTES);
        if (per_cu < 1) per_cu = 1;
        grid = cus * per_cu;
        if (n_in != 19 || ws_size < 1024 * MiB) fprintf(stderr, "kernel_launch: unexpected n_in %d / ws %zu\n", n_in, ws_size);
    }
    Args a{};
    a.x = (const float*)d_in[0]; a.rel_bias = (const float*)d_in[1]; a.norm_mix = (const float*)d_in[2]; a.norm_ffn = (const float*)d_in[3]; a.norm_final = (const float*)d_in[4];
    a.w_in_even = (const float*)d_in[5]; a.w_out_even = (const float*)d_in[6]; a.sinks = (const float*)d_in[7]; a.lam_q1 = (const float*)d_in[8]; a.lam_k1 = (const float*)d_in[9];
    a.lam_q2 = (const float*)d_in[10]; a.lam_k2 = (const float*)d_in[11]; a.diff_norm = (const float*)d_in[12]; a.w_in_odd = (const float*)d_in[13]; a.w_out_odd = (const float*)d_in[14];
    a.ffn_up = (const float*)d_in[15]; a.ffn_conv = (const float*)d_in[16]; a.ffn_conv_b = (const float*)d_in[17]; a.ffn_down = (const float*)d_in[18];
    a.out = (float*)d_out; a.ws = (unsigned char*)d_ws;
    void* args[] = {&a};
    hipError_t err = hipLaunchCooperativeKernel((const void*)mega_fwd, dim3(grid), dim3(NWAVES * 64), args, LDS_BYTES, stream);
    if (err != hipSuccess) fprintf(stderr, "kernel_launch: cooperative launch failed: %s (grid %d)\n", hipGetErrorString(err), grid);
}
```

```cpp
#include <hip/hip_runtime.h>
#include <hip/hip_cooperative_groups.h>
#include <cstdio>
#include <cstdint>
namespace cg = cooperative_groups;
namespace pg8 {
#define PG8_LAS __attribute__((address_space(3)))
typedef unsigned short bf16_t;
typedef short bf16x8 __attribute__((ext_vector_type(8)));
typedef float f32x4 __attribute__((ext_vector_type(4)));
typedef unsigned u32x4 __attribute__((ext_vector_type(4)));
constexpr int BM = 256, BK = 64, HALF = 128, HTB = HALF * BK * 2  , STAGE_BYTES = 8 * HTB, NXCD = 8, WGM = 8;

__host__ __device__ __forceinline__ int lds_byte(int r, int c) { const int st = (r >> 4) * 2 + (c >> 5), rr = r & 15, cc = c & 31, ob = rr * 64 + cc * 2; return st * 1024 + (ob ^ (((ob >> 9) & 1) << 5)); }
__host__ __device__ __forceinline__ void stage_rc(int b, int& R, int& C) { const int st = b / 1024, sb = b % 1024, swz = sb ^ (((sb >> 9) & 1) << 5); R = (st >> 1) * 16 + swz / 64; C = (st & 1) * 32 + (swz % 64) / 2; }
__host__ __device__ __forceinline__ int perm32(int rho) { const int n = rho >> 4, i = rho & 15; return 8 * (i >> 2) + 4 * n + (i & 3); }

struct Unit { int pm, pn; };
struct Gemm { const bf16_t* A; const bf16_t* Bt; int M, N, K; };

struct StaticOrder {
    int nM, nN, nwg, G, c;
    __host__ __device__ void init(int M, int N, int G_, int c_) { nM = M / BM; nN = N / BM; nwg = nM * nN; G = G_; c = c_; }
    __host__ __device__ bool next(int i, Unit& u) const {
        const long L = (long)i * G + c; if (L >= nwg) return false;
        int wgid = (int)L; { const int q = nwg / NXCD, r = nwg % NXCD, xcd = wgid % NXCD, off = wgid / NXCD; wgid = (xcd < r ? xcd * (q + 1) : r * (q + 1) + (xcd - r) * q) + off; }
        const int nig = WGM * nN, gid = wgid / nig, fm = gid * WGM, gsz = (nM - fm) < WGM ? (nM - fm) : WGM;
        u.pm = fm + ((wgid % nig) % gsz); u.pn = (wgid % nig) / gsz; return true;
    }
    __device__ __forceinline__ void a_ready(const Unit&) const {}
    __device__ __forceinline__ void done(const Unit&) const {}
};

__device__ __forceinline__ unsigned cvt_pk_bf16(float lo, float hi) { unsigned r; asm volatile("v_cvt_pk_bf16_f32 %0, %1, %2" : "=v"(r) : "v"(lo), "v"(hi)); return r; }
typedef float f32x2 __attribute__((ext_vector_type(2)));
typedef unsigned u32x2 __attribute__((ext_vector_type(2)));
constexpr float RMS_EPS = 1e-6f;
struct EpiScaleBf16 {
    static constexpr bool PERM = true, AFTER_DRAIN = false;
    bf16_t* O; int ldc; const float* ssq;
    __device__ __forceinline__ void operator()(const f32x4 (&acc)[2][2][4][2], const Unit& u, int wr, int wc, int fr, int fq) const {
        const int row0 = u.pm * BM + wr * 64 + fr, col0 = u.pn * BM + wc * 32 + 8 * fq;
        f32x4 part[2][4];
#pragma unroll
        for (int ai = 0; ai < 2; ++ai)
#pragma unroll
            for (int m = 0; m < 4; ++m) part[ai][m] = *(const f32x4*)(ssq + (size_t)(row0 + ai * HALF + m * 16) * 16 + fq * 4);
#pragma unroll
        for (int ai = 0; ai < 2; ++ai)
#pragma unroll
            for (int m = 0; m < 4; ++m) { const int row = row0 + ai * HALF + m * 16; bf16_t* rowp = O + (size_t)row * ldc + col0;
                float t = (part[ai][m][0] + part[ai][m][1]) + (part[ai][m][2] + part[ai][m][3]);
                t += __shfl_xor(t, 16); t += __shfl_xor(t, 32);
                const float rs = __builtin_amdgcn_rsqf(t * (1.0f / 1024.0f) + RMS_EPS);
#pragma unroll
                for (int bj = 0; bj < 2; ++bj) { const f32x4 v0 = acc[ai][bj][m][0] * rs, v1 = acc[ai][bj][m][1] * rs;
                    u32x4 w; w.x = cvt_pk_bf16(v0[0], v0[1]); w.y = cvt_pk_bf16(v0[2], v0[3]); w.z = cvt_pk_bf16(v1[0], v1[1]); w.w = cvt_pk_bf16(v1[2], v1[3]);
                    *(u32x4*)(rowp + bj * HALF) = w; } }
    }
};
struct EpiResid {
    static constexpr bool PERM = true, AFTER_DRAIN = false;
    const float* base; float* out; bf16_t* xb; float* ssq;
    __device__ __forceinline__ void operator()(const f32x4 (&acc)[2][2][4][2], const Unit& u, int wr, int wc, int fr, int fq) const {
        const int col0 = u.pn * BM + wc * 32 + 8 * fq;
        const size_t off0 = (size_t)(u.pm * BM + wr * 64 + fr) * 1024 + col0;
        f32x4 nx[2][2][2];
#pragma unroll
        for (int g = 0; g < 2; ++g) { const size_t offn = off0 + (size_t)(g * 16) * 1024;
#pragma unroll
            for (int bj = 0; bj < 2; ++bj)
#pragma unroll
                for (int n = 0; n < 2; ++n) nx[g][bj][n] = *(const f32x4*)(base + offn + bj * HALF + n * 4); }
        asm volatile("" ::: "memory");
#pragma unroll
        for (int g = 0; g < 8; ++g) { const int ai = g >> 2, m = g & 3; const int row = u.pm * BM + ai * HALF + wr * 64 + m * 16 + fr; const size_t off = (size_t)row * 1024 + col0; float q = 0.f;
            f32x4 cu[2][2];
#pragma unroll
            for (int bj = 0; bj < 2; ++bj)
#pragma unroll
                for (int n = 0; n < 2; ++n) cu[bj][n] = nx[g & 1][bj][n];
            if (g < 6) { const size_t offn = off0 + (size_t)(((g + 2) >> 2) * HALF + ((g + 2) & 3) * 16) * 1024;
#pragma unroll
                for (int bj = 0; bj < 2; ++bj)
#pragma unroll
                    for (int n = 0; n < 2; ++n) nx[g & 1][bj][n] = *(const f32x4*)(base + offn + bj * HALF + n * 4); }
#pragma unroll
            for (int bj = 0; bj < 2; ++bj) { const f32x4 o0 = cu[bj][0] + acc[ai][bj][m][0], o1 = cu[bj][1] + acc[ai][bj][m][1];
                *(f32x4*)(out + off + bj * HALF) = o0; *(f32x4*)(out + off + bj * HALF + 4) = o1;
                q += ((o0[0] * o0[0] + o0[1] * o0[1]) + (o0[2] * o0[2] + o0[3] * o0[3])) + ((o1[0] * o1[0] + o1[1] * o1[1]) + (o1[2] * o1[2] + o1[3] * o1[3]));
                u32x4 w; w.x = cvt_pk_bf16(o0[0], o0[1]); w.y = cvt_pk_bf16(o0[2], o0[3]); w.z = cvt_pk_bf16(o1[0], o1[1]); w.w = cvt_pk_bf16(o1[2], o1[3]);
                *(u32x4*)(xb + off + bj * HALF) = w; }
            q += __shfl_xor(q, 16); q += __shfl_xor(q, 32);
            if (fq == 0) ssq[(size_t)row * 16 + u.pn * 4 + wc] = q;
            asm volatile("" ::: "memory"); }
    }
};

struct EpiResidB {
    static constexpr bool PERM = true, AFTER_DRAIN = false;
    const bf16_t* base; bf16_t* xb; float* ssq;
    __device__ __forceinline__ void operator()(const f32x4 (&acc)[2][2][4][2], const Unit& u, int wr, int wc, int fr, int fq) const {
        const int col0 = u.pn * BM + wc * 32 + 8 * fq;
        const size_t off0 = (size_t)(u.pm * BM + wr * 64 + fr) * 1024 + col0;
        u32x4 nx[2][2];
#pragma unroll
        for (int g = 0; g < 2; ++g)
#pragma unroll
            for (int bj = 0; bj < 2; ++bj) nx[g][bj] = *(const u32x4*)(base + off0 + (size_t)(g * 16) * 1024 + bj * HALF);
        asm volatile("" ::: "memory");
#pragma unroll
        for (int g = 0; g < 8; ++g) { const int ai = g >> 2, m = g & 3; const int row = u.pm * BM + ai * HALF + wr * 64 + m * 16 + fr; const size_t off = (size_t)row * 1024 + col0; float q = 0.f;
            u32x4 cu[2];
#pragma unroll
            for (int bj = 0; bj < 2; ++bj) cu[bj] = nx[g & 1][bj];
            if (g < 6) { const size_t offn = off0 + (size_t)(((g + 2) >> 2) * HALF + ((g + 2) & 3) * 16) * 1024;
#pragma unroll
                for (int bj = 0; bj < 2; ++bj) nx[g & 1][bj] = *(const u32x4*)(base + offn + bj * HALF); }
#pragma unroll
            for (int bj = 0; bj < 2; ++bj) {
                f32x4 o0, o1;
                o0[0] = __uint_as_float(cu[bj].x << 16) + acc[ai][bj][m][0][0]; o0[1] = __uint_as_float(cu[bj].x & 0xffff0000u) + acc[ai][bj][m][0][1];
                o0[2] = __uint_as_float(cu[bj].y << 16) + acc[ai][bj][m][0][2]; o0[3] = __uint_as_float(cu[bj].y & 0xffff0000u) + acc[ai][bj][m][0][3];
                o1[0] = __uint_as_float(cu[bj].z << 16) + acc[ai][bj][m][1][0]; o1[1] = __uint_as_float(cu[bj].z & 0xffff0000u) + acc[ai][bj][m][1][1];
                o1[2] = __uint_as_float(cu[bj].w << 16) + acc[ai][bj][m][1][2]; o1[3] = __uint_as_float(cu[bj].w & 0xffff0000u) + acc[ai][bj][m][1][3];
                q += ((o0[0] * o0[0] + o0[1] * o0[1]) + (o0[2] * o0[2] + o0[3] * o0[3])) + ((o1[0] * o1[0] + o1[1] * o1[1]) + (o1[2] * o1[2] + o1[3] * o1[3]));
                u32x4 w; w.x = cvt_pk_bf16(o0[0], o0[1]); w.y = cvt_pk_bf16(o0[2], o0[3]); w.z = cvt_pk_bf16(o1[0], o1[1]); w.w = cvt_pk_bf16(o1[2], o1[3]);
                *(u32x4*)(xb + off + bj * HALF) = w; }
            q += __shfl_xor(q, 16); q += __shfl_xor(q, 32);
            if (fq == 0) ssq[(size_t)row * 16 + u.pn * 4 + wc] = q;
            asm volatile("" ::: "memory"); }
    }
};
template <class Epi, class Sched, bool ALIGN_EPI = false, bool SP2 = false>
__device__ __forceinline__ void gemm_phase(PG8_LAS unsigned char* lds, const Gemm g, const Sched& S, const Epi& E) {
    int tid_ = threadIdx.x; asm volatile("" : "+v"(tid_));
    const int tid = tid_, wid = __builtin_amdgcn_readfirstlane(tid >> 6), lane = tid & 63, wr = wid >> 2, wc = wid & 3, fr = lane & 15, fq = lane >> 4;
    const int K = g.K, nt = K / BK;
    unsigned voffA[2], voffB[2];
#pragma unroll
    for (int i = 0; i < 2; ++i) { int R, C; stage_rc(tid * 16 + i * 8192, R, C); const int Rb = Epi::PERM ? ((R & ~31) + perm32(R & 31)) : R;
        voffA[i] = (unsigned)(R * K + C) * 2u; voffB[i] = (unsigned)(Rb * K + C) * 2u; }
    const size_t kstep = (size_t)(BK * 2);
    const size_t hstep = (size_t)HALF * K * 2;
    const size_t tstep = 2 * hstep;
    const unsigned ldsw = (unsigned)wid * 1024u;
    const int aoff = lds_byte(wr * 64 + fr, fq * 8), boff = lds_byte(wc * 32 + fr, fq * 8);
#define PG8_SA(b, h) (((b) * 2 + (h)) * HTB)
#define PG8_SB(b, h) ((4 + (b) * 2 + (h)) * HTB)
#define PG8_STAGE(bufoff, gbase, voff) do { _Pragma("unroll") for (int _i = 0; _i < 2; ++_i) \
        __builtin_amdgcn_global_load_lds((const unsigned*)((const char*)(gbase) + (voff)[_i]), (PG8_LAS unsigned*)(lds + (bufoff) + ldsw + _i * 8192), 16, 0, 0); } while (0)
#define PG8_LDA(dst, b, h) do { _Pragma("unroll") for (int m = 0; m < 4; ++m) _Pragma("unroll") for (int k = 0; k < 2; ++k) dst[m][k] = *(const PG8_LAS bf16x8*)(lds + PG8_SA(b, h) + aoff + m * 2048 + k * 1024); } while (0)
#define PG8_LDB(dst, b, h) do { _Pragma("unroll") for (int n = 0; n < 2; ++n) _Pragma("unroll") for (int k = 0; k < 2; ++k) dst[n][k] = *(const PG8_LAS bf16x8*)(lds + PG8_SB(b, h) + boff + n * 2048 + k * 1024); } while (0)
#define PG8_MMA(ai, bj, At, Bt) do { __builtin_amdgcn_s_setprio(1); _Pragma("unroll") for (int m = 0; m < 4; ++m) _Pragma("unroll") for (int n = 0; n < 2; ++n) _Pragma("unroll") for (int k = 0; k < 2; ++k) \
        acc[ai][bj][m][n] = __builtin_amdgcn_mfma_f32_16x16x32_bf16(Bt[n][k], At[m][k], acc[ai][bj][m][n], 0, 0, 0); __builtin_amdgcn_s_setprio(0); } while (0)
#define PG8_WAIT_V(n) asm volatile("s_waitcnt vmcnt(" #n ")" ::: "memory")
#define PG8_WAIT_L(n) asm volatile("s_waitcnt lgkmcnt(" #n ")" ::: "memory")
#define PG8_BAR __builtin_amdgcn_s_barrier()
#define PG8_SCHED __builtin_amdgcn_sched_barrier(0)
    Unit cur, nxt; int ui = 0;
    if (!S.next(0, cur)) return;
    f32x4 acc[2][2][4][2];
#pragma unroll
    for (int a = 0; a < 2; ++a)
#pragma unroll
        for (int b = 0; b < 2; ++b)
#pragma unroll
            for (int m = 0; m < 4; ++m)
#pragma unroll
                for (int n = 0; n < 2; ++n) acc[a][b][m][n] = (f32x4){0.f, 0.f, 0.f, 0.f};
    bf16x8 At[4][2], B0[2][2], B1[2][2];
    const char* cA = (const char*)g.A + (size_t)cur.pm * tstep; const char* cB = (const char*)g.Bt + (size_t)cur.pn * tstep;
    S.a_ready(cur);
    if constexpr (SP2) {
        PG8_STAGE(PG8_SB(0, 0), cB, voffB); PG8_STAGE(PG8_SB(0, 1), cB + hstep, voffB); PG8_STAGE(PG8_SA(0, 0), cA, voffA); PG8_STAGE(PG8_SA(0, 1), cA + hstep, voffA);
        if (wr == 1) PG8_BAR;
        PG8_WAIT_V(2); PG8_BAR;
        PG8_STAGE(PG8_SB(1, 0), cB + kstep, voffB); PG8_STAGE(PG8_SA(1, 0), cA + kstep, voffA); PG8_STAGE(PG8_SB(1, 1), cB + hstep + kstep, voffB);
        PG8_WAIT_V(6); PG8_BAR;
    } else {
        PG8_STAGE(PG8_SB(0, 0), cB, voffB); PG8_STAGE(PG8_SA(0, 0), cA, voffA); PG8_STAGE(PG8_SB(0, 1), cB + hstep, voffB); PG8_STAGE(PG8_SA(0, 1), cA + hstep, voffA);
        if (wr == 1) PG8_BAR;
        PG8_WAIT_V(4); PG8_BAR;
        PG8_STAGE(PG8_SB(1, 0), cB + kstep, voffB); PG8_STAGE(PG8_SA(1, 0), cA + kstep, voffA); PG8_STAGE(PG8_SB(1, 1), cB + hstep + kstep, voffB);
        PG8_WAIT_V(6); PG8_BAR;
    }
    for (;;) {
        const bool has_next = S.next(ui + 1, nxt);
        const char* nA = has_next ? (const char*)g.A + (size_t)nxt.pm * tstep : cA; const char* nB = has_next ? (const char*)g.Bt + (size_t)nxt.pn * tstep : cB;
        for (int t = 0; t < nt; t += 2) {
            const bool last = (t == nt - 2);
            const char* a1 = cA + (size_t)(t + 1) * kstep;
            const char* a2 = last ? nA : cA + (size_t)(t + 2) * kstep; const char* b2 = last ? nB : cB + (size_t)(t + 2) * kstep;
            const char* a3 = a2 + kstep; const char* b3 = b2 + kstep;
            if (last && has_next) S.a_ready(nxt);
            if constexpr (SP2) {
            PG8_LDB(B0, 0, 0); PG8_LDB(B1, 0, 1); PG8_SCHED; PG8_LDA(At, 0, 0); PG8_STAGE(PG8_SA(1, 1), a1 + hstep, voffA);
            PG8_WAIT_V(8); PG8_WAIT_L(0); PG8_BAR; PG8_MMA(0, 0, At, B0); PG8_MMA(0, 1, At, B1); PG8_BAR; PG8_SCHED;
            PG8_LDA(At, 0, 1); PG8_STAGE(PG8_SB(0, 0), b2, voffB); PG8_STAGE(PG8_SB(0, 1), b2 + hstep, voffB); PG8_STAGE(PG8_SA(0, 0), a2, voffA);
            PG8_WAIT_V(8); PG8_WAIT_L(0); PG8_BAR; PG8_MMA(1, 0, At, B0); PG8_MMA(1, 1, At, B1); PG8_BAR; PG8_SCHED;
            PG8_LDB(B0, 1, 0); PG8_LDB(B1, 1, 1); PG8_SCHED; PG8_LDA(At, 1, 0); PG8_STAGE(PG8_SA(0, 1), a2 + hstep, voffA);
            PG8_WAIT_V(8); PG8_WAIT_L(0); PG8_BAR; PG8_MMA(0, 0, At, B0); PG8_MMA(0, 1, At, B1); PG8_BAR; PG8_SCHED;
            PG8_LDA(At, 1, 1); PG8_STAGE(PG8_SB(1, 0), b3, voffB); PG8_STAGE(PG8_SB(1, 1), b3 + hstep, voffB); PG8_STAGE(PG8_SA(1, 0), a3, voffA);
            PG8_WAIT_V(8); PG8_WAIT_L(0); PG8_BAR; PG8_MMA(1, 0, At, B0); PG8_MMA(1, 1, At, B1); PG8_BAR; PG8_SCHED;
            } else {
            PG8_LDB(B0, 0, 0); PG8_SCHED; PG8_LDA(At, 0, 0); PG8_STAGE(PG8_SA(1, 1), a1 + hstep, voffA);
            PG8_WAIT_L(8); PG8_BAR; PG8_WAIT_L(0); PG8_MMA(0, 0, At, B0); PG8_BAR; PG8_SCHED;
            PG8_LDB(B1, 0, 1); PG8_STAGE(PG8_SB(0, 0), b2, voffB);
            PG8_BAR; PG8_WAIT_L(0); PG8_MMA(0, 1, At, B1); PG8_BAR;
            PG8_LDA(At, 0, 1); PG8_STAGE(PG8_SA(0, 0), a2, voffA);
            PG8_BAR; PG8_WAIT_L(0); PG8_MMA(1, 0, At, B0); PG8_BAR; PG8_SCHED;
            PG8_STAGE(PG8_SB(0, 1), b2 + hstep, voffB);
            PG8_WAIT_V(6); PG8_BAR; PG8_MMA(1, 1, At, B1); PG8_BAR;
            PG8_LDB(B0, 1, 0); PG8_SCHED; PG8_LDA(At, 1, 0); PG8_STAGE(PG8_SA(0, 1), a2 + hstep, voffA);
            PG8_WAIT_L(8); PG8_BAR; PG8_WAIT_L(0); PG8_MMA(0, 0, At, B0); PG8_BAR; PG8_SCHED;
            PG8_LDB(B1, 1, 1); PG8_STAGE(PG8_SB(1, 0), b3, voffB);
            PG8_BAR; PG8_WAIT_L(0); PG8_MMA(0, 1, At, B1); PG8_BAR;
            PG8_LDA(At, 1, 1); PG8_STAGE(PG8_SA(1, 0), a3, voffA);
            PG8_BAR; PG8_WAIT_L(0); PG8_MMA(1, 0, At, B0); PG8_BAR; PG8_SCHED;
            PG8_STAGE(PG8_SB(1, 1), b3 + hstep, voffB);
            PG8_WAIT_V(6); PG8_BAR; PG8_MMA(1, 1, At, B1); PG8_BAR;
            }
        }
        if constexpr (ALIGN_EPI) { if (wr == 0) PG8_BAR; }
        if constexpr (!Epi::AFTER_DRAIN) { E(acc, cur, wr, wc, fr, fq); S.done(cur); }
        if (!has_next) break;
#pragma unroll
        for (int a = 0; a < 2; ++a)
#pragma unroll
            for (int b = 0; b < 2; ++b)
#pragma unroll
                for (int m = 0; m < 4; ++m)
#pragma unroll
                    for (int n = 0; n < 2; ++n) acc[a][b][m][n] = (f32x4){0.f, 0.f, 0.f, 0.f};
        cur = nxt; cA = nA; cB = nB; ++ui;
        if constexpr (ALIGN_EPI) { if (wr == 1) PG8_BAR; }
    }
    PG8_WAIT_V(0);
    if constexpr (!ALIGN_EPI) { if (wr == 0) PG8_BAR; }
    PG8_BAR;
    if constexpr (Epi::AFTER_DRAIN) { E.fused(acc, cur, wr, wc, fr, fq, lds, wid, lane); S.done(cur); }
#undef PG8_SA
#undef PG8_SB
#undef PG8_STAGE
#undef PG8_LDA
#undef PG8_LDB
#undef PG8_MMA
#undef PG8_WAIT_V
#undef PG8_WAIT_L
#undef PG8_BAR
#undef PG8_SCHED
}
}
namespace att {
#define ALAS __attribute__((address_space(3)))
typedef unsigned short bf16_t;
typedef short bf16x8 __attribute__((ext_vector_type(8)));
typedef float f32x16 __attribute__((ext_vector_type(16)));
typedef float f32x4 __attribute__((ext_vector_type(4)));
typedef unsigned u32x4 __attribute__((ext_vector_type(4)));
typedef unsigned u32x2 __attribute__((ext_vector_type(2)));
constexpr int KROW = 144;
constexpr int KBUF = 64 * KROW;
constexpr int VBUF = 64 * 320;
template <int DV> struct VRow { static constexpr int B = (DV == 128) ? 320 : 192; };
constexpr int L_K = 0, L_V = 2 * KBUF, L_BT = L_V + 2 * VBUF, L_END = L_BT + 2048;
constexpr int L_O1 = L_END;
constexpr int L_QS = L_O1 + 65536;
constexpr float LOG2E = 1.4426950408889634f;
constexpr float QSCALE = 0.125f * 1.4426950408889634f;
#define CR(r) (((r) & 3) + 8 * ((r) >> 2))
typedef float f32x2_t __attribute__((ext_vector_type(2))); typedef __bf16 bf16x2_t __attribute__((ext_vector_type(2)));
__device__ __forceinline__ unsigned cvtpk(float lo, float hi) { f32x2_t v = {lo, hi}; bf16x2_t b = __builtin_convertvector(v, bf16x2_t); return __builtin_bit_cast(unsigned, b); }
__device__ __forceinline__ unsigned cvtpk_a(float lo, float hi) { unsigned r; asm volatile("v_cvt_pk_bf16_f32 %0, %1, %2" : "=v"(r) : "v"(lo), "v"(hi)); return r; }
__device__ __forceinline__ float ex2(float x) { return __builtin_amdgcn_exp2f(x); }
__device__ __forceinline__ float rcpf_(float x) { return __builtin_amdgcn_rcpf(x); }

typedef short v4i16_t __attribute__((ext_vector_type(4)));
__device__ __forceinline__ v4i16_t vtr(const ALAS unsigned char* p) { return __builtin_amdgcn_ds_read_tr16_b64_v4i16((ALAS v4i16_t*)p); }
template <int DV> __device__ __forceinline__ bf16x8 vfrag(const ALAS unsigned char* vb, int s, int db) {
    const v4i16_t lo = vtr(vb + (16 * s) * VRow<DV>::B + 64 * db), hi4 = vtr(vb + (16 * s + 8) * VRow<DV>::B + 64 * db);
    return __builtin_shufflevector(lo, hi4, 0, 1, 2, 3, 4, 5, 6, 7);
}
template <int DV> __device__ __forceinline__ int vtr_lane_off(int lane) { return (4 * (lane >> 5) + ((lane & 15) >> 2)) * VRow<DV>::B + (16 * ((lane >> 4) & 1) + 4 * (lane & 3)) * 2; }
__device__ __forceinline__ float pair_max(float x) { auto rr = __builtin_amdgcn_permlane32_swap(__float_as_uint(x), __float_as_uint(x), false, false); return fmaxf(__uint_as_float(rr[0]), __uint_as_float(rr[1])); }
template <int DV> struct Pref { u32x4 k; u32x4 v[DV / 64]; };

template <int DV> __device__ __forceinline__ void tile_load(Pref<DV>& pf, const bf16_t* Kp, const bf16_t* Vp, int pitch, int kt, int tid) {
    const int krow = tid >> 3, kc = (tid & 7) * 8;
    pf.k = *(const u32x4*)(Kp + (size_t)(kt * 64 + krow) * pitch + kc);
#pragma unroll
    for (int i = 0; i < DV / 64; ++i) { const int c = tid + i * 512, vrow = c / (DV / 8), vc = (c % (DV / 8)) * 8;
        pf.v[i] = *(const u32x4*)(Vp + (size_t)(kt * 64 + vrow) * pitch + vc); }
}
template <int DV> __device__ __forceinline__ void tile_store(const Pref<DV>& pf, ALAS unsigned char* kbuf, ALAS unsigned char* vbuf, int tid) {
    const int krow = tid >> 3, kc = (tid & 7) * 8;
    *(ALAS u32x4*)(kbuf + krow * KROW + kc * 2) = pf.k;
#pragma unroll
    for (int i = 0; i < DV / 64; ++i) { const int c = tid + i * 512, vrow = c / (DV / 8), vc = (c % (DV / 8)) * 8;
        *(ALAS u32x4*)(vbuf + vrow * VRow<DV>::B + vc * 2) = pf.v[i]; }
}

template <int DV> __device__ __forceinline__ void pv_slab(const ALAS unsigned char* vbuf, int s, u32x4 w, f32x16 (&o)[DV / 32], int l32, int hi) {
    const bf16x8 pfr = __builtin_bit_cast(bf16x8, w);
#pragma unroll
    for (int db = 0; db < DV / 32; ++db) {
        const bf16x8 vf = vfrag<DV>(vbuf + vtr_lane_off<DV>(l32 + 32 * hi), s, db);
        o[db] = __builtin_amdgcn_mfma_f32_32x32x16_bf16(vf, pfr, o[db], 0, 0, 0); }
    if (DV > 64) __builtin_amdgcn_sched_barrier(0);
}

template <int MODE, int DV, bool MASKED>
__device__ __forceinline__ void tile_compute(const ALAS unsigned char* kbuf, const ALAS unsigned char* vbuf, const bf16x8 (&qf)[4], f32x16 (&o)[DV / 32],
                                             float& st_m, float& st_l, int lim, const ALAS float* btab, float cbias, int lane) {
    const int l32 = lane & 31, hi = lane >> 5;
    if constexpr (MODE == 0) {
        f32x16 p0, p1;
#pragma unroll
        for (int r = 0; r < 16; ++r) { p0[r] = 0.f; p1[r] = 0.f; }
        { const ALAS unsigned char* kb = kbuf + l32 * KROW + hi * 16;
#pragma unroll
          for (int d0 = 0; d0 < 4; ++d0) {
              const bf16x8 k0 = *(const ALAS bf16x8*)(kb + d0 * 32);
              const bf16x8 k1 = *(const ALAS bf16x8*)(kb + 32 * KROW + d0 * 32);
              p0 = __builtin_amdgcn_mfma_f32_32x32x16_bf16(k0, qf[d0], p0, 0, 0, 0);
              p1 = __builtin_amdgcn_mfma_f32_32x32x16_bf16(k1, qf[d0], p1, 0, 0, 0); } }
        __builtin_amdgcn_sched_barrier(0);
#pragma unroll
        for (int r = 0; r < 16; ++r) {
            float a = rcpf_(1.0f + ex2(p0[r])), b = rcpf_(1.0f + ex2(p1[r]));
            if (MASKED) { a = (CR(r) < lim) ? a : 1.0f; b = (CR(r) + 32 < lim) ? b : 1.0f; }
            p0[r] = a; p1[r] = b; }
        float g[8], hs[8], pr[8];
#pragma unroll
        for (int i = 0; i < 4; ++i) { g[i] = (p0[4 * i] * p0[4 * i + 1]) * (p0[4 * i + 2] * p0[4 * i + 3]); g[4 + i] = (p1[4 * i] * p1[4 * i + 1]) * (p1[4 * i + 2] * p1[4 * i + 3]); }
#pragma unroll
        for (int i = 0; i < 8; ++i) { auto rr = __builtin_amdgcn_permlane32_swap(__float_as_uint(g[i]), __float_as_uint(g[i]), false, false);
            pr[i] = __uint_as_float(rr[0]) * __uint_as_float(rr[1]); hs[i] = hi ? 1.0f : __uint_as_float(rr[1]); }
        float T = st_m;
#pragma unroll
        for (int i = 7; i >= 0; --i) {
            float R = hs[i] * T; T = T * pr[i];
            if (i >= 4) { const int b = 4 * (i - 4);
                float R2 = R * p1[b + 3]; p1[b + 3] = R - R2; float R1 = R2 * p1[b + 2]; p1[b + 2] = R2 - R1; float R0 = R1 * p1[b + 1]; p1[b + 1] = R1 - R0; p1[b] = R0 - R0 * p1[b]; }
            else { const int b = 4 * i;
                float R2 = R * p0[b + 3]; p0[b + 3] = R - R2; float R1 = R2 * p0[b + 2]; p0[b + 2] = R2 - R1; float R0 = R1 * p0[b + 1]; p0[b + 1] = R1 - R0; p0[b] = R0 - R0 * p0[b]; }
        }
        st_m = T;
        __builtin_amdgcn_sched_barrier(0);
#pragma unroll
        for (int s = 0; s < 4; ++s) {
            u32x4 w;
            if (s == 0) { w.x = cvtpk(p0[0], p0[1]); w.y = cvtpk(p0[2], p0[3]); w.z = cvtpk(p0[4], p0[5]); w.w = cvtpk(p0[6], p0[7]); }
            else if (s == 1) { w.x = cvtpk(p0[8], p0[9]); w.y = cvtpk(p0[10], p0[11]); w.z = cvtpk(p0[12], p0[13]); w.w = cvtpk(p0[14], p0[15]); }
            else if (s == 2) { w.x = cvtpk(p1[0], p1[1]); w.y = cvtpk(p1[2], p1[3]); w.z = cvtpk(p1[4], p1[5]); w.w = cvtpk(p1[6], p1[7]); }
            else { w.x = cvtpk(p1[8], p1[9]); w.y = cvtpk(p1[10], p1[11]); w.z = cvtpk(p1[12], p1[13]); w.w = cvtpk(p1[14], p1[15]); }
            pv_slab<DV>(vbuf, s, w, o, l32, hi);
        }
    } else {
        const float NEG = -__builtin_inff();
#pragma unroll
        for (int hk = 0; hk < 2; ++hk) {
            f32x16 p;
            const bool fresh = (st_m == NEG);
            const float mbase = fresh ? 0.f : st_m;
            { const float ini = (MASKED ? 0.f : cbias) - mbase;
#pragma unroll
              for (int r = 0; r < 16; ++r) p[r] = ini; }
            { const ALAS unsigned char* kb = kbuf + (32 * hk + l32) * KROW + hi * 16;
#pragma unroll
              for (int d0 = 0; d0 < 4; ++d0) { const bf16x8 k0 = *(const ALAS bf16x8*)(kb + d0 * 32); p = __builtin_amdgcn_mfma_f32_32x32x16_bf16(k0, qf[d0], p, 0, 0, 0); } }
            if (MASKED) {
                float bv[16];
#pragma unroll
                for (int r = 0; r < 16; ++r) { const int d0 = lim - 32 * hk - CR(r); bv[r] = btab[min(max(d0, 0), 127)]; }
#pragma unroll
                for (int r = 0; r < 16; ++r) asm volatile("" : "+v"(bv[r]));
#pragma unroll
                for (int r = 0; r < 16; ++r) {
                    const int d0 = lim - 32 * hk - CR(r);
                    const bool v0 = (MODE == 2) ? ((unsigned)d0 < 128u) : (d0 >= 0);
                    p[r] = v0 ? p[r] + bv[r] : NEG; }
            }
            float mt = fmaxf(p[0], p[1]);
#pragma unroll
            for (int r = 2; r < 16; ++r) mt = fmaxf(mt, p[r]);
            mt = fmaxf(mt, __shfl_xor(mt, 32));
            const bool need = fresh ? (mt > NEG) : (mt > 0.f);
            if (__any(need)) {
                const float dl = need ? mt : 0.f, f = fresh ? 1.0f : ex2(-dl);
                st_l *= f; st_m = need ? mbase + dl : st_m;
#pragma unroll
                for (int r = 0; r < 16; ++r) p[r] -= dl;
#pragma unroll
                for (int db = 0; db < DV / 32; ++db)
#pragma unroll
                    for (int r = 0; r < 16; ++r) o[db][r] *= f;
            }
            float s = 0.f;
#pragma unroll
            for (int r = 0; r < 16; ++r) { p[r] = ex2(p[r]); s += p[r]; }
            st_l += s;
#pragma unroll
            for (int s2 = 0; s2 < 2; ++s2) {
                u32x4 w; w.x = cvtpk(p[8 * s2], p[8 * s2 + 1]); w.y = cvtpk(p[8 * s2 + 2], p[8 * s2 + 3]); w.z = cvtpk(p[8 * s2 + 4], p[8 * s2 + 5]); w.w = cvtpk(p[8 * s2 + 6], p[8 * s2 + 7]);
                pv_slab<DV>(vbuf, 2 * hk + s2, w, o, l32, hi);
            }
        }
    }
}

template <int MODE, int DV>
__device__ __forceinline__ void attn_core(const bf16_t* Qp, const bf16_t* Kp, const bf16_t* Vp, int pitch, int q0, int kt0, int nt, int dir,
                                          ALAS unsigned char* lds, f32x16 (&o)[DV / 32], float& st_m, float& st_l) {
    int tid_ = threadIdx.x; asm volatile("" : "+v"(tid_));
    const int tid = tid_, lane = tid & 63, l32 = lane & 31, hi = lane >> 5, wid = __builtin_amdgcn_readfirstlane(tid >> 6);
    const int qw = q0 + 32 * wid, t = qw + l32;
    const ALAS float* btab = (const ALAS float*)(lds + L_BT);
    bf16x8 qf[4];
#pragma unroll
    for (int d0 = 0; d0 < 4; ++d0) qf[d0] = *(const bf16x8*)(Qp + (size_t)t * pitch + d0 * 16 + hi * 8);
#pragma unroll
    for (int db = 0; db < DV / 32; ++db)
#pragma unroll
        for (int r = 0; r < 16; ++r) o[db][r] = 0.f;
    st_m = (MODE == 0) ? 1.0f : -__builtin_inff(); st_l = 0.f;
    Pref<DV> pfA, pfB;
    tile_load<DV>(pfA, Kp, Vp, pitch, kt0, tid);
    tile_load<DV>(pfB, Kp, Vp, pitch, kt0 + dir * min(1, nt - 1), tid);
    tile_store<DV>(pfA, lds + L_K, lds + L_V, tid);
    __syncthreads();
    const float cbias = (MODE == 1) ? btab[127] : 0.f;
    bool done = false;
#define AC_STEP(it_, PFN, PFS) do { \
        const int it = (it_), kt = kt0 + dir * it, cur = it & 1, kbase = kt * 64; \
        tile_load<DV>(PFN, Kp, Vp, pitch, kt0 + dir * min(it + 2, nt - 1), tid);        \
        const ALAS unsigned char* kb = lds + L_K + cur * KBUF; const ALAS unsigned char* vb = lds + L_V + cur * VBUF; \
        const int lim = t - kbase - 4 * hi; \
        if (MODE == 0) { \
            if (kbase <= qw + 31 && __any(st_m != 0.0f)) { if (kbase + 63 >= qw) tile_compute<0, DV, true>(kb, vb, qf, o, st_m, st_l, lim, btab, cbias, lane); else tile_compute<0, DV, false>(kb, vb, qf, o, st_m, st_l, lim, btab, cbias, lane); } \
        } else if (MODE == 1) { \
            if (kbase <= qw + 31) { if (qw - (kbase + 63) < 113) tile_compute<1, DV, true>(kb, vb, qf, o, st_m, st_l, lim, btab, cbias, lane); else tile_compute<1, DV, false>(kb, vb, qf, o, st_m, st_l, lim, btab, cbias, lane); } \
        } else { \
            if (kbase <= qw + 31 && kbase + 63 >= qw - 127) tile_compute<2, DV, true>(kb, vb, qf, o, st_m, st_l, lim, btab, cbias, lane); \
        } \
        if (it + 1 < nt) tile_store<DV>(PFS, lds + L_K + (cur ^ 1) * KBUF, lds + L_V + (cur ^ 1) * VBUF, tid);     \
        if (MODE == 0) { \
              \
            if (!__syncthreads_or(st_m != 0.0f)) done = true; \
        } else __syncthreads(); } while (0)
    for (int it2 = 0; it2 < nt && !done; it2 += 2) {
        AC_STEP(it2, pfA, pfB);
        if (done) break;
        AC_STEP(it2 + 1, pfB, pfA);
    }
#undef AC_STEP
}
template <int MODE, int DV>
__device__ __forceinline__ void attn_core_pp(const bf16_t* Qp, const bf16_t* Kp, const bf16_t* Vp, int pitch, int q0, int kt0, int nt,
                                             ALAS unsigned char* lds, f32x16 (&o)[DV / 32], float& st_m, float& st_l) {
    int tid_ = threadIdx.x; asm volatile("" : "+v"(tid_));
    const int tid = tid_, lane = tid & 63, l32 = lane & 31, hi = lane >> 5, wid = __builtin_amdgcn_readfirstlane(tid >> 6), grp = wid >> 2;
    const int qw = q0 + 32 * wid, t = qw + l32;
    const ALAS float* btab = (const ALAS float*)(lds + L_BT);
    const float NEG = -__builtin_inff();
    bf16x8 qf[4];
#pragma unroll
    for (int d0 = 0; d0 < 4; ++d0) qf[d0] = *(const bf16x8*)(Qp + (size_t)t * pitch + d0 * 16 + hi * 8);
    ALAS unsigned char* qst = lds + L_QS + wid * 3072 + lane * 16;
    if (DV == 128) {
#pragma unroll
        for (int d0 = 1; d0 < 4; ++d0) *(ALAS bf16x8*)(qst + (d0 - 1) * 1024) = qf[d0];
    }
#pragma unroll
    for (int db = 0; db < DV / 32; ++db)
#pragma unroll
        for (int r = 0; r < 16; ++r) o[db][r] = 0.f;
    st_m = NEG; st_l = 0.f;
    Pref<DV> pfA, pfB;
    tile_load<DV>(pfA, Kp, Vp, pitch, kt0, tid);
    tile_load<DV>(pfB, Kp, Vp, pitch, kt0 + 1, tid);
    tile_store<DV>(pfA, lds + L_K, lds + L_V, tid);
    tile_store<DV>(pfB, lds + L_K + KBUF, lds + L_V + VBUF, tid);
    tile_load<DV>(pfA, Kp, Vp, pitch, kt0 + min(2, nt - 1), tid);
    tile_load<DV>(pfB, Kp, Vp, pitch, kt0 + min(3, nt - 1), tid);
    __syncthreads();
    const float cbias = (MODE == 1) ? btab[256 + 127] : 0.f;
    f32x16 p; u32x4 pw0, pw1;
#pragma unroll
    for (int r = 0; r < 16; ++r) p[r] = 0.f;
    pw0 = (u32x4){0u, 0u, 0u, 0u}; pw1 = pw0;
#define PP_MASKED(ti) ((MODE == 1) ? (qw - ((kt0 + (ti)) * 64 + 63) < 113) : true)
#define PP_PART(ti) ((MODE != 2) || ((kt0 + (ti)) * 64 <= qw + 31 && (kt0 + (ti)) * 64 + 63 >= qw - 127))
#define PP_QK(ti, hk) do { \
        const float mbase_ = (st_m == NEG) ? 0.f : st_m; const float ini_ = (PP_MASKED(ti) ? 0.f : cbias) - mbase_; \
        _Pragma("unroll") for (int r = 0; r < 16; ++r) p[r] = ini_; \
        const ALAS unsigned char* kb_ = lds + L_K + ((ti) & 1) * KBUF + (32 * (hk) + l32) * KROW + hi * 16; \
        _Pragma("unroll") for (int d0 = 0; d0 < 4; ++d0) { const bf16x8 k0_ = *(const ALAS bf16x8*)(kb_ + d0 * 32); \
            const bf16x8 qv_ = (DV == 128 && d0 > 0) ? *(const ALAS bf16x8*)(qst + (d0 - 1) * 1024) : qf[d0]; \
            p = __builtin_amdgcn_mfma_f32_32x32x16_bf16(k0_, qv_, p, 0, 0, 0); } } while (0)
#define PP_PVQK(tv, hv, tk, hq) do { \
        const ALAS unsigned char* vb_ = lds + L_V + ((tv) & 1) * VBUF + vtr_lane_off<DV>(lane); \
        const ALAS unsigned char* kb_ = lds + L_K + ((tk) & 1) * KBUF + (32 * (hq) + l32) * KROW + hi * 16; \
        if (PP_PART(tv)) { \
            bf16x8 vf_[DV / 32][2]; \
            _Pragma("unroll") for (int db = 0; db < DV / 32; ++db) { vf_[db][0] = vfrag<DV>(vb_, 2 * (hv), db); vf_[db][1] = vfrag<DV>(vb_, 2 * (hv) + 1, db); } \
            const bf16x8 pa_ = __builtin_bit_cast(bf16x8, pw0), pb_ = __builtin_bit_cast(bf16x8, pw1); \
            _Pragma("unroll") for (int db = 0; db < DV / 32; ++db) o[db] = __builtin_amdgcn_mfma_f32_32x32x16_bf16(vf_[db][0], pa_, o[db], 0, 0, 0); \
            _Pragma("unroll") for (int db = 0; db < DV / 32; ++db) o[db] = __builtin_amdgcn_mfma_f32_32x32x16_bf16(vf_[db][1], pb_, o[db], 0, 0, 0); } \
        if (PP_PART(tk)) { \
            bf16x8 kf_[4], qv_[4]; \
            _Pragma("unroll") for (int d0 = 0; d0 < 4; ++d0) { kf_[d0] = *(const ALAS bf16x8*)(kb_ + d0 * 32); qv_[d0] = (DV == 128 && d0 > 0) ? *(const ALAS bf16x8*)(qst + (d0 - 1) * 1024) : qf[d0]; } \
            const float mbase_ = (st_m == NEG) ? 0.f : st_m; const float ini_ = (PP_MASKED(tk) ? 0.f : cbias) - mbase_; \
            _Pragma("unroll") for (int r = 0; r < 16; ++r) p[r] = ini_; \
            _Pragma("unroll") for (int d0 = 0; d0 < 4; ++d0) p = __builtin_amdgcn_mfma_f32_32x32x16_bf16(kf_[d0], qv_[d0], p, 0, 0, 0); } } while (0)
#define PP_SM(ti, hk) do { if (PP_PART(ti)) { \
        if (PP_MASKED(ti)) { const int lim_ = t - (kt0 + (ti)) * 64 - 4 * hi - 32 * (hk); \
            const ALAS float* bp_ = btab + (lim_ + 256 - 27);            \
            float bv_[16]; \
            _Pragma("unroll") for (int r = 0; r < 16; ++r) bv_[r] = bp_[27 - CR(r)]; \
            _Pragma("unroll") for (int r = 0; r < 16; ++r) p[r] += bv_[r]; } \
        const bool fresh_ = (st_m == NEG); const float mb_ = fresh_ ? 0.f : st_m; \
        float mt_; { const float a0_ = fmaxf(fmaxf(p[0], p[1]), p[2]), a1_ = fmaxf(fmaxf(p[3], p[4]), p[5]), a2_ = fmaxf(fmaxf(p[6], p[7]), p[8]), a3_ = fmaxf(fmaxf(p[9], p[10]), p[11]), a4_ = fmaxf(fmaxf(p[12], p[13]), p[14]); \
            mt_ = fmaxf(fmaxf(fmaxf(a0_, a1_), a2_), fmaxf(fmaxf(a3_, a4_), p[15])); }        \
        mt_ = pair_max(mt_); \
        const bool need_ = fresh_ ? (mt_ > NEG) : (mt_ > 0.f); \
        if (__any(need_)) { const float dl_ = need_ ? mt_ : 0.f, f_ = fresh_ ? 1.0f : ex2(-dl_); \
            st_l *= f_; st_m = need_ ? mb_ + dl_ : st_m; \
            _Pragma("unroll") for (int r = 0; r < 16; ++r) p[r] -= dl_; \
            _Pragma("unroll") for (int db = 0; db < DV / 32; ++db) _Pragma("unroll") for (int r = 0; r < 16; ++r) o[db][r] *= f_; } \
        _Pragma("unroll") for (int r = 0; r < 16; ++r) p[r] = ex2(p[r]); \
        st_l += ((p[0] + p[1]) + (p[2] + p[3])) + ((p[4] + p[5]) + (p[6] + p[7])) + (((p[8] + p[9]) + (p[10] + p[11])) + ((p[12] + p[13]) + (p[14] + p[15]))); \
        pw0.x = cvtpk_a(p[0], p[1]); pw0.y = cvtpk_a(p[2], p[3]); pw0.z = cvtpk_a(p[4], p[5]); pw0.w = cvtpk_a(p[6], p[7]); \
        pw1.x = cvtpk_a(p[8], p[9]); pw1.y = cvtpk_a(p[10], p[11]); pw1.z = cvtpk_a(p[12], p[13]); pw1.w = cvtpk_a(p[14], p[15]); } } while (0)
#define PP_STAGE(u, PF) do { const int u_ = (u); if (u_ >= 2 && u_ < nt) tile_store<DV>(PF, lds + L_K + (u_ & 1) * KBUF, lds + L_V + (u_ & 1) * VBUF, tid); \
        tile_load<DV>(PF, Kp, Vp, pitch, kt0 + min(u_ + 2, nt - 1), tid); } while (0)
#define PP_BAR() asm volatile("s_waitcnt lgkmcnt(0)\n\ts_barrier" ::: "memory")
    if (grp == 1) __builtin_amdgcn_s_setprio(1);
    if (grp == 0) {
        PP_QK(0, 0); PP_BAR();
        for (int ti = 0; ti < nt; ti += 2) {
            PP_SM(ti, 0); PP_BAR();
            PP_PVQK(ti, 0, ti, 1); PP_STAGE(ti + 1, pfB); PP_BAR();
            PP_SM(ti, 1); PP_BAR();
            PP_PVQK(ti, 1, ti + 1, 0); PP_BAR();
            PP_SM(ti + 1, 0); PP_BAR();
            PP_PVQK(ti + 1, 0, ti + 1, 1); PP_STAGE(ti + 2, pfA); PP_BAR();
            PP_SM(ti + 1, 1); PP_BAR();
            PP_PVQK(ti + 1, 1, ti + 2, 0); PP_BAR();
        }
        PP_BAR();
    } else {
        PP_BAR();
        PP_QK(0, 0); PP_BAR();
        for (int ti = 0; ti < nt; ti += 2) {
            PP_SM(ti, 0); PP_STAGE(ti + 1, pfB); PP_BAR();
            PP_PVQK(ti, 0, ti, 1); PP_BAR();
            PP_SM(ti, 1); PP_BAR();
            PP_PVQK(ti, 1, ti + 1, 0); PP_BAR();
            PP_SM(ti + 1, 0); PP_STAGE(ti + 2, pfA); PP_BAR();
            PP_PVQK(ti + 1, 0, ti + 1, 1); PP_BAR();
            PP_SM(ti + 1, 1); PP_BAR();
            PP_PVQK(ti + 1, 1, ti + 2, 0); PP_BAR();
        }
    }
    __builtin_amdgcn_s_setprio(0);
#undef PP_MASKED
#undef PP_PART
#undef PP_QK
#undef PP_PVQK
#undef PP_SM
#undef PP_STAGE
#undef PP_BAR
}
template <int DV> __device__ __forceinline__ void store_ot(const f32x16 (&o)[DV / 32], bf16_t* orow, int hi) {
#pragma unroll
    for (int db = 0; db < DV / 32; ++db)
#pragma unroll
        for (int rg = 0; rg < 4; ++rg) { u32x2 w; w.x = cvtpk_a(o[db][4 * rg], o[db][4 * rg + 1]); w.y = cvtpk_a(o[db][4 * rg + 2], o[db][4 * rg + 3]);
            *(u32x2*)(orow + 32 * db + 8 * rg + 4 * hi) = w; }
}
}
#ifndef RESID_BF16
#define RESID_BF16 1
#endif
#ifndef OUT_STAGGER_TICKS
#define OUT_STAGGER_TICKS 0
#endif
#ifndef OUT_STAGGER_GROUPS
#define OUT_STAGGER_GROUPS 2
#endif
#ifndef REP_OUT
#define REP_OUT 1
#endif
#ifndef REP_DOWN
#define REP_DOWN 1
#endif
#ifndef REP_INPROJ
#define REP_INPROJ 1
#endif
#ifndef REP_DIFF
#define REP_DIFF 1
#endif
#ifndef REP_SWA
#define REP_SWA 1
#endif
#ifndef REP_SB
#define REP_SB 1
#endif
#ifndef REP_UP
#define REP_UP 1
#endif
#ifndef REP_CONV
#define REP_CONV 1
#endif
#ifndef PH_DIFF
#define PH_DIFF 1
#endif
#ifndef PH_SWA
#define PH_SWA 1
#endif
#ifndef PH_SB
#define PH_SB 1
#endif
#ifndef PH_CONV
#define PH_CONV 1
#endif
#define LAS __attribute__((address_space(3)))
typedef unsigned short bf16;
typedef float f32x4 __attribute__((ext_vector_type(4)));
typedef unsigned v4u __attribute__((ext_vector_type(4)));
typedef unsigned v2u __attribute__((ext_vector_type(2)));
constexpr int NWAVES = 8;
constexpr int SEQ = 4096, NB = 16, MTOK = NB * SEQ, DM = 1024, DFF = 2816, DUP = 2 * DFF;
constexpr int EVEN_IN = 2304, ODD_IN = 3072;
constexpr size_t MiB = 1u << 20;
constexpr size_t WS_SSQ = 1 * MiB;
constexpr size_t WS_WINE = 8 * MiB, WS_WOUTE = 17 * MiB, WS_WINO = 21 * MiB, WS_WOUTO = 33 * MiB, WS_WUP = 37 * MiB, WS_WDN = 81 * MiB;
constexpr size_t WS_XB = 104 * MiB, WS_R = 232 * MiB;
constexpr size_t WS_PROJ = WS_R, WS_AO = WS_R + 384 * MiB, WS_U = WS_R, WS_G = WS_R + 352 * MiB;
constexpr int LDS_MISC = 152576, LDS_BYTES = 153600;
static_assert(att::L_QS + 8 * 3072 <= LDS_MISC, "LDS map");
constexpr int HALF_ROWS = MTOK / 2;

struct Args {
    const float* x; const float* rel_bias; const float* norm_mix; const float* norm_ffn; const float* norm_final;
    const float* w_in_even; const float* w_out_even; const float* sinks; const float* lam_q1; const float* lam_k1; const float* lam_q2; const float* lam_k2;
    const float* diff_norm; const float* w_in_odd; const float* w_out_odd; const float* ffn_up; const float* ffn_conv; const float* ffn_conv_b; const float* ffn_down;
    float* out; unsigned char* ws;
};

__device__ const unsigned char T5B[128] = {0, 1, 2, 3, 4, 5, 6, 7, 8, 9, 10, 11, 12, 13, 14, 15, 16, 16, 16, 17, 17, 18, 18, 18, 19, 19, 19, 20, 20, 20, 20, 21, 21, 21, 21, 22, 22, 22, 22, 22, 23, 23, 23, 23, 23, 23, 24, 24, 24, 24, 24, 24, 25, 25, 25, 25, 25, 25, 25, 26, 26, 26, 26, 26, 26, 26, 26, 27, 27, 27, 27, 27, 27, 27, 27, 27, 27, 28, 28, 28, 28, 28, 28, 28, 28, 28, 28, 29, 29, 29, 29, 29, 29, 29, 29, 29, 29, 29, 29, 30, 30, 30, 30, 30, 30, 30, 30, 30, 30, 30, 30, 30, 30, 31, 31, 31, 31, 31, 31, 31, 31, 31, 31, 31, 31, 31, 31, 31};

__device__ __forceinline__ float wave_sum(float v) {
#pragma unroll
    for (int o = 1; o < 64; o <<= 1) v += __shfl_xor(v, o);
    return v;
}
__device__ __forceinline__ unsigned f2bf(float f) { unsigned u = __builtin_bit_cast(unsigned, f); return (u + 0x7fffu + ((u >> 16) & 1u)) >> 16; }
__device__ __forceinline__ unsigned pk2(float lo, float hi) { return f2bf(lo) | (f2bf(hi) << 16); }

__device__ __forceinline__ void transpose_item(const float* W, int K, int N, bf16* WT, const float* gk, int a0, int a1, int b0, int b1, float cs, LAS float* scr, int item, int lane) {
    const int nblk = N / 32, kb = item / nblk, nb = item % nblk, k0 = 64 * kb, n0 = 32 * nb;
    const int nn = n0 + (lane & 31);
    const float csc = ((nn >= a0 && nn < a1) || (nn >= b0 && nn < b1)) ? cs : 1.0f;
#pragma unroll 8
    for (int i = 0; i < 32; ++i) { const int kk = 2 * i + (lane >> 5); const float gv = gk ? gk[k0 + kk] : 1.0f; scr[kk * 33 + (lane & 31)] = W[(size_t)(k0 + kk) * N + nn] * (gv * csc); }
    asm volatile("s_waitcnt lgkmcnt(0)" ::: "memory");
    const int c = lane & 7;
#pragma unroll
    for (int j = 0; j < 4; ++j) { const int n = (lane >> 3) + 8 * j; const LAS float* s = scr + (8 * c) * 33 + n;
        v4u o; o.x = pk2(s[0 * 33], s[1 * 33]); o.y = pk2(s[2 * 33], s[3 * 33]); o.z = pk2(s[4 * 33], s[5 * 33]); o.w = pk2(s[6 * 33], s[7 * 33]);
        *(v4u*)(WT + (size_t)(n0 + n) * K + k0 + 8 * c) = o; }
    asm volatile("s_waitcnt lgkmcnt(0)" ::: "memory");
}

#define XB_TMO      128
#define XB_XCNT(j)  (256  + 64 * (j))
#define XB_XSUB(j)  (1280 + 64 * (j))
#define XB_XGEN(j)  (2304 + 64 * (j))
#define XB_TOP      3328
#define XB_TOPGEN   3392
#define XCD_BAR_WORDS 3456
#define XB_SPIN_CAP (1u << 18)

__device__ __forceinline__ unsigned xb_ld(unsigned* p)              { return __hip_atomic_load(p, __ATOMIC_RELAXED, __HIP_MEMORY_SCOPE_AGENT); }
__device__ __forceinline__ unsigned xb_add(unsigned* p, unsigned v) { return __hip_atomic_fetch_add(p, v, __ATOMIC_RELAXED, __HIP_MEMORY_SCOPE_AGENT); }
__device__ __forceinline__ unsigned xb_xcc_id() { return (unsigned)__builtin_amdgcn_s_getreg((3 << 11) | 20) & 0xFu; }
#define XB_SPIN(cond, bar) do { unsigned _sp = 0; while (cond) { __builtin_amdgcn_s_sleep(1); \
    if ((++_sp & 255u) == 0u) { if (xb_ld(&(bar)[XB_TMO])) break; if (_sp > XB_SPIN_CAP) { atomicAdd(&(bar)[XB_TMO], 1u); break; } } } } while (0)

struct XcdBarrier {
    unsigned* bar; unsigned x;
    volatile LAS unsigned* st;
};

__device__ __forceinline__ XcdBarrier xcd_barrier_post(unsigned* bar, volatile LAS unsigned* st) {
    XcdBarrier b; b.bar = bar; b.x = xb_xcc_id(); b.st = st;
    if (threadIdx.x == 0) (void)xb_add(&bar[XB_XCNT(b.x)], 1u);
    return b;
}
__device__ __forceinline__ void xcd_barrier_complete(unsigned* bar, unsigned x, unsigned& nloc, unsigned& nx) {
    const unsigned G = gridDim.x * gridDim.y * gridDim.z;
    unsigned sum, cnt, mine, sp = 0u;
    for (;;) {
        sum = 0u; cnt = 0u; mine = 0u;
#pragma unroll
        for (unsigned j = 0; j < 16; ++j) { const unsigned c = xb_ld(&bar[XB_XCNT(j)]); sum += c; cnt += (c > 0u) ? 1u : 0u; mine = (j == x) ? c : mine; }
        if (sum == G) break;
        __builtin_amdgcn_s_sleep(1);
        if ((++sp & 255u) == 0u) { if (xb_ld(&bar[XB_TMO])) break; if (sp > XB_SPIN_CAP) { atomicAdd(&bar[XB_TMO], 1u); break; } }
    }
    nloc = mine > 0u ? mine : 1u; nx = cnt > 0u ? cnt : 1u;
}

__device__ __forceinline__ void xcd_barrier(const XcdBarrier& b) {
    asm volatile("s_waitcnt vmcnt(0)" ::: "memory");
    __syncthreads();
    if (threadIdx.x == 0) {
        unsigned* bar = b.bar;
        __builtin_amdgcn_s_waitcnt(0);
        unsigned nloc = b.st[0], nx = b.st[1];
        if (nloc == 0u) { xcd_barrier_complete(bar, b.x, nloc, nx); b.st[0] = nloc; b.st[1] = nx; }
        const unsigned old = xb_add(&bar[XB_XSUB(b.x)], 1u);
        const unsigned gen = old / nloc;
        if (old + 1u == (gen + 1u) * nloc) {
            __builtin_amdgcn_fence(__ATOMIC_RELEASE, "agent");
            asm volatile("s_waitcnt vmcnt(0)" ::: "memory");
            const unsigned og = xb_add(&bar[XB_TOP], 1u);
            const unsigned tg = og / nx;
            if (og + 1u == (tg + 1u) * nx) xb_add(&bar[XB_TOPGEN], 1u);
            else XB_SPIN(xb_ld(&bar[XB_TOPGEN]) == tg, bar);
            __builtin_amdgcn_fence(__ATOMIC_ACQUIRE, "agent");
            xb_add(&bar[XB_XGEN(b.x)], 1u);
            asm volatile("s_waitcnt vmcnt(0)" ::: "memory");
        } else {
            XB_SPIN(xb_ld(&bar[XB_XGEN(b.x)]) == gen, bar);
            __builtin_amdgcn_fence(__ATOMIC_ACQUIRE, "agent");
            asm volatile("s_waitcnt vmcnt(0)" ::: "memory");
        }
    }
    __syncthreads();
}

__global__ void __launch_bounds__(NWAVES * 64, 2) mega_fwd(Args a) {
    extern __shared__ __attribute__((aligned(16))) unsigned char lds_raw[];
    cg::grid_group grid = cg::this_grid();
    LAS unsigned char* lds = (LAS unsigned char*)lds_raw;
    const int tid = threadIdx.x, lane = tid & 63, wave = __builtin_amdgcn_readfirstlane(tid >> 6);
    const int G = gridDim.x, bx = blockIdx.x;
    const int gw = bx * NWAVES + wave, NGW = G * NWAVES;
    const int vcu = (G % 8 == 0) ? (bx % 8) * (G / 8) + bx / 8 : bx;
    unsigned char* ws = a.ws;
    float* ssq = (float*)(ws + WS_SSQ);
    bf16* xb = (bf16*)(ws + WS_XB);
    bf16* proj = (bf16*)(ws + WS_PROJ);
    bf16* ao = (bf16*)(ws + WS_AO);
    bf16* ubuf = (bf16*)(ws + WS_U);
    bf16* gbuf = (bf16*)(ws + WS_G);

    if (bx == 0) for (int i = tid; i < XCD_BAR_WORDS; i += NWAVES * 64) ((unsigned*)ws)[i] = 0u;
    if (tid < 2) ((LAS unsigned*)(lds + LDS_MISC))[tid] = 0u;
    {
        LAS float* scr = (LAS float*)(lds + wave * 16384);
        constexpr int I_INE = 16 * (EVEN_IN / 32), I_OUT = 16 * 32, I_INO = 16 * (ODD_IN / 32), I_UP = 16 * (DUP / 32), I_DN = (DFF / 64) * 32;
        constexpr int NITEMS = 2 * I_INE + 2 * I_OUT + 2 * I_INO + 2 * I_OUT + 4 * I_UP + 4 * I_DN;
        for (int it = gw; it < NITEMS; it += NGW) {
            int r = it;
            if (r < 2 * I_INE) { const int e = r / I_INE; r -= e * I_INE;
                transpose_item(a.w_in_even + (size_t)e * DM * EVEN_IN, DM, EVEN_IN, (bf16*)(ws + WS_WINE) + (size_t)e * EVEN_IN * DM, a.norm_mix + (2 * e) * DM, 0, 512, 768, 1280, att::QSCALE, scr, r, lane); continue; }
            r -= 2 * I_INE;
            if (r < 2 * I_OUT) { const int e = r / I_OUT; r -= e * I_OUT;
                transpose_item(a.w_out_even + (size_t)e * DM * DM, DM, DM, (bf16*)(ws + WS_WOUTE) + (size_t)e * DM * DM, nullptr, 0, 0, 0, 0, 1.f, scr, r, lane); continue; }
            r -= 2 * I_OUT;
            if (r < 2 * I_INO) { const int e = r / I_INO; r -= e * I_INO;
                transpose_item(a.w_in_odd + (size_t)e * DM * ODD_IN, DM, ODD_IN, (bf16*)(ws + WS_WINO) + (size_t)e * ODD_IN * DM, a.norm_mix + (2 * e + 1) * DM, 0, 1024, 0, 0, att::QSCALE, scr, r, lane); continue; }
            r -= 2 * I_INO;
            if (r < 2 * I_OUT) { const int e = r / I_OUT; r -= e * I_OUT;
                transpose_item(a.w_out_odd + (size_t)e * DM * DM, DM, DM, (bf16*)(ws + WS_WOUTO) + (size_t)e * DM * DM, nullptr, 0, 0, 0, 0, 1.f, scr, r, lane); continue; }
            r -= 2 * I_OUT;
            if (r < 4 * I_UP) { const int e = r / I_UP; r -= e * I_UP;
                transpose_item(a.ffn_up + (size_t)e * DM * DUP, DM, DUP, (bf16*)(ws + WS_WUP) + (size_t)e * DUP * DM, a.norm_ffn + e * DM, 0, 0, 0, 0, 1.f, scr, r, lane); continue; }
            r -= 4 * I_UP;
            { const int e = r / I_DN; r -= e * I_DN;
                transpose_item(a.ffn_down + (size_t)e * DFF * DM, DFF, DM, (bf16*)(ws + WS_WDN) + (size_t)e * DM * DFF, nullptr, 0, 0, 0, 0, 1.f, scr, r, lane); }
        }
        for (int m0 = 2 * gw; m0 < MTOK; m0 += 2 * NGW) {
            f32x4 v[2][4];
#pragma unroll
            for (int h2 = 0; h2 < 2; ++h2) { const f32x4* xr = (const f32x4*)(a.x + (size_t)(m0 + h2) * DM) + lane;
#pragma unroll
                for (int j = 0; j < 4; ++j) v[h2][j] = __builtin_nontemporal_load(xr + 64 * j); }
#pragma unroll
            for (int h2 = 0; h2 < 2; ++h2) { const int m = m0 + h2; float s = 0.f;
#pragma unroll
                for (int j = 0; j < 4; ++j) s += (v[h2][j][0] * v[h2][j][0] + v[h2][j][1] * v[h2][j][1]) + (v[h2][j][2] * v[h2][j][2] + v[h2][j][3] * v[h2][j][3]);
                s = wave_sum(s);
                v2u* o8 = (v2u*)(xb + (size_t)m * DM) + lane;
#pragma unroll
                for (int j = 0; j < 4; ++j) { v2u w; w.x = pk2(v[h2][j][0], v[h2][j][1]); w.y = pk2(v[h2][j][2], v[h2][j][3]); o8[64 * j] = w; }
                if (lane < 16) ssq[(size_t)m * 16 + lane] = (lane == 0) ? s : 0.f; }
        }
    }
    grid.sync();
    const XcdBarrier xbar = xcd_barrier_post((unsigned*)ws, (volatile LAS unsigned*)(lds + LDS_MISC));

    for (int layer = 0; layer < 4; ++layer) {
        const int e = layer >> 1; const bool even = (layer & 1) == 0;
        const float* xold = (layer == 0) ? a.x : a.out;
        {
            const int N = even ? EVEN_IN : ODD_IN;
            const bf16* wt = even ? (const bf16*)(ws + WS_WINE) + (size_t)e * EVEN_IN * DM : (const bf16*)(ws + WS_WINO) + (size_t)e * ODD_IN * DM;
            pg8::Gemm g{xb, wt, MTOK, N, DM}; pg8::StaticOrder S; S.init(MTOK, N, G, bx);
            pg8::EpiScaleBf16 E{proj, N, ssq};
            for (int rep_ = 0; rep_ < REP_INPROJ; ++rep_)
            pg8::gemm_phase<pg8::EpiScaleBf16, pg8::StaticOrder, true, true>(lds, g, S, E);
        }
        xcd_barrier(xbar);
        if (even) {
            int tq = threadIdx.x; asm volatile("" : "+v"(tq)); const int tid = tq, lane = tq & 63, l32 = lane & 31, hi = lane >> 5;
            float lam, one_m_li;
            { const float li = (layer == 0) ? 0.2f : 0.47071301839f;
              const float s1 = wave_sum(a.lam_q1[e * 64 + lane] * a.lam_k1[e * 64 + lane]), s2 = wave_sum(a.lam_q2[e * 64 + lane] * a.lam_k2[e * 64 + lane]);
              lam = __expf(s1) - __expf(s2) + li; lam = __builtin_bit_cast(float, __builtin_amdgcn_readfirstlane(__builtin_bit_cast(int, lam))); one_m_li = __builtin_bit_cast(float, __builtin_amdgcn_readfirstlane(__builtin_bit_cast(int, 1.0f - li))); }
            LAS float* btab = (LAS float*)(lds + att::L_BT);

#if PH_DIFF
            for (int rep_ = 0; rep_ < REP_DIFF; ++rep_)
            for (int uidx = vcu; uidx < 1024; uidx += G) {
                const int j = uidx >> 8, c = uidx & 255, bh = c >> 2, s = c & 3, b = bh >> 2, h = bh & 3;
                const int qb = (j == 0) ? s : (j == 1) ? 7 - s : (j == 2) ? 8 + s : 15 - s;
                { int tb = threadIdx.x; asm volatile("" : "+v"(tb)); const int dd = tb - 256;
                  btab[tb] = (dd < 0) ? -__builtin_inff() : a.rel_bias[T5B[dd < 127 ? dd : 127] * 12 + 8 + h] * att::LOG2E; }
                const bf16* base = proj + (size_t)b * SEQ * EVEN_IN;
                const int q0 = qb * 256, nt = 4 * qb + 4, t = q0 + 32 * wave + l32;
                att::f32x16 o2[4]; float m2, l2; LAS unsigned* o1s = (LAS unsigned*)(lds + att::L_O1 + wave * 8192) + lane;
                { float m1, l1;
                  att::attn_core_pp<1, 128>(base + 768 + h * 128, base + 1280 + h * 128, base + 1792 + h * 128, EVEN_IN, q0, 0, nt, lds, o2, m1, l1);
                  const float inv = __builtin_amdgcn_rcpf(l1 + __shfl_xor(l1, 32));
#pragma unroll
                  for (int db = 0; db < 4; ++db)
#pragma unroll
                      for (int k = 0; k < 8; ++k) o1s[(db * 8 + k) * 64] = att::cvtpk(o2[db][2 * k] * inv, o2[db][2 * k + 1] * inv); }
                att::attn_core_pp<1, 128>(base + 768 + h * 128 + 64, base + 1280 + h * 128 + 64, base + 1792 + h * 128, EVEN_IN, q0, 0, nt, lds, o2, m2, l2);
                { const float inv = lam * __builtin_amdgcn_rcpf(l2 + __shfl_xor(l2, 32)); float ss = 0.f;
#pragma unroll
                  for (int db = 0; db < 4; ++db)
#pragma unroll
                      for (int r = 0; r < 16; ++r) { const unsigned w = o1s[(db * 8 + (r >> 1)) * 64]; const float a1 = __uint_as_float((r & 1) ? (w & 0xffff0000u) : (w << 16));
                          const float v = a1 - inv * o2[db][r]; o2[db][r] = v; ss += v * v; }
                  ss += __shfl_xor(ss, 32);
                  const float rs = __builtin_amdgcn_rsqf(ss * (1.0f / 128.0f) + 1e-6f) * one_m_li;
                  const float* gn = a.diff_norm + e * 128;
#pragma unroll
                  for (int db = 0; db < 4; ++db)
#pragma unroll
                      for (int rg = 0; rg < 4; ++rg) { const f32x4 gv = *(const f32x4*)(gn + 32 * db + 8 * rg + 4 * hi);
#pragma unroll
                          for (int k = 0; k < 4; ++k) o2[db][4 * rg + k] *= rs * gv[k]; } }
                { int tb = threadIdx.x; asm volatile("" : "+v"(tb)); const int t2 = q0 + 32 * (tb >> 6) + (tb & 31);
                  att::store_ot<128>(o2, ao + ((size_t)b * SEQ + t2) * DM + 512 + h * 128, (tb >> 5) & 1); }
            }
#endif
#if PH_SWA
            for (int rep_ = 0; rep_ < REP_SWA; ++rep_)
            for (int uidx = vcu; uidx < 2048; uidx += G) {
                const int qb = uidx & 15, qh = (uidx >> 4) & 7, b = uidx >> 7, kvh = qh >> 2;
                { int tb = threadIdx.x; asm volatile("" : "+v"(tb)); const int dd = tb - 256;
                  btab[tb] = (dd < 0 || dd >= 128) ? -__builtin_inff() : a.rel_bias[T5B[dd] * 12 + qh] * att::LOG2E; }
                const bf16* base = proj + (size_t)b * SEQ * EVEN_IN;
                const int q0 = qb * 256, t = q0 + 32 * wave + l32;
                const int kt0 = (qb * 4 - 2 > 0) ? qb * 4 - 2 : 0, nt = qb * 4 + 4 - kt0;
                att::f32x16 o[2]; float m, l;
                att::attn_core_pp<2, 64>(base + qh * 64, base + 512 + kvh * 64, base + 640 + kvh * 64, EVEN_IN, q0, kt0, nt, lds, o, m, l);
                const float sk = a.sinks[e * 8 + qh] * att::LOG2E;
                const float inv = __builtin_amdgcn_rcpf(l + __shfl_xor(l, 32) + __builtin_amdgcn_exp2f(sk - m));
#pragma unroll
                for (int db = 0; db < 2; ++db)
#pragma unroll
                    for (int r = 0; r < 16; ++r) o[db][r] *= inv;
                att::store_ot<64>(o, ao + ((size_t)b * SEQ + t) * DM + qh * 64, hi);
            }
#endif
        } else {
#if PH_SB
            int tq = threadIdx.x; asm volatile("" : "+v"(tq)); const int lane = tq & 63, l32 = lane & 31, hi = lane >> 5;
            for (int rep_ = 0; rep_ < REP_SB; ++rep_)
            for (int uidx = bx; uidx < 4096; uidx += G) {
                const int bh = uidx & 255, qb = 15 - (uidx >> 8), b = bh >> 4, h = bh & 15;
                const bf16* base = proj + (size_t)b * SEQ * ODD_IN;
                const int q0 = qb * 256, nt = 4 * qb + 4, t = q0 + 32 * wave + l32;
                att::f32x16 o[2]; float P, dummy;
                att::attn_core<0, 64>(base + h * 64, base + 1024 + h * 64, base + 2048 + h * 64, ODD_IN, q0, nt - 1, nt, -1, lds, o, P, dummy);
                att::store_ot<64>(o, ao + ((size_t)b * SEQ + t) * DM + h * 64, hi);
            }
#endif
        }
        xcd_barrier(xbar);
        {
            const bf16* wt = even ? (const bf16*)(ws + WS_WOUTE) + (size_t)e * DM * DM : (const bf16*)(ws + WS_WOUTO) + (size_t)e * DM * DM;
            pg8::Gemm g{ao, wt, MTOK, DM, DM}; pg8::StaticOrder S; S.init(MTOK, DM, G, bx);
#if OUT_STAGGER_TICKS > 0
            { const unsigned long long t0 = __builtin_amdgcn_s_memrealtime(); const unsigned long long dly = (unsigned long long)(((bx >> 3) & (OUT_STAGGER_GROUPS - 1)) * OUT_STAGGER_TICKS);
              while (__builtin_amdgcn_s_memrealtime() - t0 < dly) __builtin_amdgcn_s_sleep(8); }
#endif
#if REP_OUT == 2
            { pg8::EpiResid Ed{xold, (float*)(ws + WS_PROJ), (bf16*)(ws + WS_PROJ + 256 * MiB), (float*)(ws + 800 * MiB)};
              pg8::gemm_phase<pg8::EpiResid, pg8::StaticOrder, true, true>(lds, g, S, Ed); }
#elif REP_OUT == 3
            { pg8::EpiScaleBf16 Ed{(bf16*)(ws + WS_PROJ), DM, ssq};
              pg8::gemm_phase<pg8::EpiScaleBf16, pg8::StaticOrder, true, true>(lds, g, S, Ed); }
#endif
#if RESID_BF16
            pg8::EpiResidB E{xb, xb, ssq};
            pg8::gemm_phase<pg8::EpiResidB, pg8::StaticOrder, true, true>(lds, g, S, E);
#else
            pg8::EpiResid E{xold, a.out, xb, ssq};
            pg8::gemm_phase<pg8::EpiResid, pg8::StaticOrder, true, true>(lds, g, S, E);
#endif
        }
        xcd_barrier(xbar);
        const bf16* wup = (const bf16*)(ws + WS_WUP) + (size_t)layer * DUP * DM;
        const bf16* wdn = (const bf16*)(ws + WS_WDN) + (size_t)layer * DM * DFF;
        for (int half = 0; half < 2; ++half) {
            const size_t r0 = (size_t)half * HALF_ROWS;
            {
                pg8::Gemm g{xb + r0 * DM, wup, HALF_ROWS, DUP, DM}; pg8::StaticOrder S; S.init(HALF_ROWS, DUP, G, bx);
                pg8::EpiScaleBf16 E{ubuf, DUP, ssq + r0 * 16};
                for (int rep_ = 0; rep_ < REP_UP; ++rep_)
                pg8::gemm_phase<pg8::EpiScaleBf16, pg8::StaticOrder, true, true>(lds, g, S, E);
            }
            xcd_barrier(xbar);
#if PH_CONV
            {
                const float* cw = a.ffn_conv + (size_t)layer * 3 * DUP; const float* cb = a.ffn_conv_b + (size_t)layer * DUP;
                constexpr int NCC = 6, NRC = HALF_ROWS / 32;
                int tq = threadIdx.x; asm volatile("" : "+v"(tq)); const int lane = tq & 63;
                for (int rep_ = 0; rep_ < REP_CONV; ++rep_)
                for (int it = gw; it < NCC * NRC; it += NGW) {
                    const int cc = it % NCC, rc = it / NCC, cgp = cc * 64 + lane;
                    if (cgp < DFF / 8) {
                        const int col = cgp * 8, row0 = rc * 32;
                        float wg[3][8], wv[3][8], bg[8], bv[8];
#pragma unroll
                        for (int tp = 0; tp < 3; ++tp)
#pragma unroll
                            for (int k = 0; k < 8; k += 4) { const f32x4 t1 = *(const f32x4*)(cw + tp * DUP + col + k), t2 = *(const f32x4*)(cw + tp * DUP + DFF + col + k);
#pragma unroll
                                for (int q = 0; q < 4; ++q) { wg[tp][k + q] = t1[q]; wv[tp][k + q] = t2[q]; } }
#pragma unroll
                        for (int k = 0; k < 8; k += 4) { const f32x4 t1 = *(const f32x4*)(cb + col + k), t2 = *(const f32x4*)(cb + DFF + col + k);
#pragma unroll
                            for (int q = 0; q < 4; ++q) { bg[k + q] = t1[q]; bv[k + q] = t2[q]; } }
                        float g2[8], g1[8], v2[8], v1[8];
                        const bool head = (row0 % SEQ) == 0;
                        {
                            v4u a2 = {0, 0, 0, 0}, a1 = {0, 0, 0, 0}, c2 = {0, 0, 0, 0}, c1 = {0, 0, 0, 0};
                            if (!head) { const bf16* up = ubuf + (size_t)(row0 - 2) * DUP + col; a2 = *(const v4u*)up; c2 = *(const v4u*)(up + DFF); a1 = *(const v4u*)(up + DUP); c1 = *(const v4u*)(up + DUP + DFF); }
#pragma unroll
                            for (int k = 0; k < 8; ++k) { const int sh = (k & 1) * 16;
                                g2[k] = __uint_as_float(((a2[k >> 1] >> sh) & 0xffffu) << 16); g1[k] = __uint_as_float(((a1[k >> 1] >> sh) & 0xffffu) << 16);
                                v2[k] = __uint_as_float(((c2[k >> 1] >> sh) & 0xffffu) << 16); v1[k] = __uint_as_float(((c1[k >> 1] >> sh) & 0xffffu) << 16); }
                        }
                        for (int r4 = 0; r4 < 32; r4 += 8) {
                            v4u av[8], cv[8];
#pragma unroll
                            for (int rr = 0; rr < 8; ++rr) { const bf16* up = ubuf + (size_t)(row0 + r4 + rr) * DUP + col;
                                av[rr] = __builtin_nontemporal_load((const v4u*)up); cv[rr] = __builtin_nontemporal_load((const v4u*)(up + DFF)); }
#pragma unroll
                            for (int rr = 0; rr < 8; ++rr) {
                                const v4u a0 = av[rr], c0 = cv[rr];
                                float res[8];
#pragma unroll
                                for (int k = 0; k < 8; ++k) { const int sh = (k & 1) * 16;
                                    const float g0 = __uint_as_float(((a0[k >> 1] >> sh) & 0xffffu) << 16), v0 = __uint_as_float(((c0[k >> 1] >> sh) & 0xffffu) << 16);
                                    const float gg = bg[k] + wg[0][k] * g2[k] + wg[1][k] * g1[k] + wg[2][k] * g0;
                                    const float vv = bv[k] + wv[0][k] * v2[k] + wv[1][k] * v1[k] + wv[2][k] * v0;
                                    const float sg = gg * __builtin_amdgcn_rcpf(1.0f + __builtin_amdgcn_exp2f(-gg * att::LOG2E));
                                    res[k] = sg * vv; g2[k] = g1[k]; g1[k] = g0; v2[k] = v1[k]; v1[k] = v0; }
                                v4u w; w.x = pk2(res[0], res[1]); w.y = pk2(res[2], res[3]); w.z = pk2(res[4], res[5]); w.w = pk2(res[6], res[7]);
                                *(v4u*)(gbuf + (size_t)(row0 + r4 + rr) * DFF + col) = w;
                            }
                        }
                    }
                }
            }
#endif
            xcd_barrier(xbar);
            {
                pg8::Gemm g{gbuf, wdn, HALF_ROWS, DM, DFF}; pg8::StaticOrder S; S.init(HALF_ROWS, DM, G, bx);
#if REP_DOWN > 1
                { pg8::EpiResid Ed{a.out + r0 * DM, (float*)(ws + 760 * MiB), (bf16*)(ws + 888 * MiB), (float*)(ws + 960 * MiB)};
                  pg8::gemm_phase<pg8::EpiResid, pg8::StaticOrder, true, true>(lds, g, S, Ed); }
#endif
#if RESID_BF16
                pg8::EpiResidB E{xb + r0 * DM, xb + r0 * DM, ssq + r0 * 16};
                pg8::gemm_phase<pg8::EpiResidB, pg8::StaticOrder, true, true>(lds, g, S, E);
#else
                pg8::EpiResid E{a.out + r0 * DM, a.out + r0 * DM, xb + r0 * DM, ssq + r0 * 16};
                pg8::gemm_phase<pg8::EpiResid, pg8::StaticOrder, true, true>(lds, g, S, E);
#endif
            }
            if (half == 1) xcd_barrier(xbar);
        }
    }
    { int tq = threadIdx.x; asm volatile("" : "+v"(tq)); const int lane = tq & 63;
    for (int m = gw; m < MTOK; m += NGW) {
        f32x4* xr = (f32x4*)(a.out + (size_t)m * DM) + lane; f32x4 v[4]; float s = 0.f;
#if RESID_BF16
        const v2u* xin = (const v2u*)(xb + (size_t)m * DM) + lane;
#pragma unroll
        for (int j = 0; j < 4; ++j) { const v2u w = xin[64 * j]; v[j][0] = __uint_as_float(w.x << 16); v[j][1] = __uint_as_float(w.x & 0xffff0000u); v[j][2] = __uint_as_float(w.y << 16); v[j][3] = __uint_as_float(w.y & 0xffff0000u);
            s += (v[j][0] * v[j][0] + v[j][1] * v[j][1]) + (v[j][2] * v[j][2] + v[j][3] * v[j][3]); }
#else
#pragma unroll
        for (int j = 0; j < 4; ++j) { v[j] = xr[64 * j]; s += (v[j][0] * v[j][0] + v[j][1] * v[j][1]) + (v[j][2] * v[j][2] + v[j][3] * v[j][3]); }
#endif
        s = wave_sum(s);
        const float rs = __builtin_amdgcn_rsqf(s * (1.0f / DM) + 1e-6f);
#pragma unroll
        for (int j = 0; j < 4; ++j) { const f32x4 gv = *((const f32x4*)a.norm_final + lane + 64 * j); xr[64 * j] = v[j] * rs * gv; }
    } }
}

extern "C" void kernel_launch(void* const* d_in, const int* in_sizes, int n_in, void* d_out, int out_size, void* d_ws, size_t ws_size, hipStream_t stream) {
    static int grid = 0;
    if (grid == 0) {
        int dev = 0, cus = 0, per_cu = 0;
        (void)hipGetDevice(&dev);
        (void)hipDeviceGetAttribute(&cus, hipDeviceAttributeMultiprocessorCount, dev);
        (void)hipFuncSetAttribute((const void*)mega_fwd, hipFuncAttributeMaxDynamicSharedMemorySize, LDS_BYTES);
        (void)hipOccupancyMaxActiveBlocksPerMultiprocessor(&per_cu, (const void*)mega_fwd, NWAVES * 64, LDS_BYTES);
        if (per_cu < 1) per_cu = 1;
        grid = cus * per_cu;
        if (n_in != 19 || ws_size < 1024 * MiB) fprintf(stderr, "kernel_launch: unexpected n_in %d / ws %zu\n", n_in, ws_size);
    }
    Args a{};
    a.x = (const float*)d_in[0]; a.rel_bias = (const float*)d_in[1]; a.norm_mix = (const float*)d_in[2]; a.norm_ffn = (const float*)d_in[3]; a.norm_final = (const float*)d_in[4];
    a.w_in_even = (const float*)d_in[5]; a.w_out_even = (const float*)d_in[6]; a.sinks = (const float*)d_in[7]; a.lam_q1 = (const float*)d_in[8]; a.lam_k1 = (const float*)d_in[9];
    a.lam_q2 = (const float*)d_in[10]; a.lam_k2 = (const float*)d_in[11]; a.diff_norm = (const float*)d_in[12]; a.w_in_odd = (const float*)d_in[13]; a.w_out_odd = (const float*)d_in[14];
    a.ffn_up = (const float*)d_in[15]; a.ffn_conv = (const float*)d_in[16]; a.ffn_conv_b = (const float*)d_in[17]; a.ffn_down = (const float*)d_in[18];
    a.out = (float*)d_out; a.ws = (unsigned char*)d_ws;
    void* args[] = {&a};
    hipError_t err = hipLaunchCooperativeKernel((const void*)mega_fwd, dim3(grid), dim3(NWAVES * 64), args, LDS_BYTES, stream);
    if (err != hipSuccess) fprintf(stderr, "kernel_launch: cooperative launch failed: %s (grid %d)\n", hipGetErrorString(err), grid);
}
```

```cpp
#include <hip/hip_runtime.h>
#include <hip/hip_cooperative_groups.h>
#include <cstdio>
#include <cstdint>
namespace cg = cooperative_groups;
namespace pg8 {
#define PG8_LAS __attribute__((address_space(3)))
typedef unsigned short bf16_t;
typedef short bf16x8 __attribute__((ext_vector_type(8)));
typedef float f32x4 __attribute__((ext_vector_type(4)));
typedef unsigned u32x4 __attribute__((ext_vector_type(4)));
constexpr int BM = 256, BK = 64, HALF = 128, HTB = HALF * BK * 2  , STAGE_BYTES = 8 * HTB, NXCD = 8, WGM = 8;

__host__ __device__ __forceinline__ int lds_byte(int r, int c) { const int st = (r >> 4) * 2 + (c >> 5), rr = r & 15, cc = c & 31, ob = rr * 64 + cc * 2; return st * 1024 + (ob ^ (((ob >> 9) & 1) << 5)); }
__host__ __device__ __forceinline__ void stage_rc(int b, int& R, int& C) { const int st = b / 1024, sb = b % 1024, swz = sb ^ (((sb >> 9) & 1) << 5); R = (st >> 1) * 16 + swz / 64; C = (st & 1) * 32 + (swz % 64) / 2; }
__host__ __device__ __forceinline__ int perm32(int rho) { const int n = rho >> 4, i = rho & 15; return 8 * (i >> 2) + 4 * n + (i & 3); }

struct Unit { int pm, pn; };
struct Gemm { const bf16_t* A; const bf16_t* Bt; int M, N, K; };

struct StaticOrder {
    int nM, nN, nwg, G, c;
    __host__ __device__ void init(int M, int N, int G_, int c_) { nM = M / BM; nN = N / BM; nwg = nM * nN; G = G_; c = c_; }
    __host__ __device__ bool next(int i, Unit& u) const {
        const long L = (long)i * G + c; if (L >= nwg) return false;
        int wgid = (int)L; { const int q = nwg / NXCD, r = nwg % NXCD, xcd = wgid % NXCD, off = wgid / NXCD; wgid = (xcd < r ? xcd * (q + 1) : r * (q + 1) + (xcd - r) * q) + off; }
        const int nig = WGM * nN, gid = wgid / nig, fm = gid * WGM, gsz = (nM - fm) < WGM ? (nM - fm) : WGM;
        u.pm = fm + ((wgid % nig) % gsz); u.pn = (wgid % nig) / gsz; return true;
    }
    __device__ __forceinline__ void a_ready(const Unit&) const {}
    __device__ __forceinline__ void done(const Unit&) const {}
};

__device__ __forceinline__ unsigned cvt_pk_bf16(float lo, float hi) { unsigned r; asm volatile("v_cvt_pk_bf16_f32 %0, %1, %2" : "=v"(r) : "v"(lo), "v"(hi)); return r; }
typedef float f32x2 __attribute__((ext_vector_type(2)));
typedef unsigned u32x2 __attribute__((ext_vector_type(2)));
constexpr float RMS_EPS = 1e-6f;
struct EpiScaleBf16 {
    static constexpr bool PERM = true, AFTER_DRAIN = false;
    bf16_t* O; int ldc; const float* ssq;
    __device__ __forceinline__ void operator()(const f32x4 (&acc)[2][2][4][2], const Unit& u, int wr, int wc, int fr, int fq) const {
        const int row0 = u.pm * BM + wr * 64 + fr, col0 = u.pn * BM + wc * 32 + 8 * fq;
        f32x4 part[2][4];
#pragma unroll
        for (int ai = 0; ai < 2; ++ai)
#pragma unroll
            for (int m = 0; m < 4; ++m) part[ai][m] = *(const f32x4*)(ssq + (size_t)(row0 + ai * HALF + m * 16) * 16 + fq * 4);
#pragma unroll
        for (int ai = 0; ai < 2; ++ai)
#pragma unroll
            for (int m = 0; m < 4; ++m) { const int row = row0 + ai * HALF + m * 16; bf16_t* rowp = O + (size_t)row * ldc + col0;
                float t = (part[ai][m][0] + part[ai][m][1]) + (part[ai][m][2] + part[ai][m][3]);
                t += __shfl_xor(t, 16); t += __shfl_xor(t, 32);
                const float rs = __builtin_amdgcn_rsqf(t * (1.0f / 1024.0f) + RMS_EPS);
#pragma unroll
                for (int bj = 0; bj < 2; ++bj) { const f32x4 v0 = acc[ai][bj][m][0] * rs, v1 = acc[ai][bj][m][1] * rs;
                    u32x4 w; w.x = cvt_pk_bf16(v0[0], v0[1]); w.y = cvt_pk_bf16(v0[2], v0[3]); w.z = cvt_pk_bf16(v1[0], v1[1]); w.w = cvt_pk_bf16(v1[2], v1[3]);
                    *(u32x4*)(rowp + bj * HALF) = w; } }
    }
};
struct EpiResid {
    static constexpr bool PERM = true, AFTER_DRAIN = false;
    const float* base; float* out; bf16_t* xb; float* ssq;
    __device__ __forceinline__ void operator()(const f32x4 (&acc)[2][2][4][2], const Unit& u, int wr, int wc, int fr, int fq) const {
        const int col0 = u.pn * BM + wc * 32 + 8 * fq;
        const size_t off0 = (size_t)(u.pm * BM + wr * 64 + fr) * 1024 + col0;
        f32x4 nx[2][2][2];
#pragma unroll
        for (int g = 0; g < 2; ++g) { const size_t offn = off0 + (size_t)(g * 16) * 1024;
#pragma unroll
            for (int bj = 0; bj < 2; ++bj)
#pragma unroll
                for (int n = 0; n < 2; ++n) nx[g][bj][n] = *(const f32x4*)(base + offn + bj * HALF + n * 4); }
        asm volatile("" ::: "memory");
#pragma unroll
        for (int g = 0; g < 8; ++g) { const int ai = g >> 2, m = g & 3; const int row = u.pm * BM + ai * HALF + wr * 64 + m * 16 + fr; const size_t off = (size_t)row * 1024 + col0; float q = 0.f;
            f32x4 cu[2][2];
#pragma unroll
            for (int bj = 0; bj < 2; ++bj)
#pragma unroll
                for (int n = 0; n < 2; ++n) cu[bj][n] = nx[g & 1][bj][n];
            if (g < 6) { const size_t offn = off0 + (size_t)(((g + 2) >> 2) * HALF + ((g + 2) & 3) * 16) * 1024;
#pragma unroll
                for (int bj = 0; bj < 2; ++bj)
#pragma unroll
                    for (int n = 0; n < 2; ++n) nx[g & 1][bj][n] = *(const f32x4*)(base + offn + bj * HALF + n * 4); }
#pragma unroll
            for (int bj = 0; bj < 2; ++bj) { const f32x4 o0 = cu[bj][0] + acc[ai][bj][m][0], o1 = cu[bj][1] + acc[ai][bj][m][1];
                *(f32x4*)(out + off + bj * HALF) = o0; *(f32x4*)(out + off + bj * HALF + 4) = o1;
                q += ((o0[0] * o0[0] + o0[1] * o0[1]) + (o0[2] * o0[2] + o0[3] * o0[3])) + ((o1[0] * o1[0] + o1[1] * o1[1]) + (o1[2] * o1[2] + o1[3] * o1[3]));
                u32x4 w; w.x = cvt_pk_bf16(o0[0], o0[1]); w.y = cvt_pk_bf16(o0[2], o0[3]); w.z = cvt_pk_bf16(o1[0], o1[1]); w.w = cvt_pk_bf16(o1[2], o1[3]);
                *(u32x4*)(xb + off + bj * HALF) = w; }
            q += __shfl_xor(q, 16); q += __shfl_xor(q, 32);
            if (fq == 0) ssq[(size_t)row * 16 + u.pn * 4 + wc] = q;
            asm volatile("" ::: "memory"); }
    }
};

struct EpiResidB {
    static constexpr bool PERM = true, AFTER_DRAIN = false;
    const bf16_t* base; bf16_t* xb; float* ssq;
    __device__ __forceinline__ void operator()(const f32x4 (&acc)[2][2][4][2], const Unit& u, int wr, int wc, int fr, int fq) const {
        const int col0 = u.pn * BM + wc * 32 + 8 * fq;
        const size_t off0 = (size_t)(u.pm * BM + wr * 64 + fr) * 1024 + col0;
        u32x4 nx[2][2];
#pragma unroll
        for (int g = 0; g < 2; ++g)
#pragma unroll
            for (int bj = 0; bj < 2; ++bj) nx[g][bj] = *(const u32x4*)(base + off0 + (size_t)(g * 16) * 1024 + bj * HALF);
        asm volatile("" ::: "memory");
#pragma unroll
        for (int g = 0; g < 8; ++g) { const int ai = g >> 2, m = g & 3; const int row = u.pm * BM + ai * HALF + wr * 64 + m * 16 + fr; const size_t off = (size_t)row * 1024 + col0; float q = 0.f;
            u32x4 cu[2];
#pragma unroll
            for (int bj = 0; bj < 2; ++bj) cu[bj] = nx[g & 1][bj];
            if (g < 6) { const size_t offn = off0 + (size_t)(((g + 2) >> 2) * HALF + ((g + 2) & 3) * 16) * 1024;
#pragma unroll
                for (int bj = 0; bj < 2; ++bj) nx[g & 1][bj] = *(const u32x4*)(base + offn + bj * HALF); }
#pragma unroll
            for (int bj = 0; bj < 2; ++bj) {
                f32x4 o0, o1;
                o0[0] = __uint_as_float(cu[bj].x << 16) + acc[ai][bj][m][0][0]; o0[1] = __uint_as_float(cu[bj].x & 0xffff0000u) + acc[ai][bj][m][0][1];
                o0[2] = __uint_as_float(cu[bj].y << 16) + acc[ai][bj][m][0][2]; o0[3] = __uint_as_float(cu[bj].y & 0xffff0000u) + acc[ai][bj][m][0][3];
                o1[0] = __uint_as_float(cu[bj].z << 16) + acc[ai][bj][m][1][0]; o1[1] = __uint_as_float(cu[bj].z & 0xffff0000u) + acc[ai][bj][m][1][1];
                o1[2] = __uint_as_float(cu[bj].w << 16) + acc[ai][bj][m][1][2]; o1[3] = __uint_as_float(cu[bj].w & 0xffff0000u) + acc[ai][bj][m][1][3];
                q += ((o0[0] * o0[0] + o0[1] * o0[1]) + (o0[2] * o0[2] + o0[3] * o0[3])) + ((o1[0] * o1[0] + o1[1] * o1[1]) + (o1[2] * o1[2] + o1[3] * o1[3]));
                u32x4 w; w.x = cvt_pk_bf16(o0[0], o0[1]); w.y = cvt_pk_bf16(o0[2], o0[3]); w.z = cvt_pk_bf16(o1[0], o1[1]); w.w = cvt_pk_bf16(o1[2], o1[3]);
                *(u32x4*)(xb + off + bj * HALF) = w; }
            q += __shfl_xor(q, 16); q += __shfl_xor(q, 32);
            if (fq == 0) ssq[(size_t)row * 16 + u.pn * 4 + wc] = q;
            asm volatile("" ::: "memory"); }
    }
};
template <class Epi, class Sched, bool ALIGN_EPI = false, bool SP2 = false>
__device__ __forceinline__ void gemm_phase(PG8_LAS unsigned char* lds, const Gemm g, const Sched& S, const Epi& E) {
    int tid_ = threadIdx.x; asm volatile("" : "+v"(tid_));
    const int tid = tid_, wid = __builtin_amdgcn_readfirstlane(tid >> 6), lane = tid & 63, wr = wid >> 2, wc = wid & 3, fr = lane & 15, fq = lane >> 4;
    const int K = g.K, nt = K / BK;
    unsigned voffA[2], voffB[2];
#pragma unroll
    for (int i = 0; i < 2; ++i) { int R, C; stage_rc(tid * 16 + i * 8192, R, C); const int Rb = Epi::PERM ? ((R & ~31) + perm32(R & 31)) : R;
        voffA[i] = (unsigned)(R * K + C) * 2u; voffB[i] = (unsigned)(Rb * K + C) * 2u; }
    const size_t kstep = (size_t)(BK * 2);
    const size_t hstep = (size_t)HALF * K * 2;
    const size_t tstep = 2 * hstep;
    const unsigned ldsw = (unsigned)wid * 1024u;
    const int aoff = lds_byte(wr * 64 + fr, fq * 8), boff = lds_byte(wc * 32 + fr, fq * 8);
#define PG8_SA(b, h) (((b) * 2 + (h)) * HTB)
#define PG8_SB(b, h) ((4 + (b) * 2 + (h)) * HTB)
#define PG8_STAGE(bufoff, gbase, voff) do { _Pragma("unroll") for (int _i = 0; _i < 2; ++_i) \
        __builtin_amdgcn_global_load_lds((const unsigned*)((const char*)(gbase) + (voff)[_i]), (PG8_LAS unsigned*)(lds + (bufoff) + ldsw + _i * 8192), 16, 0, 0); } while (0)
#define PG8_LDA(dst, b, h) do { _Pragma("unroll") for (int m = 0; m < 4; ++m) _Pragma("unroll") for (int k = 0; k < 2; ++k) dst[m][k] = *(const PG8_LAS bf16x8*)(lds + PG8_SA(b, h) + aoff + m * 2048 + k * 1024); } while (0)
#define PG8_LDB(dst, b, h) do { _Pragma("unroll") for (int n = 0; n < 2; ++n) _Pragma("unroll") for (int k = 0; k < 2; ++k) dst[n][k] = *(const PG8_LAS bf16x8*)(lds + PG8_SB(b, h) + boff + n * 2048 + k * 1024); } while (0)
#define PG8_MMA(ai, bj, At, Bt) do { __builtin_amdgcn_s_setprio(1); _Pragma("unroll") for (int m = 0; m < 4; ++m) _Pragma("unroll") for (int n = 0; n < 2; ++n) _Pragma("unroll") for (int k = 0; k < 2; ++k) \
        acc[ai][bj][m][n] = __builtin_amdgcn_mfma_f32_16x16x32_bf16(Bt[n][k], At[m][k], acc[ai][bj][m][n], 0, 0, 0); __builtin_amdgcn_s_setprio(0); } while (0)
#define PG8_WAIT_V(n) asm volatile("s_waitcnt vmcnt(" #n ")" ::: "memory")
#define PG8_WAIT_L(n) asm volatile("s_waitcnt lgkmcnt(" #n ")" ::: "memory")
#define PG8_BAR __builtin_amdgcn_s_barrier()
#define PG8_SCHED __builtin_amdgcn_sched_barrier(0)
    Unit cur, nxt; int ui = 0;
    if (!S.next(0, cur)) return;
    f32x4 acc[2][2][4][2];
#pragma unroll
    for (int a = 0; a < 2; ++a)
#pragma unroll
        for (int b = 0; b < 2; ++b)
#pragma unroll
            for (int m = 0; m < 4; ++m)
#pragma unroll
                for (int n = 0; n < 2; ++n) acc[a][b][m][n] = (f32x4){0.f, 0.f, 0.f, 0.f};
    bf16x8 At[4][2], B0[2][2], B1[2][2];
    const char* cA = (const char*)g.A + (size_t)cur.pm * tstep; const char* cB = (const char*)g.Bt + (size_t)cur.pn * tstep;
    S.a_ready(cur);
    if constexpr (SP2) {
        PG8_STAGE(PG8_SB(0, 0), cB, voffB); PG8_STAGE(PG8_SB(0, 1), cB + hstep, voffB); PG8_STAGE(PG8_SA(0, 0), cA, voffA); PG8_STAGE(PG8_SA(0, 1), cA + hstep, voffA);
        if (wr == 1) PG8_BAR;
        PG8_WAIT_V(2); PG8_BAR;
        PG8_STAGE(PG8_SB(1, 0), cB + kstep, voffB); PG8_STAGE(PG8_SA(1, 0), cA + kstep, voffA); PG8_STAGE(PG8_SB(1, 1), cB + hstep + kstep, voffB);
        PG8_WAIT_V(6); PG8_BAR;
    } else {
        PG8_STAGE(PG8_SB(0, 0), cB, voffB); PG8_STAGE(PG8_SA(0, 0), cA, voffA); PG8_STAGE(PG8_SB(0, 1), cB + hstep, voffB); PG8_STAGE(PG8_SA(0, 1), cA + hstep, voffA);
        if (wr == 1) PG8_BAR;
        PG8_WAIT_V(4); PG8_BAR;
        PG8_STAGE(PG8_SB(1, 0), cB + kstep, voffB); PG8_STAGE(PG8_SA(1, 0), cA + kstep, voffA); PG8_STAGE(PG8_SB(1, 1), cB + hstep + kstep, voffB);
        PG8_WAIT_V(6); PG8_BAR;
    }
    for (;;) {
        const bool has_next = S.next(ui + 1, nxt);
        const char* nA = has_next ? (const char*)g.A + (size_t)nxt.pm * tstep : cA; const char* nB = has_next ? (const char*)g.Bt + (size_t)nxt.pn * tstep : cB;
        for (int t = 0; t < nt; t += 2) {
            const bool last = (t == nt - 2);
            const char* a1 = cA + (size_t)(t + 1) * kstep;
            const char* a2 = last ? nA : cA + (size_t)(t + 2) * kstep; const char* b2 = last ? nB : cB + (size_t)(t + 2) * kstep;
            const char* a3 = a2 + kstep; const char* b3 = b2 + kstep;
            if (last && has_next) S.a_ready(nxt);
            if constexpr (SP2) {
            PG8_LDB(B0, 0, 0); PG8_LDB(B1, 0, 1); PG8_SCHED; PG8_LDA(At, 0, 0); PG8_STAGE(PG8_SA(1, 1), a1 + hstep, voffA);
            PG8_WAIT_V(8); PG8_WAIT_L(0); PG8_BAR; PG8_MMA(0, 0, At, B0); PG8_MMA(0, 1, At, B1); PG8_BAR; PG8_SCHED;
            PG8_LDA(At, 0, 1); PG8_STAGE(PG8_SB(0, 0), b2, voffB); PG8_STAGE(PG8_SB(0, 1), b2 + hstep, voffB); PG8_STAGE(PG8_SA(0, 0), a2, voffA);
            PG8_WAIT_V(8); PG8_WAIT_L(0); PG8_BAR; PG8_MMA(1, 0, At, B0); PG8_MMA(1, 1, At, B1); PG8_BAR; PG8_SCHED;
            PG8_LDB(B0, 1, 0); PG8_LDB(B1, 1, 1); PG8_SCHED; PG8_LDA(At, 1, 0); PG8_STAGE(PG8_SA(0, 1), a2 + hstep, voffA);
            PG8_WAIT_V(8); PG8_WAIT_L(0); PG8_BAR; PG8_MMA(0, 0, At, B0); PG8_MMA(0, 1, At, B1); PG8_BAR; PG8_SCHED;
            PG8_LDA(At, 1, 1); PG8_STAGE(PG8_SB(1, 0), b3, voffB); PG8_STAGE(PG8_SB(1, 1), b3 + hstep, voffB); PG8_STAGE(PG8_SA(1, 0), a3, voffA);
            PG8_WAIT_V(8); PG8_WAIT_L(0); PG8_BAR; PG8_MMA(1, 0, At, B0); PG8_MMA(1, 1, At, B1); PG8_BAR; PG8_SCHED;
            } else {
            PG8_LDB(B0, 0, 0); PG8_SCHED; PG8_LDA(At, 0, 0); PG8_STAGE(PG8_SA(1, 1), a1 + hstep, voffA);
            PG8_WAIT_L(8); PG8_BAR; PG8_WAIT_L(0); PG8_MMA(0, 0, At, B0); PG8_BAR; PG8_SCHED;
            PG8_LDB(B1, 0, 1); PG8_STAGE(PG8_SB(0, 0), b2, voffB);
            PG8_BAR; PG8_WAIT_L(0); PG8_MMA(0, 1, At, B1); PG8_BAR;
            PG8_LDA(At, 0, 1); PG8_STAGE(PG8_SA(0, 0), a2, voffA);
            PG8_BAR; PG8_WAIT_L(0); PG8_MMA(1, 0, At, B0); PG8_BAR; PG8_SCHED;
            PG8_STAGE(PG8_SB(0, 1), b2 + hstep, voffB);
            PG8_WAIT_V(6); PG8_BAR; PG8_MMA(1, 1, At, B1); PG8_BAR;
            PG8_LDB(B0, 1, 0); PG8_SCHED; PG8_LDA(At, 1, 0); PG8_STAGE(PG8_SA(0, 1), a2 + hstep, voffA);
            PG8_WAIT_L(8); PG8_BAR; PG8_WAIT_L(0); PG8_MMA(0, 0, At, B0); PG8_BAR; PG8_SCHED;
            PG8_LDB(B1, 1, 1); PG8_STAGE(PG8_SB(1, 0), b3, voffB);
            PG8_BAR; PG8_WAIT_L(0); PG8_MMA(0, 1, At, B1); PG8_BAR;
            PG8_LDA(At, 1, 1); PG8_STAGE(PG8_SA(1, 0), a3, voffA);
            PG8_BAR; PG8_WAIT_L(0); PG8_MMA(1, 0, At, B0); PG8_BAR; PG8_SCHED;
            PG8_STAGE(PG8_SB(1, 1), b3 + hstep, voffB);
            PG8_WAIT_V(6); PG8_BAR; PG8_MMA(1, 1, At, B1); PG8_BAR;
            }
        }
        if constexpr (ALIGN_EPI) { if (wr == 0) PG8_BAR; }
        if constexpr (!Epi::AFTER_DRAIN) { E(acc, cur, wr, wc, fr, fq); S.done(cur); }
        if (!has_next) break;
#pragma unroll
        for (int a = 0; a < 2; ++a)
#pragma unroll
            for (int b = 0; b < 2; ++b)
#pragma unroll
                for (int m = 0; m < 4; ++m)
#pragma unroll
                    for (int n = 0; n < 2; ++n) acc[a][b][m][n] = (f32x4){0.f, 0.f, 0.f, 0.f};
        cur = nxt; cA = nA; cB = nB; ++ui;
        if constexpr (ALIGN_EPI) { if (wr == 1) PG8_BAR; }
    }
    PG8_WAIT_V(0);
    if constexpr (!ALIGN_EPI) { if (wr == 0) PG8_BAR; }
    PG8_BAR;
    if constexpr (Epi::AFTER_DRAIN) { E.fused(acc, cur, wr, wc, fr, fq, lds, wid, lane); S.done(cur); }
#undef PG8_SA
#undef PG8_SB
#undef PG8_STAGE
#undef PG8_LDA
#undef PG8_LDB
#undef PG8_MMA
#undef PG8_WAIT_V
#undef PG8_WAIT_L
#undef PG8_BAR
#undef PG8_SCHED
}
}
namespace att {
#define ALAS __attribute__((address_space(3)))
typedef unsigned short bf16_t;
typedef short bf16x8 __attribute__((ext_vector_type(8)));
typedef float f32x16 __attribute__((ext_vector_type(16)));
typedef float f32x4 __attribute__((ext_vector_type(4)));
typedef unsigned u32x4 __attribute__((ext_vector_type(4)));
typedef unsigned u32x2 __attribute__((ext_vector_type(2)));
constexpr int KROW = 144;
constexpr int KBUF = 64 * KROW;
constexpr int VBUF = 64 * 320;
template <int DV> struct VRow { static constexpr int B = (DV == 128) ? 320 : 192; };
constexpr int L_K = 0, L_V = 2 * KBUF, L_BT = L_V + 2 * VBUF, L_END = L_BT + 2048;
constexpr int L_O1 = L_END;
constexpr int L_QS = L_O1 + 65536;
constexpr float LOG2E = 1.4426950408889634f;
constexpr float QSCALE = 0.125f * 1.4426950408889634f;
#define CR(r) (((r) & 3) + 8 * ((r) >> 2))
typedef float f32x2_t __attribute__((ext_vector_type(2))); typedef __bf16 bf16x2_t __attribute__((ext_vector_type(2)));
__device__ __forceinline__ unsigned cvtpk(float lo, float hi) { f32x2_t v = {lo, hi}; bf16x2_t b = __builtin_convertvector(v, bf16x2_t); return __builtin_bit_cast(unsigned, b); }
__device__ __forceinline__ unsigned cvtpk_a(float lo, float hi) { unsigned r; asm volatile("v_cvt_pk_bf16_f32 %0, %1, %2" : "=v"(r) : "v"(lo), "v"(hi)); return r; }
__device__ __forceinline__ float ex2(float x) { return __builtin_amdgcn_exp2f(x); }
__device__ __forceinline__ float rcpf_(float x) { return __builtin_amdgcn_rcpf(x); }

typedef short v4i16_t __attribute__((ext_vector_type(4)));
__device__ __forceinline__ v4i16_t vtr(const ALAS unsigned char* p) { return __builtin_amdgcn_ds_read_tr16_b64_v4i16((ALAS v4i16_t*)p); }
template <int DV> __device__ __forceinline__ bf16x8 vfrag(const ALAS unsigned char* vb, int s, int db) {
    const v4i16_t lo = vtr(vb + (16 * s) * VRow<DV>::B + 64 * db), hi4 = vtr(vb + (16 * s + 8) * VRow<DV>::B + 64 * db);
    return __builtin_shufflevector(lo, hi4, 0, 1, 2, 3, 4, 5, 6, 7);
}
template <int DV> __device__ __forceinline__ int vtr_lane_off(int lane) { return (4 * (lane >> 5) + ((lane & 15) >> 2)) * VRow<DV>::B + (16 * ((lane >> 4) & 1) + 4 * (lane & 3)) * 2; }
__device__ __forceinline__ float pair_max(float x) { auto rr = __builtin_amdgcn_permlane32_swap(__float_as_uint(x), __float_as_uint(x), false, false); return fmaxf(__uint_as_float(rr[0]), __uint_as_float(rr[1])); }
template <int DV> struct Pref { u32x4 k; u32x4 v[DV / 64]; };

template <int DV> __device__ __forceinline__ void tile_load(Pref<DV>& pf, const bf16_t* Kp, const bf16_t* Vp, int pitch, int kt, int tid) {
    const int krow = tid >> 3, kc = (tid & 7) * 8;
    pf.k = *(const u32x4*)(Kp + (size_t)(kt * 64 + krow) * pitch + kc);
#pragma unroll
    for (int i = 0; i < DV / 64; ++i) { const int c = tid + i * 512, vrow = c / (DV / 8), vc = (c % (DV / 8)) * 8;
        pf.v[i] = *(const u32x4*)(Vp + (size_t)(kt * 64 + vrow) * pitch + vc); }
}
template <int DV> __device__ __forceinline__ void tile_store(const Pref<DV>& pf, ALAS unsigned char* kbuf, ALAS unsigned char* vbuf, int tid) {
    const int krow = tid >> 3, kc = (tid & 7) * 8;
    *(ALAS u32x4*)(kbuf + krow * KROW + kc * 2) = pf.k;
#pragma unroll
    for (int i = 0; i < DV / 64; ++i) { const int c = tid + i * 512, vrow = c / (DV / 8), vc = (c % (DV / 8)) * 8;
        *(ALAS u32x4*)(vbuf + vrow * VRow<DV>::B + vc * 2) = pf.v[i]; }
}

template <int DV> __device__ __forceinline__ void pv_slab(const ALAS unsigned char* vbuf, int s, u32x4 w, f32x16 (&o)[DV / 32], int l32, int hi) {
    const bf16x8 pfr = __builtin_bit_cast(bf16x8, w);
#pragma unroll
    for (int db = 0; db < DV / 32; ++db) {
        const bf16x8 vf = vfrag<DV>(vbuf + vtr_lane_off<DV>(l32 + 32 * hi), s, db);
        o[db] = __builtin_amdgcn_mfma_f32_32x32x16_bf16(vf, pfr, o[db], 0, 0, 0); }
    if (DV > 64) __builtin_amdgcn_sched_barrier(0);
}

template <int MODE, int DV, bool MASKED>
__device__ __forceinline__ void tile_compute(const ALAS unsigned char* kbuf, const ALAS unsigned char* vbuf, const bf16x8 (&qf)[4], f32x16 (&o)[DV / 32],
                                             float& st_m, float& st_l, int lim, const ALAS float* btab, float cbias, int lane) {
    const int l32 = lane & 31, hi = lane >> 5;
    if constexpr (MODE == 0) {
        f32x16 p0, p1;
#pragma unroll
        for (int r = 0; r < 16; ++r) { p0[r] = 0.f; p1[r] = 0.f; }
        { const ALAS unsigned char* kb = kbuf + l32 * KROW + hi * 16;
#pragma unroll
          for (int d0 = 0; d0 < 4; ++d0) {
              const bf16x8 k0 = *(const ALAS bf16x8*)(kb + d0 * 32);
              const bf16x8 k1 = *(const ALAS bf16x8*)(kb + 32 * KROW + d0 * 32);
              p0 = __builtin_amdgcn_mfma_f32_32x32x16_bf16(k0, qf[d0], p0, 0, 0, 0);
              p1 = __builtin_amdgcn_mfma_f32_32x32x16_bf16(k1, qf[d0], p1, 0, 0, 0); } }
        __builtin_amdgcn_sched_barrier(0);
#pragma unroll
        for (int r = 0; r < 16; ++r) {
            float a = rcpf_(1.0f + ex2(p0[r])), b = rcpf_(1.0f + ex2(p1[r]));
            if (MASKED) { a = (CR(r) < lim) ? a : 1.0f; b = (CR(r) + 32 < lim) ? b : 1.0f; }
            p0[r] = a; p1[r] = b; }
        float g[8], hs[8], pr[8];
#pragma unroll
        for (int i = 0; i < 4; ++i) { g[i] = (p0[4 * i] * p0[4 * i + 1]) * (p0[4 * i + 2] * p0[4 * i + 3]); g[4 + i] = (p1[4 * i] * p1[4 * i + 1]) * (p1[4 * i + 2] * p1[4 * i + 3]); }
#pragma unroll
        for (int i = 0; i < 8; ++i) { auto rr = __builtin_amdgcn_permlane32_swap(__float_as_uint(g[i]), __float_as_uint(g[i]), false, false);
            pr[i] = __uint_as_float(rr[0]) * __uint_as_float(rr[1]); hs[i] = hi ? 1.0f : __uint_as_float(rr[1]); }
        float T = st_m;
#pragma unroll
        for (int i = 7; i >= 0; --i) {
            float R = hs[i] * T; T = T * pr[i];
            if (i >= 4) { const int b = 4 * (i - 4);
                float R2 = R * p1[b + 3]; p1[b + 3] = R - R2; float R1 = R2 * p1[b + 2]; p1[b + 2] = R2 - R1; float R0 = R1 * p1[b + 1]; p1[b + 1] = R1 - R0; p1[b] = R0 - R0 * p1[b]; }
            else { const int b = 4 * i;
                float R2 = R * p0[b + 3]; p0[b + 3] = R - R2; float R1 = R2 * p0[b + 2]; p0[b + 2] = R2 - R1; float R0 = R1 * p0[b + 1]; p0[b + 1] = R1 - R0; p0[b] = R0 - R0 * p0[b]; }
        }
        st_m = T;
        __builtin_amdgcn_sched_barrier(0);
#pragma unroll
        for (int s = 0; s < 4; ++s) {
            u32x4 w;
            if (s == 0) { w.x = cvtpk(p0[0], p0[1]); w.y = cvtpk(p0[2], p0[3]); w.z = cvtpk(p0[4], p0[5]); w.w = cvtpk(p0[6], p0[7]); }
            else if (s == 1) { w.x = cvtpk(p0[8], p0[9]); w.y = cvtpk(p0[10], p0[11]); w.z = cvtpk(p0[12], p0[13]); w.w = cvtpk(p0[14], p0[15]); }
            else if (s == 2) { w.x = cvtpk(p1[0], p1[1]); w.y = cvtpk(p1[2], p1[3]); w.z = cvtpk(p1[4], p1[5]); w.w = cvtpk(p1[6], p1[7]); }
            else { w.x = cvtpk(p1[8], p1[9]); w.y = cvtpk(p1[10], p1[11]); w.z = cvtpk(p1[12], p1[13]); w.w = cvtpk(p1[14], p1[15]); }
            pv_slab<DV>(vbuf, s, w, o, l32, hi);
        }
    } else {
        const float NEG = -__builtin_inff();
#pragma unroll
        for (int hk = 0; hk < 2; ++hk) {
            f32x16 p;
            const bool fresh = (st_m == NEG);
            const float mbase = fresh ? 0.f : st_m;
            { const float ini = (MASKED ? 0.f : cbias) - mbase;
#pragma unroll
              for (int r = 0; r < 16; ++r) p[r] = ini; }
            { const ALAS unsigned char* kb = kbuf + (32 * hk + l32) * KROW + hi * 16;
#pragma unroll
              for (int d0 = 0; d0 < 4; ++d0) { const bf16x8 k0 = *(const ALAS bf16x8*)(kb + d0 * 32); p = __builtin_amdgcn_mfma_f32_32x32x16_bf16(k0, qf[d0], p, 0, 0, 0); } }
            if (MASKED) {
                float bv[16];
#pragma unroll
                for (int r = 0; r < 16; ++r) { const int d0 = lim - 32 * hk - CR(r); bv[r] = btab[min(max(d0, 0), 127)]; }
#pragma unroll
                for (int r = 0; r < 16; ++r) asm volatile("" : "+v"(bv[r]));
#pragma unroll
                for (int r = 0; r < 16; ++r) {
                    const int d0 = lim - 32 * hk - CR(r);
                    const bool v0 = (MODE == 2) ? ((unsigned)d0 < 128u) : (d0 >= 0);
                    p[r] = v0 ? p[r] + bv[r] : NEG; }
            }
            float mt = fmaxf(p[0], p[1]);
#pragma unroll
            for (int r = 2; r < 16; ++r) mt = fmaxf(mt, p[r]);
            mt = fmaxf(mt, __shfl_xor(mt, 32));
            const bool need = fresh ? (mt > NEG) : (mt > 0.f);
            if (__any(need)) {
                const float dl = need ? mt : 0.f, f = fresh ? 1.0f : ex2(-dl);
                st_l *= f; st_m = need ? mbase + dl : st_m;
#pragma unroll
                for (int r = 0; r < 16; ++r) p[r] -= dl;
#pragma unroll
                for (int db = 0; db < DV / 32; ++db)
#pragma unroll
                    for (int r = 0; r < 16; ++r) o[db][r] *= f;
            }
            float s = 0.f;
#pragma unroll
            for (int r = 0; r < 16; ++r) { p[r] = ex2(p[r]); s += p[r]; }
            st_l += s;
#pragma unroll
            for (int s2 = 0; s2 < 2; ++s2) {
                u32x4 w; w.x = cvtpk(p[8 * s2], p[8 * s2 + 1]); w.y = cvtpk(p[8 * s2 + 2], p[8 * s2 + 3]); w.z = cvtpk(p[8 * s2 + 4], p[8 * s2 + 5]); w.w = cvtpk(p[8 * s2 + 6], p[8 * s2 + 7]);
                pv_slab<DV>(vbuf, 2 * hk + s2, w, o, l32, hi);
            }
        }
    }
}

template <int MODE, int DV>
__device__ __forceinline__ void attn_core(const bf16_t* Qp, const bf16_t* Kp, const bf16_t* Vp, int pitch, int q0, int kt0, int nt, int dir,
                                          ALAS unsigned char* lds, f32x16 (&o)[DV / 32], float& st_m, float& st_l) {
    int tid_ = threadIdx.x; asm volatile("" : "+v"(tid_));
    const int tid = tid_, lane = tid & 63, l32 = lane & 31, hi = lane >> 5, wid = __builtin_amdgcn_readfirstlane(tid >> 6);
    const int qw = q0 + 32 * wid, t = qw + l32;
    const ALAS float* btab = (const ALAS float*)(lds + L_BT);
    bf16x8 qf[4];
#pragma unroll
    for (int d0 = 0; d0 < 4; ++d0) qf[d0] = *(const bf16x8*)(Qp + (size_t)t * pitch + d0 * 16 + hi * 8);
#pragma unroll
    for (int db = 0; db < DV / 32; ++db)
#pragma unroll
        for (int r = 0; r < 16; ++r) o[db][r] = 0.f;
    st_m = (MODE == 0) ? 1.0f : -__builtin_inff(); st_l = 0.f;
    Pref<DV> pfA, pfB;
    tile_load<DV>(pfA, Kp, Vp, pitch, kt0, tid);
    tile_load<DV>(pfB, Kp, Vp, pitch, kt0 + dir * min(1, nt - 1), tid);
    tile_store<DV>(pfA, lds + L_K, lds + L_V, tid);
    __syncthreads();
    const float cbias = (MODE == 1) ? btab[127] : 0.f;
    bool done = false;
#define AC_STEP(it_, PFN, PFS) do { \
        const int it = (it_), kt = kt0 + dir * it, cur = it & 1, kbase = kt * 64; \
        tile_load<DV>(PFN, Kp, Vp, pitch, kt0 + dir * min(it + 2, nt - 1), tid);        \
        const ALAS unsigned char* kb = lds + L_K + cur * KBUF; const ALAS unsigned char* vb = lds + L_V + cur * VBUF; \
        const int lim = t - kbase - 4 * hi; \
        if (MODE == 0) { \
            if (kbase <= qw + 31 && __any(st_m != 0.0f)) { if (kbase + 63 >= qw) tile_compute<0, DV, true>(kb, vb, qf, o, st_m, st_l, lim, btab, cbias, lane); else tile_compute<0, DV, false>(kb, vb, qf, o, st_m, st_l, lim, btab, cbias, lane); } \
        } else if (MODE == 1) { \
            if (kbase <= qw + 31) { if (qw - (kbase + 63) < 113) tile_compute<1, DV, true>(kb, vb, qf, o, st_m, st_l, lim, btab, cbias, lane); else tile_compute<1, DV, false>(kb, vb, qf, o, st_m, st_l, lim, btab, cbias, lane); } \
        } else { \
            if (kbase <= qw + 31 && kbase + 63 >= qw - 127) tile_compute<2, DV, true>(kb, vb, qf, o, st_m, st_l, lim, btab, cbias, lane); \
        } \
        if (it + 1 < nt) tile_store<DV>(PFS, lds + L_K + (cur ^ 1) * KBUF, lds + L_V + (cur ^ 1) * VBUF, tid);     \
        if (MODE == 0) { \
              \
            if (!__syncthreads_or(st_m != 0.0f)) done = true; \
        } else __syncthreads(); } while (0)
    for (int it2 = 0; it2 < nt && !done; it2 += 2) {
        AC_STEP(it2, pfA, pfB);
        if (done) break;
        AC_STEP(it2 + 1, pfB, pfA);
    }
#undef AC_STEP
}
template <int MODE, int DV>
__device__ __forceinline__ void attn_core_pp(const bf16_t* Qp, const bf16_t* Kp, const bf16_t* Vp, int pitch, int q0, int kt0, int nt,
                                             ALAS unsigned char* lds, f32x16 (&o)[DV / 32], float& st_m, float& st_l) {
    int tid_ = threadIdx.x; asm volatile("" : "+v"(tid_));
    const int tid = tid_, lane = tid & 63, l32 = lane & 31, hi = lane >> 5, wid = __builtin_amdgcn_readfirstlane(tid >> 6), grp = wid >> 2;
    const int qw = q0 + 32 * wid, t = qw + l32;
    const ALAS float* btab = (const ALAS float*)(lds + L_BT);
    const float NEG = -__builtin_inff();
    bf16x8 qf[4];
#pragma unroll
    for (int d0 = 0; d0 < 4; ++d0) qf[d0] = *(const bf16x8*)(Qp + (size_t)t * pitch + d0 * 16 + hi * 8);
    ALAS unsigned char* qst = lds + L_QS + wid * 3072 + lane * 16;
    if (DV == 128) {
#pragma unroll
        for (int d0 = 1; d0 < 4; ++d0) *(ALAS bf16x8*)(qst + (d0 - 1) * 1024) = qf[d0];
    }
#pragma unroll
    for (int db = 0; db < DV / 32; ++db)
#pragma unroll
        for (int r = 0; r < 16; ++r) o[db][r] = 0.f;
    st_m = NEG; st_l = 0.f;
    Pref<DV> pfA, pfB;
    tile_load<DV>(pfA, Kp, Vp, pitch, kt0, tid);
    tile_load<DV>(pfB, Kp, Vp, pitch, kt0 + 1, tid);
    tile_store<DV>(pfA, lds + L_K, lds + L_V, tid);
    tile_store<DV>(pfB, lds + L_K + KBUF, lds + L_V + VBUF, tid);
    tile_load<DV>(pfA, Kp, Vp, pitch, kt0 + min(2, nt - 1), tid);
    tile_load<DV>(pfB, Kp, Vp, pitch, kt0 + min(3, nt - 1), tid);
    __syncthreads();
    const float cbias = (MODE == 1) ? btab[256 + 127] : 0.f;
    f32x16 p; u32x4 pw0, pw1;
#pragma unroll
    for (int r = 0; r < 16; ++r) p[r] = 0.f;
    pw0 = (u32x4){0u, 0u, 0u, 0u}; pw1 = pw0;
#define PP_MASKED(ti) ((MODE == 1) ? (qw - ((kt0 + (ti)) * 64 + 63) < 113) : true)
#define PP_PART(ti) ((MODE != 2) || ((kt0 + (ti)) * 64 <= qw + 31 && (kt0 + (ti)) * 64 + 63 >= qw - 127))
#define PP_QK(ti, hk) do { \
        const float mbase_ = (st_m == NEG) ? 0.f : st_m; const float ini_ = (PP_MASKED(ti) ? 0.f : cbias) - mbase_; \
        _Pragma("unroll") for (int r = 0; r < 16; ++r) p[r] = ini_; \
        const ALAS unsigned char* kb_ = lds + L_K + ((ti) & 1) * KBUF + (32 * (hk) + l32) * KROW + hi * 16; \
        _Pragma("unroll") for (int d0 = 0; d0 < 4; ++d0) { const bf16x8 k0_ = *(const ALAS bf16x8*)(kb_ + d0 * 32); \
            const bf16x8 qv_ = (DV == 128 && d0 > 0) ? *(const ALAS bf16x8*)(qst + (d0 - 1) * 1024) : qf[d0]; \
            p = __builtin_amdgcn_mfma_f32_32x32x16_bf16(k0_, qv_, p, 0, 0, 0); } } while (0)
#define PP_PVQK(tv, hv, tk, hq) do { \
        const ALAS unsigned char* vb_ = lds + L_V + ((tv) & 1) * VBUF + vtr_lane_off<DV>(lane); \
        const ALAS unsigned char* kb_ = lds + L_K + ((tk) & 1) * KBUF + (32 * (hq) + l32) * KROW + hi * 16; \
        if (PP_PART(tv)) { \
            bf16x8 vf_[DV / 32][2]; \
            _Pragma("unroll") for (int db = 0; db < DV / 32; ++db) { vf_[db][0] = vfrag<DV>(vb_, 2 * (hv), db); vf_[db][1] = vfrag<DV>(vb_, 2 * (hv) + 1, db); } \
            const bf16x8 pa_ = __builtin_bit_cast(bf16x8, pw0), pb_ = __builtin_bit_cast(bf16x8, pw1); \
            _Pragma("unroll") for (int db = 0; db < DV / 32; ++db) o[db] = __builtin_amdgcn_mfma_f32_32x32x16_bf16(vf_[db][0], pa_, o[db], 0, 0, 0); \
            _Pragma("unroll") for (int db = 0; db < DV / 32; ++db) o[db] = __builtin_amdgcn_mfma_f32_32x32x16_bf16(vf_[db][1], pb_, o[db], 0, 0, 0); } \
        if (PP_PART(tk)) { \
            bf16x8 kf_[4], qv_[4]; \
            _Pragma("unroll") for (int d0 = 0; d0 < 4; ++d0) { kf_[d0] = *(const ALAS bf16x8*)(kb_ + d0 * 32); qv_[d0] = (DV == 128 && d0 > 0) ? *(const ALAS bf16x8*)(qst + (d0 - 1) * 1024) : qf[d0]; } \
            const float mbase_ = (st_m == NEG) ? 0.f : st_m; const float ini_ = (PP_MASKED(tk) ? 0.f : cbias) - mbase_; \
            _Pragma("unroll") for (int r = 0; r < 16; ++r) p[r] = ini_; \
            _Pragma("unroll") for (int d0 = 0; d0 < 4; ++d0) p = __builtin_amdgcn_mfma_f32_32x32x16_bf16(kf_[d0], qv_[d0], p, 0, 0, 0); } } while (0)
#define PP_SM(ti, hk) do { if (PP_PART(ti)) { \
        if (PP_MASKED(ti)) { const int lim_ = t - (kt0 + (ti)) * 64 - 4 * hi - 32 * (hk); \
            const ALAS float* bp_ = btab + (lim_ + 256 - 27);            \
            float bv_[16]; \
            _Pragma("unroll") for (int r = 0; r < 16; ++r) bv_[r] = bp_[27 - CR(r)]; \
            _Pragma("unroll") for (int r = 0; r < 16; ++r) p[r] += bv_[r]; } \
        const bool fresh_ = (st_m == NEG); const float mb_ = fresh_ ? 0.f : st_m; \
        float mt_; { const float a0_ = fmaxf(fmaxf(p[0], p[1]), p[2]), a1_ = fmaxf(fmaxf(p[3], p[4]), p[5]), a2_ = fmaxf(fmaxf(p[6], p[7]), p[8]), a3_ = fmaxf(fmaxf(p[9], p[10]), p[11]), a4_ = fmaxf(fmaxf(p[12], p[13]), p[14]); \
            mt_ = fmaxf(fmaxf(fmaxf(a0_, a1_), a2_), fmaxf(fmaxf(a3_, a4_), p[15])); }        \
        mt_ = pair_max(mt_); \
        const bool need_ = fresh_ ? (mt_ > NEG) : (mt_ > 6.0f);        \
        if (__any(need_)) { const float dl_ = need_ ? mt_ : 0.f, f_ = fresh_ ? 1.0f : ex2(-dl_); \
            st_l *= f_; st_m = need_ ? mb_ + dl_ : st_m; \
            _Pragma("unroll") for (int r = 0; r < 16; ++r) p[r] -= dl_; \
            _Pragma("unroll") for (int db = 0; db < DV / 32; ++db) _Pragma("unroll") for (int r = 0; r < 16; ++r) o[db][r] *= f_; } \
        _Pragma("unroll") for (int r = 0; r < 16; ++r) p[r] = ex2(p[r]); \
        st_l += ((p[0] + p[1]) + (p[2] + p[3])) + ((p[4] + p[5]) + (p[6] + p[7])) + (((p[8] + p[9]) + (p[10] + p[11])) + ((p[12] + p[13]) + (p[14] + p[15]))); \
        pw0.x = cvtpk_a(p[0], p[1]); pw0.y = cvtpk_a(p[2], p[3]); pw0.z = cvtpk_a(p[4], p[5]); pw0.w = cvtpk_a(p[6], p[7]); \
        pw1.x = cvtpk_a(p[8], p[9]); pw1.y = cvtpk_a(p[10], p[11]); pw1.z = cvtpk_a(p[12], p[13]); pw1.w = cvtpk_a(p[14], p[15]); } } while (0)
#define PP_STAGE(u, PF) do { const int u_ = (u); if (u_ >= 2 && u_ < nt) tile_store<DV>(PF, lds + L_K + (u_ & 1) * KBUF, lds + L_V + (u_ & 1) * VBUF, tid); \
        tile_load<DV>(PF, Kp, Vp, pitch, kt0 + min(u_ + 2, nt - 1), tid); } while (0)
#define PP_BAR() asm volatile("s_waitcnt lgkmcnt(0)\n\ts_barrier" ::: "memory")
    if (grp == 1) __builtin_amdgcn_s_setprio(1);
    if (grp == 0) {
        PP_QK(0, 0); PP_BAR();
        for (int ti = 0; ti < nt; ti += 2) {
            PP_SM(ti, 0); PP_BAR();
            PP_PVQK(ti, 0, ti, 1); PP_STAGE(ti + 1, pfB); PP_BAR();
            PP_SM(ti, 1); PP_BAR();
            PP_PVQK(ti, 1, ti + 1, 0); PP_BAR();
            PP_SM(ti + 1, 0); PP_BAR();
            PP_PVQK(ti + 1, 0, ti + 1, 1); PP_STAGE(ti + 2, pfA); PP_BAR();
            PP_SM(ti + 1, 1); PP_BAR();
            PP_PVQK(ti + 1, 1, ti + 2, 0); PP_BAR();
        }
        PP_BAR();
    } else {
        PP_BAR();
        PP_QK(0, 0); PP_BAR();
        for (int ti = 0; ti < nt; ti += 2) {
            PP_SM(ti, 0); PP_STAGE(ti + 1, pfB); PP_BAR();
            PP_PVQK(ti, 0, ti, 1); PP_BAR();
            PP_SM(ti, 1); PP_BAR();
            PP_PVQK(ti, 1, ti + 1, 0); PP_BAR();
            PP_SM(ti + 1, 0); PP_STAGE(ti + 2, pfA); PP_BAR();
            PP_PVQK(ti + 1, 0, ti + 1, 1); PP_BAR();
            PP_SM(ti + 1, 1); PP_BAR();
            PP_PVQK(ti + 1, 1, ti + 2, 0); PP_BAR();
        }
    }
    __builtin_amdgcn_s_setprio(0);
#undef PP_MASKED
#undef PP_PART
#undef PP_QK
#undef PP_PVQK
#undef PP_SM
#undef PP_STAGE
#undef PP_BAR
}
template <int DV> __device__ __forceinline__ void store_ot(const f32x16 (&o)[DV / 32], bf16_t* orow, int hi) {
#pragma unroll
    for (int db = 0; db < DV / 32; ++db)
#pragma unroll
        for (int rg = 0; rg < 4; ++rg) { u32x2 w; w.x = cvtpk_a(o[db][4 * rg], o[db][4 * rg + 1]); w.y = cvtpk_a(o[db][4 * rg + 2], o[db][4 * rg + 3]);
            *(u32x2*)(orow + 32 * db + 8 * rg + 4 * hi) = w; }
}
}
#ifndef RESID_BF16
#define RESID_BF16 1
#endif
#ifndef OUT_STAGGER_TICKS
#define OUT_STAGGER_TICKS 0
#endif
#ifndef OUT_STAGGER_GROUPS
#define OUT_STAGGER_GROUPS 2
#endif
#ifndef REP_OUT
#define REP_OUT 1
#endif
#ifndef REP_DOWN
#define REP_DOWN 1
#endif
#ifndef REP_INPROJ
#define REP_INPROJ 1
#endif
#ifndef REP_DIFF
#define REP_DIFF 1
#endif
#ifndef REP_SWA
#define REP_SWA 1
#endif
#ifndef REP_SB
#define REP_SB 1
#endif
#ifndef REP_UP
#define REP_UP 1
#endif
#ifndef REP_CONV
#define REP_CONV 1
#endif
#ifndef PH_DIFF
#define PH_DIFF 1
#endif
#ifndef PH_SWA
#define PH_SWA 1
#endif
#ifndef PH_SB
#define PH_SB 1
#endif
#ifndef PH_CONV
#define PH_CONV 1
#endif
#define LAS __attribute__((address_space(3)))
typedef unsigned short bf16;
typedef float f32x4 __attribute__((ext_vector_type(4)));
typedef unsigned v4u __attribute__((ext_vector_type(4)));
typedef unsigned v2u __attribute__((ext_vector_type(2)));
constexpr int NWAVES = 8;
constexpr int SEQ = 4096, NB = 16, MTOK = NB * SEQ, DM = 1024, DFF = 2816, DUP = 2 * DFF;
constexpr int EVEN_IN = 2304, ODD_IN = 3072;
constexpr size_t MiB = 1u << 20;
constexpr size_t WS_SSQ = 1 * MiB;
constexpr size_t WS_WINE = 8 * MiB, WS_WOUTE = 17 * MiB, WS_WINO = 21 * MiB, WS_WOUTO = 33 * MiB, WS_WUP = 37 * MiB, WS_WDN = 81 * MiB;
constexpr size_t WS_XB = 104 * MiB, WS_R = 232 * MiB;
constexpr size_t WS_PROJ = WS_R, WS_AO = WS_R + 384 * MiB, WS_U = WS_R, WS_G = WS_R + 352 * MiB;
constexpr int LDS_MISC = 152576, LDS_BYTES = 153600;
static_assert(att::L_QS + 8 * 3072 <= LDS_MISC, "LDS map");
constexpr int HALF_ROWS = MTOK / 2;

struct Args {
    const float* x; const float* rel_bias; const float* norm_mix; const float* norm_ffn; const float* norm_final;
    const float* w_in_even; const float* w_out_even; const float* sinks; const float* lam_q1; const float* lam_k1; const float* lam_q2; const float* lam_k2;
    const float* diff_norm; const float* w_in_odd; const float* w_out_odd; const float* ffn_up; const float* ffn_conv; const float* ffn_conv_b; const float* ffn_down;
    float* out; unsigned char* ws;
};

__device__ const unsigned char T5B[128] = {0, 1, 2, 3, 4, 5, 6, 7, 8, 9, 10, 11, 12, 13, 14, 15, 16, 16, 16, 17, 17, 18, 18, 18, 19, 19, 19, 20, 20, 20, 20, 21, 21, 21, 21, 22, 22, 22, 22, 22, 23, 23, 23, 23, 23, 23, 24, 24, 24, 24, 24, 24, 25, 25, 25, 25, 25, 25, 25, 26, 26, 26, 26, 26, 26, 26, 26, 27, 27, 27, 27, 27, 27, 27, 27, 27, 27, 28, 28, 28, 28, 28, 28, 28, 28, 28, 28, 29, 29, 29, 29, 29, 29, 29, 29, 29, 29, 29, 29, 30, 30, 30, 30, 30, 30, 30, 30, 30, 30, 30, 30, 30, 30, 31, 31, 31, 31, 31, 31, 31, 31, 31, 31, 31, 31, 31, 31, 31};

__device__ __forceinline__ float wave_sum(float v) {
#pragma unroll
    for (int o = 1; o < 64; o <<= 1) v += __shfl_xor(v, o);
    return v;
}
__device__ __forceinline__ unsigned f2bf(float f) { unsigned u = __builtin_bit_cast(unsigned, f); return (u + 0x7fffu + ((u >> 16) & 1u)) >> 16; }
__device__ __forceinline__ unsigned pk2(float lo, float hi) { return f2bf(lo) | (f2bf(hi) << 16); }

__device__ __forceinline__ void transpose_item(const float* W, int K, int N, bf16* WT, const float* gk, int a0, int a1, int b0, int b1, float cs, LAS float* scr, int item, int lane) {
    const int nblk = N / 32, kb = item / nblk, nb = item % nblk, k0 = 64 * kb, n0 = 32 * nb;
    const int nn = n0 + (lane & 31);
    const float csc = ((nn >= a0 && nn < a1) || (nn >= b0 && nn < b1)) ? cs : 1.0f;
#pragma unroll 8
    for (int i = 0; i < 32; ++i) { const int kk = 2 * i + (lane >> 5); const float gv = gk ? gk[k0 + kk] : 1.0f; scr[kk * 33 + (lane & 31)] = W[(size_t)(k0 + kk) * N + nn] * (gv * csc); }
    asm volatile("s_waitcnt lgkmcnt(0)" ::: "memory");
    const int c = lane & 7;
#pragma unroll
    for (int j = 0; j < 4; ++j) { const int n = (lane >> 3) + 8 * j; const LAS float* s = scr + (8 * c) * 33 + n;
        v4u o; o.x = pk2(s[0 * 33], s[1 * 33]); o.y = pk2(s[2 * 33], s[3 * 33]); o.z = pk2(s[4 * 33], s[5 * 33]); o.w = pk2(s[6 * 33], s[7 * 33]);
        *(v4u*)(WT + (size_t)(n0 + n) * K + k0 + 8 * c) = o; }
    asm volatile("s_waitcnt lgkmcnt(0)" ::: "memory");
}

#define XB_TMO      128
#define XB_XCNT(j)  (256  + 64 * (j))
#define XB_XSUB(j)  (1280 + 64 * (j))
#define XB_XGEN(j)  (2304 + 64 * (j))
#define XB_TOP      3328
#define XB_TOPGEN   3392
#define XCD_BAR_WORDS 3456
#define XB_SPIN_CAP (1u << 18)

__device__ __forceinline__ unsigned xb_ld(unsigned* p)              { return __hip_atomic_load(p, __ATOMIC_RELAXED, __HIP_MEMORY_SCOPE_AGENT); }
__device__ __forceinline__ unsigned xb_add(unsigned* p, unsigned v) { return __hip_atomic_fetch_add(p, v, __ATOMIC_RELAXED, __HIP_MEMORY_SCOPE_AGENT); }
__device__ __forceinline__ unsigned xb_xcc_id() { return (unsigned)__builtin_amdgcn_s_getreg((3 << 11) | 20) & 0xFu; }
#define XB_SPIN(cond, bar) do { unsigned _sp = 0; while (cond) { __builtin_amdgcn_s_sleep(1); \
    if ((++_sp & 255u) == 0u) { if (xb_ld(&(bar)[XB_TMO])) break; if (_sp > XB_SPIN_CAP) { atomicAdd(&(bar)[XB_TMO], 1u); break; } } } } while (0)

struct XcdBarrier {
    unsigned* bar; unsigned x;
    volatile LAS unsigned* st;
};

__device__ __forceinline__ XcdBarrier xcd_barrier_post(unsigned* bar, volatile LAS unsigned* st) {
    XcdBarrier b; b.bar = bar; b.x = xb_xcc_id(); b.st = st;
    if (threadIdx.x == 0) (void)xb_add(&bar[XB_XCNT(b.x)], 1u);
    return b;
}
__device__ __forceinline__ void xcd_barrier_complete(unsigned* bar, unsigned x, unsigned& nloc, unsigned& nx) {
    const unsigned G = gridDim.x * gridDim.y * gridDim.z;
    unsigned sum, cnt, mine, sp = 0u;
    for (;;) {
        sum = 0u; cnt = 0u; mine = 0u;
#pragma unroll
        for (unsigned j = 0; j < 16; ++j) { const unsigned c = xb_ld(&bar[XB_XCNT(j)]); sum += c; cnt += (c > 0u) ? 1u : 0u; mine = (j == x) ? c : mine; }
        if (sum == G) break;
        __builtin_amdgcn_s_sleep(1);
        if ((++sp & 255u) == 0u) { if (xb_ld(&bar[XB_TMO])) break; if (sp > XB_SPIN_CAP) { atomicAdd(&bar[XB_TMO], 1u); break; } }
    }
    nloc = mine > 0u ? mine : 1u; nx = cnt > 0u ? cnt : 1u;
}

__device__ __forceinline__ void xcd_barrier(const XcdBarrier& b) {
    asm volatile("s_waitcnt vmcnt(0)" ::: "memory");
    __syncthreads();
    if (threadIdx.x == 0) {
        unsigned* bar = b.bar;
        __builtin_amdgcn_s_waitcnt(0);
        unsigned nloc = b.st[0], nx = b.st[1];
        if (nloc == 0u) { xcd_barrier_complete(bar, b.x, nloc, nx); b.st[0] = nloc; b.st[1] = nx; }
        const unsigned old = xb_add(&bar[XB_XSUB(b.x)], 1u);
        const unsigned gen = old / nloc;
        if (old + 1u == (gen + 1u) * nloc) {
            __builtin_amdgcn_fence(__ATOMIC_RELEASE, "agent");
            asm volatile("s_waitcnt vmcnt(0)" ::: "memory");
            const unsigned og = xb_add(&bar[XB_TOP], 1u);
            const unsigned tg = og / nx;
            if (og + 1u == (tg + 1u) * nx) xb_add(&bar[XB_TOPGEN], 1u);
            else XB_SPIN(xb_ld(&bar[XB_TOPGEN]) == tg, bar);
            __builtin_amdgcn_fence(__ATOMIC_ACQUIRE, "agent");
            xb_add(&bar[XB_XGEN(b.x)], 1u);
            asm volatile("s_waitcnt vmcnt(0)" ::: "memory");
        } else {
            XB_SPIN(xb_ld(&bar[XB_XGEN(b.x)]) == gen, bar);
            __builtin_amdgcn_fence(__ATOMIC_ACQUIRE, "agent");
            asm volatile("s_waitcnt vmcnt(0)" ::: "memory");
        }
    }
    __syncthreads();
}

__global__ void __launch_bounds__(NWAVES * 64, 2) mega_fwd(Args a) {
    extern __shared__ __attribute__((aligned(16))) unsigned char lds_raw[];
    cg::grid_group grid = cg::this_grid();
    LAS unsigned char* lds = (LAS unsigned char*)lds_raw;
    const int tid = threadIdx.x, lane = tid & 63, wave = __builtin_amdgcn_readfirstlane(tid >> 6);
    const int G = gridDim.x, bx = blockIdx.x;
    const int gw = bx * NWAVES + wave, NGW = G * NWAVES;
    const int vcu = (G % 8 == 0) ? (bx % 8) * (G / 8) + bx / 8 : bx;
    unsigned char* ws = a.ws;
    float* ssq = (float*)(ws + WS_SSQ);
    bf16* xb = (bf16*)(ws + WS_XB);
    bf16* proj = (bf16*)(ws + WS_PROJ);
    bf16* ao = (bf16*)(ws + WS_AO);
    bf16* ubuf = (bf16*)(ws + WS_U);
    bf16* gbuf = (bf16*)(ws + WS_G);

    if (bx == 0) for (int i = tid; i < XCD_BAR_WORDS; i += NWAVES * 64) ((unsigned*)ws)[i] = 0u;
    if (tid < 2) ((LAS unsigned*)(lds + LDS_MISC))[tid] = 0u;
    {
        LAS float* scr = (LAS float*)(lds + wave * 16384);
        constexpr int I_INE = 16 * (EVEN_IN / 32), I_OUT = 16 * 32, I_INO = 16 * (ODD_IN / 32), I_UP = 16 * (DUP / 32), I_DN = (DFF / 64) * 32;
        constexpr int NITEMS = 2 * I_INE + 2 * I_OUT + 2 * I_INO + 2 * I_OUT + 4 * I_UP + 4 * I_DN;
        for (int it = gw; it < NITEMS; it += NGW) {
            int r = it;
            if (r < 2 * I_INE) { const int e = r / I_INE; r -= e * I_INE;
                transpose_item(a.w_in_even + (size_t)e * DM * EVEN_IN, DM, EVEN_IN, (bf16*)(ws + WS_WINE) + (size_t)e * EVEN_IN * DM, a.norm_mix + (2 * e) * DM, 0, 512, 768, 1280, att::QSCALE, scr, r, lane); continue; }
            r -= 2 * I_INE;
            if (r < 2 * I_OUT) { const int e = r / I_OUT; r -= e * I_OUT;
                transpose_item(a.w_out_even + (size_t)e * DM * DM, DM, DM, (bf16*)(ws + WS_WOUTE) + (size_t)e * DM * DM, nullptr, 0, 0, 0, 0, 1.f, scr, r, lane); continue; }
            r -= 2 * I_OUT;
            if (r < 2 * I_INO) { const int e = r / I_INO; r -= e * I_INO;
                transpose_item(a.w_in_odd + (size_t)e * DM * ODD_IN, DM, ODD_IN, (bf16*)(ws + WS_WINO) + (size_t)e * ODD_IN * DM, a.norm_mix + (2 * e + 1) * DM, 0, 1024, 0, 0, att::QSCALE, scr, r, lane); continue; }
            r -= 2 * I_INO;
            if (r < 2 * I_OUT) { const int e = r / I_OUT; r -= e * I_OUT;
                transpose_item(a.w_out_odd + (size_t)e * DM * DM, DM, DM, (bf16*)(ws + WS_WOUTO) + (size_t)e * DM * DM, nullptr, 0, 0, 0, 0, 1.f, scr, r, lane); continue; }
            r -= 2 * I_OUT;
            if (r < 4 * I_UP) { const int e = r / I_UP; r -= e * I_UP;
                transpose_item(a.ffn_up + (size_t)e * DM * DUP, DM, DUP, (bf16*)(ws + WS_WUP) + (size_t)e * DUP * DM, a.norm_ffn + e * DM, 0, 0, 0, 0, 1.f, scr, r, lane); continue; }
            r -= 4 * I_UP;
            { const int e = r / I_DN; r -= e * I_DN;
                transpose_item(a.ffn_down + (size_t)e * DFF * DM, DFF, DM, (bf16*)(ws + WS_WDN) + (size_t)e * DM * DFF, nullptr, 0, 0, 0, 0, 1.f, scr, r, lane); }
        }
        for (int m0 = 2 * gw; m0 < MTOK; m0 += 2 * NGW) {
            f32x4 v[2][4];
#pragma unroll
            for (int h2 = 0; h2 < 2; ++h2) { const f32x4* xr = (const f32x4*)(a.x + (size_t)(m0 + h2) * DM) + lane;
#pragma unroll
                for (int j = 0; j < 4; ++j) v[h2][j] = __builtin_nontemporal_load(xr + 64 * j); }
#pragma unroll
            for (int h2 = 0; h2 < 2; ++h2) { const int m = m0 + h2; float s = 0.f;
#pragma unroll
                for (int j = 0; j < 4; ++j) s += (v[h2][j][0] * v[h2][j][0] + v[h2][j][1] * v[h2][j][1]) + (v[h2][j][2] * v[h2][j][2] + v[h2][j][3] * v[h2][j][3]);
                s = wave_sum(s);
                v2u* o8 = (v2u*)(xb + (size_t)m * DM) + lane;
#pragma unroll
                for (int j = 0; j < 4; ++j) { v2u w; w.x = pk2(v[h2][j][0], v[h2][j][1]); w.y = pk2(v[h2][j][2], v[h2][j][3]); o8[64 * j] = w; }
                if (lane < 16) ssq[(size_t)m * 16 + lane] = (lane == 0) ? s : 0.f; }
        }
    }
    grid.sync();
    const XcdBarrier xbar = xcd_barrier_post((unsigned*)ws, (volatile LAS unsigned*)(lds + LDS_MISC));

    for (int layer = 0; layer < 4; ++layer) {
        const int e = layer >> 1; const bool even = (layer & 1) == 0;
        const float* xold = (layer == 0) ? a.x : a.out;
        {
            const int N = even ? EVEN_IN : ODD_IN;
            const bf16* wt = even ? (const bf16*)(ws + WS_WINE) + (size_t)e * EVEN_IN * DM : (const bf16*)(ws + WS_WINO) + (size_t)e * ODD_IN * DM;
            pg8::Gemm g{xb, wt, MTOK, N, DM}; pg8::StaticOrder S; S.init(MTOK, N, G, bx);
            pg8::EpiScaleBf16 E{proj, N, ssq};
            for (int rep_ = 0; rep_ < REP_INPROJ; ++rep_)
            pg8::gemm_phase<pg8::EpiScaleBf16, pg8::StaticOrder, true, true>(lds, g, S, E);
        }
        xcd_barrier(xbar);
        if (even) {
            int tq = threadIdx.x; asm volatile("" : "+v"(tq)); const int tid = tq, lane = tq & 63, l32 = lane & 31, hi = lane >> 5;
            float lam, one_m_li;
            { const float li = (layer == 0) ? 0.2f : 0.47071301839f;
              const float s1 = wave_sum(a.lam_q1[e * 64 + lane] * a.lam_k1[e * 64 + lane]), s2 = wave_sum(a.lam_q2[e * 64 + lane] * a.lam_k2[e * 64 + lane]);
              lam = __expf(s1) - __expf(s2) + li; lam = __builtin_bit_cast(float, __builtin_amdgcn_readfirstlane(__builtin_bit_cast(int, lam))); one_m_li = __builtin_bit_cast(float, __builtin_amdgcn_readfirstlane(__builtin_bit_cast(int, 1.0f - li))); }
            LAS float* btab = (LAS float*)(lds + att::L_BT);

#if PH_DIFF
            for (int rep_ = 0; rep_ < REP_DIFF; ++rep_)
            for (int uidx = vcu; uidx < 1024; uidx += G) {
                const int j = uidx >> 8, c = uidx & 255, bh = c >> 2, s = c & 3, b = bh >> 2, h = bh & 3;
                const int qb = (j == 0) ? s : (j == 1) ? 7 - s : (j == 2) ? 8 + s : 15 - s;
                { int tb = threadIdx.x; asm volatile("" : "+v"(tb)); const int dd = tb - 256;
                  btab[tb] = (dd < 0) ? -__builtin_inff() : a.rel_bias[T5B[dd < 127 ? dd : 127] * 12 + 8 + h] * att::LOG2E; }
                const bf16* base = proj + (size_t)b * SEQ * EVEN_IN;
                const int q0 = qb * 256, nt = 4 * qb + 4, t = q0 + 32 * wave + l32;
                att::f32x16 o2[4]; float m2, l2; LAS unsigned* o1s = (LAS unsigned*)(lds + att::L_O1 + wave * 8192) + lane;
                { float m1, l1;
                  att::attn_core_pp<1, 128>(base + 768 + h * 128, base + 1280 + h * 128, base + 1792 + h * 128, EVEN_IN, q0, 0, nt, lds, o2, m1, l1);
                  const float inv = __builtin_amdgcn_rcpf(l1 + __shfl_xor(l1, 32));
#pragma unroll
                  for (int db = 0; db < 4; ++db)
#pragma unroll
                      for (int k = 0; k < 8; ++k) o1s[(db * 8 + k) * 64] = att::cvtpk(o2[db][2 * k] * inv, o2[db][2 * k + 1] * inv); }
                att::attn_core_pp<1, 128>(base + 768 + h * 128 + 64, base + 1280 + h * 128 + 64, base + 1792 + h * 128, EVEN_IN, q0, 0, nt, lds, o2, m2, l2);
                { const float inv = lam * __builtin_amdgcn_rcpf(l2 + __shfl_xor(l2, 32)); float ss = 0.f;
#pragma unroll
                  for (int db = 0; db < 4; ++db)
#pragma unroll
                      for (int r = 0; r < 16; ++r) { const unsigned w = o1s[(db * 8 + (r >> 1)) * 64]; const float a1 = __uint_as_float((r & 1) ? (w & 0xffff0000u) : (w << 16));
                          const float v = a1 - inv * o2[db][r]; o2[db][r] = v; ss += v * v; }
                  ss += __shfl_xor(ss, 32);
                  const float rs = __builtin_amdgcn_rsqf(ss * (1.0f / 128.0f) + 1e-6f) * one_m_li;
                  const float* gn = a.diff_norm + e * 128;
#pragma unroll
                  for (int db = 0; db < 4; ++db)
#pragma unroll
                      for (int rg = 0; rg < 4; ++rg) { const f32x4 gv = *(const f32x4*)(gn + 32 * db + 8 * rg + 4 * hi);
#pragma unroll
                          for (int k = 0; k < 4; ++k) o2[db][4 * rg + k] *= rs * gv[k]; } }
                { int tb = threadIdx.x; asm volatile("" : "+v"(tb)); const int t2 = q0 + 32 * (tb >> 6) + (tb & 31);
                  att::store_ot<128>(o2, ao + ((size_t)b * SEQ + t2) * DM + 512 + h * 128, (tb >> 5) & 1); }
            }
#endif
#if PH_SWA
            for (int rep_ = 0; rep_ < REP_SWA; ++rep_)
            for (int uidx = vcu; uidx < 2048; uidx += G) {
                const int qb = uidx & 15, qh = (uidx >> 4) & 7, b = uidx >> 7, kvh = qh >> 2;
                { int tb = threadIdx.x; asm volatile("" : "+v"(tb)); const int dd = tb - 256;
                  btab[tb] = (dd < 0 || dd >= 128) ? -__builtin_inff() : a.rel_bias[T5B[dd] * 12 + qh] * att::LOG2E; }
                const bf16* base = proj + (size_t)b * SEQ * EVEN_IN;
                const int q0 = qb * 256, t = q0 + 32 * wave + l32;
                const int kt0 = (qb * 4 - 2 > 0) ? qb * 4 - 2 : 0, nt = qb * 4 + 4 - kt0;
                att::f32x16 o[2]; float m, l;
                att::attn_core_pp<2, 64>(base + qh * 64, base + 512 + kvh * 64, base + 640 + kvh * 64, EVEN_IN, q0, kt0, nt, lds, o, m, l);
                const float sk = a.sinks[e * 8 + qh] * att::LOG2E;
                const float inv = __builtin_amdgcn_rcpf(l + __shfl_xor(l, 32) + __builtin_amdgcn_exp2f(sk - m));
#pragma unroll
                for (int db = 0; db < 2; ++db)
#pragma unroll
                    for (int r = 0; r < 16; ++r) o[db][r] *= inv;
                att::store_ot<64>(o, ao + ((size_t)b * SEQ + t) * DM + qh * 64, hi);
            }
#endif
        } else {
#if PH_SB
            int tq = threadIdx.x; asm volatile("" : "+v"(tq)); const int lane = tq & 63, l32 = lane & 31, hi = lane >> 5;
            for (int rep_ = 0; rep_ < REP_SB; ++rep_)
            for (int uidx = bx; uidx < 4096; uidx += G) {
                const int bh = uidx & 255, qb = 15 - (uidx >> 8), b = bh >> 4, h = bh & 15;
                const bf16* base = proj + (size_t)b * SEQ * ODD_IN;
                const int q0 = qb * 256, nt = 4 * qb + 4, t = q0 + 32 * wave + l32;
                att::f32x16 o[2]; float P, dummy;
                att::attn_core<0, 64>(base + h * 64, base + 1024 + h * 64, base + 2048 + h * 64, ODD_IN, q0, nt - 1, nt, -1, lds, o, P, dummy);
                att::store_ot<64>(o, ao + ((size_t)b * SEQ + t) * DM + h * 64, hi);
            }
#endif
        }
        xcd_barrier(xbar);
        {
            const bf16* wt = even ? (const bf16*)(ws + WS_WOUTE) + (size_t)e * DM * DM : (const bf16*)(ws + WS_WOUTO) + (size_t)e * DM * DM;
            pg8::Gemm g{ao, wt, MTOK, DM, DM}; pg8::StaticOrder S; S.init(MTOK, DM, G, bx);
#if OUT_STAGGER_TICKS > 0
            { const unsigned long long t0 = __builtin_amdgcn_s_memrealtime(); const unsigned long long dly = (unsigned long long)(((bx >> 3) & (OUT_STAGGER_GROUPS - 1)) * OUT_STAGGER_TICKS);
              while (__builtin_amdgcn_s_memrealtime() - t0 < dly) __builtin_amdgcn_s_sleep(8); }
#endif
#if REP_OUT == 2
            { pg8::EpiResid Ed{xold, (float*)(ws + WS_PROJ), (bf16*)(ws + WS_PROJ + 256 * MiB), (float*)(ws + 800 * MiB)};
              pg8::gemm_phase<pg8::EpiResid, pg8::StaticOrder, true, true>(lds, g, S, Ed); }
#elif REP_OUT == 3
            { pg8::EpiScaleBf16 Ed{(bf16*)(ws + WS_PROJ), DM, ssq};
              pg8::gemm_phase<pg8::EpiScaleBf16, pg8::StaticOrder, true, true>(lds, g, S, Ed); }
#endif
#if RESID_BF16
            pg8::EpiResidB E{xb, xb, ssq};
            pg8::gemm_phase<pg8::EpiResidB, pg8::StaticOrder, true, true>(lds, g, S, E);
#else
            pg8::EpiResid E{xold, a.out, xb, ssq};
            pg8::gemm_phase<pg8::EpiResid, pg8::StaticOrder, true, true>(lds, g, S, E);
#endif
        }
        xcd_barrier(xbar);
        const bf16* wup = (const bf16*)(ws + WS_WUP) + (size_t)layer * DUP * DM;
        const bf16* wdn = (const bf16*)(ws + WS_WDN) + (size_t)layer * DM * DFF;
        for (int half = 0; half < 2; ++half) {
            const size_t r0 = (size_t)half * HALF_ROWS;
            {
                pg8::Gemm g{xb + r0 * DM, wup, HALF_ROWS, DUP, DM}; pg8::StaticOrder S; S.init(HALF_ROWS, DUP, G, bx);
                pg8::EpiScaleBf16 E{ubuf, DUP, ssq + r0 * 16};
                for (int rep_ = 0; rep_ < REP_UP; ++rep_)
                pg8::gemm_phase<pg8::EpiScaleBf16, pg8::StaticOrder, true, true>(lds, g, S, E);
            }
            xcd_barrier(xbar);
#if PH_CONV
            {
                const float* cw = a.ffn_conv + (size_t)layer * 3 * DUP; const float* cb = a.ffn_conv_b + (size_t)layer * DUP;
                constexpr int NCC = 6, NRC = HALF_ROWS / 32;
                int tq = threadIdx.x; asm volatile("" : "+v"(tq)); const int lane = tq & 63;
                for (int rep_ = 0; rep_ < REP_CONV; ++rep_)
                for (int it = gw; it < NCC * NRC; it += NGW) {
                    const int cc = it % NCC, rc = it / NCC, cgp = cc * 64 + lane;
                    if (cgp < DFF / 8) {
                        const int col = cgp * 8, row0 = rc * 32;
                        float wg[3][8], wv[3][8], bg[8], bv[8];
#pragma unroll
                        for (int tp = 0; tp < 3; ++tp)
#pragma unroll
                            for (int k = 0; k < 8; k += 4) { const f32x4 t1 = *(const f32x4*)(cw + tp * DUP + col + k), t2 = *(const f32x4*)(cw + tp * DUP + DFF + col + k);
#pragma unroll
                                for (int q = 0; q < 4; ++q) { wg[tp][k + q] = t1[q]; wv[tp][k + q] = t2[q]; } }
#pragma unroll
                        for (int k = 0; k < 8; k += 4) { const f32x4 t1 = *(const f32x4*)(cb + col + k), t2 = *(const f32x4*)(cb + DFF + col + k);
#pragma unroll
                            for (int q = 0; q < 4; ++q) { bg[k + q] = t1[q]; bv[k + q] = t2[q]; } }
                        float g2[8], g1[8], v2[8], v1[8];
                        const bool head = (row0 % SEQ) == 0;
                        {
                            v4u a2 = {0, 0, 0, 0}, a1 = {0, 0, 0, 0}, c2 = {0, 0, 0, 0}, c1 = {0, 0, 0, 0};
                            if (!head) { const bf16* up = ubuf + (size_t)(row0 - 2) * DUP + col; a2 = *(const v4u*)up; c2 = *(const v4u*)(up + DFF); a1 = *(const v4u*)(up + DUP); c1 = *(const v4u*)(up + DUP + DFF); }
#pragma unroll
                            for (int k = 0; k < 8; ++k) { const int sh = (k & 1) * 16;
                                g2[k] = __uint_as_float(((a2[k >> 1] >> sh) & 0xffffu) << 16); g1[k] = __uint_as_float(((a1[k >> 1] >> sh) & 0xffffu) << 16);
                                v2[k] = __uint_as_float(((c2[k >> 1] >> sh) & 0xffffu) << 16); v1[k] = __uint_as_float(((c1[k >> 1] >> sh) & 0xffffu) << 16); }
                        }
                        for (int r4 = 0; r4 < 32; r4 += 8) {
                            v4u av[8], cv[8];
#pragma unroll
                            for (int rr = 0; rr < 8; ++rr) { const bf16* up = ubuf + (size_t)(row0 + r4 + rr) * DUP + col;
                                av[rr] = __builtin_nontemporal_load((const v4u*)up); cv[rr] = __builtin_nontemporal_load((const v4u*)(up + DFF)); }
#pragma unroll
                            for (int rr = 0; rr < 8; ++rr) {
                                const v4u a0 = av[rr], c0 = cv[rr];
                                float res[8];
#pragma unroll
                                for (int k = 0; k < 8; ++k) { const int sh = (k & 1) * 16;
                                    const float g0 = __uint_as_float(((a0[k >> 1] >> sh) & 0xffffu) << 16), v0 = __uint_as_float(((c0[k >> 1] >> sh) & 0xffffu) << 16);
                                    const float gg = bg[k] + wg[0][k] * g2[k] + wg[1][k] * g1[k] + wg[2][k] * g0;
                                    const float vv = bv[k] + wv[0][k] * v2[k] + wv[1][k] * v1[k] + wv[2][k] * v0;
                                    const float sg = gg * __builtin_amdgcn_rcpf(1.0f + __builtin_amdgcn_exp2f(-gg * att::LOG2E));
                                    res[k] = sg * vv; g2[k] = g1[k]; g1[k] = g0; v2[k] = v1[k]; v1[k] = v0; }
                                v4u w; w.x = pk2(res[0], res[1]); w.y = pk2(res[2], res[3]); w.z = pk2(res[4], res[5]); w.w = pk2(res[6], res[7]);
                                *(v4u*)(gbuf + (size_t)(row0 + r4 + rr) * DFF + col) = w;
                            }
                        }
                    }
                }
            }
#endif
            xcd_barrier(xbar);
            {
                pg8::Gemm g{gbuf, wdn, HALF_ROWS, DM, DFF}; pg8::StaticOrder S; S.init(HALF_ROWS, DM, G, bx);
#if REP_DOWN > 1
                { pg8::EpiResid Ed{a.out + r0 * DM, (float*)(ws + 760 * MiB), (bf16*)(ws + 888 * MiB), (float*)(ws + 960 * MiB)};
                  pg8::gemm_phase<pg8::EpiResid, pg8::StaticOrder, true, true>(lds, g, S, Ed); }
#endif
#if RESID_BF16
                pg8::EpiResidB E{xb + r0 * DM, xb + r0 * DM, ssq + r0 * 16};
                pg8::gemm_phase<pg8::EpiResidB, pg8::StaticOrder, true, true>(lds, g, S, E);
#else
                pg8::EpiResid E{a.out + r0 * DM, a.out + r0 * DM, xb + r0 * DM, ssq + r0 * 16};
                pg8::gemm_phase<pg8::EpiResid, pg8::StaticOrder, true, true>(lds, g, S, E);
#endif
            }
            if (half == 1) xcd_barrier(xbar);
        }
    }
    { int tq = threadIdx.x; asm volatile("" : "+v"(tq)); const int lane = tq & 63;
    for (int m = gw; m < MTOK; m += NGW) {
        f32x4* xr = (f32x4*)(a.out + (size_t)m * DM) + lane; f32x4 v[4]; float s = 0.f;
#if RESID_BF16
        const v2u* xin = (const v2u*)(xb + (size_t)m * DM) + lane;
#pragma unroll
        for (int j = 0; j < 4; ++j) { const v2u w = xin[64 * j]; v[j][0] = __uint_as_float(w.x << 16); v[j][1] = __uint_as_float(w.x & 0xffff0000u); v[j][2] = __uint_as_float(w.y << 16); v[j][3] = __uint_as_float(w.y & 0xffff0000u);
            s += (v[j][0] * v[j][0] + v[j][1] * v[j][1]) + (v[j][2] * v[j][2] + v[j][3] * v[j][3]); }
#else
#pragma unroll
        for (int j = 0; j < 4; ++j) { v[j] = xr[64 * j]; s += (v[j][0] * v[j][0] + v[j][1] * v[j][1]) + (v[j][2] * v[j][2] + v[j][3] * v[j][3]); }
#endif
        s = wave_sum(s);
        const float rs = __builtin_amdgcn_rsqf(s * (1.0f / DM) + 1e-6f);
#pragma unroll
        for (int j = 0; j < 4; ++j) { const f32x4 gv = *((const f32x4*)a.norm_final + lane + 64 * j); xr[64 * j] = v[j] * rs * gv; }
    } }
}

extern "C" void kernel_launch(void* const* d_in, const int* in_sizes, int n_in, void* d_out, int out_size, void* d_ws, size_t ws_size, hipStream_t stream) {
    static int grid = 0;
    if (grid == 0) {
        int dev = 0, cus = 0, per_cu = 0;
        (void)hipGetDevice(&dev);
        (void)hipDeviceGetAttribute(&cus, hipDeviceAttributeMultiprocessorCount, dev);
        (void)hipFuncSetAttribute((const void*)mega_fwd, hipFuncAttributeMaxDynamicSharedMemorySize, LDS_BYTES);
        (void)hipOccupancyMaxActiveBlocksPerMultiprocessor(&per_cu, (const void*)mega_fwd, NWAVES * 64, LDS_BYTES);
        if (per_cu < 1) per_cu = 1;
        grid = cus * per_cu;
        if (n_in != 19 || ws_size < 1024 * MiB) fprintf(stderr, "kernel_launch: unexpected n_in %d / ws %zu\n", n_in, ws_size);
    }
    Args a{};
    a.x = (const float*)d_in[0]; a.rel_bias = (const float*)d_in[1]; a.norm_mix = (const float*)d_in[2]; a.norm_ffn = (const float*)d_in[3]; a.norm_final = (const float*)d_in[4];
    a.w_in_even = (const float*)d_in[5]; a.w_out_even = (const float*)d_in[6]; a.sinks = (const float*)d_in[7]; a.lam_q1 = (const float*)d_in[8]; a.lam_k1 = (const float*)d_in[9];
    a.lam_q2 = (const float*)d_in[10]; a.lam_k2 = (const float*)d_in[11]; a.diff_norm = (const float*)d_in[12]; a.w_in_odd = (const float*)d_in[13]; a.w_out_odd = (const float*)d_in[14];
    a.ffn_up = (const float*)d_in[15]; a.ffn_conv = (const float*)d_in[16]; a.ffn_conv_b = (const float*)d_in[17]; a.ffn_down = (const float*)d_in[18];
    a.out = (float*)d_out; a.ws = (unsigned char*)d_ws;
    void* args[] = {&a};
    hipError_t err = hipLaunchCooperativeKernel((const void*)mega_fwd, dim3(grid), dim3(NWAVES * 64), args, LDS_BYTES, stream);
    if (err != hipSuccess) fprintf(stderr, "kernel_launch: cooperative launch failed: %s (grid %d)\n", hipGetErrorString(err), grid);
}
```

```cpp
#include <hip/hip_runtime.h>
#include <hip/hip_cooperative_groups.h>
#include <cstdio>
#include <cstdint>
namespace cg = cooperative_groups;
namespace pg8 {
#define PG8_LAS __attribute__((address_space(3)))
typedef unsigned short bf16_t;
typedef short bf16x8 __attribute__((ext_vector_type(8)));
typedef float f32x4 __attribute__((ext_vector_type(4)));
typedef unsigned u32x4 __attribute__((ext_vector_type(4)));
constexpr int BM = 256, BK = 64, HALF = 128, HTB = HALF * BK * 2  , STAGE_BYTES = 8 * HTB, NXCD = 8, WGM = 8;

__host__ __device__ __forceinline__ int lds_byte(int r, int c) { const int st = (r >> 4) * 2 + (c >> 5), rr = r & 15, cc = c & 31, ob = rr * 64 + cc * 2; return st * 1024 + (ob ^ (((ob >> 9) & 1) << 5)); }
__host__ __device__ __forceinline__ void stage_rc(int b, int& R, int& C) { const int st = b / 1024, sb = b % 1024, swz = sb ^ (((sb >> 9) & 1) << 5); R = (st >> 1) * 16 + swz / 64; C = (st & 1) * 32 + (swz % 64) / 2; }
__host__ __device__ __forceinline__ int perm32(int rho) { const int n = rho >> 4, i = rho & 15; return 8 * (i >> 2) + 4 * n + (i & 3); }

struct Unit { int pm, pn; };
struct Gemm { const bf16_t* A; const bf16_t* Bt; int M, N, K; };

struct StaticOrder {
    int nM, nN, nwg, G, c;
    __host__ __device__ void init(int M, int N, int G_, int c_) { nM = M / BM; nN = N / BM; nwg = nM * nN; G = G_; c = c_; }
    __host__ __device__ bool next(int i, Unit& u) const {
        const long L = (long)i * G + c; if (L >= nwg) return false;
        int wgid = (int)L; { const int q = nwg / NXCD, r = nwg % NXCD, xcd = wgid % NXCD, off = wgid / NXCD; wgid = (xcd < r ? xcd * (q + 1) : r * (q + 1) + (xcd - r) * q) + off; }
        const int nig = WGM * nN, gid = wgid / nig, fm = gid * WGM, gsz = (nM - fm) < WGM ? (nM - fm) : WGM;
        u.pm = fm + ((wgid % nig) % gsz); u.pn = (wgid % nig) / gsz; return true;
    }
    __device__ __forceinline__ void a_ready(const Unit&) const {}
    __device__ __forceinline__ void done(const Unit&) const {}
};

__device__ __forceinline__ unsigned cvt_pk_bf16(float lo, float hi) { unsigned r; asm volatile("v_cvt_pk_bf16_f32 %0, %1, %2" : "=v"(r) : "v"(lo), "v"(hi)); return r; }
typedef float f32x2 __attribute__((ext_vector_type(2)));
typedef unsigned u32x2 __attribute__((ext_vector_type(2)));
constexpr float RMS_EPS = 1e-6f;
struct EpiScaleBf16 {
    static constexpr bool PERM = true, AFTER_DRAIN = false;
    bf16_t* O; int ldc; const float* ssq;
    __device__ __forceinline__ void operator()(const f32x4 (&acc)[2][2][4][2], const Unit& u, int wr, int wc, int fr, int fq) const {
        const int row0 = u.pm * BM + wr * 64 + fr, col0 = u.pn * BM + wc * 32 + 8 * fq;
        f32x4 part[2][4];
#pragma unroll
        for (int ai = 0; ai < 2; ++ai)
#pragma unroll
            for (int m = 0; m < 4; ++m) part[ai][m] = *(const f32x4*)(ssq + (size_t)(row0 + ai * HALF + m * 16) * 16 + fq * 4);
#pragma unroll
        for (int ai = 0; ai < 2; ++ai)
#pragma unroll
            for (int m = 0; m < 4; ++m) { const int row = row0 + ai * HALF + m * 16; bf16_t* rowp = O + (size_t)row * ldc + col0;
                float t = (part[ai][m][0] + part[ai][m][1]) + (part[ai][m][2] + part[ai][m][3]);
                t += __shfl_xor(t, 16); t += __shfl_xor(t, 32);
                const float rs = __builtin_amdgcn_rsqf(t * (1.0f / 1024.0f) + RMS_EPS);
#pragma unroll
                for (int bj = 0; bj < 2; ++bj) { const f32x4 v0 = acc[ai][bj][m][0] * rs, v1 = acc[ai][bj][m][1] * rs;
                    u32x4 w; w.x = cvt_pk_bf16(v0[0], v0[1]); w.y = cvt_pk_bf16(v0[2], v0[3]); w.z = cvt_pk_bf16(v1[0], v1[1]); w.w = cvt_pk_bf16(v1[2], v1[3]);
                    *(u32x4*)(rowp + bj * HALF) = w; } }
    }
};
struct EpiResid {
    static constexpr bool PERM = true, AFTER_DRAIN = false;
    const float* base; float* out; bf16_t* xb; float* ssq;
    __device__ __forceinline__ void operator()(const f32x4 (&acc)[2][2][4][2], const Unit& u, int wr, int wc, int fr, int fq) const {
        const int col0 = u.pn * BM + wc * 32 + 8 * fq;
        const size_t off0 = (size_t)(u.pm * BM + wr * 64 + fr) * 1024 + col0;
        f32x4 nx[2][2][2];
#pragma unroll
        for (int g = 0; g < 2; ++g) { const size_t offn = off0 + (size_t)(g * 16) * 1024;
#pragma unroll
            for (int bj = 0; bj < 2; ++bj)
#pragma unroll
                for (int n = 0; n < 2; ++n) nx[g][bj][n] = *(const f32x4*)(base + offn + bj * HALF + n * 4); }
        asm volatile("" ::: "memory");
#pragma unroll
        for (int g = 0; g < 8; ++g) { const int ai = g >> 2, m = g & 3; const int row = u.pm * BM + ai * HALF + wr * 64 + m * 16 + fr; const size_t off = (size_t)row * 1024 + col0; float q = 0.f;
            f32x4 cu[2][2];
#pragma unroll
            for (int bj = 0; bj < 2; ++bj)
#pragma unroll
                for (int n = 0; n < 2; ++n) cu[bj][n] = nx[g & 1][bj][n];
            if (g < 6) { const size_t offn = off0 + (size_t)(((g + 2) >> 2) * HALF + ((g + 2) & 3) * 16) * 1024;
#pragma unroll
                for (int bj = 0; bj < 2; ++bj)
#pragma unroll
                    for (int n = 0; n < 2; ++n) nx[g & 1][bj][n] = *(const f32x4*)(base + offn + bj * HALF + n * 4); }
#pragma unroll
            for (int bj = 0; bj < 2; ++bj) { const f32x4 o0 = cu[bj][0] + acc[ai][bj][m][0], o1 = cu[bj][1] + acc[ai][bj][m][1];
                *(f32x4*)(out + off + bj * HALF) = o0; *(f32x4*)(out + off + bj * HALF + 4) = o1;
                q += ((o0[0] * o0[0] + o0[1] * o0[1]) + (o0[2] * o0[2] + o0[3] * o0[3])) + ((o1[0] * o1[0] + o1[1] * o1[1]) + (o1[2] * o1[2] + o1[3] * o1[3]));
                u32x4 w; w.x = cvt_pk_bf16(o0[0], o0[1]); w.y = cvt_pk_bf16(o0[2], o0[3]); w.z = cvt_pk_bf16(o1[0], o1[1]); w.w = cvt_pk_bf16(o1[2], o1[3]);
                *(u32x4*)(xb + off + bj * HALF) = w; }
            q += __shfl_xor(q, 16); q += __shfl_xor(q, 32);
            if (fq == 0) ssq[(size_t)row * 16 + u.pn * 4 + wc] = q;
            asm volatile("" ::: "memory"); }
    }
};

struct EpiResidB {
    static constexpr bool PERM = true, AFTER_DRAIN = false;
    const bf16_t* base; bf16_t* xb; float* ssq;
    __device__ __forceinline__ void operator()(const f32x4 (&acc)[2][2][4][2], const Unit& u, int wr, int wc, int fr, int fq) const {
        const int col0 = u.pn * BM + wc * 32 + 8 * fq;
        const size_t off0 = (size_t)(u.pm * BM + wr * 64 + fr) * 1024 + col0;
        u32x4 nx[2][2];
#pragma unroll
        for (int g = 0; g < 2; ++g)
#pragma unroll
            for (int bj = 0; bj < 2; ++bj) nx[g][bj] = *(const u32x4*)(base + off0 + (size_t)(g * 16) * 1024 + bj * HALF);
        asm volatile("" ::: "memory");
#pragma unroll
        for (int g = 0; g < 8; ++g) { const int ai = g >> 2, m = g & 3; const int row = u.pm * BM + ai * HALF + wr * 64 + m * 16 + fr; const size_t off = (size_t)row * 1024 + col0; float q = 0.f;
            u32x4 cu[2];
#pragma unroll
            for (int bj = 0; bj < 2; ++bj) cu[bj] = nx[g & 1][bj];
            if (g < 6) { const size_t offn = off0 + (size_t)(((g + 2) >> 2) * HALF + ((g + 2) & 3) * 16) * 1024;
#pragma unroll
                for (int bj = 0; bj < 2; ++bj) nx[g & 1][bj] = *(const u32x4*)(base + offn + bj * HALF); }
#pragma unroll
            for (int bj = 0; bj < 2; ++bj) {
                f32x4 o0, o1;
                o0[0] = __uint_as_float(cu[bj].x << 16) + acc[ai][bj][m][0][0]; o0[1] = __uint_as_float(cu[bj].x & 0xffff0000u) + acc[ai][bj][m][0][1];
                o0[2] = __uint_as_float(cu[bj].y << 16) + acc[ai][bj][m][0][2]; o0[3] = __uint_as_float(cu[bj].y & 0xffff0000u) + acc[ai][bj][m][0][3];
                o1[0] = __uint_as_float(cu[bj].z << 16) + acc[ai][bj][m][1][0]; o1[1] = __uint_as_float(cu[bj].z & 0xffff0000u) + acc[ai][bj][m][1][1];
                o1[2] = __uint_as_float(cu[bj].w << 16) + acc[ai][bj][m][1][2]; o1[3] = __uint_as_float(cu[bj].w & 0xffff0000u) + acc[ai][bj][m][1][3];
                q += ((o0[0] * o0[0] + o0[1] * o0[1]) + (o0[2] * o0[2] + o0[3] * o0[3])) + ((o1[0] * o1[0] + o1[1] * o1[1]) + (o1[2] * o1[2] + o1[3] * o1[3]));
                u32x4 w; w.x = cvt_pk_bf16(o0[0], o0[1]); w.y = cvt_pk_bf16(o0[2], o0[3]); w.z = cvt_pk_bf16(o1[0], o1[1]); w.w = cvt_pk_bf16(o1[2], o1[3]);
                *(u32x4*)(xb + off + bj * HALF) = w; }
            q += __shfl_xor(q, 16); q += __shfl_xor(q, 32);
            if (fq == 0) ssq[(size_t)row * 16 + u.pn * 4 + wc] = q;
            asm volatile("" ::: "memory"); }
    }
};
template <class Epi, class Sched, bool ALIGN_EPI = false, bool SP2 = false>
__device__ __forceinline__ void gemm_phase(PG8_LAS unsigned char* lds, const Gemm g, const Sched& S, const Epi& E) {
    int tid_ = threadIdx.x; asm volatile("" : "+v"(tid_));
    const int tid = tid_, wid = __builtin_amdgcn_readfirstlane(tid >> 6), lane = tid & 63, wr = wid >> 2, wc = wid & 3, fr = lane & 15, fq = lane >> 4;
    const int K = g.K, nt = K / BK;
    unsigned voffA[2], voffB[2];
#pragma unroll
    for (int i = 0; i < 2; ++i) { int R, C; stage_rc(tid * 16 + i * 8192, R, C); const int Rb = Epi::PERM ? ((R & ~31) + perm32(R & 31)) : R;
        voffA[i] = (unsigned)(R * K + C) * 2u; voffB[i] = (unsigned)(Rb * K + C) * 2u; }
    const size_t kstep = (size_t)(BK * 2);
    const size_t hstep = (size_t)HALF * K * 2;
    const size_t tstep = 2 * hstep;
    const unsigned ldsw = (unsigned)wid * 1024u;
    const int aoff = lds_byte(wr * 64 + fr, fq * 8), boff = lds_byte(wc * 32 + fr, fq * 8);
#define PG8_SA(b, h) (((b) * 2 + (h)) * HTB)
#define PG8_SB(b, h) ((4 + (b) * 2 + (h)) * HTB)
#define PG8_STAGE(bufoff, gbase, voff) do { _Pragma("unroll") for (int _i = 0; _i < 2; ++_i) \
        __builtin_amdgcn_global_load_lds((const unsigned*)((const char*)(gbase) + (voff)[_i]), (PG8_LAS unsigned*)(lds + (bufoff) + ldsw + _i * 8192), 16, 0, 0); } while (0)
#define PG8_LDA(dst, b, h) do { _Pragma("unroll") for (int m = 0; m < 4; ++m) _Pragma("unroll") for (int k = 0; k < 2; ++k) dst[m][k] = *(const PG8_LAS bf16x8*)(lds + PG8_SA(b, h) + aoff + m * 2048 + k * 1024); } while (0)
#define PG8_LDB(dst, b, h) do { _Pragma("unroll") for (int n = 0; n < 2; ++n) _Pragma("unroll") for (int k = 0; k < 2; ++k) dst[n][k] = *(const PG8_LAS bf16x8*)(lds + PG8_SB(b, h) + boff + n * 2048 + k * 1024); } while (0)
#define PG8_MMA(ai, bj, At, Bt) do { __builtin_amdgcn_s_setprio(1); _Pragma("unroll") for (int m = 0; m < 4; ++m) _Pragma("unroll") for (int n = 0; n < 2; ++n) _Pragma("unroll") for (int k = 0; k < 2; ++k) \
        acc[ai][bj][m][n] = __builtin_amdgcn_mfma_f32_16x16x32_bf16(Bt[n][k], At[m][k], acc[ai][bj][m][n], 0, 0, 0); __builtin_amdgcn_s_setprio(0); } while (0)
#define PG8_WAIT_V(n) asm volatile("s_waitcnt vmcnt(" #n ")" ::: "memory")
#define PG8_WAIT_L(n) asm volatile("s_waitcnt lgkmcnt(" #n ")" ::: "memory")
#define PG8_BAR __builtin_amdgcn_s_barrier()
#define PG8_SCHED __builtin_amdgcn_sched_barrier(0)
    Unit cur, nxt; int ui = 0;
    if (!S.next(0, cur)) return;
    f32x4 acc[2][2][4][2];
#pragma unroll
    for (int a = 0; a < 2; ++a)
#pragma unroll
        for (int b = 0; b < 2; ++b)
#pragma unroll
            for (int m = 0; m < 4; ++m)
#pragma unroll
                for (int n = 0; n < 2; ++n) acc[a][b][m][n] = (f32x4){0.f, 0.f, 0.f, 0.f};
    bf16x8 At[4][2], B0[2][2], B1[2][2];
    const char* cA = (const char*)g.A + (size_t)cur.pm * tstep; const char* cB = (const char*)g.Bt + (size_t)cur.pn * tstep;
    S.a_ready(cur);
    if constexpr (SP2) {
        PG8_STAGE(PG8_SB(0, 0), cB, voffB); PG8_STAGE(PG8_SB(0, 1), cB + hstep, voffB); PG8_STAGE(PG8_SA(0, 0), cA, voffA); PG8_STAGE(PG8_SA(0, 1), cA + hstep, voffA);
        if (wr == 1) PG8_BAR;
        PG8_WAIT_V(2); PG8_BAR;
        PG8_STAGE(PG8_SB(1, 0), cB + kstep, voffB); PG8_STAGE(PG8_SA(1, 0), cA + kstep, voffA); PG8_STAGE(PG8_SB(1, 1), cB + hstep + kstep, voffB);
        PG8_WAIT_V(6); PG8_BAR;
    } else {
        PG8_STAGE(PG8_SB(0, 0), cB, voffB); PG8_STAGE(PG8_SA(0, 0), cA, voffA); PG8_STAGE(PG8_SB(0, 1), cB + hstep, voffB); PG8_STAGE(PG8_SA(0, 1), cA + hstep, voffA);
        if (wr == 1) PG8_BAR;
        PG8_WAIT_V(4); PG8_BAR;
        PG8_STAGE(PG8_SB(1, 0), cB + kstep, voffB); PG8_STAGE(PG8_SA(1, 0), cA + kstep, voffA); PG8_STAGE(PG8_SB(1, 1), cB + hstep + kstep, voffB);
        PG8_WAIT_V(6); PG8_BAR;
    }
    for (;;) {
        const bool has_next = S.next(ui + 1, nxt);
        const char* nA = has_next ? (const char*)g.A + (size_t)nxt.pm * tstep : cA; const char* nB = has_next ? (const char*)g.Bt + (size_t)nxt.pn * tstep : cB;
        for (int t = 0; t < nt; t += 2) {
            const bool last = (t == nt - 2);
            const char* a1 = cA + (size_t)(t + 1) * kstep;
            const char* a2 = last ? nA : cA + (size_t)(t + 2) * kstep; const char* b2 = last ? nB : cB + (size_t)(t + 2) * kstep;
            const char* a3 = a2 + kstep; const char* b3 = b2 + kstep;
            if (last && has_next) S.a_ready(nxt);
            if constexpr (SP2) {
            PG8_LDB(B0, 0, 0); PG8_LDB(B1, 0, 1); PG8_SCHED; PG8_LDA(At, 0, 0); PG8_STAGE(PG8_SA(1, 1), a1 + hstep, voffA);
            PG8_WAIT_V(8); PG8_WAIT_L(0); PG8_BAR; PG8_MMA(0, 0, At, B0); PG8_MMA(0, 1, At, B1); PG8_BAR; PG8_SCHED;
            PG8_LDA(At, 0, 1); PG8_STAGE(PG8_SB(0, 0), b2, voffB); PG8_STAGE(PG8_SB(0, 1), b2 + hstep, voffB); PG8_STAGE(PG8_SA(0, 0), a2, voffA);
            PG8_WAIT_V(8); PG8_WAIT_L(0); PG8_BAR; PG8_MMA(1, 0, At, B0); PG8_MMA(1, 1, At, B1); PG8_BAR; PG8_SCHED;
            PG8_LDB(B0, 1, 0); PG8_LDB(B1, 1, 1); PG8_SCHED; PG8_LDA(At, 1, 0); PG8_STAGE(PG8_SA(0, 1), a2 + hstep, voffA);
            PG8_WAIT_V(8); PG8_WAIT_L(0); PG8_BAR; PG8_MMA(0, 0, At, B0); PG8_MMA(0, 1, At, B1); PG8_BAR; PG8_SCHED;
            PG8_LDA(At, 1, 1); PG8_STAGE(PG8_SB(1, 0), b3, voffB); PG8_STAGE(PG8_SB(1, 1), b3 + hstep, voffB); PG8_STAGE(PG8_SA(1, 0), a3, voffA);
            PG8_WAIT_V(8); PG8_WAIT_L(0); PG8_BAR; PG8_MMA(1, 0, At, B0); PG8_MMA(1, 1, At, B1); PG8_BAR; PG8_SCHED;
            } else {
            PG8_LDB(B0, 0, 0); PG8_SCHED; PG8_LDA(At, 0, 0); PG8_STAGE(PG8_SA(1, 1), a1 + hstep, voffA);
            PG8_WAIT_L(8); PG8_BAR; PG8_WAIT_L(0); PG8_MMA(0, 0, At, B0); PG8_BAR; PG8_SCHED;
            PG8_LDB(B1, 0, 1); PG8_STAGE(PG8_SB(0, 0), b2, voffB);
            PG8_BAR; PG8_WAIT_L(0); PG8_MMA(0, 1, At, B1); PG8_BAR;
            PG8_LDA(At, 0, 1); PG8_STAGE(PG8_SA(0, 0), a2, voffA);
            PG8_BAR; PG8_WAIT_L(0); PG8_MMA(1, 0, At, B0); PG8_BAR; PG8_SCHED;
            PG8_STAGE(PG8_SB(0, 1), b2 + hstep, voffB);
            PG8_WAIT_V(6); PG8_BAR; PG8_MMA(1, 1, At, B1); PG8_BAR;
            PG8_LDB(B0, 1, 0); PG8_SCHED; PG8_LDA(At, 1, 0); PG8_STAGE(PG8_SA(0, 1), a2 + hstep, voffA);
            PG8_WAIT_L(8); PG8_BAR; PG8_WAIT_L(0); PG8_MMA(0, 0, At, B0); PG8_BAR; PG8_SCHED;
            PG8_LDB(B1, 1, 1); PG8_STAGE(PG8_SB(1, 0), b3, voffB);
            PG8_BAR; PG8_WAIT_L(0); PG8_MMA(0, 1, At, B1); PG8_BAR;
            PG8_LDA(At, 1, 1); PG8_STAGE(PG8_SA(1, 0), a3, voffA);
            PG8_BAR; PG8_WAIT_L(0); PG8_MMA(1, 0, At, B0); PG8_BAR; PG8_SCHED;
            PG8_STAGE(PG8_SB(1, 1), b3 + hstep, voffB);
            PG8_WAIT_V(6); PG8_BAR; PG8_MMA(1, 1, At, B1); PG8_BAR;
            }
        }
        if constexpr (ALIGN_EPI) { if (wr == 0) PG8_BAR; }
        if constexpr (!Epi::AFTER_DRAIN) { E(acc, cur, wr, wc, fr, fq); S.done(cur); }
        if (!has_next) break;
#pragma unroll
        for (int a = 0; a < 2; ++a)
#pragma unroll
            for (int b = 0; b < 2; ++b)
#pragma unroll
                for (int m = 0; m < 4; ++m)
#pragma unroll
                    for (int n = 0; n < 2; ++n) acc[a][b][m][n] = (f32x4){0.f, 0.f, 0.f, 0.f};
        cur = nxt; cA = nA; cB = nB; ++ui;
        if constexpr (ALIGN_EPI) { if (wr == 1) PG8_BAR; }
    }
    PG8_WAIT_V(0);
    if constexpr (!ALIGN_EPI) { if (wr == 0) PG8_BAR; }
    PG8_BAR;
    if constexpr (Epi::AFTER_DRAIN) { E.fused(acc, cur, wr, wc, fr, fq, lds, wid, lane); S.done(cur); }
#undef PG8_SA
#undef PG8_SB
#undef PG8_STAGE
#undef PG8_LDA
#undef PG8_LDB
#undef PG8_MMA
#undef PG8_WAIT_V
#undef PG8_WAIT_L
#undef PG8_BAR
#undef PG8_SCHED
}
}
namespace att {
#define ALAS __attribute__((address_space(3)))
typedef unsigned short bf16_t;
typedef short bf16x8 __attribute__((ext_vector_type(8)));
typedef float f32x16 __attribute__((ext_vector_type(16)));
typedef float f32x4 __attribute__((ext_vector_type(4)));
typedef unsigned u32x4 __attribute__((ext_vector_type(4)));
typedef unsigned u32x2 __attribute__((ext_vector_type(2)));
constexpr int KROW = 144;
constexpr int KBUF = 64 * KROW;
constexpr int VBUF = 64 * 320;
template <int DV> struct VRow { static constexpr int B = (DV == 128) ? 320 : 192; };
constexpr int L_K = 0, L_V = 2 * KBUF, L_BT = L_V + 2 * VBUF, L_END = L_BT + 2048;
constexpr int L_O1 = L_END;
constexpr int L_QS = L_O1 + 65536;
constexpr float LOG2E = 1.4426950408889634f;
constexpr float QSCALE = 0.125f * 1.4426950408889634f;
#define CR(r) (((r) & 3) + 8 * ((r) >> 2))
typedef float f32x2_t __attribute__((ext_vector_type(2))); typedef __bf16 bf16x2_t __attribute__((ext_vector_type(2)));
__device__ __forceinline__ unsigned cvtpk(float lo, float hi) { f32x2_t v = {lo, hi}; bf16x2_t b = __builtin_convertvector(v, bf16x2_t); return __builtin_bit_cast(unsigned, b); }
__device__ __forceinline__ unsigned cvtpk_a(float lo, float hi) { unsigned r; asm volatile("v_cvt_pk_bf16_f32 %0, %1, %2" : "=v"(r) : "v"(lo), "v"(hi)); return r; }
__device__ __forceinline__ float ex2(float x) { return __builtin_amdgcn_exp2f(x); }
__device__ __forceinline__ float rcpf_(float x) { return __builtin_amdgcn_rcpf(x); }

typedef short v4i16_t __attribute__((ext_vector_type(4)));
__device__ __forceinline__ v4i16_t vtr(const ALAS unsigned char* p) { return __builtin_amdgcn_ds_read_tr16_b64_v4i16((ALAS v4i16_t*)p); }
template <int DV> __device__ __forceinline__ bf16x8 vfrag(const ALAS unsigned char* vb, int s, int db) {
    const v4i16_t lo = vtr(vb + (16 * s) * VRow<DV>::B + 64 * db), hi4 = vtr(vb + (16 * s + 8) * VRow<DV>::B + 64 * db);
    return __builtin_shufflevector(lo, hi4, 0, 1, 2, 3, 4, 5, 6, 7);
}
template <int DV> __device__ __forceinline__ int vtr_lane_off(int lane) { return (4 * (lane >> 5) + ((lane & 15) >> 2)) * VRow<DV>::B + (16 * ((lane >> 4) & 1) + 4 * (lane & 3)) * 2; }
__device__ __forceinline__ float pair_max(float x) { auto rr = __builtin_amdgcn_permlane32_swap(__float_as_uint(x), __float_as_uint(x), false, false); return fmaxf(__uint_as_float(rr[0]), __uint_as_float(rr[1])); }
template <int DV> struct Pref { u32x4 k; u32x4 v[DV / 64]; };

template <int DV> __device__ __forceinline__ void tile_load(Pref<DV>& pf, const bf16_t* Kp, const bf16_t* Vp, int pitch, int kt, int tid) {
    const int krow = tid >> 3, kc = (tid & 7) * 8;
    pf.k = *(const u32x4*)(Kp + (size_t)(kt * 64 + krow) * pitch + kc);
#pragma unroll
    for (int i = 0; i < DV / 64; ++i) { const int c = tid + i * 512, vrow = c / (DV / 8), vc = (c % (DV / 8)) * 8;
        pf.v[i] = *(const u32x4*)(Vp + (size_t)(kt * 64 + vrow) * pitch + vc); }
}
template <int DV> __device__ __forceinline__ void tile_store(const Pref<DV>& pf, ALAS unsigned char* kbuf, ALAS unsigned char* vbuf, int tid) {
    const int krow = tid >> 3, kc = (tid & 7) * 8;
    *(ALAS u32x4*)(kbuf + krow * KROW + kc * 2) = pf.k;
#pragma unroll
    for (int i = 0; i < DV / 64; ++i) { const int c = tid + i * 512, vrow = c / (DV / 8), vc = (c % (DV / 8)) * 8;
        *(ALAS u32x4*)(vbuf + vrow * VRow<DV>::B + vc * 2) = pf.v[i]; }
}

template <int DV> __device__ __forceinline__ void pv_slab(const ALAS unsigned char* vbuf, int s, u32x4 w, f32x16 (&o)[DV / 32], int l32, int hi) {
    const bf16x8 pfr = __builtin_bit_cast(bf16x8, w);
#pragma unroll
    for (int db = 0; db < DV / 32; ++db) {
        const bf16x8 vf = vfrag<DV>(vbuf + vtr_lane_off<DV>(l32 + 32 * hi), s, db);
        o[db] = __builtin_amdgcn_mfma_f32_32x32x16_bf16(vf, pfr, o[db], 0, 0, 0); }
    if (DV > 64) __builtin_amdgcn_sched_barrier(0);
}

template <int MODE, int DV, bool MASKED>
__device__ __forceinline__ void tile_compute(const ALAS unsigned char* kbuf, const ALAS unsigned char* vbuf, const bf16x8 (&qf)[4], f32x16 (&o)[DV / 32],
                                             float& st_m, float& st_l, int lim, const ALAS float* btab, float cbias, int lane) {
    const int l32 = lane & 31, hi = lane >> 5;
    if constexpr (MODE == 0) {
        f32x16 p0, p1;
#pragma unroll
        for (int r = 0; r < 16; ++r) { p0[r] = 0.f; p1[r] = 0.f; }
        { const ALAS unsigned char* kb = kbuf + l32 * KROW + hi * 16;
#pragma unroll
          for (int d0 = 0; d0 < 4; ++d0) {
              const bf16x8 k0 = *(const ALAS bf16x8*)(kb + d0 * 32);
              const bf16x8 k1 = *(const ALAS bf16x8*)(kb + 32 * KROW + d0 * 32);
              p0 = __builtin_amdgcn_mfma_f32_32x32x16_bf16(k0, qf[d0], p0, 0, 0, 0);
              p1 = __builtin_amdgcn_mfma_f32_32x32x16_bf16(k1, qf[d0], p1, 0, 0, 0); } }
        __builtin_amdgcn_sched_barrier(0);
#pragma unroll
        for (int r = 0; r < 16; ++r) {
            float a = rcpf_(1.0f + ex2(p0[r])), b = rcpf_(1.0f + ex2(p1[r]));
            if (MASKED) { a = (CR(r) < lim) ? a : 1.0f; b = (CR(r) + 32 < lim) ? b : 1.0f; }
            p0[r] = a; p1[r] = b; }
        float g[8], hs[8], pr[8];
#pragma unroll
        for (int i = 0; i < 4; ++i) { g[i] = (p0[4 * i] * p0[4 * i + 1]) * (p0[4 * i + 2] * p0[4 * i + 3]); g[4 + i] = (p1[4 * i] * p1[4 * i + 1]) * (p1[4 * i + 2] * p1[4 * i + 3]); }
#pragma unroll
        for (int i = 0; i < 8; ++i) { auto rr = __builtin_amdgcn_permlane32_swap(__float_as_uint(g[i]), __float_as_uint(g[i]), false, false);
            pr[i] = __uint_as_float(rr[0]) * __uint_as_float(rr[1]); hs[i] = hi ? 1.0f : __uint_as_float(rr[1]); }
        float T = st_m;
#pragma unroll
        for (int i = 7; i >= 0; --i) {
            float R = hs[i] * T; T = T * pr[i];
            if (i >= 4) { const int b = 4 * (i - 4);
                float R2 = R * p1[b + 3]; p1[b + 3] = R - R2; float R1 = R2 * p1[b + 2]; p1[b + 2] = R2 - R1; float R0 = R1 * p1[b + 1]; p1[b + 1] = R1 - R0; p1[b] = R0 - R0 * p1[b]; }
            else { const int b = 4 * i;
                float R2 = R * p0[b + 3]; p0[b + 3] = R - R2; float R1 = R2 * p0[b + 2]; p0[b + 2] = R2 - R1; float R0 = R1 * p0[b + 1]; p0[b + 1] = R1 - R0; p0[b] = R0 - R0 * p0[b]; }
        }
        st_m = T;
        __builtin_amdgcn_sched_barrier(0);
#pragma unroll
        for (int s = 0; s < 4; ++s) {
            u32x4 w;
            if (s == 0) { w.x = cvtpk(p0[0], p0[1]); w.y = cvtpk(p0[2], p0[3]); w.z = cvtpk(p0[4], p0[5]); w.w = cvtpk(p0[6], p0[7]); }
            else if (s == 1) { w.x = cvtpk(p0[8], p0[9]); w.y = cvtpk(p0[10], p0[11]); w.z = cvtpk(p0[12], p0[13]); w.w = cvtpk(p0[14], p0[15]); }
            else if (s == 2) { w.x = cvtpk(p1[0], p1[1]); w.y = cvtpk(p1[2], p1[3]); w.z = cvtpk(p1[4], p1[5]); w.w = cvtpk(p1[6], p1[7]); }
            else { w.x = cvtpk(p1[8], p1[9]); w.y = cvtpk(p1[10], p1[11]); w.z = cvtpk(p1[12], p1[13]); w.w = cvtpk(p1[14], p1[15]); }
            pv_slab<DV>(vbuf, s, w, o, l32, hi);
        }
    } else {
        const float NEG = -__builtin_inff();
#pragma unroll
        for (int hk = 0; hk < 2; ++hk) {
            f32x16 p;
            const bool fresh = (st_m == NEG);
            const float mbase = fresh ? 0.f : st_m;
            { const float ini = (MASKED ? 0.f : cbias) - mbase;
#pragma unroll
              for (int r = 0; r < 16; ++r) p[r] = ini; }
            { const ALAS unsigned char* kb = kbuf + (32 * hk + l32) * KROW + hi * 16;
#pragma unroll
              for (int d0 = 0; d0 < 4; ++d0) { const bf16x8 k0 = *(const ALAS bf16x8*)(kb + d0 * 32); p = __builtin_amdgcn_mfma_f32_32x32x16_bf16(k0, qf[d0], p, 0, 0, 0); } }
            if (MASKED) {
                float bv[16];
#pragma unroll
                for (int r = 0; r < 16; ++r) { const int d0 = lim - 32 * hk - CR(r); bv[r] = btab[min(max(d0, 0), 127)]; }
#pragma unroll
                for (int r = 0; r < 16; ++r) asm volatile("" : "+v"(bv[r]));
#pragma unroll
                for (int r = 0; r < 16; ++r) {
                    const int d0 = lim - 32 * hk - CR(r);
                    const bool v0 = (MODE == 2) ? ((unsigned)d0 < 128u) : (d0 >= 0);
                    p[r] = v0 ? p[r] + bv[r] : NEG; }
            }
            float mt = fmaxf(p[0], p[1]);
#pragma unroll
            for (int r = 2; r < 16; ++r) mt = fmaxf(mt, p[r]);
            mt = fmaxf(mt, __shfl_xor(mt, 32));
            const bool need = fresh ? (mt > NEG) : (mt > 0.f);
            if (__any(need)) {
                const float dl = need ? mt : 0.f, f = fresh ? 1.0f : ex2(-dl);
                st_l *= f; st_m = need ? mbase + dl : st_m;
#pragma unroll
                for (int r = 0; r < 16; ++r) p[r] -= dl;
#pragma unroll
                for (int db = 0; db < DV / 32; ++db)
#pragma unroll
                    for (int r = 0; r < 16; ++r) o[db][r] *= f;
            }
            float s = 0.f;
#pragma unroll
            for (int r = 0; r < 16; ++r) { p[r] = ex2(p[r]); s += p[r]; }
            st_l += s;
#pragma unroll
            for (int s2 = 0; s2 < 2; ++s2) {
                u32x4 w; w.x = cvtpk(p[8 * s2], p[8 * s2 + 1]); w.y = cvtpk(p[8 * s2 + 2], p[8 * s2 + 3]); w.z = cvtpk(p[8 * s2 + 4], p[8 * s2 + 5]); w.w = cvtpk(p[8 * s2 + 6], p[8 * s2 + 7]);
                pv_slab<DV>(vbuf, 2 * hk + s2, w, o, l32, hi);
            }
        }
    }
}

template <int MODE, int DV>
__device__ __forceinline__ void attn_core(const bf16_t* Qp, const bf16_t* Kp, const bf16_t* Vp, int pitch, int q0, int kt0, int nt, int dir,
                                          ALAS unsigned char* lds, f32x16 (&o)[DV / 32], float& st_m, float& st_l) {
    int tid_ = threadIdx.x; asm volatile("" : "+v"(tid_));
    const int tid = tid_, lane = tid & 63, l32 = lane & 31, hi = lane >> 5, wid = __builtin_amdgcn_readfirstlane(tid >> 6);
    const int qw = q0 + 32 * wid, t = qw + l32;
    const ALAS float* btab = (const ALAS float*)(lds + L_BT);
    bf16x8 qf[4];
#pragma unroll
    for (int d0 = 0; d0 < 4; ++d0) qf[d0] = *(const bf16x8*)(Qp + (size_t)t * pitch + d0 * 16 + hi * 8);
#pragma unroll
    for (int db = 0; db < DV / 32; ++db)
#pragma unroll
        for (int r = 0; r < 16; ++r) o[db][r] = 0.f;
    st_m = (MODE == 0) ? 1.0f : -__builtin_inff(); st_l = 0.f;
    Pref<DV> pfA, pfB;
    tile_load<DV>(pfA, Kp, Vp, pitch, kt0, tid);
    tile_load<DV>(pfB, Kp, Vp, pitch, kt0 + dir * min(1, nt - 1), tid);
    tile_store<DV>(pfA, lds + L_K, lds + L_V, tid);
    __syncthreads();
    const float cbias = (MODE == 1) ? btab[127] : 0.f;
    bool done = false;
#define AC_STEP(it_, PFN, PFS) do { \
        const int it = (it_), kt = kt0 + dir * it, cur = it & 1, kbase = kt * 64; \
        tile_load<DV>(PFN, Kp, Vp, pitch, kt0 + dir * min(it + 2, nt - 1), tid);        \
        const ALAS unsigned char* kb = lds + L_K + cur * KBUF; const ALAS unsigned char* vb = lds + L_V + cur * VBUF; \
        const int lim = t - kbase - 4 * hi; \
        if (MODE == 0) { \
            if (kbase <= qw + 31 && __any(st_m != 0.0f)) { if (kbase + 63 >= qw) tile_compute<0, DV, true>(kb, vb, qf, o, st_m, st_l, lim, btab, cbias, lane); else tile_compute<0, DV, false>(kb, vb, qf, o, st_m, st_l, lim, btab, cbias, lane); } \
        } else if (MODE == 1) { \
            if (kbase <= qw + 31) { if (qw - (kbase + 63) < 113) tile_compute<1, DV, true>(kb, vb, qf, o, st_m, st_l, lim, btab, cbias, lane); else tile_compute<1, DV, false>(kb, vb, qf, o, st_m, st_l, lim, btab, cbias, lane); } \
        } else { \
            if (kbase <= qw + 31 && kbase + 63 >= qw - 127) tile_compute<2, DV, true>(kb, vb, qf, o, st_m, st_l, lim, btab, cbias, lane); \
        } \
        if (it + 1 < nt) tile_store<DV>(PFS, lds + L_K + (cur ^ 1) * KBUF, lds + L_V + (cur ^ 1) * VBUF, tid);     \
        if (MODE == 0) { \
              \
            if (!__syncthreads_or(st_m != 0.0f)) done = true; \
        } else __syncthreads(); } while (0)
    for (int it2 = 0; it2 < nt && !done; it2 += 2) {
        AC_STEP(it2, pfA, pfB);
        if (done) break;
        AC_STEP(it2 + 1, pfB, pfA);
    }
#undef AC_STEP
}
template <int MODE, int DV>
__device__ __forceinline__ void attn_core_pp(const bf16_t* Qp, const bf16_t* Kp, const bf16_t* Vp, int pitch, int q0, int kt0, int nt,
                                             ALAS unsigned char* lds, f32x16 (&o)[DV / 32], float& st_m, float& st_l) {
    int tid_ = threadIdx.x; asm volatile("" : "+v"(tid_));
    const int tid = tid_, lane = tid & 63, l32 = lane & 31, hi = lane >> 5, wid = __builtin_amdgcn_readfirstlane(tid >> 6), grp = wid >> 2;
    const int qw = q0 + 32 * wid, t = qw + l32;
    const ALAS float* btab = (const ALAS float*)(lds + L_BT);
    const float NEG = -__builtin_inff();
    bf16x8 qf[4];
#pragma unroll
    for (int d0 = 0; d0 < 4; ++d0) qf[d0] = *(const bf16x8*)(Qp + (size_t)t * pitch + d0 * 16 + hi * 8);
    ALAS unsigned char* qst = lds + L_QS + wid * 3072 + lane * 16;
    if (DV == 128) {
#pragma unroll
        for (int d0 = 1; d0 < 4; ++d0) *(ALAS bf16x8*)(qst + (d0 - 1) * 1024) = qf[d0];
    }
#pragma unroll
    for (int db = 0; db < DV / 32; ++db)
#pragma unroll
        for (int r = 0; r < 16; ++r) o[db][r] = 0.f;
    st_m = NEG; st_l = 0.f;
    Pref<DV> pfA, pfB;
    tile_load<DV>(pfA, Kp, Vp, pitch, kt0, tid);
    tile_load<DV>(pfB, Kp, Vp, pitch, kt0 + 1, tid);
    tile_store<DV>(pfA, lds + L_K, lds + L_V, tid);
    tile_store<DV>(pfB, lds + L_K + KBUF, lds + L_V + VBUF, tid);
    tile_load<DV>(pfA, Kp, Vp, pitch, kt0 + min(2, nt - 1), tid);
    tile_load<DV>(pfB, Kp, Vp, pitch, kt0 + min(3, nt - 1), tid);
    __syncthreads();
    const float cbias = (MODE == 1) ? btab[256 + 127] : 0.f;
    f32x16 p; u32x4 pw0, pw1;
#pragma unroll
    for (int r = 0; r < 16; ++r) p[r] = 0.f;
    pw0 = (u32x4){0u, 0u, 0u, 0u}; pw1 = pw0;
#define PP_MASKED(ti) ((MODE == 1) ? (qw - ((kt0 + (ti)) * 64 + 63) < 113) : true)
#define PP_PART(ti) ((MODE != 2) || ((kt0 + (ti)) * 64 <= qw + 31 && (kt0 + (ti)) * 64 + 63 >= qw - 127))
#define PP_QK(ti, hk) do { \
        const float mbase_ = (st_m == NEG) ? 0.f : st_m; const float ini_ = (PP_MASKED(ti) ? 0.f : cbias) - mbase_; \
        _Pragma("unroll") for (int r = 0; r < 16; ++r) p[r] = ini_; \
        const ALAS unsigned char* kb_ = lds + L_K + ((ti) & 1) * KBUF + (32 * (hk) + l32) * KROW + hi * 16; \
        _Pragma("unroll") for (int d0 = 0; d0 < 4; ++d0) { const bf16x8 k0_ = *(const ALAS bf16x8*)(kb_ + d0 * 32); \
            const bf16x8 qv_ = (DV == 128 && d0 > 0) ? *(const ALAS bf16x8*)(qst + (d0 - 1) * 1024) : qf[d0]; \
            p = __builtin_amdgcn_mfma_f32_32x32x16_bf16(k0_, qv_, p, 0, 0, 0); } } while (0)
#define PP_PVQK(tv, hv, tk, hq) do { \
        const ALAS unsigned char* vb_ = lds + L_V + ((tv) & 1) * VBUF + vtr_lane_off<DV>(lane); \
        const ALAS unsigned char* kb_ = lds + L_K + ((tk) & 1) * KBUF + (32 * (hq) + l32) * KROW + hi * 16; \
        if (PP_PART(tv)) { \
            bf16x8 vf_[DV / 32][2]; \
            _Pragma("unroll") for (int db = 0; db < DV / 32; ++db) { vf_[db][0] = vfrag<DV>(vb_, 2 * (hv), db); vf_[db][1] = vfrag<DV>(vb_, 2 * (hv) + 1, db); } \
            const bf16x8 pa_ = __builtin_bit_cast(bf16x8, pw0), pb_ = __builtin_bit_cast(bf16x8, pw1); \
            _Pragma("unroll") for (int db = 0; db < DV / 32; ++db) o[db] = __builtin_amdgcn_mfma_f32_32x32x16_bf16(vf_[db][0], pa_, o[db], 0, 0, 0); \
            _Pragma("unroll") for (int db = 0; db < DV / 32; ++db) o[db] = __builtin_amdgcn_mfma_f32_32x32x16_bf16(vf_[db][1], pb_, o[db], 0, 0, 0); } \
        if (PP_PART(tk)) { \
            bf16x8 kf_[4], qv_[4]; \
            _Pragma("unroll") for (int d0 = 0; d0 < 4; ++d0) { kf_[d0] = *(const ALAS bf16x8*)(kb_ + d0 * 32); qv_[d0] = (DV == 128 && d0 > 0) ? *(const ALAS bf16x8*)(qst + (d0 - 1) * 1024) : qf[d0]; } \
            const float mbase_ = (st_m == NEG) ? 0.f : st_m; const float ini_ = (PP_MASKED(tk) ? 0.f : cbias) - mbase_; \
            _Pragma("unroll") for (int r = 0; r < 16; ++r) p[r] = ini_; \
            _Pragma("unroll") for (int d0 = 0; d0 < 4; ++d0) p = __builtin_amdgcn_mfma_f32_32x32x16_bf16(kf_[d0], qv_[d0], p, 0, 0, 0); } } while (0)
#define PP_SM(ti, hk) do { if (PP_PART(ti)) { \
        if (PP_MASKED(ti)) { const int lim_ = t - (kt0 + (ti)) * 64 - 4 * hi - 32 * (hk); \
            const ALAS float* bp_ = btab + (lim_ + 256 - 27);            \
            float bv_[16]; \
            _Pragma("unroll") for (int r = 0; r < 16; ++r) bv_[r] = bp_[27 - CR(r)]; \
            _Pragma("unroll") for (int r = 0; r < 16; ++r) p[r] += bv_[r]; } \
        const bool fresh_ = (st_m == NEG); const float mb_ = fresh_ ? 0.f : st_m; \
        float mt_; { const float a0_ = fmaxf(fmaxf(p[0], p[1]), p[2]), a1_ = fmaxf(fmaxf(p[3], p[4]), p[5]), a2_ = fmaxf(fmaxf(p[6], p[7]), p[8]), a3_ = fmaxf(fmaxf(p[9], p[10]), p[11]), a4_ = fmaxf(fmaxf(p[12], p[13]), p[14]); \
            mt_ = fmaxf(fmaxf(fmaxf(a0_, a1_), a2_), fmaxf(fmaxf(a3_, a4_), p[15])); }        \
        mt_ = pair_max(mt_); \
        const bool need_ = fresh_ ? (mt_ > NEG) : (mt_ > 6.0f);        \
        if (__any(need_)) { const float dl_ = need_ ? mt_ : 0.f, f_ = fresh_ ? 1.0f : ex2(-dl_); \
            st_l *= f_; st_m = need_ ? mb_ + dl_ : st_m; \
            _Pragma("unroll") for (int r = 0; r < 16; ++r) p[r] -= dl_; \
            _Pragma("unroll") for (int db = 0; db < DV / 32; ++db) _Pragma("unroll") for (int r = 0; r < 16; ++r) o[db][r] *= f_; } \
        _Pragma("unroll") for (int r = 0; r < 16; ++r) p[r] = ex2(p[r]); \
        st_l += ((p[0] + p[1]) + (p[2] + p[3])) + ((p[4] + p[5]) + (p[6] + p[7])) + (((p[8] + p[9]) + (p[10] + p[11])) + ((p[12] + p[13]) + (p[14] + p[15]))); \
        pw0.x = cvtpk_a(p[0], p[1]); pw0.y = cvtpk_a(p[2], p[3]); pw0.z = cvtpk_a(p[4], p[5]); pw0.w = cvtpk_a(p[6], p[7]); \
        pw1.x = cvtpk_a(p[8], p[9]); pw1.y = cvtpk_a(p[10], p[11]); pw1.z = cvtpk_a(p[12], p[13]); pw1.w = cvtpk_a(p[14], p[15]); } } while (0)
#define PP_STAGE(u, PF) do { const int u_ = (u); if (u_ >= 2 && u_ < nt) tile_store<DV>(PF, lds + L_K + (u_ & 1) * KBUF, lds + L_V + (u_ & 1) * VBUF, tid); \
        tile_load<DV>(PF, Kp, Vp, pitch, kt0 + min(u_ + 2, nt - 1), tid); } while (0)
#define PP_BAR() asm volatile("s_waitcnt lgkmcnt(0)\n\ts_barrier" ::: "memory")
    if (grp == 1) __builtin_amdgcn_s_setprio(1);
    if (grp == 0) {
        PP_QK(0, 0); PP_BAR();
        for (int ti = 0; ti < nt; ti += 2) {
            PP_SM(ti, 0); PP_BAR();
            PP_PVQK(ti, 0, ti, 1); PP_STAGE(ti + 1, pfB); PP_BAR();
            PP_SM(ti, 1); PP_BAR();
            PP_PVQK(ti, 1, ti + 1, 0); PP_BAR();
            PP_SM(ti + 1, 0); PP_BAR();
            PP_PVQK(ti + 1, 0, ti + 1, 1); PP_STAGE(ti + 2, pfA); PP_BAR();
            PP_SM(ti + 1, 1); PP_BAR();
            PP_PVQK(ti + 1, 1, ti + 2, 0); PP_BAR();
        }
        PP_BAR();
    } else {
        PP_BAR();
        PP_QK(0, 0); PP_BAR();
        for (int ti = 0; ti < nt; ti += 2) {
            PP_SM(ti, 0); PP_STAGE(ti + 1, pfB); PP_BAR();
            PP_PVQK(ti, 0, ti, 1); PP_BAR();
            PP_SM(ti, 1); PP_BAR();
            PP_PVQK(ti, 1, ti + 1, 0); PP_BAR();
            PP_SM(ti + 1, 0); PP_STAGE(ti + 2, pfA); PP_BAR();
            PP_PVQK(ti + 1, 0, ti + 1, 1); PP_BAR();
            PP_SM(ti + 1, 1); PP_BAR();
            PP_PVQK(ti + 1, 1, ti + 2, 0); PP_BAR();
        }
    }
    __builtin_amdgcn_s_setprio(0);
#undef PP_MASKED
#undef PP_PART
#undef PP_QK
#undef PP_PVQK
#undef PP_SM
#undef PP_STAGE
#undef PP_BAR
}
template <int DV> __device__ __forceinline__ void store_ot(const f32x16 (&o)[DV / 32], bf16_t* orow, int hi) {
#pragma unroll
    for (int db = 0; db < DV / 32; ++db)
#pragma unroll
        for (int rg = 0; rg < 4; ++rg) { u32x2 w; w.x = cvtpk_a(o[db][4 * rg], o[db][4 * rg + 1]); w.y = cvtpk_a(o[db][4 * rg + 2], o[db][4 * rg + 3]);
            *(u32x2*)(orow + 32 * db + 8 * rg + 4 * hi) = w; }
}
}
#ifndef REP_PROLOG
#define REP_PROLOG 1
#endif
#ifndef RESID_BF16
#define RESID_BF16 1
#endif
#ifndef OUT_STAGGER_TICKS
#define OUT_STAGGER_TICKS 0
#endif
#ifndef OUT_STAGGER_GROUPS
#define OUT_STAGGER_GROUPS 2
#endif
#ifndef REP_OUT
#define REP_OUT 1
#endif
#ifndef REP_DOWN
#define REP_DOWN 1
#endif
#ifndef REP_INPROJ
#define REP_INPROJ 1
#endif
#ifndef REP_DIFF
#define REP_DIFF 1
#endif
#ifndef REP_SWA
#define REP_SWA 1
#endif
#ifndef REP_SB
#define REP_SB 1
#endif
#ifndef REP_UP
#define REP_UP 1
#endif
#ifndef REP_CONV
#define REP_CONV 1
#endif
#ifndef PH_DIFF
#define PH_DIFF 1
#endif
#ifndef PH_SWA
#define PH_SWA 1
#endif
#ifndef PH_SB
#define PH_SB 1
#endif
#ifndef PH_CONV
#define PH_CONV 1
#endif
#define LAS __attribute__((address_space(3)))
typedef unsigned short bf16;
typedef float f32x4 __attribute__((ext_vector_type(4)));
typedef unsigned v4u __attribute__((ext_vector_type(4)));
typedef unsigned v2u __attribute__((ext_vector_type(2)));
constexpr int NWAVES = 8;
constexpr int SEQ = 4096, NB = 16, MTOK = NB * SEQ, DM = 1024, DFF = 2816, DUP = 2 * DFF;
constexpr int EVEN_IN = 2304, ODD_IN = 3072;
constexpr size_t MiB = 1u << 20;
constexpr size_t WS_SSQ = 1 * MiB;
constexpr size_t WS_WINE = 8 * MiB, WS_WOUTE = 17 * MiB, WS_WINO = 21 * MiB, WS_WOUTO = 33 * MiB, WS_WUP = 37 * MiB, WS_WDN = 81 * MiB;
constexpr size_t WS_XB = 104 * MiB, WS_R = 232 * MiB;
constexpr size_t WS_PROJ = WS_R, WS_AO = WS_R + 384 * MiB, WS_U = WS_R, WS_G = WS_R + 352 * MiB;
constexpr int LDS_MISC = 152576, LDS_BYTES = 153600;
static_assert(att::L_QS + 8 * 3072 <= LDS_MISC, "LDS map");
constexpr int HALF_ROWS = MTOK / 2;

struct Args {
    const float* x; const float* rel_bias; const float* norm_mix; const float* norm_ffn; const float* norm_final;
    const float* w_in_even; const float* w_out_even; const float* sinks; const float* lam_q1; const float* lam_k1; const float* lam_q2; const float* lam_k2;
    const float* diff_norm; const float* w_in_odd; const float* w_out_odd; const float* ffn_up; const float* ffn_conv; const float* ffn_conv_b; const float* ffn_down;
    float* out; unsigned char* ws;
};

__device__ const unsigned char T5B[128] = {0, 1, 2, 3, 4, 5, 6, 7, 8, 9, 10, 11, 12, 13, 14, 15, 16, 16, 16, 17, 17, 18, 18, 18, 19, 19, 19, 20, 20, 20, 20, 21, 21, 21, 21, 22, 22, 22, 22, 22, 23, 23, 23, 23, 23, 23, 24, 24, 24, 24, 24, 24, 25, 25, 25, 25, 25, 25, 25, 26, 26, 26, 26, 26, 26, 26, 26, 27, 27, 27, 27, 27, 27, 27, 27, 27, 27, 28, 28, 28, 28, 28, 28, 28, 28, 28, 28, 29, 29, 29, 29, 29, 29, 29, 29, 29, 29, 29, 29, 30, 30, 30, 30, 30, 30, 30, 30, 30, 30, 30, 30, 30, 30, 31, 31, 31, 31, 31, 31, 31, 31, 31, 31, 31, 31, 31, 31, 31};

__device__ __forceinline__ float wave_sum(float v) {
#pragma unroll
    for (int o = 1; o < 64; o <<= 1) v += __shfl_xor(v, o);
    return v;
}
__device__ __forceinline__ unsigned f2bf(float f) { unsigned u = __builtin_bit_cast(unsigned, f); return (u + 0x7fffu + ((u >> 16) & 1u)) >> 16; }
__device__ __forceinline__ unsigned pk2(float lo, float hi) { return f2bf(lo) | (f2bf(hi) << 16); }

__device__ __forceinline__ void transpose_item(const float* W, int K, int N, bf16* WT, const float* gk, int a0, int a1, int b0, int b1, float cs, LAS float* scr, int item, int lane) {
    const int nblk = N / 32, kb = item / nblk, nb = item % nblk, k0 = 64 * kb, n0 = 32 * nb;
    const int nn = n0 + (lane & 31);
    const float csc = ((nn >= a0 && nn < a1) || (nn >= b0 && nn < b1)) ? cs : 1.0f;
    float tw[32];
#pragma unroll
    for (int i = 0; i < 32; ++i) tw[i] = __builtin_nontemporal_load(W + (size_t)(k0 + 2 * i + (lane >> 5)) * N + nn);
#pragma unroll
    for (int i = 0; i < 32; ++i) { const int kk = 2 * i + (lane >> 5); const float gv = gk ? gk[k0 + kk] : 1.0f; scr[kk * 33 + (lane & 31)] = tw[i] * (gv * csc); }
    asm volatile("s_waitcnt lgkmcnt(0)" ::: "memory");
    const int c = lane & 7;
#pragma unroll
    for (int j = 0; j < 4; ++j) { const int n = (lane >> 3) + 8 * j; const LAS float* s = scr + (8 * c) * 33 + n;
        v4u o; o.x = pk2(s[0 * 33], s[1 * 33]); o.y = pk2(s[2 * 33], s[3 * 33]); o.z = pk2(s[4 * 33], s[5 * 33]); o.w = pk2(s[6 * 33], s[7 * 33]);
        *(v4u*)(WT + (size_t)(n0 + n) * K + k0 + 8 * c) = o; }
    asm volatile("s_waitcnt lgkmcnt(0)" ::: "memory");
}

#define XB_TMO      128
#define XB_XCNT(j)  (256  + 64 * (j))
#define XB_XSUB(j)  (1280 + 64 * (j))
#define XB_XGEN(j)  (2304 + 64 * (j))
#define XB_TOP      3328
#define XB_TOPGEN   3392
#define XCD_BAR_WORDS 3456
#define XB_SPIN_CAP (1u << 18)

__device__ __forceinline__ unsigned xb_ld(unsigned* p)              { return __hip_atomic_load(p, __ATOMIC_RELAXED, __HIP_MEMORY_SCOPE_AGENT); }
__device__ __forceinline__ unsigned xb_add(unsigned* p, unsigned v) { return __hip_atomic_fetch_add(p, v, __ATOMIC_RELAXED, __HIP_MEMORY_SCOPE_AGENT); }
__device__ __forceinline__ unsigned xb_xcc_id() { return (unsigned)__builtin_amdgcn_s_getreg((3 << 11) | 20) & 0xFu; }
#define XB_SPIN(cond, bar) do { unsigned _sp = 0; while (cond) { __builtin_amdgcn_s_sleep(1); \
    if ((++_sp & 255u) == 0u) { if (xb_ld(&(bar)[XB_TMO])) break; if (_sp > XB_SPIN_CAP) { atomicAdd(&(bar)[XB_TMO], 1u); break; } } } } while (0)

struct XcdBarrier {
    unsigned* bar; unsigned x;
    volatile LAS unsigned* st;
};

__device__ __forceinline__ XcdBarrier xcd_barrier_post(unsigned* bar, volatile LAS unsigned* st) {
    XcdBarrier b; b.bar = bar; b.x = xb_xcc_id(); b.st = st;
    if (threadIdx.x == 0) (void)xb_add(&bar[XB_XCNT(b.x)], 1u);
    return b;
}
__device__ __forceinline__ void xcd_barrier_complete(unsigned* bar, unsigned x, unsigned& nloc, unsigned& nx) {
    const unsigned G = gridDim.x * gridDim.y * gridDim.z;
    unsigned sum, cnt, mine, sp = 0u;
    for (;;) {
        sum = 0u; cnt = 0u; mine = 0u;
#pragma unroll
        for (unsigned j = 0; j < 16; ++j) { const unsigned c = xb_ld(&bar[XB_XCNT(j)]); sum += c; cnt += (c > 0u) ? 1u : 0u; mine = (j == x) ? c : mine; }
        if (sum == G) break;
        __builtin_amdgcn_s_sleep(1);
        if ((++sp & 255u) == 0u) { if (xb_ld(&bar[XB_TMO])) break; if (sp > XB_SPIN_CAP) { atomicAdd(&bar[XB_TMO], 1u); break; } }
    }
    nloc = mine > 0u ? mine : 1u; nx = cnt > 0u ? cnt : 1u;
}

__device__ __forceinline__ void xcd_barrier(const XcdBarrier& b) {
    asm volatile("s_waitcnt vmcnt(0)" ::: "memory");
    __syncthreads();
    if (threadIdx.x == 0) {
        unsigned* bar = b.bar;
        __builtin_amdgcn_s_waitcnt(0);
        unsigned nloc = b.st[0], nx = b.st[1];
        if (nloc == 0u) { xcd_barrier_complete(bar, b.x, nloc, nx); b.st[0] = nloc; b.st[1] = nx; }
        const unsigned old = xb_add(&bar[XB_XSUB(b.x)], 1u);
        const unsigned gen = old / nloc;
        if (old + 1u == (gen + 1u) * nloc) {
            __builtin_amdgcn_fence(__ATOMIC_RELEASE, "agent");
            asm volatile("s_waitcnt vmcnt(0)" ::: "memory");
            const unsigned og = xb_add(&bar[XB_TOP], 1u);
            const unsigned tg = og / nx;
            if (og + 1u == (tg + 1u) * nx) xb_add(&bar[XB_TOPGEN], 1u);
            else XB_SPIN(xb_ld(&bar[XB_TOPGEN]) == tg, bar);
            __builtin_amdgcn_fence(__ATOMIC_ACQUIRE, "agent");
            xb_add(&bar[XB_XGEN(b.x)], 1u);
            asm volatile("s_waitcnt vmcnt(0)" ::: "memory");
        } else {
            XB_SPIN(xb_ld(&bar[XB_XGEN(b.x)]) == gen, bar);
            __builtin_amdgcn_fence(__ATOMIC_ACQUIRE, "agent");
            asm volatile("s_waitcnt vmcnt(0)" ::: "memory");
        }
    }
    __syncthreads();
}

__global__ void __launch_bounds__(NWAVES * 64, 2) mega_fwd(Args a) {
    extern __shared__ __attribute__((aligned(16))) unsigned char lds_raw[];
    cg::grid_group grid = cg::this_grid();
    LAS unsigned char* lds = (LAS unsigned char*)lds_raw;
    const int tid = threadIdx.x, lane = tid & 63, wave = __builtin_amdgcn_readfirstlane(tid >> 6);
    const int G = gridDim.x, bx = blockIdx.x;
    const int gw = bx * NWAVES + wave, NGW = G * NWAVES;
    const int vcu = (G % 8 == 0) ? (bx % 8) * (G / 8) + bx / 8 : bx;
    unsigned char* ws = a.ws;
    float* ssq = (float*)(ws + WS_SSQ);
    bf16* xb = (bf16*)(ws + WS_XB);
    bf16* proj = (bf16*)(ws + WS_PROJ);
    bf16* ao = (bf16*)(ws + WS_AO);
    bf16* ubuf = (bf16*)(ws + WS_U);
    bf16* gbuf = (bf16*)(ws + WS_G);

    if (bx == 0) for (int i = tid; i < XCD_BAR_WORDS; i += NWAVES * 64) ((unsigned*)ws)[i] = 0u;
    if (tid < 2) ((LAS unsigned*)(lds + LDS_MISC))[tid] = 0u;
    {
        LAS float* scr = (LAS float*)(lds + wave * 16384);
        constexpr int I_INE = 16 * (EVEN_IN / 32), I_OUT = 16 * 32, I_INO = 16 * (ODD_IN / 32), I_UP = 16 * (DUP / 32), I_DN = (DFF / 64) * 32;
        constexpr int NITEMS = 2 * I_INE + 2 * I_OUT + 2 * I_INO + 2 * I_OUT + 4 * I_UP + 4 * I_DN;
        for (int rep_ = 0; rep_ < REP_PROLOG; ++rep_)
        for (int it = gw; it < NITEMS; it += NGW) {
            int r = it;
            if (r < 2 * I_INE) { const int e = r / I_INE; r -= e * I_INE;
                transpose_item(a.w_in_even + (size_t)e * DM * EVEN_IN, DM, EVEN_IN, (bf16*)(ws + WS_WINE) + (size_t)e * EVEN_IN * DM, a.norm_mix + (2 * e) * DM, 0, 512, 768, 1280, att::QSCALE, scr, r, lane); continue; }
            r -= 2 * I_INE;
            if (r < 2 * I_OUT) { const int e = r / I_OUT; r -= e * I_OUT;
                transpose_item(a.w_out_even + (size_t)e * DM * DM, DM, DM, (bf16*)(ws + WS_WOUTE) + (size_t)e * DM * DM, nullptr, 0, 0, 0, 0, 1.f, scr, r, lane); continue; }
            r -= 2 * I_OUT;
            if (r < 2 * I_INO) { const int e = r / I_INO; r -= e * I_INO;
                transpose_item(a.w_in_odd + (size_t)e * DM * ODD_IN, DM, ODD_IN, (bf16*)(ws + WS_WINO) + (size_t)e * ODD_IN * DM, a.norm_mix + (2 * e + 1) * DM, 0, 1024, 0, 0, att::QSCALE, scr, r, lane); continue; }
            r -= 2 * I_INO;
            if (r < 2 * I_OUT) { const int e = r / I_OUT; r -= e * I_OUT;
                transpose_item(a.w_out_odd + (size_t)e * DM * DM, DM, DM, (bf16*)(ws + WS_WOUTO) + (size_t)e * DM * DM, nullptr, 0, 0, 0, 0, 1.f, scr, r, lane); continue; }
            r -= 2 * I_OUT;
            if (r < 4 * I_UP) { const int e = r / I_UP; r -= e * I_UP;
                transpose_item(a.ffn_up + (size_t)e * DM * DUP, DM, DUP, (bf16*)(ws + WS_WUP) + (size_t)e * DUP * DM, a.norm_ffn + e * DM, 0, 0, 0, 0, 1.f, scr, r, lane); continue; }
            r -= 4 * I_UP;
            { const int e = r / I_DN; r -= e * I_DN;
                transpose_item(a.ffn_down + (size_t)e * DFF * DM, DFF, DM, (bf16*)(ws + WS_WDN) + (size_t)e * DM * DFF, nullptr, 0, 0, 0, 0, 1.f, scr, r, lane); }
        }
        for (int m0 = 2 * gw; m0 < MTOK; m0 += 2 * NGW) {
            f32x4 v[2][4];
#pragma unroll
            for (int h2 = 0; h2 < 2; ++h2) { const f32x4* xr = (const f32x4*)(a.x + (size_t)(m0 + h2) * DM) + lane;
#pragma unroll
                for (int j = 0; j < 4; ++j) v[h2][j] = __builtin_nontemporal_load(xr + 64 * j); }
#pragma unroll
            for (int h2 = 0; h2 < 2; ++h2) { const int m = m0 + h2; float s = 0.f;
#pragma unroll
                for (int j = 0; j < 4; ++j) s += (v[h2][j][0] * v[h2][j][0] + v[h2][j][1] * v[h2][j][1]) + (v[h2][j][2] * v[h2][j][2] + v[h2][j][3] * v[h2][j][3]);
                s = wave_sum(s);
                v2u* o8 = (v2u*)(xb + (size_t)m * DM) + lane;
#pragma unroll
                for (int j = 0; j < 4; ++j) { v2u w; w.x = pk2(v[h2][j][0], v[h2][j][1]); w.y = pk2(v[h2][j][2], v[h2][j][3]); o8[64 * j] = w; }
                if (lane < 16) ssq[(size_t)m * 16 + lane] = (lane == 0) ? s : 0.f; }
        }
    }
    grid.sync();
    const XcdBarrier xbar = xcd_barrier_post((unsigned*)ws, (volatile LAS unsigned*)(lds + LDS_MISC));

    for (int layer = 0; layer < 4; ++layer) {
        const int e = layer >> 1; const bool even = (layer & 1) == 0;
        const float* xold = (layer == 0) ? a.x : a.out;
        {
            const int N = even ? EVEN_IN : ODD_IN;
            const bf16* wt = even ? (const bf16*)(ws + WS_WINE) + (size_t)e * EVEN_IN * DM : (const bf16*)(ws + WS_WINO) + (size_t)e * ODD_IN * DM;
            pg8::Gemm g{xb, wt, MTOK, N, DM}; pg8::StaticOrder S; S.init(MTOK, N, G, bx);
            pg8::EpiScaleBf16 E{proj, N, ssq};
            for (int rep_ = 0; rep_ < REP_INPROJ; ++rep_)
            pg8::gemm_phase<pg8::EpiScaleBf16, pg8::StaticOrder, true, true>(lds, g, S, E);
        }
        xcd_barrier(xbar);
        if (even) {
            int tq = threadIdx.x; asm volatile("" : "+v"(tq)); const int tid = tq, lane = tq & 63, l32 = lane & 31, hi = lane >> 5;
            float lam, one_m_li;
            { const float li = (layer == 0) ? 0.2f : 0.47071301839f;
              const float s1 = wave_sum(a.lam_q1[e * 64 + lane] * a.lam_k1[e * 64 + lane]), s2 = wave_sum(a.lam_q2[e * 64 + lane] * a.lam_k2[e * 64 + lane]);
              lam = __expf(s1) - __expf(s2) + li; lam = __builtin_bit_cast(float, __builtin_amdgcn_readfirstlane(__builtin_bit_cast(int, lam))); one_m_li = __builtin_bit_cast(float, __builtin_amdgcn_readfirstlane(__builtin_bit_cast(int, 1.0f - li))); }
            LAS float* btab = (LAS float*)(lds + att::L_BT);

#if PH_DIFF
            for (int rep_ = 0; rep_ < REP_DIFF; ++rep_)
            for (int uidx = vcu; uidx < 1024; uidx += G) {
                const int j = uidx >> 8, c = uidx & 255, bh = c >> 2, s = c & 3, b = bh >> 2, h = bh & 3;
                const int qb = (j == 0) ? s : (j == 1) ? 7 - s : (j == 2) ? 8 + s : 15 - s;
                { int tb = threadIdx.x; asm volatile("" : "+v"(tb)); const int dd = tb - 256;
                  btab[tb] = (dd < 0) ? -__builtin_inff() : a.rel_bias[T5B[dd < 127 ? dd : 127] * 12 + 8 + h] * att::LOG2E; }
                const bf16* base = proj + (size_t)b * SEQ * EVEN_IN;
                const int q0 = qb * 256, nt = 4 * qb + 4, t = q0 + 32 * wave + l32;
                att::f32x16 o2[4]; float m2, l2; LAS unsigned* o1s = (LAS unsigned*)(lds + att::L_O1 + wave * 8192) + lane;
                { float m1, l1;
                  att::attn_core_pp<1, 128>(base + 768 + h * 128, base + 1280 + h * 128, base + 1792 + h * 128, EVEN_IN, q0, 0, nt, lds, o2, m1, l1);
                  const float inv = __builtin_amdgcn_rcpf(l1 + __shfl_xor(l1, 32));
#pragma unroll
                  for (int db = 0; db < 4; ++db)
#pragma unroll
                      for (int k = 0; k < 8; ++k) o1s[(db * 8 + k) * 64] = att::cvtpk(o2[db][2 * k] * inv, o2[db][2 * k + 1] * inv); }
                att::attn_core_pp<1, 128>(base + 768 + h * 128 + 64, base + 1280 + h * 128 + 64, base + 1792 + h * 128, EVEN_IN, q0, 0, nt, lds, o2, m2, l2);
                { const float inv = lam * __builtin_amdgcn_rcpf(l2 + __shfl_xor(l2, 32)); float ss = 0.f;
#pragma unroll
                  for (int db = 0; db < 4; ++db)
#pragma unroll
                      for (int r = 0; r < 16; ++r) { const unsigned w = o1s[(db * 8 + (r >> 1)) * 64]; const float a1 = __uint_as_float((r & 1) ? (w & 0xffff0000u) : (w << 16));
                          const float v = a1 - inv * o2[db][r]; o2[db][r] = v; ss += v * v; }
                  ss += __shfl_xor(ss, 32);
                  const float rs = __builtin_amdgcn_rsqf(ss * (1.0f / 128.0f) + 1e-6f) * one_m_li;
                  const float* gn = a.diff_norm + e * 128;
#pragma unroll
                  for (int db = 0; db < 4; ++db)
#pragma unroll
                      for (int rg = 0; rg < 4; ++rg) { const f32x4 gv = *(const f32x4*)(gn + 32 * db + 8 * rg + 4 * hi);
#pragma unroll
                          for (int k = 0; k < 4; ++k) o2[db][4 * rg + k] *= rs * gv[k]; } }
                { int tb = threadIdx.x; asm volatile("" : "+v"(tb)); const int t2 = q0 + 32 * (tb >> 6) + (tb & 31);
                  att::store_ot<128>(o2, ao + ((size_t)b * SEQ + t2) * DM + 512 + h * 128, (tb >> 5) & 1); }
            }
#endif
#if PH_SWA
            for (int rep_ = 0; rep_ < REP_SWA; ++rep_)
            for (int uidx = vcu; uidx < 2048; uidx += G) {
                const int qb = uidx & 15, qh = (uidx >> 4) & 7, b = uidx >> 7, kvh = qh >> 2;
                { int tb = threadIdx.x; asm volatile("" : "+v"(tb)); const int dd = tb - 256;
                  btab[tb] = (dd < 0 || dd >= 128) ? -__builtin_inff() : a.rel_bias[T5B[dd] * 12 + qh] * att::LOG2E; }
                const bf16* base = proj + (size_t)b * SEQ * EVEN_IN;
                const int q0 = qb * 256, t = q0 + 32 * wave + l32;
                const int kt0 = (qb * 4 - 2 > 0) ? qb * 4 - 2 : 0, nt = qb * 4 + 4 - kt0;
                att::f32x16 o[2]; float m, l;
                att::attn_core_pp<2, 64>(base + qh * 64, base + 512 + kvh * 64, base + 640 + kvh * 64, EVEN_IN, q0, kt0, nt, lds, o, m, l);
                const float sk = a.sinks[e * 8 + qh] * att::LOG2E;
                const float inv = __builtin_amdgcn_rcpf(l + __shfl_xor(l, 32) + __builtin_amdgcn_exp2f(sk - m));
#pragma unroll
                for (int db = 0; db < 2; ++db)
#pragma unroll
                    for (int r = 0; r < 16; ++r) o[db][r] *= inv;
                att::store_ot<64>(o, ao + ((size_t)b * SEQ + t) * DM + qh * 64, hi);
            }
#endif
        } else {
#if PH_SB
            int tq = threadIdx.x; asm volatile("" : "+v"(tq)); const int lane = tq & 63, l32 = lane & 31, hi = lane >> 5;
            for (int rep_ = 0; rep_ < REP_SB; ++rep_)
            for (int uidx = bx; uidx < 4096; uidx += G) {
                const int bh = uidx & 255, qb = 15 - (uidx >> 8), b = bh >> 4, h = bh & 15;
                const bf16* base = proj + (size_t)b * SEQ * ODD_IN;
                const int q0 = qb * 256, nt = 4 * qb + 4, t = q0 + 32 * wave + l32;
                att::f32x16 o[2]; float P, dummy;
                att::attn_core<0, 64>(base + h * 64, base + 1024 + h * 64, base + 2048 + h * 64, ODD_IN, q0, nt - 1, nt, -1, lds, o, P, dummy);
                att::store_ot<64>(o, ao + ((size_t)b * SEQ + t) * DM + h * 64, hi);
            }
#endif
        }
        xcd_barrier(xbar);
        {
            const bf16* wt = even ? (const bf16*)(ws + WS_WOUTE) + (size_t)e * DM * DM : (const bf16*)(ws + WS_WOUTO) + (size_t)e * DM * DM;
            pg8::Gemm g{ao, wt, MTOK, DM, DM}; pg8::StaticOrder S; S.init(MTOK, DM, G, bx);
#if OUT_STAGGER_TICKS > 0
            { const unsigned long long t0 = __builtin_amdgcn_s_memrealtime(); const unsigned long long dly = (unsigned long long)(((bx >> 3) & (OUT_STAGGER_GROUPS - 1)) * OUT_STAGGER_TICKS);
              while (__builtin_amdgcn_s_memrealtime() - t0 < dly) __builtin_amdgcn_s_sleep(8); }
#endif
#if REP_OUT == 2
            { pg8::EpiResid Ed{xold, (float*)(ws + WS_PROJ), (bf16*)(ws + WS_PROJ + 256 * MiB), (float*)(ws + 800 * MiB)};
              pg8::gemm_phase<pg8::EpiResid, pg8::StaticOrder, true, true>(lds, g, S, Ed); }
#elif REP_OUT == 3
            { pg8::EpiScaleBf16 Ed{(bf16*)(ws + WS_PROJ), DM, ssq};
              pg8::gemm_phase<pg8::EpiScaleBf16, pg8::StaticOrder, true, true>(lds, g, S, Ed); }
#endif
#if RESID_BF16
            pg8::EpiResidB E{xb, xb, ssq};
            pg8::gemm_phase<pg8::EpiResidB, pg8::StaticOrder, true, true>(lds, g, S, E);
#else
            pg8::EpiResid E{xold, a.out, xb, ssq};
            pg8::gemm_phase<pg8::EpiResid, pg8::StaticOrder, true, true>(lds, g, S, E);
#endif
        }
        xcd_barrier(xbar);
        const bf16* wup = (const bf16*)(ws + WS_WUP) + (size_t)layer * DUP * DM;
        const bf16* wdn = (const bf16*)(ws + WS_WDN) + (size_t)layer * DM * DFF;
        for (int half = 0; half < 2; ++half) {
            const size_t r0 = (size_t)half * HALF_ROWS;
            {
                pg8::Gemm g{xb + r0 * DM, wup, HALF_ROWS, DUP, DM}; pg8::StaticOrder S; S.init(HALF_ROWS, DUP, G, bx);
                pg8::EpiScaleBf16 E{ubuf, DUP, ssq + r0 * 16};
                for (int rep_ = 0; rep_ < REP_UP; ++rep_)
                pg8::gemm_phase<pg8::EpiScaleBf16, pg8::StaticOrder, true, true>(lds, g, S, E);
            }
            xcd_barrier(xbar);
#if PH_CONV
            {
                const float* cw = a.ffn_conv + (size_t)layer * 3 * DUP; const float* cb = a.ffn_conv_b + (size_t)layer * DUP;
                constexpr int NCC = 6, NRC = HALF_ROWS / 32;
                int tq = threadIdx.x; asm volatile("" : "+v"(tq)); const int lane = tq & 63;
                for (int rep_ = 0; rep_ < REP_CONV; ++rep_)
                for (int it = gw; it < NCC * NRC; it += NGW) {
                    const int cc = it % NCC, rc = it / NCC, cgp = cc * 64 + lane;
                    if (cgp < DFF / 8) {
                        const int col = cgp * 8, row0 = rc * 32;
                        float wg[3][8], wv[3][8], bg[8], bv[8];
#pragma unroll
                        for (int tp = 0; tp < 3; ++tp)
#pragma unroll
                            for (int k = 0; k < 8; k += 4) { const f32x4 t1 = *(const f32x4*)(cw + tp * DUP + col + k), t2 = *(const f32x4*)(cw + tp * DUP + DFF + col + k);
#pragma unroll
                                for (int q = 0; q < 4; ++q) { wg[tp][k + q] = t1[q]; wv[tp][k + q] = t2[q]; } }
#pragma unroll
                        for (int k = 0; k < 8; k += 4) { const f32x4 t1 = *(const f32x4*)(cb + col + k), t2 = *(const f32x4*)(cb + DFF + col + k);
#pragma unroll
                            for (int q = 0; q < 4; ++q) { bg[k + q] = t1[q]; bv[k + q] = t2[q]; } }
                        float g2[8], g1[8], v2[8], v1[8];
                        const bool head = (row0 % SEQ) == 0;
                        {
                            v4u a2 = {0, 0, 0, 0}, a1 = {0, 0, 0, 0}, c2 = {0, 0, 0, 0}, c1 = {0, 0, 0, 0};
                            if (!head) { const bf16* up = ubuf + (size_t)(row0 - 2) * DUP + col; a2 = *(const v4u*)up; c2 = *(const v4u*)(up + DFF); a1 = *(const v4u*)(up + DUP); c1 = *(const v4u*)(up + DUP + DFF); }
#pragma unroll
                            for (int k = 0; k < 8; ++k) { const int sh = (k & 1) * 16;
                                g2[k] = __uint_as_float(((a2[k >> 1] >> sh) & 0xffffu) << 16); g1[k] = __uint_as_float(((a1[k >> 1] >> sh) & 0xffffu) << 16);
                                v2[k] = __uint_as_float(((c2[k >> 1] >> sh) & 0xffffu) << 16); v1[k] = __uint_as_float(((c1[k >> 1] >> sh) & 0xffffu) << 16); }
                        }
                        for (int r4 = 0; r4 < 32; r4 += 8) {
                            v4u av[8], cv[8];
#pragma unroll
                            for (int rr = 0; rr < 8; ++rr) { const bf16* up = ubuf + (size_t)(row0 + r4 + rr) * DUP + col;
                                av[rr] = __builtin_nontemporal_load((const v4u*)up); cv[rr] = __builtin_nontemporal_load((const v4u*)(up + DFF)); }
#pragma unroll
                            for (int rr = 0; rr < 8; ++rr) {
                                const v4u a0 = av[rr], c0 = cv[rr];
                                float res[8];
#pragma unroll
                                for (int k = 0; k < 8; ++k) { const int sh = (k & 1) * 16;
                                    const float g0 = __uint_as_float(((a0[k >> 1] >> sh) & 0xffffu) << 16), v0 = __uint_as_float(((c0[k >> 1] >> sh) & 0xffffu) << 16);
                                    const float gg = bg[k] + wg[0][k] * g2[k] + wg[1][k] * g1[k] + wg[2][k] * g0;
                                    const float vv = bv[k] + wv[0][k] * v2[k] + wv[1][k] * v1[k] + wv[2][k] * v0;
                                    const float sg = gg * __builtin_amdgcn_rcpf(1.0f + __builtin_amdgcn_exp2f(-gg * att::LOG2E));
                                    res[k] = sg * vv; g2[k] = g1[k]; g1[k] = g0; v2[k] = v1[k]; v1[k] = v0; }
                                v4u w; w.x = pk2(res[0], res[1]); w.y = pk2(res[2], res[3]); w.z = pk2(res[4], res[5]); w.w = pk2(res[6], res[7]);
                                *(v4u*)(gbuf + (size_t)(row0 + r4 + rr) * DFF + col) = w;
                            }
                        }
                    }
                }
            }
#endif
            xcd_barrier(xbar);
            {
                pg8::Gemm g{gbuf, wdn, HALF_ROWS, DM, DFF}; pg8::StaticOrder S; S.init(HALF_ROWS, DM, G, bx);
#if REP_DOWN > 1
                { pg8::EpiResid Ed{a.out + r0 * DM, (float*)(ws + 760 * MiB), (bf16*)(ws + 888 * MiB), (float*)(ws + 960 * MiB)};
                  pg8::gemm_phase<pg8::EpiResid, pg8::StaticOrder, true, true>(lds, g, S, Ed); }
#endif
#if RESID_BF16
                pg8::EpiResidB E{xb + r0 * DM, xb + r0 * DM, ssq + r0 * 16};
                pg8::gemm_phase<pg8::EpiResidB, pg8::StaticOrder, true, true>(lds, g, S, E);
#else
                pg8::EpiResid E{a.out + r0 * DM, a.out + r0 * DM, xb + r0 * DM, ssq + r0 * 16};
                pg8::gemm_phase<pg8::EpiResid, pg8::StaticOrder, true, true>(lds, g, S, E);
#endif
            }
            if (half == 1) xcd_barrier(xbar);
        }
    }
    { int tq = threadIdx.x; asm volatile("" : "+v"(tq)); const int lane = tq & 63;
    for (int m = gw; m < MTOK; m += NGW) {
        f32x4* xr = (f32x4*)(a.out + (size_t)m * DM) + lane; f32x4 v[4]; float s = 0.f;
#if RESID_BF16
        const v2u* xin = (const v2u*)(xb + (size_t)m * DM) + lane;
#pragma unroll
        for (int j = 0; j < 4; ++j) { const v2u w = xin[64 * j]; v[j][0] = __uint_as_float(w.x << 16); v[j][1] = __uint_as_float(w.x & 0xffff0000u); v[j][2] = __uint_as_float(w.y << 16); v[j][3] = __uint_as_float(w.y & 0xffff0000u);
            s += (v[j][0] * v[j][0] + v[j][1] * v[j][1]) + (v[j][2] * v[j][2] + v[j][3] * v[j][3]); }
#else
#pragma unroll
        for (int j = 0; j < 4; ++j) { v[j] = xr[64 * j]; s += (v[j][0] * v[j][0] + v[j][1] * v[j][1]) + (v[j][2] * v[j][2] + v[j][3] * v[j][3]); }
#endif
        s = wave_sum(s);
        const float rs = __builtin_amdgcn_rsqf(s * (1.0f / DM) + 1e-6f);
#pragma unroll
        for (int j = 0; j < 4; ++j) { const f32x4 gv = *((const f32x4*)a.norm_final + lane + 64 * j); xr[64 * j] = v[j] * rs * gv; }
    } }
}

extern "C" void kernel_launch(void* const* d_in, const int* in_sizes, int n_in, void* d_out, int out_size, void* d_ws, size_t ws_size, hipStream_t stream) {
    static int grid = 0;
    if (grid == 0) {
        int dev = 0, cus = 0, per_cu = 0;
        (void)hipGetDevice(&dev);
        (void)hipDeviceGetAttribute(&cus, hipDeviceAttributeMultiprocessorCount, dev);
        (void)hipFuncSetAttribute((const void*)mega_fwd, hipFuncAttributeMaxDynamicSharedMemorySize, LDS_BYTES);
        (void)hipOccupancyMaxActiveBlocksPerMultiprocessor(&per_cu, (const void*)mega_fwd, NWAVES * 64, LDS_BYTES);
        if (per_cu < 1) per_cu = 1;
        grid = cus * per_cu;
        if (n_in != 19 || ws_size < 1024 * MiB) fprintf(stderr, "kernel_launch: unexpected n_in %d / ws %zu\n", n_in, ws_size);
    }
    Args a{};
    a.x = (const float*)d_in[0]; a.rel_bias = (const float*)d_in[1]; a.norm_mix = (const float*)d_in[2]; a.norm_ffn = (const float*)d_in[3]; a.norm_final = (const float*)d_in[4];
    a.w_in_even = (const float*)d_in[5]; a.w_out_even = (const float*)d_in[6]; a.sinks = (const float*)d_in[7]; a.lam_q1 = (const float*)d_in[8]; a.lam_k1 = (const float*)d_in[9];
    a.lam_q2 = (const float*)d_in[10]; a.lam_k2 = (const float*)d_in[11]; a.diff_norm = (const float*)d_in[12]; a.w_in_odd = (const float*)d_in[13]; a.w_out_odd = (const float*)d_in[14];
    a.ffn_up = (const float*)d_in[15]; a.ffn_conv = (const float*)d_in[16]; a.ffn_conv_b = (const float*)d_in[17]; a.ffn_down = (const float*)d_in[18];
    a.out = (float*)d_out; a.ws = (unsigned char*)d_ws;
    void* args[] = {&a};
    hipError_t err = hipLaunchCooperativeKernel((const void*)mega_fwd, dim3(grid), dim3(NWAVES * 64), args, LDS_BYTES, stream);
    if (err != hipSuccess) fprintf(stderr, "kernel_launch: cooperative launch failed: %s (grid %d)\n", hipGetErrorString(err), grid);
}
```

```cpp
#include <hip/hip_runtime.h>
#include <hip/hip_cooperative_groups.h>
#include <cstdio>
#include <cstdint>
namespace cg = cooperative_groups;
namespace pg8 {
#define PG8_LAS __attribute__((address_space(3)))
typedef unsigned short bf16_t;
typedef short bf16x8 __attribute__((ext_vector_type(8)));
typedef float f32x4 __attribute__((ext_vector_type(4)));
typedef unsigned u32x4 __attribute__((ext_vector_type(4)));
constexpr int BM = 256, BK = 64, HALF = 128, HTB = HALF * BK * 2  , STAGE_BYTES = 8 * HTB, NXCD = 8, WGM = 8;

__host__ __device__ __forceinline__ int lds_byte(int r, int c) { const int st = (r >> 4) * 2 + (c >> 5), rr = r & 15, cc = c & 31, ob = rr * 64 + cc * 2; return st * 1024 + (ob ^ (((ob >> 9) & 1) << 5)); }
__host__ __device__ __forceinline__ void stage_rc(int b, int& R, int& C) { const int st = b / 1024, sb = b % 1024, swz = sb ^ (((sb >> 9) & 1) << 5); R = (st >> 1) * 16 + swz / 64; C = (st & 1) * 32 + (swz % 64) / 2; }
__host__ __device__ __forceinline__ int perm32(int rho) { const int n = rho >> 4, i = rho & 15; return 8 * (i >> 2) + 4 * n + (i & 3); }

struct Unit { int pm, pn; };
struct Gemm { const bf16_t* A; const bf16_t* Bt; int M, N, K; };

struct StaticOrder {
    int nM, nN, nwg, G, c;
    __host__ __device__ void init(int M, int N, int G_, int c_) { nM = M / BM; nN = N / BM; nwg = nM * nN; G = G_; c = c_; }
    __host__ __device__ bool next(int i, Unit& u) const {
        const long L = (long)i * G + c; if (L >= nwg) return false;
        int wgid = (int)L; { const int q = nwg / NXCD, r = nwg % NXCD, xcd = wgid % NXCD, off = wgid / NXCD; wgid = (xcd < r ? xcd * (q + 1) : r * (q + 1) + (xcd - r) * q) + off; }
        const int nig = WGM * nN, gid = wgid / nig, fm = gid * WGM, gsz = (nM - fm) < WGM ? (nM - fm) : WGM;
        u.pm = fm + ((wgid % nig) % gsz); u.pn = (wgid % nig) / gsz; return true;
    }
    __device__ __forceinline__ void a_ready(const Unit&) const {}
    __device__ __forceinline__ void done(const Unit&) const {}
};

__device__ __forceinline__ unsigned cvt_pk_bf16(float lo, float hi) { unsigned r; asm volatile("v_cvt_pk_bf16_f32 %0, %1, %2" : "=v"(r) : "v"(lo), "v"(hi)); return r; }
typedef float f32x2 __attribute__((ext_vector_type(2)));
typedef unsigned u32x2 __attribute__((ext_vector_type(2)));
constexpr float RMS_EPS = 1e-6f;
struct EpiScaleBf16 {
    static constexpr bool PERM = true, AFTER_DRAIN = false;
    bf16_t* O; int ldc; const float* ssq;
    __device__ __forceinline__ void operator()(const f32x4 (&acc)[2][2][4][2], const Unit& u, int wr, int wc, int fr, int fq) const {
        const int row0 = u.pm * BM + wr * 64 + fr, col0 = u.pn * BM + wc * 32 + 8 * fq;
        f32x4 part[2][4];
#pragma unroll
        for (int ai = 0; ai < 2; ++ai)
#pragma unroll
            for (int m = 0; m < 4; ++m) part[ai][m] = *(const f32x4*)(ssq + (size_t)(row0 + ai * HALF + m * 16) * 16 + fq * 4);
#pragma unroll
        for (int ai = 0; ai < 2; ++ai)
#pragma unroll
            for (int m = 0; m < 4; ++m) { const int row = row0 + ai * HALF + m * 16; bf16_t* rowp = O + (size_t)row * ldc + col0;
                float t = (part[ai][m][0] + part[ai][m][1]) + (part[ai][m][2] + part[ai][m][3]);
                t += __shfl_xor(t, 16); t += __shfl_xor(t, 32);
                const float rs = __builtin_amdgcn_rsqf(t * (1.0f / 1024.0f) + RMS_EPS);
#pragma unroll
                for (int bj = 0; bj < 2; ++bj) { const f32x4 v0 = acc[ai][bj][m][0] * rs, v1 = acc[ai][bj][m][1] * rs;
                    u32x4 w; w.x = cvt_pk_bf16(v0[0], v0[1]); w.y = cvt_pk_bf16(v0[2], v0[3]); w.z = cvt_pk_bf16(v1[0], v1[1]); w.w = cvt_pk_bf16(v1[2], v1[3]);
                    *(u32x4*)(rowp + bj * HALF) = w; } }
    }
};
struct EpiResid {
    static constexpr bool PERM = true, AFTER_DRAIN = false;
    const float* base; float* out; bf16_t* xb; float* ssq;
    __device__ __forceinline__ void operator()(const f32x4 (&acc)[2][2][4][2], const Unit& u, int wr, int wc, int fr, int fq) const {
        const int col0 = u.pn * BM + wc * 32 + 8 * fq;
        const size_t off0 = (size_t)(u.pm * BM + wr * 64 + fr) * 1024 + col0;
        f32x4 nx[2][2][2];
#pragma unroll
        for (int g = 0; g < 2; ++g) { const size_t offn = off0 + (size_t)(g * 16) * 1024;
#pragma unroll
            for (int bj = 0; bj < 2; ++bj)
#pragma unroll
                for (int n = 0; n < 2; ++n) nx[g][bj][n] = *(const f32x4*)(base + offn + bj * HALF + n * 4); }
        asm volatile("" ::: "memory");
#pragma unroll
        for (int g = 0; g < 8; ++g) { const int ai = g >> 2, m = g & 3; const int row = u.pm * BM + ai * HALF + wr * 64 + m * 16 + fr; const size_t off = (size_t)row * 1024 + col0; float q = 0.f;
            f32x4 cu[2][2];
#pragma unroll
            for (int bj = 0; bj < 2; ++bj)
#pragma unroll
                for (int n = 0; n < 2; ++n) cu[bj][n] = nx[g & 1][bj][n];
            if (g < 6) { const size_t offn = off0 + (size_t)(((g + 2) >> 2) * HALF + ((g + 2) & 3) * 16) * 1024;
#pragma unroll
                for (int bj = 0; bj < 2; ++bj)
#pragma unroll
                    for (int n = 0; n < 2; ++n) nx[g & 1][bj][n] = *(const f32x4*)(base + offn + bj * HALF + n * 4); }
#pragma unroll
            for (int bj = 0; bj < 2; ++bj) { const f32x4 o0 = cu[bj][0] + acc[ai][bj][m][0], o1 = cu[bj][1] + acc[ai][bj][m][1];
                *(f32x4*)(out + off + bj * HALF) = o0; *(f32x4*)(out + off + bj * HALF + 4) = o1;
                q += ((o0[0] * o0[0] + o0[1] * o0[1]) + (o0[2] * o0[2] + o0[3] * o0[3])) + ((o1[0] * o1[0] + o1[1] * o1[1]) + (o1[2] * o1[2] + o1[3] * o1[3]));
                u32x4 w; w.x = cvt_pk_bf16(o0[0], o0[1]); w.y = cvt_pk_bf16(o0[2], o0[3]); w.z = cvt_pk_bf16(o1[0], o1[1]); w.w = cvt_pk_bf16(o1[2], o1[3]);
                *(u32x4*)(xb + off + bj * HALF) = w; }
            q += __shfl_xor(q, 16); q += __shfl_xor(q, 32);
            if (fq == 0) ssq[(size_t)row * 16 + u.pn * 4 + wc] = q;
            asm volatile("" ::: "memory"); }
    }
};

struct EpiResidB {
    static constexpr bool PERM = true, AFTER_DRAIN = false;
    const bf16_t* base; bf16_t* xb; float* ssq;
    __device__ __forceinline__ void operator()(const f32x4 (&acc)[2][2][4][2], const Unit& u, int wr, int wc, int fr, int fq) const {
        const int col0 = u.pn * BM + wc * 32 + 8 * fq;
        const size_t off0 = (size_t)(u.pm * BM + wr * 64 + fr) * 1024 + col0;
        u32x4 nx[2][2];
#pragma unroll
        for (int g = 0; g < 2; ++g)
#pragma unroll
            for (int bj = 0; bj < 2; ++bj) nx[g][bj] = *(const u32x4*)(base + off0 + (size_t)(g * 16) * 1024 + bj * HALF);
        asm volatile("" ::: "memory");
#pragma unroll
        for (int g = 0; g < 8; ++g) { const int ai = g >> 2, m = g & 3; const int row = u.pm * BM + ai * HALF + wr * 64 + m * 16 + fr; const size_t off = (size_t)row * 1024 + col0; float q = 0.f;
            u32x4 cu[2];
#pragma unroll
            for (int bj = 0; bj < 2; ++bj) cu[bj] = nx[g & 1][bj];
            if (g < 6) { const size_t offn = off0 + (size_t)(((g + 2) >> 2) * HALF + ((g + 2) & 3) * 16) * 1024;
#pragma unroll
                for (int bj = 0; bj < 2; ++bj) nx[g & 1][bj] = *(const u32x4*)(base + offn + bj * HALF); }
#pragma unroll
            for (int bj = 0; bj < 2; ++bj) {
                f32x4 o0, o1;
                o0[0] = __uint_as_float(cu[bj].x << 16) + acc[ai][bj][m][0][0]; o0[1] = __uint_as_float(cu[bj].x & 0xffff0000u) + acc[ai][bj][m][0][1];
                o0[2] = __uint_as_float(cu[bj].y << 16) + acc[ai][bj][m][0][2]; o0[3] = __uint_as_float(cu[bj].y & 0xffff0000u) + acc[ai][bj][m][0][3];
                o1[0] = __uint_as_float(cu[bj].z << 16) + acc[ai][bj][m][1][0]; o1[1] = __uint_as_float(cu[bj].z & 0xffff0000u) + acc[ai][bj][m][1][1];
                o1[2] = __uint_as_float(cu[bj].w << 16) + acc[ai][bj][m][1][2]; o1[3] = __uint_as_float(cu[bj].w & 0xffff0000u) + acc[ai][bj][m][1][3];
                q += ((o0[0] * o0[0] + o0[1] * o0[1]) + (o0[2] * o0[2] + o0[3] * o0[3])) + ((o1[0] * o1[0] + o1[1] * o1[1]) + (o1[2] * o1[2] + o1[3] * o1[3]));
                u32x4 w; w.x = cvt_pk_bf16(o0[0], o0[1]); w.y = cvt_pk_bf16(o0[2], o0[3]); w.z = cvt_pk_bf16(o1[0], o1[1]); w.w = cvt_pk_bf16(o1[2], o1[3]);
                *(u32x4*)(xb + off + bj * HALF) = w; }
            q += __shfl_xor(q, 16); q += __shfl_xor(q, 32);
            if (fq == 0) ssq[(size_t)row * 16 + u.pn * 4 + wc] = q;
            asm volatile("" ::: "memory"); }
    }
};
template <class Epi, class Sched, bool ALIGN_EPI = false, bool SP2 = false>
__device__ __forceinline__ void gemm_phase(PG8_LAS unsigned char* lds, const Gemm g, const Sched& S, const Epi& E) {
    int tid_ = threadIdx.x; asm volatile("" : "+v"(tid_));
    const int tid = tid_, wid = __builtin_amdgcn_readfirstlane(tid >> 6), lane = tid & 63, wr = wid >> 2, wc = wid & 3, fr = lane & 15, fq = lane >> 4;
    const int K = g.K, nt = K / BK;
    unsigned voffA[2], voffB[2];
#pragma unroll
    for (int i = 0; i < 2; ++i) { int R, C; stage_rc(tid * 16 + i * 8192, R, C); const int Rb = Epi::PERM ? ((R & ~31) + perm32(R & 31)) : R;
        voffA[i] = (unsigned)(R * K + C) * 2u; voffB[i] = (unsigned)(Rb * K + C) * 2u; }
    const size_t kstep = (size_t)(BK * 2);
    const size_t hstep = (size_t)HALF * K * 2;
    const size_t tstep = 2 * hstep;
    const unsigned ldsw = (unsigned)wid * 1024u;
    const int aoff = lds_byte(wr * 64 + fr, fq * 8), boff = lds_byte(wc * 32 + fr, fq * 8);
#define PG8_SA(b, h) (((b) * 2 + (h)) * HTB)
#define PG8_SB(b, h) ((4 + (b) * 2 + (h)) * HTB)
#define PG8_STAGE(bufoff, gbase, voff) do { _Pragma("unroll") for (int _i = 0; _i < 2; ++_i) \
        __builtin_amdgcn_global_load_lds((const unsigned*)((const char*)(gbase) + (voff)[_i]), (PG8_LAS unsigned*)(lds + (bufoff) + ldsw + _i * 8192), 16, 0, 0); } while (0)
#define PG8_LDA(dst, b, h) do { _Pragma("unroll") for (int m = 0; m < 4; ++m) _Pragma("unroll") for (int k = 0; k < 2; ++k) dst[m][k] = *(const PG8_LAS bf16x8*)(lds + PG8_SA(b, h) + aoff + m * 2048 + k * 1024); } while (0)
#define PG8_LDB(dst, b, h) do { _Pragma("unroll") for (int n = 0; n < 2; ++n) _Pragma("unroll") for (int k = 0; k < 2; ++k) dst[n][k] = *(const PG8_LAS bf16x8*)(lds + PG8_SB(b, h) + boff + n * 2048 + k * 1024); } while (0)
#define PG8_MMA(ai, bj, At, Bt) do { __builtin_amdgcn_s_setprio(1); _Pragma("unroll") for (int m = 0; m < 4; ++m) _Pragma("unroll") for (int n = 0; n < 2; ++n) _Pragma("unroll") for (int k = 0; k < 2; ++k) \
        acc[ai][bj][m][n] = __builtin_amdgcn_mfma_f32_16x16x32_bf16(Bt[n][k], At[m][k], acc[ai][bj][m][n], 0, 0, 0); __builtin_amdgcn_s_setprio(0); } while (0)
#define PG8_WAIT_V(n) asm volatile("s_waitcnt vmcnt(" #n ")" ::: "memory")
#define PG8_WAIT_L(n) asm volatile("s_waitcnt lgkmcnt(" #n ")" ::: "memory")
#define PG8_BAR __builtin_amdgcn_s_barrier()
#define PG8_SCHED __builtin_amdgcn_sched_barrier(0)
    Unit cur, nxt; int ui = 0;
    if (!S.next(0, cur)) return;
    f32x4 acc[2][2][4][2];
#pragma unroll
    for (int a = 0; a < 2; ++a)
#pragma unroll
        for (int b = 0; b < 2; ++b)
#pragma unroll
            for (int m = 0; m < 4; ++m)
#pragma unroll
                for (int n = 0; n < 2; ++n) acc[a][b][m][n] = (f32x4){0.f, 0.f, 0.f, 0.f};
    bf16x8 At[4][2], B0[2][2], B1[2][2];
    const char* cA = (const char*)g.A + (size_t)cur.pm * tstep; const char* cB = (const char*)g.Bt + (size_t)cur.pn * tstep;
    S.a_ready(cur);
    if constexpr (SP2) {
        PG8_STAGE(PG8_SB(0, 0), cB, voffB); PG8_STAGE(PG8_SB(0, 1), cB + hstep, voffB); PG8_STAGE(PG8_SA(0, 0), cA, voffA); PG8_STAGE(PG8_SA(0, 1), cA + hstep, voffA);
        if (wr == 1) PG8_BAR;
        PG8_WAIT_V(2); PG8_BAR;
        PG8_STAGE(PG8_SB(1, 0), cB + kstep, voffB); PG8_STAGE(PG8_SA(1, 0), cA + kstep, voffA); PG8_STAGE(PG8_SB(1, 1), cB + hstep + kstep, voffB);
        PG8_WAIT_V(6); PG8_BAR;
    } else {
        PG8_STAGE(PG8_SB(0, 0), cB, voffB); PG8_STAGE(PG8_SA(0, 0), cA, voffA); PG8_STAGE(PG8_SB(0, 1), cB + hstep, voffB); PG8_STAGE(PG8_SA(0, 1), cA + hstep, voffA);
        if (wr == 1) PG8_BAR;
        PG8_WAIT_V(4); PG8_BAR;
        PG8_STAGE(PG8_SB(1, 0), cB + kstep, voffB); PG8_STAGE(PG8_SA(1, 0), cA + kstep, voffA); PG8_STAGE(PG8_SB(1, 1), cB + hstep + kstep, voffB);
        PG8_WAIT_V(6); PG8_BAR;
    }
    for (;;) {
        const bool has_next = S.next(ui + 1, nxt);
        const char* nA = has_next ? (const char*)g.A + (size_t)nxt.pm * tstep : cA; const char* nB = has_next ? (const char*)g.Bt + (size_t)nxt.pn * tstep : cB;
        for (int t = 0; t < nt; t += 2) {
            const bool last = (t == nt - 2);
            const char* a1 = cA + (size_t)(t + 1) * kstep;
            const char* a2 = last ? nA : cA + (size_t)(t + 2) * kstep; const char* b2 = last ? nB : cB + (size_t)(t + 2) * kstep;
            const char* a3 = a2 + kstep; const char* b3 = b2 + kstep;
            if (last && has_next) S.a_ready(nxt);
            if constexpr (SP2) {
            PG8_LDB(B0, 0, 0); PG8_LDB(B1, 0, 1); PG8_SCHED; PG8_LDA(At, 0, 0); PG8_STAGE(PG8_SA(1, 1), a1 + hstep, voffA);
            PG8_WAIT_V(8); PG8_WAIT_L(0); PG8_BAR; PG8_MMA(0, 0, At, B0); PG8_MMA(0, 1, At, B1); PG8_BAR; PG8_SCHED;
            PG8_LDA(At, 0, 1); PG8_STAGE(PG8_SB(0, 0), b2, voffB); PG8_STAGE(PG8_SB(0, 1), b2 + hstep, voffB); PG8_STAGE(PG8_SA(0, 0), a2, voffA);
            PG8_WAIT_V(8); PG8_WAIT_L(0); PG8_BAR; PG8_MMA(1, 0, At, B0); PG8_MMA(1, 1, At, B1); PG8_BAR; PG8_SCHED;
            PG8_LDB(B0, 1, 0); PG8_LDB(B1, 1, 1); PG8_SCHED; PG8_LDA(At, 1, 0); PG8_STAGE(PG8_SA(0, 1), a2 + hstep, voffA);
            PG8_WAIT_V(8); PG8_WAIT_L(0); PG8_BAR; PG8_MMA(0, 0, At, B0); PG8_MMA(0, 1, At, B1); PG8_BAR; PG8_SCHED;
            PG8_LDA(At, 1, 1); PG8_STAGE(PG8_SB(1, 0), b3, voffB); PG8_STAGE(PG8_SB(1, 1), b3 + hstep, voffB); PG8_STAGE(PG8_SA(1, 0), a3, voffA);
            PG8_WAIT_V(8); PG8_WAIT_L(0); PG8_BAR; PG8_MMA(1, 0, At, B0); PG8_MMA(1, 1, At, B1); PG8_BAR; PG8_SCHED;
            } else {
            PG8_LDB(B0, 0, 0); PG8_SCHED; PG8_LDA(At, 0, 0); PG8_STAGE(PG8_SA(1, 1), a1 + hstep, voffA);
            PG8_WAIT_L(8); PG8_BAR; PG8_WAIT_L(0); PG8_MMA(0, 0, At, B0); PG8_BAR; PG8_SCHED;
            PG8_LDB(B1, 0, 1); PG8_STAGE(PG8_SB(0, 0), b2, voffB);
            PG8_BAR; PG8_WAIT_L(0); PG8_MMA(0, 1, At, B1); PG8_BAR;
            PG8_LDA(At, 0, 1); PG8_STAGE(PG8_SA(0, 0), a2, voffA);
            PG8_BAR; PG8_WAIT_L(0); PG8_MMA(1, 0, At, B0); PG8_BAR; PG8_SCHED;
            PG8_STAGE(PG8_SB(0, 1), b2 + hstep, voffB);
            PG8_WAIT_V(6); PG8_BAR; PG8_MMA(1, 1, At, B1); PG8_BAR;
            PG8_LDB(B0, 1, 0); PG8_SCHED; PG8_LDA(At, 1, 0); PG8_STAGE(PG8_SA(0, 1), a2 + hstep, voffA);
            PG8_WAIT_L(8); PG8_BAR; PG8_WAIT_L(0); PG8_MMA(0, 0, At, B0); PG8_BAR; PG8_SCHED;
            PG8_LDB(B1, 1, 1); PG8_STAGE(PG8_SB(1, 0), b3, voffB);
            PG8_BAR; PG8_WAIT_L(0); PG8_MMA(0, 1, At, B1); PG8_BAR;
            PG8_LDA(At, 1, 1); PG8_STAGE(PG8_SA(1, 0), a3, voffA);
            PG8_BAR; PG8_WAIT_L(0); PG8_MMA(1, 0, At, B0); PG8_BAR; PG8_SCHED;
            PG8_STAGE(PG8_SB(1, 1), b3 + hstep, voffB);
            PG8_WAIT_V(6); PG8_BAR; PG8_MMA(1, 1, At, B1); PG8_BAR;
            }
        }
        if constexpr (ALIGN_EPI) { if (wr == 0) PG8_BAR; }
        if constexpr (!Epi::AFTER_DRAIN) { E(acc, cur, wr, wc, fr, fq); S.done(cur); }
        if (!has_next) break;
#pragma unroll
        for (int a = 0; a < 2; ++a)
#pragma unroll
            for (int b = 0; b < 2; ++b)
#pragma unroll
                for (int m = 0; m < 4; ++m)
#pragma unroll
                    for (int n = 0; n < 2; ++n) acc[a][b][m][n] = (f32x4){0.f, 0.f, 0.f, 0.f};
        cur = nxt; cA = nA; cB = nB; ++ui;
        if constexpr (ALIGN_EPI) { if (wr == 1) PG8_BAR; }
    }
    PG8_WAIT_V(0);
    if constexpr (!ALIGN_EPI) { if (wr == 0) PG8_BAR; }
    PG8_BAR;
    if constexpr (Epi::AFTER_DRAIN) { E.fused(acc, cur, wr, wc, fr, fq, lds, wid, lane); S.done(cur); }
#undef PG8_SA
#undef PG8_SB
#undef PG8_STAGE
#undef PG8_LDA
#undef PG8_LDB
#undef PG8_MMA
#undef PG8_WAIT_V
#undef PG8_WAIT_L
#undef PG8_BAR
#undef PG8_SCHED
}
}
namespace att {
#define ALAS __attribute__((address_space(3)))
typedef unsigned short bf16_t;
typedef short bf16x8 __attribute__((ext_vector_type(8)));
typedef float f32x16 __attribute__((ext_vector_type(16)));
typedef float f32x4 __attribute__((ext_vector_type(4)));
typedef unsigned u32x4 __attribute__((ext_vector_type(4)));
typedef unsigned u32x2 __attribute__((ext_vector_type(2)));
constexpr int KROW = 144;
constexpr int KBUF = 64 * KROW;
constexpr int VBUF = 64 * 320;
template <int DV> struct VRow { static constexpr int B = (DV == 128) ? 320 : 192; };
constexpr int L_K = 0, L_V = 2 * KBUF, L_BT = L_V + 2 * VBUF, L_END = L_BT + 2048;
constexpr int L_O1 = L_END;
constexpr int L_QS = L_O1 + 65536;
constexpr float LOG2E = 1.4426950408889634f;
constexpr float QSCALE = 0.125f * 1.4426950408889634f;
#define CR(r) (((r) & 3) + 8 * ((r) >> 2))
typedef float f32x2_t __attribute__((ext_vector_type(2))); typedef __bf16 bf16x2_t __attribute__((ext_vector_type(2)));
__device__ __forceinline__ unsigned cvtpk(float lo, float hi) { f32x2_t v = {lo, hi}; bf16x2_t b = __builtin_convertvector(v, bf16x2_t); return __builtin_bit_cast(unsigned, b); }
__device__ __forceinline__ unsigned cvtpk_a(float lo, float hi) { unsigned r; asm volatile("v_cvt_pk_bf16_f32 %0, %1, %2" : "=v"(r) : "v"(lo), "v"(hi)); return r; }
__device__ __forceinline__ float ex2(float x) { return __builtin_amdgcn_exp2f(x); }
__device__ __forceinline__ float rcpf_(float x) { return __builtin_amdgcn_rcpf(x); }

typedef short v4i16_t __attribute__((ext_vector_type(4)));
__device__ __forceinline__ v4i16_t vtr(const ALAS unsigned char* p) { return __builtin_amdgcn_ds_read_tr16_b64_v4i16((ALAS v4i16_t*)p); }
template <int DV> __device__ __forceinline__ bf16x8 vfrag(const ALAS unsigned char* vb, int s, int db) {
    const v4i16_t lo = vtr(vb + (16 * s) * VRow<DV>::B + 64 * db), hi4 = vtr(vb + (16 * s + 8) * VRow<DV>::B + 64 * db);
    return __builtin_shufflevector(lo, hi4, 0, 1, 2, 3, 4, 5, 6, 7);
}
template <int DV> __device__ __forceinline__ int vtr_lane_off(int lane) { return (4 * (lane >> 5) + ((lane & 15) >> 2)) * VRow<DV>::B + (16 * ((lane >> 4) & 1) + 4 * (lane & 3)) * 2; }
__device__ __forceinline__ float pair_max(float x) { auto rr = __builtin_amdgcn_permlane32_swap(__float_as_uint(x), __float_as_uint(x), false, false); return fmaxf(__uint_as_float(rr[0]), __uint_as_float(rr[1])); }
template <int DV> struct Pref { u32x4 k; u32x4 v[DV / 64]; };

template <int DV> __device__ __forceinline__ void tile_load(Pref<DV>& pf, const bf16_t* Kp, const bf16_t* Vp, int pitch, int kt, int tid) {
    const int krow = tid >> 3, kc = (tid & 7) * 8;
    pf.k = *(const u32x4*)(Kp + (size_t)(kt * 64 + krow) * pitch + kc);
#pragma unroll
    for (int i = 0; i < DV / 64; ++i) { const int c = tid + i * 512, vrow = c / (DV / 8), vc = (c % (DV / 8)) * 8;
        pf.v[i] = *(const u32x4*)(Vp + (size_t)(kt * 64 + vrow) * pitch + vc); }
}
template <int DV> __device__ __forceinline__ void tile_store(const Pref<DV>& pf, ALAS unsigned char* kbuf, ALAS unsigned char* vbuf, int tid) {
    const int krow = tid >> 3, kc = (tid & 7) * 8;
    *(ALAS u32x4*)(kbuf + krow * KROW + kc * 2) = pf.k;
#pragma unroll
    for (int i = 0; i < DV / 64; ++i) { const int c = tid + i * 512, vrow = c / (DV / 8), vc = (c % (DV / 8)) * 8;
        *(ALAS u32x4*)(vbuf + vrow * VRow<DV>::B + vc * 2) = pf.v[i]; }
}

template <int DV> __device__ __forceinline__ void pv_slab(const ALAS unsigned char* vbuf, int s, u32x4 w, f32x16 (&o)[DV / 32], int l32, int hi) {
    const bf16x8 pfr = __builtin_bit_cast(bf16x8, w);
#pragma unroll
    for (int db = 0; db < DV / 32; ++db) {
        const bf16x8 vf = vfrag<DV>(vbuf + vtr_lane_off<DV>(l32 + 32 * hi), s, db);
        o[db] = __builtin_amdgcn_mfma_f32_32x32x16_bf16(vf, pfr, o[db], 0, 0, 0); }
    if (DV > 64) __builtin_amdgcn_sched_barrier(0);
}

template <int MODE, int DV, bool MASKED>
__device__ __forceinline__ void tile_compute(const ALAS unsigned char* kbuf, const ALAS unsigned char* vbuf, const bf16x8 (&qf)[4], f32x16 (&o)[DV / 32],
                                             float& st_m, float& st_l, int lim, const ALAS float* btab, float cbias, int lane) {
    const int l32 = lane & 31, hi = lane >> 5;
    if constexpr (MODE == 0) {
        f32x16 p0, p1;
#pragma unroll
        for (int r = 0; r < 16; ++r) { p0[r] = 0.f; p1[r] = 0.f; }
        { const ALAS unsigned char* kb = kbuf + l32 * KROW + hi * 16;
#pragma unroll
          for (int d0 = 0; d0 < 4; ++d0) {
              const bf16x8 k0 = *(const ALAS bf16x8*)(kb + d0 * 32);
              const bf16x8 k1 = *(const ALAS bf16x8*)(kb + 32 * KROW + d0 * 32);
              p0 = __builtin_amdgcn_mfma_f32_32x32x16_bf16(k0, qf[d0], p0, 0, 0, 0);
              p1 = __builtin_amdgcn_mfma_f32_32x32x16_bf16(k1, qf[d0], p1, 0, 0, 0); } }
        __builtin_amdgcn_sched_barrier(0);
#pragma unroll
        for (int r = 0; r < 16; ++r) {
            float a = rcpf_(1.0f + ex2(p0[r])), b = rcpf_(1.0f + ex2(p1[r]));
            if (MASKED) { a = (CR(r) < lim) ? a : 1.0f; b = (CR(r) + 32 < lim) ? b : 1.0f; }
            p0[r] = a; p1[r] = b; }
        float g[8], hs[8], pr[8];
#pragma unroll
        for (int i = 0; i < 4; ++i) { g[i] = (p0[4 * i] * p0[4 * i + 1]) * (p0[4 * i + 2] * p0[4 * i + 3]); g[4 + i] = (p1[4 * i] * p1[4 * i + 1]) * (p1[4 * i + 2] * p1[4 * i + 3]); }
#pragma unroll
        for (int i = 0; i < 8; ++i) { auto rr = __builtin_amdgcn_permlane32_swap(__float_as_uint(g[i]), __float_as_uint(g[i]), false, false);
            pr[i] = __uint_as_float(rr[0]) * __uint_as_float(rr[1]); hs[i] = hi ? 1.0f : __uint_as_float(rr[1]); }
        float T = st_m;
#pragma unroll
        for (int i = 7; i >= 0; --i) {
            float R = hs[i] * T; T = T * pr[i];
            if (i >= 4) { const int b = 4 * (i - 4);
                float R2 = R * p1[b + 3]; p1[b + 3] = R - R2; float R1 = R2 * p1[b + 2]; p1[b + 2] = R2 - R1; float R0 = R1 * p1[b + 1]; p1[b + 1] = R1 - R0; p1[b] = R0 - R0 * p1[b]; }
            else { const int b = 4 * i;
                float R2 = R * p0[b + 3]; p0[b + 3] = R - R2; float R1 = R2 * p0[b + 2]; p0[b + 2] = R2 - R1; float R0 = R1 * p0[b + 1]; p0[b + 1] = R1 - R0; p0[b] = R0 - R0 * p0[b]; }
        }
        st_m = T;
        __builtin_amdgcn_sched_barrier(0);
#pragma unroll
        for (int s = 0; s < 4; ++s) {
            u32x4 w;
            if (s == 0) { w.x = cvtpk(p0[0], p0[1]); w.y = cvtpk(p0[2], p0[3]); w.z = cvtpk(p0[4], p0[5]); w.w = cvtpk(p0[6], p0[7]); }
            else if (s == 1) { w.x = cvtpk(p0[8], p0[9]); w.y = cvtpk(p0[10], p0[11]); w.z = cvtpk(p0[12], p0[13]); w.w = cvtpk(p0[14], p0[15]); }
            else if (s == 2) { w.x = cvtpk(p1[0], p1[1]); w.y = cvtpk(p1[2], p1[3]); w.z = cvtpk(p1[4], p1[5]); w.w = cvtpk(p1[6], p1[7]); }
            else { w.x = cvtpk(p1[8], p1[9]); w.y = cvtpk(p1[10], p1[11]); w.z = cvtpk(p1[12], p1[13]); w.w = cvtpk(p1[14], p1[15]); }
            pv_slab<DV>(vbuf, s, w, o, l32, hi);
        }
    } else {
        const float NEG = -__builtin_inff();
#pragma unroll
        for (int hk = 0; hk < 2; ++hk) {
            f32x16 p;
            const bool fresh = (st_m == NEG);
            const float mbase = fresh ? 0.f : st_m;
            { const float ini = (MASKED ? 0.f : cbias) - mbase;
#pragma unroll
              for (int r = 0; r < 16; ++r) p[r] = ini; }
            { const ALAS unsigned char* kb = kbuf + (32 * hk + l32) * KROW + hi * 16;
#pragma unroll
              for (int d0 = 0; d0 < 4; ++d0) { const bf16x8 k0 = *(const ALAS bf16x8*)(kb + d0 * 32); p = __builtin_amdgcn_mfma_f32_32x32x16_bf16(k0, qf[d0], p, 0, 0, 0); } }
            if (MASKED) {
                float bv[16];
#pragma unroll
                for (int r = 0; r < 16; ++r) { const int d0 = lim - 32 * hk - CR(r); bv[r] = btab[min(max(d0, 0), 127)]; }
#pragma unroll
                for (int r = 0; r < 16; ++r) asm volatile("" : "+v"(bv[r]));
#pragma unroll
                for (int r = 0; r < 16; ++r) {
                    const int d0 = lim - 32 * hk - CR(r);
                    const bool v0 = (MODE == 2) ? ((unsigned)d0 < 128u) : (d0 >= 0);
                    p[r] = v0 ? p[r] + bv[r] : NEG; }
            }
            float mt = fmaxf(p[0], p[1]);
#pragma unroll
            for (int r = 2; r < 16; ++r) mt = fmaxf(mt, p[r]);
            mt = fmaxf(mt, __shfl_xor(mt, 32));
            const bool need = fresh ? (mt > NEG) : (mt > 0.f);
            if (__any(need)) {
                const float dl = need ? mt : 0.f, f = fresh ? 1.0f : ex2(-dl);
                st_l *= f; st_m = need ? mbase + dl : st_m;
#pragma unroll
                for (int r = 0; r < 16; ++r) p[r] -= dl;
#pragma unroll
                for (int db = 0; db < DV / 32; ++db)
#pragma unroll
                    for (int r = 0; r < 16; ++r) o[db][r] *= f;
            }
            float s = 0.f;
#pragma unroll
            for (int r = 0; r < 16; ++r) { p[r] = ex2(p[r]); s += p[r]; }
            st_l += s;
#pragma unroll
            for (int s2 = 0; s2 < 2; ++s2) {
                u32x4 w; w.x = cvtpk(p[8 * s2], p[8 * s2 + 1]); w.y = cvtpk(p[8 * s2 + 2], p[8 * s2 + 3]); w.z = cvtpk(p[8 * s2 + 4], p[8 * s2 + 5]); w.w = cvtpk(p[8 * s2 + 6], p[8 * s2 + 7]);
                pv_slab<DV>(vbuf, 2 * hk + s2, w, o, l32, hi);
            }
        }
    }
}

template <int MODE, int DV>
__device__ __forceinline__ void attn_core(const bf16_t* Qp, const bf16_t* Kp, const bf16_t* Vp, int pitch, int q0, int kt0, int nt, int dir,
                                          ALAS unsigned char* lds, f32x16 (&o)[DV / 32], float& st_m, float& st_l) {
    int tid_ = threadIdx.x; asm volatile("" : "+v"(tid_));
    const int tid = tid_, lane = tid & 63, l32 = lane & 31, hi = lane >> 5, wid = __builtin_amdgcn_readfirstlane(tid >> 6);
    const int qw = q0 + 32 * wid, t = qw + l32;
    const ALAS float* btab = (const ALAS float*)(lds + L_BT);
    bf16x8 qf[4];
#pragma unroll
    for (int d0 = 0; d0 < 4; ++d0) qf[d0] = *(const bf16x8*)(Qp + (size_t)t * pitch + d0 * 16 + hi * 8);
#pragma unroll
    for (int db = 0; db < DV / 32; ++db)
#pragma unroll
        for (int r = 0; r < 16; ++r) o[db][r] = 0.f;
    st_m = (MODE == 0) ? 1.0f : -__builtin_inff(); st_l = 0.f;
    Pref<DV> pfA, pfB;
    tile_load<DV>(pfA, Kp, Vp, pitch, kt0, tid);
    tile_load<DV>(pfB, Kp, Vp, pitch, kt0 + dir * min(1, nt - 1), tid);
    tile_store<DV>(pfA, lds + L_K, lds + L_V, tid);
    __syncthreads();
    const float cbias = (MODE == 1) ? btab[127] : 0.f;
    bool done = false;
#define AC_STEP(it_, PFN, PFS) do { \
        const int it = (it_), kt = kt0 + dir * it, cur = it & 1, kbase = kt * 64; \
        tile_load<DV>(PFN, Kp, Vp, pitch, kt0 + dir * min(it + 2, nt - 1), tid);        \
        const ALAS unsigned char* kb = lds + L_K + cur * KBUF; const ALAS unsigned char* vb = lds + L_V + cur * VBUF; \
        const int lim = t - kbase - 4 * hi; \
        if (MODE == 0) { \
            if (kbase <= qw + 31 && __any(st_m != 0.0f)) { if (kbase + 63 >= qw) tile_compute<0, DV, true>(kb, vb, qf, o, st_m, st_l, lim, btab, cbias, lane); else tile_compute<0, DV, false>(kb, vb, qf, o, st_m, st_l, lim, btab, cbias, lane); } \
        } else if (MODE == 1) { \
            if (kbase <= qw + 31) { if (qw - (kbase + 63) < 113) tile_compute<1, DV, true>(kb, vb, qf, o, st_m, st_l, lim, btab, cbias, lane); else tile_compute<1, DV, false>(kb, vb, qf, o, st_m, st_l, lim, btab, cbias, lane); } \
        } else { \
            if (kbase <= qw + 31 && kbase + 63 >= qw - 127) tile_compute<2, DV, true>(kb, vb, qf, o, st_m, st_l, lim, btab, cbias, lane); \
        } \
        if (it + 1 < nt) tile_store<DV>(PFS, lds + L_K + (cur ^ 1) * KBUF, lds + L_V + (cur ^ 1) * VBUF, tid);     \
        if (MODE == 0) { \
              \
            if (!__syncthreads_or(st_m != 0.0f)) done = true; \
        } else __syncthreads(); } while (0)
    for (int it2 = 0; it2 < nt && !done; it2 += 2) {
        AC_STEP(it2, pfA, pfB);
        if (done) break;
        AC_STEP(it2 + 1, pfB, pfA);
    }
#undef AC_STEP
}
template <int MODE, int DV>
__device__ __forceinline__ void attn_core_pp(const bf16_t* Qp, const bf16_t* Kp, const bf16_t* Vp, int pitch, int q0, int kt0, int nt,
                                             ALAS unsigned char* lds, f32x16 (&o)[DV / 32], float& st_m, float& st_l) {
    int tid_ = threadIdx.x; asm volatile("" : "+v"(tid_));
    const int tid = tid_, lane = tid & 63, l32 = lane & 31, hi = lane >> 5, wid = __builtin_amdgcn_readfirstlane(tid >> 6), grp = wid >> 2;
    const int qw = q0 + 32 * wid, t = qw + l32;
    const ALAS float* btab = (const ALAS float*)(lds + L_BT);
    const float NEG = -__builtin_inff();
    bf16x8 qf[4];
#pragma unroll
    for (int d0 = 0; d0 < 4; ++d0) qf[d0] = *(const bf16x8*)(Qp + (size_t)t * pitch + d0 * 16 + hi * 8);
    ALAS unsigned char* qst = lds + L_QS + wid * 3072 + lane * 16;
    if (DV == 128) {
#pragma unroll
        for (int d0 = 1; d0 < 4; ++d0) *(ALAS bf16x8*)(qst + (d0 - 1) * 1024) = qf[d0];
    }
#pragma unroll
    for (int db = 0; db < DV / 32; ++db)
#pragma unroll
        for (int r = 0; r < 16; ++r) o[db][r] = 0.f;
    st_m = NEG; st_l = 0.f;
    Pref<DV> pfA, pfB;
    tile_load<DV>(pfA, Kp, Vp, pitch, kt0, tid);
    tile_load<DV>(pfB, Kp, Vp, pitch, kt0 + 1, tid);
    tile_store<DV>(pfA, lds + L_K, lds + L_V, tid);
    tile_store<DV>(pfB, lds + L_K + KBUF, lds + L_V + VBUF, tid);
    tile_load<DV>(pfA, Kp, Vp, pitch, kt0 + min(2, nt - 1), tid);
    tile_load<DV>(pfB, Kp, Vp, pitch, kt0 + min(3, nt - 1), tid);
    __syncthreads();
    const float cbias = (MODE == 1) ? btab[256 + 127] : 0.f;
    f32x16 p; u32x4 pw0, pw1;
#pragma unroll
    for (int r = 0; r < 16; ++r) p[r] = 0.f;
    pw0 = (u32x4){0u, 0u, 0u, 0u}; pw1 = pw0;
#define PP_MASKED(ti) ((MODE == 1) ? (qw - ((kt0 + (ti)) * 64 + 63) < 113) : true)
#define PP_PART(ti) ((MODE != 2) || ((kt0 + (ti)) * 64 <= qw + 31 && (kt0 + (ti)) * 64 + 63 >= qw - 127))
#define PP_QK(ti, hk) do { \
        const float mbase_ = (st_m == NEG) ? 0.f : st_m; const float ini_ = (PP_MASKED(ti) ? 0.f : cbias) - mbase_; \
        _Pragma("unroll") for (int r = 0; r < 16; ++r) p[r] = ini_; \
        const ALAS unsigned char* kb_ = lds + L_K + ((ti) & 1) * KBUF + (32 * (hk) + l32) * KROW + hi * 16; \
        _Pragma("unroll") for (int d0 = 0; d0 < 4; ++d0) { const bf16x8 k0_ = *(const ALAS bf16x8*)(kb_ + d0 * 32); \
            const bf16x8 qv_ = (DV == 128 && d0 > 0) ? *(const ALAS bf16x8*)(qst + (d0 - 1) * 1024) : qf[d0]; \
            p = __builtin_amdgcn_mfma_f32_32x32x16_bf16(k0_, qv_, p, 0, 0, 0); } } while (0)
#define PP_PVQK(tv, hv, tk, hq) do { \
        const ALAS unsigned char* vb_ = lds + L_V + ((tv) & 1) * VBUF + vtr_lane_off<DV>(lane); \
        const ALAS unsigned char* kb_ = lds + L_K + ((tk) & 1) * KBUF + (32 * (hq) + l32) * KROW + hi * 16; \
        if (PP_PART(tv)) { \
            bf16x8 vf_[DV / 32][2]; \
            _Pragma("unroll") for (int db = 0; db < DV / 32; ++db) { vf_[db][0] = vfrag<DV>(vb_, 2 * (hv), db); vf_[db][1] = vfrag<DV>(vb_, 2 * (hv) + 1, db); } \
            const bf16x8 pa_ = __builtin_bit_cast(bf16x8, pw0), pb_ = __builtin_bit_cast(bf16x8, pw1); \
            _Pragma("unroll") for (int db = 0; db < DV / 32; ++db) o[db] = __builtin_amdgcn_mfma_f32_32x32x16_bf16(vf_[db][0], pa_, o[db], 0, 0, 0); \
            _Pragma("unroll") for (int db = 0; db < DV / 32; ++db) o[db] = __builtin_amdgcn_mfma_f32_32x32x16_bf16(vf_[db][1], pb_, o[db], 0, 0, 0); } \
        if (PP_PART(tk)) { \
            bf16x8 kf_[4], qv_[4]; \
            _Pragma("unroll") for (int d0 = 0; d0 < 4; ++d0) { kf_[d0] = *(const ALAS bf16x8*)(kb_ + d0 * 32); qv_[d0] = (DV == 128 && d0 > 0) ? *(const ALAS bf16x8*)(qst + (d0 - 1) * 1024) : qf[d0]; } \
            const float mbase_ = (st_m == NEG) ? 0.f : st_m; const float ini_ = (PP_MASKED(tk) ? 0.f : cbias) - mbase_; \
            _Pragma("unroll") for (int r = 0; r < 16; ++r) p[r] = ini_; \
            _Pragma("unroll") for (int d0 = 0; d0 < 4; ++d0) p = __builtin_amdgcn_mfma_f32_32x32x16_bf16(kf_[d0], qv_[d0], p, 0, 0, 0); } } while (0)
#define PP_SM(ti, hk) do { if (PP_PART(ti)) { \
        if (PP_MASKED(ti)) { const int lim_ = t - (kt0 + (ti)) * 64 - 4 * hi - 32 * (hk); \
            const ALAS float* bp_ = btab + (lim_ + 256 - 27);            \
            float bv_[16]; \
            _Pragma("unroll") for (int r = 0; r < 16; ++r) bv_[r] = bp_[27 - CR(r)]; \
            _Pragma("unroll") for (int r = 0; r < 16; ++r) p[r] += bv_[r]; } \
        const bool fresh_ = (st_m == NEG); const float mb_ = fresh_ ? 0.f : st_m; \
        float mt_; { const float a0_ = fmaxf(fmaxf(p[0], p[1]), p[2]), a1_ = fmaxf(fmaxf(p[3], p[4]), p[5]), a2_ = fmaxf(fmaxf(p[6], p[7]), p[8]), a3_ = fmaxf(fmaxf(p[9], p[10]), p[11]), a4_ = fmaxf(fmaxf(p[12], p[13]), p[14]); \
            mt_ = fmaxf(fmaxf(fmaxf(a0_, a1_), a2_), fmaxf(fmaxf(a3_, a4_), p[15])); }        \
        mt_ = pair_max(mt_); \
        const bool need_ = fresh_ ? (mt_ > NEG) : (mt_ > 6.0f);        \
        if (__any(need_)) { const float dl_ = need_ ? mt_ : 0.f, f_ = fresh_ ? 1.0f : ex2(-dl_); \
            st_l *= f_; st_m = need_ ? mb_ + dl_ : st_m; \
            _Pragma("unroll") for (int r = 0; r < 16; ++r) p[r] -= dl_; \
            _Pragma("unroll") for (int db = 0; db < DV / 32; ++db) _Pragma("unroll") for (int r = 0; r < 16; ++r) o[db][r] *= f_; } \
        _Pragma("unroll") for (int r = 0; r < 16; ++r) p[r] = ex2(p[r]); \
        st_l += ((p[0] + p[1]) + (p[2] + p[3])) + ((p[4] + p[5]) + (p[6] + p[7])) + (((p[8] + p[9]) + (p[10] + p[11])) + ((p[12] + p[13]) + (p[14] + p[15]))); \
        pw0.x = cvtpk_a(p[0], p[1]); pw0.y = cvtpk_a(p[2], p[3]); pw0.z = cvtpk_a(p[4], p[5]); pw0.w = cvtpk_a(p[6], p[7]); \
        pw1.x = cvtpk_a(p[8], p[9]); pw1.y = cvtpk_a(p[10], p[11]); pw1.z = cvtpk_a(p[12], p[13]); pw1.w = cvtpk_a(p[14], p[15]); } } while (0)
#define PP_STAGE(u, PF) do { const int u_ = (u); if (u_ >= 2 && u_ < nt) tile_store<DV>(PF, lds + L_K + (u_ & 1) * KBUF, lds + L_V + (u_ & 1) * VBUF, tid); \
        tile_load<DV>(PF, Kp, Vp, pitch, kt0 + min(u_ + 2, nt - 1), tid); } while (0)
#define PP_BAR() asm volatile("s_waitcnt lgkmcnt(0)\n\ts_barrier" ::: "memory")
    if (grp == 1) __builtin_amdgcn_s_setprio(1);
    if (grp == 0) {
        PP_QK(0, 0); PP_BAR();
        for (int ti = 0; ti < nt; ti += 2) {
            PP_SM(ti, 0); PP_BAR();
            PP_PVQK(ti, 0, ti, 1); PP_STAGE(ti + 1, pfB); PP_BAR();
            PP_SM(ti, 1); PP_BAR();
            PP_PVQK(ti, 1, ti + 1, 0); PP_BAR();
            PP_SM(ti + 1, 0); PP_BAR();
            PP_PVQK(ti + 1, 0, ti + 1, 1); PP_STAGE(ti + 2, pfA); PP_BAR();
            PP_SM(ti + 1, 1); PP_BAR();
            PP_PVQK(ti + 1, 1, ti + 2, 0); PP_BAR();
        }
        PP_BAR();
    } else {
        PP_BAR();
        PP_QK(0, 0); PP_BAR();
        for (int ti = 0; ti < nt; ti += 2) {
            PP_SM(ti, 0); PP_STAGE(ti + 1, pfB); PP_BAR();
            PP_PVQK(ti, 0, ti, 1); PP_BAR();
            PP_SM(ti, 1); PP_BAR();
            PP_PVQK(ti, 1, ti + 1, 0); PP_BAR();
            PP_SM(ti + 1, 0); PP_STAGE(ti + 2, pfA); PP_BAR();
            PP_PVQK(ti + 1, 0, ti + 1, 1); PP_BAR();
            PP_SM(ti + 1, 1); PP_BAR();
            PP_PVQK(ti + 1, 1, ti + 2, 0); PP_BAR();
        }
    }
    __builtin_amdgcn_s_setprio(0);
#undef PP_MASKED
#undef PP_PART
#undef PP_QK
#undef PP_PVQK
#undef PP_SM
#undef PP_STAGE
#undef PP_BAR
}
template <int DV> __device__ __forceinline__ void store_ot(const f32x16 (&o)[DV / 32], bf16_t* orow, int hi) {
#pragma unroll
    for (int db = 0; db < DV / 32; ++db)
#pragma unroll
        for (int rg = 0; rg < 4; ++rg) { u32x2 w; w.x = cvtpk_a(o[db][4 * rg], o[db][4 * rg + 1]); w.y = cvtpk_a(o[db][4 * rg + 2], o[db][4 * rg + 3]);
            *(u32x2*)(orow + 32 * db + 8 * rg + 4 * hi) = w; }
}
}
#ifndef REP_PROLOG
#define REP_PROLOG 1
#endif
#ifndef RESID_BF16
#define RESID_BF16 1
#endif
#ifndef OUT_STAGGER_TICKS
#define OUT_STAGGER_TICKS 0
#endif
#ifndef OUT_STAGGER_GROUPS
#define OUT_STAGGER_GROUPS 2
#endif
#ifndef REP_OUT
#define REP_OUT 1
#endif
#ifndef REP_DOWN
#define REP_DOWN 1
#endif
#ifndef REP_INPROJ
#define REP_INPROJ 1
#endif
#ifndef REP_DIFF
#define REP_DIFF 1
#endif
#ifndef REP_SWA
#define REP_SWA 1
#endif
#ifndef REP_SB
#define REP_SB 1
#endif
#ifndef REP_UP
#define REP_UP 1
#endif
#ifndef REP_CONV
#define REP_CONV 1
#endif
#ifndef PH_DIFF
#define PH_DIFF 1
#endif
#ifndef PH_SWA
#define PH_SWA 1
#endif
#ifndef PH_SB
#define PH_SB 1
#endif
#ifndef PH_CONV
#define PH_CONV 1
#endif
#define LAS __attribute__((address_space(3)))
typedef unsigned short bf16;
typedef float f32x4 __attribute__((ext_vector_type(4)));
typedef unsigned v4u __attribute__((ext_vector_type(4)));
typedef unsigned v2u __attribute__((ext_vector_type(2)));
constexpr int NWAVES = 8;
constexpr int SEQ = 4096, NB = 16, MTOK = NB * SEQ, DM = 1024, DFF = 2816, DUP = 2 * DFF;
constexpr int EVEN_IN = 2304, ODD_IN = 3072;
constexpr size_t MiB = 1u << 20;
constexpr size_t WS_SSQ = 1 * MiB;
constexpr size_t WS_WINE = 8 * MiB, WS_WOUTE = 17 * MiB, WS_WINO = 21 * MiB, WS_WOUTO = 33 * MiB, WS_WUP = 37 * MiB, WS_WDN = 81 * MiB;
constexpr size_t WS_XB = 104 * MiB, WS_R = 232 * MiB;
constexpr size_t WS_PROJ = WS_R, WS_AO = WS_R + 384 * MiB, WS_U = WS_R, WS_G = WS_R + 352 * MiB;
constexpr int LDS_MISC = 152576, LDS_BYTES = 153600;
static_assert(att::L_QS + 8 * 3072 <= LDS_MISC, "LDS map");
constexpr int HALF_ROWS = MTOK / 2;

struct Args {
    const float* x; const float* rel_bias; const float* norm_mix; const float* norm_ffn; const float* norm_final;
    const float* w_in_even; const float* w_out_even; const float* sinks; const float* lam_q1; const float* lam_k1; const float* lam_q2; const float* lam_k2;
    const float* diff_norm; const float* w_in_odd; const float* w_out_odd; const float* ffn_up; const float* ffn_conv; const float* ffn_conv_b; const float* ffn_down;
    float* out; unsigned char* ws;
};

__device__ const unsigned char T5B[128] = {0, 1, 2, 3, 4, 5, 6, 7, 8, 9, 10, 11, 12, 13, 14, 15, 16, 16, 16, 17, 17, 18, 18, 18, 19, 19, 19, 20, 20, 20, 20, 21, 21, 21, 21, 22, 22, 22, 22, 22, 23, 23, 23, 23, 23, 23, 24, 24, 24, 24, 24, 24, 25, 25, 25, 25, 25, 25, 25, 26, 26, 26, 26, 26, 26, 26, 26, 27, 27, 27, 27, 27, 27, 27, 27, 27, 27, 28, 28, 28, 28, 28, 28, 28, 28, 28, 28, 29, 29, 29, 29, 29, 29, 29, 29, 29, 29, 29, 29, 30, 30, 30, 30, 30, 30, 30, 30, 30, 30, 30, 30, 30, 30, 31, 31, 31, 31, 31, 31, 31, 31, 31, 31, 31, 31, 31, 31, 31};

__device__ __forceinline__ float wave_sum(float v) {
#pragma unroll
    for (int o = 1; o < 64; o <<= 1) v += __shfl_xor(v, o);
    return v;
}
__device__ __forceinline__ unsigned f2bf(float f) { unsigned u = __builtin_bit_cast(unsigned, f); return (u + 0x7fffu + ((u >> 16) & 1u)) >> 16; }
__device__ __forceinline__ unsigned pk2(float lo, float hi) { return f2bf(lo) | (f2bf(hi) << 16); }

__device__ __forceinline__ void transpose_item(const float* W, int K, int N, bf16* WT, const float* gk, int a0, int a1, int b0, int b1, float cs, LAS float* scr, int item, int lane) {
    const int nblk = N / 32, kb = item / nblk, nb = item % nblk, k0 = 64 * kb, n0 = 32 * nb;
    const int nn = n0 + (lane & 31);
    const float csc = ((nn >= a0 && nn < a1) || (nn >= b0 && nn < b1)) ? cs : 1.0f;
    float tw[32];
#pragma unroll
    for (int i = 0; i < 32; ++i) tw[i] = __builtin_nontemporal_load(W + (size_t)(k0 + 2 * i + (lane >> 5)) * N + nn);
#pragma unroll
    for (int i = 0; i < 32; ++i) { const int kk = 2 * i + (lane >> 5); const float gv = gk ? gk[k0 + kk] : 1.0f; scr[kk * 33 + (lane & 31)] = tw[i] * (gv * csc); }
    asm volatile("s_waitcnt lgkmcnt(0)" ::: "memory");
    const int c = lane & 7;
#pragma unroll
    for (int j = 0; j < 4; ++j) { const int n = (lane >> 3) + 8 * j; const LAS float* s = scr + (8 * c) * 33 + n;
        v4u o; o.x = pk2(s[0 * 33], s[1 * 33]); o.y = pk2(s[2 * 33], s[3 * 33]); o.z = pk2(s[4 * 33], s[5 * 33]); o.w = pk2(s[6 * 33], s[7 * 33]);
        *(v4u*)(WT + (size_t)(n0 + n) * K + k0 + 8 * c) = o; }
    asm volatile("s_waitcnt lgkmcnt(0)" ::: "memory");
}

#define XB_TMO      128
#define XB_XCNT(j)  (256  + 64 * (j))
#define XB_XSUB(j)  (1280 + 64 * (j))
#define XB_XGEN(j)  (2304 + 64 * (j))
#define XB_TOP      3328
#define XB_TOPGEN   3392
#define XCD_BAR_WORDS 3456
#define XB_SPIN_CAP (1u << 18)

__device__ __forceinline__ unsigned xb_ld(unsigned* p)              { return __hip_atomic_load(p, __ATOMIC_RELAXED, __HIP_MEMORY_SCOPE_AGENT); }
__device__ __forceinline__ unsigned xb_add(unsigned* p, unsigned v) { return __hip_atomic_fetch_add(p, v, __ATOMIC_RELAXED, __HIP_MEMORY_SCOPE_AGENT); }
__device__ __forceinline__ unsigned xb_xcc_id() { return (unsigned)__builtin_amdgcn_s_getreg((3 << 11) | 20) & 0xFu; }
#define XB_SPIN(cond, bar) do { unsigned _sp = 0; while (cond) { __builtin_amdgcn_s_sleep(1); \
    if ((++_sp & 255u) == 0u) { if (xb_ld(&(bar)[XB_TMO])) break; if (_sp > XB_SPIN_CAP) { atomicAdd(&(bar)[XB_TMO], 1u); break; } } } } while (0)

struct XcdBarrier {
    unsigned* bar; unsigned x;
    volatile LAS unsigned* st;
};

__device__ __forceinline__ XcdBarrier xcd_barrier_post(unsigned* bar, volatile LAS unsigned* st) {
    XcdBarrier b; b.bar = bar; b.x = xb_xcc_id(); b.st = st;
    if (threadIdx.x == 0) (void)xb_add(&bar[XB_XCNT(b.x)], 1u);
    return b;
}
__device__ __forceinline__ void xcd_barrier_complete(unsigned* bar, unsigned x, unsigned& nloc, unsigned& nx) {
    const unsigned G = gridDim.x * gridDim.y * gridDim.z;
    unsigned sum, cnt, mine, sp = 0u;
    for (;;) {
        sum = 0u; cnt = 0u; mine = 0u;
#pragma unroll
        for (unsigned j = 0; j < 16; ++j) { const unsigned c = xb_ld(&bar[XB_XCNT(j)]); sum += c; cnt += (c > 0u) ? 1u : 0u; mine = (j == x) ? c : mine; }
        if (sum == G) break;
        __builtin_amdgcn_s_sleep(1);
        if ((++sp & 255u) == 0u) { if (xb_ld(&bar[XB_TMO])) break; if (sp > XB_SPIN_CAP) { atomicAdd(&bar[XB_TMO], 1u); break; } }
    }
    nloc = mine > 0u ? mine : 1u; nx = cnt > 0u ? cnt : 1u;
}

__device__ __forceinline__ void xcd_barrier(const XcdBarrier& b) {
    asm volatile("s_waitcnt vmcnt(0)" ::: "memory");
    __syncthreads();
    if (threadIdx.x == 0) {
        unsigned* bar = b.bar;
        __builtin_amdgcn_s_waitcnt(0);
        unsigned nloc = b.st[0], nx = b.st[1];
        if (nloc == 0u) { xcd_barrier_complete(bar, b.x, nloc, nx); b.st[0] = nloc; b.st[1] = nx; }
        const unsigned old = xb_add(&bar[XB_XSUB(b.x)], 1u);
        const unsigned gen = old / nloc;
        if (old + 1u == (gen + 1u) * nloc) {
            __builtin_amdgcn_fence(__ATOMIC_RELEASE, "agent");
            asm volatile("s_waitcnt vmcnt(0)" ::: "memory");
            const unsigned og = xb_add(&bar[XB_TOP], 1u);
            const unsigned tg = og / nx;
            if (og + 1u == (tg + 1u) * nx) xb_add(&bar[XB_TOPGEN], 1u);
            else XB_SPIN(xb_ld(&bar[XB_TOPGEN]) == tg, bar);
            __builtin_amdgcn_fence(__ATOMIC_ACQUIRE, "agent");
            xb_add(&bar[XB_XGEN(b.x)], 1u);
            asm volatile("s_waitcnt vmcnt(0)" ::: "memory");
        } else {
            XB_SPIN(xb_ld(&bar[XB_XGEN(b.x)]) == gen, bar);
            __builtin_amdgcn_fence(__ATOMIC_ACQUIRE, "agent");
            asm volatile("s_waitcnt vmcnt(0)" ::: "memory");
        }
    }
    __syncthreads();
}

__global__ void __launch_bounds__(NWAVES * 64, 2) mega_fwd(Args a) {
    extern __shared__ __attribute__((aligned(16))) unsigned char lds_raw[];
    cg::grid_group grid = cg::this_grid();
    LAS unsigned char* lds = (LAS unsigned char*)lds_raw;
    const int tid = threadIdx.x, lane = tid & 63, wave = __builtin_amdgcn_readfirstlane(tid >> 6);
    const int G = gridDim.x, bx = blockIdx.x;
    const int gw = bx * NWAVES + wave, NGW = G * NWAVES;
    const int vcu = (G % 8 == 0) ? (bx % 8) * (G / 8) + bx / 8 : bx;
    unsigned char* ws = a.ws;
    float* ssq = (float*)(ws + WS_SSQ);
    bf16* xb = (bf16*)(ws + WS_XB);
    bf16* proj = (bf16*)(ws + WS_PROJ);
    bf16* ao = (bf16*)(ws + WS_AO);
    bf16* ubuf = (bf16*)(ws + WS_U);
    bf16* gbuf = (bf16*)(ws + WS_G);

    if (bx == 0) for (int i = tid; i < XCD_BAR_WORDS; i += NWAVES * 64) ((unsigned*)ws)[i] = 0u;
    if (tid < 2) ((LAS unsigned*)(lds + LDS_MISC))[tid] = 0u;
    {
        LAS float* scr = (LAS float*)(lds + wave * 16384);
        constexpr int I_INE = 16 * (EVEN_IN / 32), I_OUT = 16 * 32, I_INO = 16 * (ODD_IN / 32), I_UP = 16 * (DUP / 32), I_DN = (DFF / 64) * 32;
        constexpr int NITEMS = 2 * I_INE + 2 * I_OUT + 2 * I_INO + 2 * I_OUT + 4 * I_UP + 4 * I_DN;
        for (int rep_ = 0; rep_ < REP_PROLOG; ++rep_)
        for (int it = gw; it < NITEMS; it += NGW) {
            int r = it;
            if (r < 2 * I_INE) { const int e = r / I_INE; r -= e * I_INE;
                transpose_item(a.w_in_even + (size_t)e * DM * EVEN_IN, DM, EVEN_IN, (bf16*)(ws + WS_WINE) + (size_t)e * EVEN_IN * DM, a.norm_mix + (2 * e) * DM, 0, 512, 768, 1280, att::QSCALE, scr, r, lane); continue; }
            r -= 2 * I_INE;
            if (r < 2 * I_OUT) { const int e = r / I_OUT; r -= e * I_OUT;
                transpose_item(a.w_out_even + (size_t)e * DM * DM, DM, DM, (bf16*)(ws + WS_WOUTE) + (size_t)e * DM * DM, nullptr, 0, 0, 0, 0, 1.f, scr, r, lane); continue; }
            r -= 2 * I_OUT;
            if (r < 2 * I_INO) { const int e = r / I_INO; r -= e * I_INO;
                transpose_item(a.w_in_odd + (size_t)e * DM * ODD_IN, DM, ODD_IN, (bf16*)(ws + WS_WINO) + (size_t)e * ODD_IN * DM, a.norm_mix + (2 * e + 1) * DM, 0, 1024, 0, 0, att::QSCALE, scr, r, lane); continue; }
            r -= 2 * I_INO;
            if (r < 2 * I_OUT) { const int e = r / I_OUT; r -= e * I_OUT;
                transpose_item(a.w_out_odd + (size_t)e * DM * DM, DM, DM, (bf16*)(ws + WS_WOUTO) + (size_t)e * DM * DM, nullptr, 0, 0, 0, 0, 1.f, scr, r, lane); continue; }
            r -= 2 * I_OUT;
            if (r < 4 * I_UP) { const int e = r / I_UP; r -= e * I_UP;
                transpose_item(a.ffn_up + (size_t)e * DM * DUP, DM, DUP, (bf16*)(ws + WS_WUP) + (size_t)e * DUP * DM, a.norm_ffn + e * DM, 0, 0, 0, 0, 1.f, scr, r, lane); continue; }
            r -= 4 * I_UP;
            { const int e = r / I_DN; r -= e * I_DN;
                transpose_item(a.ffn_down + (size_t)e * DFF * DM, DFF, DM, (bf16*)(ws + WS_WDN) + (size_t)e * DM * DFF, nullptr, 0, 0, 0, 0, 1.f, scr, r, lane); }
        }
        for (int m0 = 2 * gw; m0 < MTOK; m0 += 2 * NGW) {
            f32x4 v[2][4];
#pragma unroll
            for (int h2 = 0; h2 < 2; ++h2) { const f32x4* xr = (const f32x4*)(a.x + (size_t)(m0 + h2) * DM) + lane;
#pragma unroll
                for (int j = 0; j < 4; ++j) v[h2][j] = __builtin_nontemporal_load(xr + 64 * j); }
#pragma unroll
            for (int h2 = 0; h2 < 2; ++h2) { const int m = m0 + h2; float s = 0.f;
#pragma unroll
                for (int j = 0; j < 4; ++j) s += (v[h2][j][0] * v[h2][j][0] + v[h2][j][1] * v[h2][j][1]) + (v[h2][j][2] * v[h2][j][2] + v[h2][j][3] * v[h2][j][3]);
                s = wave_sum(s);
                v2u* o8 = (v2u*)(xb + (size_t)m * DM) + lane;
#pragma unroll
                for (int j = 0; j < 4; ++j) { v2u w; w.x = pk2(v[h2][j][0], v[h2][j][1]); w.y = pk2(v[h2][j][2], v[h2][j][3]); o8[64 * j] = w; }
                if (lane < 16) ssq[(size_t)m * 16 + lane] = (lane == 0) ? s : 0.f; }
        }
    }
    grid.sync();
    const XcdBarrier xbar = xcd_barrier_post((unsigned*)ws, (volatile LAS unsigned*)(lds + LDS_MISC));

    for (int layer = 0; layer < 4; ++layer) {
        const int e = layer >> 1; const bool even = (layer & 1) == 0;
        const float* xold = (layer == 0) ? a.x : a.out;
        {
            const int N = even ? EVEN_IN : ODD_IN;
            const bf16* wt = even ? (const bf16*)(ws + WS_WINE) + (size_t)e * EVEN_IN * DM : (const bf16*)(ws + WS_WINO) + (size_t)e * ODD_IN * DM;
            pg8::Gemm g{xb, wt, MTOK, N, DM}; pg8::StaticOrder S; S.init(MTOK, N, G, bx);
            pg8::EpiScaleBf16 E{proj, N, ssq};
            for (int rep_ = 0; rep_ < REP_INPROJ; ++rep_)
            pg8::gemm_phase<pg8::EpiScaleBf16, pg8::StaticOrder, true, true>(lds, g, S, E);
        }
        xcd_barrier(xbar);
        if (even) {
            int tq = threadIdx.x; asm volatile("" : "+v"(tq)); const int tid = tq, lane = tq & 63, l32 = lane & 31, hi = lane >> 5;
            float lam, one_m_li;
            { const float li = (layer == 0) ? 0.2f : 0.47071301839f;
              const float s1 = wave_sum(a.lam_q1[e * 64 + lane] * a.lam_k1[e * 64 + lane]), s2 = wave_sum(a.lam_q2[e * 64 + lane] * a.lam_k2[e * 64 + lane]);
              lam = __expf(s1) - __expf(s2) + li; lam = __builtin_bit_cast(float, __builtin_amdgcn_readfirstlane(__builtin_bit_cast(int, lam))); one_m_li = __builtin_bit_cast(float, __builtin_amdgcn_readfirstlane(__builtin_bit_cast(int, 1.0f - li))); }
            LAS float* btab = (LAS float*)(lds + att::L_BT);

#if PH_DIFF
            for (int rep_ = 0; rep_ < REP_DIFF; ++rep_)
            for (int uidx = vcu; uidx < 1024; uidx += G) {
                const int j = uidx >> 8, c = uidx & 255, bh = c >> 2, s = c & 3, b = bh >> 2, h = bh & 3;
                const int qb = (j == 0) ? s : (j == 1) ? 7 - s : (j == 2) ? 8 + s : 15 - s;
                { int tb = threadIdx.x; asm volatile("" : "+v"(tb)); const int dd = tb - 256;
                  btab[tb] = (dd < 0) ? -__builtin_inff() : a.rel_bias[T5B[dd < 127 ? dd : 127] * 12 + 8 + h] * att::LOG2E; }
                const bf16* base = proj + (size_t)b * SEQ * EVEN_IN;
                const int q0 = qb * 256, nt = 4 * qb + 4, t = q0 + 32 * wave + l32;
                att::f32x16 o2[4]; float m2, l2; LAS unsigned* o1s = (LAS unsigned*)(lds + att::L_O1 + wave * 8192) + lane;
                { float m1, l1;
                  att::attn_core_pp<1, 128>(base + 768 + h * 128, base + 1280 + h * 128, base + 1792 + h * 128, EVEN_IN, q0, 0, nt, lds, o2, m1, l1);
                  const float inv = __builtin_amdgcn_rcpf(l1 + __shfl_xor(l1, 32));
#pragma unroll
                  for (int db = 0; db < 4; ++db)
#pragma unroll
                      for (int k = 0; k < 8; ++k) o1s[(db * 8 + k) * 64] = att::cvtpk(o2[db][2 * k] * inv, o2[db][2 * k + 1] * inv); }
                att::attn_core_pp<1, 128>(base + 768 + h * 128 + 64, base + 1280 + h * 128 + 64, base + 1792 + h * 128, EVEN_IN, q0, 0, nt, lds, o2, m2, l2);
                { const float inv = lam * __builtin_amdgcn_rcpf(l2 + __shfl_xor(l2, 32)); float ss = 0.f;
#pragma unroll
                  for (int db = 0; db < 4; ++db)
#pragma unroll
                      for (int r = 0; r < 16; ++r) { const unsigned w = o1s[(db * 8 + (r >> 1)) * 64]; const float a1 = __uint_as_float((r & 1) ? (w & 0xffff0000u) : (w << 16));
                          const float v = a1 - inv * o2[db][r]; o2[db][r] = v; ss += v * v; }
                  ss += __shfl_xor(ss, 32);
                  const float rs = __builtin_amdgcn_rsqf(ss * (1.0f / 128.0f) + 1e-6f) * one_m_li;
                  const float* gn = a.diff_norm + e * 128;
#pragma unroll
                  for (int db = 0; db < 4; ++db)
#pragma unroll
                      for (int rg = 0; rg < 4; ++rg) { const f32x4 gv = *(const f32x4*)(gn + 32 * db + 8 * rg + 4 * hi);
#pragma unroll
                          for (int k = 0; k < 4; ++k) o2[db][4 * rg + k] *= rs * gv[k]; } }
                { int tb = threadIdx.x; asm volatile("" : "+v"(tb)); const int t2 = q0 + 32 * (tb >> 6) + (tb & 31);
                  att::store_ot<128>(o2, ao + ((size_t)b * SEQ + t2) * DM + 512 + h * 128, (tb >> 5) & 1); }
            }
#endif
#if PH_SWA
            for (int rep_ = 0; rep_ < REP_SWA; ++rep_)
            for (int uidx = vcu; uidx < 2048; uidx += G) {
                const int qb = uidx & 15, qh = (uidx >> 4) & 7, b = uidx >> 7, kvh = qh >> 2;
                { int tb = threadIdx.x; asm volatile("" : "+v"(tb)); const int dd = tb - 256;
                  btab[tb] = (dd < 0 || dd >= 128) ? -__builtin_inff() : a.rel_bias[T5B[dd] * 12 + qh] * att::LOG2E; }
                const bf16* base = proj + (size_t)b * SEQ * EVEN_IN;
                const int q0 = qb * 256, t = q0 + 32 * wave + l32;
                const int kt0 = (qb * 4 - 2 > 0) ? qb * 4 - 2 : 0, nt = qb * 4 + 4 - kt0;
                att::f32x16 o[2]; float m, l;
                att::attn_core_pp<2, 64>(base + qh * 64, base + 512 + kvh * 64, base + 640 + kvh * 64, EVEN_IN, q0, kt0, nt, lds, o, m, l);
                const float sk = a.sinks[e * 8 + qh] * att::LOG2E;
                const float inv = __builtin_amdgcn_rcpf(l + __shfl_xor(l, 32) + __builtin_amdgcn_exp2f(sk - m));
#pragma unroll
                for (int db = 0; db < 2; ++db)
#pragma unroll
                    for (int r = 0; r < 16; ++r) o[db][r] *= inv;
                att::store_ot<64>(o, ao + ((size_t)b * SEQ + t) * DM + qh * 64, hi);
            }
#endif
        } else {
#if PH_SB
            int tq = threadIdx.x; asm volatile("" : "+v"(tq)); const int lane = tq & 63, l32 = lane & 31, hi = lane >> 5;
            for (int rep_ = 0; rep_ < REP_SB; ++rep_)
            for (int uidx = bx; uidx < 4096; uidx += G) {
                const int bh = uidx & 255, qb = 15 - (uidx >> 8), b = bh >> 4, h = bh & 15;
                const bf16* base = proj + (size_t)b * SEQ * ODD_IN;
                const int q0 = qb * 256, nt = 4 * qb + 4, t = q0 + 32 * wave + l32;
                att::f32x16 o[2]; float P, dummy;
                att::attn_core<0, 64>(base + h * 64, base + 1024 + h * 64, base + 2048 + h * 64, ODD_IN, q0, nt - 1, nt, -1, lds, o, P, dummy);
                att::store_ot<64>(o, ao + ((size_t)b * SEQ + t) * DM + h * 64, hi);
            }
#endif
        }
        xcd_barrier(xbar);
        {
            const bf16* wt = even ? (const bf16*)(ws + WS_WOUTE) + (size_t)e * DM * DM : (const bf16*)(ws + WS_WOUTO) + (size_t)e * DM * DM;
            pg8::Gemm g{ao, wt, MTOK, DM, DM}; pg8::StaticOrder S; S.init(MTOK, DM, G, bx);
#if OUT_STAGGER_TICKS > 0
            { const unsigned long long t0 = __builtin_amdgcn_s_memrealtime(); const unsigned long long dly = (unsigned long long)(((bx >> 3) & (OUT_STAGGER_GROUPS - 1)) * OUT_STAGGER_TICKS);
              while (__builtin_amdgcn_s_memrealtime() - t0 < dly) __builtin_amdgcn_s_sleep(8); }
#endif
#if REP_OUT == 2
            { pg8::EpiResid Ed{xold, (float*)(ws + WS_PROJ), (bf16*)(ws + WS_PROJ + 256 * MiB), (float*)(ws + 800 * MiB)};
              pg8::gemm_phase<pg8::EpiResid, pg8::StaticOrder, true, true>(lds, g, S, Ed); }
#elif REP_OUT == 3
            { pg8::EpiScaleBf16 Ed{(bf16*)(ws + WS_PROJ), DM, ssq};
              pg8::gemm_phase<pg8::EpiScaleBf16, pg8::StaticOrder, true, true>(lds, g, S, Ed); }
#endif
#if RESID_BF16
            pg8::EpiResidB E{xb, xb, ssq};
            pg8::gemm_phase<pg8::EpiResidB, pg8::StaticOrder, true, true>(lds, g, S, E);
#else
            pg8::EpiResid E{xold, a.out, xb, ssq};
            pg8::gemm_phase<pg8::EpiResid, pg8::StaticOrder, true, true>(lds, g, S, E);
#endif
        }
        xcd_barrier(xbar);
        const bf16* wup = (const bf16*)(ws + WS_WUP) + (size_t)layer * DUP * DM;
        const bf16* wdn = (const bf16*)(ws + WS_WDN) + (size_t)layer * DM * DFF;
        for (int half = 0; half < 2; ++half) {
            const size_t r0 = (size_t)half * HALF_ROWS;
            {
                pg8::Gemm g{xb + r0 * DM, wup, HALF_ROWS, DUP, DM}; pg8::StaticOrder S; S.init(HALF_ROWS, DUP, G, bx);
                pg8::EpiScaleBf16 E{ubuf, DUP, ssq + r0 * 16};
                for (int rep_ = 0; rep_ < REP_UP; ++rep_)
                pg8::gemm_phase<pg8::EpiScaleBf16, pg8::StaticOrder, true, true>(lds, g, S, E);
            }
            xcd_barrier(xbar);
#if PH_CONV
            {
                const float* cw = a.ffn_conv + (size_t)layer * 3 * DUP; const float* cb = a.ffn_conv_b + (size_t)layer * DUP;
                constexpr int NCC = 6, NRC = HALF_ROWS / 32;
                int tq = threadIdx.x; asm volatile("" : "+v"(tq)); const int lane = tq & 63;
                for (int rep_ = 0; rep_ < REP_CONV; ++rep_)
                for (int it = gw; it < NCC * NRC; it += NGW) {
                    const int cc = it % NCC, rc = it / NCC, cgp = cc * 64 + lane;
                    if (cgp < DFF / 8) {
                        const int col = cgp * 8, row0 = rc * 32;
                        float wg[3][8], wv[3][8], bg[8], bv[8];
#pragma unroll
                        for (int tp = 0; tp < 3; ++tp)
#pragma unroll
                            for (int k = 0; k < 8; k += 4) { const f32x4 t1 = *(const f32x4*)(cw + tp * DUP + col + k), t2 = *(const f32x4*)(cw + tp * DUP + DFF + col + k);
#pragma unroll
                                for (int q = 0; q < 4; ++q) { wg[tp][k + q] = t1[q]; wv[tp][k + q] = t2[q]; } }
#pragma unroll
                        for (int k = 0; k < 8; k += 4) { const f32x4 t1 = *(const f32x4*)(cb + col + k), t2 = *(const f32x4*)(cb + DFF + col + k);
#pragma unroll
                            for (int q = 0; q < 4; ++q) { bg[k + q] = t1[q]; bv[k + q] = t2[q]; } }
                        float g2[8], g1[8], v2[8], v1[8];
                        const bool head = (row0 % SEQ) == 0;
                        {
                            v4u a2 = {0, 0, 0, 0}, a1 = {0, 0, 0, 0}, c2 = {0, 0, 0, 0}, c1 = {0, 0, 0, 0};
                            if (!head) { const bf16* up = ubuf + (size_t)(row0 - 2) * DUP + col; a2 = *(const v4u*)up; c2 = *(const v4u*)(up + DFF); a1 = *(const v4u*)(up + DUP); c1 = *(const v4u*)(up + DUP + DFF); }
#pragma unroll
                            for (int k = 0; k < 8; ++k) { const int sh = (k & 1) * 16;
                                g2[k] = __uint_as_float(((a2[k >> 1] >> sh) & 0xffffu) << 16); g1[k] = __uint_as_float(((a1[k >> 1] >> sh) & 0xffffu) << 16);
                                v2[k] = __uint_as_float(((c2[k >> 1] >> sh) & 0xffffu) << 16); v1[k] = __uint_as_float(((c1[k >> 1] >> sh) & 0xffffu) << 16); }
                        }
                        for (int r4 = 0; r4 < 32; r4 += 8) {
                            v4u av[8], cv[8];
#pragma unroll
                            for (int rr = 0; rr < 8; ++rr) { const bf16* up = ubuf + (size_t)(row0 + r4 + rr) * DUP + col;
                                av[rr] = __builtin_nontemporal_load((const v4u*)up); cv[rr] = __builtin_nontemporal_load((const v4u*)(up + DFF)); }
#pragma unroll
                            for (int rr = 0; rr < 8; ++rr) {
                                const v4u a0 = av[rr], c0 = cv[rr];
                                float res[8];
#pragma unroll
                                for (int k = 0; k < 8; ++k) { const int sh = (k & 1) * 16;
                                    const float g0 = __uint_as_float(((a0[k >> 1] >> sh) & 0xffffu) << 16), v0 = __uint_as_float(((c0[k >> 1] >> sh) & 0xffffu) << 16);
                                    const float gg = bg[k] + wg[0][k] * g2[k] + wg[1][k] * g1[k] + wg[2][k] * g0;
                                    const float vv = bv[k] + wv[0][k] * v2[k] + wv[1][k] * v1[k] + wv[2][k] * v0;
                                    const float sg = gg * __builtin_amdgcn_rcpf(1.0f + __builtin_amdgcn_exp2f(-gg * att::LOG2E));
                                    res[k] = sg * vv; g2[k] = g1[k]; g1[k] = g0; v2[k] = v1[k]; v1[k] = v0; }
                                v4u w; w.x = pk2(res[0], res[1]); w.y = pk2(res[2], res[3]); w.z = pk2(res[4], res[5]); w.w = pk2(res[6], res[7]);
                                *(v4u*)(gbuf + (size_t)(row0 + r4 + rr) * DFF + col) = w;
                            }
                        }
                    }
                }
            }
#endif
            xcd_barrier(xbar);
            {
                pg8::Gemm g{gbuf, wdn, HALF_ROWS, DM, DFF}; pg8::StaticOrder S; S.init(HALF_ROWS, DM, G, bx);
#if REP_DOWN > 1
                { pg8::EpiResid Ed{a.out + r0 * DM, (float*)(ws + 760 * MiB), (bf16*)(ws + 888 * MiB), (float*)(ws + 960 * MiB)};
                  pg8::gemm_phase<pg8::EpiResid, pg8::StaticOrder, true, true>(lds, g, S, Ed); }
#endif
#if RESID_BF16
                pg8::EpiResidB E{xb + r0 * DM, xb + r0 * DM, ssq + r0 * 16};
                pg8::gemm_phase<pg8::EpiResidB, pg8::StaticOrder, true, true>(lds, g, S, E);
#else
                pg8::EpiResid E{a.out + r0 * DM, a.out + r0 * DM, xb + r0 * DM, ssq + r0 * 16};
                pg8::gemm_phase<pg8::EpiResid, pg8::StaticOrder, true, true>(lds, g, S, E);
#endif
            }
            if (half == 1) xcd_barrier(xbar);
        }
    }
    { int tq = threadIdx.x; asm volatile("" : "+v"(tq)); const int lane = tq & 63;
    for (int m0 = 4 * gw; m0 < MTOK; m0 += 4 * NGW) {
#if RESID_BF16
        v2u win[4][4];
#pragma unroll
        for (int h4 = 0; h4 < 4; ++h4) { const v2u* xin = (const v2u*)(xb + (size_t)(m0 + h4) * DM) + lane;
#pragma unroll
            for (int j = 0; j < 4; ++j) win[h4][j] = __builtin_nontemporal_load(xin + 64 * j); }
#endif
#pragma unroll
        for (int h4 = 0; h4 < 4; ++h4) { const int m = m0 + h4;
            f32x4* xr = (f32x4*)(a.out + (size_t)m * DM) + lane; f32x4 v[4]; float s = 0.f;
#if RESID_BF16
#pragma unroll
            for (int j = 0; j < 4; ++j) { const v2u w = win[h4][j]; v[j][0] = __uint_as_float(w.x << 16); v[j][1] = __uint_as_float(w.x & 0xffff0000u); v[j][2] = __uint_as_float(w.y << 16); v[j][3] = __uint_as_float(w.y & 0xffff0000u);
                s += (v[j][0] * v[j][0] + v[j][1] * v[j][1]) + (v[j][2] * v[j][2] + v[j][3] * v[j][3]); }
#else
#pragma unroll
            for (int j = 0; j < 4; ++j) { v[j] = xr[64 * j]; s += (v[j][0] * v[j][0] + v[j][1] * v[j][1]) + (v[j][2] * v[j][2] + v[j][3] * v[j][3]); }
#endif
            s = wave_sum(s);
            const float rs = __builtin_amdgcn_rsqf(s * (1.0f / DM) + 1e-6f);
#pragma unroll
            for (int j = 0; j < 4; ++j) { const f32x4 gv = *((const f32x4*)a.norm_final + lane + 64 * j); xr[64 * j] = v[j] * rs * gv; } }
    } }
}

extern "C" void kernel_launch(void* const* d_in, const int* in_sizes, int n_in, void* d_out, int out_size, void* d_ws, size_t ws_size, hipStream_t stream) {
    static int grid = 0;
    if (grid == 0) {
        int dev = 0, cus = 0, per_cu = 0;
        (void)hipGetDevice(&dev);
        (void)hipDeviceGetAttribute(&cus, hipDeviceAttributeMultiprocessorCount, dev);
        (void)hipFuncSetAttribute((const void*)mega_fwd, hipFuncAttributeMaxDynamicSharedMemorySize, LDS_BYTES);
        (void)hipOccupancyMaxActiveBlocksPerMultiprocessor(&per_cu, (const void*)mega_fwd, NWAVES * 64, LDS_BYTES);
        if (per_cu < 1) per_cu = 1;
        grid = cus * per_cu;
        if (n_in != 19 || ws_size < 1024 * MiB) fprintf(stderr, "kernel_launch: unexpected n_in %d / ws %zu\n", n_in, ws_size);
    }
    Args a{};
    a.x = (const float*)d_in[0]; a.rel_bias = (const float*)d_in[1]; a.norm_mix = (const float*)d_in[2]; a.norm_ffn = (const float*)d_in[3]; a.norm_final = (const float*)d_in[4];
    a.w_in_even = (const float*)d_in[5]; a.w_out_even = (const float*)d_in[6]; a.sinks = (const float*)d_in[7]; a.lam_q1 = (const float*)d_in[8]; a.lam_k1 = (const float*)d_in[9];
    a.lam_q2 = (const float*)d_in[10]; a.lam_k2 = (const float*)d_in[11]; a.diff_norm = (const float*)d_in[12]; a.w_in_odd = (const float*)d_in[13]; a.w_out_odd = (const float*)d_in[14];
    a.ffn_up = (const float*)d_in[15]; a.ffn_conv = (const float*)d_in[16]; a.ffn_conv_b = (const float*)d_in[17]; a.ffn_down = (const float*)d_in[18];
    a.out = (float*)d_out; a.ws = (unsigned char*)d_ws;
    void* args[] = {&a};
    hipError_t err = hipLaunchCooperativeKernel((const void*)mega_fwd, dim3(grid), dim3(NWAVES * 64), args, LDS_BYTES, stream);
    if (err != hipSuccess) fprintf(stderr, "kernel_launch: cooperative launch failed: %s (grid %d)\n", hipGetErrorString(err), grid);
}
```

```cpp
#include <hip/hip_runtime.h>
#include <hip/hip_cooperative_groups.h>
#include <cstdio>
#include <cstdint>
namespace cg = cooperative_groups;
namespace pg8 {
#define PG8_LAS __attribute__((address_space(3)))
typedef unsigned short bf16_t;
typedef short bf16x8 __attribute__((ext_vector_type(8)));
typedef float f32x4 __attribute__((ext_vector_type(4)));
typedef unsigned u32x4 __attribute__((ext_vector_type(4)));
constexpr int BM = 256, BK = 64, HALF = 128, HTB = HALF * BK * 2  , STAGE_BYTES = 8 * HTB, NXCD = 8, WGM = 8;

__host__ __device__ __forceinline__ int lds_byte(int r, int c) { const int st = (r >> 4) * 2 + (c >> 5), rr = r & 15, cc = c & 31, ob = rr * 64 + cc * 2; return st * 1024 + (ob ^ (((ob >> 9) & 1) << 5)); }
__host__ __device__ __forceinline__ void stage_rc(int b, int& R, int& C) { const int st = b / 1024, sb = b % 1024, swz = sb ^ (((sb >> 9) & 1) << 5); R = (st >> 1) * 16 + swz / 64; C = (st & 1) * 32 + (swz % 64) / 2; }
__host__ __device__ __forceinline__ int perm32(int rho) { const int n = rho >> 4, i = rho & 15; return 8 * (i >> 2) + 4 * n + (i & 3); }

struct Unit { int pm, pn; };
struct Gemm { const bf16_t* A; const bf16_t* Bt; int M, N, K; };

struct StaticOrder {
    int nM, nN, nwg, G, c;
    __host__ __device__ void init(int M, int N, int G_, int c_) { nM = M / BM; nN = N / BM; nwg = nM * nN; G = G_; c = c_; }
    __host__ __device__ bool next(int i, Unit& u) const {
        const long L = (long)i * G + c; if (L >= nwg) return false;
        int wgid = (int)L; { const int q = nwg / NXCD, r = nwg % NXCD, xcd = wgid % NXCD, off = wgid / NXCD; wgid = (xcd < r ? xcd * (q + 1) : r * (q + 1) + (xcd - r) * q) + off; }
        const int nig = WGM * nN, gid = wgid / nig, fm = gid * WGM, gsz = (nM - fm) < WGM ? (nM - fm) : WGM;
        u.pm = fm + ((wgid % nig) % gsz); u.pn = (wgid % nig) / gsz; return true;
    }
    __device__ __forceinline__ void a_ready(const Unit&) const {}
    __device__ __forceinline__ void done(const Unit&) const {}
};

__device__ __forceinline__ unsigned cvt_pk_bf16(float lo, float hi) { unsigned r; asm volatile("v_cvt_pk_bf16_f32 %0, %1, %2" : "=v"(r) : "v"(lo), "v"(hi)); return r; }
typedef float f32x2 __attribute__((ext_vector_type(2)));
typedef unsigned u32x2 __attribute__((ext_vector_type(2)));
constexpr float RMS_EPS = 1e-6f;
struct EpiScaleBf16 {
    static constexpr bool PERM = true, AFTER_DRAIN = false;
    bf16_t* O; int ldc; const float* ssq;
    __device__ __forceinline__ void operator()(const f32x4 (&acc)[2][2][4][2], const Unit& u, int wr, int wc, int fr, int fq) const {
        const int row0 = u.pm * BM + wr * 64 + fr, col0 = u.pn * BM + wc * 32 + 8 * fq;
        f32x4 part[2][4];
#pragma unroll
        for (int ai = 0; ai < 2; ++ai)
#pragma unroll
            for (int m = 0; m < 4; ++m) part[ai][m] = *(const f32x4*)(ssq + (size_t)(row0 + ai * HALF + m * 16) * 16 + fq * 4);
#pragma unroll
        for (int ai = 0; ai < 2; ++ai)
#pragma unroll
            for (int m = 0; m < 4; ++m) { const int row = row0 + ai * HALF + m * 16; bf16_t* rowp = O + (size_t)row * ldc + col0;
                float t = (part[ai][m][0] + part[ai][m][1]) + (part[ai][m][2] + part[ai][m][3]);
                t += __shfl_xor(t, 16); t += __shfl_xor(t, 32);
                const float rs = __builtin_amdgcn_rsqf(t * (1.0f / 1024.0f) + RMS_EPS);
#pragma unroll
                for (int bj = 0; bj < 2; ++bj) { const f32x4 v0 = acc[ai][bj][m][0] * rs, v1 = acc[ai][bj][m][1] * rs;
                    u32x4 w; w.x = cvt_pk_bf16(v0[0], v0[1]); w.y = cvt_pk_bf16(v0[2], v0[3]); w.z = cvt_pk_bf16(v1[0], v1[1]); w.w = cvt_pk_bf16(v1[2], v1[3]);
                    *(u32x4*)(rowp + bj * HALF) = w; } }
    }
};
struct EpiResid {
    static constexpr bool PERM = true, AFTER_DRAIN = false;
    const float* base; float* out; bf16_t* xb; float* ssq;
    __device__ __forceinline__ void operator()(const f32x4 (&acc)[2][2][4][2], const Unit& u, int wr, int wc, int fr, int fq) const {
        const int col0 = u.pn * BM + wc * 32 + 8 * fq;
        const size_t off0 = (size_t)(u.pm * BM + wr * 64 + fr) * 1024 + col0;
        f32x4 nx[2][2][2];
#pragma unroll
        for (int g = 0; g < 2; ++g) { const size_t offn = off0 + (size_t)(g * 16) * 1024;
#pragma unroll
            for (int bj = 0; bj < 2; ++bj)
#pragma unroll
                for (int n = 0; n < 2; ++n) nx[g][bj][n] = *(const f32x4*)(base + offn + bj * HALF + n * 4); }
        asm volatile("" ::: "memory");
#pragma unroll
        for (int g = 0; g < 8; ++g) { const int ai = g >> 2, m = g & 3; const int row = u.pm * BM + ai * HALF + wr * 64 + m * 16 + fr; const size_t off = (size_t)row * 1024 + col0; float q = 0.f;
            f32x4 cu[2][2];
#pragma unroll
            for (int bj = 0; bj < 2; ++bj)
#pragma unroll
                for (int n = 0; n < 2; ++n) cu[bj][n] = nx[g & 1][bj][n];
            if (g < 6) { const size_t offn = off0 + (size_t)(((g + 2) >> 2) * HALF + ((g + 2) & 3) * 16) * 1024;
#pragma unroll
                for (int bj = 0; bj < 2; ++bj)
#pragma unroll
                    for (int n = 0; n < 2; ++n) nx[g & 1][bj][n] = *(const f32x4*)(base + offn + bj * HALF + n * 4); }
#pragma unroll
            for (int bj = 0; bj < 2; ++bj) { const f32x4 o0 = cu[bj][0] + acc[ai][bj][m][0], o1 = cu[bj][1] + acc[ai][bj][m][1];
                *(f32x4*)(out + off + bj * HALF) = o0; *(f32x4*)(out + off + bj * HALF + 4) = o1;
                q += ((o0[0] * o0[0] + o0[1] * o0[1]) + (o0[2] * o0[2] + o0[3] * o0[3])) + ((o1[0] * o1[0] + o1[1] * o1[1]) + (o1[2] * o1[2] + o1[3] * o1[3]));
                u32x4 w; w.x = cvt_pk_bf16(o0[0], o0[1]); w.y = cvt_pk_bf16(o0[2], o0[3]); w.z = cvt_pk_bf16(o1[0], o1[1]); w.w = cvt_pk_bf16(o1[2], o1[3]);
                *(u32x4*)(xb + off + bj * HALF) = w; }
            q += __shfl_xor(q, 16); q += __shfl_xor(q, 32);
            if (fq == 0) ssq[(size_t)row * 16 + u.pn * 4 + wc] = q;
            asm volatile("" ::: "memory"); }
    }
};

struct EpiResidB {
    static constexpr bool PERM = true, AFTER_DRAIN = false;
    const bf16_t* base; bf16_t* xb; float* ssq;
    __device__ __forceinline__ void operator()(const f32x4 (&acc)[2][2][4][2], const Unit& u, int wr, int wc, int fr, int fq) const {
        const int col0 = u.pn * BM + wc * 32 + 8 * fq;
        const size_t off0 = (size_t)(u.pm * BM + wr * 64 + fr) * 1024 + col0;
        u32x4 nx[4][2];
#pragma unroll
        for (int g = 0; g < 4; ++g)
#pragma unroll
            for (int bj = 0; bj < 2; ++bj) nx[g][bj] = *(const u32x4*)(base + off0 + (size_t)(g * 16) * 1024 + bj * HALF);
        asm volatile("" ::: "memory");
#pragma unroll
        for (int g = 0; g < 8; ++g) { const int ai = g >> 2, m = g & 3; const int row = u.pm * BM + ai * HALF + wr * 64 + m * 16 + fr; const size_t off = (size_t)row * 1024 + col0; float q = 0.f;
            u32x4 cu[2];
#pragma unroll
            for (int bj = 0; bj < 2; ++bj) cu[bj] = nx[g & 3][bj];
            if (g < 4) { const size_t offn = off0 + (size_t)(((g + 4) >> 2) * HALF + ((g + 4) & 3) * 16) * 1024;
#pragma unroll
                for (int bj = 0; bj < 2; ++bj) nx[g & 3][bj] = *(const u32x4*)(base + offn + bj * HALF); }
#pragma unroll
            for (int bj = 0; bj < 2; ++bj) {
                f32x4 o0, o1;
                o0[0] = __uint_as_float(cu[bj].x << 16) + acc[ai][bj][m][0][0]; o0[1] = __uint_as_float(cu[bj].x & 0xffff0000u) + acc[ai][bj][m][0][1];
                o0[2] = __uint_as_float(cu[bj].y << 16) + acc[ai][bj][m][0][2]; o0[3] = __uint_as_float(cu[bj].y & 0xffff0000u) + acc[ai][bj][m][0][3];
                o1[0] = __uint_as_float(cu[bj].z << 16) + acc[ai][bj][m][1][0]; o1[1] = __uint_as_float(cu[bj].z & 0xffff0000u) + acc[ai][bj][m][1][1];
                o1[2] = __uint_as_float(cu[bj].w << 16) + acc[ai][bj][m][1][2]; o1[3] = __uint_as_float(cu[bj].w & 0xffff0000u) + acc[ai][bj][m][1][3];
                q += ((o0[0] * o0[0] + o0[1] * o0[1]) + (o0[2] * o0[2] + o0[3] * o0[3])) + ((o1[0] * o1[0] + o1[1] * o1[1]) + (o1[2] * o1[2] + o1[3] * o1[3]));
                u32x4 w; w.x = cvt_pk_bf16(o0[0], o0[1]); w.y = cvt_pk_bf16(o0[2], o0[3]); w.z = cvt_pk_bf16(o1[0], o1[1]); w.w = cvt_pk_bf16(o1[2], o1[3]);
                *(u32x4*)(xb + off + bj * HALF) = w; }
            q += __shfl_xor(q, 16); q += __shfl_xor(q, 32);
            if (fq == 0) ssq[(size_t)row * 16 + u.pn * 4 + wc] = q;
            asm volatile("" ::: "memory"); }
    }
};
template <class Epi, class Sched, bool ALIGN_EPI = false, bool SP2 = false>
__device__ __forceinline__ void gemm_phase(PG8_LAS unsigned char* lds, const Gemm g, const Sched& S, const Epi& E) {
    int tid_ = threadIdx.x; asm volatile("" : "+v"(tid_));
    const int tid = tid_, wid = __builtin_amdgcn_readfirstlane(tid >> 6), lane = tid & 63, wr = wid >> 2, wc = wid & 3, fr = lane & 15, fq = lane >> 4;
    const int K = g.K, nt = K / BK;
    unsigned voffA[2], voffB[2];
#pragma unroll
    for (int i = 0; i < 2; ++i) { int R, C; stage_rc(tid * 16 + i * 8192, R, C); const int Rb = Epi::PERM ? ((R & ~31) + perm32(R & 31)) : R;
        voffA[i] = (unsigned)(R * K + C) * 2u; voffB[i] = (unsigned)(Rb * K + C) * 2u; }
    const size_t kstep = (size_t)(BK * 2);
    const size_t hstep = (size_t)HALF * K * 2;
    const size_t tstep = 2 * hstep;
    const unsigned ldsw = (unsigned)wid * 1024u;
    const int aoff = lds_byte(wr * 64 + fr, fq * 8), boff = lds_byte(wc * 32 + fr, fq * 8);
#define PG8_SA(b, h) (((b) * 2 + (h)) * HTB)
#define PG8_SB(b, h) ((4 + (b) * 2 + (h)) * HTB)
#define PG8_STAGE(bufoff, gbase, voff) do { _Pragma("unroll") for (int _i = 0; _i < 2; ++_i) \
        __builtin_amdgcn_global_load_lds((const unsigned*)((const char*)(gbase) + (voff)[_i]), (PG8_LAS unsigned*)(lds + (bufoff) + ldsw + _i * 8192), 16, 0, 0); } while (0)
#define PG8_LDA(dst, b, h) do { _Pragma("unroll") for (int m = 0; m < 4; ++m) _Pragma("unroll") for (int k = 0; k < 2; ++k) dst[m][k] = *(const PG8_LAS bf16x8*)(lds + PG8_SA(b, h) + aoff + m * 2048 + k * 1024); } while (0)
#define PG8_LDB(dst, b, h) do { _Pragma("unroll") for (int n = 0; n < 2; ++n) _Pragma("unroll") for (int k = 0; k < 2; ++k) dst[n][k] = *(const PG8_LAS bf16x8*)(lds + PG8_SB(b, h) + boff + n * 2048 + k * 1024); } while (0)
#define PG8_MMA(ai, bj, At, Bt) do { __builtin_amdgcn_s_setprio(1); _Pragma("unroll") for (int m = 0; m < 4; ++m) _Pragma("unroll") for (int n = 0; n < 2; ++n) _Pragma("unroll") for (int k = 0; k < 2; ++k) \
        acc[ai][bj][m][n] = __builtin_amdgcn_mfma_f32_16x16x32_bf16(Bt[n][k], At[m][k], acc[ai][bj][m][n], 0, 0, 0); __builtin_amdgcn_s_setprio(0); } while (0)
#define PG8_WAIT_V(n) asm volatile("s_waitcnt vmcnt(" #n ")" ::: "memory")
#define PG8_WAIT_L(n) asm volatile("s_waitcnt lgkmcnt(" #n ")" ::: "memory")
#define PG8_BAR __builtin_amdgcn_s_barrier()
#define PG8_SCHED __builtin_amdgcn_sched_barrier(0)
    Unit cur, nxt; int ui = 0;
    if (!S.next(0, cur)) return;
    f32x4 acc[2][2][4][2];
#pragma unroll
    for (int a = 0; a < 2; ++a)
#pragma unroll
        for (int b = 0; b < 2; ++b)
#pragma unroll
            for (int m = 0; m < 4; ++m)
#pragma unroll
                for (int n = 0; n < 2; ++n) acc[a][b][m][n] = (f32x4){0.f, 0.f, 0.f, 0.f};
    bf16x8 At[4][2], B0[2][2], B1[2][2];
    const char* cA = (const char*)g.A + (size_t)cur.pm * tstep; const char* cB = (const char*)g.Bt + (size_t)cur.pn * tstep;
    S.a_ready(cur);
    if constexpr (SP2) {
        PG8_STAGE(PG8_SB(0, 0), cB, voffB); PG8_STAGE(PG8_SB(0, 1), cB + hstep, voffB); PG8_STAGE(PG8_SA(0, 0), cA, voffA); PG8_STAGE(PG8_SA(0, 1), cA + hstep, voffA);
        if (wr == 1) PG8_BAR;
        PG8_WAIT_V(2); PG8_BAR;
        PG8_STAGE(PG8_SB(1, 0), cB + kstep, voffB); PG8_STAGE(PG8_SA(1, 0), cA + kstep, voffA); PG8_STAGE(PG8_SB(1, 1), cB + hstep + kstep, voffB);
        PG8_WAIT_V(6); PG8_BAR;
    } else {
        PG8_STAGE(PG8_SB(0, 0), cB, voffB); PG8_STAGE(PG8_SA(0, 0), cA, voffA); PG8_STAGE(PG8_SB(0, 1), cB + hstep, voffB); PG8_STAGE(PG8_SA(0, 1), cA + hstep, voffA);
        if (wr == 1) PG8_BAR;
        PG8_WAIT_V(4); PG8_BAR;
        PG8_STAGE(PG8_SB(1, 0), cB + kstep, voffB); PG8_STAGE(PG8_SA(1, 0), cA + kstep, voffA); PG8_STAGE(PG8_SB(1, 1), cB + hstep + kstep, voffB);
        PG8_WAIT_V(6); PG8_BAR;
    }
    for (;;) {
        const bool has_next = S.next(ui + 1, nxt);
        const char* nA = has_next ? (const char*)g.A + (size_t)nxt.pm * tstep : cA; const char* nB = has_next ? (const char*)g.Bt + (size_t)nxt.pn * tstep : cB;
        for (int t = 0; t < nt; t += 2) {
            const bool last = (t == nt - 2);
            const char* a1 = cA + (size_t)(t + 1) * kstep;
            const char* a2 = last ? nA : cA + (size_t)(t + 2) * kstep; const char* b2 = last ? nB : cB + (size_t)(t + 2) * kstep;
            const char* a3 = a2 + kstep; const char* b3 = b2 + kstep;
            if (last && has_next) S.a_ready(nxt);
            if constexpr (SP2) {
            PG8_LDB(B0, 0, 0); PG8_LDB(B1, 0, 1); PG8_SCHED; PG8_LDA(At, 0, 0); PG8_STAGE(PG8_SA(1, 1), a1 + hstep, voffA);
            PG8_WAIT_V(8); PG8_WAIT_L(0); PG8_BAR; PG8_MMA(0, 0, At, B0); PG8_MMA(0, 1, At, B1); PG8_BAR; PG8_SCHED;
            PG8_LDA(At, 0, 1); PG8_STAGE(PG8_SB(0, 0), b2, voffB); PG8_STAGE(PG8_SB(0, 1), b2 + hstep, voffB); PG8_STAGE(PG8_SA(0, 0), a2, voffA);
            PG8_WAIT_V(8); PG8_WAIT_L(0); PG8_BAR; PG8_MMA(1, 0, At, B0); PG8_MMA(1, 1, At, B1); PG8_BAR; PG8_SCHED;
            PG8_LDB(B0, 1, 0); PG8_LDB(B1, 1, 1); PG8_SCHED; PG8_LDA(At, 1, 0); PG8_STAGE(PG8_SA(0, 1), a2 + hstep, voffA);
            PG8_WAIT_V(8); PG8_WAIT_L(0); PG8_BAR; PG8_MMA(0, 0, At, B0); PG8_MMA(0, 1, At, B1); PG8_BAR; PG8_SCHED;
            PG8_LDA(At, 1, 1); PG8_STAGE(PG8_SB(1, 0), b3, voffB); PG8_STAGE(PG8_SB(1, 1), b3 + hstep, voffB); PG8_STAGE(PG8_SA(1, 0), a3, voffA);
            PG8_WAIT_V(8); PG8_WAIT_L(0); PG8_BAR; PG8_MMA(1, 0, At, B0); PG8_MMA(1, 1, At, B1); PG8_BAR; PG8_SCHED;
            } else {
            PG8_LDB(B0, 0, 0); PG8_SCHED; PG8_LDA(At, 0, 0); PG8_STAGE(PG8_SA(1, 1), a1 + hstep, voffA);
            PG8_WAIT_L(8); PG8_BAR; PG8_WAIT_L(0); PG8_MMA(0, 0, At, B0); PG8_BAR; PG8_SCHED;
            PG8_LDB(B1, 0, 1); PG8_STAGE(PG8_SB(0, 0), b2, voffB);
            PG8_BAR; PG8_WAIT_L(0); PG8_MMA(0, 1, At, B1); PG8_BAR;
            PG8_LDA(At, 0, 1); PG8_STAGE(PG8_SA(0, 0), a2, voffA);
            PG8_BAR; PG8_WAIT_L(0); PG8_MMA(1, 0, At, B0); PG8_BAR; PG8_SCHED;
            PG8_STAGE(PG8_SB(0, 1), b2 + hstep, voffB);
            PG8_WAIT_V(6); PG8_BAR; PG8_MMA(1, 1, At, B1); PG8_BAR;
            PG8_LDB(B0, 1, 0); PG8_SCHED; PG8_LDA(At, 1, 0); PG8_STAGE(PG8_SA(0, 1), a2 + hstep, voffA);
            PG8_WAIT_L(8); PG8_BAR; PG8_WAIT_L(0); PG8_MMA(0, 0, At, B0); PG8_BAR; PG8_SCHED;
            PG8_LDB(B1, 1, 1); PG8_STAGE(PG8_SB(1, 0), b3, voffB);
            PG8_BAR; PG8_WAIT_L(0); PG8_MMA(0, 1, At, B1); PG8_BAR;
            PG8_LDA(At, 1, 1); PG8_STAGE(PG8_SA(1, 0), a3, voffA);
            PG8_BAR; PG8_WAIT_L(0); PG8_MMA(1, 0, At, B0); PG8_BAR; PG8_SCHED;
            PG8_STAGE(PG8_SB(1, 1), b3 + hstep, voffB);
            PG8_WAIT_V(6); PG8_BAR; PG8_MMA(1, 1, At, B1); PG8_BAR;
            }
        }
        if constexpr (ALIGN_EPI) { if (wr == 0) PG8_BAR; }
        if constexpr (!Epi::AFTER_DRAIN) { E(acc, cur, wr, wc, fr, fq); S.done(cur); }
        if (!has_next) break;
#pragma unroll
        for (int a = 0; a < 2; ++a)
#pragma unroll
            for (int b = 0; b < 2; ++b)
#pragma unroll
                for (int m = 0; m < 4; ++m)
#pragma unroll
                    for (int n = 0; n < 2; ++n) acc[a][b][m][n] = (f32x4){0.f, 0.f, 0.f, 0.f};
        cur = nxt; cA = nA; cB = nB; ++ui;
        if constexpr (ALIGN_EPI) { if (wr == 1) PG8_BAR; }
    }
    PG8_WAIT_V(0);
    if constexpr (!ALIGN_EPI) { if (wr == 0) PG8_BAR; }
    PG8_BAR;
    if constexpr (Epi::AFTER_DRAIN) { E.fused(acc, cur, wr, wc, fr, fq, lds, wid, lane); S.done(cur); }
#undef PG8_SA
#undef PG8_SB
#undef PG8_STAGE
#undef PG8_LDA
#undef PG8_LDB
#undef PG8_MMA
#undef PG8_WAIT_V
#undef PG8_WAIT_L
#undef PG8_BAR
#undef PG8_SCHED
}
}
namespace att {
#define ALAS __attribute__((address_space(3)))
typedef unsigned short bf16_t;
typedef short bf16x8 __attribute__((ext_vector_type(8)));
typedef float f32x16 __attribute__((ext_vector_type(16)));
typedef float f32x4 __attribute__((ext_vector_type(4)));
typedef unsigned u32x4 __attribute__((ext_vector_type(4)));
typedef unsigned u32x2 __attribute__((ext_vector_type(2)));
constexpr int KROW = 144;
constexpr int KBUF = 64 * KROW;
constexpr int VBUF = 64 * 320;
template <int DV> struct VRow { static constexpr int B = (DV == 128) ? 320 : 192; };
constexpr int L_K = 0, L_V = 2 * KBUF, L_BT = L_V + 2 * VBUF, L_END = L_BT + 2048;
constexpr int L_O1 = L_END;
constexpr int L_QS = L_O1 + 65536;
constexpr float LOG2E = 1.4426950408889634f;
constexpr float QSCALE = 0.125f * 1.4426950408889634f;
#define CR(r) (((r) & 3) + 8 * ((r) >> 2))
typedef float f32x2_t __attribute__((ext_vector_type(2))); typedef __bf16 bf16x2_t __attribute__((ext_vector_type(2)));
__device__ __forceinline__ unsigned cvtpk(float lo, float hi) { f32x2_t v = {lo, hi}; bf16x2_t b = __builtin_convertvector(v, bf16x2_t); return __builtin_bit_cast(unsigned, b); }
__device__ __forceinline__ unsigned cvtpk_a(float lo, float hi) { unsigned r; asm volatile("v_cvt_pk_bf16_f32 %0, %1, %2" : "=v"(r) : "v"(lo), "v"(hi)); return r; }
__device__ __forceinline__ float ex2(float x) { return __builtin_amdgcn_exp2f(x); }
__device__ __forceinline__ float rcpf_(float x) { return __builtin_amdgcn_rcpf(x); }

typedef short v4i16_t __attribute__((ext_vector_type(4)));
__device__ __forceinline__ v4i16_t vtr(const ALAS unsigned char* p) { return __builtin_amdgcn_ds_read_tr16_b64_v4i16((ALAS v4i16_t*)p); }
template <int DV> __device__ __forceinline__ bf16x8 vfrag(const ALAS unsigned char* vb, int s, int db) {
    const v4i16_t lo = vtr(vb + (16 * s) * VRow<DV>::B + 64 * db), hi4 = vtr(vb + (16 * s + 8) * VRow<DV>::B + 64 * db);
    return __builtin_shufflevector(lo, hi4, 0, 1, 2, 3, 4, 5, 6, 7);
}
template <int DV> __device__ __forceinline__ int vtr_lane_off(int lane) { return (4 * (lane >> 5) + ((lane & 15) >> 2)) * VRow<DV>::B + (16 * ((lane >> 4) & 1) + 4 * (lane & 3)) * 2; }
__device__ __forceinline__ float pair_max(float x) { auto rr = __builtin_amdgcn_permlane32_swap(__float_as_uint(x), __float_as_uint(x), false, false); return fmaxf(__uint_as_float(rr[0]), __uint_as_float(rr[1])); }
template <int DV> struct Pref { u32x4 k; u32x4 v[DV / 64]; };

template <int DV> __device__ __forceinline__ void tile_load(Pref<DV>& pf, const bf16_t* Kp, const bf16_t* Vp, int pitch, int kt, int tid) {
    const int krow = tid >> 3, kc = (tid & 7) * 8;
    pf.k = *(const u32x4*)(Kp + (size_t)(kt * 64 + krow) * pitch + kc);
#pragma unroll
    for (int i = 0; i < DV / 64; ++i) { const int c = tid + i * 512, vrow = c / (DV / 8), vc = (c % (DV / 8)) * 8;
        pf.v[i] = *(const u32x4*)(Vp + (size_t)(kt * 64 + vrow) * pitch + vc); }
}
template <int DV> __device__ __forceinline__ void tile_store(const Pref<DV>& pf, ALAS unsigned char* kbuf, ALAS unsigned char* vbuf, int tid) {
    const int krow = tid >> 3, kc = (tid & 7) * 8;
    *(ALAS u32x4*)(kbuf + krow * KROW + kc * 2) = pf.k;
#pragma unroll
    for (int i = 0; i < DV / 64; ++i) { const int c = tid + i * 512, vrow = c / (DV / 8), vc = (c % (DV / 8)) * 8;
        *(ALAS u32x4*)(vbuf + vrow * VRow<DV>::B + vc * 2) = pf.v[i]; }
}

template <int DV> __device__ __forceinline__ void pv_slab(const ALAS unsigned char* vbuf, int s, u32x4 w, f32x16 (&o)[DV / 32], int l32, int hi) {
    const bf16x8 pfr = __builtin_bit_cast(bf16x8, w);
#pragma unroll
    for (int db = 0; db < DV / 32; ++db) {
        const bf16x8 vf = vfrag<DV>(vbuf + vtr_lane_off<DV>(l32 + 32 * hi), s, db);
        o[db] = __builtin_amdgcn_mfma_f32_32x32x16_bf16(vf, pfr, o[db], 0, 0, 0); }
    if (DV > 64) __builtin_amdgcn_sched_barrier(0);
}

template <int MODE, int DV, bool MASKED>
__device__ __forceinline__ void tile_compute(const ALAS unsigned char* kbuf, const ALAS unsigned char* vbuf, const bf16x8 (&qf)[4], f32x16 (&o)[DV / 32],
                                             float& st_m, float& st_l, int lim, const ALAS float* btab, float cbias, int lane) {
    const int l32 = lane & 31, hi = lane >> 5;
    if constexpr (MODE == 0) {
        f32x16 p0, p1;
#pragma unroll
        for (int r = 0; r < 16; ++r) { p0[r] = 0.f; p1[r] = 0.f; }
        { const ALAS unsigned char* kb = kbuf + l32 * KROW + hi * 16;
#pragma unroll
          for (int d0 = 0; d0 < 4; ++d0) {
              const bf16x8 k0 = *(const ALAS bf16x8*)(kb + d0 * 32);
              const bf16x8 k1 = *(const ALAS bf16x8*)(kb + 32 * KROW + d0 * 32);
              p0 = __builtin_amdgcn_mfma_f32_32x32x16_bf16(k0, qf[d0], p0, 0, 0, 0);
              p1 = __builtin_amdgcn_mfma_f32_32x32x16_bf16(k1, qf[d0], p1, 0, 0, 0); } }
        __builtin_amdgcn_sched_barrier(0);
#pragma unroll
        for (int r = 0; r < 16; ++r) {
            float a = rcpf_(1.0f + ex2(p0[r])), b = rcpf_(1.0f + ex2(p1[r]));
            if (MASKED) { a = (CR(r) < lim) ? a : 1.0f; b = (CR(r) + 32 < lim) ? b : 1.0f; }
            p0[r] = a; p1[r] = b; }
        float g[8], hs[8], pr[8];
#pragma unroll
        for (int i = 0; i < 4; ++i) { g[i] = (p0[4 * i] * p0[4 * i + 1]) * (p0[4 * i + 2] * p0[4 * i + 3]); g[4 + i] = (p1[4 * i] * p1[4 * i + 1]) * (p1[4 * i + 2] * p1[4 * i + 3]); }
#pragma unroll
        for (int i = 0; i < 8; ++i) { auto rr = __builtin_amdgcn_permlane32_swap(__float_as_uint(g[i]), __float_as_uint(g[i]), false, false);
            pr[i] = __uint_as_float(rr[0]) * __uint_as_float(rr[1]); hs[i] = hi ? 1.0f : __uint_as_float(rr[1]); }
        float T = st_m;
#pragma unroll
        for (int i = 7; i >= 0; --i) {
            float R = hs[i] * T; T = T * pr[i];
            if (i >= 4) { const int b = 4 * (i - 4);
                float R2 = R * p1[b + 3]; p1[b + 3] = R - R2; float R1 = R2 * p1[b + 2]; p1[b + 2] = R2 - R1; float R0 = R1 * p1[b + 1]; p1[b + 1] = R1 - R0; p1[b] = R0 - R0 * p1[b]; }
            else { const int b = 4 * i;
                float R2 = R * p0[b + 3]; p0[b + 3] = R - R2; float R1 = R2 * p0[b + 2]; p0[b + 2] = R2 - R1; float R0 = R1 * p0[b + 1]; p0[b + 1] = R1 - R0; p0[b] = R0 - R0 * p0[b]; }
        }
        st_m = T;
        __builtin_amdgcn_sched_barrier(0);
#pragma unroll
        for (int s = 0; s < 4; ++s) {
            u32x4 w;
            if (s == 0) { w.x = cvtpk(p0[0], p0[1]); w.y = cvtpk(p0[2], p0[3]); w.z = cvtpk(p0[4], p0[5]); w.w = cvtpk(p0[6], p0[7]); }
            else if (s == 1) { w.x = cvtpk(p0[8], p0[9]); w.y = cvtpk(p0[10], p0[11]); w.z = cvtpk(p0[12], p0[13]); w.w = cvtpk(p0[14], p0[15]); }
            else if (s == 2) { w.x = cvtpk(p1[0], p1[1]); w.y = cvtpk(p1[2], p1[3]); w.z = cvtpk(p1[4], p1[5]); w.w = cvtpk(p1[6], p1[7]); }
            else { w.x = cvtpk(p1[8], p1[9]); w.y = cvtpk(p1[10], p1[11]); w.z = cvtpk(p1[12], p1[13]); w.w = cvtpk(p1[14], p1[15]); }
            pv_slab<DV>(vbuf, s, w, o, l32, hi);
        }
    } else {
        const float NEG = -__builtin_inff();
#pragma unroll
        for (int hk = 0; hk < 2; ++hk) {
            f32x16 p;
            const bool fresh = (st_m == NEG);
            const float mbase = fresh ? 0.f : st_m;
            { const float ini = (MASKED ? 0.f : cbias) - mbase;
#pragma unroll
              for (int r = 0; r < 16; ++r) p[r] = ini; }
            { const ALAS unsigned char* kb = kbuf + (32 * hk + l32) * KROW + hi * 16;
#pragma unroll
              for (int d0 = 0; d0 < 4; ++d0) { const bf16x8 k0 = *(const ALAS bf16x8*)(kb + d0 * 32); p = __builtin_amdgcn_mfma_f32_32x32x16_bf16(k0, qf[d0], p, 0, 0, 0); } }
            if (MASKED) {
                float bv[16];
#pragma unroll
                for (int r = 0; r < 16; ++r) { const int d0 = lim - 32 * hk - CR(r); bv[r] = btab[min(max(d0, 0), 127)]; }
#pragma unroll
                for (int r = 0; r < 16; ++r) asm volatile("" : "+v"(bv[r]));
#pragma unroll
                for (int r = 0; r < 16; ++r) {
                    const int d0 = lim - 32 * hk - CR(r);
                    const bool v0 = (MODE == 2) ? ((unsigned)d0 < 128u) : (d0 >= 0);
                    p[r] = v0 ? p[r] + bv[r] : NEG; }
            }
            float mt = fmaxf(p[0], p[1]);
#pragma unroll
            for (int r = 2; r < 16; ++r) mt = fmaxf(mt, p[r]);
            mt = fmaxf(mt, __shfl_xor(mt, 32));
            const bool need = fresh ? (mt > NEG) : (mt > 0.f);
            if (__any(need)) {
                const float dl = need ? mt : 0.f, f = fresh ? 1.0f : ex2(-dl);
                st_l *= f; st_m = need ? mbase + dl : st_m;
#pragma unroll
                for (int r = 0; r < 16; ++r) p[r] -= dl;
#pragma unroll
                for (int db = 0; db < DV / 32; ++db)
#pragma unroll
                    for (int r = 0; r < 16; ++r) o[db][r] *= f;
            }
            float s = 0.f;
#pragma unroll
            for (int r = 0; r < 16; ++r) { p[r] = ex2(p[r]); s += p[r]; }
            st_l += s;
#pragma unroll
            for (int s2 = 0; s2 < 2; ++s2) {
                u32x4 w; w.x = cvtpk(p[8 * s2], p[8 * s2 + 1]); w.y = cvtpk(p[8 * s2 + 2], p[8 * s2 + 3]); w.z = cvtpk(p[8 * s2 + 4], p[8 * s2 + 5]); w.w = cvtpk(p[8 * s2 + 6], p[8 * s2 + 7]);
                pv_slab<DV>(vbuf, 2 * hk + s2, w, o, l32, hi);
            }
        }
    }
}

template <int MODE, int DV>
__device__ __forceinline__ void attn_core(const bf16_t* Qp, const bf16_t* Kp, const bf16_t* Vp, int pitch, int q0, int kt0, int nt, int dir,
                                          ALAS unsigned char* lds, f32x16 (&o)[DV / 32], float& st_m, float& st_l) {
    int tid_ = threadIdx.x; asm volatile("" : "+v"(tid_));
    const int tid = tid_, lane = tid & 63, l32 = lane & 31, hi = lane >> 5, wid = __builtin_amdgcn_readfirstlane(tid >> 6);
    const int qw = q0 + 32 * wid, t = qw + l32;
    const ALAS float* btab = (const ALAS float*)(lds + L_BT);
    bf16x8 qf[4];
#pragma unroll
    for (int d0 = 0; d0 < 4; ++d0) qf[d0] = *(const bf16x8*)(Qp + (size_t)t * pitch + d0 * 16 + hi * 8);
#pragma unroll
    for (int db = 0; db < DV / 32; ++db)
#pragma unroll
        for (int r = 0; r < 16; ++r) o[db][r] = 0.f;
    st_m = (MODE == 0) ? 1.0f : -__builtin_inff(); st_l = 0.f;
    Pref<DV> pfA, pfB;
    tile_load<DV>(pfA, Kp, Vp, pitch, kt0, tid);
    tile_load<DV>(pfB, Kp, Vp, pitch, kt0 + dir * min(1, nt - 1), tid);
    tile_store<DV>(pfA, lds + L_K, lds + L_V, tid);
    __syncthreads();
    const float cbias = (MODE == 1) ? btab[127] : 0.f;
    bool done = false;
#define AC_STEP(it_, PFN, PFS) do { \
        const int it = (it_), kt = kt0 + dir * it, cur = it & 1, kbase = kt * 64; \
        tile_load<DV>(PFN, Kp, Vp, pitch, kt0 + dir * min(it + 2, nt - 1), tid);        \
        const ALAS unsigned char* kb = lds + L_K + cur * KBUF; const ALAS unsigned char* vb = lds + L_V + cur * VBUF; \
        const int lim = t - kbase - 4 * hi; \
        if (MODE == 0) { \
            if (kbase <= qw + 31 && __any(st_m != 0.0f)) { if (kbase + 63 >= qw) tile_compute<0, DV, true>(kb, vb, qf, o, st_m, st_l, lim, btab, cbias, lane); else tile_compute<0, DV, false>(kb, vb, qf, o, st_m, st_l, lim, btab, cbias, lane); } \
        } else if (MODE == 1) { \
            if (kbase <= qw + 31) { if (qw - (kbase + 63) < 113) tile_compute<1, DV, true>(kb, vb, qf, o, st_m, st_l, lim, btab, cbias, lane); else tile_compute<1, DV, false>(kb, vb, qf, o, st_m, st_l, lim, btab, cbias, lane); } \
        } else { \
            if (kbase <= qw + 31 && kbase + 63 >= qw - 127) tile_compute<2, DV, true>(kb, vb, qf, o, st_m, st_l, lim, btab, cbias, lane); \
        } \
        if (it + 1 < nt) tile_store<DV>(PFS, lds + L_K + (cur ^ 1) * KBUF, lds + L_V + (cur ^ 1) * VBUF, tid);     \
        if (MODE == 0) { \
              \
            if (!__syncthreads_or(st_m != 0.0f)) done = true; \
        } else __syncthreads(); } while (0)
    for (int it2 = 0; it2 < nt && !done; it2 += 2) {
        AC_STEP(it2, pfA, pfB);
        if (done) break;
        AC_STEP(it2 + 1, pfB, pfA);
    }
#undef AC_STEP
}
template <int MODE, int DV>
__device__ __forceinline__ void attn_core_pp(const bf16_t* Qp, const bf16_t* Kp, const bf16_t* Vp, int pitch, int q0, int kt0, int nt,
                                             ALAS unsigned char* lds, f32x16 (&o)[DV / 32], float& st_m, float& st_l) {
    int tid_ = threadIdx.x; asm volatile("" : "+v"(tid_));
    const int tid = tid_, lane = tid & 63, l32 = lane & 31, hi = lane >> 5, wid = __builtin_amdgcn_readfirstlane(tid >> 6), grp = wid >> 2;
    const int qw = q0 + 32 * wid, t = qw + l32;
    const ALAS float* btab = (const ALAS float*)(lds + L_BT);
    const float NEG = -__builtin_inff();
    bf16x8 qf[4];
#pragma unroll
    for (int d0 = 0; d0 < 4; ++d0) qf[d0] = *(const bf16x8*)(Qp + (size_t)t * pitch + d0 * 16 + hi * 8);
    ALAS unsigned char* qst = lds + L_QS + wid * 3072 + lane * 16;
    if (DV == 128) {
#pragma unroll
        for (int d0 = 1; d0 < 4; ++d0) *(ALAS bf16x8*)(qst + (d0 - 1) * 1024) = qf[d0];
    }
#pragma unroll
    for (int db = 0; db < DV / 32; ++db)
#pragma unroll
        for (int r = 0; r < 16; ++r) o[db][r] = 0.f;
    st_m = NEG; st_l = 0.f;
    Pref<DV> pfA, pfB;
    tile_load<DV>(pfA, Kp, Vp, pitch, kt0, tid);
    tile_load<DV>(pfB, Kp, Vp, pitch, kt0 + 1, tid);
    tile_store<DV>(pfA, lds + L_K, lds + L_V, tid);
    tile_store<DV>(pfB, lds + L_K + KBUF, lds + L_V + VBUF, tid);
    tile_load<DV>(pfA, Kp, Vp, pitch, kt0 + min(2, nt - 1), tid);
    tile_load<DV>(pfB, Kp, Vp, pitch, kt0 + min(3, nt - 1), tid);
    __syncthreads();
    const float cbias = (MODE == 1) ? btab[256 + 127] : 0.f;
    f32x16 p; u32x4 pw0, pw1;
#pragma unroll
    for (int r = 0; r < 16; ++r) p[r] = 0.f;
    pw0 = (u32x4){0u, 0u, 0u, 0u}; pw1 = pw0;
#define PP_MASKED(ti) ((MODE == 1) ? (qw - ((kt0 + (ti)) * 64 + 63) < 113) : true)
#define PP_PART(ti) ((MODE != 2) || ((kt0 + (ti)) * 64 <= qw + 31 && (kt0 + (ti)) * 64 + 63 >= qw - 127))
#define PP_QK(ti, hk) do { \
        const float mbase_ = (st_m == NEG) ? 0.f : st_m; const float ini_ = (PP_MASKED(ti) ? 0.f : cbias) - mbase_; \
        _Pragma("unroll") for (int r = 0; r < 16; ++r) p[r] = ini_; \
        const ALAS unsigned char* kb_ = lds + L_K + ((ti) & 1) * KBUF + (32 * (hk) + l32) * KROW + hi * 16; \
        _Pragma("unroll") for (int d0 = 0; d0 < 4; ++d0) { const bf16x8 k0_ = *(const ALAS bf16x8*)(kb_ + d0 * 32); \
            const bf16x8 qv_ = (DV == 128 && d0 > 0) ? *(const ALAS bf16x8*)(qst + (d0 - 1) * 1024) : qf[d0]; \
            p = __builtin_amdgcn_mfma_f32_32x32x16_bf16(k0_, qv_, p, 0, 0, 0); } } while (0)
#define PP_PVQK(tv, hv, tk, hq) do { \
        const ALAS unsigned char* vb_ = lds + L_V + ((tv) & 1) * VBUF + vtr_lane_off<DV>(lane); \
        const ALAS unsigned char* kb_ = lds + L_K + ((tk) & 1) * KBUF + (32 * (hq) + l32) * KROW + hi * 16; \
        if (PP_PART(tv)) { \
            bf16x8 vf_[DV / 32][2]; \
            _Pragma("unroll") for (int db = 0; db < DV / 32; ++db) { vf_[db][0] = vfrag<DV>(vb_, 2 * (hv), db); vf_[db][1] = vfrag<DV>(vb_, 2 * (hv) + 1, db); } \
            const bf16x8 pa_ = __builtin_bit_cast(bf16x8, pw0), pb_ = __builtin_bit_cast(bf16x8, pw1); \
            _Pragma("unroll") for (int db = 0; db < DV / 32; ++db) o[db] = __builtin_amdgcn_mfma_f32_32x32x16_bf16(vf_[db][0], pa_, o[db], 0, 0, 0); \
            _Pragma("unroll") for (int db = 0; db < DV / 32; ++db) o[db] = __builtin_amdgcn_mfma_f32_32x32x16_bf16(vf_[db][1], pb_, o[db], 0, 0, 0); } \
        if (PP_PART(tk)) { \
            bf16x8 kf_[4], qv_[4]; \
            _Pragma("unroll") for (int d0 = 0; d0 < 4; ++d0) { kf_[d0] = *(const ALAS bf16x8*)(kb_ + d0 * 32); qv_[d0] = (DV == 128 && d0 > 0) ? *(const ALAS bf16x8*)(qst + (d0 - 1) * 1024) : qf[d0]; } \
            const float mbase_ = (st_m == NEG) ? 0.f : st_m; const float ini_ = (PP_MASKED(tk) ? 0.f : cbias) - mbase_; \
            _Pragma("unroll") for (int r = 0; r < 16; ++r) p[r] = ini_; \
            _Pragma("unroll") for (int d0 = 0; d0 < 4; ++d0) p = __builtin_amdgcn_mfma_f32_32x32x16_bf16(kf_[d0], qv_[d0], p, 0, 0, 0); } } while (0)
#define PP_SM(ti, hk) do { if (PP_PART(ti)) { \
        if (PP_MASKED(ti)) { const int lim_ = t - (kt0 + (ti)) * 64 - 4 * hi - 32 * (hk); \
            const ALAS float* bp_ = btab + (lim_ + 256 - 27);            \
            float bv_[16]; \
            _Pragma("unroll") for (int r = 0; r < 16; ++r) bv_[r] = bp_[27 - CR(r)]; \
            _Pragma("unroll") for (int r = 0; r < 16; ++r) p[r] += bv_[r]; } \
        const bool fresh_ = (st_m == NEG); const float mb_ = fresh_ ? 0.f : st_m; \
        float mt_; { const float a0_ = fmaxf(fmaxf(p[0], p[1]), p[2]), a1_ = fmaxf(fmaxf(p[3], p[4]), p[5]), a2_ = fmaxf(fmaxf(p[6], p[7]), p[8]), a3_ = fmaxf(fmaxf(p[9], p[10]), p[11]), a4_ = fmaxf(fmaxf(p[12], p[13]), p[14]); \
            mt_ = fmaxf(fmaxf(fmaxf(a0_, a1_), a2_), fmaxf(fmaxf(a3_, a4_), p[15])); }        \
        mt_ = pair_max(mt_); \
        const bool need_ = fresh_ ? (mt_ > NEG) : (mt_ > 6.0f);        \
        if (__any(need_)) { const float dl_ = need_ ? mt_ : 0.f, f_ = fresh_ ? 1.0f : ex2(-dl_); \
            st_l *= f_; st_m = need_ ? mb_ + dl_ : st_m; \
            _Pragma("unroll") for (int r = 0; r < 16; ++r) p[r] -= dl_; \
            _Pragma("unroll") for (int db = 0; db < DV / 32; ++db) _Pragma("unroll") for (int r = 0; r < 16; ++r) o[db][r] *= f_; } \
        _Pragma("unroll") for (int r = 0; r < 16; ++r) p[r] = ex2(p[r]); \
        st_l += ((p[0] + p[1]) + (p[2] + p[3])) + ((p[4] + p[5]) + (p[6] + p[7])) + (((p[8] + p[9]) + (p[10] + p[11])) + ((p[12] + p[13]) + (p[14] + p[15]))); \
        pw0.x = cvtpk_a(p[0], p[1]); pw0.y = cvtpk_a(p[2], p[3]); pw0.z = cvtpk_a(p[4], p[5]); pw0.w = cvtpk_a(p[6], p[7]); \
        pw1.x = cvtpk_a(p[8], p[9]); pw1.y = cvtpk_a(p[10], p[11]); pw1.z = cvtpk_a(p[12], p[13]); pw1.w = cvtpk_a(p[14], p[15]); } } while (0)
#define PP_STAGE(u, PF) do { const int u_ = (u); if (u_ >= 2 && u_ < nt) tile_store<DV>(PF, lds + L_K + (u_ & 1) * KBUF, lds + L_V + (u_ & 1) * VBUF, tid); \
        tile_load<DV>(PF, Kp, Vp, pitch, kt0 + min(u_ + 2, nt - 1), tid); } while (0)
#define PP_BAR() asm volatile("s_waitcnt lgkmcnt(0)\n\ts_barrier" ::: "memory")
    if (grp == 1) __builtin_amdgcn_s_setprio(1);
    if (grp == 0) {
        PP_QK(0, 0); PP_BAR();
        for (int ti = 0; ti < nt; ti += 2) {
            PP_SM(ti, 0); PP_BAR();
            PP_PVQK(ti, 0, ti, 1); PP_STAGE(ti + 1, pfB); PP_BAR();
            PP_SM(ti, 1); PP_BAR();
            PP_PVQK(ti, 1, ti + 1, 0); PP_BAR();
            PP_SM(ti + 1, 0); PP_BAR();
            PP_PVQK(ti + 1, 0, ti + 1, 1); PP_STAGE(ti + 2, pfA); PP_BAR();
            PP_SM(ti + 1, 1); PP_BAR();
            PP_PVQK(ti + 1, 1, ti + 2, 0); PP_BAR();
        }
        PP_BAR();
    } else {
        PP_BAR();
        PP_QK(0, 0); PP_BAR();
        for (int ti = 0; ti < nt; ti += 2) {
            PP_SM(ti, 0); PP_STAGE(ti + 1, pfB); PP_BAR();
            PP_PVQK(ti, 0, ti, 1); PP_BAR();
            PP_SM(ti, 1); PP_BAR();
            PP_PVQK(ti, 1, ti + 1, 0); PP_BAR();
            PP_SM(ti + 1, 0); PP_STAGE(ti + 2, pfA); PP_BAR();
            PP_PVQK(ti + 1, 0, ti + 1, 1); PP_BAR();
            PP_SM(ti + 1, 1); PP_BAR();
            PP_PVQK(ti + 1, 1, ti + 2, 0); PP_BAR();
        }
    }
    __builtin_amdgcn_s_setprio(0);
#undef PP_MASKED
#undef PP_PART
#undef PP_QK
#undef PP_PVQK
#undef PP_SM
#undef PP_STAGE
#undef PP_BAR
}
template <int DV> __device__ __forceinline__ void store_ot(const f32x16 (&o)[DV / 32], bf16_t* orow, int hi) {
#pragma unroll
    for (int db = 0; db < DV / 32; ++db)
#pragma unroll
        for (int rg = 0; rg < 4; ++rg) { u32x2 w; w.x = cvtpk_a(o[db][4 * rg], o[db][4 * rg + 1]); w.y = cvtpk_a(o[db][4 * rg + 2], o[db][4 * rg + 3]);
            *(u32x2*)(orow + 32 * db + 8 * rg + 4 * hi) = w; }
}
}
#ifndef REP_PROLOG
#define REP_PROLOG 1
#endif
#ifndef RESID_BF16
#define RESID_BF16 1
#endif
#ifndef OUT_STAGGER_TICKS
#define OUT_STAGGER_TICKS 0
#endif
#ifndef OUT_STAGGER_GROUPS
#define OUT_STAGGER_GROUPS 2
#endif
#ifndef REP_OUT
#define REP_OUT 1
#endif
#ifndef REP_DOWN
#define REP_DOWN 1
#endif
#ifndef REP_INPROJ
#define REP_INPROJ 1
#endif
#ifndef REP_DIFF
#define REP_DIFF 1
#endif
#ifndef REP_SWA
#define REP_SWA 1
#endif
#ifndef REP_SB
#define REP_SB 1
#endif
#ifndef REP_UP
#define REP_UP 1
#endif
#ifndef REP_CONV
#define REP_CONV 1
#endif
#ifndef PH_DIFF
#define PH_DIFF 1
#endif
#ifndef PH_SWA
#define PH_SWA 1
#endif
#ifndef PH_SB
#define PH_SB 1
#endif
#ifndef PH_CONV
#define PH_CONV 1
#endif
#define LAS __attribute__((address_space(3)))
typedef unsigned short bf16;
typedef float f32x4 __attribute__((ext_vector_type(4)));
typedef unsigned v4u __attribute__((ext_vector_type(4)));
typedef unsigned v2u __attribute__((ext_vector_type(2)));
constexpr int NWAVES = 8;
constexpr int SEQ = 4096, NB = 16, MTOK = NB * SEQ, DM = 1024, DFF = 2816, DUP = 2 * DFF;
constexpr int EVEN_IN = 2304, ODD_IN = 3072;
constexpr size_t MiB = 1u << 20;
constexpr size_t WS_SSQ = 1 * MiB;
constexpr size_t WS_WINE = 8 * MiB, WS_WOUTE = 17 * MiB, WS_WINO = 21 * MiB, WS_WOUTO = 33 * MiB, WS_WUP = 37 * MiB, WS_WDN = 81 * MiB;
constexpr size_t WS_XB = 104 * MiB, WS_R = 232 * MiB;
constexpr size_t WS_PROJ = WS_R, WS_AO = WS_R + 384 * MiB, WS_U = WS_R, WS_G = WS_R + 352 * MiB;
constexpr int LDS_MISC = 152576, LDS_BYTES = 153600;
static_assert(att::L_QS + 8 * 3072 <= LDS_MISC, "LDS map");
constexpr int HALF_ROWS = MTOK / 2;

struct Args {
    const float* x; const float* rel_bias; const float* norm_mix; const float* norm_ffn; const float* norm_final;
    const float* w_in_even; const float* w_out_even; const float* sinks; const float* lam_q1; const float* lam_k1; const float* lam_q2; const float* lam_k2;
    const float* diff_norm; const float* w_in_odd; const float* w_out_odd; const float* ffn_up; const float* ffn_conv; const float* ffn_conv_b; const float* ffn_down;
    float* out; unsigned char* ws;
};

__device__ const unsigned char T5B[128] = {0, 1, 2, 3, 4, 5, 6, 7, 8, 9, 10, 11, 12, 13, 14, 15, 16, 16, 16, 17, 17, 18, 18, 18, 19, 19, 19, 20, 20, 20, 20, 21, 21, 21, 21, 22, 22, 22, 22, 22, 23, 23, 23, 23, 23, 23, 24, 24, 24, 24, 24, 24, 25, 25, 25, 25, 25, 25, 25, 26, 26, 26, 26, 26, 26, 26, 26, 27, 27, 27, 27, 27, 27, 27, 27, 27, 27, 28, 28, 28, 28, 28, 28, 28, 28, 28, 28, 29, 29, 29, 29, 29, 29, 29, 29, 29, 29, 29, 29, 30, 30, 30, 30, 30, 30, 30, 30, 30, 30, 30, 30, 30, 30, 31, 31, 31, 31, 31, 31, 31, 31, 31, 31, 31, 31, 31, 31, 31};

__device__ __forceinline__ float wave_sum(float v) {
#pragma unroll
    for (int o = 1; o < 64; o <<= 1) v += __shfl_xor(v, o);
    return v;
}
__device__ __forceinline__ unsigned f2bf(float f) { unsigned u = __builtin_bit_cast(unsigned, f); return (u + 0x7fffu + ((u >> 16) & 1u)) >> 16; }
__device__ __forceinline__ unsigned pk2(float lo, float hi) { return f2bf(lo) | (f2bf(hi) << 16); }

__device__ __forceinline__ void transpose_item(const float* W, int K, int N, bf16* WT, const float* gk, int a0, int a1, int b0, int b1, float cs, LAS float* scr, int item, int lane) {
    const int nblk = N / 32, kb = item / nblk, nb = item % nblk, k0 = 64 * kb, n0 = 32 * nb;
    const int nn = n0 + (lane & 31);
    const float csc = ((nn >= a0 && nn < a1) || (nn >= b0 && nn < b1)) ? cs : 1.0f;
    float tw[32];
#pragma unroll
    for (int i = 0; i < 32; ++i) tw[i] = __builtin_nontemporal_load(W + (size_t)(k0 + 2 * i + (lane >> 5)) * N + nn);
#pragma unroll
    for (int i = 0; i < 32; ++i) { const int kk = 2 * i + (lane >> 5); const float gv = gk ? gk[k0 + kk] : 1.0f; scr[kk * 33 + (lane & 31)] = tw[i] * (gv * csc); }
    asm volatile("s_waitcnt lgkmcnt(0)" ::: "memory");
    const int c = lane & 7;
#pragma unroll
    for (int j = 0; j < 4; ++j) { const int n = (lane >> 3) + 8 * j; const LAS float* s = scr + (8 * c) * 33 + n;
        v4u o; o.x = pk2(s[0 * 33], s[1 * 33]); o.y = pk2(s[2 * 33], s[3 * 33]); o.z = pk2(s[4 * 33], s[5 * 33]); o.w = pk2(s[6 * 33], s[7 * 33]);
        *(v4u*)(WT + (size_t)(n0 + n) * K + k0 + 8 * c) = o; }
    asm volatile("s_waitcnt lgkmcnt(0)" ::: "memory");
}

#define XB_TMO      128
#define XB_XCNT(j)  (256  + 64 * (j))
#define XB_XSUB(j)  (1280 + 64 * (j))
#define XB_XGEN(j)  (2304 + 64 * (j))
#define XB_TOP      3328
#define XB_TOPGEN   3392
#define XCD_BAR_WORDS 3456
#define XB_SPIN_CAP (1u << 18)

__device__ __forceinline__ unsigned xb_ld(unsigned* p)              { return __hip_atomic_load(p, __ATOMIC_RELAXED, __HIP_MEMORY_SCOPE_AGENT); }
__device__ __forceinline__ unsigned xb_add(unsigned* p, unsigned v) { return __hip_atomic_fetch_add(p, v, __ATOMIC_RELAXED, __HIP_MEMORY_SCOPE_AGENT); }
__device__ __forceinline__ unsigned xb_xcc_id() { return (unsigned)__builtin_amdgcn_s_getreg((3 << 11) | 20) & 0xFu; }
#define XB_SPIN(cond, bar) do { unsigned _sp = 0; while (cond) { __builtin_amdgcn_s_sleep(1); \
    if ((++_sp & 255u) == 0u) { if (xb_ld(&(bar)[XB_TMO])) break; if (_sp > XB_SPIN_CAP) { atomicAdd(&(bar)[XB_TMO], 1u); break; } } } } while (0)

struct XcdBarrier {
    unsigned* bar; unsigned x;
    volatile LAS unsigned* st;
};

__device__ __forceinline__ XcdBarrier xcd_barrier_post(unsigned* bar, volatile LAS unsigned* st) {
    XcdBarrier b; b.bar = bar; b.x = xb_xcc_id(); b.st = st;
    if (threadIdx.x == 0) (void)xb_add(&bar[XB_XCNT(b.x)], 1u);
    return b;
}
__device__ __forceinline__ void xcd_barrier_complete(unsigned* bar, unsigned x, unsigned& nloc, unsigned& nx) {
    const unsigned G = gridDim.x * gridDim.y * gridDim.z;
    unsigned sum, cnt, mine, sp = 0u;
    for (;;) {
        sum = 0u; cnt = 0u; mine = 0u;
#pragma unroll
        for (unsigned j = 0; j < 16; ++j) { const unsigned c = xb_ld(&bar[XB_XCNT(j)]); sum += c; cnt += (c > 0u) ? 1u : 0u; mine = (j == x) ? c : mine; }
        if (sum == G) break;
        __builtin_amdgcn_s_sleep(1);
        if ((++sp & 255u) == 0u) { if (xb_ld(&bar[XB_TMO])) break; if (sp > XB_SPIN_CAP) { atomicAdd(&bar[XB_TMO], 1u); break; } }
    }
    nloc = mine > 0u ? mine : 1u; nx = cnt > 0u ? cnt : 1u;
}

__device__ __forceinline__ void xcd_barrier(const XcdBarrier& b) {
    asm volatile("s_waitcnt vmcnt(0)" ::: "memory");
    __syncthreads();
    if (threadIdx.x == 0) {
        unsigned* bar = b.bar;
        __builtin_amdgcn_s_waitcnt(0);
        unsigned nloc = b.st[0], nx = b.st[1];
        if (nloc == 0u) { xcd_barrier_complete(bar, b.x, nloc, nx); b.st[0] = nloc; b.st[1] = nx; }
        const unsigned old = xb_add(&bar[XB_XSUB(b.x)], 1u);
        const unsigned gen = old / nloc;
        if (old + 1u == (gen + 1u) * nloc) {
            __builtin_amdgcn_fence(__ATOMIC_RELEASE, "agent");
            asm volatile("s_waitcnt vmcnt(0)" ::: "memory");
            const unsigned og = xb_add(&bar[XB_TOP], 1u);
            const unsigned tg = og / nx;
            if (og + 1u == (tg + 1u) * nx) xb_add(&bar[XB_TOPGEN], 1u);
            else XB_SPIN(xb_ld(&bar[XB_TOPGEN]) == tg, bar);
            __builtin_amdgcn_fence(__ATOMIC_ACQUIRE, "agent");
            xb_add(&bar[XB_XGEN(b.x)], 1u);
            asm volatile("s_waitcnt vmcnt(0)" ::: "memory");
        } else {
            XB_SPIN(xb_ld(&bar[XB_XGEN(b.x)]) == gen, bar);
            __builtin_amdgcn_fence(__ATOMIC_ACQUIRE, "agent");
            asm volatile("s_waitcnt vmcnt(0)" ::: "memory");
        }
    }
    __syncthreads();
}

__global__ void __launch_bounds__(NWAVES * 64, 2) mega_fwd(Args a) {
    extern __shared__ __attribute__((aligned(16))) unsigned char lds_raw[];
    cg::grid_group grid = cg::this_grid();
    LAS unsigned char* lds = (LAS unsigned char*)lds_raw;
    const int tid = threadIdx.x, lane = tid & 63, wave = __builtin_amdgcn_readfirstlane(tid >> 6);
    const int G = gridDim.x, bx = blockIdx.x;
    const int gw = bx * NWAVES + wave, NGW = G * NWAVES;
    const int vcu = (G % 8 == 0) ? (bx % 8) * (G / 8) + bx / 8 : bx;
    unsigned char* ws = a.ws;
    float* ssq = (float*)(ws + WS_SSQ);
    bf16* xb = (bf16*)(ws + WS_XB);
    bf16* proj = (bf16*)(ws + WS_PROJ);
    bf16* ao = (bf16*)(ws + WS_AO);
    bf16* ubuf = (bf16*)(ws + WS_U);
    bf16* gbuf = (bf16*)(ws + WS_G);

    if (bx == 0) for (int i = tid; i < XCD_BAR_WORDS; i += NWAVES * 64) ((unsigned*)ws)[i] = 0u;
    if (tid < 2) ((LAS unsigned*)(lds + LDS_MISC))[tid] = 0u;
    {
        LAS float* scr = (LAS float*)(lds + wave * 16384);
        constexpr int I_INE = 16 * (EVEN_IN / 32), I_OUT = 16 * 32, I_INO = 16 * (ODD_IN / 32), I_UP = 16 * (DUP / 32), I_DN = (DFF / 64) * 32;
        constexpr int NITEMS = 2 * I_INE + 2 * I_OUT + 2 * I_INO + 2 * I_OUT + 4 * I_UP + 4 * I_DN;
        for (int rep_ = 0; rep_ < REP_PROLOG; ++rep_)
        for (int it = gw; it < NITEMS; it += NGW) {
            int r = it;
            if (r < 2 * I_INE) { const int e = r / I_INE; r -= e * I_INE;
                transpose_item(a.w_in_even + (size_t)e * DM * EVEN_IN, DM, EVEN_IN, (bf16*)(ws + WS_WINE) + (size_t)e * EVEN_IN * DM, a.norm_mix + (2 * e) * DM, 0, 512, 768, 1280, att::QSCALE, scr, r, lane); continue; }
            r -= 2 * I_INE;
            if (r < 2 * I_OUT) { const int e = r / I_OUT; r -= e * I_OUT;
                transpose_item(a.w_out_even + (size_t)e * DM * DM, DM, DM, (bf16*)(ws + WS_WOUTE) + (size_t)e * DM * DM, nullptr, 0, 0, 0, 0, 1.f, scr, r, lane); continue; }
            r -= 2 * I_OUT;
            if (r < 2 * I_INO) { const int e = r / I_INO; r -= e * I_INO;
                transpose_item(a.w_in_odd + (size_t)e * DM * ODD_IN, DM, ODD_IN, (bf16*)(ws + WS_WINO) + (size_t)e * ODD_IN * DM, a.norm_mix + (2 * e + 1) * DM, 0, 1024, 0, 0, att::QSCALE, scr, r, lane); continue; }
            r -= 2 * I_INO;
            if (r < 2 * I_OUT) { const int e = r / I_OUT; r -= e * I_OUT;
                transpose_item(a.w_out_odd + (size_t)e * DM * DM, DM, DM, (bf16*)(ws + WS_WOUTO) + (size_t)e * DM * DM, nullptr, 0, 0, 0, 0, 1.f, scr, r, lane); continue; }
            r -= 2 * I_OUT;
            if (r < 4 * I_UP) { const int e = r / I_UP; r -= e * I_UP;
                transpose_item(a.ffn_up + (size_t)e * DM * DUP, DM, DUP, (bf16*)(ws + WS_WUP) + (size_t)e * DUP * DM, a.norm_ffn + e * DM, 0, 0, 0, 0, 1.f, scr, r, lane); continue; }
            r -= 4 * I_UP;
            { const int e = r / I_DN; r -= e * I_DN;
                transpose_item(a.ffn_down + (size_t)e * DFF * DM, DFF, DM, (bf16*)(ws + WS_WDN) + (size_t)e * DM * DFF, nullptr, 0, 0, 0, 0, 1.f, scr, r, lane); }
        }
        for (int m0 = 4 * gw; m0 < MTOK; m0 += 4 * NGW) {
            f32x4 v[4][4];
#pragma unroll
            for (int h2 = 0; h2 < 4; ++h2) { const f32x4* xr = (const f32x4*)(a.x + (size_t)(m0 + h2) * DM) + lane;
#pragma unroll
                for (int j = 0; j < 4; ++j) v[h2][j] = __builtin_nontemporal_load(xr + 64 * j); }
#pragma unroll
            for (int h2 = 0; h2 < 4; ++h2) { const int m = m0 + h2; float s = 0.f;
#pragma unroll
                for (int j = 0; j < 4; ++j) s += (v[h2][j][0] * v[h2][j][0] + v[h2][j][1] * v[h2][j][1]) + (v[h2][j][2] * v[h2][j][2] + v[h2][j][3] * v[h2][j][3]);
                s = wave_sum(s);
                v2u* o8 = (v2u*)(xb + (size_t)m * DM) + lane;
#pragma unroll
                for (int j = 0; j < 4; ++j) { v2u w; w.x = pk2(v[h2][j][0], v[h2][j][1]); w.y = pk2(v[h2][j][2], v[h2][j][3]); o8[64 * j] = w; }
                if (lane < 16) ssq[(size_t)m * 16 + lane] = (lane == 0) ? s : 0.f; }
        }
    }
    grid.sync();
    const XcdBarrier xbar = xcd_barrier_post((unsigned*)ws, (volatile LAS unsigned*)(lds + LDS_MISC));

    for (int layer = 0; layer < 4; ++layer) {
        const int e = layer >> 1; const bool even = (layer & 1) == 0;
        const float* xold = (layer == 0) ? a.x : a.out;
        {
            const int N = even ? EVEN_IN : ODD_IN;
            const bf16* wt = even ? (const bf16*)(ws + WS_WINE) + (size_t)e * EVEN_IN * DM : (const bf16*)(ws + WS_WINO) + (size_t)e * ODD_IN * DM;
            pg8::Gemm g{xb, wt, MTOK, N, DM}; pg8::StaticOrder S; S.init(MTOK, N, G, bx);
            pg8::EpiScaleBf16 E{proj, N, ssq};
            for (int rep_ = 0; rep_ < REP_INPROJ; ++rep_)
            pg8::gemm_phase<pg8::EpiScaleBf16, pg8::StaticOrder, true, true>(lds, g, S, E);
        }
        xcd_barrier(xbar);
        if (even) {
            int tq = threadIdx.x; asm volatile("" : "+v"(tq)); const int tid = tq, lane = tq & 63, l32 = lane & 31, hi = lane >> 5;
            float lam, one_m_li;
            { const float li = (layer == 0) ? 0.2f : 0.47071301839f;
              const float s1 = wave_sum(a.lam_q1[e * 64 + lane] * a.lam_k1[e * 64 + lane]), s2 = wave_sum(a.lam_q2[e * 64 + lane] * a.lam_k2[e * 64 + lane]);
              lam = __expf(s1) - __expf(s2) + li; lam = __builtin_bit_cast(float, __builtin_amdgcn_readfirstlane(__builtin_bit_cast(int, lam))); one_m_li = __builtin_bit_cast(float, __builtin_amdgcn_readfirstlane(__builtin_bit_cast(int, 1.0f - li))); }
            LAS float* btab = (LAS float*)(lds + att::L_BT);

#if PH_DIFF
            for (int rep_ = 0; rep_ < REP_DIFF; ++rep_)
            for (int uidx = vcu; uidx < 1024; uidx += G) {
                const int j = uidx >> 8, c = uidx & 255, bh = c >> 2, s = c & 3, b = bh >> 2, h = bh & 3;
                const int qb = (j == 0) ? s : (j == 1) ? 7 - s : (j == 2) ? 8 + s : 15 - s;
                { int tb = threadIdx.x; asm volatile("" : "+v"(tb)); const int dd = tb - 256;
                  btab[tb] = (dd < 0) ? -__builtin_inff() : a.rel_bias[T5B[dd < 127 ? dd : 127] * 12 + 8 + h] * att::LOG2E; }
                const bf16* base = proj + (size_t)b * SEQ * EVEN_IN;
                const int q0 = qb * 256, nt = 4 * qb + 4, t = q0 + 32 * wave + l32;
                att::f32x16 o2[4]; float m2, l2; LAS unsigned* o1s = (LAS unsigned*)(lds + att::L_O1 + wave * 8192) + lane;
                { float m1, l1;
                  att::attn_core_pp<1, 128>(base + 768 + h * 128, base + 1280 + h * 128, base + 1792 + h * 128, EVEN_IN, q0, 0, nt, lds, o2, m1, l1);
                  const float inv = __builtin_amdgcn_rcpf(l1 + __shfl_xor(l1, 32));
#pragma unroll
                  for (int db = 0; db < 4; ++db)
#pragma unroll
                      for (int k = 0; k < 8; ++k) o1s[(db * 8 + k) * 64] = att::cvtpk(o2[db][2 * k] * inv, o2[db][2 * k + 1] * inv); }
                att::attn_core_pp<1, 128>(base + 768 + h * 128 + 64, base + 1280 + h * 128 + 64, base + 1792 + h * 128, EVEN_IN, q0, 0, nt, lds, o2, m2, l2);
                { const float inv = lam * __builtin_amdgcn_rcpf(l2 + __shfl_xor(l2, 32)); float ss = 0.f;
#pragma unroll
                  for (int db = 0; db < 4; ++db)
#pragma unroll
                      for (int r = 0; r < 16; ++r) { const unsigned w = o1s[(db * 8 + (r >> 1)) * 64]; const float a1 = __uint_as_float((r & 1) ? (w & 0xffff0000u) : (w << 16));
                          const float v = a1 - inv * o2[db][r]; o2[db][r] = v; ss += v * v; }
                  ss += __shfl_xor(ss, 32);
                  const float rs = __builtin_amdgcn_rsqf(ss * (1.0f / 128.0f) + 1e-6f) * one_m_li;
                  const float* gn = a.diff_norm + e * 128;
#pragma unroll
                  for (int db = 0; db < 4; ++db)
#pragma unroll
                      for (int rg = 0; rg < 4; ++rg) { const f32x4 gv = *(const f32x4*)(gn + 32 * db + 8 * rg + 4 * hi);
#pragma unroll
                          for (int k = 0; k < 4; ++k) o2[db][4 * rg + k] *= rs * gv[k]; } }
                { int tb = threadIdx.x; asm volatile("" : "+v"(tb)); const int t2 = q0 + 32 * (tb >> 6) + (tb & 31);
                  att::store_ot<128>(o2, ao + ((size_t)b * SEQ + t2) * DM + 512 + h * 128, (tb >> 5) & 1); }
            }
#endif
#if PH_SWA
            for (int rep_ = 0; rep_ < REP_SWA; ++rep_)
            for (int uidx = vcu; uidx < 2048; uidx += G) {
                const int qb = uidx & 15, qh = (uidx >> 4) & 7, b = uidx >> 7, kvh = qh >> 2;
                { int tb = threadIdx.x; asm volatile("" : "+v"(tb)); const int dd = tb - 256;
                  btab[tb] = (dd < 0 || dd >= 128) ? -__builtin_inff() : a.rel_bias[T5B[dd] * 12 + qh] * att::LOG2E; }
                const bf16* base = proj + (size_t)b * SEQ * EVEN_IN;
                const int q0 = qb * 256, t = q0 + 32 * wave + l32;
                const int kt0 = (qb * 4 - 2 > 0) ? qb * 4 - 2 : 0, nt = qb * 4 + 4 - kt0;
                att::f32x16 o[2]; float m, l;
                att::attn_core_pp<2, 64>(base + qh * 64, base + 512 + kvh * 64, base + 640 + kvh * 64, EVEN_IN, q0, kt0, nt, lds, o, m, l);
                const float sk = a.sinks[e * 8 + qh] * att::LOG2E;
                const float inv = __builtin_amdgcn_rcpf(l + __shfl_xor(l, 32) + __builtin_amdgcn_exp2f(sk - m));
#pragma unroll
                for (int db = 0; db < 2; ++db)
#pragma unroll
                    for (int r = 0; r < 16; ++r) o[db][r] *= inv;
                att::store_ot<64>(o, ao + ((size_t)b * SEQ + t) * DM + qh * 64, hi);
            }
#endif
        } else {
#if PH_SB
            int tq = threadIdx.x; asm volatile("" : "+v"(tq)); const int lane = tq & 63, l32 = lane & 31, hi = lane >> 5;
            for (int rep_ = 0; rep_ < REP_SB; ++rep_)
            for (int uidx = bx; uidx < 4096; uidx += G) {
                const int bh = uidx & 255, qb = 15 - (uidx >> 8), b = bh >> 4, h = bh & 15;
                const bf16* base = proj + (size_t)b * SEQ * ODD_IN;
                const int q0 = qb * 256, nt = 4 * qb + 4, t = q0 + 32 * wave + l32;
                att::f32x16 o[2]; float P, dummy;
                att::attn_core<0, 64>(base + h * 64, base + 1024 + h * 64, base + 2048 + h * 64, ODD_IN, q0, nt - 1, nt, -1, lds, o, P, dummy);
                att::store_ot<64>(o, ao + ((size_t)b * SEQ + t) * DM + h * 64, hi);
            }
#endif
        }
        xcd_barrier(xbar);
        {
            const bf16* wt = even ? (const bf16*)(ws + WS_WOUTE) + (size_t)e * DM * DM : (const bf16*)(ws + WS_WOUTO) + (size_t)e * DM * DM;
            pg8::Gemm g{ao, wt, MTOK, DM, DM}; pg8::StaticOrder S; S.init(MTOK, DM, G, bx);
#if OUT_STAGGER_TICKS > 0
            { const unsigned long long t0 = __builtin_amdgcn_s_memrealtime(); const unsigned long long dly = (unsigned long long)(((bx >> 3) & (OUT_STAGGER_GROUPS - 1)) * OUT_STAGGER_TICKS);
              while (__builtin_amdgcn_s_memrealtime() - t0 < dly) __builtin_amdgcn_s_sleep(8); }
#endif
#if REP_OUT == 2
            { pg8::EpiResid Ed{xold, (float*)(ws + WS_PROJ), (bf16*)(ws + WS_PROJ + 256 * MiB), (float*)(ws + 800 * MiB)};
              pg8::gemm_phase<pg8::EpiResid, pg8::StaticOrder, true, true>(lds, g, S, Ed); }
#elif REP_OUT == 3
            { pg8::EpiScaleBf16 Ed{(bf16*)(ws + WS_PROJ), DM, ssq};
              pg8::gemm_phase<pg8::EpiScaleBf16, pg8::StaticOrder, true, true>(lds, g, S, Ed); }
#endif
#if RESID_BF16
            pg8::EpiResidB E{xb, xb, ssq};
            pg8::gemm_phase<pg8::EpiResidB, pg8::StaticOrder, true, true>(lds, g, S, E);
#else
            pg8::EpiResid E{xold, a.out, xb, ssq};
            pg8::gemm_phase<pg8::EpiResid, pg8::StaticOrder, true, true>(lds, g, S, E);
#endif
        }
        xcd_barrier(xbar);
        const bf16* wup = (const bf16*)(ws + WS_WUP) + (size_t)layer * DUP * DM;
        const bf16* wdn = (const bf16*)(ws + WS_WDN) + (size_t)layer * DM * DFF;
        for (int half = 0; half < 2; ++half) {
            const size_t r0 = (size_t)half * HALF_ROWS;
            {
                pg8::Gemm g{xb + r0 * DM, wup, HALF_ROWS, DUP, DM}; pg8::StaticOrder S; S.init(HALF_ROWS, DUP, G, bx);
                pg8::EpiScaleBf16 E{ubuf, DUP, ssq + r0 * 16};
                for (int rep_ = 0; rep_ < REP_UP; ++rep_)
                pg8::gemm_phase<pg8::EpiScaleBf16, pg8::StaticOrder, true, true>(lds, g, S, E);
            }
            xcd_barrier(xbar);
#if PH_CONV
            {
                const float* cw = a.ffn_conv + (size_t)layer * 3 * DUP; const float* cb = a.ffn_conv_b + (size_t)layer * DUP;
                constexpr int NCC = 6, NRC = HALF_ROWS / 32;
                int tq = threadIdx.x; asm volatile("" : "+v"(tq)); const int lane = tq & 63;
                for (int rep_ = 0; rep_ < REP_CONV; ++rep_)
                for (int it = gw; it < NCC * NRC; it += NGW) {
                    const int cc = it % NCC, rc = it / NCC, cgp = cc * 64 + lane;
                    if (cgp < DFF / 8) {
                        const int col = cgp * 8, row0 = rc * 32;
                        float wg[3][8], wv[3][8], bg[8], bv[8];
#pragma unroll
                        for (int tp = 0; tp < 3; ++tp)
#pragma unroll
                            for (int k = 0; k < 8; k += 4) { const f32x4 t1 = *(const f32x4*)(cw + tp * DUP + col + k), t2 = *(const f32x4*)(cw + tp * DUP + DFF + col + k);
#pragma unroll
                                for (int q = 0; q < 4; ++q) { wg[tp][k + q] = t1[q]; wv[tp][k + q] = t2[q]; } }
#pragma unroll
                        for (int k = 0; k < 8; k += 4) { const f32x4 t1 = *(const f32x4*)(cb + col + k), t2 = *(const f32x4*)(cb + DFF + col + k);
#pragma unroll
                            for (int q = 0; q < 4; ++q) { bg[k + q] = t1[q]; bv[k + q] = t2[q]; } }
                        float g2[8], g1[8], v2[8], v1[8];
                        const bool head = (row0 % SEQ) == 0;
                        {
                            v4u a2 = {0, 0, 0, 0}, a1 = {0, 0, 0, 0}, c2 = {0, 0, 0, 0}, c1 = {0, 0, 0, 0};
                            if (!head) { const bf16* up = ubuf + (size_t)(row0 - 2) * DUP + col; a2 = *(const v4u*)up; c2 = *(const v4u*)(up + DFF); a1 = *(const v4u*)(up + DUP); c1 = *(const v4u*)(up + DUP + DFF); }
#pragma unroll
                            for (int k = 0; k < 8; ++k) { const int sh = (k & 1) * 16;
                                g2[k] = __uint_as_float(((a2[k >> 1] >> sh) & 0xffffu) << 16); g1[k] = __uint_as_float(((a1[k >> 1] >> sh) & 0xffffu) << 16);
                                v2[k] = __uint_as_float(((c2[k >> 1] >> sh) & 0xffffu) << 16); v1[k] = __uint_as_float(((c1[k >> 1] >> sh) & 0xffffu) << 16); }
                        }
                        for (int r4 = 0; r4 < 32; r4 += 8) {
                            v4u av[8], cv[8];
#pragma unroll
                            for (int rr = 0; rr < 8; ++rr) { const bf16* up = ubuf + (size_t)(row0 + r4 + rr) * DUP + col;
                                av[rr] = __builtin_nontemporal_load((const v4u*)up); cv[rr] = __builtin_nontemporal_load((const v4u*)(up + DFF)); }
#pragma unroll
                            for (int rr = 0; rr < 8; ++rr) {
                                const v4u a0 = av[rr], c0 = cv[rr];
                                float res[8];
#pragma unroll
                                for (int k = 0; k < 8; ++k) { const int sh = (k & 1) * 16;
                                    const float g0 = __uint_as_float(((a0[k >> 1] >> sh) & 0xffffu) << 16), v0 = __uint_as_float(((c0[k >> 1] >> sh) & 0xffffu) << 16);
                                    const float gg = bg[k] + wg[0][k] * g2[k] + wg[1][k] * g1[k] + wg[2][k] * g0;
                                    const float vv = bv[k] + wv[0][k] * v2[k] + wv[1][k] * v1[k] + wv[2][k] * v0;
                                    const float sg = gg * __builtin_amdgcn_rcpf(1.0f + __builtin_amdgcn_exp2f(-gg * att::LOG2E));
                                    res[k] = sg * vv; g2[k] = g1[k]; g1[k] = g0; v2[k] = v1[k]; v1[k] = v0; }
                                v4u w; w.x = pk2(res[0], res[1]); w.y = pk2(res[2], res[3]); w.z = pk2(res[4], res[5]); w.w = pk2(res[6], res[7]);
                                *(v4u*)(gbuf + (size_t)(row0 + r4 + rr) * DFF + col) = w;
                            }
                        }
                    }
                }
            }
#endif
            xcd_barrier(xbar);
            {
                pg8::Gemm g{gbuf, wdn, HALF_ROWS, DM, DFF}; pg8::StaticOrder S; S.init(HALF_ROWS, DM, G, bx);
#if REP_DOWN > 1
                { pg8::EpiResid Ed{a.out + r0 * DM, (float*)(ws + 760 * MiB), (bf16*)(ws + 888 * MiB), (float*)(ws + 960 * MiB)};
                  pg8::gemm_phase<pg8::EpiResid, pg8::StaticOrder, true, true>(lds, g, S, Ed); }
#endif
#if RESID_BF16
                pg8::EpiResidB E{xb + r0 * DM, xb + r0 * DM, ssq + r0 * 16};
                pg8::gemm_phase<pg8::EpiResidB, pg8::StaticOrder, true, true>(lds, g, S, E);
#else
                pg8::EpiResid E{a.out + r0 * DM, a.out + r0 * DM, xb + r0 * DM, ssq + r0 * 16};
                pg8::gemm_phase<pg8::EpiResid, pg8::StaticOrder, true, true>(lds, g, S, E);
#endif
            }
            if (half == 1) xcd_barrier(xbar);
        }
    }
    { int tq = threadIdx.x; asm volatile("" : "+v"(tq)); const int lane = tq & 63;
    for (int m0 = 4 * gw; m0 < MTOK; m0 += 4 * NGW) {
#if RESID_BF16
        v2u win[4][4];
#pragma unroll
        for (int h4 = 0; h4 < 4; ++h4) { const v2u* xin = (const v2u*)(xb + (size_t)(m0 + h4) * DM) + lane;
#pragma unroll
            for (int j = 0; j < 4; ++j) win[h4][j] = __builtin_nontemporal_load(xin + 64 * j); }
#endif
#pragma unroll
        for (int h4 = 0; h4 < 4; ++h4) { const int m = m0 + h4;
            f32x4* xr = (f32x4*)(a.out + (size_t)m * DM) + lane; f32x4 v[4]; float s = 0.f;
#if RESID_BF16
#pragma unroll
            for (int j = 0; j < 4; ++j) { const v2u w = win[h4][j]; v[j][0] = __uint_as_float(w.x << 16); v[j][1] = __uint_as_float(w.x & 0xffff0000u); v[j][2] = __uint_as_float(w.y << 16); v[j][3] = __uint_as_float(w.y & 0xffff0000u);
                s += (v[j][0] * v[j][0] + v[j][1] * v[j][1]) + (v[j][2] * v[j][2] + v[j][3] * v[j][3]); }
#else
#pragma unroll
            for (int j = 0; j < 4; ++j) { v[j] = xr[64 * j]; s += (v[j][0] * v[j][0] + v[j][1] * v[j][1]) + (v[j][2] * v[j][2] + v[j][3] * v[j][3]); }
#endif
            s = wave_sum(s);
            const float rs = __builtin_amdgcn_rsqf(s * (1.0f / DM) + 1e-6f);
#pragma unroll
            for (int j = 0; j < 4; ++j) { const f32x4 gv = *((const f32x4*)a.norm_final + lane + 64 * j); xr[64 * j] = v[j] * rs * gv; } }
    } }
}

extern "C" void kernel_launch(void* const* d_in, const int* in_sizes, int n_in, void* d_out, int out_size, void* d_ws, size_t ws_size, hipStream_t stream) {
    static int grid = 0;
    if (grid == 0) {
        int dev = 0, cus = 0, per_cu = 0;
        (void)hipGetDevice(&dev);
        (void)hipDeviceGetAttribute(&cus, hipDeviceAttributeMultiprocessorCount, dev);
        (void)hipFuncSetAttribute((const void*)mega_fwd, hipFuncAttributeMaxDynamicSharedMemorySize, LDS_BYTES);
        (void)hipOccupancyMaxActiveBlocksPerMultiprocessor(&per_cu, (const void*)mega_fwd, NWAVES * 64, LDS_BYTES);
        if (per_cu < 1) per_cu = 1;
        grid = cus * per_cu;
        if (n_in != 19 || ws_size < 1024 * MiB) fprintf(stderr, "kernel_launch: unexpected n_in %d / ws %zu\n", n_in, ws_size);
    }
    Args a{};
    a.x = (const float*)d_in[0]; a.rel_bias = (const float*)d_in[1]; a.norm_mix = (const float*)d_in[2]; a.norm_ffn = (const float*)d_in[3]; a.norm_final = (const float*)d_in[4];
    a.w_in_even = (const float*)d_in[5]; a.w_out_even = (const float*)d_in[6]; a.sinks = (const float*)d_in[7]; a.lam_q1 = (const float*)d_in[8]; a.lam_k1 = (const float*)d_in[9];
    a.lam_q2 = (const float*)d_in[10]; a.lam_k2 = (const float*)d_in[11]; a.diff_norm = (const float*)d_in[12]; a.w_in_odd = (const float*)d_in[13]; a.w_out_odd = (const float*)d_in[14];
    a.ffn_up = (const float*)d_in[15]; a.ffn_conv = (const float*)d_in[16]; a.ffn_conv_b = (const float*)d_in[17]; a.ffn_down = (const float*)d_in[18];
    a.out = (float*)d_out; a.ws = (unsigned char*)d_ws;
    void* args[] = {&a};
    hipError_t err = hipLaunchCooperativeKernel((const void*)mega_fwd, dim3(grid), dim3(NWAVES * 64), args, LDS_BYTES, stream);
    if (err != hipSuccess) fprintf(stderr, "kernel_launch: cooperative launch failed: %s (grid %d)\n", hipGetErrorString(err), grid);
}
```
